# Optimizing an MI355X kernel written in HIP

```python
import jax, jax.numpy as jnp
from jax import lax
import numpy as np

D_MODEL = 1024
BATCH = 32
SEQ = 2048
DEPTH = 4

CHUNK = 64
N_MIXERS = 2
N_HGRN_LAYERS = (DEPTH + N_MIXERS - 1) // N_MIXERS
N_RET_LAYERS = DEPTH // N_MIXERS

HG_DK = 128
HG_HEADS = D_MODEL // HG_DK
HG_DV = D_MODEL // HG_HEADS
HG_BLOCK = 16

RET_DK = 256
RET_HEADS = D_MODEL // RET_DK
RET_DV = 2 * RET_DK
ROPE_BASE = 10000.0
MAX_POS_OFFSET = 4096

N_EXPERTS = 32
TOP_K = 4
D_EXPERT = D_MODEL
SWIGLU_ALPHA = 1.702
SWIGLU_LIMIT = 7.0
MOE_BLOCK = 512

EPS = 1e-6

kernel_name = 'hybrid_hgrn2_retention_moe_adaln'


def rms_norm(x, g=None):
    x32 = x.astype(jnp.float32)
    y = x32 * lax.rsqrt(jnp.mean(x32 * x32, axis=-1, keepdims=True) + EPS)
    if g is not None:
        y = y * g.astype(jnp.float32)
    return y.astype(x.dtype)


def hgrn_lower_bounds(lb_logits):
    p = jax.nn.softmax(lb_logits.astype(jnp.float32), axis=0)
    cum = jnp.cumsum(p, axis=0)
    return cum - cum[0:1]


def hgrn2_mixer(h, w_in, w_out, o_gain, lb):
    B, S, _ = h.shape
    hk = HG_HEADS * HG_DK
    hv = HG_HEADS * HG_DV
    proj = h @ w_in
    q, f, i, g = jnp.split(proj, [hk, 2 * hk, 2 * hk + hv], axis=-1)
    f = f.astype(jnp.float32)
    log_f = jnp.logaddexp(jnp.log(lb), jnp.log1p(-lb) + jax.nn.log_sigmoid(f))
    k = (1.0 - lb) * jax.nn.sigmoid(-f)
    q = jax.nn.silu(q.astype(jnp.float32))
    v = i.astype(jnp.float32)
    L = HG_BLOCK
    nb = S // L

    def to_blocks(t, d):
        return t.reshape(B, nb, L, HG_HEADS, d).transpose(1, 0, 3, 2, 4)

    qb, kb, gb = to_blocks(q, HG_DK), to_blocks(k, HG_DK), to_blocks(log_f, HG_DK)
    vb = to_blocks(v, HG_DV)
    tri = jnp.tril(jnp.ones((L, L), dtype=bool))[:, :, None]

    def step(state, blk):
        qc, kc, vc, gc = blk
        b = jnp.cumsum(gc, axis=2)
        o = jnp.einsum('bhtd,bhdv->bhtv', qc * jnp.exp(b), state)
        diff = b[:, :, :, None, :] - b[:, :, None, :, :]
        decay = jnp.where(tri, jnp.exp(jnp.minimum(diff, 0.0)), 0.0)
        att = jnp.einsum('bhtd,bhsd,bhtsd->bhts', qc, kc, decay)
        o = o + jnp.einsum('bhts,bhsv->bhtv', att, vc)
        b_last = b[:, :, -1:, :]
        state = jnp.exp(b_last[:, :, 0, :, None]) * state + jnp.einsum('bhsd,bhsv->bhdv', kc * jnp.exp(b_last - b), vc)
        return state, o

    s0 = jnp.zeros((B, HG_HEADS, HG_DK, HG_DV), jnp.float32)
    _, o = lax.scan(step, s0, (qb, kb, vb, gb))
    o = o.transpose(1, 0, 3, 2, 4).reshape(B, S, HG_HEADS, HG_DV)
    o = rms_norm(o, o_gain) * jax.nn.silu(g.astype(jnp.float32).reshape(B, S, HG_HEADS, HG_DV))
    return o.reshape(B, S, hv).astype(h.dtype) @ w_out


def rotate(x, cos, sin):
    half = x.shape[-1] // 2
    x1, x2 = x[..., :half], x[..., half:]
    return jnp.concatenate([x1 * cos - x2 * sin, x2 * cos + x1 * sin], axis=-1)


def retention_mixer(h, positions, w_in, w_out):
    B, S, _ = h.shape
    hq = RET_HEADS * RET_DK
    hv = RET_HEADS * RET_DV
    proj = h @ w_in
    q, k, v, g = jnp.split(proj, [hq, 2 * hq, 2 * hq + hv], axis=-1)
    q = q.astype(jnp.float32).reshape(B, S, RET_HEADS, RET_DK)
    k = k.astype(jnp.float32).reshape(B, S, RET_HEADS, RET_DK)
    v = v.astype(jnp.float32).reshape(B, S, RET_HEADS, RET_DV)
    inv_freq = 1.0 / (ROPE_BASE ** jnp.linspace(0.0, 1.0, RET_DK // 2, dtype=jnp.float32))
    ang = positions.astype(jnp.float32)[..., None] * inv_freq
    cos = jnp.cos(ang)[:, :, None, :]
    sin = jnp.sin(ang)[:, :, None, :]
    q = rotate(q, cos, sin)
    k = rotate(k, cos, sin) * (RET_DK ** -0.5)
    log_gamma = jnp.log(1.0 - 2.0 ** (-5.0 - jnp.arange(RET_HEADS, dtype=jnp.float32)))
    idx = jnp.arange(CHUNK, dtype=jnp.float32)
    dmat = jnp.exp(jnp.abs(idx[:, None] - idx[None, :])[None] * log_gamma[:, None, None])
    q_decay = jnp.exp((idx + 1.0)[None] * log_gamma[:, None])[None, :, :, None]
    k_decay = jnp.exp((CHUNK - 1.0 - idx)[None] * log_gamma[:, None])[None, :, :, None]
    chunk_decay = jnp.exp(CHUNK * log_gamma)[None, :, None, None]
    nc = S // CHUNK

    def to_chunks(t, d):
        return t.reshape(B, nc, CHUNK, RET_HEADS, d).transpose(1, 0, 3, 2, 4)

    qc_all, kc_all, vc_all = to_chunks(q, RET_DK), to_chunks(k, RET_DK), to_chunks(v, RET_DV)

    def step(R, blk):
        qc, kc, vc = blk
        sc = jnp.einsum('bhnd,bhmd->bhnm', qc, kc) * dmat
        o = jnp.einsum('bhnm,bhmv->bhnv', sc, vc) + jnp.einsum('bhnd,bhdv->bhnv', qc, R) * q_decay
        R = chunk_decay * R + jnp.einsum('bhmd,bhmv->bhdv', kc * k_decay, vc)
        return R, o

    R0 = jnp.zeros((B, RET_HEADS, RET_DK, RET_DV), jnp.float32)
    _, o = lax.scan(step, R0, (qc_all, kc_all, vc_all))
    o = o.transpose(1, 0, 3, 2, 4).reshape(B, S, RET_HEADS, RET_DV)
    o = rms_norm(o) * jax.nn.silu(g.astype(jnp.float32).reshape(B, S, RET_HEADS, RET_DV))
    return o.reshape(B, S, hv).astype(h.dtype) @ w_out


def moe_ffn(h, router_w, router_b, w1, b1, w2, b2):
    N, D = h.shape
    logits = (h @ router_w + router_b).astype(jnp.float32)
    top_logit, top_idx = lax.top_k(logits, TOP_K)
    gate = jax.nn.softmax(top_logit, axis=-1)
    n_assign = N * TOP_K
    flat_e = top_idx.reshape(-1)
    order = jnp.argsort(flat_e)
    e_sorted = flat_e[order]
    tok_sorted = (order // TOP_K).astype(jnp.int32)
    w_sorted = gate.reshape(-1)[order]
    counts = jnp.bincount(flat_e, length=N_EXPERTS)
    padded = (counts + MOE_BLOCK - 1) // MOE_BLOCK * MOE_BLOCK
    pad_end = jnp.cumsum(padded)
    pad_start = pad_end - padded
    start = jnp.cumsum(counts) - counts
    dest = pad_start[e_sorted] + jnp.arange(n_assign, dtype=jnp.int32) - start[e_sorted]
    n_blocks = -(-n_assign // MOE_BLOCK) + N_EXPERTS
    n_rows = n_blocks * MOE_BLOCK
    row_tok = jnp.zeros((n_rows,), jnp.int32).at[dest].set(tok_sorted)
    row_w = jnp.zeros((n_rows,), jnp.float32).at[dest].set(w_sorted)
    block_e = jnp.minimum(jnp.searchsorted(pad_end, jnp.arange(n_blocks, dtype=jnp.int32) * MOE_BLOCK, side='right'), N_EXPERTS - 1)
    xb = h[row_tok].reshape(n_blocks, MOE_BLOCK, D)
    wb = row_w.reshape(n_blocks, MOE_BLOCK).astype(h.dtype)

    def expert_block(args):
        xe, we, e = args
        u = xe @ w1[e] + b1[e]
        glu, lin = jnp.split(u, 2, axis=-1)
        glu = jnp.minimum(glu, SWIGLU_LIMIT)
        lin = jnp.clip(lin, -SWIGLU_LIMIT, SWIGLU_LIMIT)
        a = glu * jax.nn.sigmoid(SWIGLU_ALPHA * glu) * (lin + 1.0)
        return (a @ w2[e] + b2[e]) * we[:, None]

    y = lax.map(expert_block, (xb, wb, block_e)).reshape(n_rows, D)
    return jax.ops.segment_sum(y, row_tok, num_segments=N)


def setup_inputs(seed: int = 0) -> dict:
    key = jax.random.key(seed)
    ks = jax.random.split(key, 24)
    f32 = jnp.float32

    def nrm(k, shape, scale):
        return jax.random.normal(k, shape, f32) * scale

    hk = HG_HEADS * HG_DK
    hv = HG_HEADS * HG_DV
    rq = RET_HEADS * RET_DK
    rv = RET_HEADS * RET_DV
    x = nrm(ks[0], (BATCH, SEQ, D_MODEL), 1.0)
    c = nrm(ks[1], (BATCH, D_MODEL), 1.0)
    offsets = jax.random.randint(ks[2], (BATCH, 1), 0, MAX_POS_OFFSET, dtype=jnp.int32)
    positions = offsets + jnp.arange(SEQ, dtype=jnp.int32)[None, :]
    return {
        'x': x,
        'c': c,
        'positions': positions,
        'ada_w': nrm(ks[3], (DEPTH, D_MODEL, 6 * D_MODEL), 0.5 * D_MODEL ** -0.5),
        'ada_b': nrm(ks[4], (DEPTH, 6 * D_MODEL), 0.02),
        'norm1_g': 1.0 + nrm(ks[5], (DEPTH, D_MODEL), 0.02),
        'norm2_g': 1.0 + nrm(ks[6], (DEPTH, D_MODEL), 0.02),
        'hgrn_w_in': nrm(ks[7], (N_HGRN_LAYERS, D_MODEL, 2 * hk + 2 * hv), D_MODEL ** -0.5),
        'hgrn_w_out': nrm(ks[8], (N_HGRN_LAYERS, hv, D_MODEL), hv ** -0.5),
        'hgrn_o_gain': 1.0 + nrm(ks[9], (N_HGRN_LAYERS, HG_DV), 0.02),
        'hgrn_lb_logits': nrm(ks[10], (N_HGRN_LAYERS, hk), 0.5),
        'ret_w_in': nrm(ks[11], (N_RET_LAYERS, D_MODEL, 2 * rq + 2 * rv), D_MODEL ** -0.5),
        'ret_w_out': nrm(ks[12], (N_RET_LAYERS, rv, D_MODEL), rv ** -0.5),
        'router_w': nrm(ks[13], (DEPTH, D_MODEL, N_EXPERTS), D_MODEL ** -0.5),
        'router_b': nrm(ks[14], (DEPTH, N_EXPERTS), 0.01),
        'moe_w1': nrm(ks[15], (DEPTH, N_EXPERTS, D_MODEL, 2 * D_EXPERT), D_MODEL ** -0.5),
        'moe_b1': nrm(ks[16], (DEPTH, N_EXPERTS, 2 * D_EXPERT), 0.01),
        'moe_w2': nrm(ks[17], (DEPTH, N_EXPERTS, D_EXPERT, D_MODEL), D_EXPERT ** -0.5),
        'moe_b2': nrm(ks[18], (DEPTH, N_EXPERTS, D_MODEL), 0.01),
        'final_g': 1.0 + nrm(ks[19], (D_MODEL,), 0.02),
        'final_ada_w': nrm(ks[20], (D_MODEL, 2 * D_MODEL), 0.5 * D_MODEL ** -0.5),
        'final_ada_b': nrm(ks[21], (2 * D_MODEL,), 0.02),
    }


def reference(x, c, positions, ada_w, ada_b, norm1_g, norm2_g, hgrn_w_in, hgrn_w_out, hgrn_o_gain, hgrn_lb_logits, ret_w_in, ret_w_out, router_w, router_b, moe_w1, moe_b1, moe_w2, moe_b2, final_g, final_ada_w, final_ada_b):
    B, S, D = x.shape
    cond = jax.nn.silu(c)
    lbs = hgrn_lower_bounds(hgrn_lb_logits)
    for layer in range(DEPTH):
        mod = (cond @ ada_w[layer] + ada_b[layer])[:, None, :]
        sh1, sc1, g1, sh2, sc2, g2 = jnp.split(mod, 6, axis=-1)
        h = rms_norm(x, norm1_g[layer]) * (1.0 + sc1) + sh1
        j = layer // N_MIXERS
        if layer % N_MIXERS == 0:
            y = hgrn2_mixer(h, hgrn_w_in[j], hgrn_w_out[j], hgrn_o_gain[j], lbs[j])
        else:
            y = retention_mixer(h, positions, ret_w_in[j], ret_w_out[j])
        x = x + g1 * y
        h = rms_norm(x, norm2_g[layer]) * (1.0 + sc2) + sh2
        y = moe_ffn(h.reshape(B * S, D), router_w[layer], router_b[layer], moe_w1[layer], moe_b1[layer], moe_w2[layer], moe_b2[layer])
        x = x + g2 * y.reshape(B, S, D)
    fmod = (cond @ final_ada_w + final_ada_b)[:, None, :]
    shf, scf = jnp.split(fmod, 2, axis=-1)
    return rms_norm(x, final_g) * (1.0 + scf) + shf
```

```cpp
#include <hip/hip_runtime.h>
#include <cstdio>
#include <cstdint>

#ifndef ONLY_PH
#define ONLY_PH -1
#endif
#define PH_EN(n) (ONLY_PH < 0 || ONLY_PH == (n))
#ifndef DBG_LIMIT
#define DBG_LIMIT NPHASES
#endif
#ifndef MK_SPLIT
#define MK_SPLIT 0
#endif

namespace pg8 {
#define PG8_LAS __attribute__((address_space(3)))
typedef unsigned short bf16_t;
typedef short bf16x8 __attribute__((ext_vector_type(8)));
typedef float f32x4 __attribute__((ext_vector_type(4)));
typedef unsigned u32x4 __attribute__((ext_vector_type(4)));
constexpr int BM = 256, BK = 64, HALF = 128, HTB = HALF * BK * 2  , STAGE_BYTES = 8 * HTB, NXCD = 8, WGM = 8;

__host__ __device__ __forceinline__ int lds_byte(int r, int c) { const int st = (r >> 4) * 2 + (c >> 5), rr = r & 15, cc = c & 31, ob = rr * 64 + cc * 2; return st * 1024 + (ob ^ (((ob >> 9) & 1) << 5)); }
__host__ __device__ __forceinline__ void stage_rc(int b, int& R, int& C) { const int st = b / 1024, sb = b % 1024, swz = sb ^ (((sb >> 9) & 1) << 5); R = (st >> 1) * 16 + swz / 64; C = (st & 1) * 32 + (swz % 64) / 2; }
__host__ __device__ __forceinline__ int perm32(int rho) { const int n = rho >> 4, i = rho & 15; return 8 * (i >> 2) + 4 * n + (i & 3); }

struct Unit { int pm, pn, e, nn; };
struct Gemm { const bf16_t* A; const bf16_t* Bt; int M, N, K; };

struct StaticOrder {
    int nM, nN, nwg, G, c;
    __host__ __device__ void init(int M, int N, int G_, int c_) { nM = M / BM; nN = N / BM; nwg = nM * nN; G = G_; c = c_; }
    __host__ __device__ bool next(int i, Unit& u) const {
        const long L = (long)i * G + c; if (L >= nwg) return false;
        int wgid = (int)L; { const int q = nwg / NXCD, r = nwg % NXCD, xcd = wgid % NXCD, off = wgid / NXCD; wgid = (xcd < r ? xcd * (q + 1) : r * (q + 1) + (xcd - r) * q) + off; }
        const int nig = WGM * nN, gid = wgid / nig, fm = gid * WGM, gsz = (nM - fm) < WGM ? (nM - fm) : WGM;
        u.pm = fm + ((wgid % nig) % gsz); u.pn = (wgid % nig) / gsz; u.e = 0; u.nn = u.pn; return true;
    }
    __device__ __forceinline__ void a_ready(const Unit&) const {}
    __device__ __forceinline__ void done(const Unit&) const {}
};
struct MoeOrder {
    int nN, G, c; const PG8_LAS int* ts;
    __device__ __forceinline__ bool next(int i, Unit& u) const {
        const int NT = ts[32]; const long L = (long)i * G + c; if (L >= (long)NT * nN) return false;
        const int mt = (int)(L / nN), n = (int)(L % nN); int e = 0;
        for (int k = 1; k < 32; ++k) e += (ts[k] <= mt) ? 1 : 0;
        u.pm = mt; u.pn = e * nN + n; u.e = e; u.nn = n; return true;
    }
    __device__ __forceinline__ void a_ready(const Unit&) const {}
    __device__ __forceinline__ void done(const Unit&) const {}
};

__device__ __forceinline__ unsigned cvt_pk_bf16(float lo, float hi) { unsigned r; asm volatile("v_cvt_pk_bf16_f32 %0, %1, %2" : "=v"(r) : "v"(lo), "v"(hi)); return r; }

template <class Epi, class Sched, bool ALIGN_EPI = false, bool SP2 = false>
__device__ __forceinline__ void gemm_phase(PG8_LAS unsigned char* lds, const Gemm g, const Sched& S, const Epi& E) {
    int tid_ = threadIdx.x; asm volatile("" : "+v"(tid_));
    const int tid = tid_, wid = __builtin_amdgcn_readfirstlane(tid >> 6), lane = tid & 63, wr = wid >> 2, wc = wid & 3, fr = lane & 15, fq = lane >> 4;
    const int K = g.K, nt = K / BK;
    unsigned voffA[2], voffB[2];
#pragma unroll
    for (int i = 0; i < 2; ++i) { int R, C; stage_rc(tid * 16 + i * 8192, R, C); const int Rb = Epi::PERM ? ((R & ~31) + perm32(R & 31)) : R;
        voffA[i] = (unsigned)(R * K + C) * 2u; voffB[i] = (unsigned)(Rb * K + C) * 2u; }
    const size_t kstep = (size_t)(BK * 2);
    const size_t hstep = (size_t)HALF * K * 2;
    const size_t tstep = 2 * hstep;
    const unsigned ldsw = (unsigned)wid * 1024u;
    const int aoff = lds_byte(wr * 64 + fr, fq * 8), boff = lds_byte(wc * 32 + fr, fq * 8);
#define PG8_SA(b, h) (((b) * 2 + (h)) * HTB)
#define PG8_SB(b, h) ((4 + (b) * 2 + (h)) * HTB)
#define PG8_STAGE(bufoff, gbase, voff) do { _Pragma("unroll") for (int _i = 0; _i < 2; ++_i) \
        __builtin_amdgcn_global_load_lds((const unsigned*)((const char*)(gbase) + (voff)[_i]), (PG8_LAS unsigned*)(lds + (bufoff) + ldsw + _i * 8192), 16, 0, 0); } while (0)
#define PG8_LDA(dst, b, h) do { _Pragma("unroll") for (int m = 0; m < 4; ++m) _Pragma("unroll") for (int k = 0; k < 2; ++k) dst[m][k] = *(const PG8_LAS bf16x8*)(lds + PG8_SA(b, h) + aoff + m * 2048 + k * 1024); } while (0)
#define PG8_LDB(dst, b, h) do { _Pragma("unroll") for (int n = 0; n < 2; ++n) _Pragma("unroll") for (int k = 0; k < 2; ++k) dst[n][k] = *(const PG8_LAS bf16x8*)(lds + PG8_SB(b, h) + boff + n * 2048 + k * 1024); } while (0)
#define PG8_MMA(ai, bj, At, Bt) do { __builtin_amdgcn_s_setprio(1); _Pragma("unroll") for (int m = 0; m < 4; ++m) _Pragma("unroll") for (int n = 0; n < 2; ++n) _Pragma("unroll") for (int k = 0; k < 2; ++k) \
        acc[ai][bj][m][n] = __builtin_amdgcn_mfma_f32_16x16x32_bf16(Bt[n][k], At[m][k], acc[ai][bj][m][n], 0, 0, 0); __builtin_amdgcn_s_setprio(0); } while (0)
#define PG8_WAIT_V(n) asm volatile("s_waitcnt vmcnt(" #n ")" ::: "memory")
#define PG8_WAIT_L(n) asm volatile("s_waitcnt lgkmcnt(" #n ")" ::: "memory")
#define PG8_BAR __builtin_amdgcn_s_barrier()
#define PG8_SCHED __builtin_amdgcn_sched_barrier(0)
    Unit cur, nxt; int ui = 0;
    if (!S.next(0, cur)) return;
    f32x4 acc[2][2][4][2];
#pragma unroll
    for (int a = 0; a < 2; ++a)
#pragma unroll
        for (int b = 0; b < 2; ++b)
#pragma unroll
            for (int m = 0; m < 4; ++m)
#pragma unroll
                for (int n = 0; n < 2; ++n) acc[a][b][m][n] = (f32x4){0.f, 0.f, 0.f, 0.f};
    bf16x8 At[4][2], B0[2][2], B1[2][2];
    const char* cA = (const char*)g.A + (size_t)cur.pm * tstep; const char* cB = (const char*)g.Bt + (size_t)cur.pn * tstep;
    S.a_ready(cur);
    if constexpr (SP2) {
        PG8_STAGE(PG8_SB(0, 0), cB, voffB); PG8_STAGE(PG8_SB(0, 1), cB + hstep, voffB); PG8_STAGE(PG8_SA(0, 0), cA, voffA); PG8_STAGE(PG8_SA(0, 1), cA + hstep, voffA);
        if (wr == 1) PG8_BAR;
        PG8_WAIT_V(2); PG8_BAR;
        PG8_STAGE(PG8_SB(1, 0), cB + kstep, voffB); PG8_STAGE(PG8_SA(1, 0), cA + kstep, voffA); PG8_STAGE(PG8_SB(1, 1), cB + hstep + kstep, voffB);
        PG8_WAIT_V(6); PG8_BAR;
    } else {
        PG8_STAGE(PG8_SB(0, 0), cB, voffB); PG8_STAGE(PG8_SA(0, 0), cA, voffA); PG8_STAGE(PG8_SB(0, 1), cB + hstep, voffB); PG8_STAGE(PG8_SA(0, 1), cA + hstep, voffA);
        if (wr == 1) PG8_BAR;
        PG8_WAIT_V(4); PG8_BAR;
        PG8_STAGE(PG8_SB(1, 0), cB + kstep, voffB); PG8_STAGE(PG8_SA(1, 0), cA + kstep, voffA); PG8_STAGE(PG8_SB(1, 1), cB + hstep + kstep, voffB);
        PG8_WAIT_V(6); PG8_BAR;
    }
    for (;;) {
        const bool has_next = S.next(ui + 1, nxt);
        const char* nA = has_next ? (const char*)g.A + (size_t)nxt.pm * tstep : cA; const char* nB = has_next ? (const char*)g.Bt + (size_t)nxt.pn * tstep : cB;
        for (int t = 0; t < nt; t += 2) {
            const bool last = (t == nt - 2);
            const char* a1 = cA + (size_t)(t + 1) * kstep;
            const char* a2 = last ? nA : cA + (size_t)(t + 2) * kstep; const char* b2 = last ? nB : cB + (size_t)(t + 2) * kstep;
            const char* a3 = a2 + kstep; const char* b3 = b2 + kstep;
            if (last && has_next) S.a_ready(nxt);
            if constexpr (SP2) {
            PG8_LDB(B0, 0, 0); PG8_LDB(B1, 0, 1); PG8_SCHED; PG8_LDA(At, 0, 0); PG8_STAGE(PG8_SA(1, 1), a1 + hstep, voffA);
            PG8_WAIT_V(8); PG8_WAIT_L(0); PG8_BAR; PG8_MMA(0, 0, At, B0); PG8_MMA(0, 1, At, B1); PG8_BAR; PG8_SCHED;
            PG8_LDA(At, 0, 1); PG8_STAGE(PG8_SB(0, 0), b2, voffB); PG8_STAGE(PG8_SB(0, 1), b2 + hstep, voffB); PG8_STAGE(PG8_SA(0, 0), a2, voffA);
            PG8_WAIT_V(8); PG8_WAIT_L(0); PG8_BAR; PG8_MMA(1, 0, At, B0); PG8_MMA(1, 1, At, B1); PG8_BAR; PG8_SCHED;
            PG8_LDB(B0, 1, 0); PG8_LDB(B1, 1, 1); PG8_SCHED; PG8_LDA(At, 1, 0); PG8_STAGE(PG8_SA(0, 1), a2 + hstep, voffA);
            PG8_WAIT_V(8); PG8_WAIT_L(0); PG8_BAR; PG8_MMA(0, 0, At, B0); PG8_MMA(0, 1, At, B1); PG8_BAR; PG8_SCHED;
            PG8_LDA(At, 1, 1); PG8_STAGE(PG8_SB(1, 0), b3, voffB); PG8_STAGE(PG8_SB(1, 1), b3 + hstep, voffB); PG8_STAGE(PG8_SA(1, 0), a3, voffA);
            PG8_WAIT_V(8); PG8_WAIT_L(0); PG8_BAR; PG8_MMA(1, 0, At, B0); PG8_MMA(1, 1, At, B1); PG8_BAR; PG8_SCHED;
            } else {
            PG8_LDB(B0, 0, 0); PG8_SCHED; PG8_LDA(At, 0, 0); PG8_STAGE(PG8_SA(1, 1), a1 + hstep, voffA);
            PG8_WAIT_L(8); PG8_BAR; PG8_WAIT_L(0); PG8_MMA(0, 0, At, B0); PG8_BAR; PG8_SCHED;
            PG8_LDB(B1, 0, 1); PG8_STAGE(PG8_SB(0, 0), b2, voffB);
            PG8_BAR; PG8_WAIT_L(0); PG8_MMA(0, 1, At, B1); PG8_BAR;
            PG8_LDA(At, 0, 1); PG8_STAGE(PG8_SA(0, 0), a2, voffA);
            PG8_BAR; PG8_WAIT_L(0); PG8_MMA(1, 0, At, B0); PG8_BAR; PG8_SCHED;
            PG8_STAGE(PG8_SB(0, 1), b2 + hstep, voffB);
            PG8_WAIT_V(6); PG8_BAR; PG8_MMA(1, 1, At, B1); PG8_BAR;
            PG8_LDB(B0, 1, 0); PG8_SCHED; PG8_LDA(At, 1, 0); PG8_STAGE(PG8_SA(0, 1), a2 + hstep, voffA);
            PG8_WAIT_L(8); PG8_BAR; PG8_WAIT_L(0); PG8_MMA(0, 0, At, B0); PG8_BAR; PG8_SCHED;
            PG8_LDB(B1, 1, 1); PG8_STAGE(PG8_SB(1, 0), b3, voffB);
            PG8_BAR; PG8_WAIT_L(0); PG8_MMA(0, 1, At, B1); PG8_BAR;
            PG8_LDA(At, 1, 1); PG8_STAGE(PG8_SA(1, 0), a3, voffA);
            PG8_BAR; PG8_WAIT_L(0); PG8_MMA(1, 0, At, B0); PG8_BAR; PG8_SCHED;
            PG8_STAGE(PG8_SB(1, 1), b3 + hstep, voffB);
            PG8_WAIT_V(6); PG8_BAR; PG8_MMA(1, 1, At, B1); PG8_BAR;
            }
        }
        if constexpr (ALIGN_EPI) { if (wr == 0) PG8_BAR; }
        E(acc, cur, wr, wc, fr, fq);
        if (!has_next) break;
#pragma unroll
        for (int a = 0; a < 2; ++a)
#pragma unroll
            for (int b = 0; b < 2; ++b)
#pragma unroll
                for (int m = 0; m < 4; ++m)
#pragma unroll
                    for (int n = 0; n < 2; ++n) acc[a][b][m][n] = (f32x4){0.f, 0.f, 0.f, 0.f};
        cur = nxt; cA = nA; cB = nB; ++ui;
        if constexpr (ALIGN_EPI) { if (wr == 1) PG8_BAR; }
    }
    PG8_WAIT_V(0);
    if constexpr (!ALIGN_EPI) { if (wr == 0) PG8_BAR; }
    PG8_BAR;
#undef PG8_SA
#undef PG8_SB
#undef PG8_STAGE
#undef PG8_LDA
#undef PG8_LDB
#undef PG8_MMA
#undef PG8_WAIT_V
#undef PG8_WAIT_L
#undef PG8_BAR
#undef PG8_SCHED
}
}

constexpr int NWAVES = 8;
constexpr int DM = 1024, NBATCH = 32, SEQ = 2048, MTOK = NBATCH * SEQ, DEPTH = 4, NEXP = 32, TOPK = 4;
constexpr int HG_N = 4096, RT_N = 6144, HG_H = 8, RT_H = 4;
constexpr float EPS = 1e-6f;
constexpr int LCAP = 65536;
constexpr int MAXTILES = 1056;

constexpr size_t MiB = 1u << 20;
constexpr size_t WS_CTL = 0, CTL_ZERO_BYTES = 1 * MiB;
constexpr size_t WS_MOD = 1 * MiB;
constexpr size_t WS_FMOD = 4 * MiB;
constexpr size_t WS_LBV = 4 * MiB + 512 * 1024;
constexpr size_t WS_HWIN = 8 * MiB, WS_HWOUT = 24 * MiB, WS_RWIN = 28 * MiB, WS_RWOUT = 52 * MiB, WS_W1T = 64 * MiB, WS_W2T = 576 * MiB;
constexpr size_t WS_H = 832 * MiB;
constexpr size_t WS_LIST = 960 * MiB;
constexpr size_t WS_TSLOT = 968 * MiB, WS_TGATE = 969 * MiB;
constexpr size_t WS_R1 = 976 * MiB;
constexpr size_t WS_R2 = 1744 * MiB;
constexpr size_t WS_END = 2272 * MiB;
constexpr int CW_BAR = 4096;
constexpr int CW_CNT = 8192;

constexpr int RING_OFF = 0, RING_BYTES = 131072;
constexpr int MISC_OFF = 155648;
constexpr int TAB_OFF = MISC_OFF + 128;
constexpr int LDS_BYTES = 160 * 1024;

#define GAS __attribute__((address_space(1)))
#define LAS __attribute__((address_space(3)))
typedef unsigned short bf16;
typedef unsigned v4u __attribute__((ext_vector_type(4)));
typedef unsigned v2u __attribute__((ext_vector_type(2)));
typedef float f32x4 __attribute__((ext_vector_type(4)));
typedef short bf16x8 __attribute__((ext_vector_type(8)));
#define RLX_AGENT __ATOMIC_RELAXED, __HIP_MEMORY_SCOPE_AGENT
#define LDS_WAIT() asm volatile("s_waitcnt lgkmcnt(0)" ::: "memory")
#define VM_WAIT() asm volatile("s_waitcnt vmcnt(0)" ::: "memory")
__device__ __forceinline__ unsigned pk2(float lo, float hi) { return pg8::cvt_pk_bf16(lo, hi); }
__device__ __forceinline__ float bflo(unsigned w) { return __uint_as_float(w << 16); }
__device__ __forceinline__ float bfhi(unsigned w) { return __uint_as_float(w & 0xffff0000u); }
__device__ __forceinline__ float bf2f(unsigned short h) { return __uint_as_float(((unsigned)h) << 16); }
__device__ __forceinline__ float sigmoidf_(float x) { return __builtin_amdgcn_rcpf(1.f + __expf(-x)); }
__device__ __forceinline__ float siluf_(float x) { return x * sigmoidf_(x); }
__device__ __forceinline__ unsigned ldu_vec(const unsigned* p) { return __hip_atomic_load(p, RLX_AGENT); }

#define XB_TMO      128
#define XB_XCNT(j)  (256  + 64 * (j))
#define XB_XSUB(j)  (1280 + 64 * (j))
#define XB_XGEN(j)  (2304 + 64 * (j))
#define XB_TOP      3328
#define XB_TOPGEN   3392
#define XCD_BAR_WORDS 3456
#define XB_SPIN_CAP (1u << 18)

__device__ __forceinline__ unsigned xb_ld(unsigned* p)              { return __hip_atomic_load(p, __ATOMIC_RELAXED, __HIP_MEMORY_SCOPE_AGENT); }
__device__ __forceinline__ unsigned xb_add(unsigned* p, unsigned v) { return __hip_atomic_fetch_add(p, v, __ATOMIC_RELAXED, __HIP_MEMORY_SCOPE_AGENT); }
__device__ __forceinline__ unsigned xb_xcc_id() { return (unsigned)__builtin_amdgcn_s_getreg((3 << 11) | 20) & 0xFu; }
#define XB_SPIN(cond, bar) do { unsigned _sp = 0; while (cond) { __builtin_amdgcn_s_sleep(1); \
    if ((++_sp & 255u) == 0u) { if (xb_ld(&(bar)[XB_TMO])) break; if (_sp > XB_SPIN_CAP) { atomicAdd(&(bar)[XB_TMO], 1u); break; } } } } while (0)

struct XcdBarrier {
    unsigned* bar; unsigned x;
    volatile LAS unsigned* st;
};
__device__ __forceinline__ XcdBarrier xcd_barrier_post(unsigned* bar, volatile LAS unsigned* st) {
    XcdBarrier b; b.bar = bar; b.x = xb_xcc_id(); b.st = st;
    if (threadIdx.x == 0) (void)xb_add(&bar[XB_XCNT(b.x)], 1u);
    return b;
}
__device__ __forceinline__ void xcd_barrier_complete(unsigned* bar, unsigned x, unsigned& nloc, unsigned& nx) {
    const unsigned G = gridDim.x * gridDim.y * gridDim.z;
    unsigned sum, cnt, mine, sp = 0u;
    for (;;) {
        sum = 0u; cnt = 0u; mine = 0u;
#pragma unroll
        for (unsigned j = 0; j < 16; ++j) { const unsigned c = xb_ld(&bar[XB_XCNT(j)]); sum += c; cnt += (c > 0u) ? 1u : 0u; mine = (j == x) ? c : mine; }
        if (sum == G) break;
        __builtin_amdgcn_s_sleep(1);
        if ((++sp & 255u) == 0u) { if (xb_ld(&bar[XB_TMO])) break; if (sp > XB_SPIN_CAP) { atomicAdd(&bar[XB_TMO], 1u); break; } }
    }
    nloc = mine > 0u ? mine : 1u; nx = cnt > 0u ? cnt : 1u;
}
__device__ __forceinline__ void xcd_barrier(const XcdBarrier& b) {
    asm volatile("s_waitcnt vmcnt(0)" ::: "memory");
    __syncthreads();
    if (threadIdx.x == 0) {
        unsigned* bar = b.bar;
        __builtin_amdgcn_s_waitcnt(0);
        unsigned nloc = b.st[0], nx = b.st[1];
        if (nloc == 0u) { xcd_barrier_complete(bar, b.x, nloc, nx); b.st[0] = nloc; b.st[1] = nx; }
        const unsigned old = xb_add(&bar[XB_XSUB(b.x)], 1u);
        const unsigned gen = old / nloc;
        if (old + 1u == (gen + 1u) * nloc) {
            __builtin_amdgcn_fence(__ATOMIC_RELEASE, "agent");
            asm volatile("s_waitcnt vmcnt(0)" ::: "memory");
            const unsigned og = xb_add(&bar[XB_TOP], 1u);
            const unsigned tg = og / nx;
            if (og + 1u == (tg + 1u) * nx) xb_add(&bar[XB_TOPGEN], 1u);
            else XB_SPIN(xb_ld(&bar[XB_TOPGEN]) == tg, bar);
            __builtin_amdgcn_fence(__ATOMIC_ACQUIRE, "agent");
            xb_add(&bar[XB_XGEN(b.x)], 1u);
            asm volatile("s_waitcnt vmcnt(0)" ::: "memory");
        } else {
            XB_SPIN(xb_ld(&bar[XB_XGEN(b.x)]) == gen, bar);
            __builtin_amdgcn_fence(__ATOMIC_ACQUIRE, "agent");
            asm volatile("s_waitcnt vmcnt(0)" ::: "memory");
        }
    }
    __syncthreads();
}

struct Frame {
    LAS unsigned char* lds;
    unsigned* ctl;
    int tid, lane, wave, vcu, G;
    float* out; unsigned char* ws;
};
__device__ __forceinline__ void relaunder(Frame& F) { int t = threadIdx.x; asm volatile("" : "+v"(t)); F.tid = t; F.lane = t & 63; F.wave = __builtin_amdgcn_readfirstlane(t >> 6); }
#define KAS __attribute__((address_space(4)))
__device__ __forceinline__ const void* kin_(int i) { const KAS char* kp = (const KAS char*)__builtin_amdgcn_kernarg_segment_ptr(); asm volatile("" : "+s"(kp)); return *(const void* const KAS*)(kp + 8 * i); }
enum { I_X = 0, I_C, I_POS, I_ADAW, I_ADAB, I_N1G, I_N2G, I_HWIN, I_HWOUT, I_HGAIN, I_HLB, I_RWIN, I_RWOUT, I_RTW, I_RTB, I_W1, I_B1, I_W2, I_B2, I_FG, I_FADAW, I_FADAB };
#define KIN(i) ((const float*)kin_(i))
__device__ __forceinline__ float wave_sum(float v) {
#pragma unroll
    for (int o = 1; o < 64; o <<= 1) v += __shfl_xor(v, o);
    return v;
}

__device__ __forceinline__ void p0_transpose_item(const float* W, int N, bf16* WT, int K, int k0, int n0, int drow0, LAS float* scr, int lane) {
#pragma unroll 8
    for (int i = 0; i < 32; ++i) { const int kk = 2 * i + (lane >> 5); scr[kk * 33 + (lane & 31)] = W[(size_t)(k0 + kk) * N + n0 + (lane & 31)]; }
    LDS_WAIT(); asm volatile("" ::: "memory");
    const int c = lane & 7;
#pragma unroll
    for (int j = 0; j < 4; ++j) { const int n = (lane >> 3) + 8 * j; const LAS float* s = scr + (8 * c) * 33 + n;
        v4u o; o.x = pk2(s[0 * 33], s[1 * 33]); o.y = pk2(s[2 * 33], s[3 * 33]); o.z = pk2(s[4 * 33], s[5 * 33]); o.w = pk2(s[6 * 33], s[7 * 33]);
        *(GAS v4u*)(WT + (size_t)(drow0 + n) * K + k0 + 8 * c) = o; }
    LDS_WAIT(); asm volatile("" ::: "memory");
}
__device__ __forceinline__ void p0_prologue(Frame& F) {
    relaunder(F);
    const int gw = F.vcu * NWAVES + F.wave, NGW = F.G * NWAVES;
    {
        LAS float* condT = (LAS float*)(F.lds + RING_OFF);
        const float* cin = KIN(I_C);
        for (int idx = F.tid; idx < NBATCH * DM; idx += NWAVES * 64) { const int b = idx >> 10, k = idx & 1023; condT[k * 32 + b] = siluf_(cin[idx]); }
        __syncthreads();
        if ((gw & 3) == 0 && (gw >> 2) < 416) {
            const int u = gw >> 2; const float* W; const float* bias; float* outp; int N, n0, ostride;
            if (u < 384) { const int l = u / 96; n0 = (u % 96) * 64; N = 6 * DM; W = KIN(I_ADAW) + (size_t)l * DM * N; bias = KIN(I_ADAB) + l * N; outp = (float*)(F.ws + WS_MOD) + (size_t)l * NBATCH * N; ostride = N; }
            else { n0 = (u - 384) * 64; N = 2 * DM; W = KIN(I_FADAW); bias = KIN(I_FADAB); outp = (float*)(F.ws + WS_FMOD); ostride = N; }
            float acc[32];
#pragma unroll
            for (int b = 0; b < 32; ++b) acc[b] = 0.f;
#pragma unroll 4
            for (int k = 0; k < DM; ++k) {
                const float w = W[(size_t)k * N + n0 + F.lane];
                const LAS f32x4* cb = (const LAS f32x4*)(condT + k * 32);
#pragma unroll
                for (int q = 0; q < 8; ++q) { const f32x4 cv = cb[q]; acc[4 * q + 0] += cv.x * w; acc[4 * q + 1] += cv.y * w; acc[4 * q + 2] += cv.z * w; acc[4 * q + 3] += cv.w * w; }
            }
            const float bv = bias[n0 + F.lane];
#pragma unroll
            for (int b = 0; b < 32; ++b) outp[(size_t)b * ostride + n0 + F.lane] = acc[b] + bv;
        }
        if (gw == NGW - 1) {
            float* lbv = (float*)(F.ws + WS_LBV); const float* hlb = KIN(I_HLB);
            for (int d = F.lane; d < DM; d += 64) { const float a = hlb[d], b = hlb[DM + d], m = fmaxf(a, b), ea = __expf(a - m), eb = __expf(b - m); lbv[d] = 0.f; lbv[DM + d] = eb / (ea + eb); }
        }
        __syncthreads();
    }
    {
        LAS float* scr = (LAS float*)(F.lds + RING_OFF + F.wave * 16384);
        constexpr int NI_HI = 2 * 16 * 128, NI_HO = 2 * 16 * 32, NI_RI = 2 * 16 * 192, NI_RO = 2 * 32 * 32, NI_W1 = 128 * 16 * 64, NI_W2 = 128 * 16 * 32;
        constexpr int NITEMS = NI_HI + NI_HO + NI_RI + NI_RO + NI_W1 + NI_W2;
        for (int it = gw; it < NITEMS; it += NGW) {
            int r = it;
            if (r < NI_HI) { const int j = r / 2048, q = r % 2048, kb = q / 128, nb = q % 128;
                p0_transpose_item(KIN(I_HWIN) + (size_t)j * DM * HG_N, HG_N, (bf16*)(F.ws + WS_HWIN) + (size_t)j * HG_N * DM, DM, 64 * kb, 32 * nb, 32 * nb, scr, F.lane); continue; } r -= NI_HI;
            if (r < NI_HO) { const int j = r / 512, q = r % 512, kb = q / 32, nb = q % 32;
                p0_transpose_item(KIN(I_HWOUT) + (size_t)j * DM * DM, DM, (bf16*)(F.ws + WS_HWOUT) + (size_t)j * DM * DM, DM, 64 * kb, 32 * nb, 32 * nb, scr, F.lane); continue; } r -= NI_HO;
            if (r < NI_RI) { const int j = r / 3072, q = r % 3072, kb = q / 192, nb = q % 192;
                p0_transpose_item(KIN(I_RWIN) + (size_t)j * DM * RT_N, RT_N, (bf16*)(F.ws + WS_RWIN) + (size_t)j * RT_N * DM, DM, 64 * kb, 32 * nb, 32 * nb, scr, F.lane); continue; } r -= NI_RI;
            if (r < NI_RO) { const int j = r / 1024, q = r % 1024, kb = q / 32, nb = q % 32;
                p0_transpose_item(KIN(I_RWOUT) + (size_t)j * 2048 * DM, DM, (bf16*)(F.ws + WS_RWOUT) + (size_t)j * DM * 2048, 2048, 64 * kb, 32 * nb, 32 * nb, scr, F.lane); continue; } r -= NI_RO;
            if (r < NI_W1) { const int mi = r / 1024, q = r % 1024, kb = q / 64, nb = q % 64; const int n0 = 32 * nb;
                const int cc = n0 & 1023, drow0 = 256 * (cc >> 7) + (cc & 127) + ((n0 >= 1024) ? 128 : 0);
                p0_transpose_item(KIN(I_W1) + (size_t)mi * DM * 2048, 2048, (bf16*)(F.ws + WS_W1T) + (size_t)mi * 2048 * DM, DM, 64 * kb, n0, drow0, scr, F.lane); continue; } r -= NI_W1;
            { const int mi = r / 512, q = r % 512, kb = q / 32, nb = q % 32;
                p0_transpose_item(KIN(I_W2) + (size_t)mi * DM * DM, DM, (bf16*)(F.ws + WS_W2T) + (size_t)mi * DM * DM, DM, 64 * kb, 32 * nb, 32 * nb, scr, F.lane); }
        }
    }
}

__device__ __forceinline__ void build_tiles(Frame& F, int l) {
    LAS int* ts = (LAS int*)(F.lds + TAB_OFF); LAS int* cnt = ts + 40;
    __syncthreads();
    if (F.tid < NEXP) cnt[F.tid] = (int)ldu_vec(F.ctl + CW_CNT + l * 2048 + F.tid * 64);
    __syncthreads();
    if (F.tid == 0) { int a = 0; for (int e = 0; e < NEXP; ++e) { ts[e] = a; a += (cnt[e] + 255) >> 8; } ts[NEXP] = a; }
    __syncthreads();
}

__device__ __forceinline__ void row_phase1(Frame& F, int l, int mode) {
    relaunder(F);
    const LAS int* ts = (const LAS int*)(F.lds + TAB_OFF);
    const bool comb = (l > 0);
    if (comb) build_tiles(F, l - 1);
    const float* xsrc = comb ? F.out : KIN(I_X);
    const bf16* Y = (const bf16*)(F.ws + WS_R1);
    const unsigned* tslot = (const unsigned*)(F.ws + WS_TSLOT); const unsigned* tgate = (const unsigned*)(F.ws + WS_TGATE);
    bf16* H = (bf16*)(F.ws + WS_H);
    for (int rb = F.vcu * 256; rb < MTOK; rb += F.G * 256) {
        const int b = rb / SEQ;
        f32x4 A[4], B[4], G2[4];
#pragma unroll
        for (int j = 0; j < 4; ++j) {
            const int c = 4 * F.lane + 256 * j;
            if (mode == 0) { const float* mv = (const float*)(F.ws + WS_MOD) + (size_t)(l * NBATCH + b) * 6 * DM;
                const f32x4 g = *(const f32x4*)(KIN(I_N1G) + l * DM + c), sc = *(const f32x4*)(mv + 1 * DM + c); A[j] = g * (sc + 1.0f); B[j] = *(const f32x4*)(mv + c); }
            else { const float* fm = (const float*)(F.ws + WS_FMOD) + (size_t)b * 2 * DM;
                const f32x4 g = *(const f32x4*)(KIN(I_FG) + c), sc = *(const f32x4*)(fm + DM + c); A[j] = g * (sc + 1.0f); B[j] = *(const f32x4*)(fm + c); }
            if (comb) G2[j] = *(const f32x4*)((const float*)(F.ws + WS_MOD) + (size_t)((l - 1) * NBATCH + b) * 6 * DM + 5 * DM + c); else G2[j] = (f32x4){0.f, 0.f, 0.f, 0.f};
        }
        for (int r = 0; r < 32; ++r) {
            const int row = rb + 32 * F.wave + r;
            f32x4 v[4];
#pragma unroll
            for (int j = 0; j < 4; ++j) v[j] = *(const f32x4*)(xsrc + (size_t)row * DM + 4 * F.lane + 256 * j);
            if (comb) {
                const unsigned sl = tslot[(size_t)row * 4 + (F.lane & 3)], gt = tgate[(size_t)row * 4 + (F.lane & 3)];
                f32x4 ys[4];
#pragma unroll
                for (int j = 0; j < 4; ++j) ys[j] = (f32x4){0.f, 0.f, 0.f, 0.f};
#pragma unroll
                for (int k = 0; k < TOPK; ++k) {
                    const unsigned s = (unsigned)__shfl((int)sl, k); const float gk = __uint_as_float((unsigned)__shfl((int)gt, k));
                    const int e = (int)(s >> 20), pos = (int)(s & 0xFFFFFu); const size_t yrow = (size_t)ts[e] * 256 + pos;
#pragma unroll
                    for (int j = 0; j < 4; ++j) { const v2u w = *(const v2u*)(Y + yrow * DM + 4 * F.lane + 256 * j);
                        ys[j].x += gk * bflo(w.x); ys[j].y += gk * bfhi(w.x); ys[j].z += gk * bflo(w.y); ys[j].w += gk * bfhi(w.y); }
                }
#pragma unroll
                for (int j = 0; j < 4; ++j) v[j] = v[j] + G2[j] * ys[j];
                if (mode == 0) {
#pragma unroll
                    for (int j = 0; j < 4; ++j) *(f32x4*)(F.out + (size_t)row * DM + 4 * F.lane + 256 * j) = v[j];
                }
            }
            float s2 = 0.f;
#pragma unroll
            for (int j = 0; j < 4; ++j) s2 += (v[j].x * v[j].x + v[j].y * v[j].y) + (v[j].z * v[j].z + v[j].w * v[j].w);
            const float rstd = 1.0f / sqrtf(wave_sum(s2) * (1.0f / DM) + EPS);
            if (mode == 0) {
#pragma unroll
                for (int j = 0; j < 4; ++j) { const f32x4 h = v[j] * rstd * A[j] + B[j]; v2u w; w.x = pk2(h.x, h.y); w.y = pk2(h.z, h.w); *(v2u*)(H + (size_t)row * DM + 4 * F.lane + 256 * j) = w; }
            } else {
#pragma unroll
                for (int j = 0; j < 4; ++j) *(f32x4*)(F.out + (size_t)row * DM + 4 * F.lane + 256 * j) = v[j] * rstd * A[j] + B[j];
            }
        }
    }
}

__device__ __forceinline__ void row_phase2(Frame& F, int l) {
    relaunder(F);
    bf16* H = (bf16*)(F.ws + WS_H);
    LAS unsigned char* frag = F.lds + RING_OFF;
    LAS float* lg = (LAS float*)(F.lds + 131072 + F.wave * 2112);
    LAS int* cntL = (LAS int*)(F.lds + 147968); LAS int* baseL = cntL + 32; LAS float* rbias = (LAS float*)(cntL + 64);
    unsigned* list = (unsigned*)(F.ws + WS_LIST); unsigned* tslot = (unsigned*)(F.ws + WS_TSLOT); float* tgate = (float*)(F.ws + WS_TGATE);
    __syncthreads();
    { const float* rw = KIN(I_RTW) + (size_t)l * DM * NEXP;
      for (int it = F.tid; it < 32 * 2 * 64; it += NWAVES * 64) { const int ln = it & 63, nt = (it >> 6) & 1, s = it >> 7; const int e = 16 * nt + (ln & 15), k0 = 32 * s + 8 * (ln >> 4);
          float w[8], hi[8];
#pragma unroll
          for (int j = 0; j < 8; ++j) { w[j] = rw[(size_t)(k0 + j) * NEXP + e]; }
          v4u ph, pl;
          { unsigned a = pk2(w[0], w[1]), b2 = pk2(w[2], w[3]), c2 = pk2(w[4], w[5]), d2 = pk2(w[6], w[7]); ph = (v4u){a, b2, c2, d2};
            hi[0] = bflo(a); hi[1] = bfhi(a); hi[2] = bflo(b2); hi[3] = bfhi(b2); hi[4] = bflo(c2); hi[5] = bfhi(c2); hi[6] = bflo(d2); hi[7] = bfhi(d2); }
          pl = (v4u){pk2(w[0] - hi[0], w[1] - hi[1]), pk2(w[2] - hi[2], w[3] - hi[3]), pk2(w[4] - hi[4], w[5] - hi[5]), pk2(w[6] - hi[6], w[7] - hi[7])};
          *(LAS v4u*)(frag + ((s * 2 + nt) * 2 + 0) * 1024 + ln * 16) = ph; *(LAS v4u*)(frag + ((s * 2 + nt) * 2 + 1) * 1024 + ln * 16) = pl; }
      if (F.tid < NEXP) rbias[F.tid] = KIN(I_RTB)[l * NEXP + F.tid];
    }
    for (int rb = F.vcu * 256; rb < MTOK; rb += F.G * 256) {
        const int b = rb / SEQ;
        if (F.tid < NEXP) cntL[F.tid] = 0;
        __syncthreads();
        {
            f32x4 A[4], B[4];
            const float* mv = (const float*)(F.ws + WS_MOD) + (size_t)(l * NBATCH + b) * 6 * DM;
#pragma unroll
            for (int j = 0; j < 4; ++j) { const int c = 4 * F.lane + 256 * j; const f32x4 g = *(const f32x4*)(KIN(I_N2G) + l * DM + c), sc = *(const f32x4*)(mv + 4 * DM + c); A[j] = g * (sc + 1.0f); B[j] = *(const f32x4*)(mv + 3 * DM + c); }
            for (int r = 0; r < 32; ++r) {
                const int row = rb + 32 * F.wave + r;
                f32x4 v[4]; float s2 = 0.f;
#pragma unroll
                for (int j = 0; j < 4; ++j) { v[j] = *(const f32x4*)(F.out + (size_t)row * DM + 4 * F.lane + 256 * j); s2 += (v[j].x * v[j].x + v[j].y * v[j].y) + (v[j].z * v[j].z + v[j].w * v[j].w); }
                const float rstd = 1.0f / sqrtf(wave_sum(s2) * (1.0f / DM) + EPS);
#pragma unroll
                for (int j = 0; j < 4; ++j) { const f32x4 h = v[j] * rstd * A[j] + B[j]; v2u w; w.x = pk2(h.x, h.y); w.y = pk2(h.z, h.w); *(v2u*)(H + (size_t)row * DM + 4 * F.lane + 256 * j) = w; }
            }
        }
        VM_WAIT();
        int my_e[2][TOPK], my_lp[2][TOPK]; float my_g[2][TOPK];
#pragma unroll
        for (int grp = 0; grp < 2; ++grp) {
            const int row0 = rb + 32 * F.wave + 16 * grp;
            f32x4 acc0 = (f32x4){0.f, 0.f, 0.f, 0.f}, acc1 = (f32x4){0.f, 0.f, 0.f, 0.f};
            const unsigned long long* ap = (const unsigned long long*)(H + (size_t)(row0 + (F.lane & 15)) * DM + 8 * (F.lane >> 4));
#pragma unroll 4
            for (int s = 0; s < 32; ++s) {
                const unsigned long long lo = __hip_atomic_load(ap + 8 * s, RLX_AGENT), hi = __hip_atomic_load(ap + 8 * s + 1, RLX_AGENT);
                v4u av = (v4u){(unsigned)lo, (unsigned)(lo >> 32), (unsigned)hi, (unsigned)(hi >> 32)}; const bf16x8 a = __builtin_bit_cast(bf16x8, av);
                const bf16x8 b00 = *(const LAS bf16x8*)(frag + ((s * 2 + 0) * 2 + 0) * 1024 + F.lane * 16), b01 = *(const LAS bf16x8*)(frag + ((s * 2 + 0) * 2 + 1) * 1024 + F.lane * 16);
                const bf16x8 b10 = *(const LAS bf16x8*)(frag + ((s * 2 + 1) * 2 + 0) * 1024 + F.lane * 16), b11 = *(const LAS bf16x8*)(frag + ((s * 2 + 1) * 2 + 1) * 1024 + F.lane * 16);
                acc0 = __builtin_amdgcn_mfma_f32_16x16x32_bf16(a, b00, acc0, 0, 0, 0); acc0 = __builtin_amdgcn_mfma_f32_16x16x32_bf16(a, b01, acc0, 0, 0, 0);
                acc1 = __builtin_amdgcn_mfma_f32_16x16x32_bf16(a, b10, acc1, 0, 0, 0); acc1 = __builtin_amdgcn_mfma_f32_16x16x32_bf16(a, b11, acc1, 0, 0, 0);
            }
#pragma unroll
            for (int q = 0; q < 4; ++q) { lg[(4 * (F.lane >> 4) + q) * 33 + (F.lane & 15)] = acc0[q]; lg[(4 * (F.lane >> 4) + q) * 33 + 16 + (F.lane & 15)] = acc1[q]; }
            LDS_WAIT(); asm volatile("" ::: "memory");
            if (F.lane < 16) {
                unsigned taken = 0u; float tl[TOPK];
#pragma unroll
                for (int k = 0; k < TOPK; ++k) {
                    float best = -3.0e38f; int bi = 0;
                    for (int e = 0; e < NEXP; ++e) { const float v = lg[F.lane * 33 + e] + rbias[e]; if (!((taken >> e) & 1u) && v > best) { best = v; bi = e; } }
                    taken |= 1u << bi; my_e[grp][k] = bi; tl[k] = best;
                }
                float den = 0.f, ex[TOPK];
#pragma unroll
                for (int k = 0; k < TOPK; ++k) { ex[k] = __expf(tl[k] - tl[0]); den += ex[k]; }
#pragma unroll
                for (int k = 0; k < TOPK; ++k) { my_g[grp][k] = ex[k] / den; my_lp[grp][k] = __hip_atomic_fetch_add(&cntL[my_e[grp][k]], 1, __ATOMIC_RELAXED, __HIP_MEMORY_SCOPE_WORKGROUP); }
            } else {
#pragma unroll
                for (int k = 0; k < TOPK; ++k) { my_e[grp][k] = 0; my_lp[grp][k] = 0; my_g[grp][k] = 0.f; }
            }
            LDS_WAIT(); asm volatile("" ::: "memory");
        }
        __syncthreads();
        if (F.tid < NEXP) baseL[F.tid] = (int)__hip_atomic_fetch_add(F.ctl + CW_CNT + l * 2048 + F.tid * 64, (unsigned)cntL[F.tid], RLX_AGENT);
        __syncthreads();
        if (F.lane < 16) {
#pragma unroll
            for (int grp = 0; grp < 2; ++grp) {
                const int row = rb + 32 * F.wave + 16 * grp + F.lane;
#pragma unroll
                for (int k = 0; k < TOPK; ++k) { const int e = my_e[grp][k], pos = baseL[e] + my_lp[grp][k];
                    list[(size_t)e * LCAP + pos] = (unsigned)row; tslot[(size_t)row * 4 + k] = ((unsigned)e << 20) | (unsigned)pos; tgate[(size_t)row * 4 + k] = my_g[grp][k]; }
            }
        }
        __syncthreads();
    }
}

__device__ __forceinline__ void moe_gather(Frame& F, int l) {
    relaunder(F);
    build_tiles(F, l);
    const LAS int* ts = (const LAS int*)(F.lds + TAB_OFF); const LAS int* cnt = ts + 40;
    const unsigned* list = (const unsigned*)(F.ws + WS_LIST); const bf16* H = (const bf16*)(F.ws + WS_H); bf16* Xg = (bf16*)(F.ws + WS_R1);
    const int gw = F.vcu * NWAVES + F.wave, NGW = F.G * NWAVES, NR = ts[NEXP] * 256;
    for (int r = gw; r < NR; r += NGW) {
        const int mt = r >> 8; int e = 0;
        for (int k = 1; k < NEXP; ++k) e += (ts[k] <= mt) ? 1 : 0;
        const int pos = r - ts[e] * 256;
        unsigned tok = 0u; if (pos < cnt[e]) tok = ldu_vec(list + (size_t)e * LCAP + pos);
        const v4u* src = (const v4u*)(H + (size_t)tok * DM); v4u* dst = (v4u*)(Xg + (size_t)r * DM);
        dst[F.lane] = src[F.lane]; dst[F.lane + 64] = src[F.lane + 64];
    }
}

using pg8::Unit;
__device__ __forceinline__ v4u pack8(const f32x4 a, const f32x4 b) { v4u w; w.x = pk2(a.x, a.y); w.y = pk2(a.z, a.w); w.z = pk2(b.x, b.y); w.w = pk2(b.z, b.w); return w; }

struct EpiHgrnIn {
    static constexpr bool PERM = true;
    unsigned char* r1; const float* lb;
    __device__ __forceinline__ void operator()(const f32x4 (&acc)[2][2][4][2], const Unit& u, int wr, int wc, int fr, int fq) const {
        const int seg = u.pn >> 2, row0 = u.pm * 256 + wr * 64 + fr, cs0 = (u.pn & 3) * 256 + wc * 32 + 8 * fq;
        if (seg == 1) {
            bf16* K = (bf16*)(r1 + 128 * MiB); float* LF = (float*)(r1 + 512 * MiB);
#pragma unroll
            for (int bj = 0; bj < 2; ++bj) {
                f32x4 lbv[2]; lbv[0] = *(const f32x4*)(lb + cs0 + bj * 128); lbv[1] = *(const f32x4*)(lb + cs0 + bj * 128 + 4);
#pragma unroll
                for (int ai = 0; ai < 2; ++ai)
#pragma unroll
                    for (int m = 0; m < 4; ++m) { const size_t ro = (size_t)(row0 + ai * 128 + m * 16) * DM + cs0 + bj * 128; f32x4 kk[2], lf[2];
#pragma unroll
                        for (int n = 0; n < 2; ++n)
#pragma unroll
                            for (int j = 0; j < 4; ++j) { const float f = fminf(fmaxf(acc[ai][bj][m][n][j], -60.f), 60.f), l0 = lbv[n][j], ef = __expf(f);
                                const float sg = ef * __builtin_amdgcn_rcpf(1.f + ef), sgm = __builtin_amdgcn_rcpf(1.f + ef);
                                lf[n][j] = __logf(l0 + (1.f - l0) * sg); kk[n][j] = (1.f - l0) * sgm; }
                        *(v4u*)(K + ro) = pack8(kk[0], kk[1]); *(f32x4*)(LF + ro) = lf[0]; *(f32x4*)(LF + ro + 4) = lf[1];
                        __builtin_amdgcn_sched_barrier(0); }
            }
        } else {
            bf16* dst = (bf16*)(r1 + (seg == 0 ? 0 : (seg == 2 ? 256 * MiB : 384 * MiB))); const bool act = (seg != 2);
#pragma unroll
            for (int ai = 0; ai < 2; ++ai)
#pragma unroll
                for (int m = 0; m < 4; ++m) { const size_t ro = (size_t)(row0 + ai * 128 + m * 16) * DM;
#pragma unroll
                    for (int bj = 0; bj < 2; ++bj) { f32x4 v0 = acc[ai][bj][m][0], v1 = acc[ai][bj][m][1];
                        if (act) {
#pragma unroll
                            for (int j = 0; j < 4; ++j) { v0[j] = siluf_(v0[j]); v1[j] = siluf_(v1[j]); } }
                        *(v4u*)(dst + ro + cs0 + bj * 128) = pack8(v0, v1); }
                    __builtin_amdgcn_sched_barrier(0); }
        }
    }
};

struct EpiRetIn {
    static constexpr bool PERM = true;
    unsigned char* r1; const int* positions;
    __device__ __forceinline__ void operator()(const f32x4 (&acc)[2][2][4][2], const Unit& u, int wr, int wc, int fr, int fq) const {
        const int row0 = u.pm * 256 + wr * 64 + fr, cl = wc * 32 + 8 * fq;
        if (u.pn < 8) {
            bf16* dst = (bf16*)(r1 + ((u.pn < 4) ? 0 : 128 * MiB)); const float sc = (u.pn < 4) ? 1.0f : 0.0625f; const int hh = u.pn & 3;
            float invrev[2][4];
#pragma unroll
            for (int n = 0; n < 2; ++n)
#pragma unroll
                for (int j = 0; j < 4; ++j) invrev[n][j] = exp2f(-(float)(cl + 4 * n + j) * 0.10462765653188542f) * 0.15915494309189535f;
#pragma unroll
            for (int ai = 0; ai < 2; ++ai)
#pragma unroll
                for (int m = 0; m < 4; ++m) { const int row = row0 + ai * 128 + m * 16; const float pos = (float)positions[row]; const size_t ro = (size_t)row * DM + hh * 256 + cl;
                    f32x4 o1[2], o2[2];
#pragma unroll
                    for (int n = 0; n < 2; ++n)
#pragma unroll
                        for (int j = 0; j < 4; ++j) { const float rev = pos * invrev[n][j], fr_ = rev - floorf(rev); const float cs = __builtin_amdgcn_cosf(fr_), sn = __builtin_amdgcn_sinf(fr_);
                            const float x1 = acc[ai][0][m][n][j], x2 = acc[ai][1][m][n][j]; o1[n][j] = (x1 * cs - x2 * sn) * sc; o2[n][j] = (x2 * cs + x1 * sn) * sc; }
                    *(v4u*)(dst + ro) = pack8(o1[0], o1[1]); *(v4u*)(dst + ro + 128) = pack8(o2[0], o2[1]); }
        } else {
            const bool isg = (u.pn >= 16); bf16* dst = (bf16*)(r1 + (isg ? 512 * MiB : 256 * MiB)); const int ct = (isg ? u.pn - 16 : u.pn - 8) * 256 + cl;
#pragma unroll
            for (int ai = 0; ai < 2; ++ai)
#pragma unroll
                for (int m = 0; m < 4; ++m) { const size_t ro = (size_t)(row0 + ai * 128 + m * 16) * 2048 + ct;
#pragma unroll
                    for (int bj = 0; bj < 2; ++bj) { f32x4 v0 = acc[ai][bj][m][0], v1 = acc[ai][bj][m][1];
                        if (isg) {
#pragma unroll
                            for (int j = 0; j < 4; ++j) { v0[j] = siluf_(v0[j]); v1[j] = siluf_(v1[j]); } }
                        *(v4u*)(dst + ro + bj * 128) = pack8(v0, v1); } }
        }
    }
};

struct EpiOut {
    static constexpr bool PERM = false;
    const float* xin; float* xout; const float* gate;
    __device__ __forceinline__ void operator()(const f32x4 (&acc)[2][2][4][2], const Unit& u, int wr, int wc, int fr, int fq) const {
        const int row0 = u.pm * 256 + wr * 64 + fr, col0 = u.pn * 256 + wc * 32 + 4 * fq, b = (u.pm * 256) / SEQ;
        f32x4 gv[2][2];
#pragma unroll
        for (int bj = 0; bj < 2; ++bj)
#pragma unroll
            for (int n = 0; n < 2; ++n) gv[bj][n] = *(const f32x4*)(gate + (size_t)b * 6 * DM + col0 + bj * 128 + n * 16);
#pragma unroll
        for (int ai = 0; ai < 2; ++ai)
#pragma unroll
            for (int mp = 0; mp < 2; ++mp) { f32x4 xi[2][2][2];
#pragma unroll
                for (int mm = 0; mm < 2; ++mm)
#pragma unroll
                    for (int bj = 0; bj < 2; ++bj)
#pragma unroll
                        for (int n = 0; n < 2; ++n) xi[mm][bj][n] = *(const f32x4*)(xin + (size_t)(row0 + ai * 128 + (2 * mp + mm) * 16) * DM + col0 + bj * 128 + n * 16);
#pragma unroll
                for (int mm = 0; mm < 2; ++mm)
#pragma unroll
                    for (int bj = 0; bj < 2; ++bj)
#pragma unroll
                        for (int n = 0; n < 2; ++n) *(f32x4*)(xout + (size_t)(row0 + ai * 128 + (2 * mp + mm) * 16) * DM + col0 + bj * 128 + n * 16) = xi[mm][bj][n] + gv[bj][n] * acc[ai][bj][2 * mp + mm][n];
                asm volatile("" ::: "memory"); }
    }
};

struct EpiMoe1 {
    static constexpr bool PERM = true;
    bf16* A2; const float* b1;
    __device__ __forceinline__ void operator()(const f32x4 (&acc)[2][2][4][2], const Unit& u, int wr, int wc, int fr, int fq) const {
        const int row0 = u.pm * 256 + wr * 64 + fr, gc = u.nn * 128 + wc * 32 + 8 * fq; const float* bp = b1 + (size_t)u.e * 2048;
        f32x4 bg[2], bl[2];
#pragma unroll
        for (int n = 0; n < 2; ++n) { bg[n] = *(const f32x4*)(bp + gc + 4 * n); bl[n] = *(const f32x4*)(bp + 1024 + gc + 4 * n); }
#pragma unroll
        for (int ai = 0; ai < 2; ++ai)
#pragma unroll
            for (int m = 0; m < 4; ++m) { f32x4 o[2];
#pragma unroll
                for (int n = 0; n < 2; ++n)
#pragma unroll
                    for (int j = 0; j < 4; ++j) { const float g = fminf(acc[ai][0][m][n][j] + bg[n][j], 7.0f), li = fminf(fmaxf(acc[ai][1][m][n][j] + bl[n][j], -7.0f), 7.0f);
                        o[n][j] = g * sigmoidf_(1.702f * g) * (li + 1.0f); }
                *(v4u*)(A2 + (size_t)(row0 + ai * 128 + m * 16) * DM + gc) = pack8(o[0], o[1]); }
    }
};

struct EpiMoe2 {
    static constexpr bool PERM = true;
    bf16* Y; const float* b2;
    __device__ __forceinline__ void operator()(const f32x4 (&acc)[2][2][4][2], const Unit& u, int wr, int wc, int fr, int fq) const {
        const int row0 = u.pm * 256 + wr * 64 + fr, c0 = u.nn * 256 + wc * 32 + 8 * fq; const float* bp = b2 + (size_t)u.e * DM;
        f32x4 bv[2][2];
#pragma unroll
        for (int bj = 0; bj < 2; ++bj)
#pragma unroll
            for (int n = 0; n < 2; ++n) bv[bj][n] = *(const f32x4*)(bp + c0 + bj * 128 + 4 * n);
#pragma unroll
        for (int ai = 0; ai < 2; ++ai)
#pragma unroll
            for (int m = 0; m < 4; ++m) { const size_t ro = (size_t)(row0 + ai * 128 + m * 16) * DM + c0;
#pragma unroll
                for (int bj = 0; bj < 2; ++bj) *(v4u*)(Y + ro + bj * 128) = pack8(acc[ai][bj][m][0] + bv[bj][0], acc[ai][bj][m][1] + bv[bj][1]); }
    }
};

__device__ __forceinline__ void hgrn_scan(Frame& F, int j) {
    relaunder(F);
    const bf16* Q = (const bf16*)(F.ws + WS_R1); const bf16* K = (const bf16*)(F.ws + WS_R1 + 128 * MiB); const bf16* V = (const bf16*)(F.ws + WS_R1 + 256 * MiB); const bf16* SG = (const bf16*)(F.ws + WS_R1 + 384 * MiB);
    const float* LF = (const float*)(F.ws + WS_R1 + 512 * MiB); bf16* O = (bf16*)(F.ws + WS_R2);
    LAS float* Qs = (LAS float*)(F.lds); LAS float* Ks = Qs + 4096; LAS float* Fs = Qs + 8192; LAS float* Vs = Qs + 12288; LAS float* P = Qs + 16384;
    const int v = F.tid & 127, kq = F.tid >> 7, t16 = F.tid >> 4, c8 = (F.tid & 15) * 8;
    f32x4 gain0 = *(const f32x4*)(KIN(I_HGAIN) + j * 128 + c8), gain1 = *(const f32x4*)(KIN(I_HGAIN) + j * 128 + c8 + 4);
    for (int u = F.vcu; u < NBATCH * HG_H; u += F.G) {
        const int b = u / HG_H, h = u % HG_H;
        float S[32];
#pragma unroll
        for (int i = 0; i < 32; ++i) S[i] = 0.f;
        for (int ch = 0; ch < SEQ / 32; ++ch) {
            const int row0 = b * SEQ + 32 * ch; const size_t gi = (size_t)(row0 + t16) * DM + h * 128 + c8;
            __syncthreads();
            { const v4u q = *(const v4u*)(Q + gi), k = *(const v4u*)(K + gi), vv = *(const v4u*)(V + gi); const f32x4 l0 = *(const f32x4*)(LF + gi), l1 = *(const f32x4*)(LF + gi + 4);
              LAS f32x4* d;
              d = (LAS f32x4*)(Qs + t16 * 128 + c8); d[0] = (f32x4){bflo(q.x), bfhi(q.x), bflo(q.y), bfhi(q.y)}; d[1] = (f32x4){bflo(q.z), bfhi(q.z), bflo(q.w), bfhi(q.w)};
              d = (LAS f32x4*)(Ks + t16 * 128 + c8); d[0] = (f32x4){bflo(k.x), bfhi(k.x), bflo(k.y), bfhi(k.y)}; d[1] = (f32x4){bflo(k.z), bfhi(k.z), bflo(k.w), bfhi(k.w)};
              d = (LAS f32x4*)(Vs + t16 * 128 + c8); d[0] = (f32x4){bflo(vv.x), bfhi(vv.x), bflo(vv.y), bfhi(vv.y)}; d[1] = (f32x4){bflo(vv.z), bfhi(vv.z), bflo(vv.w), bfhi(vv.w)};
              d = (LAS f32x4*)(Fs + t16 * 128 + c8); d[0] = (f32x4){__expf(l0.x), __expf(l0.y), __expf(l0.z), __expf(l0.w)}; d[1] = (f32x4){__expf(l1.x), __expf(l1.y), __expf(l1.z), __expf(l1.w)}; }
            __syncthreads();
            for (int t = 0; t < 32; ++t) {
                const float vt = Vs[t * 128 + v]; float a = 0.f;
#pragma unroll
                for (int i4 = 0; i4 < 8; ++i4) { const f32x4 f4 = *(const LAS f32x4*)(Fs + t * 128 + 32 * kq + 4 * i4), k4 = *(const LAS f32x4*)(Ks + t * 128 + 32 * kq + 4 * i4), q4 = *(const LAS f32x4*)(Qs + t * 128 + 32 * kq + 4 * i4);
#pragma unroll
                    for (int i = 0; i < 4; ++i) { S[4 * i4 + i] = f4[i] * S[4 * i4 + i] + k4[i] * vt; a += q4[i] * S[4 * i4 + i]; } }
                P[(t * 4 + kq) * 128 + v] = a;
            }
            __syncthreads();
            { f32x4 o0 = (f32x4){0.f, 0.f, 0.f, 0.f}, o1 = o0;
#pragma unroll
              for (int q = 0; q < 4; ++q) { o0 += *(const LAS f32x4*)(P + (t16 * 4 + q) * 128 + c8); o1 += *(const LAS f32x4*)(P + (t16 * 4 + q) * 128 + c8 + 4); }
              float ss = (o0.x * o0.x + o0.y * o0.y) + (o0.z * o0.z + o0.w * o0.w) + (o1.x * o1.x + o1.y * o1.y) + (o1.z * o1.z + o1.w * o1.w);
              ss += __shfl_xor(ss, 1); ss += __shfl_xor(ss, 2); ss += __shfl_xor(ss, 4); ss += __shfl_xor(ss, 8);
              const float r = 1.0f / sqrtf(ss * (1.0f / 128.f) + EPS);
              const v4u sg = *(const v4u*)(SG + gi);
              f32x4 a0 = o0 * r * gain0, a1 = o1 * r * gain1;
              a0.x *= bflo(sg.x); a0.y *= bfhi(sg.x); a0.z *= bflo(sg.y); a0.w *= bfhi(sg.y); a1.x *= bflo(sg.z); a1.y *= bfhi(sg.z); a1.z *= bflo(sg.w); a1.w *= bfhi(sg.w);
              *(v4u*)(O + gi) = pack8(a0, a1); }
        }
    }
}

__device__ __forceinline__ void ret_scan(Frame& F) {
    relaunder(F);
    const bf16* Q = (const bf16*)(F.ws + WS_R1); const bf16* K = (const bf16*)(F.ws + WS_R1 + 128 * MiB); const bf16* V = (const bf16*)(F.ws + WS_R1 + 256 * MiB); const bf16* SG = (const bf16*)(F.ws + WS_R1 + 512 * MiB);
    bf16* O = (bf16*)(F.ws + WS_R2);
    LAS bf16* Qs = (LAS bf16*)(F.lds); LAS bf16* Ks = (LAS bf16*)(F.lds + 33792); LAS bf16* Vs = (LAS bf16*)(F.lds + 67584);
    LAS float* St = (LAS float*)(F.lds + 133120); LAS float* wred = (LAS float*)(F.lds + 149504); LAS float* rtab = (LAS float*)(F.lds + 151552);
    for (int u = F.vcu; u < NBATCH * RT_H * 16; u += F.G) {
        const int bh = u >> 4, cp = u & 15, b = bh >> 2, h = bh & 3;
        const float lg2g = log2f(1.0f - exp2f(-5.0f - (float)h));
        for (int half = 0; half < 2; ++half) {
            const int c = half ? 31 - cp : cp; const int row0 = b * SEQ + 64 * c;
            __syncthreads();
#pragma unroll
            for (int i = 0; i < 4; ++i) { const int p = F.tid + 512 * i, r = p >> 5, cc = (p & 31) * 8; *(LAS v4u*)(Qs + r * 264 + cc) = *(const v4u*)(Q + (size_t)(row0 + r) * DM + h * 256 + cc); }
            float acc[64];
#pragma unroll
            for (int n = 0; n < 64; ++n) acc[n] = 0.f;
            for (int cq = 0; cq <= c; ++cq) {
                const int krow0 = b * SEQ + 64 * cq;
                __syncthreads();
#pragma unroll
                for (int i = 0; i < 4; ++i) { const int p = F.tid + 512 * i, r = p >> 5, cc = (p & 31) * 8; *(LAS v4u*)(Ks + r * 264 + cc) = *(const v4u*)(K + (size_t)(krow0 + r) * DM + h * 256 + cc); }
#pragma unroll
                for (int i = 0; i < 8; ++i) { const int p = F.tid + 512 * i, r = p >> 6, cc = (p & 63) * 8; *(LAS v4u*)(Vs + r * 512 + cc) = *(const v4u*)(V + (size_t)(krow0 + r) * 2048 + h * 512 + cc); }
                __syncthreads();
                { float s[8];
#pragma unroll
                  for (int j8 = 0; j8 < 8; ++j8) s[j8] = 0.f;
                  for (int dc = 0; dc < 32; ++dc) {
                      const v4u kv = *(const LAS v4u*)(Ks + F.lane * 264 + dc * 8);
                      const float k0 = bflo(kv.x), k1 = bfhi(kv.x), k2 = bflo(kv.y), k3 = bfhi(kv.y), k4 = bflo(kv.z), k5 = bfhi(kv.z), k6 = bflo(kv.w), k7 = bfhi(kv.w);
#pragma unroll
                      for (int j8 = 0; j8 < 8; ++j8) { const v4u qv = *(const LAS v4u*)(Qs + (8 * F.wave + j8) * 264 + dc * 8);
                          s[j8] += (bflo(qv.x) * k0 + bfhi(qv.x) * k1) + (bflo(qv.y) * k2 + bfhi(qv.y) * k3) + (bflo(qv.z) * k4 + bfhi(qv.z) * k5) + (bflo(qv.w) * k6 + bfhi(qv.w) * k7); }
                  }
                  f32x4 w0, w1;
#pragma unroll
                  for (int j8 = 0; j8 < 8; ++j8) { const float dist = fabsf((float)((64 * c + 8 * F.wave + j8) - (64 * cq + F.lane))); const float val = s[j8] * exp2f(dist * lg2g); if (j8 < 4) w0[j8] = val; else w1[j8 - 4] = val; }
                  *(LAS f32x4*)(St + F.lane * 64 + 8 * F.wave) = w0; *(LAS f32x4*)(St + F.lane * 64 + 8 * F.wave + 4) = w1; }
                __syncthreads();
                for (int m2 = 0; m2 < 64; ++m2) {
                    const float vv = bf2f(Vs[m2 * 512 + F.tid]);
#pragma unroll
                    for (int n4 = 0; n4 < 16; ++n4) { const f32x4 sv = *(const LAS f32x4*)(St + m2 * 64 + 4 * n4); acc[4 * n4 + 0] += sv.x * vv; acc[4 * n4 + 1] += sv.y * vv; acc[4 * n4 + 2] += sv.z * vv; acc[4 * n4 + 3] += sv.w * vv; }
                }
            }
#pragma unroll
            for (int n = 0; n < 64; ++n) { const float p = wave_sum(acc[n] * acc[n]); if (F.lane == 0) wred[F.wave * 64 + n] = p; }
            __syncthreads();
            if (F.tid < 64) { float s = 0.f;
#pragma unroll
                for (int w = 0; w < 8; ++w) s += wred[w * 64 + F.tid];
                rtab[F.tid] = 1.0f / sqrtf(s * (1.0f / 512.f) + EPS); }
            __syncthreads();
#pragma unroll
            for (int n = 0; n < 64; ++n) { const size_t gi = (size_t)(row0 + n) * 2048 + h * 512 + F.tid; const float sg = bf2f(SG[gi]); O[gi] = (bf16)(pk2(acc[n] * rtab[n] * sg, 0.f) & 0xffffu); }
        }
    }
}

struct Args { const void* in[22]; float* out; unsigned char* ws; int ph_lo, ph_hi; };
constexpr int PH_PER_LAYER = 9, NPHASES = 1 + DEPTH * PH_PER_LAYER + 1;

__global__ void __launch_bounds__(NWAVES * 64, 2) hybrid_fwd(Args args) {
    extern __shared__ __attribute__((aligned(16))) unsigned char lds[];
    Frame F;
    F.lds = (LAS unsigned char*)lds;
    F.tid = threadIdx.x; F.lane = F.tid & 63; F.wave = __builtin_amdgcn_readfirstlane(F.tid >> 6);
    F.G = gridDim.x; { const int bx = blockIdx.x; F.vcu = (F.G % 8 == 0) ? (bx % 8) * (F.G / 8) + bx / 8 : bx; }
    F.ws = args.ws; F.out = args.out; F.ctl = (unsigned*)(args.ws + WS_CTL);
    for (int u = F.tid; u < (LDS_BYTES - MISC_OFF) / 4; u += NWAVES * 64) ((LAS unsigned*)(F.lds + MISC_OFF))[u] = 0u;
    __syncthreads();
    const int lo = args.ph_lo, hi = args.ph_hi;
    XcdBarrier bar; bar.bar = F.ctl + CW_BAR; bar.x = 0; bar.st = nullptr;
    if (hi - lo > 1) bar = xcd_barrier_post(F.ctl + CW_BAR, (volatile LAS unsigned*)(F.lds + MISC_OFF) + 8);
#define IN(k) (lo <= (k) && (k) < hi)
#define SEAM(k) do { if (IN(k) && hi > (k) + 1) xcd_barrier(bar); } while (0)

    if (PH_EN(0) && IN(0)) { p0_prologue(F); } SEAM(0);

#pragma unroll 1
    for (int l = 0; l < DEPTH; ++l) {
        const int pb = 1 + l * PH_PER_LAYER, j = l >> 1; const bool is_ret = (l & 1);
        if (PH_EN(1) && IN(pb + 0)) row_phase1(F, l, 0);
        SEAM(pb + 0);
        if (IN(pb + 1)) {
            if (PH_EN(2) && !is_ret) {
                pg8::Gemm g{(const bf16*)(F.ws + WS_H), (const bf16*)(F.ws + WS_HWIN) + (size_t)j * HG_N * DM, MTOK, HG_N, DM}; pg8::StaticOrder S; S.init(MTOK, HG_N, F.G, (int)blockIdx.x);
                EpiHgrnIn E{F.ws + WS_R1, (const float*)(F.ws + WS_LBV) + j * DM};
                pg8::gemm_phase<EpiHgrnIn, pg8::StaticOrder, true, true>(F.lds + RING_OFF, g, S, E);
            } else if (PH_EN(3)) {
                pg8::Gemm g{(const bf16*)(F.ws + WS_H), (const bf16*)(F.ws + WS_RWIN) + (size_t)j * RT_N * DM, MTOK, RT_N, DM}; pg8::StaticOrder S; S.init(MTOK, RT_N, F.G, (int)blockIdx.x);
                EpiRetIn E{F.ws + WS_R1, (const int*)kin_(I_POS)};
                pg8::gemm_phase<EpiRetIn, pg8::StaticOrder, true, true>(F.lds + RING_OFF, g, S, E);
            }
        }
        SEAM(pb + 1);
        if (IN(pb + 2)) { if (!is_ret) { if (PH_EN(4)) hgrn_scan(F, j); } else { if (PH_EN(5)) ret_scan(F); } }
        SEAM(pb + 2);
        if (PH_EN(6) && IN(pb + 4)) {
            const int Ko = is_ret ? 2048 : DM;
            const bf16* Wt = is_ret ? (const bf16*)(F.ws + WS_RWOUT) + (size_t)j * DM * 2048 : (const bf16*)(F.ws + WS_HWOUT) + (size_t)j * DM * DM;
            pg8::Gemm g{(const bf16*)(F.ws + WS_R2), Wt, MTOK, DM, Ko}; pg8::StaticOrder S; S.init(MTOK, DM, F.G, (int)blockIdx.x);
            EpiOut E{l == 0 ? KIN(I_X) : F.out, F.out, (const float*)(F.ws + WS_MOD) + (size_t)l * NBATCH * 6 * DM + 2 * DM};
            pg8::gemm_phase<EpiOut, pg8::StaticOrder, true, true>(F.lds + RING_OFF, g, S, E);
        }
        SEAM(pb + 4);
        if (PH_EN(7) && IN(pb + 5)) row_phase2(F, l);
        SEAM(pb + 5);
        if (PH_EN(8) && IN(pb + 6)) moe_gather(F, l);
        SEAM(pb + 6);
        if (PH_EN(9) && IN(pb + 7)) {
            build_tiles(F, l);
            pg8::Gemm g{(const bf16*)(F.ws + WS_R1), (const bf16*)(F.ws + WS_W1T) + (size_t)l * NEXP * 2048 * DM, 0, 0, DM};
            pg8::MoeOrder S{8, F.G, F.vcu, (const LAS int*)(F.lds + TAB_OFF)};
            EpiMoe1 E{(bf16*)(F.ws + WS_R2), KIN(I_B1) + (size_t)l * NEXP * 2048};
            pg8::gemm_phase<EpiMoe1, pg8::MoeOrder, true, true>(F.lds + RING_OFF, g, S, E);
        }
        SEAM(pb + 7);
        if (PH_EN(10) && IN(pb + 8)) {
            build_tiles(F, l);
            pg8::Gemm g{(const bf16*)(F.ws + WS_R2), (const bf16*)(F.ws + WS_W2T) + (size_t)l * NEXP * DM * DM, 0, 0, DM};
            pg8::MoeOrder S{4, F.G, F.vcu, (const LAS int*)(F.lds + TAB_OFF)};
            EpiMoe2 E{(bf16*)(F.ws + WS_R1), KIN(I_B2) + (size_t)l * NEXP * DM};
            pg8::gemm_phase<EpiMoe2, pg8::MoeOrder, true, true>(F.lds + RING_OFF, g, S, E);
        }
        SEAM(pb + 8);
    }
    if (PH_EN(11) && IN(NPHASES - 1)) row_phase1(F, DEPTH, 1);
#undef IN
#undef SEAM
}

extern "C" void kernel_launch(void* const* d_in, const int* in_sizes, int n_in, void* d_out, int out_size, void* d_ws, size_t ws_size, hipStream_t stream) {
    static int grid = 0;
    if (grid == 0) {
        if (n_in != 22 || in_sizes[0] != MTOK * DM || out_size != MTOK * DM || ws_size < WS_END) { fprintf(stderr, "kernel_launch: unexpected shapes (n_in %d, in0 %d, out %d, ws %zu < %zu)\n", n_in, n_in > 0 ? in_sizes[0] : -1, out_size, ws_size, (size_t)WS_END); grid = -1; return; }
        int dev = 0, cus = 0, per_cu = 0;
        if (hipGetDevice(&dev) != hipSuccess || hipDeviceGetAttribute(&cus, hipDeviceAttributeMultiprocessorCount, dev) != hipSuccess) { grid = -1; return; }
        if (hipFuncSetAttribute((const void*)hybrid_fwd, hipFuncAttributeMaxDynamicSharedMemorySize, LDS_BYTES) != hipSuccess) { fprintf(stderr, "kernel_launch: hipFuncSetAttribute failed\n"); grid = -1; return; }
        if (hipOccupancyMaxActiveBlocksPerMultiprocessor(&per_cu, (const void*)hybrid_fwd, NWAVES * 64, LDS_BYTES) != hipSuccess || per_cu < 1) { fprintf(stderr, "kernel_launch: occupancy query says %d blocks per CU\n", per_cu); }
        (void)hipGetLastError();
        grid = cus;
    }
    if (grid < 0) return;
    (void)hipMemsetAsync((char*)d_ws + WS_CTL, 0, CTL_ZERO_BYTES, stream);
    Args a{};
    for (int i = 0; i < 22; ++i) a.in[i] = d_in[i];
    a.out = (float*)d_out; a.ws = (unsigned char*)d_ws;
#if MK_SPLIT
    for (int p = 0; p < DBG_LIMIT; ++p) {
        if (p >= 1 && p < NPHASES - 1 && ((p - 1) % PH_PER_LAYER) == 3) continue;
        a.ph_lo = p; a.ph_hi = p + 1;
        hipLaunchKernelGGL(hybrid_fwd, dim3(grid), dim3(NWAVES * 64), LDS_BYTES, stream, a);
    }
#else
    a.ph_lo = 0; a.ph_hi = NPHASES;
    hipLaunchKernelGGL(hybrid_fwd, dim3(grid), dim3(NWAVES * 64), LDS_BYTES, stream, a);
#endif
    const hipError_t le = hipPeekAtLastError();
    if (le != hipSuccess) fprintf(stderr, "kernel_launch: launch failed: %s\n", hipGetErrorName(le));
}
```

```cpp
#include <hip/hip_runtime.h>
#include <cstdio>
#include <cstdint>

#ifndef ONLY_PH
#define ONLY_PH -1
#endif
#define PH_EN(n) (ONLY_PH < 0 || ONLY_PH == (n))
#ifndef DBG_LIMIT
#define DBG_LIMIT NPHASES
#endif
#ifndef RET_MFMA
#define RET_MFMA 1
#endif
#ifndef MK_SPLIT
#define MK_SPLIT 0
#endif

namespace pg8 {
#define PG8_LAS __attribute__((address_space(3)))
typedef unsigned short bf16_t;
typedef short bf16x8 __attribute__((ext_vector_type(8)));
typedef float f32x4 __attribute__((ext_vector_type(4)));
typedef unsigned u32x4 __attribute__((ext_vector_type(4)));
constexpr int BM = 256, BK = 64, HALF = 128, HTB = HALF * BK * 2  , STAGE_BYTES = 8 * HTB, NXCD = 8, WGM = 8;

__host__ __device__ __forceinline__ int lds_byte(int r, int c) { const int st = (r >> 4) * 2 + (c >> 5), rr = r & 15, cc = c & 31, ob = rr * 64 + cc * 2; return st * 1024 + (ob ^ (((ob >> 9) & 1) << 5)); }
__host__ __device__ __forceinline__ void stage_rc(int b, int& R, int& C) { const int st = b / 1024, sb = b % 1024, swz = sb ^ (((sb >> 9) & 1) << 5); R = (st >> 1) * 16 + swz / 64; C = (st & 1) * 32 + (swz % 64) / 2; }
__host__ __device__ __forceinline__ int perm32(int rho) { const int n = rho >> 4, i = rho & 15; return 8 * (i >> 2) + 4 * n + (i & 3); }

struct Unit { int pm, pn, e, nn; };
struct Gemm { const bf16_t* A; const bf16_t* Bt; int M, N, K; };

struct StaticOrder {
    int nM, nN, nwg, G, c;
    __host__ __device__ void init(int M, int N, int G_, int c_) { nM = M / BM; nN = N / BM; nwg = nM * nN; G = G_; c = c_; }
    __host__ __device__ bool next(int i, Unit& u) const {
        const long L = (long)i * G + c; if (L >= nwg) return false;
        int wgid = (int)L; { const int q = nwg / NXCD, r = nwg % NXCD, xcd = wgid % NXCD, off = wgid / NXCD; wgid = (xcd < r ? xcd * (q + 1) : r * (q + 1) + (xcd - r) * q) + off; }
        const int nig = WGM * nN, gid = wgid / nig, fm = gid * WGM, gsz = (nM - fm) < WGM ? (nM - fm) : WGM;
        u.pm = fm + ((wgid % nig) % gsz); u.pn = (wgid % nig) / gsz; u.e = 0; u.nn = u.pn; return true;
    }
    __device__ __forceinline__ void a_ready(const Unit&) const {}
    __device__ __forceinline__ void done(const Unit&) const {}
};
struct MoeOrder {
    int nN, G, c; const PG8_LAS int* ts;
    __device__ __forceinline__ bool next(int i, Unit& u) const {
        const int NT = ts[32]; const long L = (long)i * G + c; if (L >= (long)NT * nN) return false;
        const int mt = (int)(L / nN), n = (int)(L % nN); int e = 0;
        for (int k = 1; k < 32; ++k) e += (ts[k] <= mt) ? 1 : 0;
        u.pm = mt; u.pn = e * nN + n; u.e = e; u.nn = n; return true;
    }
    __device__ __forceinline__ void a_ready(const Unit&) const {}
    __device__ __forceinline__ void done(const Unit&) const {}
};

__device__ __forceinline__ unsigned cvt_pk_bf16(float lo, float hi) { unsigned r; asm volatile("v_cvt_pk_bf16_f32 %0, %1, %2" : "=v"(r) : "v"(lo), "v"(hi)); return r; }

template <class Epi, class Sched, bool ALIGN_EPI = false, bool SP2 = false>
__device__ __forceinline__ void gemm_phase(PG8_LAS unsigned char* lds, const Gemm g, const Sched& S, const Epi& E) {
    int tid_ = threadIdx.x; asm volatile("" : "+v"(tid_));
    const int tid = tid_, wid = __builtin_amdgcn_readfirstlane(tid >> 6), lane = tid & 63, wr = wid >> 2, wc = wid & 3, fr = lane & 15, fq = lane >> 4;
    const int K = g.K, nt = K / BK;
    unsigned voffA[2], voffB[2];
#pragma unroll
    for (int i = 0; i < 2; ++i) { int R, C; stage_rc(tid * 16 + i * 8192, R, C); const int Rb = Epi::PERM ? ((R & ~31) + perm32(R & 31)) : R;
        voffA[i] = (unsigned)(R * K + C) * 2u; voffB[i] = (unsigned)(Rb * K + C) * 2u; }
    const size_t kstep = (size_t)(BK * 2);
    const size_t hstep = (size_t)HALF * K * 2;
    const size_t tstep = 2 * hstep;
    const unsigned ldsw = (unsigned)wid * 1024u;
    const int aoff = lds_byte(wr * 64 + fr, fq * 8), boff = lds_byte(wc * 32 + fr, fq * 8);
#define PG8_SA(b, h) (((b) * 2 + (h)) * HTB)
#define PG8_SB(b, h) ((4 + (b) * 2 + (h)) * HTB)
#define PG8_STAGE(bufoff, gbase, voff) do { _Pragma("unroll") for (int _i = 0; _i < 2; ++_i) \
        __builtin_amdgcn_global_load_lds((const unsigned*)((const char*)(gbase) + (voff)[_i]), (PG8_LAS unsigned*)(lds + (bufoff) + ldsw + _i * 8192), 16, 0, 0); } while (0)
#define PG8_LDA(dst, b, h) do { _Pragma("unroll") for (int m = 0; m < 4; ++m) _Pragma("unroll") for (int k = 0; k < 2; ++k) dst[m][k] = *(const PG8_LAS bf16x8*)(lds + PG8_SA(b, h) + aoff + m * 2048 + k * 1024); } while (0)
#define PG8_LDB(dst, b, h) do { _Pragma("unroll") for (int n = 0; n < 2; ++n) _Pragma("unroll") for (int k = 0; k < 2; ++k) dst[n][k] = *(const PG8_LAS bf16x8*)(lds + PG8_SB(b, h) + boff + n * 2048 + k * 1024); } while (0)
#define PG8_MMA(ai, bj, At, Bt) do { __builtin_amdgcn_s_setprio(1); _Pragma("unroll") for (int m = 0; m < 4; ++m) _Pragma("unroll") for (int n = 0; n < 2; ++n) _Pragma("unroll") for (int k = 0; k < 2; ++k) \
        acc[ai][bj][m][n] = __builtin_amdgcn_mfma_f32_16x16x32_bf16(Bt[n][k], At[m][k], acc[ai][bj][m][n], 0, 0, 0); __builtin_amdgcn_s_setprio(0); } while (0)
#define PG8_WAIT_V(n) asm volatile("s_waitcnt vmcnt(" #n ")" ::: "memory")
#define PG8_WAIT_L(n) asm volatile("s_waitcnt lgkmcnt(" #n ")" ::: "memory")
#define PG8_BAR __builtin_amdgcn_s_barrier()
#define PG8_SCHED __builtin_amdgcn_sched_barrier(0)
    Unit cur, nxt; int ui = 0;
    if (!S.next(0, cur)) return;
    f32x4 acc[2][2][4][2];
#pragma unroll
    for (int a = 0; a < 2; ++a)
#pragma unroll
        for (int b = 0; b < 2; ++b)
#pragma unroll
            for (int m = 0; m < 4; ++m)
#pragma unroll
                for (int n = 0; n < 2; ++n) acc[a][b][m][n] = (f32x4){0.f, 0.f, 0.f, 0.f};
    bf16x8 At[4][2], B0[2][2], B1[2][2];
    const char* cA = (const char*)g.A + (size_t)cur.pm * tstep; const char* cB = (const char*)g.Bt + (size_t)cur.pn * tstep;
    S.a_ready(cur);
    if constexpr (SP2) {
        PG8_STAGE(PG8_SB(0, 0), cB, voffB); PG8_STAGE(PG8_SB(0, 1), cB + hstep, voffB); PG8_STAGE(PG8_SA(0, 0), cA, voffA); PG8_STAGE(PG8_SA(0, 1), cA + hstep, voffA);
        if (wr == 1) PG8_BAR;
        PG8_WAIT_V(2); PG8_BAR;
        PG8_STAGE(PG8_SB(1, 0), cB + kstep, voffB); PG8_STAGE(PG8_SA(1, 0), cA + kstep, voffA); PG8_STAGE(PG8_SB(1, 1), cB + hstep + kstep, voffB);
        PG8_WAIT_V(6); PG8_BAR;
    } else {
        PG8_STAGE(PG8_SB(0, 0), cB, voffB); PG8_STAGE(PG8_SA(0, 0), cA, voffA); PG8_STAGE(PG8_SB(0, 1), cB + hstep, voffB); PG8_STAGE(PG8_SA(0, 1), cA + hstep, voffA);
        if (wr == 1) PG8_BAR;
        PG8_WAIT_V(4); PG8_BAR;
        PG8_STAGE(PG8_SB(1, 0), cB + kstep, voffB); PG8_STAGE(PG8_SA(1, 0), cA + kstep, voffA); PG8_STAGE(PG8_SB(1, 1), cB + hstep + kstep, voffB);
        PG8_WAIT_V(6); PG8_BAR;
    }
    for (;;) {
        const bool has_next = S.next(ui + 1, nxt);
        const char* nA = has_next ? (const char*)g.A + (size_t)nxt.pm * tstep : cA; const char* nB = has_next ? (const char*)g.Bt + (size_t)nxt.pn * tstep : cB;
        for (int t = 0; t < nt; t += 2) {
            const bool last = (t == nt - 2);
            const char* a1 = cA + (size_t)(t + 1) * kstep;
            const char* a2 = last ? nA : cA + (size_t)(t + 2) * kstep; const char* b2 = last ? nB : cB + (size_t)(t + 2) * kstep;
            const char* a3 = a2 + kstep; const char* b3 = b2 + kstep;
            if (last && has_next) S.a_ready(nxt);
            if constexpr (SP2) {
            PG8_LDB(B0, 0, 0); PG8_LDB(B1, 0, 1); PG8_SCHED; PG8_LDA(At, 0, 0); PG8_STAGE(PG8_SA(1, 1), a1 + hstep, voffA);
            PG8_WAIT_V(8); PG8_WAIT_L(0); PG8_BAR; PG8_MMA(0, 0, At, B0); PG8_MMA(0, 1, At, B1); PG8_BAR; PG8_SCHED;
            PG8_LDA(At, 0, 1); PG8_STAGE(PG8_SB(0, 0), b2, voffB); PG8_STAGE(PG8_SB(0, 1), b2 + hstep, voffB); PG8_STAGE(PG8_SA(0, 0), a2, voffA);
            PG8_WAIT_V(8); PG8_WAIT_L(0); PG8_BAR; PG8_MMA(1, 0, At, B0); PG8_MMA(1, 1, At, B1); PG8_BAR; PG8_SCHED;
            PG8_LDB(B0, 1, 0); PG8_LDB(B1, 1, 1); PG8_SCHED; PG8_LDA(At, 1, 0); PG8_STAGE(PG8_SA(0, 1), a2 + hstep, voffA);
            PG8_WAIT_V(8); PG8_WAIT_L(0); PG8_BAR; PG8_MMA(0, 0, At, B0); PG8_MMA(0, 1, At, B1); PG8_BAR; PG8_SCHED;
            PG8_LDA(At, 1, 1); PG8_STAGE(PG8_SB(1, 0), b3, voffB); PG8_STAGE(PG8_SB(1, 1), b3 + hstep, voffB); PG8_STAGE(PG8_SA(1, 0), a3, voffA);
            PG8_WAIT_V(8); PG8_WAIT_L(0); PG8_BAR; PG8_MMA(1, 0, At, B0); PG8_MMA(1, 1, At, B1); PG8_BAR; PG8_SCHED;
            } else {
            PG8_LDB(B0, 0, 0); PG8_SCHED; PG8_LDA(At, 0, 0); PG8_STAGE(PG8_SA(1, 1), a1 + hstep, voffA);
            PG8_WAIT_L(8); PG8_BAR; PG8_WAIT_L(0); PG8_MMA(0, 0, At, B0); PG8_BAR; PG8_SCHED;
            PG8_LDB(B1, 0, 1); PG8_STAGE(PG8_SB(0, 0), b2, voffB);
            PG8_BAR; PG8_WAIT_L(0); PG8_MMA(0, 1, At, B1); PG8_BAR;
            PG8_LDA(At, 0, 1); PG8_STAGE(PG8_SA(0, 0), a2, voffA);
            PG8_BAR; PG8_WAIT_L(0); PG8_MMA(1, 0, At, B0); PG8_BAR; PG8_SCHED;
            PG8_STAGE(PG8_SB(0, 1), b2 + hstep, voffB);
            PG8_WAIT_V(6); PG8_BAR; PG8_MMA(1, 1, At, B1); PG8_BAR;
            PG8_LDB(B0, 1, 0); PG8_SCHED; PG8_LDA(At, 1, 0); PG8_STAGE(PG8_SA(0, 1), a2 + hstep, voffA);
            PG8_WAIT_L(8); PG8_BAR; PG8_WAIT_L(0); PG8_MMA(0, 0, At, B0); PG8_BAR; PG8_SCHED;
            PG8_LDB(B1, 1, 1); PG8_STAGE(PG8_SB(1, 0), b3, voffB);
            PG8_BAR; PG8_WAIT_L(0); PG8_MMA(0, 1, At, B1); PG8_BAR;
            PG8_LDA(At, 1, 1); PG8_STAGE(PG8_SA(1, 0), a3, voffA);
            PG8_BAR; PG8_WAIT_L(0); PG8_MMA(1, 0, At, B0); PG8_BAR; PG8_SCHED;
            PG8_STAGE(PG8_SB(1, 1), b3 + hstep, voffB);
            PG8_WAIT_V(6); PG8_BAR; PG8_MMA(1, 1, At, B1); PG8_BAR;
            }
        }
        if constexpr (ALIGN_EPI) { if (wr == 0) PG8_BAR; }
        E(acc, cur, wr, wc, fr, fq);
        if (!has_next) break;
#pragma unroll
        for (int a = 0; a < 2; ++a)
#pragma unroll
            for (int b = 0; b < 2; ++b)
#pragma unroll
                for (int m = 0; m < 4; ++m)
#pragma unroll
                    for (int n = 0; n < 2; ++n) acc[a][b][m][n] = (f32x4){0.f, 0.f, 0.f, 0.f};
        cur = nxt; cA = nA; cB = nB; ++ui;
        if constexpr (ALIGN_EPI) { if (wr == 1) PG8_BAR; }
    }
    PG8_WAIT_V(0);
    if constexpr (!ALIGN_EPI) { if (wr == 0) PG8_BAR; }
    PG8_BAR;
#undef PG8_SA
#undef PG8_SB
#undef PG8_STAGE
#undef PG8_LDA
#undef PG8_LDB
#undef PG8_MMA
#undef PG8_WAIT_V
#undef PG8_WAIT_L
#undef PG8_BAR
#undef PG8_SCHED
}
}

constexpr int NWAVES = 8;
constexpr int DM = 1024, NBATCH = 32, SEQ = 2048, MTOK = NBATCH * SEQ, DEPTH = 4, NEXP = 32, TOPK = 4;
constexpr int HG_N = 4096, RT_N = 6144, HG_H = 8, RT_H = 4;
constexpr float EPS = 1e-6f;
constexpr int LCAP = 65536;
constexpr int MAXTILES = 1056;

constexpr size_t MiB = 1u << 20;
constexpr size_t WS_CTL = 0, CTL_ZERO_BYTES = 1 * MiB;
constexpr size_t WS_MOD = 1 * MiB;
constexpr size_t WS_FMOD = 4 * MiB;
constexpr size_t WS_LBV = 4 * MiB + 512 * 1024;
constexpr size_t WS_HWIN = 8 * MiB, WS_HWOUT = 24 * MiB, WS_RWIN = 28 * MiB, WS_RWOUT = 52 * MiB, WS_W1T = 64 * MiB, WS_W2T = 576 * MiB;
constexpr size_t WS_H = 832 * MiB;
constexpr size_t WS_LIST = 960 * MiB;
constexpr size_t WS_TSLOT = 968 * MiB, WS_TGATE = 969 * MiB;
constexpr size_t WS_R1 = 976 * MiB;
constexpr size_t WS_R2 = 1744 * MiB;
constexpr size_t WS_END = 2272 * MiB;
constexpr int CW_BAR = 4096;
constexpr int CW_CNT = 8192;

constexpr int RING_OFF = 0, RING_BYTES = 131072;
constexpr int MISC_OFF = 155648;
constexpr int TAB_OFF = MISC_OFF + 128;
constexpr int LDS_BYTES = 160 * 1024;

#define GAS __attribute__((address_space(1)))
#define LAS __attribute__((address_space(3)))
typedef unsigned short bf16;
typedef unsigned v4u __attribute__((ext_vector_type(4)));
typedef unsigned v2u __attribute__((ext_vector_type(2)));
typedef float f32x4 __attribute__((ext_vector_type(4)));
typedef short bf16x8 __attribute__((ext_vector_type(8)));
#define RLX_AGENT __ATOMIC_RELAXED, __HIP_MEMORY_SCOPE_AGENT
#define LDS_WAIT() asm volatile("s_waitcnt lgkmcnt(0)" ::: "memory")
#define VM_WAIT() asm volatile("s_waitcnt vmcnt(0)" ::: "memory")
__device__ __forceinline__ unsigned pk2(float lo, float hi) { return pg8::cvt_pk_bf16(lo, hi); }
__device__ __forceinline__ float bflo(unsigned w) { return __uint_as_float(w << 16); }
__device__ __forceinline__ float bfhi(unsigned w) { return __uint_as_float(w & 0xffff0000u); }
__device__ __forceinline__ float bf2f(unsigned short h) { return __uint_as_float(((unsigned)h) << 16); }
__device__ __forceinline__ float sigmoidf_(float x) { return __builtin_amdgcn_rcpf(1.f + __expf(-x)); }
__device__ __forceinline__ float siluf_(float x) { return x * sigmoidf_(x); }
__device__ __forceinline__ unsigned ldu_vec(const unsigned* p) { return __hip_atomic_load(p, RLX_AGENT); }

#define XB_TMO      128
#define XB_XCNT(j)  (256  + 64 * (j))
#define XB_XSUB(j)  (1280 + 64 * (j))
#define XB_XGEN(j)  (2304 + 64 * (j))
#define XB_TOP      3328
#define XB_TOPGEN   3392
#define XCD_BAR_WORDS 3456
#define XB_SPIN_CAP (1u << 18)

__device__ __forceinline__ unsigned xb_ld(unsigned* p)              { return __hip_atomic_load(p, __ATOMIC_RELAXED, __HIP_MEMORY_SCOPE_AGENT); }
__device__ __forceinline__ unsigned xb_add(unsigned* p, unsigned v) { return __hip_atomic_fetch_add(p, v, __ATOMIC_RELAXED, __HIP_MEMORY_SCOPE_AGENT); }
__device__ __forceinline__ unsigned xb_xcc_id() { return (unsigned)__builtin_amdgcn_s_getreg((3 << 11) | 20) & 0xFu; }
#define XB_SPIN(cond, bar) do { unsigned _sp = 0; while (cond) { __builtin_amdgcn_s_sleep(1); \
    if ((++_sp & 255u) == 0u) { if (xb_ld(&(bar)[XB_TMO])) break; if (_sp > XB_SPIN_CAP) { atomicAdd(&(bar)[XB_TMO], 1u); break; } } } } while (0)

struct XcdBarrier {
    unsigned* bar; unsigned x;
    volatile LAS unsigned* st;
};
__device__ __forceinline__ XcdBarrier xcd_barrier_post(unsigned* bar, volatile LAS unsigned* st) {
    XcdBarrier b; b.bar = bar; b.x = xb_xcc_id(); b.st = st;
    if (threadIdx.x == 0) (void)xb_add(&bar[XB_XCNT(b.x)], 1u);
    return b;
}
__device__ __forceinline__ void xcd_barrier_complete(unsigned* bar, unsigned x, unsigned& nloc, unsigned& nx) {
    const unsigned G = gridDim.x * gridDim.y * gridDim.z;
    unsigned sum, cnt, mine, sp = 0u;
    for (;;) {
        sum = 0u; cnt = 0u; mine = 0u;
#pragma unroll
        for (unsigned j = 0; j < 16; ++j) { const unsigned c = xb_ld(&bar[XB_XCNT(j)]); sum += c; cnt += (c > 0u) ? 1u : 0u; mine = (j == x) ? c : mine; }
        if (sum == G) break;
        __builtin_amdgcn_s_sleep(1);
        if ((++sp & 255u) == 0u) { if (xb_ld(&bar[XB_TMO])) break; if (sp > XB_SPIN_CAP) { atomicAdd(&bar[XB_TMO], 1u); break; } }
    }
    nloc = mine > 0u ? mine : 1u; nx = cnt > 0u ? cnt : 1u;
}
__device__ __forceinline__ void xcd_barrier(const XcdBarrier& b) {
    asm volatile("s_waitcnt vmcnt(0)" ::: "memory");
    __syncthreads();
    if (threadIdx.x == 0) {
        unsigned* bar = b.bar;
        __builtin_amdgcn_s_waitcnt(0);
        unsigned nloc = b.st[0], nx = b.st[1];
        if (nloc == 0u) { xcd_barrier_complete(bar, b.x, nloc, nx); b.st[0] = nloc; b.st[1] = nx; }
        const unsigned old = xb_add(&bar[XB_XSUB(b.x)], 1u);
        const unsigned gen = old / nloc;
        if (old + 1u == (gen + 1u) * nloc) {
            __builtin_amdgcn_fence(__ATOMIC_RELEASE, "agent");
            asm volatile("s_waitcnt vmcnt(0)" ::: "memory");
            const unsigned og = xb_add(&bar[XB_TOP], 1u);
            const unsigned tg = og / nx;
            if (og + 1u == (tg + 1u) * nx) xb_add(&bar[XB_TOPGEN], 1u);
            else XB_SPIN(xb_ld(&bar[XB_TOPGEN]) == tg, bar);
            __builtin_amdgcn_fence(__ATOMIC_ACQUIRE, "agent");
            xb_add(&bar[XB_XGEN(b.x)], 1u);
            asm volatile("s_waitcnt vmcnt(0)" ::: "memory");
        } else {
            XB_SPIN(xb_ld(&bar[XB_XGEN(b.x)]) == gen, bar);
            __builtin_amdgcn_fence(__ATOMIC_ACQUIRE, "agent");
            asm volatile("s_waitcnt vmcnt(0)" ::: "memory");
        }
    }
    __syncthreads();
}

struct Frame {
    LAS unsigned char* lds;
    unsigned* ctl;
    int tid, lane, wave, vcu, G;
    float* out; unsigned char* ws;
};
__device__ __forceinline__ void relaunder(Frame& F) { int t = threadIdx.x; asm volatile("" : "+v"(t)); F.tid = t; F.lane = t & 63; F.wave = __builtin_amdgcn_readfirstlane(t >> 6); }
#define KAS __attribute__((address_space(4)))
__device__ __forceinline__ const void* kin_(int i) { const KAS char* kp = (const KAS char*)__builtin_amdgcn_kernarg_segment_ptr(); asm volatile("" : "+s"(kp)); return *(const void* const KAS*)(kp + 8 * i); }
enum { I_X = 0, I_C, I_POS, I_ADAW, I_ADAB, I_N1G, I_N2G, I_HWIN, I_HWOUT, I_HGAIN, I_HLB, I_RWIN, I_RWOUT, I_RTW, I_RTB, I_W1, I_B1, I_W2, I_B2, I_FG, I_FADAW, I_FADAB };
#define KIN(i) ((const float*)kin_(i))
__device__ __forceinline__ float wave_sum(float v) {
#pragma unroll
    for (int o = 1; o < 64; o <<= 1) v += __shfl_xor(v, o);
    return v;
}

__device__ __forceinline__ void p0_transpose_item(const float* W, int N, bf16* WT, int K, int k0, int n0, int drow0, LAS float* scr, int lane) {
#pragma unroll 8
    for (int i = 0; i < 32; ++i) { const int kk = 2 * i + (lane >> 5); scr[kk * 33 + (lane & 31)] = W[(size_t)(k0 + kk) * N + n0 + (lane & 31)]; }
    LDS_WAIT(); asm volatile("" ::: "memory");
    const int c = lane & 7;
#pragma unroll
    for (int j = 0; j < 4; ++j) { const int n = (lane >> 3) + 8 * j; const LAS float* s = scr + (8 * c) * 33 + n;
        v4u o; o.x = pk2(s[0 * 33], s[1 * 33]); o.y = pk2(s[2 * 33], s[3 * 33]); o.z = pk2(s[4 * 33], s[5 * 33]); o.w = pk2(s[6 * 33], s[7 * 33]);
        *(GAS v4u*)(WT + (size_t)(drow0 + n) * K + k0 + 8 * c) = o; }
    LDS_WAIT(); asm volatile("" ::: "memory");
}
__device__ __forceinline__ void p0_prologue(Frame& F) {
    relaunder(F);
    const int gw = F.vcu * NWAVES + F.wave, NGW = F.G * NWAVES;
    {
        LAS float* condT = (LAS float*)(F.lds + RING_OFF);
        const float* cin = KIN(I_C);
        for (int idx = F.tid; idx < NBATCH * DM; idx += NWAVES * 64) { const int b = idx >> 10, k = idx & 1023; condT[k * 32 + b] = siluf_(cin[idx]); }
        __syncthreads();
        if ((gw & 3) == 0 && (gw >> 2) < 416) {
            const int u = gw >> 2; const float* W; const float* bias; float* outp; int N, n0, ostride;
            if (u < 384) { const int l = u / 96; n0 = (u % 96) * 64; N = 6 * DM; W = KIN(I_ADAW) + (size_t)l * DM * N; bias = KIN(I_ADAB) + l * N; outp = (float*)(F.ws + WS_MOD) + (size_t)l * NBATCH * N; ostride = N; }
            else { n0 = (u - 384) * 64; N = 2 * DM; W = KIN(I_FADAW); bias = KIN(I_FADAB); outp = (float*)(F.ws + WS_FMOD); ostride = N; }
            float acc[32];
#pragma unroll
            for (int b = 0; b < 32; ++b) acc[b] = 0.f;
#pragma unroll 4
            for (int k = 0; k < DM; ++k) {
                const float w = W[(size_t)k * N + n0 + F.lane];
                const LAS f32x4* cb = (const LAS f32x4*)(condT + k * 32);
#pragma unroll
                for (int q = 0; q < 8; ++q) { const f32x4 cv = cb[q]; acc[4 * q + 0] += cv.x * w; acc[4 * q + 1] += cv.y * w; acc[4 * q + 2] += cv.z * w; acc[4 * q + 3] += cv.w * w; }
            }
            const float bv = bias[n0 + F.lane];
#pragma unroll
            for (int b = 0; b < 32; ++b) outp[(size_t)b * ostride + n0 + F.lane] = acc[b] + bv;
        }
        if (gw == NGW - 1) {
            float* lbv = (float*)(F.ws + WS_LBV); const float* hlb = KIN(I_HLB);
            for (int d = F.lane; d < DM; d += 64) { const float a = hlb[d], b = hlb[DM + d], m = fmaxf(a, b), ea = __expf(a - m), eb = __expf(b - m); lbv[d] = 0.f; lbv[DM + d] = eb / (ea + eb); }
        }
        __syncthreads();
    }
    {
        LAS float* scr = (LAS float*)(F.lds + RING_OFF + F.wave * 16384);
        constexpr int NI_HI = 2 * 16 * 128, NI_HO = 2 * 16 * 32, NI_RI = 2 * 16 * 192, NI_RO = 2 * 32 * 32, NI_W1 = 128 * 16 * 64, NI_W2 = 128 * 16 * 32;
        constexpr int NITEMS = NI_HI + NI_HO + NI_RI + NI_RO + NI_W1 + NI_W2;
        for (int it = gw; it < NITEMS; it += NGW) {
            int r = it;
            if (r < NI_HI) { const int j = r / 2048, q = r % 2048, kb = q / 128, nb = q % 128;
                p0_transpose_item(KIN(I_HWIN) + (size_t)j * DM * HG_N, HG_N, (bf16*)(F.ws + WS_HWIN) + (size_t)j * HG_N * DM, DM, 64 * kb, 32 * nb, 32 * nb, scr, F.lane); continue; } r -= NI_HI;
            if (r < NI_HO) { const int j = r / 512, q = r % 512, kb = q / 32, nb = q % 32;
                p0_transpose_item(KIN(I_HWOUT) + (size_t)j * DM * DM, DM, (bf16*)(F.ws + WS_HWOUT) + (size_t)j * DM * DM, DM, 64 * kb, 32 * nb, 32 * nb, scr, F.lane); continue; } r -= NI_HO;
            if (r < NI_RI) { const int j = r / 3072, q = r % 3072, kb = q / 192, nb = q % 192;
                p0_transpose_item(KIN(I_RWIN) + (size_t)j * DM * RT_N, RT_N, (bf16*)(F.ws + WS_RWIN) + (size_t)j * RT_N * DM, DM, 64 * kb, 32 * nb, 32 * nb, scr, F.lane); continue; } r -= NI_RI;
            if (r < NI_RO) { const int j = r / 1024, q = r % 1024, kb = q / 32, nb = q % 32;
                p0_transpose_item(KIN(I_RWOUT) + (size_t)j * 2048 * DM, DM, (bf16*)(F.ws + WS_RWOUT) + (size_t)j * DM * 2048, 2048, 64 * kb, 32 * nb, 32 * nb, scr, F.lane); continue; } r -= NI_RO;
            if (r < NI_W1) { const int mi = r / 1024, q = r % 1024, kb = q / 64, nb = q % 64; const int n0 = 32 * nb;
                const int cc = n0 & 1023, drow0 = 256 * (cc >> 7) + (cc & 127) + ((n0 >= 1024) ? 128 : 0);
                p0_transpose_item(KIN(I_W1) + (size_t)mi * DM * 2048, 2048, (bf16*)(F.ws + WS_W1T) + (size_t)mi * 2048 * DM, DM, 64 * kb, n0, drow0, scr, F.lane); continue; } r -= NI_W1;
            { const int mi = r / 512, q = r % 512, kb = q / 32, nb = q % 32;
                p0_transpose_item(KIN(I_W2) + (size_t)mi * DM * DM, DM, (bf16*)(F.ws + WS_W2T) + (size_t)mi * DM * DM, DM, 64 * kb, 32 * nb, 32 * nb, scr, F.lane); }
        }
    }
}

__device__ __forceinline__ void build_tiles(Frame& F, int l) {
    LAS int* ts = (LAS int*)(F.lds + TAB_OFF); LAS int* cnt = ts + 40;
    __syncthreads();
    if (F.tid < NEXP) cnt[F.tid] = (int)ldu_vec(F.ctl + CW_CNT + l * 2048 + F.tid * 64);
    __syncthreads();
    if (F.tid == 0) { int a = 0; for (int e = 0; e < NEXP; ++e) { ts[e] = a; a += (cnt[e] + 255) >> 8; } ts[NEXP] = a; }
    __syncthreads();
}

__device__ __forceinline__ void row_phase1(Frame& F, int l, int mode) {
    relaunder(F);
    const LAS int* ts = (const LAS int*)(F.lds + TAB_OFF);
    const bool comb = (l > 0);
    if (comb) build_tiles(F, l - 1);
    const float* xsrc = comb ? F.out : KIN(I_X);
    const bf16* Y = (const bf16*)(F.ws + WS_R1);
    const unsigned* tslot = (const unsigned*)(F.ws + WS_TSLOT); const unsigned* tgate = (const unsigned*)(F.ws + WS_TGATE);
    bf16* H = (bf16*)(F.ws + WS_H);
    for (int rb = F.vcu * 256; rb < MTOK; rb += F.G * 256) {
        const int b = rb / SEQ;
        f32x4 A[4], B[4], G2[4];
#pragma unroll
        for (int j = 0; j < 4; ++j) {
            const int c = 4 * F.lane + 256 * j;
            if (mode == 0) { const float* mv = (const float*)(F.ws + WS_MOD) + (size_t)(l * NBATCH + b) * 6 * DM;
                const f32x4 g = *(const f32x4*)(KIN(I_N1G) + l * DM + c), sc = *(const f32x4*)(mv + 1 * DM + c); A[j] = g * (sc + 1.0f); B[j] = *(const f32x4*)(mv + c); }
            else { const float* fm = (const float*)(F.ws + WS_FMOD) + (size_t)b * 2 * DM;
                const f32x4 g = *(const f32x4*)(KIN(I_FG) + c), sc = *(const f32x4*)(fm + DM + c); A[j] = g * (sc + 1.0f); B[j] = *(const f32x4*)(fm + c); }
            if (comb) G2[j] = *(const f32x4*)((const float*)(F.ws + WS_MOD) + (size_t)((l - 1) * NBATCH + b) * 6 * DM + 5 * DM + c); else G2[j] = (f32x4){0.f, 0.f, 0.f, 0.f};
        }
        for (int r = 0; r < 32; ++r) {
            const int row = rb + 32 * F.wave + r;
            f32x4 v[4];
#pragma unroll
            for (int j = 0; j < 4; ++j) v[j] = *(const f32x4*)(xsrc + (size_t)row * DM + 4 * F.lane + 256 * j);
            if (comb) {
                const unsigned sl = tslot[(size_t)row * 4 + (F.lane & 3)], gt = tgate[(size_t)row * 4 + (F.lane & 3)];
                f32x4 ys[4];
#pragma unroll
                for (int j = 0; j < 4; ++j) ys[j] = (f32x4){0.f, 0.f, 0.f, 0.f};
#pragma unroll
                for (int k = 0; k < TOPK; ++k) {
                    const unsigned s = (unsigned)__shfl((int)sl, k); const float gk = __uint_as_float((unsigned)__shfl((int)gt, k));
                    const int e = (int)(s >> 20), pos = (int)(s & 0xFFFFFu); const size_t yrow = (size_t)ts[e] * 256 + pos;
#pragma unroll
                    for (int j = 0; j < 4; ++j) { const v2u w = *(const v2u*)(Y + yrow * DM + 4 * F.lane + 256 * j);
                        ys[j].x += gk * bflo(w.x); ys[j].y += gk * bfhi(w.x); ys[j].z += gk * bflo(w.y); ys[j].w += gk * bfhi(w.y); }
                }
#pragma unroll
                for (int j = 0; j < 4; ++j) v[j] = v[j] + G2[j] * ys[j];
                if (mode == 0) {
#pragma unroll
                    for (int j = 0; j < 4; ++j) *(f32x4*)(F.out + (size_t)row * DM + 4 * F.lane + 256 * j) = v[j];
                }
            }
            float s2 = 0.f;
#pragma unroll
            for (int j = 0; j < 4; ++j) s2 += (v[j].x * v[j].x + v[j].y * v[j].y) + (v[j].z * v[j].z + v[j].w * v[j].w);
            const float rstd = 1.0f / sqrtf(wave_sum(s2) * (1.0f / DM) + EPS);
            if (mode == 0) {
#pragma unroll
                for (int j = 0; j < 4; ++j) { const f32x4 h = v[j] * rstd * A[j] + B[j]; v2u w; w.x = pk2(h.x, h.y); w.y = pk2(h.z, h.w); *(v2u*)(H + (size_t)row * DM + 4 * F.lane + 256 * j) = w; }
            } else {
#pragma unroll
                for (int j = 0; j < 4; ++j) *(f32x4*)(F.out + (size_t)row * DM + 4 * F.lane + 256 * j) = v[j] * rstd * A[j] + B[j];
            }
        }
    }
}

__device__ __forceinline__ void row_phase2(Frame& F, int l) {
    relaunder(F);
    bf16* H = (bf16*)(F.ws + WS_H);
    LAS unsigned char* frag = F.lds + RING_OFF;
    LAS float* lg = (LAS float*)(F.lds + 131072 + F.wave * 2112);
    LAS int* cntL = (LAS int*)(F.lds + 147968); LAS int* baseL = cntL + 32; LAS float* rbias = (LAS float*)(cntL + 64);
    unsigned* list = (unsigned*)(F.ws + WS_LIST); unsigned* tslot = (unsigned*)(F.ws + WS_TSLOT); float* tgate = (float*)(F.ws + WS_TGATE);
    __syncthreads();
    { const float* rw = KIN(I_RTW) + (size_t)l * DM * NEXP;
      for (int it = F.tid; it < 32 * 2 * 64; it += NWAVES * 64) { const int ln = it & 63, nt = (it >> 6) & 1, s = it >> 7; const int e = 16 * nt + (ln & 15), k0 = 32 * s + 8 * (ln >> 4);
          float w[8], hi[8];
#pragma unroll
          for (int j = 0; j < 8; ++j) { w[j] = rw[(size_t)(k0 + j) * NEXP + e]; }
          v4u ph, pl;
          { unsigned a = pk2(w[0], w[1]), b2 = pk2(w[2], w[3]), c2 = pk2(w[4], w[5]), d2 = pk2(w[6], w[7]); ph = (v4u){a, b2, c2, d2};
            hi[0] = bflo(a); hi[1] = bfhi(a); hi[2] = bflo(b2); hi[3] = bfhi(b2); hi[4] = bflo(c2); hi[5] = bfhi(c2); hi[6] = bflo(d2); hi[7] = bfhi(d2); }
          pl = (v4u){pk2(w[0] - hi[0], w[1] - hi[1]), pk2(w[2] - hi[2], w[3] - hi[3]), pk2(w[4] - hi[4], w[5] - hi[5]), pk2(w[6] - hi[6], w[7] - hi[7])};
          *(LAS v4u*)(frag + ((s * 2 + nt) * 2 + 0) * 1024 + ln * 16) = ph; *(LAS v4u*)(frag + ((s * 2 + nt) * 2 + 1) * 1024 + ln * 16) = pl; }
      if (F.tid < NEXP) rbias[F.tid] = KIN(I_RTB)[l * NEXP + F.tid];
    }
    for (int rb = F.vcu * 256; rb < MTOK; rb += F.G * 256) {
        const int b = rb / SEQ;
        if (F.tid < NEXP) cntL[F.tid] = 0;
        __syncthreads();
        {
            f32x4 A[4], B[4];
            const float* mv = (const float*)(F.ws + WS_MOD) + (size_t)(l * NBATCH + b) * 6 * DM;
#pragma unroll
            for (int j = 0; j < 4; ++j) { const int c = 4 * F.lane + 256 * j; const f32x4 g = *(const f32x4*)(KIN(I_N2G) + l * DM + c), sc = *(const f32x4*)(mv + 4 * DM + c); A[j] = g * (sc + 1.0f); B[j] = *(const f32x4*)(mv + 3 * DM + c); }
            for (int r = 0; r < 32; ++r) {
                const int row = rb + 32 * F.wave + r;
                f32x4 v[4]; float s2 = 0.f;
#pragma unroll
                for (int j = 0; j < 4; ++j) { v[j] = *(const f32x4*)(F.out + (size_t)row * DM + 4 * F.lane + 256 * j); s2 += (v[j].x * v[j].x + v[j].y * v[j].y) + (v[j].z * v[j].z + v[j].w * v[j].w); }
                const float rstd = 1.0f / sqrtf(wave_sum(s2) * (1.0f / DM) + EPS);
#pragma unroll
                for (int j = 0; j < 4; ++j) { const f32x4 h = v[j] * rstd * A[j] + B[j]; v2u w; w.x = pk2(h.x, h.y); w.y = pk2(h.z, h.w); *(v2u*)(H + (size_t)row * DM + 4 * F.lane + 256 * j) = w; }
            }
        }
        VM_WAIT();
        int my_e[2][TOPK], my_lp[2][TOPK]; float my_g[2][TOPK];
#pragma unroll
        for (int grp = 0; grp < 2; ++grp) {
            const int row0 = rb + 32 * F.wave + 16 * grp;
            f32x4 acc0 = (f32x4){0.f, 0.f, 0.f, 0.f}, acc1 = (f32x4){0.f, 0.f, 0.f, 0.f};
            const unsigned long long* ap = (const unsigned long long*)(H + (size_t)(row0 + (F.lane & 15)) * DM + 8 * (F.lane >> 4));
#pragma unroll 4
            for (int s = 0; s < 32; ++s) {
                const unsigned long long lo = __hip_atomic_load(ap + 8 * s, RLX_AGENT), hi = __hip_atomic_load(ap + 8 * s + 1, RLX_AGENT);
                v4u av = (v4u){(unsigned)lo, (unsigned)(lo >> 32), (unsigned)hi, (unsigned)(hi >> 32)}; const bf16x8 a = __builtin_bit_cast(bf16x8, av);
                const bf16x8 b00 = *(const LAS bf16x8*)(frag + ((s * 2 + 0) * 2 + 0) * 1024 + F.lane * 16), b01 = *(const LAS bf16x8*)(frag + ((s * 2 + 0) * 2 + 1) * 1024 + F.lane * 16);
                const bf16x8 b10 = *(const LAS bf16x8*)(frag + ((s * 2 + 1) * 2 + 0) * 1024 + F.lane * 16), b11 = *(const LAS bf16x8*)(frag + ((s * 2 + 1) * 2 + 1) * 1024 + F.lane * 16);
                acc0 = __builtin_amdgcn_mfma_f32_16x16x32_bf16(a, b00, acc0, 0, 0, 0); acc0 = __builtin_amdgcn_mfma_f32_16x16x32_bf16(a, b01, acc0, 0, 0, 0);
                acc1 = __builtin_amdgcn_mfma_f32_16x16x32_bf16(a, b10, acc1, 0, 0, 0); acc1 = __builtin_amdgcn_mfma_f32_16x16x32_bf16(a, b11, acc1, 0, 0, 0);
            }
#pragma unroll
            for (int q = 0; q < 4; ++q) { lg[(4 * (F.lane >> 4) + q) * 33 + (F.lane & 15)] = acc0[q]; lg[(4 * (F.lane >> 4) + q) * 33 + 16 + (F.lane & 15)] = acc1[q]; }
            LDS_WAIT(); asm volatile("" ::: "memory");
            if (F.lane < 16) {
                unsigned taken = 0u; float tl[TOPK];
#pragma unroll
                for (int k = 0; k < TOPK; ++k) {
                    float best = -3.0e38f; int bi = 0;
                    for (int e = 0; e < NEXP; ++e) { const float v = lg[F.lane * 33 + e] + rbias[e]; if (!((taken >> e) & 1u) && v > best) { best = v; bi = e; } }
                    taken |= 1u << bi; my_e[grp][k] = bi; tl[k] = best;
                }
                float den = 0.f, ex[TOPK];
#pragma unroll
                for (int k = 0; k < TOPK; ++k) { ex[k] = __expf(tl[k] - tl[0]); den += ex[k]; }
#pragma unroll
                for (int k = 0; k < TOPK; ++k) { my_g[grp][k] = ex[k] / den; my_lp[grp][k] = __hip_atomic_fetch_add(&cntL[my_e[grp][k]], 1, __ATOMIC_RELAXED, __HIP_MEMORY_SCOPE_WORKGROUP); }
            } else {
#pragma unroll
                for (int k = 0; k < TOPK; ++k) { my_e[grp][k] = 0; my_lp[grp][k] = 0; my_g[grp][k] = 0.f; }
            }
            LDS_WAIT(); asm volatile("" ::: "memory");
        }
        __syncthreads();
        if (F.tid < NEXP) baseL[F.tid] = (int)__hip_atomic_fetch_add(F.ctl + CW_CNT + l * 2048 + F.tid * 64, (unsigned)cntL[F.tid], RLX_AGENT);
        __syncthreads();
        if (F.lane < 16) {
#pragma unroll
            for (int grp = 0; grp < 2; ++grp) {
                const int row = rb + 32 * F.wave + 16 * grp + F.lane;
#pragma unroll
                for (int k = 0; k < TOPK; ++k) { const int e = my_e[grp][k], pos = baseL[e] + my_lp[grp][k];
                    list[(size_t)e * LCAP + pos] = (unsigned)row; tslot[(size_t)row * 4 + k] = ((unsigned)e << 20) | (unsigned)pos; tgate[(size_t)row * 4 + k] = my_g[grp][k]; }
            }
        }
        __syncthreads();
    }
}

__device__ __forceinline__ void moe_gather(Frame& F, int l) {
    relaunder(F);
    build_tiles(F, l);
    const LAS int* ts = (const LAS int*)(F.lds + TAB_OFF); const LAS int* cnt = ts + 40;
    const unsigned* list = (const unsigned*)(F.ws + WS_LIST); const bf16* H = (const bf16*)(F.ws + WS_H); bf16* Xg = (bf16*)(F.ws + WS_R1);
    const int gw = F.vcu * NWAVES + F.wave, NGW = F.G * NWAVES, NR = ts[NEXP] * 256;
    for (int r = gw; r < NR; r += NGW) {
        const int mt = r >> 8; int e = 0;
        for (int k = 1; k < NEXP; ++k) e += (ts[k] <= mt) ? 1 : 0;
        const int pos = r - ts[e] * 256;
        unsigned tok = 0u; if (pos < cnt[e]) tok = ldu_vec(list + (size_t)e * LCAP + pos);
        const v4u* src = (const v4u*)(H + (size_t)tok * DM); v4u* dst = (v4u*)(Xg + (size_t)r * DM);
        dst[F.lane] = src[F.lane]; dst[F.lane + 64] = src[F.lane + 64];
    }
}

using pg8::Unit;
__device__ __forceinline__ v4u pack8(const f32x4 a, const f32x4 b) { v4u w; w.x = pk2(a.x, a.y); w.y = pk2(a.z, a.w); w.z = pk2(b.x, b.y); w.w = pk2(b.z, b.w); return w; }

struct EpiHgrnIn {
    static constexpr bool PERM = true;
    unsigned char* r1; const float* lb;
    __device__ __forceinline__ void operator()(const f32x4 (&acc)[2][2][4][2], const Unit& u, int wr, int wc, int fr, int fq) const {
        const int seg = u.pn >> 2, row0 = u.pm * 256 + wr * 64 + fr, cs0 = (u.pn & 3) * 256 + wc * 32 + 8 * fq;
        if (seg == 1) {
            bf16* K = (bf16*)(r1 + 128 * MiB); float* LF = (float*)(r1 + 512 * MiB);
#pragma unroll
            for (int bj = 0; bj < 2; ++bj) {
                f32x4 lbv[2]; lbv[0] = *(const f32x4*)(lb + cs0 + bj * 128); lbv[1] = *(const f32x4*)(lb + cs0 + bj * 128 + 4);
#pragma unroll
                for (int ai = 0; ai < 2; ++ai)
#pragma unroll
                    for (int m = 0; m < 4; ++m) { const size_t ro = (size_t)(row0 + ai * 128 + m * 16) * DM + cs0 + bj * 128; f32x4 kk[2], lf[2];
#pragma unroll
                        for (int n = 0; n < 2; ++n)
#pragma unroll
                            for (int j = 0; j < 4; ++j) { const float f = fminf(fmaxf(acc[ai][bj][m][n][j], -60.f), 60.f), l0 = lbv[n][j], ef = __expf(f);
                                const float sg = ef * __builtin_amdgcn_rcpf(1.f + ef), sgm = __builtin_amdgcn_rcpf(1.f + ef);
                                lf[n][j] = __logf(l0 + (1.f - l0) * sg); kk[n][j] = (1.f - l0) * sgm; }
                        *(v4u*)(K + ro) = pack8(kk[0], kk[1]); *(f32x4*)(LF + ro) = lf[0]; *(f32x4*)(LF + ro + 4) = lf[1];
                        __builtin_amdgcn_sched_barrier(0); }
            }
        } else {
            bf16* dst = (bf16*)(r1 + (seg == 0 ? 0 : (seg == 2 ? 256 * MiB : 384 * MiB))); const bool act = (seg != 2);
#pragma unroll
            for (int ai = 0; ai < 2; ++ai)
#pragma unroll
                for (int m = 0; m < 4; ++m) { const size_t ro = (size_t)(row0 + ai * 128 + m * 16) * DM;
#pragma unroll
                    for (int bj = 0; bj < 2; ++bj) { f32x4 v0 = acc[ai][bj][m][0], v1 = acc[ai][bj][m][1];
                        if (act) {
#pragma unroll
                            for (int j = 0; j < 4; ++j) { v0[j] = siluf_(v0[j]); v1[j] = siluf_(v1[j]); } }
                        *(v4u*)(dst + ro + cs0 + bj * 128) = pack8(v0, v1); }
                    __builtin_amdgcn_sched_barrier(0); }
        }
    }
};

struct EpiRetIn {
    static constexpr bool PERM = true;
    unsigned char* r1; const int* positions;
    __device__ __forceinline__ void operator()(const f32x4 (&acc)[2][2][4][2], const Unit& u, int wr, int wc, int fr, int fq) const {
        const int row0 = u.pm * 256 + wr * 64 + fr, cl = wc * 32 + 8 * fq;
        if (u.pn < 8) {
            bf16* dst = (bf16*)(r1 + ((u.pn < 4) ? 0 : 128 * MiB)); const float sc = (u.pn < 4) ? 1.0f : 0.0625f; const int hh = u.pn & 3;
            float invrev[2][4];
#pragma unroll
            for (int n = 0; n < 2; ++n)
#pragma unroll
                for (int j = 0; j < 4; ++j) invrev[n][j] = exp2f(-(float)(cl + 4 * n + j) * 0.10462765653188542f) * 0.15915494309189535f;
#pragma unroll
            for (int ai = 0; ai < 2; ++ai)
#pragma unroll
                for (int m = 0; m < 4; ++m) { const int row = row0 + ai * 128 + m * 16; const float pos = (float)positions[row]; const size_t ro = (size_t)row * DM + hh * 256 + cl;
                    f32x4 o1[2], o2[2];
#pragma unroll
                    for (int n = 0; n < 2; ++n)
#pragma unroll
                        for (int j = 0; j < 4; ++j) { const float rev = pos * invrev[n][j], fr_ = rev - floorf(rev); const float cs = __builtin_amdgcn_cosf(fr_), sn = __builtin_amdgcn_sinf(fr_);
                            const float x1 = acc[ai][0][m][n][j], x2 = acc[ai][1][m][n][j]; o1[n][j] = (x1 * cs - x2 * sn) * sc; o2[n][j] = (x2 * cs + x1 * sn) * sc; }
                    *(v4u*)(dst + ro) = pack8(o1[0], o1[1]); *(v4u*)(dst + ro + 128) = pack8(o2[0], o2[1]); }
        } else {
            const bool isg = (u.pn >= 16); bf16* dst = (bf16*)(r1 + (isg ? 512 * MiB : 256 * MiB)); const int ct = (isg ? u.pn - 16 : u.pn - 8) * 256 + cl;
#pragma unroll
            for (int ai = 0; ai < 2; ++ai)
#pragma unroll
                for (int m = 0; m < 4; ++m) { const size_t ro = (size_t)(row0 + ai * 128 + m * 16) * 2048 + ct;
#pragma unroll
                    for (int bj = 0; bj < 2; ++bj) { f32x4 v0 = acc[ai][bj][m][0], v1 = acc[ai][bj][m][1];
                        if (isg) {
#pragma unroll
                            for (int j = 0; j < 4; ++j) { v0[j] = siluf_(v0[j]); v1[j] = siluf_(v1[j]); } }
                        *(v4u*)(dst + ro + bj * 128) = pack8(v0, v1); } }
        }
    }
};

struct EpiOut {
    static constexpr bool PERM = false;
    const float* xin; float* xout; const float* gate;
    __device__ __forceinline__ void operator()(const f32x4 (&acc)[2][2][4][2], const Unit& u, int wr, int wc, int fr, int fq) const {
        const int row0 = u.pm * 256 + wr * 64 + fr, col0 = u.pn * 256 + wc * 32 + 4 * fq, b = (u.pm * 256) / SEQ;
        f32x4 gv[2][2];
#pragma unroll
        for (int bj = 0; bj < 2; ++bj)
#pragma unroll
            for (int n = 0; n < 2; ++n) gv[bj][n] = *(const f32x4*)(gate + (size_t)b * 6 * DM + col0 + bj * 128 + n * 16);
#pragma unroll
        for (int ai = 0; ai < 2; ++ai)
#pragma unroll
            for (int mp = 0; mp < 2; ++mp) { f32x4 xi[2][2][2];
#pragma unroll
                for (int mm = 0; mm < 2; ++mm)
#pragma unroll
                    for (int bj = 0; bj < 2; ++bj)
#pragma unroll
                        for (int n = 0; n < 2; ++n) xi[mm][bj][n] = *(const f32x4*)(xin + (size_t)(row0 + ai * 128 + (2 * mp + mm) * 16) * DM + col0 + bj * 128 + n * 16);
#pragma unroll
                for (int mm = 0; mm < 2; ++mm)
#pragma unroll
                    for (int bj = 0; bj < 2; ++bj)
#pragma unroll
                        for (int n = 0; n < 2; ++n) *(f32x4*)(xout + (size_t)(row0 + ai * 128 + (2 * mp + mm) * 16) * DM + col0 + bj * 128 + n * 16) = xi[mm][bj][n] + gv[bj][n] * acc[ai][bj][2 * mp + mm][n];
                asm volatile("" ::: "memory"); }
    }
};

struct EpiMoe1 {
    static constexpr bool PERM = true;
    bf16* A2; const float* b1;
    __device__ __forceinline__ void operator()(const f32x4 (&acc)[2][2][4][2], const Unit& u, int wr, int wc, int fr, int fq) const {
        const int row0 = u.pm * 256 + wr * 64 + fr, gc = u.nn * 128 + wc * 32 + 8 * fq; const float* bp = b1 + (size_t)u.e * 2048;
        f32x4 bg[2], bl[2];
#pragma unroll
        for (int n = 0; n < 2; ++n) { bg[n] = *(const f32x4*)(bp + gc + 4 * n); bl[n] = *(const f32x4*)(bp + 1024 + gc + 4 * n); }
#pragma unroll
        for (int ai = 0; ai < 2; ++ai)
#pragma unroll
            for (int m = 0; m < 4; ++m) { f32x4 o[2];
#pragma unroll
                for (int n = 0; n < 2; ++n)
#pragma unroll
                    for (int j = 0; j < 4; ++j) { const float g = fminf(acc[ai][0][m][n][j] + bg[n][j], 7.0f), li = fminf(fmaxf(acc[ai][1][m][n][j] + bl[n][j], -7.0f), 7.0f);
                        o[n][j] = g * sigmoidf_(1.702f * g) * (li + 1.0f); }
                *(v4u*)(A2 + (size_t)(row0 + ai * 128 + m * 16) * DM + gc) = pack8(o[0], o[1]); }
    }
};

struct EpiMoe2 {
    static constexpr bool PERM = true;
    bf16* Y; const float* b2;
    __device__ __forceinline__ void operator()(const f32x4 (&acc)[2][2][4][2], const Unit& u, int wr, int wc, int fr, int fq) const {
        const int row0 = u.pm * 256 + wr * 64 + fr, c0 = u.nn * 256 + wc * 32 + 8 * fq; const float* bp = b2 + (size_t)u.e * DM;
        f32x4 bv[2][2];
#pragma unroll
        for (int bj = 0; bj < 2; ++bj)
#pragma unroll
            for (int n = 0; n < 2; ++n) bv[bj][n] = *(const f32x4*)(bp + c0 + bj * 128 + 4 * n);
#pragma unroll
        for (int ai = 0; ai < 2; ++ai)
#pragma unroll
            for (int m = 0; m < 4; ++m) { const size_t ro = (size_t)(row0 + ai * 128 + m * 16) * DM + c0;
#pragma unroll
                for (int bj = 0; bj < 2; ++bj) *(v4u*)(Y + ro + bj * 128) = pack8(acc[ai][bj][m][0] + bv[bj][0], acc[ai][bj][m][1] + bv[bj][1]); }
    }
};

__device__ __forceinline__ void hgrn_scan(Frame& F, int j) {
    relaunder(F);
    const bf16* Q = (const bf16*)(F.ws + WS_R1); const bf16* K = (const bf16*)(F.ws + WS_R1 + 128 * MiB); const bf16* V = (const bf16*)(F.ws + WS_R1 + 256 * MiB); const bf16* SG = (const bf16*)(F.ws + WS_R1 + 384 * MiB);
    const float* LF = (const float*)(F.ws + WS_R1 + 512 * MiB); bf16* O = (bf16*)(F.ws + WS_R2);
    LAS float* Qs = (LAS float*)(F.lds); LAS float* Ks = Qs + 4096; LAS float* Fs = Qs + 8192; LAS float* Vs = Qs + 12288; LAS float* P = Qs + 16384;
    const int v = F.tid & 127, kq = F.tid >> 7, t16 = F.tid >> 4, c8 = (F.tid & 15) * 8;
    f32x4 gain0 = *(const f32x4*)(KIN(I_HGAIN) + j * 128 + c8), gain1 = *(const f32x4*)(KIN(I_HGAIN) + j * 128 + c8 + 4);
    for (int u = F.vcu; u < NBATCH * HG_H; u += F.G) {
        const int b = u / HG_H, h = u % HG_H;
        float S[32];
#pragma unroll
        for (int i = 0; i < 32; ++i) S[i] = 0.f;
        for (int ch = 0; ch < SEQ / 32; ++ch) {
            const int row0 = b * SEQ + 32 * ch; const size_t gi = (size_t)(row0 + t16) * DM + h * 128 + c8;
            __syncthreads();
            { const v4u q = *(const v4u*)(Q + gi), k = *(const v4u*)(K + gi), vv = *(const v4u*)(V + gi); const f32x4 l0 = *(const f32x4*)(LF + gi), l1 = *(const f32x4*)(LF + gi + 4);
              LAS f32x4* d;
              d = (LAS f32x4*)(Qs + t16 * 128 + c8); d[0] = (f32x4){bflo(q.x), bfhi(q.x), bflo(q.y), bfhi(q.y)}; d[1] = (f32x4){bflo(q.z), bfhi(q.z), bflo(q.w), bfhi(q.w)};
              d = (LAS f32x4*)(Ks + t16 * 128 + c8); d[0] = (f32x4){bflo(k.x), bfhi(k.x), bflo(k.y), bfhi(k.y)}; d[1] = (f32x4){bflo(k.z), bfhi(k.z), bflo(k.w), bfhi(k.w)};
              d = (LAS f32x4*)(Vs + t16 * 128 + c8); d[0] = (f32x4){bflo(vv.x), bfhi(vv.x), bflo(vv.y), bfhi(vv.y)}; d[1] = (f32x4){bflo(vv.z), bfhi(vv.z), bflo(vv.w), bfhi(vv.w)};
              d = (LAS f32x4*)(Fs + t16 * 128 + c8); d[0] = (f32x4){__expf(l0.x), __expf(l0.y), __expf(l0.z), __expf(l0.w)}; d[1] = (f32x4){__expf(l1.x), __expf(l1.y), __expf(l1.z), __expf(l1.w)}; }
            __syncthreads();
            for (int t = 0; t < 32; ++t) {
                const float vt = Vs[t * 128 + v]; float a = 0.f;
#pragma unroll
                for (int i4 = 0; i4 < 8; ++i4) { const f32x4 f4 = *(const LAS f32x4*)(Fs + t * 128 + 32 * kq + 4 * i4), k4 = *(const LAS f32x4*)(Ks + t * 128 + 32 * kq + 4 * i4), q4 = *(const LAS f32x4*)(Qs + t * 128 + 32 * kq + 4 * i4);
#pragma unroll
                    for (int i = 0; i < 4; ++i) { S[4 * i4 + i] = f4[i] * S[4 * i4 + i] + k4[i] * vt; a += q4[i] * S[4 * i4 + i]; } }
                P[(t * 4 + kq) * 128 + v] = a;
            }
            __syncthreads();
            { f32x4 o0 = (f32x4){0.f, 0.f, 0.f, 0.f}, o1 = o0;
#pragma unroll
              for (int q = 0; q < 4; ++q) { o0 += *(const LAS f32x4*)(P + (t16 * 4 + q) * 128 + c8); o1 += *(const LAS f32x4*)(P + (t16 * 4 + q) * 128 + c8 + 4); }
              float ss = (o0.x * o0.x + o0.y * o0.y) + (o0.z * o0.z + o0.w * o0.w) + (o1.x * o1.x + o1.y * o1.y) + (o1.z * o1.z + o1.w * o1.w);
              ss += __shfl_xor(ss, 1); ss += __shfl_xor(ss, 2); ss += __shfl_xor(ss, 4); ss += __shfl_xor(ss, 8);
              const float r = 1.0f / sqrtf(ss * (1.0f / 128.f) + EPS);
              const v4u sg = *(const v4u*)(SG + gi);
              f32x4 a0 = o0 * r * gain0, a1 = o1 * r * gain1;
              a0.x *= bflo(sg.x); a0.y *= bfhi(sg.x); a0.z *= bflo(sg.y); a0.w *= bfhi(sg.y); a1.x *= bflo(sg.z); a1.y *= bfhi(sg.z); a1.z *= bflo(sg.w); a1.w *= bfhi(sg.w);
              *(v4u*)(O + gi) = pack8(a0, a1); }
        }
    }
}

__device__ __forceinline__ void ret_scan(Frame& F) {
    relaunder(F);
    const bf16* Q = (const bf16*)(F.ws + WS_R1); const bf16* K = (const bf16*)(F.ws + WS_R1 + 128 * MiB); const bf16* V = (const bf16*)(F.ws + WS_R1 + 256 * MiB); const bf16* SG = (const bf16*)(F.ws + WS_R1 + 512 * MiB);
    bf16* O = (bf16*)(F.ws + WS_R2);
    LAS bf16* Qs = (LAS bf16*)(F.lds); LAS bf16* Ks = (LAS bf16*)(F.lds + 33792); LAS bf16* Vs = (LAS bf16*)(F.lds + 67584);
    LAS float* St = (LAS float*)(F.lds + 133120); LAS float* wred = (LAS float*)(F.lds + 149504); LAS float* rtab = (LAS float*)(F.lds + 151552);
    for (int u = F.vcu; u < NBATCH * RT_H * 16; u += F.G) {
        const int bh = u >> 4, cp = u & 15, b = bh >> 2, h = bh & 3;
        const float lg2g = log2f(1.0f - exp2f(-5.0f - (float)h));
        for (int half = 0; half < 2; ++half) {
            const int c = half ? 31 - cp : cp; const int row0 = b * SEQ + 64 * c;
            __syncthreads();
#pragma unroll
            for (int i = 0; i < 4; ++i) { const int p = F.tid + 512 * i, r = p >> 5, cc = (p & 31) * 8; *(LAS v4u*)(Qs + r * 264 + cc) = *(const v4u*)(Q + (size_t)(row0 + r) * DM + h * 256 + cc); }
            float acc[64];
#pragma unroll
            for (int n = 0; n < 64; ++n) acc[n] = 0.f;
            for (int cq = 0; cq <= c; ++cq) {
                const int krow0 = b * SEQ + 64 * cq;
                __syncthreads();
#pragma unroll
                for (int i = 0; i < 4; ++i) { const int p = F.tid + 512 * i, r = p >> 5, cc = (p & 31) * 8; *(LAS v4u*)(Ks + r * 264 + cc) = *(const v4u*)(K + (size_t)(krow0 + r) * DM + h * 256 + cc); }
#pragma unroll
                for (int i = 0; i < 8; ++i) { const int p = F.tid + 512 * i, r = p >> 6, cc = (p & 63) * 8; *(LAS v4u*)(Vs + r * 512 + cc) = *(const v4u*)(V + (size_t)(krow0 + r) * 2048 + h * 512 + cc); }
                __syncthreads();
                { float s[8];
#pragma unroll
                  for (int j8 = 0; j8 < 8; ++j8) s[j8] = 0.f;
                  for (int dc = 0; dc < 32; ++dc) {
                      const v4u kv = *(const LAS v4u*)(Ks + F.lane * 264 + dc * 8);
                      const float k0 = bflo(kv.x), k1 = bfhi(kv.x), k2 = bflo(kv.y), k3 = bfhi(kv.y), k4 = bflo(kv.z), k5 = bfhi(kv.z), k6 = bflo(kv.w), k7 = bfhi(kv.w);
#pragma unroll
                      for (int j8 = 0; j8 < 8; ++j8) { const v4u qv = *(const LAS v4u*)(Qs + (8 * F.wave + j8) * 264 + dc * 8);
                          s[j8] += (bflo(qv.x) * k0 + bfhi(qv.x) * k1) + (bflo(qv.y) * k2 + bfhi(qv.y) * k3) + (bflo(qv.z) * k4 + bfhi(qv.z) * k5) + (bflo(qv.w) * k6 + bfhi(qv.w) * k7); }
                  }
                  f32x4 w0, w1;
#pragma unroll
                  for (int j8 = 0; j8 < 8; ++j8) { const float dist = fabsf((float)((64 * c + 8 * F.wave + j8) - (64 * cq + F.lane))); const float val = s[j8] * exp2f(dist * lg2g); if (j8 < 4) w0[j8] = val; else w1[j8 - 4] = val; }
                  *(LAS f32x4*)(St + F.lane * 64 + 8 * F.wave) = w0; *(LAS f32x4*)(St + F.lane * 64 + 8 * F.wave + 4) = w1; }
                __syncthreads();
                for (int m2 = 0; m2 < 64; ++m2) {
                    const float vv = bf2f(Vs[m2 * 512 + F.tid]);
#pragma unroll
                    for (int n4 = 0; n4 < 16; ++n4) { const f32x4 sv = *(const LAS f32x4*)(St + m2 * 64 + 4 * n4); acc[4 * n4 + 0] += sv.x * vv; acc[4 * n4 + 1] += sv.y * vv; acc[4 * n4 + 2] += sv.z * vv; acc[4 * n4 + 3] += sv.w * vv; }
                }
            }
#pragma unroll
            for (int n = 0; n < 64; ++n) { const float p = wave_sum(acc[n] * acc[n]); if (F.lane == 0) wred[F.wave * 64 + n] = p; }
            __syncthreads();
            if (F.tid < 64) { float s = 0.f;
#pragma unroll
                for (int w = 0; w < 8; ++w) s += wred[w * 64 + F.tid];
                rtab[F.tid] = 1.0f / sqrtf(s * (1.0f / 512.f) + EPS); }
            __syncthreads();
#pragma unroll
            for (int n = 0; n < 64; ++n) { const size_t gi = (size_t)(row0 + n) * 2048 + h * 512 + F.tid; const float sg = bf2f(SG[gi]); O[gi] = (bf16)(pk2(acc[n] * rtab[n] * sg, 0.f) & 0xffffu); }
        }
    }
}

typedef short s16x4 __attribute__((ext_vector_type(4)));
__device__ __forceinline__ unsigned off_b(unsigned row, unsigned ch) { return 256u * row + 16u * (ch ^ (((row & 3u) << 2) | ((row >> 2) & 3u))); }
__device__ __forceinline__ bf16x8 row_frag(const LAS unsigned char* tile, unsigned row, unsigned s4, unsigned g) { return *(const LAS bf16x8*)(tile + off_b(row, 4u * s4 + g)); }
__device__ __forceinline__ bf16x8 tr_frag16(const LAS unsigned char* tile, unsigned lane, unsigned c, unsigned ks) {
    const unsigned g = lane >> 4, q = (lane & 15u) >> 2, p = lane & 3u;
    const unsigned a0 = off_b(32u * ks + 8u * g + q, 2u * c + (p >> 1)) + 8u * (p & 1u), a1 = off_b(32u * ks + 8u * g + 4u + q, 2u * c + (p >> 1)) + 8u * (p & 1u);
    const s16x4 lo = __builtin_amdgcn_ds_read_tr16_b64_v4i16((LAS s16x4*)(tile + a0)), hi = __builtin_amdgcn_ds_read_tr16_b64_v4i16((LAS s16x4*)(tile + a1));
    return (bf16x8){lo[0], lo[1], lo[2], lo[3], hi[0], hi[1], hi[2], hi[3]};
}
__device__ __forceinline__ void ret_scan_mfma(Frame& F) {
    relaunder(F);
    const bf16* Q = (const bf16*)(F.ws + WS_R1); const bf16* K = (const bf16*)(F.ws + WS_R1 + 128 * MiB); const bf16* V = (const bf16*)(F.ws + WS_R1 + 256 * MiB);
    bf16* O = (bf16*)(F.ws + WS_R2); float* SS = (float*)(F.ws + WS_R2 + 256 * MiB);
    LAS unsigned char* Qi = F.lds; LAS unsigned char* Ki = F.lds + 32768; LAS unsigned char* Vi = F.lds + 65536; LAS unsigned char* Si = F.lds + 81920;
    const unsigned w = (unsigned)F.wave;
    for (int u = F.vcu; u < NBATCH * RT_H * 4; u += F.G) {
        const int bh = u >> 2, vs = u & 3, b = bh >> 2, h = bh & 3;
        const float lg2g = log2f(1.0f - exp2f(-5.0f - (float)h)), cd = exp2f(64.0f * lg2g);
        f32x4 R[16];
#pragma unroll
        for (int i = 0; i < 16; ++i) R[i] = (f32x4){0.f, 0.f, 0.f, 0.f};
        v4u pq[4], pk[4], pv[2];
        { const int row0 = b * SEQ;
#pragma unroll
          for (int i = 0; i < 4; ++i) { const int p = F.tid + 512 * i, r = p >> 5, c32 = p & 31; pq[i] = *(const v4u*)(Q + (size_t)(row0 + r) * DM + h * 256 + c32 * 8); pk[i] = *(const v4u*)(K + (size_t)(row0 + r) * DM + h * 256 + c32 * 8); }
#pragma unroll
          for (int i = 0; i < 2; ++i) { const int p = F.tid + 512 * i, r = p >> 4, c16 = p & 15; pv[i] = *(const v4u*)(V + (size_t)(row0 + r) * 2048 + h * 512 + vs * 128 + c16 * 8); } }
        for (int c = 0; c < SEQ / 64; ++c) {
            const int row0 = b * SEQ + 64 * c;
            unsigned lane = (unsigned)F.lane; asm volatile("" : "+v"(lane));
            const unsigned g = lane >> 4, li = lane & 15u;
            __syncthreads();
#pragma unroll
            for (int i = 0; i < 4; ++i) { const unsigned p = (unsigned)F.tid + 512u * i, r = p >> 5, c32 = p & 31u; const unsigned o = (c32 >> 4) * 16384u + off_b(r, c32 & 15u); *(LAS v4u*)(Qi + o) = pq[i]; *(LAS v4u*)(Ki + o) = pk[i]; }
#pragma unroll
            for (int i = 0; i < 2; ++i) { const unsigned p = (unsigned)F.tid + 512u * i, r = p >> 4, c16 = p & 15u; *(LAS v4u*)(Vi + off_b(r, c16)) = pv[i]; }
            __syncthreads();
            if (c + 1 < SEQ / 64) { const int rn = row0 + 64;
#pragma unroll
                for (int i = 0; i < 4; ++i) { const int p = F.tid + 512 * i, r = p >> 5, c32 = p & 31; pq[i] = *(const v4u*)(Q + (size_t)(rn + r) * DM + h * 256 + c32 * 8); pk[i] = *(const v4u*)(K + (size_t)(rn + r) * DM + h * 256 + c32 * 8); }
#pragma unroll
                for (int i = 0; i < 2; ++i) { const int p = F.tid + 512 * i, r = p >> 4, c16 = p & 15; pv[i] = *(const v4u*)(V + (size_t)(rn + r) * 2048 + h * 512 + vs * 128 + c16 * 8); } }
            { const unsigned mt = w >> 1;
#pragma unroll
              for (int t2 = 0; t2 < 2; ++t2) { const unsigned nt = 2u * (w & 1u) + t2; f32x4 sa = (f32x4){0.f, 0.f, 0.f, 0.f};
#pragma unroll
                  for (int s8 = 0; s8 < 8; ++s8) { const bf16x8 a = row_frag(Qi + (s8 >> 2) * 16384, 16u * mt + li, s8 & 3, g), bb = row_frag(Ki + (s8 >> 2) * 16384, 16u * nt + li, s8 & 3, g);
                      sa = __builtin_amdgcn_mfma_f32_16x16x32_bf16(a, bb, sa, 0, 0, 0); }
#pragma unroll
                  for (int q = 0; q < 4; ++q) { const int n = (int)(16u * mt + 4u * g) + q, m = (int)(16u * nt + li); const float val = sa[q] * exp2f(fabsf((float)(n - m)) * lg2g);
                      *(LAS unsigned short*)(Si + (unsigned)n * 144u + 2u * (unsigned)m) = (unsigned short)(pk2(val, 0.f) & 0xffffu); } } }
            f32x4 Oa[4];
#pragma unroll
            for (int mt = 0; mt < 4; ++mt) Oa[mt] = (f32x4){0.f, 0.f, 0.f, 0.f};
#pragma unroll
            for (int s8 = 0; s8 < 8; ++s8) {
                const v4u rt = (v4u){pk2(R[2 * s8][0], R[2 * s8][1]), pk2(R[2 * s8][2], R[2 * s8][3]), pk2(R[2 * s8 + 1][0], R[2 * s8 + 1][1]), pk2(R[2 * s8 + 1][2], R[2 * s8 + 1][3])}; const bf16x8 Rb = __builtin_bit_cast(bf16x8, rt);
                const LAS unsigned char* qt = Qi + (s8 >> 2) * 16384; const unsigned s4 = s8 & 3;
#pragma unroll
                for (int mt = 0; mt < 4; ++mt) { const unsigned n = 16u * mt + li;
                    const v2u lo = *(const LAS v2u*)(qt + off_b(n, 4u * s4 + (g >> 1)) + 8u * (g & 1u)), hi = *(const LAS v2u*)(qt + off_b(n, 4u * s4 + 2u + (g >> 1)) + 8u * (g & 1u));
                    const v4u av = (v4u){lo.x, lo.y, hi.x, hi.y};
                    Oa[mt] = __builtin_amdgcn_mfma_f32_16x16x32_bf16(__builtin_bit_cast(bf16x8, av), Rb, Oa[mt], 0, 0, 0); }
                if (s8 & 1) __builtin_amdgcn_sched_barrier(0); }
#pragma unroll
            for (int mt = 0; mt < 4; ++mt)
#pragma unroll
                for (int q = 0; q < 4; ++q) Oa[mt][q] *= exp2f((float)(16 * mt + 4 * (int)g + q + 1) * lg2g);
            __syncthreads();
            bf16x8 Vf[2];
#pragma unroll
            for (int ks = 0; ks < 2; ++ks) Vf[ks] = tr_frag16(Vi, lane, w, ks);
#pragma unroll
            for (int mt = 0; mt < 4; ++mt)
#pragma unroll
                for (int ks = 0; ks < 2; ++ks) { const bf16x8 a = *(const LAS bf16x8*)(Si + (16u * mt + li) * 144u + 64u * ks + 16u * g); Oa[mt] = __builtin_amdgcn_mfma_f32_16x16x32_bf16(a, Vf[ks], Oa[mt], 0, 0, 0); }
            bf16x8 Vd[2];
#pragma unroll
            for (int ks = 0; ks < 2; ++ks) { const v4u vv = __builtin_bit_cast(v4u, Vf[ks]); float f[8];
#pragma unroll
                for (int j = 0; j < 8; ++j) f[j] = exp2f((float)(63 - (32 * ks + 8 * (int)g + j)) * lg2g);
                const v4u sv = (v4u){pk2(bflo(vv.x) * f[0], bfhi(vv.x) * f[1]), pk2(bflo(vv.y) * f[2], bfhi(vv.y) * f[3]), pk2(bflo(vv.z) * f[4], bfhi(vv.z) * f[5]), pk2(bflo(vv.w) * f[6], bfhi(vv.w) * f[7])};
                Vd[ks] = __builtin_bit_cast(bf16x8, sv); }
#pragma unroll
            for (int dt = 0; dt < 16; ++dt) { R[dt] = R[dt] * cd;
#pragma unroll
                for (int ks = 0; ks < 2; ++ks) { const bf16x8 a = tr_frag16(Ki + (dt >> 3) * 16384, lane, dt & 7, ks); R[dt] = __builtin_amdgcn_mfma_f32_16x16x32_bf16(a, Vd[ks], R[dt], 0, 0, 0); }
                if (dt & 1) __builtin_amdgcn_sched_barrier(0); }
#pragma unroll
            for (int mt = 0; mt < 4; ++mt)
#pragma unroll
                for (int q = 0; q < 4; ++q) { const int row = row0 + 16 * mt + 4 * (int)g + q; const float ov = Oa[mt][q];
                    O[(size_t)row * 2048 + h * 512 + vs * 128 + 16 * w + li] = (bf16)(pk2(ov, 0.f) & 0xffffu);
                    float ssq = ov * ov; ssq += __shfl_xor(ssq, 1); ssq += __shfl_xor(ssq, 2); ssq += __shfl_xor(ssq, 4); ssq += __shfl_xor(ssq, 8);
                    if (li == 0) SS[((size_t)row * 4 + h) * 32 + vs * 8 + w] = ssq; }
        }
    }
}
__device__ __forceinline__ void ret_norm(Frame& F) {
    relaunder(F);
    bf16* O = (bf16*)(F.ws + WS_R2); const float* SS = (const float*)(F.ws + WS_R2 + 256 * MiB); const bf16* SG = (const bf16*)(F.ws + WS_R1 + 512 * MiB);
    const int gw = F.vcu * NWAVES + F.wave, NGW = F.G * NWAVES;
    for (int row = gw; row < MTOK; row += NGW) {
        float r[4];
#pragma unroll
        for (int h = 0; h < 4; ++h) { const float p = (F.lane < 32) ? SS[((size_t)row * 4 + h) * 32 + F.lane] : 0.f; r[h] = 1.0f / sqrtf(wave_sum(p) * (1.0f / 512.f) + EPS); }
#pragma unroll
        for (int j = 0; j < 4; ++j) { const size_t gi = (size_t)row * 2048 + 512 * j + 8 * F.lane; const v4u o = *(const v4u*)(O + gi), sg = *(const v4u*)(SG + gi); const float rr = r[j];
            v4u w; w.x = pk2(bflo(o.x) * rr * bflo(sg.x), bfhi(o.x) * rr * bfhi(sg.x)); w.y = pk2(bflo(o.y) * rr * bflo(sg.y), bfhi(o.y) * rr * bfhi(sg.y));
            w.z = pk2(bflo(o.z) * rr * bflo(sg.z), bfhi(o.z) * rr * bfhi(sg.z)); w.w = pk2(bflo(o.w) * rr * bflo(sg.w), bfhi(o.w) * rr * bfhi(sg.w));
            *(v4u*)(O + gi) = w; }
    }
}

struct Args { const void* in[22]; float* out; unsigned char* ws; int ph_lo, ph_hi; };
constexpr int PH_PER_LAYER = 9, NPHASES = 1 + DEPTH * PH_PER_LAYER + 1;

__global__ void __launch_bounds__(NWAVES * 64, 2) hybrid_fwd(Args args) {
    extern __shared__ __attribute__((aligned(16))) unsigned char lds[];
    Frame F;
    F.lds = (LAS unsigned char*)lds;
    F.tid = threadIdx.x; F.lane = F.tid & 63; F.wave = __builtin_amdgcn_readfirstlane(F.tid >> 6);
    F.G = gridDim.x; { const int bx = blockIdx.x; F.vcu = (F.G % 8 == 0) ? (bx % 8) * (F.G / 8) + bx / 8 : bx; }
    F.ws = args.ws; F.out = args.out; F.ctl = (unsigned*)(args.ws + WS_CTL);
    for (int u = F.tid; u < (LDS_BYTES - MISC_OFF) / 4; u += NWAVES * 64) ((LAS unsigned*)(F.lds + MISC_OFF))[u] = 0u;
    __syncthreads();
    const int lo = args.ph_lo, hi = args.ph_hi;
    XcdBarrier bar; bar.bar = F.ctl + CW_BAR; bar.x = 0; bar.st = nullptr;
    if (hi - lo > 1) bar = xcd_barrier_post(F.ctl + CW_BAR, (volatile LAS unsigned*)(F.lds + MISC_OFF) + 8);
#define IN(k) (lo <= (k) && (k) < hi)
#define SEAM(k) do { if (IN(k) && hi > (k) + 1) xcd_barrier(bar); } while (0)

    if (PH_EN(0) && IN(0)) { p0_prologue(F); } SEAM(0);

#pragma unroll 1
    for (int l = 0; l < DEPTH; ++l) {
        const int pb = 1 + l * PH_PER_LAYER, j = l >> 1; const bool is_ret = (l & 1);
        if (PH_EN(1) && IN(pb + 0)) row_phase1(F, l, 0);
        SEAM(pb + 0);
        if (IN(pb + 1)) {
            if (PH_EN(2) && !is_ret) {
                pg8::Gemm g{(const bf16*)(F.ws + WS_H), (const bf16*)(F.ws + WS_HWIN) + (size_t)j * HG_N * DM, MTOK, HG_N, DM}; pg8::StaticOrder S; S.init(MTOK, HG_N, F.G, (int)blockIdx.x);
                EpiHgrnIn E{F.ws + WS_R1, (const float*)(F.ws + WS_LBV) + j * DM};
                pg8::gemm_phase<EpiHgrnIn, pg8::StaticOrder, true, true>(F.lds + RING_OFF, g, S, E);
            } else if (PH_EN(3)) {
                pg8::Gemm g{(const bf16*)(F.ws + WS_H), (const bf16*)(F.ws + WS_RWIN) + (size_t)j * RT_N * DM, MTOK, RT_N, DM}; pg8::StaticOrder S; S.init(MTOK, RT_N, F.G, (int)blockIdx.x);
                EpiRetIn E{F.ws + WS_R1, (const int*)kin_(I_POS)};
                pg8::gemm_phase<EpiRetIn, pg8::StaticOrder, true, true>(F.lds + RING_OFF, g, S, E);
            }
        }
        SEAM(pb + 1);
        if (IN(pb + 2)) { if (!is_ret) { if (PH_EN(4)) hgrn_scan(F, j); } else { if (PH_EN(5)) { if (RET_MFMA) ret_scan_mfma(F); else ret_scan(F); } } }
        SEAM(pb + 2);
        if (RET_MFMA && PH_EN(12) && IN(pb + 3) && is_ret) ret_norm(F);
        if (RET_MFMA && is_ret) SEAM(pb + 3);
        if (PH_EN(6) && IN(pb + 4)) {
            const int Ko = is_ret ? 2048 : DM;
            const bf16* Wt = is_ret ? (const bf16*)(F.ws + WS_RWOUT) + (size_t)j * DM * 2048 : (const bf16*)(F.ws + WS_HWOUT) + (size_t)j * DM * DM;
            pg8::Gemm g{(const bf16*)(F.ws + WS_R2), Wt, MTOK, DM, Ko}; pg8::StaticOrder S; S.init(MTOK, DM, F.G, (int)blockIdx.x);
            EpiOut E{l == 0 ? KIN(I_X) : F.out, F.out, (const float*)(F.ws + WS_MOD) + (size_t)l * NBATCH * 6 * DM + 2 * DM};
            pg8::gemm_phase<EpiOut, pg8::StaticOrder, true, true>(F.lds + RING_OFF, g, S, E);
        }
        SEAM(pb + 4);
        if (PH_EN(7) && IN(pb + 5)) row_phase2(F, l);
        SEAM(pb + 5);
        if (PH_EN(8) && IN(pb + 6)) moe_gather(F, l);
        SEAM(pb + 6);
        if (PH_EN(9) && IN(pb + 7)) {
            build_tiles(F, l);
            pg8::Gemm g{(const bf16*)(F.ws + WS_R1), (const bf16*)(F.ws + WS_W1T) + (size_t)l * NEXP * 2048 * DM, 0, 0, DM};
            pg8::MoeOrder S{8, F.G, F.vcu, (const LAS int*)(F.lds + TAB_OFF)};
            EpiMoe1 E{(bf16*)(F.ws + WS_R2), KIN(I_B1) + (size_t)l * NEXP * 2048};
            pg8::gemm_phase<EpiMoe1, pg8::MoeOrder, true, true>(F.lds + RING_OFF, g, S, E);
        }
        SEAM(pb + 7);
        if (PH_EN(10) && IN(pb + 8)) {
            build_tiles(F, l);
            pg8::Gemm g{(const bf16*)(F.ws + WS_R2), (const bf16*)(F.ws + WS_W2T) + (size_t)l * NEXP * DM * DM, 0, 0, DM};
            pg8::MoeOrder S{4, F.G, F.vcu, (const LAS int*)(F.lds + TAB_OFF)};
            EpiMoe2 E{(bf16*)(F.ws + WS_R1), KIN(I_B2) + (size_t)l * NEXP * DM};
            pg8::gemm_phase<EpiMoe2, pg8::MoeOrder, true, true>(F.lds + RING_OFF, g, S, E);
        }
        SEAM(pb + 8);
    }
    if (PH_EN(11) && IN(NPHASES - 1)) row_phase1(F, DEPTH, 1);
#undef IN
#undef SEAM
}

extern "C" void kernel_launch(void* const* d_in, const int* in_sizes, int n_in, void* d_out, int out_size, void* d_ws, size_t ws_size, hipStream_t stream) {
    static int grid = 0;
    if (grid == 0) {
        if (n_in != 22 || in_sizes[0] != MTOK * DM || out_size != MTOK * DM || ws_size < WS_END) { fprintf(stderr, "kernel_launch: unexpected shapes (n_in %d, in0 %d, out %d, ws %zu < %zu)\n", n_in, n_in > 0 ? in_sizes[0] : -1, out_size, ws_size, (size_t)WS_END); grid = -1; return; }
        int dev = 0, cus = 0, per_cu = 0;
        if (hipGetDevice(&dev) != hipSuccess || hipDeviceGetAttribute(&cus, hipDeviceAttributeMultiprocessorCount, dev) != hipSuccess) { grid = -1; return; }
        if (hipFuncSetAttribute((const void*)hybrid_fwd, hipFuncAttributeMaxDynamicSharedMemorySize, LDS_BYTES) != hipSuccess) { fprintf(stderr, "kernel_launch: hipFuncSetAttribute failed\n"); grid = -1; return; }
        if (hipOccupancyMaxActiveBlocksPerMultiprocessor(&per_cu, (const void*)hybrid_fwd, NWAVES * 64, LDS_BYTES) != hipSuccess || per_cu < 1) { fprintf(stderr, "kernel_launch: occupancy query says %d blocks per CU\n", per_cu); }
        (void)hipGetLastError();
        grid = cus;
    }
    if (grid < 0) return;
    (void)hipMemsetAsync((char*)d_ws + WS_CTL, 0, CTL_ZERO_BYTES, stream);
    Args a{};
    for (int i = 0; i < 22; ++i) a.in[i] = d_in[i];
    a.out = (float*)d_out; a.ws = (unsigned char*)d_ws;
#if MK_SPLIT
    for (int p = 0; p < DBG_LIMIT; ++p) {
        if (p >= 1 && p < NPHASES - 1 && ((p - 1) % PH_PER_LAYER) == 3 && (!RET_MFMA || (((p - 1) / PH_PER_LAYER) & 1) == 0)) continue;
        a.ph_lo = p; a.ph_hi = p + 1;
        hipLaunchKernelGGL(hybrid_fwd, dim3(grid), dim3(NWAVES * 64), LDS_BYTES, stream, a);
    }
#else
    a.ph_lo = 0; a.ph_hi = NPHASES;
    hipLaunchKernelGGL(hybrid_fwd, dim3(grid), dim3(NWAVES * 64), LDS_BYTES, stream, a);
#endif
    const hipError_t le = hipPeekAtLastError();
    if (le != hipSuccess) fprintf(stderr, "kernel_launch: launch failed: %s\n", hipGetErrorName(le));
}
```

```cpp
#include <hip/hip_runtime.h>
#include <cstdio>
#include <cstdint>

#ifndef ONLY_PH
#define ONLY_PH -1
#endif
#define PH_EN(n) (ONLY_PH < 0 || ONLY_PH == (n))
#ifndef DBG_LIMIT
#define DBG_LIMIT NPHASES
#endif
#ifndef RET_MFMA
#define RET_MFMA 1
#endif
#ifndef HGRN_MFMA
#define HGRN_MFMA 1
#endif
#ifndef MK_SPLIT
#define MK_SPLIT 0
#endif

namespace pg8 {
#define PG8_LAS __attribute__((address_space(3)))
typedef unsigned short bf16_t;
typedef short bf16x8 __attribute__((ext_vector_type(8)));
typedef float f32x4 __attribute__((ext_vector_type(4)));
typedef unsigned u32x4 __attribute__((ext_vector_type(4)));
constexpr int BM = 256, BK = 64, HALF = 128, HTB = HALF * BK * 2  , STAGE_BYTES = 8 * HTB, NXCD = 8, WGM = 8;

__host__ __device__ __forceinline__ int lds_byte(int r, int c) { const int st = (r >> 4) * 2 + (c >> 5), rr = r & 15, cc = c & 31, ob = rr * 64 + cc * 2; return st * 1024 + (ob ^ (((ob >> 9) & 1) << 5)); }
__host__ __device__ __forceinline__ void stage_rc(int b, int& R, int& C) { const int st = b / 1024, sb = b % 1024, swz = sb ^ (((sb >> 9) & 1) << 5); R = (st >> 1) * 16 + swz / 64; C = (st & 1) * 32 + (swz % 64) / 2; }
__host__ __device__ __forceinline__ int perm32(int rho) { const int n = rho >> 4, i = rho & 15; return 8 * (i >> 2) + 4 * n + (i & 3); }

struct Unit { int pm, pn, e, nn; };
struct Gemm { const bf16_t* A; const bf16_t* Bt; int M, N, K; };

struct StaticOrder {
    int nM, nN, nwg, G, c;
    __host__ __device__ void init(int M, int N, int G_, int c_) { nM = M / BM; nN = N / BM; nwg = nM * nN; G = G_; c = c_; }
    __host__ __device__ bool next(int i, Unit& u) const {
        const long L = (long)i * G + c; if (L >= nwg) return false;
        int wgid = (int)L; { const int q = nwg / NXCD, r = nwg % NXCD, xcd = wgid % NXCD, off = wgid / NXCD; wgid = (xcd < r ? xcd * (q + 1) : r * (q + 1) + (xcd - r) * q) + off; }
        const int nig = WGM * nN, gid = wgid / nig, fm = gid * WGM, gsz = (nM - fm) < WGM ? (nM - fm) : WGM;
        u.pm = fm + ((wgid % nig) % gsz); u.pn = (wgid % nig) / gsz; u.e = 0; u.nn = u.pn; return true;
    }
    __device__ __forceinline__ void a_ready(const Unit&) const {}
    __device__ __forceinline__ void done(const Unit&) const {}
};
struct MoeOrder {
    int nN, G, c; const PG8_LAS int* ts;
    __device__ __forceinline__ bool next(int i, Unit& u) const {
        const int NT = ts[32]; const long L = (long)i * G + c; if (L >= (long)NT * nN) return false;
        const int mt = (int)(L / nN), n = (int)(L % nN); int e = 0;
        for (int k = 1; k < 32; ++k) e += (ts[k] <= mt) ? 1 : 0;
        u.pm = mt; u.pn = e * nN + n; u.e = e; u.nn = n; return true;
    }
    __device__ __forceinline__ void a_ready(const Unit&) const {}
    __device__ __forceinline__ void done(const Unit&) const {}
};

__device__ __forceinline__ unsigned cvt_pk_bf16(float lo, float hi) { unsigned r; asm volatile("v_cvt_pk_bf16_f32 %0, %1, %2" : "=v"(r) : "v"(lo), "v"(hi)); return r; }

template <class Epi, class Sched, bool ALIGN_EPI = false, bool SP2 = false>
__device__ __forceinline__ void gemm_phase(PG8_LAS unsigned char* lds, const Gemm g, const Sched& S, const Epi& E) {
    int tid_ = threadIdx.x; asm volatile("" : "+v"(tid_));
    const int tid = tid_, wid = __builtin_amdgcn_readfirstlane(tid >> 6), lane = tid & 63, wr = wid >> 2, wc = wid & 3, fr = lane & 15, fq = lane >> 4;
    const int K = g.K, nt = K / BK;
    unsigned voffA[2], voffB[2];
#pragma unroll
    for (int i = 0; i < 2; ++i) { int R, C; stage_rc(tid * 16 + i * 8192, R, C); const int Rb = Epi::PERM ? ((R & ~31) + perm32(R & 31)) : R;
        voffA[i] = (unsigned)(R * K + C) * 2u; voffB[i] = (unsigned)(Rb * K + C) * 2u; }
    const size_t kstep = (size_t)(BK * 2);
    const size_t hstep = (size_t)HALF * K * 2;
    const size_t tstep = 2 * hstep;
    const unsigned ldsw = (unsigned)wid * 1024u;
    const int aoff = lds_byte(wr * 64 + fr, fq * 8), boff = lds_byte(wc * 32 + fr, fq * 8);
#define PG8_SA(b, h) (((b) * 2 + (h)) * HTB)
#define PG8_SB(b, h) ((4 + (b) * 2 + (h)) * HTB)
#define PG8_STAGE(bufoff, gbase, voff) do { _Pragma("unroll") for (int _i = 0; _i < 2; ++_i) \
        __builtin_amdgcn_global_load_lds((const unsigned*)((const char*)(gbase) + (voff)[_i]), (PG8_LAS unsigned*)(lds + (bufoff) + ldsw + _i * 8192), 16, 0, 0); } while (0)
#define PG8_LDA(dst, b, h) do { _Pragma("unroll") for (int m = 0; m < 4; ++m) _Pragma("unroll") for (int k = 0; k < 2; ++k) dst[m][k] = *(const PG8_LAS bf16x8*)(lds + PG8_SA(b, h) + aoff + m * 2048 + k * 1024); } while (0)
#define PG8_LDB(dst, b, h) do { _Pragma("unroll") for (int n = 0; n < 2; ++n) _Pragma("unroll") for (int k = 0; k < 2; ++k) dst[n][k] = *(const PG8_LAS bf16x8*)(lds + PG8_SB(b, h) + boff + n * 2048 + k * 1024); } while (0)
#define PG8_MMA(ai, bj, At, Bt) do { __builtin_amdgcn_s_setprio(1); _Pragma("unroll") for (int m = 0; m < 4; ++m) _Pragma("unroll") for (int n = 0; n < 2; ++n) _Pragma("unroll") for (int k = 0; k < 2; ++k) \
        acc[ai][bj][m][n] = __builtin_amdgcn_mfma_f32_16x16x32_bf16(Bt[n][k], At[m][k], acc[ai][bj][m][n], 0, 0, 0); __builtin_amdgcn_s_setprio(0); } while (0)
#define PG8_WAIT_V(n) asm volatile("s_waitcnt vmcnt(" #n ")" ::: "memory")
#define PG8_WAIT_L(n) asm volatile("s_waitcnt lgkmcnt(" #n ")" ::: "memory")
#define PG8_BAR __builtin_amdgcn_s_barrier()
#define PG8_SCHED __builtin_amdgcn_sched_barrier(0)
    Unit cur, nxt; int ui = 0;
    if (!S.next(0, cur)) return;
    f32x4 acc[2][2][4][2];
#pragma unroll
    for (int a = 0; a < 2; ++a)
#pragma unroll
        for (int b = 0; b < 2; ++b)
#pragma unroll
            for (int m = 0; m < 4; ++m)
#pragma unroll
                for (int n = 0; n < 2; ++n) acc[a][b][m][n] = (f32x4){0.f, 0.f, 0.f, 0.f};
    bf16x8 At[4][2], B0[2][2], B1[2][2];
    const char* cA = (const char*)g.A + (size_t)cur.pm * tstep; const char* cB = (const char*)g.Bt + (size_t)cur.pn * tstep;
    S.a_ready(cur);
    if constexpr (SP2) {
        PG8_STAGE(PG8_SB(0, 0), cB, voffB); PG8_STAGE(PG8_SB(0, 1), cB + hstep, voffB); PG8_STAGE(PG8_SA(0, 0), cA, voffA); PG8_STAGE(PG8_SA(0, 1), cA + hstep, voffA);
        if (wr == 1) PG8_BAR;
        PG8_WAIT_V(2); PG8_BAR;
        PG8_STAGE(PG8_SB(1, 0), cB + kstep, voffB); PG8_STAGE(PG8_SA(1, 0), cA + kstep, voffA); PG8_STAGE(PG8_SB(1, 1), cB + hstep + kstep, voffB);
        PG8_WAIT_V(6); PG8_BAR;
    } else {
        PG8_STAGE(PG8_SB(0, 0), cB, voffB); PG8_STAGE(PG8_SA(0, 0), cA, voffA); PG8_STAGE(PG8_SB(0, 1), cB + hstep, voffB); PG8_STAGE(PG8_SA(0, 1), cA + hstep, voffA);
        if (wr == 1) PG8_BAR;
        PG8_WAIT_V(4); PG8_BAR;
        PG8_STAGE(PG8_SB(1, 0), cB + kstep, voffB); PG8_STAGE(PG8_SA(1, 0), cA + kstep, voffA); PG8_STAGE(PG8_SB(1, 1), cB + hstep + kstep, voffB);
        PG8_WAIT_V(6); PG8_BAR;
    }
    for (;;) {
        const bool has_next = S.next(ui + 1, nxt);
        const char* nA = has_next ? (const char*)g.A + (size_t)nxt.pm * tstep : cA; const char* nB = has_next ? (const char*)g.Bt + (size_t)nxt.pn * tstep : cB;
        for (int t = 0; t < nt; t += 2) {
            const bool last = (t == nt - 2);
            const char* a1 = cA + (size_t)(t + 1) * kstep;
            const char* a2 = last ? nA : cA + (size_t)(t + 2) * kstep; const char* b2 = last ? nB : cB + (size_t)(t + 2) * kstep;
            const char* a3 = a2 + kstep; const char* b3 = b2 + kstep;
            if (last && has_next) S.a_ready(nxt);
            if constexpr (SP2) {
            PG8_LDB(B0, 0, 0); PG8_LDB(B1, 0, 1); PG8_SCHED; PG8_LDA(At, 0, 0); PG8_STAGE(PG8_SA(1, 1), a1 + hstep, voffA);
            PG8_WAIT_V(8); PG8_WAIT_L(0); PG8_BAR; PG8_MMA(0, 0, At, B0); PG8_MMA(0, 1, At, B1); PG8_BAR; PG8_SCHED;
            PG8_LDA(At, 0, 1); PG8_STAGE(PG8_SB(0, 0), b2, voffB); PG8_STAGE(PG8_SB(0, 1), b2 + hstep, voffB); PG8_STAGE(PG8_SA(0, 0), a2, voffA);
            PG8_WAIT_V(8); PG8_WAIT_L(0); PG8_BAR; PG8_MMA(1, 0, At, B0); PG8_MMA(1, 1, At, B1); PG8_BAR; PG8_SCHED;
            PG8_LDB(B0, 1, 0); PG8_LDB(B1, 1, 1); PG8_SCHED; PG8_LDA(At, 1, 0); PG8_STAGE(PG8_SA(0, 1), a2 + hstep, voffA);
            PG8_WAIT_V(8); PG8_WAIT_L(0); PG8_BAR; PG8_MMA(0, 0, At, B0); PG8_MMA(0, 1, At, B1); PG8_BAR; PG8_SCHED;
            PG8_LDA(At, 1, 1); PG8_STAGE(PG8_SB(1, 0), b3, voffB); PG8_STAGE(PG8_SB(1, 1), b3 + hstep, voffB); PG8_STAGE(PG8_SA(1, 0), a3, voffA);
            PG8_WAIT_V(8); PG8_WAIT_L(0); PG8_BAR; PG8_MMA(1, 0, At, B0); PG8_MMA(1, 1, At, B1); PG8_BAR; PG8_SCHED;
            } else {
            PG8_LDB(B0, 0, 0); PG8_SCHED; PG8_LDA(At, 0, 0); PG8_STAGE(PG8_SA(1, 1), a1 + hstep, voffA);
            PG8_WAIT_L(8); PG8_BAR; PG8_WAIT_L(0); PG8_MMA(0, 0, At, B0); PG8_BAR; PG8_SCHED;
            PG8_LDB(B1, 0, 1); PG8_STAGE(PG8_SB(0, 0), b2, voffB);
            PG8_BAR; PG8_WAIT_L(0); PG8_MMA(0, 1, At, B1); PG8_BAR;
            PG8_LDA(At, 0, 1); PG8_STAGE(PG8_SA(0, 0), a2, voffA);
            PG8_BAR; PG8_WAIT_L(0); PG8_MMA(1, 0, At, B0); PG8_BAR; PG8_SCHED;
            PG8_STAGE(PG8_SB(0, 1), b2 + hstep, voffB);
            PG8_WAIT_V(6); PG8_BAR; PG8_MMA(1, 1, At, B1); PG8_BAR;
            PG8_LDB(B0, 1, 0); PG8_SCHED; PG8_LDA(At, 1, 0); PG8_STAGE(PG8_SA(0, 1), a2 + hstep, voffA);
            PG8_WAIT_L(8); PG8_BAR; PG8_WAIT_L(0); PG8_MMA(0, 0, At, B0); PG8_BAR; PG8_SCHED;
            PG8_LDB(B1, 1, 1); PG8_STAGE(PG8_SB(1, 0), b3, voffB);
            PG8_BAR; PG8_WAIT_L(0); PG8_MMA(0, 1, At, B1); PG8_BAR;
            PG8_LDA(At, 1, 1); PG8_STAGE(PG8_SA(1, 0), a3, voffA);
            PG8_BAR; PG8_WAIT_L(0); PG8_MMA(1, 0, At, B0); PG8_BAR; PG8_SCHED;
            PG8_STAGE(PG8_SB(1, 1), b3 + hstep, voffB);
            PG8_WAIT_V(6); PG8_BAR; PG8_MMA(1, 1, At, B1); PG8_BAR;
            }
        }
        if constexpr (ALIGN_EPI) { if (wr == 0) PG8_BAR; }
        E(acc, cur, wr, wc, fr, fq);
        if (!has_next) break;
#pragma unroll
        for (int a = 0; a < 2; ++a)
#pragma unroll
            for (int b = 0; b < 2; ++b)
#pragma unroll
                for (int m = 0; m < 4; ++m)
#pragma unroll
                    for (int n = 0; n < 2; ++n) acc[a][b][m][n] = (f32x4){0.f, 0.f, 0.f, 0.f};
        cur = nxt; cA = nA; cB = nB; ++ui;
        if constexpr (ALIGN_EPI) { if (wr == 1) PG8_BAR; }
    }
    PG8_WAIT_V(0);
    if constexpr (!ALIGN_EPI) { if (wr == 0) PG8_BAR; }
    PG8_BAR;
#undef PG8_SA
#undef PG8_SB
#undef PG8_STAGE
#undef PG8_LDA
#undef PG8_LDB
#undef PG8_MMA
#undef PG8_WAIT_V
#undef PG8_WAIT_L
#undef PG8_BAR
#undef PG8_SCHED
}
}

constexpr int NWAVES = 8;
constexpr int DM = 1024, NBATCH = 32, SEQ = 2048, MTOK = NBATCH * SEQ, DEPTH = 4, NEXP = 32, TOPK = 4;
constexpr int HG_N = 4096, RT_N = 6144, HG_H = 8, RT_H = 4;
constexpr float EPS = 1e-6f;
constexpr int LCAP = 65536;
constexpr int MAXTILES = 1056;

constexpr size_t MiB = 1u << 20;
constexpr size_t WS_CTL = 0, CTL_ZERO_BYTES = 1 * MiB;
constexpr size_t WS_MOD = 1 * MiB;
constexpr size_t WS_FMOD = 4 * MiB;
constexpr size_t WS_LBV = 4 * MiB + 512 * 1024;
constexpr size_t WS_HWIN = 8 * MiB, WS_HWOUT = 24 * MiB, WS_RWIN = 28 * MiB, WS_RWOUT = 52 * MiB, WS_W1T = 64 * MiB, WS_W2T = 576 * MiB;
constexpr size_t WS_H = 832 * MiB;
constexpr size_t WS_LIST = 960 * MiB;
constexpr size_t WS_TSLOT = 968 * MiB, WS_TGATE = 969 * MiB;
constexpr size_t WS_R1 = 976 * MiB;
constexpr size_t WS_R2 = 1744 * MiB;
constexpr size_t WS_END = 2272 * MiB;
constexpr int CW_BAR = 4096;
constexpr int CW_CNT = 8192;

constexpr int RING_OFF = 0, RING_BYTES = 131072;
constexpr int MISC_OFF = 155648;
constexpr int TAB_OFF = MISC_OFF + 128;
constexpr int LDS_BYTES = 160 * 1024;

#define GAS __attribute__((address_space(1)))
#define LAS __attribute__((address_space(3)))
typedef unsigned short bf16;
typedef unsigned v4u __attribute__((ext_vector_type(4)));
typedef unsigned v2u __attribute__((ext_vector_type(2)));
typedef float f32x4 __attribute__((ext_vector_type(4)));
typedef short bf16x8 __attribute__((ext_vector_type(8)));
#define RLX_AGENT __ATOMIC_RELAXED, __HIP_MEMORY_SCOPE_AGENT
#define LDS_WAIT() asm volatile("s_waitcnt lgkmcnt(0)" ::: "memory")
#define VM_WAIT() asm volatile("s_waitcnt vmcnt(0)" ::: "memory")
__device__ __forceinline__ unsigned pk2(float lo, float hi) { return pg8::cvt_pk_bf16(lo, hi); }
__device__ __forceinline__ float bflo(unsigned w) { return __uint_as_float(w << 16); }
__device__ __forceinline__ float bfhi(unsigned w) { return __uint_as_float(w & 0xffff0000u); }
__device__ __forceinline__ float bf2f(unsigned short h) { return __uint_as_float(((unsigned)h) << 16); }
__device__ __forceinline__ float sigmoidf_(float x) { return __builtin_amdgcn_rcpf(1.f + __expf(-x)); }
__device__ __forceinline__ float siluf_(float x) { return x * sigmoidf_(x); }
__device__ __forceinline__ unsigned ldu_vec(const unsigned* p) { return __hip_atomic_load(p, RLX_AGENT); }

#define XB_TMO      128
#define XB_XCNT(j)  (256  + 64 * (j))
#define XB_XSUB(j)  (1280 + 64 * (j))
#define XB_XGEN(j)  (2304 + 64 * (j))
#define XB_TOP      3328
#define XB_TOPGEN   3392
#define XCD_BAR_WORDS 3456
#define XB_SPIN_CAP (1u << 18)

__device__ __forceinline__ unsigned xb_ld(unsigned* p)              { return __hip_atomic_load(p, __ATOMIC_RELAXED, __HIP_MEMORY_SCOPE_AGENT); }
__device__ __forceinline__ unsigned xb_add(unsigned* p, unsigned v) { return __hip_atomic_fetch_add(p, v, __ATOMIC_RELAXED, __HIP_MEMORY_SCOPE_AGENT); }
__device__ __forceinline__ unsigned xb_xcc_id() { return (unsigned)__builtin_amdgcn_s_getreg((3 << 11) | 20) & 0xFu; }
#define XB_SPIN(cond, bar) do { unsigned _sp = 0; while (cond) { __builtin_amdgcn_s_sleep(1); \
    if ((++_sp & 255u) == 0u) { if (xb_ld(&(bar)[XB_TMO])) break; if (_sp > XB_SPIN_CAP) { atomicAdd(&(bar)[XB_TMO], 1u); break; } } } } while (0)

struct XcdBarrier {
    unsigned* bar; unsigned x;
    volatile LAS unsigned* st;
};
__device__ __forceinline__ XcdBarrier xcd_barrier_post(unsigned* bar, volatile LAS unsigned* st) {
    XcdBarrier b; b.bar = bar; b.x = xb_xcc_id(); b.st = st;
    if (threadIdx.x == 0) (void)xb_add(&bar[XB_XCNT(b.x)], 1u);
    return b;
}
__device__ __forceinline__ void xcd_barrier_complete(unsigned* bar, unsigned x, unsigned& nloc, unsigned& nx) {
    const unsigned G = gridDim.x * gridDim.y * gridDim.z;
    unsigned sum, cnt, mine, sp = 0u;
    for (;;) {
        sum = 0u; cnt = 0u; mine = 0u;
#pragma unroll
        for (unsigned j = 0; j < 16; ++j) { const unsigned c = xb_ld(&bar[XB_XCNT(j)]); sum += c; cnt += (c > 0u) ? 1u : 0u; mine = (j == x) ? c : mine; }
        if (sum == G) break;
        __builtin_amdgcn_s_sleep(1);
        if ((++sp & 255u) == 0u) { if (xb_ld(&bar[XB_TMO])) break; if (sp > XB_SPIN_CAP) { atomicAdd(&bar[XB_TMO], 1u); break; } }
    }
    nloc = mine > 0u ? mine : 1u; nx = cnt > 0u ? cnt : 1u;
}
__device__ __forceinline__ void xcd_barrier(const XcdBarrier& b) {
    asm volatile("s_waitcnt vmcnt(0)" ::: "memory");
    __syncthreads();
    if (threadIdx.x == 0) {
        unsigned* bar = b.bar;
        __builtin_amdgcn_s_waitcnt(0);
        unsigned nloc = b.st[0], nx = b.st[1];
        if (nloc == 0u) { xcd_barrier_complete(bar, b.x, nloc, nx); b.st[0] = nloc; b.st[1] = nx; }
        const unsigned old = xb_add(&bar[XB_XSUB(b.x)], 1u);
        const unsigned gen = old / nloc;
        if (old + 1u == (gen + 1u) * nloc) {
            __builtin_amdgcn_fence(__ATOMIC_RELEASE, "agent");
            asm volatile("s_waitcnt vmcnt(0)" ::: "memory");
            const unsigned og = xb_add(&bar[XB_TOP], 1u);
            const unsigned tg = og / nx;
            if (og + 1u == (tg + 1u) * nx) xb_add(&bar[XB_TOPGEN], 1u);
            else XB_SPIN(xb_ld(&bar[XB_TOPGEN]) == tg, bar);
            __builtin_amdgcn_fence(__ATOMIC_ACQUIRE, "agent");
            xb_add(&bar[XB_XGEN(b.x)], 1u);
            asm volatile("s_waitcnt vmcnt(0)" ::: "memory");
        } else {
            XB_SPIN(xb_ld(&bar[XB_XGEN(b.x)]) == gen, bar);
            __builtin_amdgcn_fence(__ATOMIC_ACQUIRE, "agent");
            asm volatile("s_waitcnt vmcnt(0)" ::: "memory");
        }
    }
    __syncthreads();
}

struct Frame {
    LAS unsigned char* lds;
    unsigned* ctl;
    int tid, lane, wave, vcu, G;
    float* out; unsigned char* ws;
};
__device__ __forceinline__ void relaunder(Frame& F) { int t = threadIdx.x; asm volatile("" : "+v"(t)); F.tid = t; F.lane = t & 63; F.wave = __builtin_amdgcn_readfirstlane(t >> 6); }
#define KAS __attribute__((address_space(4)))
__device__ __forceinline__ const void* kin_(int i) { const KAS char* kp = (const KAS char*)__builtin_amdgcn_kernarg_segment_ptr(); asm volatile("" : "+s"(kp)); return *(const void* const KAS*)(kp + 8 * i); }
enum { I_X = 0, I_C, I_POS, I_ADAW, I_ADAB, I_N1G, I_N2G, I_HWIN, I_HWOUT, I_HGAIN, I_HLB, I_RWIN, I_RWOUT, I_RTW, I_RTB, I_W1, I_B1, I_W2, I_B2, I_FG, I_FADAW, I_FADAB };
#define KIN(i) ((const float*)kin_(i))
__device__ __forceinline__ float wave_sum(float v) {
#pragma unroll
    for (int o = 1; o < 64; o <<= 1) v += __shfl_xor(v, o);
    return v;
}

__device__ __forceinline__ void p0_transpose_item(const float* W, int N, bf16* WT, int K, int k0, int n0, int drow0, LAS float* scr, int lane) {
#pragma unroll 8
    for (int i = 0; i < 32; ++i) { const int kk = 2 * i + (lane >> 5); scr[kk * 33 + (lane & 31)] = W[(size_t)(k0 + kk) * N + n0 + (lane & 31)]; }
    LDS_WAIT(); asm volatile("" ::: "memory");
    const int c = lane & 7;
#pragma unroll
    for (int j = 0; j < 4; ++j) { const int n = (lane >> 3) + 8 * j; const LAS float* s = scr + (8 * c) * 33 + n;
        v4u o; o.x = pk2(s[0 * 33], s[1 * 33]); o.y = pk2(s[2 * 33], s[3 * 33]); o.z = pk2(s[4 * 33], s[5 * 33]); o.w = pk2(s[6 * 33], s[7 * 33]);
        *(GAS v4u*)(WT + (size_t)(drow0 + n) * K + k0 + 8 * c) = o; }
    LDS_WAIT(); asm volatile("" ::: "memory");
}
__device__ __forceinline__ void p0_prologue(Frame& F) {
    relaunder(F);
    const int gw = F.vcu * NWAVES + F.wave, NGW = F.G * NWAVES;
    {
        LAS float* condT = (LAS float*)(F.lds + RING_OFF);
        const float* cin = KIN(I_C);
        for (int idx = F.tid; idx < NBATCH * DM; idx += NWAVES * 64) { const int b = idx >> 10, k = idx & 1023; condT[k * 32 + b] = siluf_(cin[idx]); }
        __syncthreads();
        if ((gw & 3) == 0 && (gw >> 2) < 416) {
            const int u = gw >> 2; const float* W; const float* bias; float* outp; int N, n0, ostride;
            if (u < 384) { const int l = u / 96; n0 = (u % 96) * 64; N = 6 * DM; W = KIN(I_ADAW) + (size_t)l * DM * N; bias = KIN(I_ADAB) + l * N; outp = (float*)(F.ws + WS_MOD) + (size_t)l * NBATCH * N; ostride = N; }
            else { n0 = (u - 384) * 64; N = 2 * DM; W = KIN(I_FADAW); bias = KIN(I_FADAB); outp = (float*)(F.ws + WS_FMOD); ostride = N; }
            float acc[32];
#pragma unroll
            for (int b = 0; b < 32; ++b) acc[b] = 0.f;
#pragma unroll 4
            for (int k = 0; k < DM; ++k) {
                const float w = W[(size_t)k * N + n0 + F.lane];
                const LAS f32x4* cb = (const LAS f32x4*)(condT + k * 32);
#pragma unroll
                for (int q = 0; q < 8; ++q) { const f32x4 cv = cb[q]; acc[4 * q + 0] += cv.x * w; acc[4 * q + 1] += cv.y * w; acc[4 * q + 2] += cv.z * w; acc[4 * q + 3] += cv.w * w; }
            }
            const float bv = bias[n0 + F.lane];
#pragma unroll
            for (int b = 0; b < 32; ++b) outp[(size_t)b * ostride + n0 + F.lane] = acc[b] + bv;
        }
        if (gw == NGW - 1) {
            float* lbv = (float*)(F.ws + WS_LBV); const float* hlb = KIN(I_HLB);
            for (int d = F.lane; d < DM; d += 64) { const float a = hlb[d], b = hlb[DM + d], m = fmaxf(a, b), ea = __expf(a - m), eb = __expf(b - m); lbv[d] = 0.f; lbv[DM + d] = eb / (ea + eb); }
        }
        __syncthreads();
    }
    {
        LAS float* scr = (LAS float*)(F.lds + RING_OFF + F.wave * 16384);
        constexpr int NI_HI = 2 * 16 * 128, NI_HO = 2 * 16 * 32, NI_RI = 2 * 16 * 192, NI_RO = 2 * 32 * 32, NI_W1 = 128 * 16 * 64, NI_W2 = 128 * 16 * 32;
        constexpr int NITEMS = NI_HI + NI_HO + NI_RI + NI_RO + NI_W1 + NI_W2;
        for (int it = gw; it < NITEMS; it += NGW) {
            int r = it;
            if (r < NI_HI) { const int j = r / 2048, q = r % 2048, kb = q / 128, nb = q % 128;
                p0_transpose_item(KIN(I_HWIN) + (size_t)j * DM * HG_N, HG_N, (bf16*)(F.ws + WS_HWIN) + (size_t)j * HG_N * DM, DM, 64 * kb, 32 * nb, 32 * nb, scr, F.lane); continue; } r -= NI_HI;
            if (r < NI_HO) { const int j = r / 512, q = r % 512, kb = q / 32, nb = q % 32;
                p0_transpose_item(KIN(I_HWOUT) + (size_t)j * DM * DM, DM, (bf16*)(F.ws + WS_HWOUT) + (size_t)j * DM * DM, DM, 64 * kb, 32 * nb, 32 * nb, scr, F.lane); continue; } r -= NI_HO;
            if (r < NI_RI) { const int j = r / 3072, q = r % 3072, kb = q / 192, nb = q % 192;
                p0_transpose_item(KIN(I_RWIN) + (size_t)j * DM * RT_N, RT_N, (bf16*)(F.ws + WS_RWIN) + (size_t)j * RT_N * DM, DM, 64 * kb, 32 * nb, 32 * nb, scr, F.lane); continue; } r -= NI_RI;
            if (r < NI_RO) { const int j = r / 1024, q = r % 1024, kb = q / 32, nb = q % 32;
                p0_transpose_item(KIN(I_RWOUT) + (size_t)j * 2048 * DM, DM, (bf16*)(F.ws + WS_RWOUT) + (size_t)j * DM * 2048, 2048, 64 * kb, 32 * nb, 32 * nb, scr, F.lane); continue; } r -= NI_RO;
            if (r < NI_W1) { const int mi = r / 1024, q = r % 1024, kb = q / 64, nb = q % 64; const int n0 = 32 * nb;
                const int cc = n0 & 1023, drow0 = 256 * (cc >> 7) + (cc & 127) + ((n0 >= 1024) ? 128 : 0);
                p0_transpose_item(KIN(I_W1) + (size_t)mi * DM * 2048, 2048, (bf16*)(F.ws + WS_W1T) + (size_t)mi * 2048 * DM, DM, 64 * kb, n0, drow0, scr, F.lane); continue; } r -= NI_W1;
            { const int mi = r / 512, q = r % 512, kb = q / 32, nb = q % 32;
                p0_transpose_item(KIN(I_W2) + (size_t)mi * DM * DM, DM, (bf16*)(F.ws + WS_W2T) + (size_t)mi * DM * DM, DM, 64 * kb, 32 * nb, 32 * nb, scr, F.lane); }
        }
    }
}

__device__ __forceinline__ void build_tiles(Frame& F, int l) {
    LAS int* ts = (LAS int*)(F.lds + TAB_OFF); LAS int* cnt = ts + 40;
    __syncthreads();
    if (F.tid < NEXP) cnt[F.tid] = (int)ldu_vec(F.ctl + CW_CNT + l * 2048 + F.tid * 64);
    __syncthreads();
    if (F.tid == 0) { int a = 0; for (int e = 0; e < NEXP; ++e) { ts[e] = a; a += (cnt[e] + 255) >> 8; } ts[NEXP] = a; }
    __syncthreads();
}

__device__ __forceinline__ void row_phase1(Frame& F, int l, int mode) {
    relaunder(F);
    const LAS int* ts = (const LAS int*)(F.lds + TAB_OFF);
    const bool comb = (l > 0);
    if (comb) build_tiles(F, l - 1);
    const float* xsrc = comb ? F.out : KIN(I_X);
    const bf16* Y = (const bf16*)(F.ws + WS_R1);
    const unsigned* tslot = (const unsigned*)(F.ws + WS_TSLOT); const unsigned* tgate = (const unsigned*)(F.ws + WS_TGATE);
    bf16* H = (bf16*)(F.ws + WS_H);
    for (int rb = F.vcu * 256; rb < MTOK; rb += F.G * 256) {
        const int b = rb / SEQ;
        f32x4 A[4], B[4], G2[4];
#pragma unroll
        for (int j = 0; j < 4; ++j) {
            const int c = 4 * F.lane + 256 * j;
            if (mode == 0) { const float* mv = (const float*)(F.ws + WS_MOD) + (size_t)(l * NBATCH + b) * 6 * DM;
                const f32x4 g = *(const f32x4*)(KIN(I_N1G) + l * DM + c), sc = *(const f32x4*)(mv + 1 * DM + c); A[j] = g * (sc + 1.0f); B[j] = *(const f32x4*)(mv + c); }
            else { const float* fm = (const float*)(F.ws + WS_FMOD) + (size_t)b * 2 * DM;
                const f32x4 g = *(const f32x4*)(KIN(I_FG) + c), sc = *(const f32x4*)(fm + DM + c); A[j] = g * (sc + 1.0f); B[j] = *(const f32x4*)(fm + c); }
            if (comb) G2[j] = *(const f32x4*)((const float*)(F.ws + WS_MOD) + (size_t)((l - 1) * NBATCH + b) * 6 * DM + 5 * DM + c); else G2[j] = (f32x4){0.f, 0.f, 0.f, 0.f};
        }
        for (int r = 0; r < 32; ++r) {
            const int row = rb + 32 * F.wave + r;
            f32x4 v[4];
#pragma unroll
            for (int j = 0; j < 4; ++j) v[j] = *(const f32x4*)(xsrc + (size_t)row * DM + 4 * F.lane + 256 * j);
            if (comb) {
                const unsigned sl = tslot[(size_t)row * 4 + (F.lane & 3)], gt = tgate[(size_t)row * 4 + (F.lane & 3)];
                f32x4 ys[4];
#pragma unroll
                for (int j = 0; j < 4; ++j) ys[j] = (f32x4){0.f, 0.f, 0.f, 0.f};
#pragma unroll
                for (int k = 0; k < TOPK; ++k) {
                    const unsigned s = (unsigned)__shfl((int)sl, k); const float gk = __uint_as_float((unsigned)__shfl((int)gt, k));
                    const int e = (int)(s >> 20), pos = (int)(s & 0xFFFFFu); const size_t yrow = (size_t)ts[e] * 256 + pos;
#pragma unroll
                    for (int j = 0; j < 4; ++j) { const v2u w = *(const v2u*)(Y + yrow * DM + 4 * F.lane + 256 * j);
                        ys[j].x += gk * bflo(w.x); ys[j].y += gk * bfhi(w.x); ys[j].z += gk * bflo(w.y); ys[j].w += gk * bfhi(w.y); }
                }
#pragma unroll
                for (int j = 0; j < 4; ++j) v[j] = v[j] + G2[j] * ys[j];
                if (mode == 0) {
#pragma unroll
                    for (int j = 0; j < 4; ++j) *(f32x4*)(F.out + (size_t)row * DM + 4 * F.lane + 256 * j) = v[j];
                }
            }
            float s2 = 0.f;
#pragma unroll
            for (int j = 0; j < 4; ++j) s2 += (v[j].x * v[j].x + v[j].y * v[j].y) + (v[j].z * v[j].z + v[j].w * v[j].w);
            const float rstd = 1.0f / sqrtf(wave_sum(s2) * (1.0f / DM) + EPS);
            if (mode == 0) {
#pragma unroll
                for (int j = 0; j < 4; ++j) { const f32x4 h = v[j] * rstd * A[j] + B[j]; v2u w; w.x = pk2(h.x, h.y); w.y = pk2(h.z, h.w); *(v2u*)(H + (size_t)row * DM + 4 * F.lane + 256 * j) = w; }
            } else {
#pragma unroll
                for (int j = 0; j < 4; ++j) *(f32x4*)(F.out + (size_t)row * DM + 4 * F.lane + 256 * j) = v[j] * rstd * A[j] + B[j];
            }
        }
    }
}

__device__ __forceinline__ void row_phase2(Frame& F, int l) {
    relaunder(F);
    bf16* H = (bf16*)(F.ws + WS_H);
    LAS unsigned char* frag = F.lds + RING_OFF;
    LAS float* lg = (LAS float*)(F.lds + 131072 + F.wave * 2112);
    LAS int* cntL = (LAS int*)(F.lds + 147968); LAS int* baseL = cntL + 32; LAS float* rbias = (LAS float*)(cntL + 64);
    unsigned* list = (unsigned*)(F.ws + WS_LIST); unsigned* tslot = (unsigned*)(F.ws + WS_TSLOT); float* tgate = (float*)(F.ws + WS_TGATE);
    __syncthreads();
    { const float* rw = KIN(I_RTW) + (size_t)l * DM * NEXP;
      for (int it = F.tid; it < 32 * 2 * 64; it += NWAVES * 64) { const int ln = it & 63, nt = (it >> 6) & 1, s = it >> 7; const int e = 16 * nt + (ln & 15), k0 = 32 * s + 8 * (ln >> 4);
          float w[8], hi[8];
#pragma unroll
          for (int j = 0; j < 8; ++j) { w[j] = rw[(size_t)(k0 + j) * NEXP + e]; }
          v4u ph, pl;
          { unsigned a = pk2(w[0], w[1]), b2 = pk2(w[2], w[3]), c2 = pk2(w[4], w[5]), d2 = pk2(w[6], w[7]); ph = (v4u){a, b2, c2, d2};
            hi[0] = bflo(a); hi[1] = bfhi(a); hi[2] = bflo(b2); hi[3] = bfhi(b2); hi[4] = bflo(c2); hi[5] = bfhi(c2); hi[6] = bflo(d2); hi[7] = bfhi(d2); }
          pl = (v4u){pk2(w[0] - hi[0], w[1] - hi[1]), pk2(w[2] - hi[2], w[3] - hi[3]), pk2(w[4] - hi[4], w[5] - hi[5]), pk2(w[6] - hi[6], w[7] - hi[7])};
          *(LAS v4u*)(frag + ((s * 2 + nt) * 2 + 0) * 1024 + ln * 16) = ph; *(LAS v4u*)(frag + ((s * 2 + nt) * 2 + 1) * 1024 + ln * 16) = pl; }
      if (F.tid < NEXP) rbias[F.tid] = KIN(I_RTB)[l * NEXP + F.tid];
    }
    for (int rb = F.vcu * 256; rb < MTOK; rb += F.G * 256) {
        const int b = rb / SEQ;
        if (F.tid < NEXP) cntL[F.tid] = 0;
        __syncthreads();
        {
            f32x4 A[4], B[4];
            const float* mv = (const float*)(F.ws + WS_MOD) + (size_t)(l * NBATCH + b) * 6 * DM;
#pragma unroll
            for (int j = 0; j < 4; ++j) { const int c = 4 * F.lane + 256 * j; const f32x4 g = *(const f32x4*)(KIN(I_N2G) + l * DM + c), sc = *(const f32x4*)(mv + 4 * DM + c); A[j] = g * (sc + 1.0f); B[j] = *(const f32x4*)(mv + 3 * DM + c); }
            for (int r = 0; r < 32; ++r) {
                const int row = rb + 32 * F.wave + r;
                f32x4 v[4]; float s2 = 0.f;
#pragma unroll
                for (int j = 0; j < 4; ++j) { v[j] = *(const f32x4*)(F.out + (size_t)row * DM + 4 * F.lane + 256 * j); s2 += (v[j].x * v[j].x + v[j].y * v[j].y) + (v[j].z * v[j].z + v[j].w * v[j].w); }
                const float rstd = 1.0f / sqrtf(wave_sum(s2) * (1.0f / DM) + EPS);
#pragma unroll
                for (int j = 0; j < 4; ++j) { const f32x4 h = v[j] * rstd * A[j] + B[j]; v2u w; w.x = pk2(h.x, h.y); w.y = pk2(h.z, h.w); *(v2u*)(H + (size_t)row * DM + 4 * F.lane + 256 * j) = w; }
            }
        }
        VM_WAIT();
        int my_e[2][TOPK], my_lp[2][TOPK]; float my_g[2][TOPK];
#pragma unroll
        for (int grp = 0; grp < 2; ++grp) {
            const int row0 = rb + 32 * F.wave + 16 * grp;
            f32x4 acc0 = (f32x4){0.f, 0.f, 0.f, 0.f}, acc1 = (f32x4){0.f, 0.f, 0.f, 0.f};
            const unsigned long long* ap = (const unsigned long long*)(H + (size_t)(row0 + (F.lane & 15)) * DM + 8 * (F.lane >> 4));
#pragma unroll 4
            for (int s = 0; s < 32; ++s) {
                const unsigned long long lo = __hip_atomic_load(ap + 8 * s, RLX_AGENT), hi = __hip_atomic_load(ap + 8 * s + 1, RLX_AGENT);
                v4u av = (v4u){(unsigned)lo, (unsigned)(lo >> 32), (unsigned)hi, (unsigned)(hi >> 32)}; const bf16x8 a = __builtin_bit_cast(bf16x8, av);
                const bf16x8 b00 = *(const LAS bf16x8*)(frag + ((s * 2 + 0) * 2 + 0) * 1024 + F.lane * 16), b01 = *(const LAS bf16x8*)(frag + ((s * 2 + 0) * 2 + 1) * 1024 + F.lane * 16);
                const bf16x8 b10 = *(const LAS bf16x8*)(frag + ((s * 2 + 1) * 2 + 0) * 1024 + F.lane * 16), b11 = *(const LAS bf16x8*)(frag + ((s * 2 + 1) * 2 + 1) * 1024 + F.lane * 16);
                acc0 = __builtin_amdgcn_mfma_f32_16x16x32_bf16(a, b00, acc0, 0, 0, 0); acc0 = __builtin_amdgcn_mfma_f32_16x16x32_bf16(a, b01, acc0, 0, 0, 0);
                acc1 = __builtin_amdgcn_mfma_f32_16x16x32_bf16(a, b10, acc1, 0, 0, 0); acc1 = __builtin_amdgcn_mfma_f32_16x16x32_bf16(a, b11, acc1, 0, 0, 0);
            }
#pragma unroll
            for (int q = 0; q < 4; ++q) { lg[(4 * (F.lane >> 4) + q) * 33 + (F.lane & 15)] = acc0[q]; lg[(4 * (F.lane >> 4) + q) * 33 + 16 + (F.lane & 15)] = acc1[q]; }
            LDS_WAIT(); asm volatile("" ::: "memory");
            if (F.lane < 16) {
                unsigned taken = 0u; float tl[TOPK];
#pragma unroll
                for (int k = 0; k < TOPK; ++k) {
                    float best = -3.0e38f; int bi = 0;
                    for (int e = 0; e < NEXP; ++e) { const float v = lg[F.lane * 33 + e] + rbias[e]; if (!((taken >> e) & 1u) && v > best) { best = v; bi = e; } }
                    taken |= 1u << bi; my_e[grp][k] = bi; tl[k] = best;
                }
                float den = 0.f, ex[TOPK];
#pragma unroll
                for (int k = 0; k < TOPK; ++k) { ex[k] = __expf(tl[k] - tl[0]); den += ex[k]; }
#pragma unroll
                for (int k = 0; k < TOPK; ++k) { my_g[grp][k] = ex[k] / den; my_lp[grp][k] = __hip_atomic_fetch_add(&cntL[my_e[grp][k]], 1, __ATOMIC_RELAXED, __HIP_MEMORY_SCOPE_WORKGROUP); }
            } else {
#pragma unroll
                for (int k = 0; k < TOPK; ++k) { my_e[grp][k] = 0; my_lp[grp][k] = 0; my_g[grp][k] = 0.f; }
            }
            LDS_WAIT(); asm volatile("" ::: "memory");
        }
        __syncthreads();
        if (F.tid < NEXP) baseL[F.tid] = (int)__hip_atomic_fetch_add(F.ctl + CW_CNT + l * 2048 + F.tid * 64, (unsigned)cntL[F.tid], RLX_AGENT);
        __syncthreads();
        if (F.lane < 16) {
#pragma unroll
            for (int grp = 0; grp < 2; ++grp) {
                const int row = rb + 32 * F.wave + 16 * grp + F.lane;
#pragma unroll
                for (int k = 0; k < TOPK; ++k) { const int e = my_e[grp][k], pos = baseL[e] + my_lp[grp][k];
                    list[(size_t)e * LCAP + pos] = (unsigned)row; tslot[(size_t)row * 4 + k] = ((unsigned)e << 20) | (unsigned)pos; tgate[(size_t)row * 4 + k] = my_g[grp][k]; }
            }
        }
        __syncthreads();
    }
}

__device__ __forceinline__ void moe_gather(Frame& F, int l) {
    relaunder(F);
    build_tiles(F, l);
    const LAS int* ts = (const LAS int*)(F.lds + TAB_OFF); const LAS int* cnt = ts + 40;
    const unsigned* list = (const unsigned*)(F.ws + WS_LIST); const bf16* H = (const bf16*)(F.ws + WS_H); bf16* Xg = (bf16*)(F.ws + WS_R1);
    const int gw = F.vcu * NWAVES + F.wave, NGW = F.G * NWAVES, NR = ts[NEXP] * 256;
    for (int r = gw; r < NR; r += NGW) {
        const int mt = r >> 8; int e = 0;
        for (int k = 1; k < NEXP; ++k) e += (ts[k] <= mt) ? 1 : 0;
        const int pos = r - ts[e] * 256;
        unsigned tok = 0u; if (pos < cnt[e]) tok = ldu_vec(list + (size_t)e * LCAP + pos);
        const v4u* src = (const v4u*)(H + (size_t)tok * DM); v4u* dst = (v4u*)(Xg + (size_t)r * DM);
        dst[F.lane] = src[F.lane]; dst[F.lane + 64] = src[F.lane + 64];
    }
}

using pg8::Unit;
__device__ __forceinline__ v4u pack8(const f32x4 a, const f32x4 b) { v4u w; w.x = pk2(a.x, a.y); w.y = pk2(a.z, a.w); w.z = pk2(b.x, b.y); w.w = pk2(b.z, b.w); return w; }

struct EpiHgrnIn {
    static constexpr bool PERM = true;
    unsigned char* r1; const float* lb;
    __device__ __forceinline__ void operator()(const f32x4 (&acc)[2][2][4][2], const Unit& u, int wr, int wc, int fr, int fq) const {
        const int seg = u.pn >> 2, row0 = u.pm * 256 + wr * 64 + fr, cs0 = (u.pn & 3) * 256 + wc * 32 + 8 * fq;
        if (seg == 1) {
            bf16* K = (bf16*)(r1 + 128 * MiB); float* LF = (float*)(r1 + 512 * MiB);
#pragma unroll
            for (int bj = 0; bj < 2; ++bj) {
                f32x4 lbv[2]; lbv[0] = *(const f32x4*)(lb + cs0 + bj * 128); lbv[1] = *(const f32x4*)(lb + cs0 + bj * 128 + 4);
#pragma unroll
                for (int ai = 0; ai < 2; ++ai)
#pragma unroll
                    for (int m = 0; m < 4; ++m) { const size_t ro = (size_t)(row0 + ai * 128 + m * 16) * DM + cs0 + bj * 128; f32x4 kk[2], lf[2];
#pragma unroll
                        for (int n = 0; n < 2; ++n)
#pragma unroll
                            for (int j = 0; j < 4; ++j) { const float f = fminf(fmaxf(acc[ai][bj][m][n][j], -60.f), 60.f), l0 = lbv[n][j], ef = __expf(f);
                                const float sg = ef * __builtin_amdgcn_rcpf(1.f + ef), sgm = __builtin_amdgcn_rcpf(1.f + ef);
                                lf[n][j] = __logf(l0 + (1.f - l0) * sg); kk[n][j] = (1.f - l0) * sgm; }
                        *(v4u*)(K + ro) = pack8(kk[0], kk[1]); *(f32x4*)(LF + ro) = lf[0]; *(f32x4*)(LF + ro + 4) = lf[1];
                        __builtin_amdgcn_sched_barrier(0); }
            }
        } else {
            bf16* dst = (bf16*)(r1 + (seg == 0 ? 0 : (seg == 2 ? 256 * MiB : 384 * MiB))); const bool act = (seg != 2);
#pragma unroll
            for (int ai = 0; ai < 2; ++ai)
#pragma unroll
                for (int m = 0; m < 4; ++m) { const size_t ro = (size_t)(row0 + ai * 128 + m * 16) * DM;
#pragma unroll
                    for (int bj = 0; bj < 2; ++bj) { f32x4 v0 = acc[ai][bj][m][0], v1 = acc[ai][bj][m][1];
                        if (act) {
#pragma unroll
                            for (int j = 0; j < 4; ++j) { v0[j] = siluf_(v0[j]); v1[j] = siluf_(v1[j]); } }
                        *(v4u*)(dst + ro + cs0 + bj * 128) = pack8(v0, v1); }
                    __builtin_amdgcn_sched_barrier(0); }
        }
    }
};

struct EpiRetIn {
    static constexpr bool PERM = true;
    unsigned char* r1; const int* positions;
    __device__ __forceinline__ void operator()(const f32x4 (&acc)[2][2][4][2], const Unit& u, int wr, int wc, int fr, int fq) const {
        const int row0 = u.pm * 256 + wr * 64 + fr, cl = wc * 32 + 8 * fq;
        if (u.pn < 8) {
            bf16* dst = (bf16*)(r1 + ((u.pn < 4) ? 0 : 128 * MiB)); const float sc = (u.pn < 4) ? 1.0f : 0.0625f; const int hh = u.pn & 3;
            float invrev[2][4];
#pragma unroll
            for (int n = 0; n < 2; ++n)
#pragma unroll
                for (int j = 0; j < 4; ++j) invrev[n][j] = exp2f(-(float)(cl + 4 * n + j) * 0.10462765653188542f) * 0.15915494309189535f;
#pragma unroll
            for (int ai = 0; ai < 2; ++ai)
#pragma unroll
                for (int m = 0; m < 4; ++m) { const int row = row0 + ai * 128 + m * 16; const float pos = (float)positions[row]; const size_t ro = (size_t)row * DM + hh * 256 + cl;
                    f32x4 o1[2], o2[2];
#pragma unroll
                    for (int n = 0; n < 2; ++n)
#pragma unroll
                        for (int j = 0; j < 4; ++j) { const float rev = pos * invrev[n][j], fr_ = rev - floorf(rev); const float cs = __builtin_amdgcn_cosf(fr_), sn = __builtin_amdgcn_sinf(fr_);
                            const float x1 = acc[ai][0][m][n][j], x2 = acc[ai][1][m][n][j]; o1[n][j] = (x1 * cs - x2 * sn) * sc; o2[n][j] = (x2 * cs + x1 * sn) * sc; }
                    *(v4u*)(dst + ro) = pack8(o1[0], o1[1]); *(v4u*)(dst + ro + 128) = pack8(o2[0], o2[1]); }
        } else {
            const bool isg = (u.pn >= 16); bf16* dst = (bf16*)(r1 + (isg ? 512 * MiB : 256 * MiB)); const int ct = (isg ? u.pn - 16 : u.pn - 8) * 256 + cl;
#pragma unroll
            for (int ai = 0; ai < 2; ++ai)
#pragma unroll
                for (int m = 0; m < 4; ++m) { const size_t ro = (size_t)(row0 + ai * 128 + m * 16) * 2048 + ct;
#pragma unroll
                    for (int bj = 0; bj < 2; ++bj) { f32x4 v0 = acc[ai][bj][m][0], v1 = acc[ai][bj][m][1];
                        if (isg) {
#pragma unroll
                            for (int j = 0; j < 4; ++j) { v0[j] = siluf_(v0[j]); v1[j] = siluf_(v1[j]); } }
                        *(v4u*)(dst + ro + bj * 128) = pack8(v0, v1); } }
        }
    }
};

struct EpiOut {
    static constexpr bool PERM = false;
    const float* xin; float* xout; const float* gate;
    __device__ __forceinline__ void operator()(const f32x4 (&acc)[2][2][4][2], const Unit& u, int wr, int wc, int fr, int fq) const {
        const int row0 = u.pm * 256 + wr * 64 + fr, col0 = u.pn * 256 + wc * 32 + 4 * fq, b = (u.pm * 256) / SEQ;
        f32x4 gv[2][2];
#pragma unroll
        for (int bj = 0; bj < 2; ++bj)
#pragma unroll
            for (int n = 0; n < 2; ++n) gv[bj][n] = *(const f32x4*)(gate + (size_t)b * 6 * DM + col0 + bj * 128 + n * 16);
#pragma unroll
        for (int ai = 0; ai < 2; ++ai)
#pragma unroll
            for (int mp = 0; mp < 2; ++mp) { f32x4 xi[2][2][2];
#pragma unroll
                for (int mm = 0; mm < 2; ++mm)
#pragma unroll
                    for (int bj = 0; bj < 2; ++bj)
#pragma unroll
                        for (int n = 0; n < 2; ++n) xi[mm][bj][n] = *(const f32x4*)(xin + (size_t)(row0 + ai * 128 + (2 * mp + mm) * 16) * DM + col0 + bj * 128 + n * 16);
#pragma unroll
                for (int mm = 0; mm < 2; ++mm)
#pragma unroll
                    for (int bj = 0; bj < 2; ++bj)
#pragma unroll
                        for (int n = 0; n < 2; ++n) *(f32x4*)(xout + (size_t)(row0 + ai * 128 + (2 * mp + mm) * 16) * DM + col0 + bj * 128 + n * 16) = xi[mm][bj][n] + gv[bj][n] * acc[ai][bj][2 * mp + mm][n];
                asm volatile("" ::: "memory"); }
    }
};

struct EpiMoe1 {
    static constexpr bool PERM = true;
    bf16* A2; const float* b1;
    __device__ __forceinline__ void operator()(const f32x4 (&acc)[2][2][4][2], const Unit& u, int wr, int wc, int fr, int fq) const {
        const int row0 = u.pm * 256 + wr * 64 + fr, gc = u.nn * 128 + wc * 32 + 8 * fq; const float* bp = b1 + (size_t)u.e * 2048;
        f32x4 bg[2], bl[2];
#pragma unroll
        for (int n = 0; n < 2; ++n) { bg[n] = *(const f32x4*)(bp + gc + 4 * n); bl[n] = *(const f32x4*)(bp + 1024 + gc + 4 * n); }
#pragma unroll
        for (int ai = 0; ai < 2; ++ai)
#pragma unroll
            for (int m = 0; m < 4; ++m) { f32x4 o[2];
#pragma unroll
                for (int n = 0; n < 2; ++n)
#pragma unroll
                    for (int j = 0; j < 4; ++j) { const float g = fminf(acc[ai][0][m][n][j] + bg[n][j], 7.0f), li = fminf(fmaxf(acc[ai][1][m][n][j] + bl[n][j], -7.0f), 7.0f);
                        o[n][j] = g * sigmoidf_(1.702f * g) * (li + 1.0f); }
                *(v4u*)(A2 + (size_t)(row0 + ai * 128 + m * 16) * DM + gc) = pack8(o[0], o[1]); }
    }
};

struct EpiMoe2 {
    static constexpr bool PERM = true;
    bf16* Y; const float* b2;
    __device__ __forceinline__ void operator()(const f32x4 (&acc)[2][2][4][2], const Unit& u, int wr, int wc, int fr, int fq) const {
        const int row0 = u.pm * 256 + wr * 64 + fr, c0 = u.nn * 256 + wc * 32 + 8 * fq; const float* bp = b2 + (size_t)u.e * DM;
        f32x4 bv[2][2];
#pragma unroll
        for (int bj = 0; bj < 2; ++bj)
#pragma unroll
            for (int n = 0; n < 2; ++n) bv[bj][n] = *(const f32x4*)(bp + c0 + bj * 128 + 4 * n);
#pragma unroll
        for (int ai = 0; ai < 2; ++ai)
#pragma unroll
            for (int m = 0; m < 4; ++m) { const size_t ro = (size_t)(row0 + ai * 128 + m * 16) * DM + c0;
#pragma unroll
                for (int bj = 0; bj < 2; ++bj) *(v4u*)(Y + ro + bj * 128) = pack8(acc[ai][bj][m][0] + bv[bj][0], acc[ai][bj][m][1] + bv[bj][1]); }
    }
};

__device__ __forceinline__ void hgrn_scan(Frame& F, int j) {
    relaunder(F);
    const bf16* Q = (const bf16*)(F.ws + WS_R1); const bf16* K = (const bf16*)(F.ws + WS_R1 + 128 * MiB); const bf16* V = (const bf16*)(F.ws + WS_R1 + 256 * MiB); const bf16* SG = (const bf16*)(F.ws + WS_R1 + 384 * MiB);
    const float* LF = (const float*)(F.ws + WS_R1 + 512 * MiB); bf16* O = (bf16*)(F.ws + WS_R2);
    LAS float* Qs = (LAS float*)(F.lds); LAS float* Ks = Qs + 4096; LAS float* Fs = Qs + 8192; LAS float* Vs = Qs + 12288; LAS float* P = Qs + 16384;
    const int v = F.tid & 127, kq = F.tid >> 7, t16 = F.tid >> 4, c8 = (F.tid & 15) * 8;
    f32x4 gain0 = *(const f32x4*)(KIN(I_HGAIN) + j * 128 + c8), gain1 = *(const f32x4*)(KIN(I_HGAIN) + j * 128 + c8 + 4);
    for (int u = F.vcu; u < NBATCH * HG_H; u += F.G) {
        const int b = u / HG_H, h = u % HG_H;
        float S[32];
#pragma unroll
        for (int i = 0; i < 32; ++i) S[i] = 0.f;
        for (int ch = 0; ch < SEQ / 32; ++ch) {
            const int row0 = b * SEQ + 32 * ch; const size_t gi = (size_t)(row0 + t16) * DM + h * 128 + c8;
            __syncthreads();
            { const v4u q = *(const v4u*)(Q + gi), k = *(const v4u*)(K + gi), vv = *(const v4u*)(V + gi); const f32x4 l0 = *(const f32x4*)(LF + gi), l1 = *(const f32x4*)(LF + gi + 4);
              LAS f32x4* d;
              d = (LAS f32x4*)(Qs + t16 * 128 + c8); d[0] = (f32x4){bflo(q.x), bfhi(q.x), bflo(q.y), bfhi(q.y)}; d[1] = (f32x4){bflo(q.z), bfhi(q.z), bflo(q.w), bfhi(q.w)};
              d = (LAS f32x4*)(Ks + t16 * 128 + c8); d[0] = (f32x4){bflo(k.x), bfhi(k.x), bflo(k.y), bfhi(k.y)}; d[1] = (f32x4){bflo(k.z), bfhi(k.z), bflo(k.w), bfhi(k.w)};
              d = (LAS f32x4*)(Vs + t16 * 128 + c8); d[0] = (f32x4){bflo(vv.x), bfhi(vv.x), bflo(vv.y), bfhi(vv.y)}; d[1] = (f32x4){bflo(vv.z), bfhi(vv.z), bflo(vv.w), bfhi(vv.w)};
              d = (LAS f32x4*)(Fs + t16 * 128 + c8); d[0] = (f32x4){__expf(l0.x), __expf(l0.y), __expf(l0.z), __expf(l0.w)}; d[1] = (f32x4){__expf(l1.x), __expf(l1.y), __expf(l1.z), __expf(l1.w)}; }
            __syncthreads();
            for (int t = 0; t < 32; ++t) {
                const float vt = Vs[t * 128 + v]; float a = 0.f;
#pragma unroll
                for (int i4 = 0; i4 < 8; ++i4) { const f32x4 f4 = *(const LAS f32x4*)(Fs + t * 128 + 32 * kq + 4 * i4), k4 = *(const LAS f32x4*)(Ks + t * 128 + 32 * kq + 4 * i4), q4 = *(const LAS f32x4*)(Qs + t * 128 + 32 * kq + 4 * i4);
#pragma unroll
                    for (int i = 0; i < 4; ++i) { S[4 * i4 + i] = f4[i] * S[4 * i4 + i] + k4[i] * vt; a += q4[i] * S[4 * i4 + i]; } }
                P[(t * 4 + kq) * 128 + v] = a;
            }
            __syncthreads();
            { f32x4 o0 = (f32x4){0.f, 0.f, 0.f, 0.f}, o1 = o0;
#pragma unroll
              for (int q = 0; q < 4; ++q) { o0 += *(const LAS f32x4*)(P + (t16 * 4 + q) * 128 + c8); o1 += *(const LAS f32x4*)(P + (t16 * 4 + q) * 128 + c8 + 4); }
              float ss = (o0.x * o0.x + o0.y * o0.y) + (o0.z * o0.z + o0.w * o0.w) + (o1.x * o1.x + o1.y * o1.y) + (o1.z * o1.z + o1.w * o1.w);
              ss += __shfl_xor(ss, 1); ss += __shfl_xor(ss, 2); ss += __shfl_xor(ss, 4); ss += __shfl_xor(ss, 8);
              const float r = 1.0f / sqrtf(ss * (1.0f / 128.f) + EPS);
              const v4u sg = *(const v4u*)(SG + gi);
              f32x4 a0 = o0 * r * gain0, a1 = o1 * r * gain1;
              a0.x *= bflo(sg.x); a0.y *= bfhi(sg.x); a0.z *= bflo(sg.y); a0.w *= bfhi(sg.y); a1.x *= bflo(sg.z); a1.y *= bfhi(sg.z); a1.z *= bflo(sg.w); a1.w *= bfhi(sg.w);
              *(v4u*)(O + gi) = pack8(a0, a1); }
        }
    }
}

__device__ __forceinline__ void ret_scan(Frame& F) {
    relaunder(F);
    const bf16* Q = (const bf16*)(F.ws + WS_R1); const bf16* K = (const bf16*)(F.ws + WS_R1 + 128 * MiB); const bf16* V = (const bf16*)(F.ws + WS_R1 + 256 * MiB); const bf16* SG = (const bf16*)(F.ws + WS_R1 + 512 * MiB);
    bf16* O = (bf16*)(F.ws + WS_R2);
    LAS bf16* Qs = (LAS bf16*)(F.lds); LAS bf16* Ks = (LAS bf16*)(F.lds + 33792); LAS bf16* Vs = (LAS bf16*)(F.lds + 67584);
    LAS float* St = (LAS float*)(F.lds + 133120); LAS float* wred = (LAS float*)(F.lds + 149504); LAS float* rtab = (LAS float*)(F.lds + 151552);
    for (int u = F.vcu; u < NBATCH * RT_H * 16; u += F.G) {
        const int bh = u >> 4, cp = u & 15, b = bh >> 2, h = bh & 3;
        const float lg2g = log2f(1.0f - exp2f(-5.0f - (float)h));
        for (int half = 0; half < 2; ++half) {
            const int c = half ? 31 - cp : cp; const int row0 = b * SEQ + 64 * c;
            __syncthreads();
#pragma unroll
            for (int i = 0; i < 4; ++i) { const int p = F.tid + 512 * i, r = p >> 5, cc = (p & 31) * 8; *(LAS v4u*)(Qs + r * 264 + cc) = *(const v4u*)(Q + (size_t)(row0 + r) * DM + h * 256 + cc); }
            float acc[64];
#pragma unroll
            for (int n = 0; n < 64; ++n) acc[n] = 0.f;
            for (int cq = 0; cq <= c; ++cq) {
                const int krow0 = b * SEQ + 64 * cq;
                __syncthreads();
#pragma unroll
                for (int i = 0; i < 4; ++i) { const int p = F.tid + 512 * i, r = p >> 5, cc = (p & 31) * 8; *(LAS v4u*)(Ks + r * 264 + cc) = *(const v4u*)(K + (size_t)(krow0 + r) * DM + h * 256 + cc); }
#pragma unroll
                for (int i = 0; i < 8; ++i) { const int p = F.tid + 512 * i, r = p >> 6, cc = (p & 63) * 8; *(LAS v4u*)(Vs + r * 512 + cc) = *(const v4u*)(V + (size_t)(krow0 + r) * 2048 + h * 512 + cc); }
                __syncthreads();
                { float s[8];
#pragma unroll
                  for (int j8 = 0; j8 < 8; ++j8) s[j8] = 0.f;
                  for (int dc = 0; dc < 32; ++dc) {
                      const v4u kv = *(const LAS v4u*)(Ks + F.lane * 264 + dc * 8);
                      const float k0 = bflo(kv.x), k1 = bfhi(kv.x), k2 = bflo(kv.y), k3 = bfhi(kv.y), k4 = bflo(kv.z), k5 = bfhi(kv.z), k6 = bflo(kv.w), k7 = bfhi(kv.w);
#pragma unroll
                      for (int j8 = 0; j8 < 8; ++j8) { const v4u qv = *(const LAS v4u*)(Qs + (8 * F.wave + j8) * 264 + dc * 8);
                          s[j8] += (bflo(qv.x) * k0 + bfhi(qv.x) * k1) + (bflo(qv.y) * k2 + bfhi(qv.y) * k3) + (bflo(qv.z) * k4 + bfhi(qv.z) * k5) + (bflo(qv.w) * k6 + bfhi(qv.w) * k7); }
                  }
                  f32x4 w0, w1;
#pragma unroll
                  for (int j8 = 0; j8 < 8; ++j8) { const float dist = fabsf((float)((64 * c + 8 * F.wave + j8) - (64 * cq + F.lane))); const float val = s[j8] * exp2f(dist * lg2g); if (j8 < 4) w0[j8] = val; else w1[j8 - 4] = val; }
                  *(LAS f32x4*)(St + F.lane * 64 + 8 * F.wave) = w0; *(LAS f32x4*)(St + F.lane * 64 + 8 * F.wave + 4) = w1; }
                __syncthreads();
                for (int m2 = 0; m2 < 64; ++m2) {
                    const float vv = bf2f(Vs[m2 * 512 + F.tid]);
#pragma unroll
                    for (int n4 = 0; n4 < 16; ++n4) { const f32x4 sv = *(const LAS f32x4*)(St + m2 * 64 + 4 * n4); acc[4 * n4 + 0] += sv.x * vv; acc[4 * n4 + 1] += sv.y * vv; acc[4 * n4 + 2] += sv.z * vv; acc[4 * n4 + 3] += sv.w * vv; }
                }
            }
#pragma unroll
            for (int n = 0; n < 64; ++n) { const float p = wave_sum(acc[n] * acc[n]); if (F.lane == 0) wred[F.wave * 64 + n] = p; }
            __syncthreads();
            if (F.tid < 64) { float s = 0.f;
#pragma unroll
                for (int w = 0; w < 8; ++w) s += wred[w * 64 + F.tid];
                rtab[F.tid] = 1.0f / sqrtf(s * (1.0f / 512.f) + EPS); }
            __syncthreads();
#pragma unroll
            for (int n = 0; n < 64; ++n) { const size_t gi = (size_t)(row0 + n) * 2048 + h * 512 + F.tid; const float sg = bf2f(SG[gi]); O[gi] = (bf16)(pk2(acc[n] * rtab[n] * sg, 0.f) & 0xffffu); }
        }
    }
}

typedef short s16x4 __attribute__((ext_vector_type(4)));
__device__ __forceinline__ unsigned off_b(unsigned row, unsigned ch) { return 256u * row + 16u * (ch ^ (((row & 3u) << 2) | ((row >> 2) & 3u))); }
__device__ __forceinline__ bf16x8 row_frag(const LAS unsigned char* tile, unsigned row, unsigned s4, unsigned g) { return *(const LAS bf16x8*)(tile + off_b(row, 4u * s4 + g)); }
__device__ __forceinline__ bf16x8 tr_frag16(const LAS unsigned char* tile, unsigned lane, unsigned c, unsigned ks) {
    const unsigned g = lane >> 4, q = (lane & 15u) >> 2, p = lane & 3u;
    const unsigned a0 = off_b(32u * ks + 8u * g + q, 2u * c + (p >> 1)) + 8u * (p & 1u), a1 = off_b(32u * ks + 8u * g + 4u + q, 2u * c + (p >> 1)) + 8u * (p & 1u);
    const s16x4 lo = __builtin_amdgcn_ds_read_tr16_b64_v4i16((LAS s16x4*)(tile + a0)), hi = __builtin_amdgcn_ds_read_tr16_b64_v4i16((LAS s16x4*)(tile + a1));
    return (bf16x8){lo[0], lo[1], lo[2], lo[3], hi[0], hi[1], hi[2], hi[3]};
}
__device__ __forceinline__ void ret_scan_mfma(Frame& F) {
    relaunder(F);
    const bf16* Q = (const bf16*)(F.ws + WS_R1); const bf16* K = (const bf16*)(F.ws + WS_R1 + 128 * MiB); const bf16* V = (const bf16*)(F.ws + WS_R1 + 256 * MiB);
    bf16* O = (bf16*)(F.ws + WS_R2); float* SS = (float*)(F.ws + WS_R2 + 256 * MiB);
    LAS unsigned char* Qi = F.lds; LAS unsigned char* Ki = F.lds + 32768; LAS unsigned char* Vi = F.lds + 65536; LAS unsigned char* Si = F.lds + 81920;
    const unsigned w = (unsigned)F.wave;
    for (int u = F.vcu; u < NBATCH * RT_H * 4; u += F.G) {
        const int bh = u >> 2, vs = u & 3, b = bh >> 2, h = bh & 3;
        const float lg2g = log2f(1.0f - exp2f(-5.0f - (float)h)), cd = exp2f(64.0f * lg2g);
        f32x4 R[16];
#pragma unroll
        for (int i = 0; i < 16; ++i) R[i] = (f32x4){0.f, 0.f, 0.f, 0.f};
        v4u pq[4], pk[4], pv[2];
        { const int row0 = b * SEQ;
#pragma unroll
          for (int i = 0; i < 4; ++i) { const int p = F.tid + 512 * i, r = p >> 5, c32 = p & 31; pq[i] = *(const v4u*)(Q + (size_t)(row0 + r) * DM + h * 256 + c32 * 8); pk[i] = *(const v4u*)(K + (size_t)(row0 + r) * DM + h * 256 + c32 * 8); }
#pragma unroll
          for (int i = 0; i < 2; ++i) { const int p = F.tid + 512 * i, r = p >> 4, c16 = p & 15; pv[i] = *(const v4u*)(V + (size_t)(row0 + r) * 2048 + h * 512 + vs * 128 + c16 * 8); } }
        for (int c = 0; c < SEQ / 64; ++c) {
            const int row0 = b * SEQ + 64 * c;
            unsigned lane = (unsigned)F.lane; asm volatile("" : "+v"(lane));
            const unsigned g = lane >> 4, li = lane & 15u;
            __syncthreads();
#pragma unroll
            for (int i = 0; i < 4; ++i) { const unsigned p = (unsigned)F.tid + 512u * i, r = p >> 5, c32 = p & 31u; const unsigned o = (c32 >> 4) * 16384u + off_b(r, c32 & 15u); *(LAS v4u*)(Qi + o) = pq[i]; *(LAS v4u*)(Ki + o) = pk[i]; }
#pragma unroll
            for (int i = 0; i < 2; ++i) { const unsigned p = (unsigned)F.tid + 512u * i, r = p >> 4, c16 = p & 15u; *(LAS v4u*)(Vi + off_b(r, c16)) = pv[i]; }
            __syncthreads();
            if (c + 1 < SEQ / 64) { const int rn = row0 + 64;
#pragma unroll
                for (int i = 0; i < 4; ++i) { const int p = F.tid + 512 * i, r = p >> 5, c32 = p & 31; pq[i] = *(const v4u*)(Q + (size_t)(rn + r) * DM + h * 256 + c32 * 8); pk[i] = *(const v4u*)(K + (size_t)(rn + r) * DM + h * 256 + c32 * 8); }
#pragma unroll
                for (int i = 0; i < 2; ++i) { const int p = F.tid + 512 * i, r = p >> 4, c16 = p & 15; pv[i] = *(const v4u*)(V + (size_t)(rn + r) * 2048 + h * 512 + vs * 128 + c16 * 8); } }
            { const unsigned mt = w >> 1;
#pragma unroll
              for (int t2 = 0; t2 < 2; ++t2) { const unsigned nt = 2u * (w & 1u) + t2; f32x4 sa = (f32x4){0.f, 0.f, 0.f, 0.f};
#pragma unroll
                  for (int s8 = 0; s8 < 8; ++s8) { const bf16x8 a = row_frag(Qi + (s8 >> 2) * 16384, 16u * mt + li, s8 & 3, g), bb = row_frag(Ki + (s8 >> 2) * 16384, 16u * nt + li, s8 & 3, g);
                      sa = __builtin_amdgcn_mfma_f32_16x16x32_bf16(a, bb, sa, 0, 0, 0); }
#pragma unroll
                  for (int q = 0; q < 4; ++q) { const int n = (int)(16u * mt + 4u * g) + q, m = (int)(16u * nt + li); const float val = sa[q] * exp2f(fabsf((float)(n - m)) * lg2g);
                      *(LAS unsigned short*)(Si + (unsigned)n * 144u + 2u * (unsigned)m) = (unsigned short)(pk2(val, 0.f) & 0xffffu); } } }
            f32x4 Oa[4];
#pragma unroll
            for (int mt = 0; mt < 4; ++mt) Oa[mt] = (f32x4){0.f, 0.f, 0.f, 0.f};
#pragma unroll
            for (int s8 = 0; s8 < 8; ++s8) {
                const v4u rt = (v4u){pk2(R[2 * s8][0], R[2 * s8][1]), pk2(R[2 * s8][2], R[2 * s8][3]), pk2(R[2 * s8 + 1][0], R[2 * s8 + 1][1]), pk2(R[2 * s8 + 1][2], R[2 * s8 + 1][3])}; const bf16x8 Rb = __builtin_bit_cast(bf16x8, rt);
                const LAS unsigned char* qt = Qi + (s8 >> 2) * 16384; const unsigned s4 = s8 & 3;
#pragma unroll
                for (int mt = 0; mt < 4; ++mt) { const unsigned n = 16u * mt + li;
                    const v2u lo = *(const LAS v2u*)(qt + off_b(n, 4u * s4 + (g >> 1)) + 8u * (g & 1u)), hi = *(const LAS v2u*)(qt + off_b(n, 4u * s4 + 2u + (g >> 1)) + 8u * (g & 1u));
                    const v4u av = (v4u){lo.x, lo.y, hi.x, hi.y};
                    Oa[mt] = __builtin_amdgcn_mfma_f32_16x16x32_bf16(__builtin_bit_cast(bf16x8, av), Rb, Oa[mt], 0, 0, 0); }
                if (s8 & 1) __builtin_amdgcn_sched_barrier(0); }
#pragma unroll
            for (int mt = 0; mt < 4; ++mt)
#pragma unroll
                for (int q = 0; q < 4; ++q) Oa[mt][q] *= exp2f((float)(16 * mt + 4 * (int)g + q + 1) * lg2g);
            __syncthreads();
            bf16x8 Vf[2];
#pragma unroll
            for (int ks = 0; ks < 2; ++ks) Vf[ks] = tr_frag16(Vi, lane, w, ks);
#pragma unroll
            for (int mt = 0; mt < 4; ++mt)
#pragma unroll
                for (int ks = 0; ks < 2; ++ks) { const bf16x8 a = *(const LAS bf16x8*)(Si + (16u * mt + li) * 144u + 64u * ks + 16u * g); Oa[mt] = __builtin_amdgcn_mfma_f32_16x16x32_bf16(a, Vf[ks], Oa[mt], 0, 0, 0); }
            bf16x8 Vd[2];
#pragma unroll
            for (int ks = 0; ks < 2; ++ks) { const v4u vv = __builtin_bit_cast(v4u, Vf[ks]); float f[8];
#pragma unroll
                for (int j = 0; j < 8; ++j) f[j] = exp2f((float)(63 - (32 * ks + 8 * (int)g + j)) * lg2g);
                const v4u sv = (v4u){pk2(bflo(vv.x) * f[0], bfhi(vv.x) * f[1]), pk2(bflo(vv.y) * f[2], bfhi(vv.y) * f[3]), pk2(bflo(vv.z) * f[4], bfhi(vv.z) * f[5]), pk2(bflo(vv.w) * f[6], bfhi(vv.w) * f[7])};
                Vd[ks] = __builtin_bit_cast(bf16x8, sv); }
#pragma unroll
            for (int dt = 0; dt < 16; ++dt) { R[dt] = R[dt] * cd;
#pragma unroll
                for (int ks = 0; ks < 2; ++ks) { const bf16x8 a = tr_frag16(Ki + (dt >> 3) * 16384, lane, dt & 7, ks); R[dt] = __builtin_amdgcn_mfma_f32_16x16x32_bf16(a, Vd[ks], R[dt], 0, 0, 0); }
                if (dt & 1) __builtin_amdgcn_sched_barrier(0); }
#pragma unroll
            for (int mt = 0; mt < 4; ++mt)
#pragma unroll
                for (int q = 0; q < 4; ++q) { const int row = row0 + 16 * mt + 4 * (int)g + q; const float ov = Oa[mt][q];
                    O[(size_t)row * 2048 + h * 512 + vs * 128 + 16 * w + li] = (bf16)(pk2(ov, 0.f) & 0xffffu);
                    float ssq = ov * ov; ssq += __shfl_xor(ssq, 1); ssq += __shfl_xor(ssq, 2); ssq += __shfl_xor(ssq, 4); ssq += __shfl_xor(ssq, 8);
                    if (li == 0) SS[((size_t)row * 4 + h) * 32 + vs * 8 + w] = ssq; }
        }
    }
}
__device__ __forceinline__ void ret_norm(Frame& F) {
    relaunder(F);
    bf16* O = (bf16*)(F.ws + WS_R2); const float* SS = (const float*)(F.ws + WS_R2 + 256 * MiB); const bf16* SG = (const bf16*)(F.ws + WS_R1 + 512 * MiB);
    const int gw = F.vcu * NWAVES + F.wave, NGW = F.G * NWAVES;
    for (int row = gw; row < MTOK; row += NGW) {
        float r[4];
#pragma unroll
        for (int h = 0; h < 4; ++h) { const float p = (F.lane < 32) ? SS[((size_t)row * 4 + h) * 32 + F.lane] : 0.f; r[h] = 1.0f / sqrtf(wave_sum(p) * (1.0f / 512.f) + EPS); }
#pragma unroll
        for (int j = 0; j < 4; ++j) { const size_t gi = (size_t)row * 2048 + 512 * j + 8 * F.lane; const v4u o = *(const v4u*)(O + gi), sg = *(const v4u*)(SG + gi); const float rr = r[j];
            v4u w; w.x = pk2(bflo(o.x) * rr * bflo(sg.x), bfhi(o.x) * rr * bfhi(sg.x)); w.y = pk2(bflo(o.y) * rr * bflo(sg.y), bfhi(o.y) * rr * bfhi(sg.y));
            w.z = pk2(bflo(o.z) * rr * bflo(sg.z), bfhi(o.z) * rr * bfhi(sg.z)); w.w = pk2(bflo(o.w) * rr * bflo(sg.w), bfhi(o.w) * rr * bfhi(sg.w));
            *(v4u*)(O + gi) = w; }
    }
}

__device__ __forceinline__ bf16x8 pad8(s16x4 a) { return (bf16x8){a[0], a[1], a[2], a[3], 0, 0, 0, 0}; }
__device__ __forceinline__ void hgrn_scan_mfma(Frame& F, int j) {
    relaunder(F);
    const bf16* Q = (const bf16*)(F.ws + WS_R1); const bf16* K = (const bf16*)(F.ws + WS_R1 + 128 * MiB); const bf16* V = (const bf16*)(F.ws + WS_R1 + 256 * MiB); const bf16* SG = (const bf16*)(F.ws + WS_R1 + 384 * MiB);
    const float* LF = (const float*)(F.ws + WS_R1 + 512 * MiB); bf16* O = (bf16*)(F.ws + WS_R2);
    LAS unsigned char* QEi = F.lds; LAS unsigned char* QE2i = F.lds + 16384; LAS unsigned char* KEi = F.lds + 32768; LAS unsigned char* Vi = F.lds + 49152;
    LAS float* BL = (LAS float*)(F.lds + 65536); LAS float* OT = (LAS float*)(F.lds + 67584);
    const unsigned w = (unsigned)F.wave;
    for (int u = F.vcu; u < NBATCH * HG_H; u += F.G) {
        const int b = u >> 3, h = u & 7;
        f32x4 S[8];
#pragma unroll
        for (int i = 0; i < 8; ++i) S[i] = (f32x4){0.f, 0.f, 0.f, 0.f};
        float plf[16]; unsigned pqk[16]; v4u pv[2], psg[2];
        { const int kbp = F.tid >> 7, dp = F.tid & 127, row0 = b * SEQ;
#pragma unroll
          for (int t = 0; t < 16; ++t) { const size_t gi = (size_t)(row0 + 16 * kbp + t) * DM + h * 128 + dp; plf[t] = LF[gi]; pqk[t] = (unsigned)Q[gi] | ((unsigned)K[gi] << 16); }
#pragma unroll
          for (int i = 0; i < 2; ++i) { const int p = F.tid + 512 * i, r = p >> 4, c16 = p & 15; pv[i] = *(const v4u*)(V + (size_t)(row0 + r) * DM + h * 128 + c16 * 8); }
#pragma unroll
          for (int i = 0; i < 2; ++i) psg[i] = *(const v4u*)(SG + (size_t)(row0 + (F.tid >> 3)) * DM + h * 128 + 16 * (F.tid & 7) + 8 * i); }
        for (int c = 0; c < SEQ / 64; ++c) {
            const int row0 = b * SEQ + 64 * c;
            unsigned tidl = (unsigned)F.tid; asm volatile("" : "+v"(tidl));
            const unsigned lane = tidl & 63u, g = lane >> 4, li = lane & 15u, kbp = tidl >> 7, dp = tidl & 127u;
            { float bs = 0.f;
#pragma unroll
              for (int t = 0; t < 16; ++t) { bs += plf[t]; plf[t] = bs; }
              const float bl = plf[15];
#pragma unroll
              for (int t = 0; t < 16; ++t) { const float bt = plf[t], q = bflo(pqk[t]), k = bfhi(pqk[t]);
                  const unsigned a = off_b(16u * kbp + t, dp >> 3) + 2u * (dp & 7u);
                  const unsigned w0 = pk2(q * __expf(bt), q * __expf(fminf(bt - bl, 80.f))), w1 = pk2(k * __expf(bl - bt), 0.f);
                  *(LAS unsigned short*)(QEi + a) = (unsigned short)(w0 & 0xffffu); *(LAS unsigned short*)(QE2i + a) = (unsigned short)(w0 >> 16); *(LAS unsigned short*)(KEi + a) = (unsigned short)(w1 & 0xffffu); }
              BL[kbp * 128u + dp] = __expf(bl); }
#pragma unroll
            for (int i = 0; i < 2; ++i) { const unsigned p = tidl + 512u * i, r = p >> 4, c16 = p & 15u; *(LAS v4u*)(Vi + off_b(r, c16)) = pv[i]; }
            const v4u csg0 = psg[0], csg1 = psg[1];
            __syncthreads();
            if (c + 1 < SEQ / 64) { const int rn = row0 + 64;
#pragma unroll
                for (int t = 0; t < 16; ++t) { const size_t gi = (size_t)(rn + 16 * (int)kbp + t) * DM + h * 128 + dp; plf[t] = LF[gi]; pqk[t] = (unsigned)Q[gi] | ((unsigned)K[gi] << 16); }
#pragma unroll
                for (int i = 0; i < 2; ++i) { const unsigned p = tidl + 512u * i, r = p >> 4, c16 = p & 15u; pv[i] = *(const v4u*)(V + (size_t)(rn + (int)r) * DM + h * 128 + c16 * 8); }
#pragma unroll
                for (int i = 0; i < 2; ++i) psg[i] = *(const v4u*)(SG + (size_t)(rn + (int)(tidl >> 3)) * DM + h * 128 + 16 * (tidl & 7u) + 8 * i); }
#pragma unroll 1
            for (unsigned kb = 0; kb < 4; ++kb) {
                const unsigned rowl = 16u * kb + li;
                f32x4 P = (f32x4){0.f, 0.f, 0.f, 0.f};
#pragma unroll
                for (int s4 = 0; s4 < 4; ++s4) P = __builtin_amdgcn_mfma_f32_16x16x32_bf16(row_frag(KEi, rowl, s4, g), row_frag(QE2i, rowl, s4, g), P, 0, 0, 0);
                s16x4 a16;
                { const unsigned lo = pk2((4u * g + 0u <= li) ? P[0] : 0.f, (4u * g + 1u <= li) ? P[1] : 0.f), hi = pk2((4u * g + 2u <= li) ? P[2] : 0.f, (4u * g + 3u <= li) ? P[3] : 0.f); const v2u t2 = (v2u){lo, hi}; a16 = __builtin_bit_cast(s16x4, t2); }
                const unsigned q4 = li >> 2, p4 = li & 3u, trow = 16u * kb + 4u * g + q4;
                const s16x4 Vb = __builtin_amdgcn_ds_read_tr16_b64_v4i16((LAS s16x4*)(Vi + off_b(trow, 2u * w + (p4 >> 1)) + 8u * (p4 & 1u)));
                f32x4 oa = (f32x4){0.f, 0.f, 0.f, 0.f};
#pragma unroll
                for (int s4 = 0; s4 < 4; ++s4) {
                    const v4u st = (v4u){pk2(S[2 * s4][0], S[2 * s4][1]), pk2(S[2 * s4][2], S[2 * s4][3]), pk2(S[2 * s4 + 1][0], S[2 * s4 + 1][1]), pk2(S[2 * s4 + 1][2], S[2 * s4 + 1][3])};
                    const v2u lo = *(const LAS v2u*)(QEi + off_b(rowl, 4u * s4 + (g >> 1)) + 8u * (g & 1u)), hi = *(const LAS v2u*)(QEi + off_b(rowl, 4u * s4 + 2u + (g >> 1)) + 8u * (g & 1u));
                    const v4u av = (v4u){lo.x, lo.y, hi.x, hi.y};
                    oa = __builtin_amdgcn_mfma_f32_16x16x32_bf16(__builtin_bit_cast(bf16x8, av), __builtin_bit_cast(bf16x8, st), oa, 0, 0, 0); }
                oa = __builtin_amdgcn_mfma_f32_16x16x32_bf16(pad8(a16), pad8(Vb), oa, 0, 0, 0);
#pragma unroll
                for (int dt = 0; dt < 8; ++dt) { const f32x4 e4 = *(const LAS f32x4*)(BL + kb * 128u + 16u * dt + 4u * g);
                    const s16x4 kt = __builtin_amdgcn_ds_read_tr16_b64_v4i16((LAS s16x4*)(KEi + off_b(trow, 2u * dt + (p4 >> 1)) + 8u * (p4 & 1u)));
                    S[dt] = __builtin_amdgcn_mfma_f32_16x16x32_bf16(pad8(kt), pad8(Vb), S[dt] * e4, 0, 0, 0); }
#pragma unroll
                for (int q = 0; q < 4; ++q) OT[(16u * kb + 4u * g + q) * 128u + 16u * w + li] = oa[q];
            }
            __syncthreads();
            { const unsigned tn = tidl >> 3, vg = tidl & 7u; f32x4 o[4]; float ss = 0.f;
#pragma unroll
              for (int i = 0; i < 4; ++i) { o[i] = *(const LAS f32x4*)(OT + tn * 128u + 16u * vg + 4u * i); ss += (o[i].x * o[i].x + o[i].y * o[i].y) + (o[i].z * o[i].z + o[i].w * o[i].w); }
              ss += __shfl_xor(ss, 1); ss += __shfl_xor(ss, 2); ss += __shfl_xor(ss, 4);
              const float r = 1.0f / sqrtf(ss * (1.0f / 128.f) + EPS); const float* gp = KIN(I_HGAIN) + j * 128 + 16 * vg;
#pragma unroll
              for (int i = 0; i < 4; ++i) o[i] = o[i] * r * *(const f32x4*)(gp + 4 * i);
              v4u w0, w1;
              w0.x = pk2(o[0].x * bflo(csg0.x), o[0].y * bfhi(csg0.x)); w0.y = pk2(o[0].z * bflo(csg0.y), o[0].w * bfhi(csg0.y)); w0.z = pk2(o[1].x * bflo(csg0.z), o[1].y * bfhi(csg0.z)); w0.w = pk2(o[1].z * bflo(csg0.w), o[1].w * bfhi(csg0.w));
              w1.x = pk2(o[2].x * bflo(csg1.x), o[2].y * bfhi(csg1.x)); w1.y = pk2(o[2].z * bflo(csg1.y), o[2].w * bfhi(csg1.y)); w1.z = pk2(o[3].x * bflo(csg1.z), o[3].y * bfhi(csg1.z)); w1.w = pk2(o[3].z * bflo(csg1.w), o[3].w * bfhi(csg1.w));
              bf16* op = O + (size_t)(row0 + (int)tn) * DM + h * 128 + 16 * vg; *(v4u*)op = w0; *(v4u*)(op + 8) = w1; }
        }
    }
}

struct Args { const void* in[22]; float* out; unsigned char* ws; int ph_lo, ph_hi; };
constexpr int PH_PER_LAYER = 9, NPHASES = 1 + DEPTH * PH_PER_LAYER + 1;

__global__ void __launch_bounds__(NWAVES * 64, 2) hybrid_fwd(Args args) {
    extern __shared__ __attribute__((aligned(16))) unsigned char lds[];
    Frame F;
    F.lds = (LAS unsigned char*)lds;
    F.tid = threadIdx.x; F.lane = F.tid & 63; F.wave = __builtin_amdgcn_readfirstlane(F.tid >> 6);
    F.G = gridDim.x; { const int bx = blockIdx.x; F.vcu = (F.G % 8 == 0) ? (bx % 8) * (F.G / 8) + bx / 8 : bx; }
    F.ws = args.ws; F.out = args.out; F.ctl = (unsigned*)(args.ws + WS_CTL);
    for (int u = F.tid; u < (LDS_BYTES - MISC_OFF) / 4; u += NWAVES * 64) ((LAS unsigned*)(F.lds + MISC_OFF))[u] = 0u;
    __syncthreads();
    const int lo = args.ph_lo, hi = args.ph_hi;
    XcdBarrier bar; bar.bar = F.ctl + CW_BAR; bar.x = 0; bar.st = nullptr;
    if (hi - lo > 1) bar = xcd_barrier_post(F.ctl + CW_BAR, (volatile LAS unsigned*)(F.lds + MISC_OFF) + 8);
#define IN(k) (lo <= (k) && (k) < hi)
#define SEAM(k) do { if (IN(k) && hi > (k) + 1) xcd_barrier(bar); } while (0)

    if (PH_EN(0) && IN(0)) { p0_prologue(F); } SEAM(0);

#pragma unroll 1
    for (int l = 0; l < DEPTH; ++l) {
        const int pb = 1 + l * PH_PER_LAYER, j = l >> 1; const bool is_ret = (l & 1);
        if (PH_EN(1) && IN(pb + 0)) row_phase1(F, l, 0);
        SEAM(pb + 0);
        if (IN(pb + 1)) {
            if (PH_EN(2) && !is_ret) {
                pg8::Gemm g{(const bf16*)(F.ws + WS_H), (const bf16*)(F.ws + WS_HWIN) + (size_t)j * HG_N * DM, MTOK, HG_N, DM}; pg8::StaticOrder S; S.init(MTOK, HG_N, F.G, (int)blockIdx.x);
                EpiHgrnIn E{F.ws + WS_R1, (const float*)(F.ws + WS_LBV) + j * DM};
                pg8::gemm_phase<EpiHgrnIn, pg8::StaticOrder, true, true>(F.lds + RING_OFF, g, S, E);
            } else if (PH_EN(3)) {
                pg8::Gemm g{(const bf16*)(F.ws + WS_H), (const bf16*)(F.ws + WS_RWIN) + (size_t)j * RT_N * DM, MTOK, RT_N, DM}; pg8::StaticOrder S; S.init(MTOK, RT_N, F.G, (int)blockIdx.x);
                EpiRetIn E{F.ws + WS_R1, (const int*)kin_(I_POS)};
                pg8::gemm_phase<EpiRetIn, pg8::StaticOrder, true, true>(F.lds + RING_OFF, g, S, E);
            }
        }
        SEAM(pb + 1);
        if (IN(pb + 2)) { if (!is_ret) { if (PH_EN(4)) { if (HGRN_MFMA) hgrn_scan_mfma(F, j); else hgrn_scan(F, j); } } else { if (PH_EN(5)) { if (RET_MFMA) ret_scan_mfma(F); else ret_scan(F); } } }
        SEAM(pb + 2);
        if (RET_MFMA && PH_EN(12) && IN(pb + 3) && is_ret) ret_norm(F);
        if (RET_MFMA && is_ret) SEAM(pb + 3);
        if (PH_EN(6) && IN(pb + 4)) {
            const int Ko = is_ret ? 2048 : DM;
            const bf16* Wt = is_ret ? (const bf16*)(F.ws + WS_RWOUT) + (size_t)j * DM * 2048 : (const bf16*)(F.ws + WS_HWOUT) + (size_t)j * DM * DM;
            pg8::Gemm g{(const bf16*)(F.ws + WS_R2), Wt, MTOK, DM, Ko}; pg8::StaticOrder S; S.init(MTOK, DM, F.G, (int)blockIdx.x);
            EpiOut E{l == 0 ? KIN(I_X) : F.out, F.out, (const float*)(F.ws + WS_MOD) + (size_t)l * NBATCH * 6 * DM + 2 * DM};
            pg8::gemm_phase<EpiOut, pg8::StaticOrder, true, true>(F.lds + RING_OFF, g, S, E);
        }
        SEAM(pb + 4);
        if (PH_EN(7) && IN(pb + 5)) row_phase2(F, l);
        SEAM(pb + 5);
        if (PH_EN(8) && IN(pb + 6)) moe_gather(F, l);
        SEAM(pb + 6);
        if (PH_EN(9) && IN(pb + 7)) {
            build_tiles(F, l);
            pg8::Gemm g{(const bf16*)(F.ws + WS_R1), (const bf16*)(F.ws + WS_W1T) + (size_t)l * NEXP * 2048 * DM, 0, 0, DM};
            pg8::MoeOrder S{8, F.G, F.vcu, (const LAS int*)(F.lds + TAB_OFF)};
            EpiMoe1 E{(bf16*)(F.ws + WS_R2), KIN(I_B1) + (size_t)l * NEXP * 2048};
            pg8::gemm_phase<EpiMoe1, pg8::MoeOrder, true, true>(F.lds + RING_OFF, g, S, E);
        }
        SEAM(pb + 7);
        if (PH_EN(10) && IN(pb + 8)) {
            build_tiles(F, l);
            pg8::Gemm g{(const bf16*)(F.ws + WS_R2), (const bf16*)(F.ws + WS_W2T) + (size_t)l * NEXP * DM * DM, 0, 0, DM};
            pg8::MoeOrder S{4, F.G, F.vcu, (const LAS int*)(F.lds + TAB_OFF)};
            EpiMoe2 E{(bf16*)(F.ws + WS_R1), KIN(I_B2) + (size_t)l * NEXP * DM};
            pg8::gemm_phase<EpiMoe2, pg8::MoeOrder, true, true>(F.lds + RING_OFF, g, S, E);
        }
        SEAM(pb + 8);
    }
    if (PH_EN(11) && IN(NPHASES - 1)) row_phase1(F, DEPTH, 1);
#undef IN
#undef SEAM
}

extern "C" void kernel_launch(void* const* d_in, const int* in_sizes, int n_in, void* d_out, int out_size, void* d_ws, size_t ws_size, hipStream_t stream) {
    static int grid = 0;
    if (grid == 0) {
        if (n_in != 22 || in_sizes[0] != MTOK * DM || out_size != MTOK * DM || ws_size < WS_END) { fprintf(stderr, "kernel_launch: unexpected shapes (n_in %d, in0 %d, out %d, ws %zu < %zu)\n", n_in, n_in > 0 ? in_sizes[0] : -1, out_size, ws_size, (size_t)WS_END); grid = -1; return; }
        int dev = 0, cus = 0, per_cu = 0;
        if (hipGetDevice(&dev) != hipSuccess || hipDeviceGetAttribute(&cus, hipDeviceAttributeMultiprocessorCount, dev) != hipSuccess) { grid = -1; return; }
        if (hipFuncSetAttribute((const void*)hybrid_fwd, hipFuncAttributeMaxDynamicSharedMemorySize, LDS_BYTES) != hipSuccess) { fprintf(stderr, "kernel_launch: hipFuncSetAttribute failed\n"); grid = -1; return; }
        if (hipOccupancyMaxActiveBlocksPerMultiprocessor(&per_cu, (const void*)hybrid_fwd, NWAVES * 64, LDS_BYTES) != hipSuccess || per_cu < 1) { fprintf(stderr, "kernel_launch: occupancy query says %d blocks per CU\n", per_cu); }
        (void)hipGetLastError();
        grid = cus;
    }
    if (grid < 0) return;
    (void)hipMemsetAsync((char*)d_ws + WS_CTL, 0, CTL_ZERO_BYTES, stream);
    Args a{};
    for (int i = 0; i < 22; ++i) a.in[i] = d_in[i];
    a.out = (float*)d_out; a.ws = (unsigned char*)d_ws;
#if MK_SPLIT
    for (int p = 0; p < DBG_LIMIT; ++p) {
        if (p >= 1 && p < NPHASES - 1 && ((p - 1) % PH_PER_LAYER) == 3 && (!RET_MFMA || (((p - 1) / PH_PER_LAYER) & 1) == 0)) continue;
        a.ph_lo = p; a.ph_hi = p + 1;
        hipLaunchKernelGGL(hybrid_fwd, dim3(grid), dim3(NWAVES * 64), LDS_BYTES, stream, a);
    }
#else
    a.ph_lo = 0; a.ph_hi = NPHASES;
    hipLaunchKernelGGL(hybrid_fwd, dim3(grid), dim3(NWAVES * 64), LDS_BYTES, stream, a);
#endif
    const hipError_t le = hipPeekAtLastError();
    if (le != hipSuccess) fprintf(stderr, "kernel_launch: launch failed: %s\n", hipGetErrorName(le));
}
```

```cpp
#include <hip/hip_runtime.h>
#include <cstdio>
#include <cstdint>

#ifndef ONLY_PH
#define ONLY_PH -1
#endif
#define PH_EN(n) (ONLY_PH < 0 || ONLY_PH == (n))
#ifndef DBG_LIMIT
#define DBG_LIMIT NPHASES
#endif
#ifndef RET_MFMA
#define RET_MFMA 1
#endif
#ifndef HGRN_MFMA
#define HGRN_MFMA 1
#endif
#ifndef REPEAT_MASK
#define REPEAT_MASK 0
#endif
#define REPS(k) (1 + ((REPEAT_MASK >> (k)) & 1))
#ifndef MOE_GATHER_PASS
#define MOE_GATHER_PASS 0
#endif
#ifndef MK_SPLIT
#define MK_SPLIT 0
#endif

namespace pg8 {
#define PG8_LAS __attribute__((address_space(3)))
typedef unsigned short bf16_t;
typedef short bf16x8 __attribute__((ext_vector_type(8)));
typedef float f32x4 __attribute__((ext_vector_type(4)));
typedef unsigned u32x4 __attribute__((ext_vector_type(4)));
constexpr int BM = 256, BK = 64, HALF = 128, HTB = HALF * BK * 2  , STAGE_BYTES = 8 * HTB, NXCD = 8, WGM = 8;

__host__ __device__ __forceinline__ int lds_byte(int r, int c) { const int st = (r >> 4) * 2 + (c >> 5), rr = r & 15, cc = c & 31, ob = rr * 64 + cc * 2; return st * 1024 + (ob ^ (((ob >> 9) & 1) << 5)); }
__host__ __device__ __forceinline__ void stage_rc(int b, int& R, int& C) { const int st = b / 1024, sb = b % 1024, swz = sb ^ (((sb >> 9) & 1) << 5); R = (st >> 1) * 16 + swz / 64; C = (st & 1) * 32 + (swz % 64) / 2; }
__host__ __device__ __forceinline__ int perm32(int rho) { const int n = rho >> 4, i = rho & 15; return 8 * (i >> 2) + 4 * n + (i & 3); }

struct Unit { int pm, pn, e, nn; };
struct Gemm { const bf16_t* A; const bf16_t* Bt; int M, N, K; };

struct StaticOrder {
    int nM, nN, nwg, G, c;
    __host__ __device__ void init(int M, int N, int G_, int c_) { nM = M / BM; nN = N / BM; nwg = nM * nN; G = G_; c = c_; }
    __host__ __device__ bool next(int i, Unit& u) const {
        const long L = (long)i * G + c; if (L >= nwg) return false;
        int wgid = (int)L; { const int q = nwg / NXCD, r = nwg % NXCD, xcd = wgid % NXCD, off = wgid / NXCD; wgid = (xcd < r ? xcd * (q + 1) : r * (q + 1) + (xcd - r) * q) + off; }
        const int nig = WGM * nN, gid = wgid / nig, fm = gid * WGM, gsz = (nM - fm) < WGM ? (nM - fm) : WGM;
        u.pm = fm + ((wgid % nig) % gsz); u.pn = (wgid % nig) / gsz; u.e = 0; u.nn = u.pn; return true;
    }
    __device__ __forceinline__ unsigned tok(int, int) const { return 0u; }
    __device__ __forceinline__ void a_ready(const Unit&) const {}
    __device__ __forceinline__ void done(const Unit&) const {}
};
struct MoeOrder {
    int nN, G, c; const PG8_LAS int* ts; const PG8_LAS unsigned short* tt;
    __device__ __forceinline__ unsigned tok(int i, int r) const { return tt[i * 256 + r]; }
    __device__ __forceinline__ bool next(int i, Unit& u) const {
        const int NT = ts[32]; const long L = (long)i * G + c; if (L >= (long)NT * nN) return false;
        const int mt = (int)(L / nN), n = (int)(L % nN); int e = 0;
        for (int k = 1; k < 32; ++k) e += (ts[k] <= mt) ? 1 : 0;
        u.pm = mt; u.pn = e * nN + n; u.e = e; u.nn = n; return true;
    }
    __device__ __forceinline__ void a_ready(const Unit&) const {}
    __device__ __forceinline__ void done(const Unit&) const {}
};

__device__ __forceinline__ unsigned cvt_pk_bf16(float lo, float hi) { unsigned r; asm volatile("v_cvt_pk_bf16_f32 %0, %1, %2" : "=v"(r) : "v"(lo), "v"(hi)); return r; }

template <class Epi, class Sched, bool ALIGN_EPI = false, bool SP2 = false, bool GATHER = false>
__device__ __forceinline__ void gemm_phase(PG8_LAS unsigned char* lds, const Gemm g, const Sched& S, const Epi& E) {
    int tid_ = threadIdx.x; asm volatile("" : "+v"(tid_));
    const int tid = tid_, wid = __builtin_amdgcn_readfirstlane(tid >> 6), lane = tid & 63, wr = wid >> 2, wc = wid & 3, fr = lane & 15, fq = lane >> 4;
    const int K = g.K, nt = K / BK;
    unsigned voffA[2], voffB[2];
#pragma unroll
    for (int i = 0; i < 2; ++i) { int R, C; stage_rc(tid * 16 + i * 8192, R, C); const int Rb = Epi::PERM ? ((R & ~31) + perm32(R & 31)) : R;
        voffA[i] = (unsigned)(R * K + C) * 2u; voffB[i] = (unsigned)(Rb * K + C) * 2u; }
    int gR[2]; unsigned gC[2];
#pragma unroll
    for (int i = 0; i < 2; ++i) { int R, C; stage_rc(tid * 16 + i * 8192, R, C); gR[i] = R; gC[i] = (unsigned)C * 2u; }
#define PG8_GVOFF(v, ui_, h_) do { _Pragma("unroll") for (int _i = 0; _i < 2; ++_i) v[_i] = (S.tok((ui_), gR[_i] + HALF * (h_)) * (unsigned)(K * 2)) + gC[_i]; } while (0)
    const size_t kstep = (size_t)(BK * 2);
    const size_t hstep = (size_t)HALF * K * 2;
    const size_t tstep = 2 * hstep;
    const unsigned ldsw = (unsigned)wid * 1024u;
    const int aoff = lds_byte(wr * 64 + fr, fq * 8), boff = lds_byte(wc * 32 + fr, fq * 8);
#define PG8_SA(b, h) (((b) * 2 + (h)) * HTB)
#define PG8_SB(b, h) ((4 + (b) * 2 + (h)) * HTB)
#define PG8_STAGE(bufoff, gbase, voff) do { _Pragma("unroll") for (int _i = 0; _i < 2; ++_i) \
        __builtin_amdgcn_global_load_lds((const unsigned*)((const char*)(gbase) + (voff)[_i]), (PG8_LAS unsigned*)(lds + (bufoff) + ldsw + _i * 8192), 16, 0, 0); } while (0)
#define PG8_LDA(dst, b, h) do { _Pragma("unroll") for (int m = 0; m < 4; ++m) _Pragma("unroll") for (int k = 0; k < 2; ++k) dst[m][k] = *(const PG8_LAS bf16x8*)(lds + PG8_SA(b, h) + aoff + m * 2048 + k * 1024); } while (0)
#define PG8_LDB(dst, b, h) do { _Pragma("unroll") for (int n = 0; n < 2; ++n) _Pragma("unroll") for (int k = 0; k < 2; ++k) dst[n][k] = *(const PG8_LAS bf16x8*)(lds + PG8_SB(b, h) + boff + n * 2048 + k * 1024); } while (0)
#define PG8_MMA(ai, bj, At, Bt) do { __builtin_amdgcn_s_setprio(1); _Pragma("unroll") for (int m = 0; m < 4; ++m) _Pragma("unroll") for (int n = 0; n < 2; ++n) _Pragma("unroll") for (int k = 0; k < 2; ++k) \
        acc[ai][bj][m][n] = __builtin_amdgcn_mfma_f32_16x16x32_bf16(Bt[n][k], At[m][k], acc[ai][bj][m][n], 0, 0, 0); __builtin_amdgcn_s_setprio(0); } while (0)
#define PG8_WAIT_V(n) asm volatile("s_waitcnt vmcnt(" #n ")" ::: "memory")
#define PG8_WAIT_L(n) asm volatile("s_waitcnt lgkmcnt(" #n ")" ::: "memory")
#define PG8_BAR __builtin_amdgcn_s_barrier()
#define PG8_SCHED __builtin_amdgcn_sched_barrier(0)
    Unit cur, nxt; int ui = 0;
    if (!S.next(0, cur)) return;
    f32x4 acc[2][2][4][2];
#pragma unroll
    for (int a = 0; a < 2; ++a)
#pragma unroll
        for (int b = 0; b < 2; ++b)
#pragma unroll
            for (int m = 0; m < 4; ++m)
#pragma unroll
                for (int n = 0; n < 2; ++n) acc[a][b][m][n] = (f32x4){0.f, 0.f, 0.f, 0.f};
    bf16x8 At[4][2], B0[2][2], B1[2][2];
    const char* cA = GATHER ? (const char*)g.A : (const char*)g.A + (size_t)cur.pm * tstep; const char* cB = (const char*)g.Bt + (size_t)cur.pn * tstep;
    S.a_ready(cur);
    static_assert(!GATHER || SP2, "GATHER is written for the SP2 loop");
    if constexpr (SP2) {
        if constexpr (GATHER) { unsigned v0[2], v1[2]; PG8_GVOFF(v0, 0, 0); PG8_GVOFF(v1, 0, 1); PG8_STAGE(PG8_SB(0, 0), cB, voffB); PG8_STAGE(PG8_SB(0, 1), cB + hstep, voffB); PG8_STAGE(PG8_SA(0, 0), cA, v0); PG8_STAGE(PG8_SA(0, 1), cA, v1); }
        else { PG8_STAGE(PG8_SB(0, 0), cB, voffB); PG8_STAGE(PG8_SB(0, 1), cB + hstep, voffB); PG8_STAGE(PG8_SA(0, 0), cA, voffA); PG8_STAGE(PG8_SA(0, 1), cA + hstep, voffA); }
        if (wr == 1) PG8_BAR;
        PG8_WAIT_V(2); PG8_BAR;
        if constexpr (GATHER) { unsigned v0[2]; PG8_GVOFF(v0, 0, 0); PG8_STAGE(PG8_SB(1, 0), cB + kstep, voffB); PG8_STAGE(PG8_SA(1, 0), cA + kstep, v0); PG8_STAGE(PG8_SB(1, 1), cB + hstep + kstep, voffB); }
        else { PG8_STAGE(PG8_SB(1, 0), cB + kstep, voffB); PG8_STAGE(PG8_SA(1, 0), cA + kstep, voffA); PG8_STAGE(PG8_SB(1, 1), cB + hstep + kstep, voffB); }
        PG8_WAIT_V(6); PG8_BAR;
    } else {
        PG8_STAGE(PG8_SB(0, 0), cB, voffB); PG8_STAGE(PG8_SA(0, 0), cA, voffA); PG8_STAGE(PG8_SB(0, 1), cB + hstep, voffB); PG8_STAGE(PG8_SA(0, 1), cA + hstep, voffA);
        if (wr == 1) PG8_BAR;
        PG8_WAIT_V(4); PG8_BAR;
        PG8_STAGE(PG8_SB(1, 0), cB + kstep, voffB); PG8_STAGE(PG8_SA(1, 0), cA + kstep, voffA); PG8_STAGE(PG8_SB(1, 1), cB + hstep + kstep, voffB);
        PG8_WAIT_V(6); PG8_BAR;
    }
    for (;;) {
        const bool has_next = S.next(ui + 1, nxt);
        const char* nA = GATHER ? cA : (has_next ? (const char*)g.A + (size_t)nxt.pm * tstep : cA); const char* nB = has_next ? (const char*)g.Bt + (size_t)nxt.pn * tstep : cB;
        for (int t = 0; t < nt; t += 2) {
            const bool last = (t == nt - 2);
            const char* a1 = cA + (size_t)(t + 1) * kstep;
            const char* a2 = last ? nA : cA + (size_t)(t + 2) * kstep; const char* b2 = last ? nB : cB + (size_t)(t + 2) * kstep;
            const char* a3 = a2 + kstep; const char* b3 = b2 + kstep;
            if (last && has_next) S.a_ready(nxt);
            if constexpr (SP2 && GATHER) {
            const int uix = (last && has_next) ? ui + 1 : ui;
            unsigned vc1[2], vx0[2], vx1[2]; PG8_GVOFF(vc1, ui, 1); PG8_GVOFF(vx0, uix, 0); PG8_GVOFF(vx1, uix, 1);
            PG8_LDB(B0, 0, 0); PG8_LDB(B1, 0, 1); PG8_SCHED; PG8_LDA(At, 0, 0); PG8_STAGE(PG8_SA(1, 1), a1, vc1);
            PG8_WAIT_V(8); PG8_WAIT_L(0); PG8_BAR; PG8_MMA(0, 0, At, B0); PG8_MMA(0, 1, At, B1); PG8_BAR; PG8_SCHED;
            PG8_LDA(At, 0, 1); PG8_STAGE(PG8_SB(0, 0), b2, voffB); PG8_STAGE(PG8_SB(0, 1), b2 + hstep, voffB); PG8_STAGE(PG8_SA(0, 0), a2, vx0);
            PG8_WAIT_V(8); PG8_WAIT_L(0); PG8_BAR; PG8_MMA(1, 0, At, B0); PG8_MMA(1, 1, At, B1); PG8_BAR; PG8_SCHED;
            PG8_LDB(B0, 1, 0); PG8_LDB(B1, 1, 1); PG8_SCHED; PG8_LDA(At, 1, 0); PG8_STAGE(PG8_SA(0, 1), a2, vx1);
            PG8_WAIT_V(8); PG8_WAIT_L(0); PG8_BAR; PG8_MMA(0, 0, At, B0); PG8_MMA(0, 1, At, B1); PG8_BAR; PG8_SCHED;
            PG8_LDA(At, 1, 1); PG8_STAGE(PG8_SB(1, 0), b3, voffB); PG8_STAGE(PG8_SB(1, 1), b3 + hstep, voffB); PG8_STAGE(PG8_SA(1, 0), a3, vx0);
            PG8_WAIT_V(8); PG8_WAIT_L(0); PG8_BAR; PG8_MMA(1, 0, At, B0); PG8_MMA(1, 1, At, B1); PG8_BAR; PG8_SCHED;
            } else if constexpr (SP2) {
            PG8_LDB(B0, 0, 0); PG8_LDB(B1, 0, 1); PG8_SCHED; PG8_LDA(At, 0, 0); PG8_STAGE(PG8_SA(1, 1), a1 + hstep, voffA);
            PG8_WAIT_V(8); PG8_WAIT_L(0); PG8_BAR; PG8_MMA(0, 0, At, B0); PG8_MMA(0, 1, At, B1); PG8_BAR; PG8_SCHED;
            PG8_LDA(At, 0, 1); PG8_STAGE(PG8_SB(0, 0), b2, voffB); PG8_STAGE(PG8_SB(0, 1), b2 + hstep, voffB); PG8_STAGE(PG8_SA(0, 0), a2, voffA);
            PG8_WAIT_V(8); PG8_WAIT_L(0); PG8_BAR; PG8_MMA(1, 0, At, B0); PG8_MMA(1, 1, At, B1); PG8_BAR; PG8_SCHED;
            PG8_LDB(B0, 1, 0); PG8_LDB(B1, 1, 1); PG8_SCHED; PG8_LDA(At, 1, 0); PG8_STAGE(PG8_SA(0, 1), a2 + hstep, voffA);
            PG8_WAIT_V(8); PG8_WAIT_L(0); PG8_BAR; PG8_MMA(0, 0, At, B0); PG8_MMA(0, 1, At, B1); PG8_BAR; PG8_SCHED;
            PG8_LDA(At, 1, 1); PG8_STAGE(PG8_SB(1, 0), b3, voffB); PG8_STAGE(PG8_SB(1, 1), b3 + hstep, voffB); PG8_STAGE(PG8_SA(1, 0), a3, voffA);
            PG8_WAIT_V(8); PG8_WAIT_L(0); PG8_BAR; PG8_MMA(1, 0, At, B0); PG8_MMA(1, 1, At, B1); PG8_BAR; PG8_SCHED;
            } else {
            PG8_LDB(B0, 0, 0); PG8_SCHED; PG8_LDA(At, 0, 0); PG8_STAGE(PG8_SA(1, 1), a1 + hstep, voffA);
            PG8_WAIT_L(8); PG8_BAR; PG8_WAIT_L(0); PG8_MMA(0, 0, At, B0); PG8_BAR; PG8_SCHED;
            PG8_LDB(B1, 0, 1); PG8_STAGE(PG8_SB(0, 0), b2, voffB);
            PG8_BAR; PG8_WAIT_L(0); PG8_MMA(0, 1, At, B1); PG8_BAR;
            PG8_LDA(At, 0, 1); PG8_STAGE(PG8_SA(0, 0), a2, voffA);
            PG8_BAR; PG8_WAIT_L(0); PG8_MMA(1, 0, At, B0); PG8_BAR; PG8_SCHED;
            PG8_STAGE(PG8_SB(0, 1), b2 + hstep, voffB);
            PG8_WAIT_V(6); PG8_BAR; PG8_MMA(1, 1, At, B1); PG8_BAR;
            PG8_LDB(B0, 1, 0); PG8_SCHED; PG8_LDA(At, 1, 0); PG8_STAGE(PG8_SA(0, 1), a2 + hstep, voffA);
            PG8_WAIT_L(8); PG8_BAR; PG8_WAIT_L(0); PG8_MMA(0, 0, At, B0); PG8_BAR; PG8_SCHED;
            PG8_LDB(B1, 1, 1); PG8_STAGE(PG8_SB(1, 0), b3, voffB);
            PG8_BAR; PG8_WAIT_L(0); PG8_MMA(0, 1, At, B1); PG8_BAR;
            PG8_LDA(At, 1, 1); PG8_STAGE(PG8_SA(1, 0), a3, voffA);
            PG8_BAR; PG8_WAIT_L(0); PG8_MMA(1, 0, At, B0); PG8_BAR; PG8_SCHED;
            PG8_STAGE(PG8_SB(1, 1), b3 + hstep, voffB);
            PG8_WAIT_V(6); PG8_BAR; PG8_MMA(1, 1, At, B1); PG8_BAR;
            }
        }
        if constexpr (ALIGN_EPI) { if (wr == 0) PG8_BAR; }
        E(acc, cur, wr, wc, fr, fq);
        if (!has_next) break;
#pragma unroll
        for (int a = 0; a < 2; ++a)
#pragma unroll
            for (int b = 0; b < 2; ++b)
#pragma unroll
                for (int m = 0; m < 4; ++m)
#pragma unroll
                    for (int n = 0; n < 2; ++n) acc[a][b][m][n] = (f32x4){0.f, 0.f, 0.f, 0.f};
        cur = nxt; cA = nA; cB = nB; ++ui;
        if constexpr (ALIGN_EPI) { if (wr == 1) PG8_BAR; }
    }
    PG8_WAIT_V(0);
    if constexpr (!ALIGN_EPI) { if (wr == 0) PG8_BAR; }
    PG8_BAR;
#undef PG8_GVOFF
#undef PG8_SA
#undef PG8_SB
#undef PG8_STAGE
#undef PG8_LDA
#undef PG8_LDB
#undef PG8_MMA
#undef PG8_WAIT_V
#undef PG8_WAIT_L
#undef PG8_BAR
#undef PG8_SCHED
}
}

constexpr int NWAVES = 8;
constexpr int DM = 1024, NBATCH = 32, SEQ = 2048, MTOK = NBATCH * SEQ, DEPTH = 4, NEXP = 32, TOPK = 4;
constexpr int HG_N = 4096, RT_N = 6144, HG_H = 8, RT_H = 4;
constexpr float EPS = 1e-6f;
constexpr int LCAP = 65536;
constexpr int MAXTILES = 1056;

constexpr size_t MiB = 1u << 20;
constexpr size_t WS_CTL = 0, CTL_ZERO_BYTES = 1 * MiB;
constexpr size_t WS_MOD = 1 * MiB;
constexpr size_t WS_FMOD = 4 * MiB;
constexpr size_t WS_LBV = 4 * MiB + 512 * 1024;
constexpr size_t WS_HWIN = 8 * MiB, WS_HWOUT = 24 * MiB, WS_RWIN = 28 * MiB, WS_RWOUT = 52 * MiB, WS_W1T = 64 * MiB, WS_W2T = 576 * MiB;
constexpr size_t WS_H = 832 * MiB;
constexpr size_t WS_LIST = 960 * MiB;
constexpr size_t WS_TSLOT = 968 * MiB, WS_TGATE = 969 * MiB;
constexpr size_t WS_R1 = 976 * MiB;
constexpr size_t WS_R2 = 1744 * MiB;
constexpr size_t WS_END = 2272 * MiB;
constexpr int CW_BAR = 4096;
constexpr int CW_CNT = 8192;

constexpr int RING_OFF = 0, RING_BYTES = 131072;
constexpr int MISC_OFF = 155648;
constexpr int TAB_OFF = MISC_OFF + 128;
constexpr int LDS_BYTES = 160 * 1024;

#define GAS __attribute__((address_space(1)))
#define LAS __attribute__((address_space(3)))
typedef unsigned short bf16;
typedef unsigned v4u __attribute__((ext_vector_type(4)));
typedef unsigned v2u __attribute__((ext_vector_type(2)));
typedef float f32x4 __attribute__((ext_vector_type(4)));
typedef short bf16x8 __attribute__((ext_vector_type(8)));
#define RLX_AGENT __ATOMIC_RELAXED, __HIP_MEMORY_SCOPE_AGENT
#define LDS_WAIT() asm volatile("s_waitcnt lgkmcnt(0)" ::: "memory")
#define VM_WAIT() asm volatile("s_waitcnt vmcnt(0)" ::: "memory")
__device__ __forceinline__ unsigned pk2(float lo, float hi) { return pg8::cvt_pk_bf16(lo, hi); }
__device__ __forceinline__ float bflo(unsigned w) { return __uint_as_float(w << 16); }
__device__ __forceinline__ float bfhi(unsigned w) { return __uint_as_float(w & 0xffff0000u); }
__device__ __forceinline__ float bf2f(unsigned short h) { return __uint_as_float(((unsigned)h) << 16); }
__device__ __forceinline__ float sigmoidf_(float x) { return __builtin_amdgcn_rcpf(1.f + __expf(-x)); }
__device__ __forceinline__ float siluf_(float x) { return x * sigmoidf_(x); }
__device__ __forceinline__ unsigned ldu_vec(const unsigned* p) { return __hip_atomic_load(p, RLX_AGENT); }

#define XB_TMO      128
#define XB_XCNT(j)  (256  + 64 * (j))
#define XB_XSUB(j)  (1280 + 64 * (j))
#define XB_XGEN(j)  (2304 + 64 * (j))
#define XB_TOP      3328
#define XB_TOPGEN   3392
#define XCD_BAR_WORDS 3456
#define XB_SPIN_CAP (1u << 18)

__device__ __forceinline__ unsigned xb_ld(unsigned* p)              { return __hip_atomic_load(p, __ATOMIC_RELAXED, __HIP_MEMORY_SCOPE_AGENT); }
__device__ __forceinline__ unsigned xb_add(unsigned* p, unsigned v) { return __hip_atomic_fetch_add(p, v, __ATOMIC_RELAXED, __HIP_MEMORY_SCOPE_AGENT); }
__device__ __forceinline__ unsigned xb_xcc_id() { return (unsigned)__builtin_amdgcn_s_getreg((3 << 11) | 20) & 0xFu; }
#define XB_SPIN(cond, bar) do { unsigned _sp = 0; while (cond) { __builtin_amdgcn_s_sleep(1); \
    if ((++_sp & 255u) == 0u) { if (xb_ld(&(bar)[XB_TMO])) break; if (_sp > XB_SPIN_CAP) { atomicAdd(&(bar)[XB_TMO], 1u); break; } } } } while (0)

struct XcdBarrier {
    unsigned* bar; unsigned x;
    volatile LAS unsigned* st;
};
__device__ __forceinline__ XcdBarrier xcd_barrier_post(unsigned* bar, volatile LAS unsigned* st) {
    XcdBarrier b; b.bar = bar; b.x = xb_xcc_id(); b.st = st;
    if (threadIdx.x == 0) (void)xb_add(&bar[XB_XCNT(b.x)], 1u);
    return b;
}
__device__ __forceinline__ void xcd_barrier_complete(unsigned* bar, unsigned x, unsigned& nloc, unsigned& nx) {
    const unsigned G = gridDim.x * gridDim.y * gridDim.z;
    unsigned sum, cnt, mine, sp = 0u;
    for (;;) {
        sum = 0u; cnt = 0u; mine = 0u;
#pragma unroll
        for (unsigned j = 0; j < 16; ++j) { const unsigned c = xb_ld(&bar[XB_XCNT(j)]); sum += c; cnt += (c > 0u) ? 1u : 0u; mine = (j == x) ? c : mine; }
        if (sum == G) break;
        __builtin_amdgcn_s_sleep(1);
        if ((++sp & 255u) == 0u) { if (xb_ld(&bar[XB_TMO])) break; if (sp > XB_SPIN_CAP) { atomicAdd(&bar[XB_TMO], 1u); break; } }
    }
    nloc = mine > 0u ? mine : 1u; nx = cnt > 0u ? cnt : 1u;
}
__device__ __forceinline__ void xcd_barrier(const XcdBarrier& b) {
    asm volatile("s_waitcnt vmcnt(0)" ::: "memory");
    __syncthreads();
    if (threadIdx.x == 0) {
        unsigned* bar = b.bar;
        __builtin_amdgcn_s_waitcnt(0);
        unsigned nloc = b.st[0], nx = b.st[1];
        if (nloc == 0u) { xcd_barrier_complete(bar, b.x, nloc, nx); b.st[0] = nloc; b.st[1] = nx; }
        const unsigned old = xb_add(&bar[XB_XSUB(b.x)], 1u);
        const unsigned gen = old / nloc;
        if (old + 1u == (gen + 1u) * nloc) {
            __builtin_amdgcn_fence(__ATOMIC_RELEASE, "agent");
            asm volatile("s_waitcnt vmcnt(0)" ::: "memory");
            const unsigned og = xb_add(&bar[XB_TOP], 1u);
            const unsigned tg = og / nx;
            if (og + 1u == (tg + 1u) * nx) xb_add(&bar[XB_TOPGEN], 1u);
            else XB_SPIN(xb_ld(&bar[XB_TOPGEN]) == tg, bar);
            __builtin_amdgcn_fence(__ATOMIC_ACQUIRE, "agent");
            xb_add(&bar[XB_XGEN(b.x)], 1u);
            asm volatile("s_waitcnt vmcnt(0)" ::: "memory");
        } else {
            XB_SPIN(xb_ld(&bar[XB_XGEN(b.x)]) == gen, bar);
            __builtin_amdgcn_fence(__ATOMIC_ACQUIRE, "agent");
            asm volatile("s_waitcnt vmcnt(0)" ::: "memory");
        }
    }
    __syncthreads();
}

struct Frame {
    LAS unsigned char* lds;
    unsigned* ctl;
    int tid, lane, wave, vcu, G;
    float* out; unsigned char* ws;
};
__device__ __forceinline__ void relaunder(Frame& F) { int t = threadIdx.x; asm volatile("" : "+v"(t)); F.tid = t; F.lane = t & 63; F.wave = __builtin_amdgcn_readfirstlane(t >> 6); }
#define KAS __attribute__((address_space(4)))
__device__ __forceinline__ const void* kin_(int i) { const KAS char* kp = (const KAS char*)__builtin_amdgcn_kernarg_segment_ptr(); asm volatile("" : "+s"(kp)); return *(const void* const KAS*)(kp + 8 * i); }
enum { I_X = 0, I_C, I_POS, I_ADAW, I_ADAB, I_N1G, I_N2G, I_HWIN, I_HWOUT, I_HGAIN, I_HLB, I_RWIN, I_RWOUT, I_RTW, I_RTB, I_W1, I_B1, I_W2, I_B2, I_FG, I_FADAW, I_FADAB };
#define KIN(i) ((const float*)kin_(i))
__device__ __forceinline__ float wave_sum(float v) {
#pragma unroll
    for (int o = 1; o < 64; o <<= 1) v += __shfl_xor(v, o);
    return v;
}

__device__ __forceinline__ void p0_transpose_item(const float* W, int N, bf16* WT, int K, int k0, int n0, int drow0, LAS float* scr, int lane) {
#pragma unroll 8
    for (int i = 0; i < 32; ++i) { const int kk = 2 * i + (lane >> 5); scr[kk * 33 + (lane & 31)] = W[(size_t)(k0 + kk) * N + n0 + (lane & 31)]; }
    LDS_WAIT(); asm volatile("" ::: "memory");
    const int c = lane & 7;
#pragma unroll
    for (int j = 0; j < 4; ++j) { const int n = (lane >> 3) + 8 * j; const LAS float* s = scr + (8 * c) * 33 + n;
        v4u o; o.x = pk2(s[0 * 33], s[1 * 33]); o.y = pk2(s[2 * 33], s[3 * 33]); o.z = pk2(s[4 * 33], s[5 * 33]); o.w = pk2(s[6 * 33], s[7 * 33]);
        *(GAS v4u*)(WT + (size_t)(drow0 + n) * K + k0 + 8 * c) = o; }
    LDS_WAIT(); asm volatile("" ::: "memory");
}
__device__ __forceinline__ void p0_prologue(Frame& F) {
    relaunder(F);
    __syncthreads();
    const int gw = F.vcu * NWAVES + F.wave, NGW = F.G * NWAVES;
    {
        LAS float* condT = (LAS float*)(F.lds + RING_OFF);
        const float* cin = KIN(I_C);
        for (int idx = F.tid; idx < NBATCH * DM; idx += NWAVES * 64) { const int b = idx >> 10, k = idx & 1023; condT[k * 32 + b] = siluf_(cin[idx]); }
        __syncthreads();
        if ((gw & 3) == 0 && (gw >> 2) < 416) {
            const int u = gw >> 2; const float* W; const float* bias; float* outp; int N, n0, ostride;
            if (u < 384) { const int l = u / 96; n0 = (u % 96) * 64; N = 6 * DM; W = KIN(I_ADAW) + (size_t)l * DM * N; bias = KIN(I_ADAB) + l * N; outp = (float*)(F.ws + WS_MOD) + (size_t)l * NBATCH * N; ostride = N; }
            else { n0 = (u - 384) * 64; N = 2 * DM; W = KIN(I_FADAW); bias = KIN(I_FADAB); outp = (float*)(F.ws + WS_FMOD); ostride = N; }
            float acc[32];
#pragma unroll
            for (int b = 0; b < 32; ++b) acc[b] = 0.f;
#pragma unroll 4
            for (int k = 0; k < DM; ++k) {
                const float w = W[(size_t)k * N + n0 + F.lane];
                const LAS f32x4* cb = (const LAS f32x4*)(condT + k * 32);
#pragma unroll
                for (int q = 0; q < 8; ++q) { const f32x4 cv = cb[q]; acc[4 * q + 0] += cv.x * w; acc[4 * q + 1] += cv.y * w; acc[4 * q + 2] += cv.z * w; acc[4 * q + 3] += cv.w * w; }
            }
            const float bv = bias[n0 + F.lane];
#pragma unroll
            for (int b = 0; b < 32; ++b) outp[(size_t)b * ostride + n0 + F.lane] = acc[b] + bv;
        }
        if (gw == NGW - 1) {
            float* lbv = (float*)(F.ws + WS_LBV); const float* hlb = KIN(I_HLB);
            for (int d = F.lane; d < DM; d += 64) { const float a = hlb[d], b = hlb[DM + d], m = fmaxf(a, b), ea = __expf(a - m), eb = __expf(b - m); lbv[d] = 0.f; lbv[DM + d] = eb / (ea + eb); }
        }
        __syncthreads();
    }
    {
        LAS float* scr = (LAS float*)(F.lds + RING_OFF + F.wave * 16384);
        constexpr int NI_HI = 2 * 16 * 128, NI_HO = 2 * 16 * 32, NI_RI = 2 * 16 * 192, NI_RO = 2 * 32 * 32, NI_W1 = 128 * 16 * 64, NI_W2 = 128 * 16 * 32;
        constexpr int NITEMS = NI_HI + NI_HO + NI_RI + NI_RO + NI_W1 + NI_W2;
        for (int it = gw; it < NITEMS; it += NGW) {
            int r = it;
            if (r < NI_HI) { const int j = r / 2048, q = r % 2048, kb = q / 128, nb = q % 128;
                p0_transpose_item(KIN(I_HWIN) + (size_t)j * DM * HG_N, HG_N, (bf16*)(F.ws + WS_HWIN) + (size_t)j * HG_N * DM, DM, 64 * kb, 32 * nb, 32 * nb, scr, F.lane); continue; } r -= NI_HI;
            if (r < NI_HO) { const int j = r / 512, q = r % 512, kb = q / 32, nb = q % 32;
                p0_transpose_item(KIN(I_HWOUT) + (size_t)j * DM * DM, DM, (bf16*)(F.ws + WS_HWOUT) + (size_t)j * DM * DM, DM, 64 * kb, 32 * nb, 32 * nb, scr, F.lane); continue; } r -= NI_HO;
            if (r < NI_RI) { const int j = r / 3072, q = r % 3072, kb = q / 192, nb = q % 192;
                p0_transpose_item(KIN(I_RWIN) + (size_t)j * DM * RT_N, RT_N, (bf16*)(F.ws + WS_RWIN) + (size_t)j * RT_N * DM, DM, 64 * kb, 32 * nb, 32 * nb, scr, F.lane); continue; } r -= NI_RI;
            if (r < NI_RO) { const int j = r / 1024, q = r % 1024, kb = q / 32, nb = q % 32;
                p0_transpose_item(KIN(I_RWOUT) + (size_t)j * 2048 * DM, DM, (bf16*)(F.ws + WS_RWOUT) + (size_t)j * DM * 2048, 2048, 64 * kb, 32 * nb, 32 * nb, scr, F.lane); continue; } r -= NI_RO;
            if (r < NI_W1) { const int mi = r / 1024, q = r % 1024, kb = q / 64, nb = q % 64; const int n0 = 32 * nb;
                const int cc = n0 & 1023, drow0 = 256 * (cc >> 7) + (cc & 127) + ((n0 >= 1024) ? 128 : 0);
                p0_transpose_item(KIN(I_W1) + (size_t)mi * DM * 2048, 2048, (bf16*)(F.ws + WS_W1T) + (size_t)mi * 2048 * DM, DM, 64 * kb, n0, drow0, scr, F.lane); continue; } r -= NI_W1;
            { const int mi = r / 512, q = r % 512, kb = q / 32, nb = q % 32;
                p0_transpose_item(KIN(I_W2) + (size_t)mi * DM * DM, DM, (bf16*)(F.ws + WS_W2T) + (size_t)mi * DM * DM, DM, 64 * kb, 32 * nb, 32 * nb, scr, F.lane); }
        }
    }
}

__device__ __forceinline__ void build_tiles(Frame& F, int l) {
    LAS int* ts = (LAS int*)(F.lds + TAB_OFF); LAS int* cnt = ts + 40;
    __syncthreads();
    if (F.tid < NEXP) cnt[F.tid] = (int)ldu_vec(F.ctl + CW_CNT + l * 2048 + F.tid * 64);
    __syncthreads();
    if (F.tid == 0) { int a = 0; for (int e = 0; e < NEXP; ++e) { ts[e] = a; a += (cnt[e] + 255) >> 8; } ts[NEXP] = a; }
    __syncthreads();
}

__device__ __forceinline__ void row_phase1(Frame& F, int l, int mode) {
    relaunder(F);
    const LAS int* ts = (const LAS int*)(F.lds + TAB_OFF);
    const bool comb = (l > 0);
    if (comb) build_tiles(F, l - 1);
    const float* xsrc = comb ? F.out : KIN(I_X);
    const bf16* Y = (const bf16*)(F.ws + WS_R1);
    const unsigned* tslot = (const unsigned*)(F.ws + WS_TSLOT); const unsigned* tgate = (const unsigned*)(F.ws + WS_TGATE);
    bf16* H = (bf16*)(F.ws + WS_H);
    for (int rb = F.vcu * 256; rb < MTOK; rb += F.G * 256) {
        const int b = rb / SEQ;
        f32x4 A[4], B[4], G2[4];
#pragma unroll
        for (int j = 0; j < 4; ++j) {
            const int c = 4 * F.lane + 256 * j;
            if (mode == 0) { const float* mv = (const float*)(F.ws + WS_MOD) + (size_t)(l * NBATCH + b) * 6 * DM;
                const f32x4 g = *(const f32x4*)(KIN(I_N1G) + l * DM + c), sc = *(const f32x4*)(mv + 1 * DM + c); A[j] = g * (sc + 1.0f); B[j] = *(const f32x4*)(mv + c); }
            else { const float* fm = (const float*)(F.ws + WS_FMOD) + (size_t)b * 2 * DM;
                const f32x4 g = *(const f32x4*)(KIN(I_FG) + c), sc = *(const f32x4*)(fm + DM + c); A[j] = g * (sc + 1.0f); B[j] = *(const f32x4*)(fm + c); }
            if (comb) G2[j] = *(const f32x4*)((const float*)(F.ws + WS_MOD) + (size_t)((l - 1) * NBATCH + b) * 6 * DM + 5 * DM + c); else G2[j] = (f32x4){0.f, 0.f, 0.f, 0.f};
        }
        for (int r = 0; r < 32; ++r) {
            const int row = rb + 32 * F.wave + r;
            f32x4 v[4];
#pragma unroll
            for (int j = 0; j < 4; ++j) v[j] = *(const f32x4*)(xsrc + (size_t)row * DM + 4 * F.lane + 256 * j);
            if (comb) {
                const unsigned sl = tslot[(size_t)row * 4 + (F.lane & 3)], gt = tgate[(size_t)row * 4 + (F.lane & 3)];
                f32x4 ys[4];
#pragma unroll
                for (int j = 0; j < 4; ++j) ys[j] = (f32x4){0.f, 0.f, 0.f, 0.f};
#pragma unroll
                for (int k = 0; k < TOPK; ++k) {
                    const unsigned s = (unsigned)__shfl((int)sl, k); const float gk = __uint_as_float((unsigned)__shfl((int)gt, k));
                    const int e = (int)(s >> 20), pos = (int)(s & 0xFFFFFu); const size_t yrow = (size_t)ts[e] * 256 + pos;
#pragma unroll
                    for (int j = 0; j < 4; ++j) { const v2u w = *(const v2u*)(Y + yrow * DM + 4 * F.lane + 256 * j);
                        ys[j].x += gk * bflo(w.x); ys[j].y += gk * bfhi(w.x); ys[j].z += gk * bflo(w.y); ys[j].w += gk * bfhi(w.y); }
                }
#pragma unroll
                for (int j = 0; j < 4; ++j) v[j] = v[j] + G2[j] * ys[j];
                if (mode == 0) {
#pragma unroll
                    for (int j = 0; j < 4; ++j) *(f32x4*)(F.out + (size_t)row * DM + 4 * F.lane + 256 * j) = v[j];
                }
            }
            float s2 = 0.f;
#pragma unroll
            for (int j = 0; j < 4; ++j) s2 += (v[j].x * v[j].x + v[j].y * v[j].y) + (v[j].z * v[j].z + v[j].w * v[j].w);
            const float rstd = 1.0f / sqrtf(wave_sum(s2) * (1.0f / DM) + EPS);
            if (mode == 0) {
#pragma unroll
                for (int j = 0; j < 4; ++j) { const f32x4 h = v[j] * rstd * A[j] + B[j]; v2u w; w.x = pk2(h.x, h.y); w.y = pk2(h.z, h.w); *(v2u*)(H + (size_t)row * DM + 4 * F.lane + 256 * j) = w; }
            } else {
#pragma unroll
                for (int j = 0; j < 4; ++j) *(f32x4*)(F.out + (size_t)row * DM + 4 * F.lane + 256 * j) = v[j] * rstd * A[j] + B[j];
            }
        }
    }
}

__device__ __forceinline__ void row_phase2(Frame& F, int l) {
    relaunder(F);
    bf16* H = (bf16*)(F.ws + WS_H);
    LAS unsigned char* frag = F.lds + RING_OFF;
    LAS float* lg = (LAS float*)(F.lds + 131072 + F.wave * 2112);
    LAS int* cntL = (LAS int*)(F.lds + 147968); LAS int* baseL = cntL + 32; LAS float* rbias = (LAS float*)(cntL + 64);
    unsigned* list = (unsigned*)(F.ws + WS_LIST); unsigned* tslot = (unsigned*)(F.ws + WS_TSLOT); float* tgate = (float*)(F.ws + WS_TGATE);
    __syncthreads();
    { const float* rw = KIN(I_RTW) + (size_t)l * DM * NEXP;
      for (int it = F.tid; it < 32 * 2 * 64; it += NWAVES * 64) { const int ln = it & 63, nt = (it >> 6) & 1, s = it >> 7; const int e = 16 * nt + (ln & 15), k0 = 32 * s + 8 * (ln >> 4);
          float w[8], hi[8];
#pragma unroll
          for (int j = 0; j < 8; ++j) { w[j] = rw[(size_t)(k0 + j) * NEXP + e]; }
          v4u ph, pl;
          { unsigned a = pk2(w[0], w[1]), b2 = pk2(w[2], w[3]), c2 = pk2(w[4], w[5]), d2 = pk2(w[6], w[7]); ph = (v4u){a, b2, c2, d2};
            hi[0] = bflo(a); hi[1] = bfhi(a); hi[2] = bflo(b2); hi[3] = bfhi(b2); hi[4] = bflo(c2); hi[5] = bfhi(c2); hi[6] = bflo(d2); hi[7] = bfhi(d2); }
          pl = (v4u){pk2(w[0] - hi[0], w[1] - hi[1]), pk2(w[2] - hi[2], w[3] - hi[3]), pk2(w[4] - hi[4], w[5] - hi[5]), pk2(w[6] - hi[6], w[7] - hi[7])};
          *(LAS v4u*)(frag + ((s * 2 + nt) * 2 + 0) * 1024 + ln * 16) = ph; *(LAS v4u*)(frag + ((s * 2 + nt) * 2 + 1) * 1024 + ln * 16) = pl; }
      if (F.tid < NEXP) rbias[F.tid] = KIN(I_RTB)[l * NEXP + F.tid];
    }
    for (int rb = F.vcu * 256; rb < MTOK; rb += F.G * 256) {
        const int b = rb / SEQ;
        if (F.tid < NEXP) cntL[F.tid] = 0;
        __syncthreads();
        {
            f32x4 A[4], B[4];
            const float* mv = (const float*)(F.ws + WS_MOD) + (size_t)(l * NBATCH + b) * 6 * DM;
#pragma unroll
            for (int j = 0; j < 4; ++j) { const int c = 4 * F.lane + 256 * j; const f32x4 g = *(const f32x4*)(KIN(I_N2G) + l * DM + c), sc = *(const f32x4*)(mv + 4 * DM + c); A[j] = g * (sc + 1.0f); B[j] = *(const f32x4*)(mv + 3 * DM + c); }
            for (int r = 0; r < 32; ++r) {
                const int row = rb + 32 * F.wave + r;
                f32x4 v[4]; float s2 = 0.f;
#pragma unroll
                for (int j = 0; j < 4; ++j) { v[j] = *(const f32x4*)(F.out + (size_t)row * DM + 4 * F.lane + 256 * j); s2 += (v[j].x * v[j].x + v[j].y * v[j].y) + (v[j].z * v[j].z + v[j].w * v[j].w); }
                const float rstd = 1.0f / sqrtf(wave_sum(s2) * (1.0f / DM) + EPS);
#pragma unroll
                for (int j = 0; j < 4; ++j) { const f32x4 h = v[j] * rstd * A[j] + B[j]; v2u w; w.x = pk2(h.x, h.y); w.y = pk2(h.z, h.w); *(v2u*)(H + (size_t)row * DM + 4 * F.lane + 256 * j) = w; }
            }
        }
        VM_WAIT();
        int my_e[2][TOPK], my_lp[2][TOPK]; float my_g[2][TOPK];
#pragma unroll
        for (int grp = 0; grp < 2; ++grp) {
            const int row0 = rb + 32 * F.wave + 16 * grp;
            f32x4 acc0 = (f32x4){0.f, 0.f, 0.f, 0.f}, acc1 = (f32x4){0.f, 0.f, 0.f, 0.f};
            const unsigned long long* ap = (const unsigned long long*)(H + (size_t)(row0 + (F.lane & 15)) * DM + 8 * (F.lane >> 4));
#pragma unroll 4
            for (int s = 0; s < 32; ++s) {
                const unsigned long long lo = __hip_atomic_load(ap + 8 * s, RLX_AGENT), hi = __hip_atomic_load(ap + 8 * s + 1, RLX_AGENT);
                v4u av = (v4u){(unsigned)lo, (unsigned)(lo >> 32), (unsigned)hi, (unsigned)(hi >> 32)}; const bf16x8 a = __builtin_bit_cast(bf16x8, av);
                const bf16x8 b00 = *(const LAS bf16x8*)(frag + ((s * 2 + 0) * 2 + 0) * 1024 + F.lane * 16), b01 = *(const LAS bf16x8*)(frag + ((s * 2 + 0) * 2 + 1) * 1024 + F.lane * 16);
                const bf16x8 b10 = *(const LAS bf16x8*)(frag + ((s * 2 + 1) * 2 + 0) * 1024 + F.lane * 16), b11 = *(const LAS bf16x8*)(frag + ((s * 2 + 1) * 2 + 1) * 1024 + F.lane * 16);
                acc0 = __builtin_amdgcn_mfma_f32_16x16x32_bf16(a, b00, acc0, 0, 0, 0); acc0 = __builtin_amdgcn_mfma_f32_16x16x32_bf16(a, b01, acc0, 0, 0, 0);
                acc1 = __builtin_amdgcn_mfma_f32_16x16x32_bf16(a, b10, acc1, 0, 0, 0); acc1 = __builtin_amdgcn_mfma_f32_16x16x32_bf16(a, b11, acc1, 0, 0, 0);
            }
#pragma unroll
            for (int q = 0; q < 4; ++q) { lg[(4 * (F.lane >> 4) + q) * 33 + (F.lane & 15)] = acc0[q]; lg[(4 * (F.lane >> 4) + q) * 33 + 16 + (F.lane & 15)] = acc1[q]; }
            LDS_WAIT(); asm volatile("" ::: "memory");
            if (F.lane < 16) {
                unsigned taken = 0u; float tl[TOPK];
#pragma unroll
                for (int k = 0; k < TOPK; ++k) {
                    float best = -3.0e38f; int bi = 0;
                    for (int e = 0; e < NEXP; ++e) { const float v = lg[F.lane * 33 + e] + rbias[e]; if (!((taken >> e) & 1u) && v > best) { best = v; bi = e; } }
                    taken |= 1u << bi; my_e[grp][k] = bi; tl[k] = best;
                }
                float den = 0.f, ex[TOPK];
#pragma unroll
                for (int k = 0; k < TOPK; ++k) { ex[k] = __expf(tl[k] - tl[0]); den += ex[k]; }
#pragma unroll
                for (int k = 0; k < TOPK; ++k) { my_g[grp][k] = ex[k] / den; my_lp[grp][k] = __hip_atomic_fetch_add(&cntL[my_e[grp][k]], 1, __ATOMIC_RELAXED, __HIP_MEMORY_SCOPE_WORKGROUP); }
            } else {
#pragma unroll
                for (int k = 0; k < TOPK; ++k) { my_e[grp][k] = 0; my_lp[grp][k] = 0; my_g[grp][k] = 0.f; }
            }
            LDS_WAIT(); asm volatile("" ::: "memory");
        }
        __syncthreads();
        if (F.tid < NEXP) baseL[F.tid] = (int)__hip_atomic_fetch_add(F.ctl + CW_CNT + l * 2048 + F.tid * 64, (unsigned)cntL[F.tid], RLX_AGENT);
        __syncthreads();
        if (F.lane < 16) {
#pragma unroll
            for (int grp = 0; grp < 2; ++grp) {
                const int row = rb + 32 * F.wave + 16 * grp + F.lane;
#pragma unroll
                for (int k = 0; k < TOPK; ++k) { const int e = my_e[grp][k], pos = baseL[e] + my_lp[grp][k];
                    list[(size_t)e * LCAP + pos] = (unsigned)row; tslot[(size_t)row * 4 + k] = ((unsigned)e << 20) | (unsigned)pos; tgate[(size_t)row * 4 + k] = my_g[grp][k]; }
            }
        }
        __syncthreads();
    }
}

__device__ __forceinline__ void moe_gather(Frame& F, int l) {
    relaunder(F);
    build_tiles(F, l);
    const LAS int* ts = (const LAS int*)(F.lds + TAB_OFF); const LAS int* cnt = ts + 40;
    const unsigned* list = (const unsigned*)(F.ws + WS_LIST); const bf16* H = (const bf16*)(F.ws + WS_H); bf16* Xg = (bf16*)(F.ws + WS_R1);
    const int gw = F.vcu * NWAVES + F.wave, NGW = F.G * NWAVES, NR = ts[NEXP] * 256;
    for (int r = gw; r < NR; r += NGW) {
        const int mt = r >> 8; int e = 0;
        for (int k = 1; k < NEXP; ++k) e += (ts[k] <= mt) ? 1 : 0;
        const int pos = r - ts[e] * 256;
        unsigned tok = 0u; if (pos < cnt[e]) tok = ldu_vec(list + (size_t)e * LCAP + pos);
        const v4u* src = (const v4u*)(H + (size_t)tok * DM); v4u* dst = (v4u*)(Xg + (size_t)r * DM);
        dst[F.lane] = src[F.lane]; dst[F.lane + 64] = src[F.lane + 64];
    }
}

__device__ __forceinline__ void moe_build_tt(Frame& F, int nN) {
    const LAS int* ts = (const LAS int*)(F.lds + TAB_OFF); const LAS int* cnt = ts + 40;
    LAS unsigned short* tt = (LAS unsigned short*)(F.lds + 131072);
    const unsigned* list = (const unsigned*)(F.ws + WS_LIST); const long NU = (long)ts[NEXP] * nN;
    for (int j = 0; j < 17; ++j) { const int i = 2 * j + (F.tid >> 8), r = F.tid & 255; const long L = (long)i * F.G + F.vcu;
        if (L < NU) { const int mt = (int)(L / nN); int e = 0;
            for (int k = 1; k < NEXP; ++k) e += (ts[k] <= mt) ? 1 : 0;
            const int pos = (mt - ts[e]) * 256 + r; unsigned tok = 0u; if (pos < cnt[e]) tok = list[(size_t)e * LCAP + pos];
            tt[i * 256 + r] = (unsigned short)tok; } }
    __syncthreads();
}

using pg8::Unit;
__device__ __forceinline__ v4u pack8(const f32x4 a, const f32x4 b) { v4u w; w.x = pk2(a.x, a.y); w.y = pk2(a.z, a.w); w.z = pk2(b.x, b.y); w.w = pk2(b.z, b.w); return w; }

struct EpiHgrnIn {
    static constexpr bool PERM = true;
    unsigned char* r1; const float* lb;
    __device__ __forceinline__ void operator()(const f32x4 (&acc)[2][2][4][2], const Unit& u, int wr, int wc, int fr, int fq) const {
        const int seg = u.pn >> 2, row0 = u.pm * 256 + wr * 64 + fr, cs0 = (u.pn & 3) * 256 + wc * 32 + 8 * fq;
        if (seg == 1) {
            bf16* K = (bf16*)(r1 + 128 * MiB); float* LF = (float*)(r1 + 512 * MiB);
#pragma unroll
            for (int bj = 0; bj < 2; ++bj) {
                f32x4 lbv[2]; lbv[0] = *(const f32x4*)(lb + cs0 + bj * 128); lbv[1] = *(const f32x4*)(lb + cs0 + bj * 128 + 4);
#pragma unroll
                for (int ai = 0; ai < 2; ++ai)
#pragma unroll
                    for (int m = 0; m < 4; ++m) { const size_t ro = (size_t)(row0 + ai * 128 + m * 16) * DM + cs0 + bj * 128; f32x4 kk[2], lf[2];
#pragma unroll
                        for (int n = 0; n < 2; ++n)
#pragma unroll
                            for (int j = 0; j < 4; ++j) { const float f = fminf(fmaxf(acc[ai][bj][m][n][j], -60.f), 60.f), l0 = lbv[n][j], ef = __expf(f);
                                const float sg = ef * __builtin_amdgcn_rcpf(1.f + ef), sgm = __builtin_amdgcn_rcpf(1.f + ef);
                                lf[n][j] = __logf(l0 + (1.f - l0) * sg); kk[n][j] = (1.f - l0) * sgm; }
                        *(v4u*)(K + ro) = pack8(kk[0], kk[1]); *(f32x4*)(LF + ro) = lf[0]; *(f32x4*)(LF + ro + 4) = lf[1];
                        __builtin_amdgcn_sched_barrier(0); }
            }
        } else {
            bf16* dst = (bf16*)(r1 + (seg == 0 ? 0 : (seg == 2 ? 256 * MiB : 384 * MiB))); const bool act = (seg != 2);
#pragma unroll
            for (int ai = 0; ai < 2; ++ai)
#pragma unroll
                for (int m = 0; m < 4; ++m) { const size_t ro = (size_t)(row0 + ai * 128 + m * 16) * DM;
#pragma unroll
                    for (int bj = 0; bj < 2; ++bj) { f32x4 v0 = acc[ai][bj][m][0], v1 = acc[ai][bj][m][1];
                        if (act) {
#pragma unroll
                            for (int j = 0; j < 4; ++j) { v0[j] = siluf_(v0[j]); v1[j] = siluf_(v1[j]); } }
                        *(v4u*)(dst + ro + cs0 + bj * 128) = pack8(v0, v1); }
                    __builtin_amdgcn_sched_barrier(0); }
        }
    }
};

struct EpiRetIn {
    static constexpr bool PERM = true;
    unsigned char* r1; const int* positions;
    __device__ __forceinline__ void operator()(const f32x4 (&acc)[2][2][4][2], const Unit& u, int wr, int wc, int fr, int fq) const {
        const int row0 = u.pm * 256 + wr * 64 + fr, cl = wc * 32 + 8 * fq;
        if (u.pn < 8) {
            bf16* dst = (bf16*)(r1 + ((u.pn < 4) ? 0 : 128 * MiB)); const float sc = (u.pn < 4) ? 1.0f : 0.0625f; const int hh = u.pn & 3;
            float invrev[2][4];
#pragma unroll
            for (int n = 0; n < 2; ++n)
#pragma unroll
                for (int j = 0; j < 4; ++j) invrev[n][j] = exp2f(-(float)(cl + 4 * n + j) * 0.10462765653188542f) * 0.15915494309189535f;
#pragma unroll
            for (int ai = 0; ai < 2; ++ai)
#pragma unroll
                for (int m = 0; m < 4; ++m) { const int row = row0 + ai * 128 + m * 16; const float pos = (float)positions[row]; const size_t ro = (size_t)row * DM + hh * 256 + cl;
                    f32x4 o1[2], o2[2];
#pragma unroll
                    for (int n = 0; n < 2; ++n)
#pragma unroll
                        for (int j = 0; j < 4; ++j) { const float rev = pos * invrev[n][j], fr_ = rev - floorf(rev); const float cs = __builtin_amdgcn_cosf(fr_), sn = __builtin_amdgcn_sinf(fr_);
                            const float x1 = acc[ai][0][m][n][j], x2 = acc[ai][1][m][n][j]; o1[n][j] = (x1 * cs - x2 * sn) * sc; o2[n][j] = (x2 * cs + x1 * sn) * sc; }
                    *(v4u*)(dst + ro) = pack8(o1[0], o1[1]); *(v4u*)(dst + ro + 128) = pack8(o2[0], o2[1]); }
        } else {
            const bool isg = (u.pn >= 16); bf16* dst = (bf16*)(r1 + (isg ? 512 * MiB : 256 * MiB)); const int ct = (isg ? u.pn - 16 : u.pn - 8) * 256 + cl;
#pragma unroll
            for (int ai = 0; ai < 2; ++ai)
#pragma unroll
                for (int m = 0; m < 4; ++m) { const size_t ro = (size_t)(row0 + ai * 128 + m * 16) * 2048 + ct;
#pragma unroll
                    for (int bj = 0; bj < 2; ++bj) { f32x4 v0 = acc[ai][bj][m][0], v1 = acc[ai][bj][m][1];
                        if (isg) {
#pragma unroll
                            for (int j = 0; j < 4; ++j) { v0[j] = siluf_(v0[j]); v1[j] = siluf_(v1[j]); } }
                        *(v4u*)(dst + ro + bj * 128) = pack8(v0, v1); } }
        }
    }
};

struct EpiOut {
    static constexpr bool PERM = false;
    const float* xin; float* xout; const float* gate;
    __device__ __forceinline__ void operator()(const f32x4 (&acc)[2][2][4][2], const Unit& u, int wr, int wc, int fr, int fq) const {
        const int row0 = u.pm * 256 + wr * 64 + fr, col0 = u.pn * 256 + wc * 32 + 4 * fq, b = (u.pm * 256) / SEQ;
        f32x4 gv[2][2];
#pragma unroll
        for (int bj = 0; bj < 2; ++bj)
#pragma unroll
            for (int n = 0; n < 2; ++n) gv[bj][n] = *(const f32x4*)(gate + (size_t)b * 6 * DM + col0 + bj * 128 + n * 16);
#pragma unroll
        for (int ai = 0; ai < 2; ++ai)
#pragma unroll
            for (int mp = 0; mp < 2; ++mp) { f32x4 xi[2][2][2];
#pragma unroll
                for (int mm = 0; mm < 2; ++mm)
#pragma unroll
                    for (int bj = 0; bj < 2; ++bj)
#pragma unroll
                        for (int n = 0; n < 2; ++n) xi[mm][bj][n] = *(const f32x4*)(xin + (size_t)(row0 + ai * 128 + (2 * mp + mm) * 16) * DM + col0 + bj * 128 + n * 16);
#pragma unroll
                for (int mm = 0; mm < 2; ++mm)
#pragma unroll
                    for (int bj = 0; bj < 2; ++bj)
#pragma unroll
                        for (int n = 0; n < 2; ++n) *(f32x4*)(xout + (size_t)(row0 + ai * 128 + (2 * mp + mm) * 16) * DM + col0 + bj * 128 + n * 16) = xi[mm][bj][n] + gv[bj][n] * acc[ai][bj][2 * mp + mm][n];
                asm volatile("" ::: "memory"); }
    }
};

struct EpiMoe1 {
    static constexpr bool PERM = true;
    bf16* A2; const float* b1;
    __device__ __forceinline__ void operator()(const f32x4 (&acc)[2][2][4][2], const Unit& u, int wr, int wc, int fr, int fq) const {
        const int row0 = u.pm * 256 + wr * 64 + fr, gc = u.nn * 128 + wc * 32 + 8 * fq; const float* bp = b1 + (size_t)u.e * 2048;
        f32x4 bg[2], bl[2];
#pragma unroll
        for (int n = 0; n < 2; ++n) { bg[n] = *(const f32x4*)(bp + gc + 4 * n); bl[n] = *(const f32x4*)(bp + 1024 + gc + 4 * n); }
#pragma unroll
        for (int ai = 0; ai < 2; ++ai)
#pragma unroll
            for (int m = 0; m < 4; ++m) { f32x4 o[2];
#pragma unroll
                for (int n = 0; n < 2; ++n)
#pragma unroll
                    for (int j = 0; j < 4; ++j) { const float g = fminf(acc[ai][0][m][n][j] + bg[n][j], 7.0f), li = fminf(fmaxf(acc[ai][1][m][n][j] + bl[n][j], -7.0f), 7.0f);
                        o[n][j] = g * sigmoidf_(1.702f * g) * (li + 1.0f); }
                *(v4u*)(A2 + (size_t)(row0 + ai * 128 + m * 16) * DM + gc) = pack8(o[0], o[1]); }
    }
};

struct EpiMoe2 {
    static constexpr bool PERM = true;
    bf16* Y; const float* b2;
    __device__ __forceinline__ void operator()(const f32x4 (&acc)[2][2][4][2], const Unit& u, int wr, int wc, int fr, int fq) const {
        const int row0 = u.pm * 256 + wr * 64 + fr, c0 = u.nn * 256 + wc * 32 + 8 * fq; const float* bp = b2 + (size_t)u.e * DM;
        f32x4 bv[2][2];
#pragma unroll
        for (int bj = 0; bj < 2; ++bj)
#pragma unroll
            for (int n = 0; n < 2; ++n) bv[bj][n] = *(const f32x4*)(bp + c0 + bj * 128 + 4 * n);
#pragma unroll
        for (int ai = 0; ai < 2; ++ai)
#pragma unroll
            for (int m = 0; m < 4; ++m) { const size_t ro = (size_t)(row0 + ai * 128 + m * 16) * DM + c0;
#pragma unroll
                for (int bj = 0; bj < 2; ++bj) *(v4u*)(Y + ro + bj * 128) = pack8(acc[ai][bj][m][0] + bv[bj][0], acc[ai][bj][m][1] + bv[bj][1]); }
    }
};

__device__ __forceinline__ void hgrn_scan(Frame& F, int j) {
    relaunder(F);
    const bf16* Q = (const bf16*)(F.ws + WS_R1); const bf16* K = (const bf16*)(F.ws + WS_R1 + 128 * MiB); const bf16* V = (const bf16*)(F.ws + WS_R1 + 256 * MiB); const bf16* SG = (const bf16*)(F.ws + WS_R1 + 384 * MiB);
    const float* LF = (const float*)(F.ws + WS_R1 + 512 * MiB); bf16* O = (bf16*)(F.ws + WS_R2);
    LAS float* Qs = (LAS float*)(F.lds); LAS float* Ks = Qs + 4096; LAS float* Fs = Qs + 8192; LAS float* Vs = Qs + 12288; LAS float* P = Qs + 16384;
    const int v = F.tid & 127, kq = F.tid >> 7, t16 = F.tid >> 4, c8 = (F.tid & 15) * 8;
    f32x4 gain0 = *(const f32x4*)(KIN(I_HGAIN) + j * 128 + c8), gain1 = *(const f32x4*)(KIN(I_HGAIN) + j * 128 + c8 + 4);
    for (int u = F.vcu; u < NBATCH * HG_H; u += F.G) {
        const int b = u / HG_H, h = u % HG_H;
        float S[32];
#pragma unroll
        for (int i = 0; i < 32; ++i) S[i] = 0.f;
        for (int ch = 0; ch < SEQ / 32; ++ch) {
            const int row0 = b * SEQ + 32 * ch; const size_t gi = (size_t)(row0 + t16) * DM + h * 128 + c8;
            __syncthreads();
            { const v4u q = *(const v4u*)(Q + gi), k = *(const v4u*)(K + gi), vv = *(const v4u*)(V + gi); const f32x4 l0 = *(const f32x4*)(LF + gi), l1 = *(const f32x4*)(LF + gi + 4);
              LAS f32x4* d;
              d = (LAS f32x4*)(Qs + t16 * 128 + c8); d[0] = (f32x4){bflo(q.x), bfhi(q.x), bflo(q.y), bfhi(q.y)}; d[1] = (f32x4){bflo(q.z), bfhi(q.z), bflo(q.w), bfhi(q.w)};
              d = (LAS f32x4*)(Ks + t16 * 128 + c8); d[0] = (f32x4){bflo(k.x), bfhi(k.x), bflo(k.y), bfhi(k.y)}; d[1] = (f32x4){bflo(k.z), bfhi(k.z), bflo(k.w), bfhi(k.w)};
              d = (LAS f32x4*)(Vs + t16 * 128 + c8); d[0] = (f32x4){bflo(vv.x), bfhi(vv.x), bflo(vv.y), bfhi(vv.y)}; d[1] = (f32x4){bflo(vv.z), bfhi(vv.z), bflo(vv.w), bfhi(vv.w)};
              d = (LAS f32x4*)(Fs + t16 * 128 + c8); d[0] = (f32x4){__expf(l0.x), __expf(l0.y), __expf(l0.z), __expf(l0.w)}; d[1] = (f32x4){__expf(l1.x), __expf(l1.y), __expf(l1.z), __expf(l1.w)}; }
            __syncthreads();
            for (int t = 0; t < 32; ++t) {
                const float vt = Vs[t * 128 + v]; float a = 0.f;
#pragma unroll
                for (int i4 = 0; i4 < 8; ++i4) { const f32x4 f4 = *(const LAS f32x4*)(Fs + t * 128 + 32 * kq + 4 * i4), k4 = *(const LAS f32x4*)(Ks + t * 128 + 32 * kq + 4 * i4), q4 = *(const LAS f32x4*)(Qs + t * 128 + 32 * kq + 4 * i4);
#pragma unroll
                    for (int i = 0; i < 4; ++i) { S[4 * i4 + i] = f4[i] * S[4 * i4 + i] + k4[i] * vt; a += q4[i] * S[4 * i4 + i]; } }
                P[(t * 4 + kq) * 128 + v] = a;
            }
            __syncthreads();
            { f32x4 o0 = (f32x4){0.f, 0.f, 0.f, 0.f}, o1 = o0;
#pragma unroll
              for (int q = 0; q < 4; ++q) { o0 += *(const LAS f32x4*)(P + (t16 * 4 + q) * 128 + c8); o1 += *(const LAS f32x4*)(P + (t16 * 4 + q) * 128 + c8 + 4); }
              float ss = (o0.x * o0.x + o0.y * o0.y) + (o0.z * o0.z + o0.w * o0.w) + (o1.x * o1.x + o1.y * o1.y) + (o1.z * o1.z + o1.w * o1.w);
              ss += __shfl_xor(ss, 1); ss += __shfl_xor(ss, 2); ss += __shfl_xor(ss, 4); ss += __shfl_xor(ss, 8);
              const float r = 1.0f / sqrtf(ss * (1.0f / 128.f) + EPS);
              const v4u sg = *(const v4u*)(SG + gi);
              f32x4 a0 = o0 * r * gain0, a1 = o1 * r * gain1;
              a0.x *= bflo(sg.x); a0.y *= bfhi(sg.x); a0.z *= bflo(sg.y); a0.w *= bfhi(sg.y); a1.x *= bflo(sg.z); a1.y *= bfhi(sg.z); a1.z *= bflo(sg.w); a1.w *= bfhi(sg.w);
              *(v4u*)(O + gi) = pack8(a0, a1); }
        }
    }
}

__device__ __forceinline__ void ret_scan(Frame& F) {
    relaunder(F);
    const bf16* Q = (const bf16*)(F.ws + WS_R1); const bf16* K = (const bf16*)(F.ws + WS_R1 + 128 * MiB); const bf16* V = (const bf16*)(F.ws + WS_R1 + 256 * MiB); const bf16* SG = (const bf16*)(F.ws + WS_R1 + 512 * MiB);
    bf16* O = (bf16*)(F.ws + WS_R2);
    LAS bf16* Qs = (LAS bf16*)(F.lds); LAS bf16* Ks = (LAS bf16*)(F.lds + 33792); LAS bf16* Vs = (LAS bf16*)(F.lds + 67584);
    LAS float* St = (LAS float*)(F.lds + 133120); LAS float* wred = (LAS float*)(F.lds + 149504); LAS float* rtab = (LAS float*)(F.lds + 151552);
    for (int u = F.vcu; u < NBATCH * RT_H * 16; u += F.G) {
        const int bh = u >> 4, cp = u & 15, b = bh >> 2, h = bh & 3;
        const float lg2g = log2f(1.0f - exp2f(-5.0f - (float)h));
        for (int half = 0; half < 2; ++half) {
            const int c = half ? 31 - cp : cp; const int row0 = b * SEQ + 64 * c;
            __syncthreads();
#pragma unroll
            for (int i = 0; i < 4; ++i) { const int p = F.tid + 512 * i, r = p >> 5, cc = (p & 31) * 8; *(LAS v4u*)(Qs + r * 264 + cc) = *(const v4u*)(Q + (size_t)(row0 + r) * DM + h * 256 + cc); }
            float acc[64];
#pragma unroll
            for (int n = 0; n < 64; ++n) acc[n] = 0.f;
            for (int cq = 0; cq <= c; ++cq) {
                const int krow0 = b * SEQ + 64 * cq;
                __syncthreads();
#pragma unroll
                for (int i = 0; i < 4; ++i) { const int p = F.tid + 512 * i, r = p >> 5, cc = (p & 31) * 8; *(LAS v4u*)(Ks + r * 264 + cc) = *(const v4u*)(K + (size_t)(krow0 + r) * DM + h * 256 + cc); }
#pragma unroll
                for (int i = 0; i < 8; ++i) { const int p = F.tid + 512 * i, r = p >> 6, cc = (p & 63) * 8; *(LAS v4u*)(Vs + r * 512 + cc) = *(const v4u*)(V + (size_t)(krow0 + r) * 2048 + h * 512 + cc); }
                __syncthreads();
                { float s[8];
#pragma unroll
                  for (int j8 = 0; j8 < 8; ++j8) s[j8] = 0.f;
                  for (int dc = 0; dc < 32; ++dc) {
                      const v4u kv = *(const LAS v4u*)(Ks + F.lane * 264 + dc * 8);
                      const float k0 = bflo(kv.x), k1 = bfhi(kv.x), k2 = bflo(kv.y), k3 = bfhi(kv.y), k4 = bflo(kv.z), k5 = bfhi(kv.z), k6 = bflo(kv.w), k7 = bfhi(kv.w);
#pragma unroll
                      for (int j8 = 0; j8 < 8; ++j8) { const v4u qv = *(const LAS v4u*)(Qs + (8 * F.wave + j8) * 264 + dc * 8);
                          s[j8] += (bflo(qv.x) * k0 + bfhi(qv.x) * k1) + (bflo(qv.y) * k2 + bfhi(qv.y) * k3) + (bflo(qv.z) * k4 + bfhi(qv.z) * k5) + (bflo(qv.w) * k6 + bfhi(qv.w) * k7); }
                  }
                  f32x4 w0, w1;
#pragma unroll
                  for (int j8 = 0; j8 < 8; ++j8) { const float dist = fabsf((float)((64 * c + 8 * F.wave + j8) - (64 * cq + F.lane))); const float val = s[j8] * exp2f(dist * lg2g); if (j8 < 4) w0[j8] = val; else w1[j8 - 4] = val; }
                  *(LAS f32x4*)(St + F.lane * 64 + 8 * F.wave) = w0; *(LAS f32x4*)(St + F.lane * 64 + 8 * F.wave + 4) = w1; }
                __syncthreads();
                for (int m2 = 0; m2 < 64; ++m2) {
                    const float vv = bf2f(Vs[m2 * 512 + F.tid]);
#pragma unroll
                    for (int n4 = 0; n4 < 16; ++n4) { const f32x4 sv = *(const LAS f32x4*)(St + m2 * 64 + 4 * n4); acc[4 * n4 + 0] += sv.x * vv; acc[4 * n4 + 1] += sv.y * vv; acc[4 * n4 + 2] += sv.z * vv; acc[4 * n4 + 3] += sv.w * vv; }
                }
            }
#pragma unroll
            for (int n = 0; n < 64; ++n) { const float p = wave_sum(acc[n] * acc[n]); if (F.lane == 0) wred[F.wave * 64 + n] = p; }
            __syncthreads();
            if (F.tid < 64) { float s = 0.f;
#pragma unroll
                for (int w = 0; w < 8; ++w) s += wred[w * 64 + F.tid];
                rtab[F.tid] = 1.0f / sqrtf(s * (1.0f / 512.f) + EPS); }
            __syncthreads();
#pragma unroll
            for (int n = 0; n < 64; ++n) { const size_t gi = (size_t)(row0 + n) * 2048 + h * 512 + F.tid; const float sg = bf2f(SG[gi]); O[gi] = (bf16)(pk2(acc[n] * rtab[n] * sg, 0.f) & 0xffffu); }
        }
    }
}

typedef short s16x4 __attribute__((ext_vector_type(4)));
__device__ __forceinline__ unsigned off_b(unsigned row, unsigned ch) { return 256u * row + 16u * (ch ^ (((row & 3u) << 2) | ((row >> 2) & 3u))); }
__device__ __forceinline__ bf16x8 row_frag(const LAS unsigned char* tile, unsigned row, unsigned s4, unsigned g) { return *(const LAS bf16x8*)(tile + off_b(row, 4u * s4 + g)); }
__device__ __forceinline__ bf16x8 tr_frag16(const LAS unsigned char* tile, unsigned lane, unsigned c, unsigned ks) {
    const unsigned g = lane >> 4, q = (lane & 15u) >> 2, p = lane & 3u;
    const unsigned a0 = off_b(32u * ks + 8u * g + q, 2u * c + (p >> 1)) + 8u * (p & 1u), a1 = off_b(32u * ks + 8u * g + 4u + q, 2u * c + (p >> 1)) + 8u * (p & 1u);
    const s16x4 lo = __builtin_amdgcn_ds_read_tr16_b64_v4i16((LAS s16x4*)(tile + a0)), hi = __builtin_amdgcn_ds_read_tr16_b64_v4i16((LAS s16x4*)(tile + a1));
    return (bf16x8){lo[0], lo[1], lo[2], lo[3], hi[0], hi[1], hi[2], hi[3]};
}
#define RSB() __builtin_amdgcn_sched_barrier(0)
constexpr unsigned RQS = 528, RVS = 272;
template <unsigned RS> __device__ __forceinline__ bf16x8 tr_lin(const LAS unsigned char* img, unsigned trb, int c, int ks) {
    const s16x4 lo = __builtin_amdgcn_ds_read_tr16_b64_v4i16((LAS s16x4*)(img + trb + (32 * ks) * RS + 32 * c)), hi = __builtin_amdgcn_ds_read_tr16_b64_v4i16((LAS s16x4*)(img + trb + (32 * ks + 4) * RS + 32 * c));
    return (bf16x8){lo[0], lo[1], lo[2], lo[3], hi[0], hi[1], hi[2], hi[3]};
}
__device__ __forceinline__ void ret_scan_mfma(Frame& F) {
    relaunder(F);
    const bf16* Q = (const bf16*)(F.ws + WS_R1); const bf16* K = (const bf16*)(F.ws + WS_R1 + 128 * MiB); const bf16* V = (const bf16*)(F.ws + WS_R1 + 256 * MiB);
    bf16* O = (bf16*)(F.ws + WS_R2); float* SS = (float*)(F.ws + WS_R2 + 256 * MiB);
    LAS unsigned char* Qi = F.lds; LAS unsigned char* Ki = F.lds + 33792; LAS unsigned char* Vi = F.lds + 67584; LAS unsigned char* Si = F.lds + 84992; LAS float* OT = (LAS float*)(F.lds + 94208);
    const unsigned w = (unsigned)F.wave;
    for (int u = F.vcu; u < NBATCH * RT_H * 4; u += F.G) {
        const int bh = u >> 2, vs = u & 3, b = bh >> 2, h = bh & 3;
        const float lg2g = log2f(1.0f - exp2f(-5.0f - (float)h)), cd = exp2f(64.0f * lg2g);
        f32x4 R[16];
#pragma unroll
        for (int i = 0; i < 16; ++i) R[i] = (f32x4){0.f, 0.f, 0.f, 0.f};
        v4u pq[4], pk[4], pv[2];
        { const int row0 = b * SEQ;
#pragma unroll
          for (int i = 0; i < 4; ++i) { const int p = F.tid + 512 * i, r = p >> 5, c32 = p & 31; pq[i] = *(const v4u*)(Q + (size_t)(row0 + r) * DM + h * 256 + c32 * 8); pk[i] = *(const v4u*)(K + (size_t)(row0 + r) * DM + h * 256 + c32 * 8); }
#pragma unroll
          for (int i = 0; i < 2; ++i) { const int p = F.tid + 512 * i, r = p >> 4, c16 = p & 15; pv[i] = *(const v4u*)(V + (size_t)(row0 + r) * 2048 + h * 512 + vs * 128 + c16 * 8); } }
        __syncthreads();
        for (int c = 0; c < SEQ / 64; ++c) {
            const int row0 = b * SEQ + 64 * c;
            unsigned tidl = (unsigned)F.tid; asm volatile("" : "+v"(tidl));
            const unsigned lane = tidl & 63u, g = lane >> 4, li = lane & 15u;
#pragma unroll
            for (int i = 0; i < 4; ++i) { const unsigned p = tidl + 512u * i, r = p >> 5, c32 = p & 31u; const unsigned o = r * RQS + 16u * c32; *(LAS v4u*)(Qi + o) = pq[i]; *(LAS v4u*)(Ki + o) = pk[i]; }
#pragma unroll
            for (int i = 0; i < 2; ++i) { const unsigned p = tidl + 512u * i, r = p >> 4, c16 = p & 15u; *(LAS v4u*)(Vi + r * RVS + 16u * c16) = pv[i]; }
            __syncthreads();
            if (c + 1 < SEQ / 64) { const int rn = row0 + 64;
#pragma unroll
                for (int i = 0; i < 4; ++i) { const unsigned p = tidl + 512u * i, r = p >> 5, c32 = p & 31u; pq[i] = *(const v4u*)(Q + (size_t)(rn + (int)r) * DM + h * 256 + c32 * 8); pk[i] = *(const v4u*)(K + (size_t)(rn + (int)r) * DM + h * 256 + c32 * 8); }
#pragma unroll
                for (int i = 0; i < 2; ++i) { const unsigned p = tidl + 512u * i, r = p >> 4, c16 = p & 15u; pv[i] = *(const v4u*)(V + (size_t)(rn + (int)r) * 2048 + h * 512 + vs * 128 + c16 * 8); } }
            RSB();
            const unsigned rb128 = li * RQS + 16u * g, rb64 = li * RQS + 8u * g, trq = (8u * g + (li >> 2)) * RQS + 8u * (li & 3u), trv = (8u * g + (li >> 2)) * RVS + 8u * (li & 3u);
            { const unsigned mt = w >> 1, nt0 = 2u * (w & 1u); f32x4 sa0 = (f32x4){0.f, 0.f, 0.f, 0.f}, sa1 = sa0;
              const LAS unsigned char* qrow = Qi + rb128 + mt * (16u * RQS); const LAS unsigned char* krow = Ki + rb128 + nt0 * (16u * RQS);
              bf16x8 qa[2][2], kb0[2][2], kb1[2][2];
#define RET_LDS(buf, s8b) do { _Pragma("unroll") for (int k2 = 0; k2 < 2; ++k2) { const int s8 = (s8b) + k2; \
                  qa[buf][k2] = *(const LAS bf16x8*)(qrow + 64 * s8); kb0[buf][k2] = *(const LAS bf16x8*)(krow + 64 * s8); kb1[buf][k2] = *(const LAS bf16x8*)(krow + 16 * RQS + 64 * s8); } } while (0)
              RET_LDS(0, 0); RSB();
#pragma unroll
              for (int bt = 0; bt < 4; ++bt) { if (bt < 3) RET_LDS((bt + 1) & 1, 2 * (bt + 1)); RSB();
#pragma unroll
                  for (int k2 = 0; k2 < 2; ++k2) { sa0 = __builtin_amdgcn_mfma_f32_16x16x32_bf16(qa[bt & 1][k2], kb0[bt & 1][k2], sa0, 0, 0, 0); sa1 = __builtin_amdgcn_mfma_f32_16x16x32_bf16(qa[bt & 1][k2], kb1[bt & 1][k2], sa1, 0, 0, 0); }
                  RSB(); }
#undef RET_LDS
#pragma unroll
              for (int q = 0; q < 4; ++q) { const int n = (int)(16u * mt + 4u * g) + q, m0 = (int)(16u * nt0 + li);
                  const float v0 = sa0[q] * exp2f(fabsf((float)(n - m0)) * lg2g), v1 = sa1[q] * exp2f(fabsf((float)(n - m0 - 16)) * lg2g); const unsigned pk = pk2(v0, v1);
                  *(LAS unsigned short*)(Si + (unsigned)n * 144u + 2u * (unsigned)m0) = (unsigned short)(pk & 0xffffu); *(LAS unsigned short*)(Si + (unsigned)n * 144u + 2u * (unsigned)m0 + 32u) = (unsigned short)(pk >> 16); } }
            RSB();
            f32x4 Oa[4];
#pragma unroll
            for (int mt = 0; mt < 4; ++mt) Oa[mt] = (f32x4){0.f, 0.f, 0.f, 0.f};
            { v2u qlo[2][4], qhi[2][4]; const LAS unsigned char* qp = Qi + rb64;
#define RET_LDQ(buf, s8) do { _Pragma("unroll") for (int mt = 0; mt < 4; ++mt) { qlo[buf][mt] = *(const LAS v2u*)(qp + mt * (16 * RQS) + 64 * (s8)); qhi[buf][mt] = *(const LAS v2u*)(qp + mt * (16 * RQS) + 64 * (s8) + 32); } } while (0)
              RET_LDQ(0, 0); RSB();
#pragma unroll
              for (int s8 = 0; s8 < 8; ++s8) { if (s8 < 7) RET_LDQ((s8 + 1) & 1, s8 + 1); RSB();
                  const v4u rt = (v4u){pk2(R[2 * s8][0], R[2 * s8][1]), pk2(R[2 * s8][2], R[2 * s8][3]), pk2(R[2 * s8 + 1][0], R[2 * s8 + 1][1]), pk2(R[2 * s8 + 1][2], R[2 * s8 + 1][3])}; const bf16x8 Rb = __builtin_bit_cast(bf16x8, rt);
#pragma unroll
                  for (int mt = 0; mt < 4; ++mt) { const v4u av = (v4u){qlo[s8 & 1][mt].x, qlo[s8 & 1][mt].y, qhi[s8 & 1][mt].x, qhi[s8 & 1][mt].y}; Oa[mt] = __builtin_amdgcn_mfma_f32_16x16x32_bf16(__builtin_bit_cast(bf16x8, av), Rb, Oa[mt], 0, 0, 0); }
                  RSB(); }
#undef RET_LDQ
            }
#pragma unroll
            for (int mt = 0; mt < 4; ++mt)
#pragma unroll
                for (int q = 0; q < 4; ++q) Oa[mt][q] *= exp2f((float)(16 * mt + 4 * (int)g + q + 1) * lg2g);
            __syncthreads();
            bf16x8 Vf[2], sf[4][2], ka[2][2][2];
#define RET_LDK(buf, dtb) do { _Pragma("unroll") for (int d2 = 0; d2 < 2; ++d2) _Pragma("unroll") for (int ks = 0; ks < 2; ++ks) ka[buf][d2][ks] = tr_lin<RQS>(Ki, trq, (dtb) + d2, ks); } while (0)
#pragma unroll
            for (int ks = 0; ks < 2; ++ks) Vf[ks] = tr_lin<RVS>(Vi + 32u * w, trv, 0, ks);
#pragma unroll
            for (int mt = 0; mt < 4; ++mt)
#pragma unroll
                for (int ks = 0; ks < 2; ++ks) sf[mt][ks] = *(const LAS bf16x8*)(Si + (16u * mt + li) * 144u + 64u * ks + 16u * g);
            RET_LDK(0, 0); RSB();
#pragma unroll
            for (int mt = 0; mt < 4; ++mt)
#pragma unroll
                for (int ks = 0; ks < 2; ++ks) Oa[mt] = __builtin_amdgcn_mfma_f32_16x16x32_bf16(sf[mt][ks], Vf[ks], Oa[mt], 0, 0, 0);
            bf16x8 Vd[2];
#pragma unroll
            for (int ks = 0; ks < 2; ++ks) { const v4u vv = __builtin_bit_cast(v4u, Vf[ks]); float f[8];
#pragma unroll
                for (int j = 0; j < 8; ++j) f[j] = exp2f((float)(63 - (32 * ks + 8 * (int)g + j)) * lg2g);
                const v4u sv = (v4u){pk2(bflo(vv.x) * f[0], bfhi(vv.x) * f[1]), pk2(bflo(vv.y) * f[2], bfhi(vv.y) * f[3]), pk2(bflo(vv.z) * f[4], bfhi(vv.z) * f[5]), pk2(bflo(vv.w) * f[6], bfhi(vv.w) * f[7])};
                Vd[ks] = __builtin_bit_cast(bf16x8, sv); }
            RSB();
#pragma unroll
            for (int bt = 0; bt < 8; ++bt) { if (bt < 7) RET_LDK((bt + 1) & 1, 2 * (bt + 1)); RSB();
#pragma unroll
                for (int d2 = 0; d2 < 2; ++d2) { const int dt = 2 * bt + d2; R[dt] = R[dt] * cd;
#pragma unroll
                    for (int ks = 0; ks < 2; ++ks) R[dt] = __builtin_amdgcn_mfma_f32_16x16x32_bf16(ka[bt & 1][d2][ks], Vd[ks], R[dt], 0, 0, 0); }
                RSB(); }
#undef RET_LDK
#pragma unroll
            for (int mt = 0; mt < 4; ++mt)
#pragma unroll
                for (int q = 0; q < 4; ++q) OT[(16u * mt + 4u * g + q) * 132u + 16u * w + li] = Oa[mt][q];
            __syncthreads();
            { const unsigned tn = tidl >> 3, vg = tidl & 7u; f32x4 o[4]; float ssq = 0.f;
#pragma unroll
              for (int i = 0; i < 4; ++i) { o[i] = *(const LAS f32x4*)(OT + tn * 132u + 16u * vg + 4u * i); ssq += (o[i].x * o[i].x + o[i].y * o[i].y) + (o[i].z * o[i].z + o[i].w * o[i].w); }
              ssq += __shfl_xor(ssq, 1); ssq += __shfl_xor(ssq, 2); ssq += __shfl_xor(ssq, 4);
              bf16* op = O + (size_t)(row0 + (int)tn) * 2048 + h * 512 + vs * 128 + 16 * vg; *(v4u*)op = pack8(o[0], o[1]); *(v4u*)(op + 8) = pack8(o[2], o[3]);
              if (vg == 0) SS[((size_t)(row0 + (int)tn) * 4 + h) * 4 + vs] = ssq; }
        }
    }
}
__device__ __forceinline__ void ret_norm(Frame& F) {
    relaunder(F);
    bf16* O = (bf16*)(F.ws + WS_R2); const float* SS = (const float*)(F.ws + WS_R2 + 256 * MiB); const bf16* SG = (const bf16*)(F.ws + WS_R1 + 512 * MiB);
    const int gw = F.vcu * NWAVES + F.wave, NGW = F.G * NWAVES;
    for (int row = gw; row < MTOK; row += NGW) {
        float r[4];
#pragma unroll
        for (int h = 0; h < 4; ++h) { const f32x4 p = *(const f32x4*)(SS + ((size_t)row * 4 + h) * 4); r[h] = 1.0f / sqrtf(((p.x + p.y) + (p.z + p.w)) * (1.0f / 512.f) + EPS); }
#pragma unroll
        for (int j = 0; j < 4; ++j) { const size_t gi = (size_t)row * 2048 + 512 * j + 8 * F.lane; const v4u o = *(const v4u*)(O + gi), sg = *(const v4u*)(SG + gi); const float rr = r[j];
            v4u w; w.x = pk2(bflo(o.x) * rr * bflo(sg.x), bfhi(o.x) * rr * bfhi(sg.x)); w.y = pk2(bflo(o.y) * rr * bflo(sg.y), bfhi(o.y) * rr * bfhi(sg.y));
            w.z = pk2(bflo(o.z) * rr * bflo(sg.z), bfhi(o.z) * rr * bfhi(sg.z)); w.w = pk2(bflo(o.w) * rr * bflo(sg.w), bfhi(o.w) * rr * bfhi(sg.w));
            *(v4u*)(O + gi) = w; }
    }
}

__device__ __forceinline__ bf16x8 pad8(s16x4 a) { return (bf16x8){a[0], a[1], a[2], a[3], 0, 0, 0, 0}; }
__device__ __forceinline__ void hgrn_scan_mfma(Frame& F, int j) {
    relaunder(F);
    const bf16* Q = (const bf16*)(F.ws + WS_R1); const bf16* K = (const bf16*)(F.ws + WS_R1 + 128 * MiB); const bf16* V = (const bf16*)(F.ws + WS_R1 + 256 * MiB); const bf16* SG = (const bf16*)(F.ws + WS_R1 + 384 * MiB);
    const float* LF = (const float*)(F.ws + WS_R1 + 512 * MiB); bf16* O = (bf16*)(F.ws + WS_R2);
    LAS unsigned char* QEi = F.lds; LAS unsigned char* QE2i = F.lds + 16384; LAS unsigned char* KEi = F.lds + 32768; LAS unsigned char* Vi = F.lds + 49152;
    LAS float* BL = (LAS float*)(F.lds + 65536); LAS float* OT = (LAS float*)(F.lds + 67584);
    const unsigned w = (unsigned)F.wave;
    for (int u = F.vcu; u < NBATCH * HG_H; u += F.G) {
        const int b = u >> 3, h = u & 7;
        f32x4 S[8];
#pragma unroll
        for (int i = 0; i < 8; ++i) S[i] = (f32x4){0.f, 0.f, 0.f, 0.f};
        float plf[16]; unsigned pqk[16]; v4u pv[2], psg[2];
        { const int kbp = F.tid >> 7, dp = F.tid & 127, row0 = b * SEQ;
#pragma unroll
          for (int t = 0; t < 16; ++t) { const size_t gi = (size_t)(row0 + 16 * kbp + t) * DM + h * 128 + dp; plf[t] = LF[gi]; pqk[t] = (unsigned)Q[gi] | ((unsigned)K[gi] << 16); }
#pragma unroll
          for (int i = 0; i < 2; ++i) { const int p = F.tid + 512 * i, r = p >> 4, c16 = p & 15; pv[i] = *(const v4u*)(V + (size_t)(row0 + r) * DM + h * 128 + c16 * 8); }
#pragma unroll
          for (int i = 0; i < 2; ++i) psg[i] = *(const v4u*)(SG + (size_t)(row0 + (F.tid >> 3)) * DM + h * 128 + 16 * (F.tid & 7) + 8 * i); }
        for (int c = 0; c < SEQ / 64; ++c) {
            const int row0 = b * SEQ + 64 * c;
            unsigned tidl = (unsigned)F.tid; asm volatile("" : "+v"(tidl));
            const unsigned lane = tidl & 63u, g = lane >> 4, li = lane & 15u, kbp = tidl >> 7, dp = tidl & 127u;
            { float bs = 0.f;
#pragma unroll
              for (int t = 0; t < 16; ++t) { bs += plf[t]; plf[t] = bs; }
              const float bl = plf[15];
#pragma unroll
              for (int t = 0; t < 16; ++t) { const float bt = plf[t], q = bflo(pqk[t]), k = bfhi(pqk[t]);
                  const unsigned a = off_b(16u * kbp + t, dp >> 3) + 2u * (dp & 7u);
                  const unsigned w0 = pk2(q * __expf(bt), q * __expf(fminf(bt - bl, 80.f))), w1 = pk2(k * __expf(bl - bt), 0.f);
                  *(LAS unsigned short*)(QEi + a) = (unsigned short)(w0 & 0xffffu); *(LAS unsigned short*)(QE2i + a) = (unsigned short)(w0 >> 16); *(LAS unsigned short*)(KEi + a) = (unsigned short)(w1 & 0xffffu); }
              BL[kbp * 128u + dp] = __expf(bl); }
#pragma unroll
            for (int i = 0; i < 2; ++i) { const unsigned p = tidl + 512u * i, r = p >> 4, c16 = p & 15u; *(LAS v4u*)(Vi + off_b(r, c16)) = pv[i]; }
            const v4u csg0 = psg[0], csg1 = psg[1];
            __syncthreads();
            if (c + 1 < SEQ / 64) { const int rn = row0 + 64;
#pragma unroll
                for (int t = 0; t < 16; ++t) { const size_t gi = (size_t)(rn + 16 * (int)kbp + t) * DM + h * 128 + dp; plf[t] = LF[gi]; pqk[t] = (unsigned)Q[gi] | ((unsigned)K[gi] << 16); }
#pragma unroll
                for (int i = 0; i < 2; ++i) { const unsigned p = tidl + 512u * i, r = p >> 4, c16 = p & 15u; pv[i] = *(const v4u*)(V + (size_t)(rn + (int)r) * DM + h * 128 + c16 * 8); }
#pragma unroll
                for (int i = 0; i < 2; ++i) psg[i] = *(const v4u*)(SG + (size_t)(rn + (int)(tidl >> 3)) * DM + h * 128 + 16 * (tidl & 7u) + 8 * i); }
#pragma unroll 1
            for (unsigned kb = 0; kb < 4; ++kb) {
                const unsigned rowl = 16u * kb + li;
                f32x4 P = (f32x4){0.f, 0.f, 0.f, 0.f};
#pragma unroll
                for (int s4 = 0; s4 < 4; ++s4) P = __builtin_amdgcn_mfma_f32_16x16x32_bf16(row_frag(KEi, rowl, s4, g), row_frag(QE2i, rowl, s4, g), P, 0, 0, 0);
                s16x4 a16;
                { const unsigned lo = pk2((4u * g + 0u <= li) ? P[0] : 0.f, (4u * g + 1u <= li) ? P[1] : 0.f), hi = pk2((4u * g + 2u <= li) ? P[2] : 0.f, (4u * g + 3u <= li) ? P[3] : 0.f); const v2u t2 = (v2u){lo, hi}; a16 = __builtin_bit_cast(s16x4, t2); }
                const unsigned q4 = li >> 2, p4 = li & 3u, trow = 16u * kb + 4u * g + q4;
                const s16x4 Vb = __builtin_amdgcn_ds_read_tr16_b64_v4i16((LAS s16x4*)(Vi + off_b(trow, 2u * w + (p4 >> 1)) + 8u * (p4 & 1u)));
                f32x4 oa = (f32x4){0.f, 0.f, 0.f, 0.f};
#pragma unroll
                for (int s4 = 0; s4 < 4; ++s4) {
                    const v4u st = (v4u){pk2(S[2 * s4][0], S[2 * s4][1]), pk2(S[2 * s4][2], S[2 * s4][3]), pk2(S[2 * s4 + 1][0], S[2 * s4 + 1][1]), pk2(S[2 * s4 + 1][2], S[2 * s4 + 1][3])};
                    const v2u lo = *(const LAS v2u*)(QEi + off_b(rowl, 4u * s4 + (g >> 1)) + 8u * (g & 1u)), hi = *(const LAS v2u*)(QEi + off_b(rowl, 4u * s4 + 2u + (g >> 1)) + 8u * (g & 1u));
                    const v4u av = (v4u){lo.x, lo.y, hi.x, hi.y};
                    oa = __builtin_amdgcn_mfma_f32_16x16x32_bf16(__builtin_bit_cast(bf16x8, av), __builtin_bit_cast(bf16x8, st), oa, 0, 0, 0); }
                oa = __builtin_amdgcn_mfma_f32_16x16x32_bf16(pad8(a16), pad8(Vb), oa, 0, 0, 0);
#pragma unroll
                for (int dt = 0; dt < 8; ++dt) { const f32x4 e4 = *(const LAS f32x4*)(BL + kb * 128u + 16u * dt + 4u * g);
                    const s16x4 kt = __builtin_amdgcn_ds_read_tr16_b64_v4i16((LAS s16x4*)(KEi + off_b(trow, 2u * dt + (p4 >> 1)) + 8u * (p4 & 1u)));
                    S[dt] = __builtin_amdgcn_mfma_f32_16x16x32_bf16(pad8(kt), pad8(Vb), S[dt] * e4, 0, 0, 0); }
#pragma unroll
                for (int q = 0; q < 4; ++q) OT[(16u * kb + 4u * g + q) * 128u + 16u * w + li] = oa[q];
            }
            __syncthreads();
            { const unsigned tn = tidl >> 3, vg = tidl & 7u; f32x4 o[4]; float ss = 0.f;
#pragma unroll
              for (int i = 0; i < 4; ++i) { o[i] = *(const LAS f32x4*)(OT + tn * 128u + 16u * vg + 4u * i); ss += (o[i].x * o[i].x + o[i].y * o[i].y) + (o[i].z * o[i].z + o[i].w * o[i].w); }
              ss += __shfl_xor(ss, 1); ss += __shfl_xor(ss, 2); ss += __shfl_xor(ss, 4);
              const float r = 1.0f / sqrtf(ss * (1.0f / 128.f) + EPS); const float* gp = KIN(I_HGAIN) + j * 128 + 16 * vg;
#pragma unroll
              for (int i = 0; i < 4; ++i) o[i] = o[i] * r * *(const f32x4*)(gp + 4 * i);
              v4u w0, w1;
              w0.x = pk2(o[0].x * bflo(csg0.x), o[0].y * bfhi(csg0.x)); w0.y = pk2(o[0].z * bflo(csg0.y), o[0].w * bfhi(csg0.y)); w0.z = pk2(o[1].x * bflo(csg0.z), o[1].y * bfhi(csg0.z)); w0.w = pk2(o[1].z * bflo(csg0.w), o[1].w * bfhi(csg0.w));
              w1.x = pk2(o[2].x * bflo(csg1.x), o[2].y * bfhi(csg1.x)); w1.y = pk2(o[2].z * bflo(csg1.y), o[2].w * bfhi(csg1.y)); w1.z = pk2(o[3].x * bflo(csg1.z), o[3].y * bfhi(csg1.z)); w1.w = pk2(o[3].z * bflo(csg1.w), o[3].w * bfhi(csg1.w));
              bf16* op = O + (size_t)(row0 + (int)tn) * DM + h * 128 + 16 * vg; *(v4u*)op = w0; *(v4u*)(op + 8) = w1; }
        }
    }
}

struct Args { const void* in[22]; float* out; unsigned char* ws; int ph_lo, ph_hi; };
constexpr int PH_PER_LAYER = 9, NPHASES = 1 + DEPTH * PH_PER_LAYER + 1;

__global__ void __launch_bounds__(NWAVES * 64, 2) hybrid_fwd(Args args) {
    extern __shared__ __attribute__((aligned(16))) unsigned char lds[];
    Frame F;
    F.lds = (LAS unsigned char*)lds;
    F.tid = threadIdx.x; F.lane = F.tid & 63; F.wave = __builtin_amdgcn_readfirstlane(F.tid >> 6);
    F.G = gridDim.x; { const int bx = blockIdx.x; F.vcu = (F.G % 8 == 0) ? (bx % 8) * (F.G / 8) + bx / 8 : bx; }
    F.ws = args.ws; F.out = args.out; F.ctl = (unsigned*)(args.ws + WS_CTL);
    for (int u = F.tid; u < (LDS_BYTES - MISC_OFF) / 4; u += NWAVES * 64) ((LAS unsigned*)(F.lds + MISC_OFF))[u] = 0u;
    __syncthreads();
    const int lo = args.ph_lo, hi = args.ph_hi;
    XcdBarrier bar; bar.bar = F.ctl + CW_BAR; bar.x = 0; bar.st = nullptr;
    if (hi - lo > 1) bar = xcd_barrier_post(F.ctl + CW_BAR, (volatile LAS unsigned*)(F.lds + MISC_OFF) + 8);
#define IN(k) (lo <= (k) && (k) < hi)
#define SEAM(k) do { if (IN(k) && hi > (k) + 1) xcd_barrier(bar); } while (0)

    if (PH_EN(0) && IN(0)) { for (int rep = 0; rep < REPS(0); ++rep) p0_prologue(F); } SEAM(0);

#pragma unroll 1
    for (int l = 0; l < DEPTH; ++l) {
        const int pb = 1 + l * PH_PER_LAYER, j = l >> 1; const bool is_ret = (l & 1);
        if (PH_EN(1) && IN(pb + 0)) row_phase1(F, l, 0);
        SEAM(pb + 0);
        if (IN(pb + 1)) {
            if (PH_EN(2) && !is_ret) {
                pg8::Gemm g{(const bf16*)(F.ws + WS_H), (const bf16*)(F.ws + WS_HWIN) + (size_t)j * HG_N * DM, MTOK, HG_N, DM}; pg8::StaticOrder S; S.init(MTOK, HG_N, F.G, (int)blockIdx.x);
                EpiHgrnIn E{F.ws + WS_R1, (const float*)(F.ws + WS_LBV) + j * DM};
                for (int rep = 0; rep < REPS(2); ++rep) pg8::gemm_phase<EpiHgrnIn, pg8::StaticOrder, true, true>(F.lds + RING_OFF, g, S, E);
            } else if (PH_EN(3)) {
                pg8::Gemm g{(const bf16*)(F.ws + WS_H), (const bf16*)(F.ws + WS_RWIN) + (size_t)j * RT_N * DM, MTOK, RT_N, DM}; pg8::StaticOrder S; S.init(MTOK, RT_N, F.G, (int)blockIdx.x);
                EpiRetIn E{F.ws + WS_R1, (const int*)kin_(I_POS)};
                for (int rep = 0; rep < REPS(3); ++rep) pg8::gemm_phase<EpiRetIn, pg8::StaticOrder, true, true>(F.lds + RING_OFF, g, S, E);
            }
        }
        SEAM(pb + 1);
        if (IN(pb + 2)) { if (!is_ret) { if (PH_EN(4)) { for (int rep = 0; rep < REPS(4); ++rep) { if (HGRN_MFMA) hgrn_scan_mfma(F, j); else hgrn_scan(F, j); } } } else { if (PH_EN(5)) { for (int rep = 0; rep < REPS(5); ++rep) { if (RET_MFMA) ret_scan_mfma(F); else ret_scan(F); } } } }
        SEAM(pb + 2);
        if (RET_MFMA && PH_EN(12) && IN(pb + 3) && is_ret) ret_norm(F);
        if (RET_MFMA && is_ret) SEAM(pb + 3);
        if (PH_EN(6) && IN(pb + 4)) {
            const int Ko = is_ret ? 2048 : DM;
            const bf16* Wt = is_ret ? (const bf16*)(F.ws + WS_RWOUT) + (size_t)j * DM * 2048 : (const bf16*)(F.ws + WS_HWOUT) + (size_t)j * DM * DM;
            pg8::Gemm g{(const bf16*)(F.ws + WS_R2), Wt, MTOK, DM, Ko}; pg8::StaticOrder S; S.init(MTOK, DM, F.G, (int)blockIdx.x);
            EpiOut E{l == 0 ? KIN(I_X) : F.out, F.out, (const float*)(F.ws + WS_MOD) + (size_t)l * NBATCH * 6 * DM + 2 * DM};
            pg8::gemm_phase<EpiOut, pg8::StaticOrder, true, true>(F.lds + RING_OFF, g, S, E);
        }
        SEAM(pb + 4);
        if (PH_EN(7) && IN(pb + 5)) row_phase2(F, l);
        SEAM(pb + 5);
        if (MOE_GATHER_PASS) { if (PH_EN(8) && IN(pb + 6)) { for (int rep = 0; rep < REPS(8); ++rep) moe_gather(F, l); } SEAM(pb + 6); }
        if (PH_EN(9) && IN(pb + 7)) {
            build_tiles(F, l);
            if (!MOE_GATHER_PASS) moe_build_tt(F, 8);
            pg8::Gemm g{(const bf16*)(F.ws + (MOE_GATHER_PASS ? WS_R1 : WS_H)), (const bf16*)(F.ws + WS_W1T) + (size_t)l * NEXP * 2048 * DM, 0, 0, DM};
            pg8::MoeOrder S{8, F.G, F.vcu, (const LAS int*)(F.lds + TAB_OFF), (const LAS unsigned short*)(F.lds + 131072)};
            EpiMoe1 E{(bf16*)(F.ws + WS_R2), KIN(I_B1) + (size_t)l * NEXP * 2048};
            for (int rep = 0; rep < REPS(9); ++rep) pg8::gemm_phase<EpiMoe1, pg8::MoeOrder, true, true, !MOE_GATHER_PASS>(F.lds + RING_OFF, g, S, E);
        }
        SEAM(pb + 7);
        if (PH_EN(10) && IN(pb + 8)) {
            build_tiles(F, l);
            pg8::Gemm g{(const bf16*)(F.ws + WS_R2), (const bf16*)(F.ws + WS_W2T) + (size_t)l * NEXP * DM * DM, 0, 0, DM};
            pg8::MoeOrder S{4, F.G, F.vcu, (const LAS int*)(F.lds + TAB_OFF), nullptr};
            EpiMoe2 E{(bf16*)(F.ws + WS_R1), KIN(I_B2) + (size_t)l * NEXP * DM};
            for (int rep = 0; rep < REPS(10); ++rep) pg8::gemm_phase<EpiMoe2, pg8::MoeOrder, true, true>(F.lds + RING_OFF, g, S, E);
        }
        SEAM(pb + 8);
    }
    if (PH_EN(11) && IN(NPHASES - 1)) row_phase1(F, DEPTH, 1);
#undef IN
#undef SEAM
}

extern "C" void kernel_launch(void* const* d_in, const int* in_sizes, int n_in, void* d_out, int out_size, void* d_ws, size_t ws_size, hipStream_t stream) {
    static int grid = 0;
    if (grid == 0) {
        if (n_in != 22 || in_sizes[0] != MTOK * DM || out_size != MTOK * DM || ws_size < WS_END) { fprintf(stderr, "kernel_launch: unexpected shapes (n_in %d, in0 %d, out %d, ws %zu < %zu)\n", n_in, n_in > 0 ? in_sizes[0] : -1, out_size, ws_size, (size_t)WS_END); grid = -1; return; }
        int dev = 0, cus = 0, per_cu = 0;
        if (hipGetDevice(&dev) != hipSuccess || hipDeviceGetAttribute(&cus, hipDeviceAttributeMultiprocessorCount, dev) != hipSuccess) { grid = -1; return; }
        if (hipFuncSetAttribute((const void*)hybrid_fwd, hipFuncAttributeMaxDynamicSharedMemorySize, LDS_BYTES) != hipSuccess) { fprintf(stderr, "kernel_launch: hipFuncSetAttribute failed\n"); grid = -1; return; }
        if (hipOccupancyMaxActiveBlocksPerMultiprocessor(&per_cu, (const void*)hybrid_fwd, NWAVES * 64, LDS_BYTES) != hipSuccess || per_cu < 1) { fprintf(stderr, "kernel_launch: occupancy query says %d blocks per CU\n", per_cu); }
        (void)hipGetLastError();
        grid = cus;
    }
    if (grid < 0) return;
    (void)hipMemsetAsync((char*)d_ws + WS_CTL, 0, CTL_ZERO_BYTES, stream);
    Args a{};
    for (int i = 0; i < 22; ++i) a.in[i] = d_in[i];
    a.out = (float*)d_out; a.ws = (unsigned char*)d_ws;
#if MK_SPLIT
    for (int p = 0; p < DBG_LIMIT; ++p) {
        if (p >= 1 && p < NPHASES - 1 && ((p - 1) % PH_PER_LAYER) == 3 && (!RET_MFMA || (((p - 1) / PH_PER_LAYER) & 1) == 0)) continue;
        if (!MOE_GATHER_PASS && p >= 1 && p < NPHASES - 1 && ((p - 1) % PH_PER_LAYER) == 6) continue;
        a.ph_lo = p; a.ph_hi = p + 1;
        hipLaunchKernelGGL(hybrid_fwd, dim3(grid), dim3(NWAVES * 64), LDS_BYTES, stream, a);
    }
#else
    a.ph_lo = 0; a.ph_hi = NPHASES;
    hipLaunchKernelGGL(hybrid_fwd, dim3(grid), dim3(NWAVES * 64), LDS_BYTES, stream, a);
#endif
    const hipError_t le = hipPeekAtLastError();
    if (le != hipSuccess) fprintf(stderr, "kernel_launch: launch failed: %s\n", hipGetErrorName(le));
}
```

```cpp
#include <hip/hip_runtime.h>
#include <cstdio>
#include <cstdint>

#ifndef ONLY_PH
#define ONLY_PH -1
#endif
#define PH_EN(n) (ONLY_PH < 0 || ONLY_PH == (n))
#ifndef DBG_LIMIT
#define DBG_LIMIT NPHASES
#endif
#ifndef RET_MFMA
#define RET_MFMA 1
#endif
#ifndef HGRN_MFMA
#define HGRN_MFMA 1
#endif
#ifndef REPEAT_MASK
#define REPEAT_MASK 0
#endif
#define REPS(k) (1 + ((REPEAT_MASK >> (k)) & 1))
#ifndef MOE_GATHER_PASS
#define MOE_GATHER_PASS 0
#endif
#ifndef MOE_FP8
#define MOE_FP8 1
#endif
#ifndef MK_SPLIT
#define MK_SPLIT 0
#endif

namespace pg8 {
#define PG8_LAS __attribute__((address_space(3)))
typedef unsigned short bf16_t;
typedef short bf16x8 __attribute__((ext_vector_type(8)));
typedef float f32x4 __attribute__((ext_vector_type(4)));
typedef unsigned u32x4 __attribute__((ext_vector_type(4)));
constexpr int BM = 256, BK = 64, HALF = 128, HTB = HALF * BK * 2  , STAGE_BYTES = 8 * HTB, NXCD = 8, WGM = 8;

__host__ __device__ __forceinline__ int lds_byte(int r, int c) { const int st = (r >> 4) * 2 + (c >> 5), rr = r & 15, cc = c & 31, ob = rr * 64 + cc * 2; return st * 1024 + (ob ^ (((ob >> 9) & 1) << 5)); }
__host__ __device__ __forceinline__ void stage_rc(int b, int& R, int& C) { const int st = b / 1024, sb = b % 1024, swz = sb ^ (((sb >> 9) & 1) << 5); R = (st >> 1) * 16 + swz / 64; C = (st & 1) * 32 + (swz % 64) / 2; }
__host__ __device__ __forceinline__ int perm32(int rho) { const int n = rho >> 4, i = rho & 15; return 8 * (i >> 2) + 4 * n + (i & 3); }

struct Unit { int pm, pn, e, nn; };
struct Gemm { const bf16_t* A; const bf16_t* Bt; int M, N, K; };

struct StaticOrder {
    int nM, nN, nwg, G, c;
    __host__ __device__ void init(int M, int N, int G_, int c_) { nM = M / BM; nN = N / BM; nwg = nM * nN; G = G_; c = c_; }
    __host__ __device__ bool next(int i, Unit& u) const {
        const long L = (long)i * G + c; if (L >= nwg) return false;
        int wgid = (int)L; { const int q = nwg / NXCD, r = nwg % NXCD, xcd = wgid % NXCD, off = wgid / NXCD; wgid = (xcd < r ? xcd * (q + 1) : r * (q + 1) + (xcd - r) * q) + off; }
        const int nig = WGM * nN, gid = wgid / nig, fm = gid * WGM, gsz = (nM - fm) < WGM ? (nM - fm) : WGM;
        u.pm = fm + ((wgid % nig) % gsz); u.pn = (wgid % nig) / gsz; u.e = 0; u.nn = u.pn; return true;
    }
    __device__ __forceinline__ unsigned tok(int, int) const { return 0u; }
    __device__ __forceinline__ void a_ready(const Unit&) const {}
    __device__ __forceinline__ void done(const Unit&) const {}
};
struct MoeOrder {
    int nN, G, c; const PG8_LAS int* ts; const PG8_LAS unsigned short* tt;
    __device__ __forceinline__ unsigned tok(int i, int r) const { return tt[i * 256 + r]; }
    __device__ __forceinline__ bool next(int i, Unit& u) const {
        const int NT = ts[32]; const long L = (long)i * G + c; if (L >= (long)NT * nN) return false;
        const int mt = (int)(L / nN), n = (int)(L % nN); int e = 0;
        for (int k = 1; k < 32; ++k) e += (ts[k] <= mt) ? 1 : 0;
        u.pm = mt; u.pn = e * nN + n; u.e = e; u.nn = n; return true;
    }
    __device__ __forceinline__ void a_ready(const Unit&) const {}
    __device__ __forceinline__ void done(const Unit&) const {}
};

__device__ __forceinline__ unsigned cvt_pk_bf16(float lo, float hi) { unsigned r; asm volatile("v_cvt_pk_bf16_f32 %0, %1, %2" : "=v"(r) : "v"(lo), "v"(hi)); return r; }

typedef int v8i32 __attribute__((ext_vector_type(8)));
template <class Epi, class Sched, bool ALIGN_EPI = false, bool SP2 = false, bool GATHER = false, bool FP8 = false>
__device__ __forceinline__ void gemm_phase(PG8_LAS unsigned char* lds, const Gemm g, const Sched& S, const Epi& E) {
    int tid_ = threadIdx.x; asm volatile("" : "+v"(tid_));
    const int tid = tid_, wid = __builtin_amdgcn_readfirstlane(tid >> 6), lane = tid & 63, wr = wid >> 2, wc = wid & 3, fr = lane & 15, fq = lane >> 4;
    const int K = g.K, nt = K / BK;
    unsigned voffA[2], voffB[2];
#pragma unroll
    for (int i = 0; i < 2; ++i) { int R, C; stage_rc(tid * 16 + i * 8192, R, C); const int Rb = Epi::PERM ? ((R & ~31) + perm32(R & 31)) : R;
        voffA[i] = (unsigned)(R * K + C) * 2u; voffB[i] = (unsigned)(Rb * K + C) * 2u; }
    int gR[2]; unsigned gC[2];
#pragma unroll
    for (int i = 0; i < 2; ++i) { int R, C; stage_rc(tid * 16 + i * 8192, R, C); gR[i] = R; gC[i] = (unsigned)C * 2u; }
#define PG8_GVOFF(v, ui_, h_) do { _Pragma("unroll") for (int _i = 0; _i < 2; ++_i) v[_i] = (S.tok((ui_), gR[_i] + HALF * (h_)) * (unsigned)(K * 2)) + gC[_i]; } while (0)
    const size_t kstep = (size_t)(BK * 2);
    const size_t hstep = (size_t)HALF * K * 2;
    const size_t tstep = 2 * hstep;
    const unsigned ldsw = (unsigned)wid * 1024u;
    const int aoff = FP8 ? lds_byte(wr * 64 + fr, fq * 16) : lds_byte(wr * 64 + fr, fq * 8), boff = FP8 ? lds_byte(wc * 32 + fr, fq * 16) : lds_byte(wc * 32 + fr, fq * 8);

#define PG8_SA(b, h) (((b) * 2 + (h)) * HTB)
#define PG8_SB(b, h) ((4 + (b) * 2 + (h)) * HTB)
#define PG8_STAGE(bufoff, gbase, voff) do { _Pragma("unroll") for (int _i = 0; _i < 2; ++_i) \
        __builtin_amdgcn_global_load_lds((const unsigned*)((const char*)(gbase) + (voff)[_i]), (PG8_LAS unsigned*)(lds + (bufoff) + ldsw + _i * 8192), 16, 0, 0); } while (0)
#define PG8_LDA(dst, b, h) do { if constexpr (FP8) { _Pragma("unroll") for (int m = 0; m < 4; ++m) { const u32x4 p0_ = *(const PG8_LAS u32x4*)(lds + PG8_SA(b, h) + aoff + m * 2048), p1_ = *(const PG8_LAS u32x4*)(lds + PG8_SA(b, h) + aoff + m * 2048 + 16); dst##8[m] = __builtin_bit_cast(v8i32, __builtin_shufflevector(p0_, p1_, 0, 1, 2, 3, 4, 5, 6, 7)); } } \
    else { _Pragma("unroll") for (int m = 0; m < 4; ++m) _Pragma("unroll") for (int k = 0; k < 2; ++k) dst[m][k] = *(const PG8_LAS bf16x8*)(lds + PG8_SA(b, h) + aoff + m * 2048 + k * 1024); } } while (0)
#define PG8_LDB(dst, b, h) do { if constexpr (FP8) { _Pragma("unroll") for (int n = 0; n < 2; ++n) { const u32x4 p0_ = *(const PG8_LAS u32x4*)(lds + PG8_SB(b, h) + boff + n * 2048), p1_ = *(const PG8_LAS u32x4*)(lds + PG8_SB(b, h) + boff + n * 2048 + 16); dst##8[n] = __builtin_bit_cast(v8i32, __builtin_shufflevector(p0_, p1_, 0, 1, 2, 3, 4, 5, 6, 7)); } } \
    else { _Pragma("unroll") for (int n = 0; n < 2; ++n) _Pragma("unroll") for (int k = 0; k < 2; ++k) dst[n][k] = *(const PG8_LAS bf16x8*)(lds + PG8_SB(b, h) + boff + n * 2048 + k * 1024); } } while (0)
#define PG8_CAT(x) __builtin_shufflevector(__builtin_bit_cast(u32x4, (x)[0]), __builtin_bit_cast(u32x4, (x)[1]), 0, 1, 2, 3, 4, 5, 6, 7)
#define PG8_MMA(ai, bj, At, Bt) do { __builtin_amdgcn_s_setprio(1); if constexpr (FP8) { _Pragma("unroll") for (int m = 0; m < 4; ++m) _Pragma("unroll") for (int n = 0; n < 2; ++n) \
        asm volatile("v_mfma_scale_f32_16x16x128_f8f6f4 %0, %1, %2, %0, %3, %3 op_sel_hi:[0,0,0]" : "+v"(acc[ai][bj][m][n]) : "v"(Bt##8[n]), "v"(At##8[m]), "v"(scl1)); } \
    else { _Pragma("unroll") for (int m = 0; m < 4; ++m) _Pragma("unroll") for (int n = 0; n < 2; ++n) _Pragma("unroll") for (int k = 0; k < 2; ++k) \
        acc[ai][bj][m][n] = __builtin_amdgcn_mfma_f32_16x16x32_bf16(Bt[n][k], At[m][k], acc[ai][bj][m][n], 0, 0, 0); } __builtin_amdgcn_s_setprio(0); } while (0)
#define PG8_WAIT_V(n) asm volatile("s_waitcnt vmcnt(" #n ")" ::: "memory")
#define PG8_WAIT_L(n) asm volatile("s_waitcnt lgkmcnt(" #n ")" ::: "memory")
#define PG8_BAR __builtin_amdgcn_s_barrier()
#define PG8_SCHED __builtin_amdgcn_sched_barrier(0)
    Unit cur, nxt; int ui = 0;
    if (!S.next(0, cur)) return;
    f32x4 acc[2][2][4][2];
#pragma unroll
    for (int a = 0; a < 2; ++a)
#pragma unroll
        for (int b = 0; b < 2; ++b)
#pragma unroll
            for (int m = 0; m < 4; ++m)
#pragma unroll
                for (int n = 0; n < 2; ++n) acc[a][b][m][n] = (f32x4){0.f, 0.f, 0.f, 0.f};
    const unsigned scl1 = 0x7f7f7f7fu;
    bf16x8 At[4][2], B0[2][2], B1[2][2]; v8i32 At8[4], B08[2], B18[2];
    const char* cA = GATHER ? (const char*)g.A : (const char*)g.A + (size_t)cur.pm * tstep; const char* cB = (const char*)g.Bt + (size_t)cur.pn * tstep;
    S.a_ready(cur);
    static_assert(!GATHER || SP2, "GATHER is written for the SP2 loop");
    if constexpr (SP2) {
        if constexpr (GATHER) { unsigned v0[2], v1[2]; PG8_GVOFF(v0, 0, 0); PG8_GVOFF(v1, 0, 1); PG8_STAGE(PG8_SB(0, 0), cB, voffB); PG8_STAGE(PG8_SB(0, 1), cB + hstep, voffB); PG8_STAGE(PG8_SA(0, 0), cA, v0); PG8_STAGE(PG8_SA(0, 1), cA, v1); }
        else { PG8_STAGE(PG8_SB(0, 0), cB, voffB); PG8_STAGE(PG8_SB(0, 1), cB + hstep, voffB); PG8_STAGE(PG8_SA(0, 0), cA, voffA); PG8_STAGE(PG8_SA(0, 1), cA + hstep, voffA); }
        if (wr == 1) PG8_BAR;
        PG8_WAIT_V(2); PG8_BAR;
        if constexpr (GATHER) { unsigned v0[2]; PG8_GVOFF(v0, 0, 0); PG8_STAGE(PG8_SB(1, 0), cB + kstep, voffB); PG8_STAGE(PG8_SA(1, 0), cA + kstep, v0); PG8_STAGE(PG8_SB(1, 1), cB + hstep + kstep, voffB); }
        else { PG8_STAGE(PG8_SB(1, 0), cB + kstep, voffB); PG8_STAGE(PG8_SA(1, 0), cA + kstep, voffA); PG8_STAGE(PG8_SB(1, 1), cB + hstep + kstep, voffB); }
        PG8_WAIT_V(6); PG8_BAR;
    } else {
        PG8_STAGE(PG8_SB(0, 0), cB, voffB); PG8_STAGE(PG8_SA(0, 0), cA, voffA); PG8_STAGE(PG8_SB(0, 1), cB + hstep, voffB); PG8_STAGE(PG8_SA(0, 1), cA + hstep, voffA);
        if (wr == 1) PG8_BAR;
        PG8_WAIT_V(4); PG8_BAR;
        PG8_STAGE(PG8_SB(1, 0), cB + kstep, voffB); PG8_STAGE(PG8_SA(1, 0), cA + kstep, voffA); PG8_STAGE(PG8_SB(1, 1), cB + hstep + kstep, voffB);
        PG8_WAIT_V(6); PG8_BAR;
    }
    for (;;) {
        const bool has_next = S.next(ui + 1, nxt);
        const char* nA = GATHER ? cA : (has_next ? (const char*)g.A + (size_t)nxt.pm * tstep : cA); const char* nB = has_next ? (const char*)g.Bt + (size_t)nxt.pn * tstep : cB;
#pragma unroll 1
        for (int t = 0; t < nt; t += 2) {
            asm volatile("" : "+v"(voffA[0]), "+v"(voffA[1]), "+v"(voffB[0]), "+v"(voffB[1]));
            const bool last = (t == nt - 2);
            const char* a1 = cA + (size_t)(t + 1) * kstep;
            const char* a2 = last ? nA : cA + (size_t)(t + 2) * kstep; const char* b2 = last ? nB : cB + (size_t)(t + 2) * kstep;
            const char* a3 = a2 + kstep; const char* b3 = b2 + kstep;
            if (last && has_next) S.a_ready(nxt);
            if constexpr (SP2 && GATHER) {
            const int uix = (last && has_next) ? ui + 1 : ui;
            unsigned vc1[2], vx0[2], vx1[2]; PG8_GVOFF(vc1, ui, 1); PG8_GVOFF(vx0, uix, 0); PG8_GVOFF(vx1, uix, 1);
            PG8_LDB(B0, 0, 0); PG8_LDB(B1, 0, 1); PG8_SCHED; PG8_LDA(At, 0, 0); PG8_STAGE(PG8_SA(1, 1), a1, vc1);
            PG8_WAIT_V(8); PG8_WAIT_L(0); PG8_BAR; PG8_MMA(0, 0, At, B0); PG8_MMA(0, 1, At, B1); PG8_BAR; PG8_SCHED;
            PG8_LDA(At, 0, 1); PG8_STAGE(PG8_SB(0, 0), b2, voffB); PG8_STAGE(PG8_SB(0, 1), b2 + hstep, voffB); PG8_STAGE(PG8_SA(0, 0), a2, vx0);
            PG8_WAIT_V(8); PG8_WAIT_L(0); PG8_BAR; PG8_MMA(1, 0, At, B0); PG8_MMA(1, 1, At, B1); PG8_BAR; PG8_SCHED;
            PG8_LDB(B0, 1, 0); PG8_LDB(B1, 1, 1); PG8_SCHED; PG8_LDA(At, 1, 0); PG8_STAGE(PG8_SA(0, 1), a2, vx1);
            PG8_WAIT_V(8); PG8_WAIT_L(0); PG8_BAR; PG8_MMA(0, 0, At, B0); PG8_MMA(0, 1, At, B1); PG8_BAR; PG8_SCHED;
            PG8_LDA(At, 1, 1); PG8_STAGE(PG8_SB(1, 0), b3, voffB); PG8_STAGE(PG8_SB(1, 1), b3 + hstep, voffB); PG8_STAGE(PG8_SA(1, 0), a3, vx0);
            PG8_WAIT_V(8); PG8_WAIT_L(0); PG8_BAR; PG8_MMA(1, 0, At, B0); PG8_MMA(1, 1, At, B1); PG8_BAR; PG8_SCHED;
            } else if constexpr (SP2) {
            PG8_LDB(B0, 0, 0); PG8_LDB(B1, 0, 1); PG8_SCHED; PG8_LDA(At, 0, 0); PG8_STAGE(PG8_SA(1, 1), a1 + hstep, voffA);
            PG8_WAIT_V(8); PG8_WAIT_L(0); PG8_BAR; PG8_MMA(0, 0, At, B0); PG8_MMA(0, 1, At, B1); PG8_BAR; PG8_SCHED;
            PG8_LDA(At, 0, 1); PG8_STAGE(PG8_SB(0, 0), b2, voffB); PG8_STAGE(PG8_SB(0, 1), b2 + hstep, voffB); PG8_STAGE(PG8_SA(0, 0), a2, voffA);
            PG8_WAIT_V(8); PG8_WAIT_L(0); PG8_BAR; PG8_MMA(1, 0, At, B0); PG8_MMA(1, 1, At, B1); PG8_BAR; PG8_SCHED;
            PG8_LDB(B0, 1, 0); PG8_LDB(B1, 1, 1); PG8_SCHED; PG8_LDA(At, 1, 0); PG8_STAGE(PG8_SA(0, 1), a2 + hstep, voffA);
            PG8_WAIT_V(8); PG8_WAIT_L(0); PG8_BAR; PG8_MMA(0, 0, At, B0); PG8_MMA(0, 1, At, B1); PG8_BAR; PG8_SCHED;
            PG8_LDA(At, 1, 1); PG8_STAGE(PG8_SB(1, 0), b3, voffB); PG8_STAGE(PG8_SB(1, 1), b3 + hstep, voffB); PG8_STAGE(PG8_SA(1, 0), a3, voffA);
            PG8_WAIT_V(8); PG8_WAIT_L(0); PG8_BAR; PG8_MMA(1, 0, At, B0); PG8_MMA(1, 1, At, B1); PG8_BAR; PG8_SCHED;
            } else {
            PG8_LDB(B0, 0, 0); PG8_SCHED; PG8_LDA(At, 0, 0); PG8_STAGE(PG8_SA(1, 1), a1 + hstep, voffA);
            PG8_WAIT_L(8); PG8_BAR; PG8_WAIT_L(0); PG8_MMA(0, 0, At, B0); PG8_BAR; PG8_SCHED;
            PG8_LDB(B1, 0, 1); PG8_STAGE(PG8_SB(0, 0), b2, voffB);
            PG8_BAR; PG8_WAIT_L(0); PG8_MMA(0, 1, At, B1); PG8_BAR;
            PG8_LDA(At, 0, 1); PG8_STAGE(PG8_SA(0, 0), a2, voffA);
            PG8_BAR; PG8_WAIT_L(0); PG8_MMA(1, 0, At, B0); PG8_BAR; PG8_SCHED;
            PG8_STAGE(PG8_SB(0, 1), b2 + hstep, voffB);
            PG8_WAIT_V(6); PG8_BAR; PG8_MMA(1, 1, At, B1); PG8_BAR;
            PG8_LDB(B0, 1, 0); PG8_SCHED; PG8_LDA(At, 1, 0); PG8_STAGE(PG8_SA(0, 1), a2 + hstep, voffA);
            PG8_WAIT_L(8); PG8_BAR; PG8_WAIT_L(0); PG8_MMA(0, 0, At, B0); PG8_BAR; PG8_SCHED;
            PG8_LDB(B1, 1, 1); PG8_STAGE(PG8_SB(1, 0), b3, voffB);
            PG8_BAR; PG8_WAIT_L(0); PG8_MMA(0, 1, At, B1); PG8_BAR;
            PG8_LDA(At, 1, 1); PG8_STAGE(PG8_SA(1, 0), a3, voffA);
            PG8_BAR; PG8_WAIT_L(0); PG8_MMA(1, 0, At, B0); PG8_BAR; PG8_SCHED;
            PG8_STAGE(PG8_SB(1, 1), b3 + hstep, voffB);
            PG8_WAIT_V(6); PG8_BAR; PG8_MMA(1, 1, At, B1); PG8_BAR;
            }
        }
        if constexpr (ALIGN_EPI) { if (wr == 0) PG8_BAR; }
        if constexpr (FP8) asm volatile("s_nop 15\n\ts_nop 7" ::: "memory");
        { int te = threadIdx.x; asm volatile("" : "+v"(te));
          E(acc, cur, wr, wc, te & 15, (te & 63) >> 4); }
        if (!has_next) break;
#pragma unroll
        for (int a = 0; a < 2; ++a)
#pragma unroll
            for (int b = 0; b < 2; ++b)
#pragma unroll
                for (int m = 0; m < 4; ++m)
#pragma unroll
                    for (int n = 0; n < 2; ++n) acc[a][b][m][n] = (f32x4){0.f, 0.f, 0.f, 0.f};
        cur = nxt; cA = nA; cB = nB; ++ui;
        if constexpr (ALIGN_EPI) { if (wr == 1) PG8_BAR; }
    }
    PG8_WAIT_V(0);
    if constexpr (!ALIGN_EPI) { if (wr == 0) PG8_BAR; }
    PG8_BAR;
#undef PG8_GVOFF
#undef PG8_CAT
#undef PG8_SA
#undef PG8_SB
#undef PG8_STAGE
#undef PG8_LDA
#undef PG8_LDB
#undef PG8_MMA
#undef PG8_WAIT_V
#undef PG8_WAIT_L
#undef PG8_BAR
#undef PG8_SCHED
}
}

constexpr int NWAVES = 8;
constexpr int DM = 1024, NBATCH = 32, SEQ = 2048, MTOK = NBATCH * SEQ, DEPTH = 4, NEXP = 32, TOPK = 4;
constexpr int HG_N = 4096, RT_N = 6144, HG_H = 8, RT_H = 4;
constexpr float EPS = 1e-6f;
constexpr int LCAP = 65536;
constexpr int MAXTILES = 1056;

constexpr size_t MiB = 1u << 20;
constexpr size_t WS_CTL = 0, CTL_ZERO_BYTES = 1 * MiB;
constexpr size_t WS_MOD = 1 * MiB;
constexpr size_t WS_FMOD = 4 * MiB;
constexpr size_t WS_LBV = 4 * MiB + 512 * 1024;
constexpr size_t WS_HWIN = 8 * MiB, WS_HWOUT = 24 * MiB, WS_RWIN = 28 * MiB, WS_RWOUT = 52 * MiB, WS_W1T = 64 * MiB, WS_W2T = 576 * MiB;
constexpr size_t WS_H = 832 * MiB;
constexpr size_t WS_LIST = 960 * MiB;
constexpr size_t WS_TSLOT = 968 * MiB, WS_TGATE = 969 * MiB;
constexpr size_t WS_R1 = 976 * MiB;
constexpr size_t WS_R2 = 1744 * MiB;
constexpr size_t WS_H8 = 2272 * MiB;
constexpr size_t WS_END = 2336 * MiB;
constexpr int CW_BAR = 4096;
constexpr int CW_CNT = 8192;

constexpr int RING_OFF = 0, RING_BYTES = 131072;
constexpr int MISC_OFF = 155648;
constexpr int TAB_OFF = MISC_OFF + 128;
constexpr int LDS_BYTES = 160 * 1024;

#define GAS __attribute__((address_space(1)))
#define LAS __attribute__((address_space(3)))
typedef unsigned short bf16;
typedef unsigned v4u __attribute__((ext_vector_type(4)));
typedef unsigned v2u __attribute__((ext_vector_type(2)));
typedef float f32x4 __attribute__((ext_vector_type(4)));
typedef short bf16x8 __attribute__((ext_vector_type(8)));
#define RLX_AGENT __ATOMIC_RELAXED, __HIP_MEMORY_SCOPE_AGENT
#define LDS_WAIT() asm volatile("s_waitcnt lgkmcnt(0)" ::: "memory")
#define VM_WAIT() asm volatile("s_waitcnt vmcnt(0)" ::: "memory")
__device__ __forceinline__ unsigned pk2(float lo, float hi) { return pg8::cvt_pk_bf16(lo, hi); }
__device__ __forceinline__ unsigned pk4_fp8(float a, float b, float c, float d) { int p = 0; p = __builtin_amdgcn_cvt_pk_fp8_f32(a, b, p, false); p = __builtin_amdgcn_cvt_pk_fp8_f32(c, d, p, true); return (unsigned)p; }
__device__ __forceinline__ float bflo(unsigned w) { return __uint_as_float(w << 16); }
__device__ __forceinline__ float bfhi(unsigned w) { return __uint_as_float(w & 0xffff0000u); }
__device__ __forceinline__ float bf2f(unsigned short h) { return __uint_as_float(((unsigned)h) << 16); }
__device__ __forceinline__ float sigmoidf_(float x) { return __builtin_amdgcn_rcpf(1.f + __expf(-x)); }
__device__ __forceinline__ float siluf_(float x) { return x * sigmoidf_(x); }
__device__ __forceinline__ unsigned ldu_vec(const unsigned* p) { return __hip_atomic_load(p, RLX_AGENT); }

#define XB_TMO      128
#define XB_XCNT(j)  (256  + 64 * (j))
#define XB_XSUB(j)  (1280 + 64 * (j))
#define XB_XGEN(j)  (2304 + 64 * (j))
#define XB_TOP      3328
#define XB_TOPGEN   3392
#define XCD_BAR_WORDS 3456
#define XB_SPIN_CAP (1u << 18)

__device__ __forceinline__ unsigned xb_ld(unsigned* p)              { return __hip_atomic_load(p, __ATOMIC_RELAXED, __HIP_MEMORY_SCOPE_AGENT); }
__device__ __forceinline__ unsigned xb_add(unsigned* p, unsigned v) { return __hip_atomic_fetch_add(p, v, __ATOMIC_RELAXED, __HIP_MEMORY_SCOPE_AGENT); }
__device__ __forceinline__ unsigned xb_xcc_id() { return (unsigned)__builtin_amdgcn_s_getreg((3 << 11) | 20) & 0xFu; }
#define XB_SPIN(cond, bar) do { unsigned _sp = 0; while (cond) { __builtin_amdgcn_s_sleep(1); \
    if ((++_sp & 255u) == 0u) { if (xb_ld(&(bar)[XB_TMO])) break; if (_sp > XB_SPIN_CAP) { atomicAdd(&(bar)[XB_TMO], 1u); break; } } } } while (0)

struct XcdBarrier {
    unsigned* bar; unsigned x;
    volatile LAS unsigned* st;
};
__device__ __forceinline__ XcdBarrier xcd_barrier_post(unsigned* bar, volatile LAS unsigned* st) {
    XcdBarrier b; b.bar = bar; b.x = xb_xcc_id(); b.st = st;
    if (threadIdx.x == 0) (void)xb_add(&bar[XB_XCNT(b.x)], 1u);
    return b;
}
__device__ __forceinline__ void xcd_barrier_complete(unsigned* bar, unsigned x, unsigned& nloc, unsigned& nx) {
    const unsigned G = gridDim.x * gridDim.y * gridDim.z;
    unsigned sum, cnt, mine, sp = 0u;
    for (;;) {
        sum = 0u; cnt = 0u; mine = 0u;
#pragma unroll
        for (unsigned j = 0; j < 16; ++j) { const unsigned c = xb_ld(&bar[XB_XCNT(j)]); sum += c; cnt += (c > 0u) ? 1u : 0u; mine = (j == x) ? c : mine; }
        if (sum == G) break;
        __builtin_amdgcn_s_sleep(1);
        if ((++sp & 255u) == 0u) { if (xb_ld(&bar[XB_TMO])) break; if (sp > XB_SPIN_CAP) { atomicAdd(&bar[XB_TMO], 1u); break; } }
    }
    nloc = mine > 0u ? mine : 1u; nx = cnt > 0u ? cnt : 1u;
}
__device__ __forceinline__ void xcd_barrier(const XcdBarrier& b) {
    asm volatile("s_waitcnt vmcnt(0)" ::: "memory");
    __syncthreads();
    if (threadIdx.x == 0) {
        unsigned* bar = b.bar;
        __builtin_amdgcn_s_waitcnt(0);
        unsigned nloc = b.st[0], nx = b.st[1];
        if (nloc == 0u) { xcd_barrier_complete(bar, b.x, nloc, nx); b.st[0] = nloc; b.st[1] = nx; }
        const unsigned old = xb_add(&bar[XB_XSUB(b.x)], 1u);
        const unsigned gen = old / nloc;
        if (old + 1u == (gen + 1u) * nloc) {
            __builtin_amdgcn_fence(__ATOMIC_RELEASE, "agent");
            asm volatile("s_waitcnt vmcnt(0)" ::: "memory");
            const unsigned og = xb_add(&bar[XB_TOP], 1u);
            const unsigned tg = og / nx;
            if (og + 1u == (tg + 1u) * nx) xb_add(&bar[XB_TOPGEN], 1u);
            else XB_SPIN(xb_ld(&bar[XB_TOPGEN]) == tg, bar);
            __builtin_amdgcn_fence(__ATOMIC_ACQUIRE, "agent");
            xb_add(&bar[XB_XGEN(b.x)], 1u);
            asm volatile("s_waitcnt vmcnt(0)" ::: "memory");
        } else {
            XB_SPIN(xb_ld(&bar[XB_XGEN(b.x)]) == gen, bar);
            __builtin_amdgcn_fence(__ATOMIC_ACQUIRE, "agent");
            asm volatile("s_waitcnt vmcnt(0)" ::: "memory");
        }
    }
    __syncthreads();
}

struct Frame {
    LAS unsigned char* lds;
    unsigned* ctl;
    int tid, lane, wave, vcu, G;
    float* out; unsigned char* ws;
};
__device__ __forceinline__ void relaunder(Frame& F) { int t = threadIdx.x; asm volatile("" : "+v"(t)); F.tid = t; F.lane = t & 63; F.wave = __builtin_amdgcn_readfirstlane(t >> 6); }
#define KAS __attribute__((address_space(4)))
__device__ __forceinline__ const void* kin_(int i) { const KAS char* kp = (const KAS char*)__builtin_amdgcn_kernarg_segment_ptr(); asm volatile("" : "+s"(kp)); return *(const void* const KAS*)(kp + 8 * i); }
enum { I_X = 0, I_C, I_POS, I_ADAW, I_ADAB, I_N1G, I_N2G, I_HWIN, I_HWOUT, I_HGAIN, I_HLB, I_RWIN, I_RWOUT, I_RTW, I_RTB, I_W1, I_B1, I_W2, I_B2, I_FG, I_FADAW, I_FADAB };
#define KIN(i) ((const float*)kin_(i))
__device__ __forceinline__ float wave_sum(float v) {
#pragma unroll
    for (int o = 1; o < 64; o <<= 1) v += __shfl_xor(v, o);
    return v;
}

__device__ __forceinline__ void p0_transpose_item(const float* W, int N, bf16* WT, int K, int k0, int n0, int drow0, LAS float* scr, int lane) {
#pragma unroll 8
    for (int i = 0; i < 32; ++i) { const int kk = 2 * i + (lane >> 5); scr[kk * 33 + (lane & 31)] = W[(size_t)(k0 + kk) * N + n0 + (lane & 31)]; }
    LDS_WAIT(); asm volatile("" ::: "memory");
    const int c = lane & 7;
#pragma unroll
    for (int j = 0; j < 4; ++j) { const int n = (lane >> 3) + 8 * j; const LAS float* s = scr + (8 * c) * 33 + n;
        v4u o; o.x = pk2(s[0 * 33], s[1 * 33]); o.y = pk2(s[2 * 33], s[3 * 33]); o.z = pk2(s[4 * 33], s[5 * 33]); o.w = pk2(s[6 * 33], s[7 * 33]);
        *(GAS v4u*)(WT + (size_t)(drow0 + n) * K + k0 + 8 * c) = o; }
    LDS_WAIT(); asm volatile("" ::: "memory");
}
__device__ __forceinline__ void p0_transpose_item_f8(const float* W, int N, unsigned char* WT, int K, int k0, int n0, int drow0, LAS float* scr, int lane, float scale) {
#pragma unroll 8
    for (int i = 0; i < 32; ++i) { const int kk = 2 * i + (lane >> 5); scr[kk * 33 + (lane & 31)] = W[(size_t)(k0 + kk) * N + n0 + (lane & 31)]; }
    LDS_WAIT(); asm volatile("" ::: "memory");
    const int n = lane >> 1, hf = lane & 1; const LAS float* sp = scr + (32 * hf) * 33 + n;
    v4u o0, o1;
    o0.x = pk4_fp8(sp[0 * 33] * scale, sp[1 * 33] * scale, sp[2 * 33] * scale, sp[3 * 33] * scale); o0.y = pk4_fp8(sp[4 * 33] * scale, sp[5 * 33] * scale, sp[6 * 33] * scale, sp[7 * 33] * scale);
    o0.z = pk4_fp8(sp[8 * 33] * scale, sp[9 * 33] * scale, sp[10 * 33] * scale, sp[11 * 33] * scale); o0.w = pk4_fp8(sp[12 * 33] * scale, sp[13 * 33] * scale, sp[14 * 33] * scale, sp[15 * 33] * scale);
    o1.x = pk4_fp8(sp[16 * 33] * scale, sp[17 * 33] * scale, sp[18 * 33] * scale, sp[19 * 33] * scale); o1.y = pk4_fp8(sp[20 * 33] * scale, sp[21 * 33] * scale, sp[22 * 33] * scale, sp[23 * 33] * scale);
    o1.z = pk4_fp8(sp[24 * 33] * scale, sp[25 * 33] * scale, sp[26 * 33] * scale, sp[27 * 33] * scale); o1.w = pk4_fp8(sp[28 * 33] * scale, sp[29 * 33] * scale, sp[30 * 33] * scale, sp[31 * 33] * scale);
    unsigned char* d = WT + (size_t)(drow0 + n) * K + k0 + 32 * hf; *(GAS v4u*)d = o0; *(GAS v4u*)(d + 16) = o1;
    LDS_WAIT(); asm volatile("" ::: "memory");
}
__device__ __forceinline__ void p0_prologue(Frame& F) {
    relaunder(F);
    __syncthreads();
    const int gw = F.vcu * NWAVES + F.wave, NGW = F.G * NWAVES;
    {
        LAS float* condT = (LAS float*)(F.lds + RING_OFF);
        const float* cin = KIN(I_C);
        for (int idx = F.tid; idx < NBATCH * DM; idx += NWAVES * 64) { const int b = idx >> 10, k = idx & 1023; condT[k * 32 + b] = siluf_(cin[idx]); }
        __syncthreads();
        if ((gw & 3) == 0 && (gw >> 2) < 416) {
            const int u = gw >> 2; const float* W; const float* bias; float* outp; int N, n0, ostride;
            if (u < 384) { const int l = u / 96; n0 = (u % 96) * 64; N = 6 * DM; W = KIN(I_ADAW) + (size_t)l * DM * N; bias = KIN(I_ADAB) + l * N; outp = (float*)(F.ws + WS_MOD) + (size_t)l * NBATCH * N; ostride = N; }
            else { n0 = (u - 384) * 64; N = 2 * DM; W = KIN(I_FADAW); bias = KIN(I_FADAB); outp = (float*)(F.ws + WS_FMOD); ostride = N; }
            float acc[32];
#pragma unroll
            for (int b = 0; b < 32; ++b) acc[b] = 0.f;
#pragma unroll 4
            for (int k = 0; k < DM; ++k) {
                const float w = W[(size_t)k * N + n0 + F.lane];
                const LAS f32x4* cb = (const LAS f32x4*)(condT + k * 32);
#pragma unroll
                for (int q = 0; q < 8; ++q) { const f32x4 cv = cb[q]; acc[4 * q + 0] += cv.x * w; acc[4 * q + 1] += cv.y * w; acc[4 * q + 2] += cv.z * w; acc[4 * q + 3] += cv.w * w; }
            }
            const float bv = bias[n0 + F.lane];
#pragma unroll
            for (int b = 0; b < 32; ++b) outp[(size_t)b * ostride + n0 + F.lane] = acc[b] + bv;
        }
        if (gw == NGW - 1) {
            float* lbv = (float*)(F.ws + WS_LBV); const float* hlb = KIN(I_HLB);
            for (int d = F.lane; d < DM; d += 64) { const float a = hlb[d], b = hlb[DM + d], m = fmaxf(a, b), ea = __expf(a - m), eb = __expf(b - m); lbv[d] = 0.f; lbv[DM + d] = eb / (ea + eb); }
        }
        __syncthreads();
    }
    {
        LAS float* scr = (LAS float*)(F.lds + RING_OFF + F.wave * 16384);
        constexpr int NI_HI = 2 * 16 * 128, NI_HO = 2 * 16 * 32, NI_RI = 2 * 16 * 192, NI_RO = 2 * 32 * 32, NI_W1 = 128 * 16 * 64, NI_W2 = 128 * 16 * 32;
        constexpr int NITEMS = NI_HI + NI_HO + NI_RI + NI_RO + NI_W1 + NI_W2;
        for (int it = gw; it < NITEMS; it += NGW) {
            int r = it;
            if (r < NI_HI) { const int j = r / 2048, q = r % 2048, kb = q / 128, nb = q % 128;
                p0_transpose_item(KIN(I_HWIN) + (size_t)j * DM * HG_N, HG_N, (bf16*)(F.ws + WS_HWIN) + (size_t)j * HG_N * DM, DM, 64 * kb, 32 * nb, 32 * nb, scr, F.lane); continue; } r -= NI_HI;
            if (r < NI_HO) { const int j = r / 512, q = r % 512, kb = q / 32, nb = q % 32;
                p0_transpose_item(KIN(I_HWOUT) + (size_t)j * DM * DM, DM, (bf16*)(F.ws + WS_HWOUT) + (size_t)j * DM * DM, DM, 64 * kb, 32 * nb, 32 * nb, scr, F.lane); continue; } r -= NI_HO;
            if (r < NI_RI) { const int j = r / 3072, q = r % 3072, kb = q / 192, nb = q % 192;
                p0_transpose_item(KIN(I_RWIN) + (size_t)j * DM * RT_N, RT_N, (bf16*)(F.ws + WS_RWIN) + (size_t)j * RT_N * DM, DM, 64 * kb, 32 * nb, 32 * nb, scr, F.lane); continue; } r -= NI_RI;
            if (r < NI_RO) { const int j = r / 1024, q = r % 1024, kb = q / 32, nb = q % 32;
                p0_transpose_item(KIN(I_RWOUT) + (size_t)j * 2048 * DM, DM, (bf16*)(F.ws + WS_RWOUT) + (size_t)j * DM * 2048, 2048, 64 * kb, 32 * nb, 32 * nb, scr, F.lane); continue; } r -= NI_RO;
            if (r < NI_W1) { const int mi = r / 1024, q = r % 1024, kb = q / 64, nb = q % 64; const int n0 = 32 * nb;
                const int cc = n0 & 1023, drow0 = 256 * (cc >> 7) + (cc & 127) + ((n0 >= 1024) ? 128 : 0);
                if (MOE_FP8) p0_transpose_item_f8(KIN(I_W1) + (size_t)mi * DM * 2048, 2048, F.ws + WS_W1T + (size_t)mi * 2048 * DM, DM, 64 * kb, n0, drow0, scr, F.lane, 64.0f);
                else p0_transpose_item(KIN(I_W1) + (size_t)mi * DM * 2048, 2048, (bf16*)(F.ws + WS_W1T) + (size_t)mi * 2048 * DM, DM, 64 * kb, n0, drow0, scr, F.lane);
                continue; } r -= NI_W1;
            { const int mi = r / 512, q = r % 512, kb = q / 32, nb = q % 32;
                if (MOE_FP8) p0_transpose_item_f8(KIN(I_W2) + (size_t)mi * DM * DM, DM, F.ws + WS_W2T + (size_t)mi * DM * DM, DM, 64 * kb, 32 * nb, 32 * nb, scr, F.lane, 64.0f);
                else p0_transpose_item(KIN(I_W2) + (size_t)mi * DM * DM, DM, (bf16*)(F.ws + WS_W2T) + (size_t)mi * DM * DM, DM, 64 * kb, 32 * nb, 32 * nb, scr, F.lane); }
        }
    }
}

__device__ __forceinline__ void build_tiles(Frame& F, int l) {
    LAS int* ts = (LAS int*)(F.lds + TAB_OFF); LAS int* cnt = ts + 40;
    __syncthreads();
    if (F.tid < NEXP) cnt[F.tid] = (int)ldu_vec(F.ctl + CW_CNT + l * 2048 + F.tid * 64);
    __syncthreads();
    if (F.tid == 0) { int a = 0; for (int e = 0; e < NEXP; ++e) { ts[e] = a; a += (cnt[e] + 255) >> 8; } ts[NEXP] = a; }
    __syncthreads();
}

__device__ __forceinline__ void row_phase1(Frame& F, int l, int mode) {
    relaunder(F);
    const LAS int* ts = (const LAS int*)(F.lds + TAB_OFF);
    const bool comb = (l > 0);
    if (comb) build_tiles(F, l - 1);
    const float* xsrc = comb ? F.out : KIN(I_X);
    const bf16* Y = (const bf16*)(F.ws + WS_R1);
    const unsigned* tslot = (const unsigned*)(F.ws + WS_TSLOT); const unsigned* tgate = (const unsigned*)(F.ws + WS_TGATE);
    bf16* H = (bf16*)(F.ws + WS_H);
    for (int rb = F.vcu * 256; rb < MTOK; rb += F.G * 256) {
        const int b = rb / SEQ;
        f32x4 A[4], B[4], G2[4];
#pragma unroll
        for (int j = 0; j < 4; ++j) {
            const int c = 4 * F.lane + 256 * j;
            if (mode == 0) { const float* mv = (const float*)(F.ws + WS_MOD) + (size_t)(l * NBATCH + b) * 6 * DM;
                const f32x4 g = *(const f32x4*)(KIN(I_N1G) + l * DM + c), sc = *(const f32x4*)(mv + 1 * DM + c); A[j] = g * (sc + 1.0f); B[j] = *(const f32x4*)(mv + c); }
            else { const float* fm = (const float*)(F.ws + WS_FMOD) + (size_t)b * 2 * DM;
                const f32x4 g = *(const f32x4*)(KIN(I_FG) + c), sc = *(const f32x4*)(fm + DM + c); A[j] = g * (sc + 1.0f); B[j] = *(const f32x4*)(fm + c); }
            if (comb) G2[j] = *(const f32x4*)((const float*)(F.ws + WS_MOD) + (size_t)((l - 1) * NBATCH + b) * 6 * DM + 5 * DM + c); else G2[j] = (f32x4){0.f, 0.f, 0.f, 0.f};
        }
        for (int r = 0; r < 32; ++r) {
            const int row = rb + 32 * F.wave + r;
            f32x4 v[4];
#pragma unroll
            for (int j = 0; j < 4; ++j) v[j] = *(const f32x4*)(xsrc + (size_t)row * DM + 4 * F.lane + 256 * j);
            if (comb) {
                const unsigned sl = tslot[(size_t)row * 4 + (F.lane & 3)], gt = tgate[(size_t)row * 4 + (F.lane & 3)];
                f32x4 ys[4];
#pragma unroll
                for (int j = 0; j < 4; ++j) ys[j] = (f32x4){0.f, 0.f, 0.f, 0.f};
#pragma unroll
                for (int k = 0; k < TOPK; ++k) {
                    const unsigned s = (unsigned)__shfl((int)sl, k); const float gk = __uint_as_float((unsigned)__shfl((int)gt, k));
                    const int e = (int)(s >> 20), pos = (int)(s & 0xFFFFFu); const size_t yrow = (size_t)ts[e] * 256 + pos;
#pragma unroll
                    for (int j = 0; j < 4; ++j) { const v2u w = *(const v2u*)(Y + yrow * DM + 4 * F.lane + 256 * j);
                        ys[j].x += gk * bflo(w.x); ys[j].y += gk * bfhi(w.x); ys[j].z += gk * bflo(w.y); ys[j].w += gk * bfhi(w.y); }
                }
#pragma unroll
                for (int j = 0; j < 4; ++j) v[j] = v[j] + G2[j] * ys[j];
                if (mode == 0) {
#pragma unroll
                    for (int j = 0; j < 4; ++j) *(f32x4*)(F.out + (size_t)row * DM + 4 * F.lane + 256 * j) = v[j];
                }
            }
            float s2 = 0.f;
#pragma unroll
            for (int j = 0; j < 4; ++j) s2 += (v[j].x * v[j].x + v[j].y * v[j].y) + (v[j].z * v[j].z + v[j].w * v[j].w);
            const float rstd = 1.0f / sqrtf(wave_sum(s2) * (1.0f / DM) + EPS);
            if (mode == 0) {
#pragma unroll
                for (int j = 0; j < 4; ++j) { const f32x4 h = v[j] * rstd * A[j] + B[j]; v2u w; w.x = pk2(h.x, h.y); w.y = pk2(h.z, h.w); *(v2u*)(H + (size_t)row * DM + 4 * F.lane + 256 * j) = w; }
            } else {
#pragma unroll
                for (int j = 0; j < 4; ++j) *(f32x4*)(F.out + (size_t)row * DM + 4 * F.lane + 256 * j) = v[j] * rstd * A[j] + B[j];
            }
        }
    }
}

__device__ __forceinline__ void row_phase2(Frame& F, int l) {
    relaunder(F);
    bf16* H = (bf16*)(F.ws + WS_H);
    LAS unsigned char* frag = F.lds + RING_OFF;
    LAS float* lg = (LAS float*)(F.lds + 131072 + F.wave * 2112);
    LAS int* cntL = (LAS int*)(F.lds + 147968); LAS int* baseL = cntL + 32; LAS float* rbias = (LAS float*)(cntL + 64);
    unsigned* list = (unsigned*)(F.ws + WS_LIST); unsigned* tslot = (unsigned*)(F.ws + WS_TSLOT); float* tgate = (float*)(F.ws + WS_TGATE);
    __syncthreads();
    { const float* rw = KIN(I_RTW) + (size_t)l * DM * NEXP;
      for (int it = F.tid; it < 32 * 2 * 64; it += NWAVES * 64) { const int ln = it & 63, nt = (it >> 6) & 1, s = it >> 7; const int e = 16 * nt + (ln & 15), k0 = 32 * s + 8 * (ln >> 4);
          float w[8], hi[8];
#pragma unroll
          for (int j = 0; j < 8; ++j) { w[j] = rw[(size_t)(k0 + j) * NEXP + e]; }
          v4u ph, pl;
          { unsigned a = pk2(w[0], w[1]), b2 = pk2(w[2], w[3]), c2 = pk2(w[4], w[5]), d2 = pk2(w[6], w[7]); ph = (v4u){a, b2, c2, d2};
            hi[0] = bflo(a); hi[1] = bfhi(a); hi[2] = bflo(b2); hi[3] = bfhi(b2); hi[4] = bflo(c2); hi[5] = bfhi(c2); hi[6] = bflo(d2); hi[7] = bfhi(d2); }
          pl = (v4u){pk2(w[0] - hi[0], w[1] - hi[1]), pk2(w[2] - hi[2], w[3] - hi[3]), pk2(w[4] - hi[4], w[5] - hi[5]), pk2(w[6] - hi[6], w[7] - hi[7])};
          *(LAS v4u*)(frag + ((s * 2 + nt) * 2 + 0) * 1024 + ln * 16) = ph; *(LAS v4u*)(frag + ((s * 2 + nt) * 2 + 1) * 1024 + ln * 16) = pl; }
      if (F.tid < NEXP) rbias[F.tid] = KIN(I_RTB)[l * NEXP + F.tid];
    }
    for (int rb = F.vcu * 256; rb < MTOK; rb += F.G * 256) {
        const int b = rb / SEQ;
        if (F.tid < NEXP) cntL[F.tid] = 0;
        __syncthreads();
        {
            f32x4 A[4], B[4];
            const float* mv = (const float*)(F.ws + WS_MOD) + (size_t)(l * NBATCH + b) * 6 * DM;
#pragma unroll
            for (int j = 0; j < 4; ++j) { const int c = 4 * F.lane + 256 * j; const f32x4 g = *(const f32x4*)(KIN(I_N2G) + l * DM + c), sc = *(const f32x4*)(mv + 4 * DM + c); A[j] = g * (sc + 1.0f); B[j] = *(const f32x4*)(mv + 3 * DM + c); }
            for (int r = 0; r < 32; ++r) {
                const int row = rb + 32 * F.wave + r;
                f32x4 v[4]; float s2 = 0.f;
#pragma unroll
                for (int j = 0; j < 4; ++j) { v[j] = *(const f32x4*)(F.out + (size_t)row * DM + 4 * F.lane + 256 * j); s2 += (v[j].x * v[j].x + v[j].y * v[j].y) + (v[j].z * v[j].z + v[j].w * v[j].w); }
                const float rstd = 1.0f / sqrtf(wave_sum(s2) * (1.0f / DM) + EPS);
#pragma unroll
                for (int j = 0; j < 4; ++j) { const f32x4 h = v[j] * rstd * A[j] + B[j]; v2u w; w.x = pk2(h.x, h.y); w.y = pk2(h.z, h.w); *(v2u*)(H + (size_t)row * DM + 4 * F.lane + 256 * j) = w;
                    if (MOE_FP8) *(unsigned*)(F.ws + WS_H8 + (size_t)row * DM + 4 * F.lane + 256 * j) = pk4_fp8(h.x * 8.0f, h.y * 8.0f, h.z * 8.0f, h.w * 8.0f); }
            }
        }
        VM_WAIT();
        int my_e[2][TOPK], my_lp[2][TOPK]; float my_g[2][TOPK];
#pragma unroll
        for (int grp = 0; grp < 2; ++grp) {
            const int row0 = rb + 32 * F.wave + 16 * grp;
            f32x4 acc0 = (f32x4){0.f, 0.f, 0.f, 0.f}, acc1 = (f32x4){0.f, 0.f, 0.f, 0.f};
            const unsigned long long* ap = (const unsigned long long*)(H + (size_t)(row0 + (F.lane & 15)) * DM + 8 * (F.lane >> 4));
#pragma unroll 4
            for (int s = 0; s < 32; ++s) {
                const unsigned long long lo = __hip_atomic_load(ap + 8 * s, RLX_AGENT), hi = __hip_atomic_load(ap + 8 * s + 1, RLX_AGENT);
                v4u av = (v4u){(unsigned)lo, (unsigned)(lo >> 32), (unsigned)hi, (unsigned)(hi >> 32)}; const bf16x8 a = __builtin_bit_cast(bf16x8, av);
                const bf16x8 b00 = *(const LAS bf16x8*)(frag + ((s * 2 + 0) * 2 + 0) * 1024 + F.lane * 16), b01 = *(const LAS bf16x8*)(frag + ((s * 2 + 0) * 2 + 1) * 1024 + F.lane * 16);
                const bf16x8 b10 = *(const LAS bf16x8*)(frag + ((s * 2 + 1) * 2 + 0) * 1024 + F.lane * 16), b11 = *(const LAS bf16x8*)(frag + ((s * 2 + 1) * 2 + 1) * 1024 + F.lane * 16);
                acc0 = __builtin_amdgcn_mfma_f32_16x16x32_bf16(a, b00, acc0, 0, 0, 0); acc0 = __builtin_amdgcn_mfma_f32_16x16x32_bf16(a, b01, acc0, 0, 0, 0);
                acc1 = __builtin_amdgcn_mfma_f32_16x16x32_bf16(a, b10, acc1, 0, 0, 0); acc1 = __builtin_amdgcn_mfma_f32_16x16x32_bf16(a, b11, acc1, 0, 0, 0);
            }
#pragma unroll
            for (int q = 0; q < 4; ++q) { lg[(4 * (F.lane >> 4) + q) * 33 + (F.lane & 15)] = acc0[q]; lg[(4 * (F.lane >> 4) + q) * 33 + 16 + (F.lane & 15)] = acc1[q]; }
            LDS_WAIT(); asm volatile("" ::: "memory");
            if (F.lane < 16) {
                unsigned taken = 0u; float tl[TOPK];
#pragma unroll
                for (int k = 0; k < TOPK; ++k) {
                    float best = -3.0e38f; int bi = 0;
                    for (int e = 0; e < NEXP; ++e) { const float v = lg[F.lane * 33 + e] + rbias[e]; if (!((taken >> e) & 1u) && v > best) { best = v; bi = e; } }
                    taken |= 1u << bi; my_e[grp][k] = bi; tl[k] = best;
                }
                float den = 0.f, ex[TOPK];
#pragma unroll
                for (int k = 0; k < TOPK; ++k) { ex[k] = __expf(tl[k] - tl[0]); den += ex[k]; }
#pragma unroll
                for (int k = 0; k < TOPK; ++k) { my_g[grp][k] = ex[k] / den; my_lp[grp][k] = __hip_atomic_fetch_add(&cntL[my_e[grp][k]], 1, __ATOMIC_RELAXED, __HIP_MEMORY_SCOPE_WORKGROUP); }
            } else {
#pragma unroll
                for (int k = 0; k < TOPK; ++k) { my_e[grp][k] = 0; my_lp[grp][k] = 0; my_g[grp][k] = 0.f; }
            }
            LDS_WAIT(); asm volatile("" ::: "memory");
        }
        __syncthreads();
        if (F.tid < NEXP) baseL[F.tid] = (int)__hip_atomic_fetch_add(F.ctl + CW_CNT + l * 2048 + F.tid * 64, (unsigned)cntL[F.tid], RLX_AGENT);
        __syncthreads();
        if (F.lane < 16) {
#pragma unroll
            for (int grp = 0; grp < 2; ++grp) {
                const int row = rb + 32 * F.wave + 16 * grp + F.lane;
#pragma unroll
                for (int k = 0; k < TOPK; ++k) { const int e = my_e[grp][k], pos = baseL[e] + my_lp[grp][k];
                    list[(size_t)e * LCAP + pos] = (unsigned)row; tslot[(size_t)row * 4 + k] = ((unsigned)e << 20) | (unsigned)pos; tgate[(size_t)row * 4 + k] = my_g[grp][k]; }
            }
        }
        __syncthreads();
    }
}

__device__ __forceinline__ void moe_gather(Frame& F, int l) {
    relaunder(F);
    build_tiles(F, l);
    const LAS int* ts = (const LAS int*)(F.lds + TAB_OFF); const LAS int* cnt = ts + 40;
    const unsigned* list = (const unsigned*)(F.ws + WS_LIST); const bf16* H = (const bf16*)(F.ws + WS_H); bf16* Xg = (bf16*)(F.ws + WS_R1);
    const int gw = F.vcu * NWAVES + F.wave, NGW = F.G * NWAVES, NR = ts[NEXP] * 256;
    for (int r = gw; r < NR; r += NGW) {
        const int mt = r >> 8; int e = 0;
        for (int k = 1; k < NEXP; ++k) e += (ts[k] <= mt) ? 1 : 0;
        const int pos = r - ts[e] * 256;
        unsigned tok = 0u; if (pos < cnt[e]) tok = ldu_vec(list + (size_t)e * LCAP + pos);
        const v4u* src = (const v4u*)(H + (size_t)tok * DM); v4u* dst = (v4u*)(Xg + (size_t)r * DM);
        dst[F.lane] = src[F.lane]; dst[F.lane + 64] = src[F.lane + 64];
    }
}

__device__ __forceinline__ void moe_build_tt(Frame& F, int nN) {
    const LAS int* ts = (const LAS int*)(F.lds + TAB_OFF); const LAS int* cnt = ts + 40;
    LAS unsigned short* tt = (LAS unsigned short*)(F.lds + 131072);
    const unsigned* list = (const unsigned*)(F.ws + WS_LIST); const long NU = (long)ts[NEXP] * nN;
    for (int j = 0; j < 17; ++j) { const int i = 2 * j + (F.tid >> 8), r = F.tid & 255; const long L = (long)i * F.G + F.vcu;
        if (L < NU) { const int mt = (int)(L / nN); int e = 0;
            for (int k = 1; k < NEXP; ++k) e += (ts[k] <= mt) ? 1 : 0;
            const int pos = (mt - ts[e]) * 256 + r; unsigned tok = 0u; if (pos < cnt[e]) tok = list[(size_t)e * LCAP + pos];
            tt[i * 256 + r] = (unsigned short)tok; } }
    __syncthreads();
}

using pg8::Unit;
__device__ __forceinline__ v4u pack8(const f32x4 a, const f32x4 b) { v4u w; w.x = pk2(a.x, a.y); w.y = pk2(a.z, a.w); w.z = pk2(b.x, b.y); w.w = pk2(b.z, b.w); return w; }

struct EpiHgrnIn {
    static constexpr bool PERM = true;
    unsigned char* r1; const float* lb;
    __device__ __forceinline__ void operator()(const f32x4 (&acc)[2][2][4][2], const Unit& u, int wr, int wc, int fr, int fq) const {
        const int seg = u.pn >> 2, row0 = u.pm * 256 + wr * 64 + fr, cs0 = (u.pn & 3) * 256 + wc * 32 + 8 * fq;
        if (seg == 1) {
            bf16* K = (bf16*)(r1 + 128 * MiB); float* LF = (float*)(r1 + 512 * MiB);
#pragma unroll
            for (int bj = 0; bj < 2; ++bj) {
                f32x4 lbv[2]; lbv[0] = *(const f32x4*)(lb + cs0 + bj * 128); lbv[1] = *(const f32x4*)(lb + cs0 + bj * 128 + 4);
#pragma unroll
                for (int ai = 0; ai < 2; ++ai)
#pragma unroll
                    for (int m = 0; m < 4; ++m) { const size_t ro = (size_t)(row0 + ai * 128 + m * 16) * DM + cs0 + bj * 128; f32x4 kk[2], lf[2];
#pragma unroll
                        for (int n = 0; n < 2; ++n)
#pragma unroll
                            for (int j = 0; j < 4; ++j) { const float f = fminf(fmaxf(acc[ai][bj][m][n][j], -60.f), 60.f), l0 = lbv[n][j], ef = __expf(f);
                                const float sg = ef * __builtin_amdgcn_rcpf(1.f + ef), sgm = __builtin_amdgcn_rcpf(1.f + ef);
                                lf[n][j] = __logf(l0 + (1.f - l0) * sg); kk[n][j] = (1.f - l0) * sgm; }
                        *(v4u*)(K + ro) = pack8(kk[0], kk[1]); *(f32x4*)(LF + ro) = lf[0]; *(f32x4*)(LF + ro + 4) = lf[1];
                        __builtin_amdgcn_sched_barrier(0); }
            }
        } else {
            bf16* dst = (bf16*)(r1 + (seg == 0 ? 0 : (seg == 2 ? 256 * MiB : 384 * MiB))); const bool act = (seg != 2);
#pragma unroll
            for (int ai = 0; ai < 2; ++ai)
#pragma unroll
                for (int m = 0; m < 4; ++m) { const size_t ro = (size_t)(row0 + ai * 128 + m * 16) * DM;
#pragma unroll
                    for (int bj = 0; bj < 2; ++bj) { f32x4 v0 = acc[ai][bj][m][0], v1 = acc[ai][bj][m][1];
                        if (act) {
#pragma unroll
                            for (int j = 0; j < 4; ++j) { v0[j] = siluf_(v0[j]); v1[j] = siluf_(v1[j]); } }
                        *(v4u*)(dst + ro + cs0 + bj * 128) = pack8(v0, v1); }
                    __builtin_amdgcn_sched_barrier(0); }
        }
    }
};

struct EpiRetIn {
    static constexpr bool PERM = true;
    unsigned char* r1; const int* positions;
    __device__ __forceinline__ void operator()(const f32x4 (&acc)[2][2][4][2], const Unit& u, int wr, int wc, int fr, int fq) const {
        const int row0 = u.pm * 256 + wr * 64 + fr, cl = wc * 32 + 8 * fq;
        if (u.pn < 8) {
            bf16* dst = (bf16*)(r1 + ((u.pn < 4) ? 0 : 128 * MiB)); const float sc = (u.pn < 4) ? 1.0f : 0.0625f; const int hh = u.pn & 3;
            float invrev[2][4];
#pragma unroll
            for (int n = 0; n < 2; ++n)
#pragma unroll
                for (int j = 0; j < 4; ++j) invrev[n][j] = exp2f(-(float)(cl + 4 * n + j) * 0.10462765653188542f) * 0.15915494309189535f;
#pragma unroll
            for (int ai = 0; ai < 2; ++ai)
#pragma unroll
                for (int m = 0; m < 4; ++m) { const int row = row0 + ai * 128 + m * 16; const float pos = (float)positions[row]; const size_t ro = (size_t)row * DM + hh * 256 + cl;
                    f32x4 o1[2], o2[2];
#pragma unroll
                    for (int n = 0; n < 2; ++n)
#pragma unroll
                        for (int j = 0; j < 4; ++j) { const float rev = pos * invrev[n][j], fr_ = rev - floorf(rev); const float cs = __builtin_amdgcn_cosf(fr_), sn = __builtin_amdgcn_sinf(fr_);
                            const float x1 = acc[ai][0][m][n][j], x2 = acc[ai][1][m][n][j]; o1[n][j] = (x1 * cs - x2 * sn) * sc; o2[n][j] = (x2 * cs + x1 * sn) * sc; }
                    *(v4u*)(dst + ro) = pack8(o1[0], o1[1]); *(v4u*)(dst + ro + 128) = pack8(o2[0], o2[1]); }
        } else {
            const bool isg = (u.pn >= 16); bf16* dst = (bf16*)(r1 + (isg ? 512 * MiB : 256 * MiB)); const int ct = (isg ? u.pn - 16 : u.pn - 8) * 256 + cl;
#pragma unroll
            for (int ai = 0; ai < 2; ++ai)
#pragma unroll
                for (int m = 0; m < 4; ++m) { const size_t ro = (size_t)(row0 + ai * 128 + m * 16) * 2048 + ct;
#pragma unroll
                    for (int bj = 0; bj < 2; ++bj) { f32x4 v0 = acc[ai][bj][m][0], v1 = acc[ai][bj][m][1];
                        if (isg) {
#pragma unroll
                            for (int j = 0; j < 4; ++j) { v0[j] = siluf_(v0[j]); v1[j] = siluf_(v1[j]); } }
                        *(v4u*)(dst + ro + bj * 128) = pack8(v0, v1); } }
        }
    }
};

struct EpiOut {
    static constexpr bool PERM = false;
    const float* xin; float* xout; const float* gate;
    __device__ __forceinline__ void operator()(const f32x4 (&acc)[2][2][4][2], const Unit& u, int wr, int wc, int fr, int fq) const {
        const int row0 = u.pm * 256 + wr * 64 + fr, col0 = u.pn * 256 + wc * 32 + 4 * fq, b = (u.pm * 256) / SEQ;
        f32x4 gv[2][2];
#pragma unroll
        for (int bj = 0; bj < 2; ++bj)
#pragma unroll
            for (int n = 0; n < 2; ++n) gv[bj][n] = *(const f32x4*)(gate + (size_t)b * 6 * DM + col0 + bj * 128 + n * 16);
#pragma unroll
        for (int ai = 0; ai < 2; ++ai)
#pragma unroll
            for (int mp = 0; mp < 2; ++mp) { f32x4 xi[2][2][2];
#pragma unroll
                for (int mm = 0; mm < 2; ++mm)
#pragma unroll
                    for (int bj = 0; bj < 2; ++bj)
#pragma unroll
                        for (int n = 0; n < 2; ++n) xi[mm][bj][n] = *(const f32x4*)(xin + (size_t)(row0 + ai * 128 + (2 * mp + mm) * 16) * DM + col0 + bj * 128 + n * 16);
#pragma unroll
                for (int mm = 0; mm < 2; ++mm)
#pragma unroll
                    for (int bj = 0; bj < 2; ++bj)
#pragma unroll
                        for (int n = 0; n < 2; ++n) *(f32x4*)(xout + (size_t)(row0 + ai * 128 + (2 * mp + mm) * 16) * DM + col0 + bj * 128 + n * 16) = xi[mm][bj][n] + gv[bj][n] * acc[ai][bj][2 * mp + mm][n];
                asm volatile("" ::: "memory"); }
    }
};

struct EpiMoe1F8 {
    static constexpr bool PERM = true;
    unsigned char* A2; const float* b1;
    __device__ __forceinline__ void operator()(const f32x4 (&acc)[2][2][4][2], const Unit& u, int wr, int wc, int fr, int fq) const {
        const int row0 = u.pm * 256 + wr * 64 + fr, gc = u.nn * 128 + wc * 32 + 8 * fq; const float* bp = b1 + (size_t)u.e * 2048;
        f32x4 bg[2], bl[2];
#pragma unroll
        for (int n = 0; n < 2; ++n) { bg[n] = *(const f32x4*)(bp + gc + 4 * n); bl[n] = *(const f32x4*)(bp + 1024 + gc + 4 * n); }
#pragma unroll
        for (int ai = 0; ai < 2; ++ai)
#pragma unroll
            for (int m = 0; m < 4; ++m) { f32x4 o[2];
#pragma unroll
                for (int n = 0; n < 2; ++n)
#pragma unroll
                    for (int j = 0; j < 4; ++j) { const float g = fminf(acc[ai][0][m][n][j] * (1.0f / 512.f) + bg[n][j], 7.0f), li = fminf(fmaxf(acc[ai][1][m][n][j] * (1.0f / 512.f) + bl[n][j], -7.0f), 7.0f);
                        o[n][j] = g * sigmoidf_(1.702f * g) * (li + 1.0f) * 4.0f; }
                v2u w; w.x = pk4_fp8(o[0].x, o[0].y, o[0].z, o[0].w); w.y = pk4_fp8(o[1].x, o[1].y, o[1].z, o[1].w);
                *(v2u*)(A2 + (size_t)(row0 + ai * 128 + m * 16) * DM + gc) = w; }
    }
};
struct EpiMoe1 {
    static constexpr bool PERM = true;
    bf16* A2; const float* b1;
    __device__ __forceinline__ void operator()(const f32x4 (&acc)[2][2][4][2], const Unit& u, int wr, int wc, int fr, int fq) const {
        const int row0 = u.pm * 256 + wr * 64 + fr, gc = u.nn * 128 + wc * 32 + 8 * fq; const float* bp = b1 + (size_t)u.e * 2048;
        f32x4 bg[2], bl[2];
#pragma unroll
        for (int n = 0; n < 2; ++n) { bg[n] = *(const f32x4*)(bp + gc + 4 * n); bl[n] = *(const f32x4*)(bp + 1024 + gc + 4 * n); }
#pragma unroll
        for (int ai = 0; ai < 2; ++ai)
#pragma unroll
            for (int m = 0; m < 4; ++m) { f32x4 o[2];
#pragma unroll
                for (int n = 0; n < 2; ++n)
#pragma unroll
                    for (int j = 0; j < 4; ++j) { const float g = fminf(acc[ai][0][m][n][j] + bg[n][j], 7.0f), li = fminf(fmaxf(acc[ai][1][m][n][j] + bl[n][j], -7.0f), 7.0f);
                        o[n][j] = g * sigmoidf_(1.702f * g) * (li + 1.0f); }
                *(v4u*)(A2 + (size_t)(row0 + ai * 128 + m * 16) * DM + gc) = pack8(o[0], o[1]); }
    }
};

struct EpiMoe2 {
    static constexpr bool PERM = true;
    bf16* Y; const float* b2; float sc;
    __device__ __forceinline__ void operator()(const f32x4 (&acc)[2][2][4][2], const Unit& u, int wr, int wc, int fr, int fq) const {
        const int row0 = u.pm * 256 + wr * 64 + fr, c0 = u.nn * 256 + wc * 32 + 8 * fq; const float* bp = b2 + (size_t)u.e * DM;
        f32x4 bv[2][2];
#pragma unroll
        for (int bj = 0; bj < 2; ++bj)
#pragma unroll
            for (int n = 0; n < 2; ++n) bv[bj][n] = *(const f32x4*)(bp + c0 + bj * 128 + 4 * n);
#pragma unroll
        for (int ai = 0; ai < 2; ++ai)
#pragma unroll
            for (int m = 0; m < 4; ++m) { const size_t ro = (size_t)(row0 + ai * 128 + m * 16) * DM + c0;
#pragma unroll
                for (int bj = 0; bj < 2; ++bj) *(v4u*)(Y + ro + bj * 128) = pack8(acc[ai][bj][m][0] * sc + bv[bj][0], acc[ai][bj][m][1] * sc + bv[bj][1]); }
    }
};

__device__ __forceinline__ void hgrn_scan(Frame& F, int j) {
    relaunder(F);
    const bf16* Q = (const bf16*)(F.ws + WS_R1); const bf16* K = (const bf16*)(F.ws + WS_R1 + 128 * MiB); const bf16* V = (const bf16*)(F.ws + WS_R1 + 256 * MiB); const bf16* SG = (const bf16*)(F.ws + WS_R1 + 384 * MiB);
    const float* LF = (const float*)(F.ws + WS_R1 + 512 * MiB); bf16* O = (bf16*)(F.ws + WS_R2);
    LAS float* Qs = (LAS float*)(F.lds); LAS float* Ks = Qs + 4096; LAS float* Fs = Qs + 8192; LAS float* Vs = Qs + 12288; LAS float* P = Qs + 16384;
    const int v = F.tid & 127, kq = F.tid >> 7, t16 = F.tid >> 4, c8 = (F.tid & 15) * 8;
    f32x4 gain0 = *(const f32x4*)(KIN(I_HGAIN) + j * 128 + c8), gain1 = *(const f32x4*)(KIN(I_HGAIN) + j * 128 + c8 + 4);
    for (int u = F.vcu; u < NBATCH * HG_H; u += F.G) {
        const int b = u / HG_H, h = u % HG_H;
        float S[32];
#pragma unroll
        for (int i = 0; i < 32; ++i) S[i] = 0.f;
        for (int ch = 0; ch < SEQ / 32; ++ch) {
            const int row0 = b * SEQ + 32 * ch; const size_t gi = (size_t)(row0 + t16) * DM + h * 128 + c8;
            __syncthreads();
            { const v4u q = *(const v4u*)(Q + gi), k = *(const v4u*)(K + gi), vv = *(const v4u*)(V + gi); const f32x4 l0 = *(const f32x4*)(LF + gi), l1 = *(const f32x4*)(LF + gi + 4);
              LAS f32x4* d;
              d = (LAS f32x4*)(Qs + t16 * 128 + c8); d[0] = (f32x4){bflo(q.x), bfhi(q.x), bflo(q.y), bfhi(q.y)}; d[1] = (f32x4){bflo(q.z), bfhi(q.z), bflo(q.w), bfhi(q.w)};
              d = (LAS f32x4*)(Ks + t16 * 128 + c8); d[0] = (f32x4){bflo(k.x), bfhi(k.x), bflo(k.y), bfhi(k.y)}; d[1] = (f32x4){bflo(k.z), bfhi(k.z), bflo(k.w), bfhi(k.w)};
              d = (LAS f32x4*)(Vs + t16 * 128 + c8); d[0] = (f32x4){bflo(vv.x), bfhi(vv.x), bflo(vv.y), bfhi(vv.y)}; d[1] = (f32x4){bflo(vv.z), bfhi(vv.z), bflo(vv.w), bfhi(vv.w)};
              d = (LAS f32x4*)(Fs + t16 * 128 + c8); d[0] = (f32x4){__expf(l0.x), __expf(l0.y), __expf(l0.z), __expf(l0.w)}; d[1] = (f32x4){__expf(l1.x), __expf(l1.y), __expf(l1.z), __expf(l1.w)}; }
            __syncthreads();
            for (int t = 0; t < 32; ++t) {
                const float vt = Vs[t * 128 + v]; float a = 0.f;
#pragma unroll
                for (int i4 = 0; i4 < 8; ++i4) { const f32x4 f4 = *(const LAS f32x4*)(Fs + t * 128 + 32 * kq + 4 * i4), k4 = *(const LAS f32x4*)(Ks + t * 128 + 32 * kq + 4 * i4), q4 = *(const LAS f32x4*)(Qs + t * 128 + 32 * kq + 4 * i4);
#pragma unroll
                    for (int i = 0; i < 4; ++i) { S[4 * i4 + i] = f4[i] * S[4 * i4 + i] + k4[i] * vt; a += q4[i] * S[4 * i4 + i]; } }
                P[(t * 4 + kq) * 128 + v] = a;
            }
            __syncthreads();
            { f32x4 o0 = (f32x4){0.f, 0.f, 0.f, 0.f}, o1 = o0;
#pragma unroll
              for (int q = 0; q < 4; ++q) { o0 += *(const LAS f32x4*)(P + (t16 * 4 + q) * 128 + c8); o1 += *(const LAS f32x4*)(P + (t16 * 4 + q) * 128 + c8 + 4); }
              float ss = (o0.x * o0.x + o0.y * o0.y) + (o0.z * o0.z + o0.w * o0.w) + (o1.x * o1.x + o1.y * o1.y) + (o1.z * o1.z + o1.w * o1.w);
              ss += __shfl_xor(ss, 1); ss += __shfl_xor(ss, 2); ss += __shfl_xor(ss, 4); ss += __shfl_xor(ss, 8);
              const float r = 1.0f / sqrtf(ss * (1.0f / 128.f) + EPS);
              const v4u sg = *(const v4u*)(SG + gi);
              f32x4 a0 = o0 * r * gain0, a1 = o1 * r * gain1;
              a0.x *= bflo(sg.x); a0.y *= bfhi(sg.x); a0.z *= bflo(sg.y); a0.w *= bfhi(sg.y); a1.x *= bflo(sg.z); a1.y *= bfhi(sg.z); a1.z *= bflo(sg.w); a1.w *= bfhi(sg.w);
              *(v4u*)(O + gi) = pack8(a0, a1); }
        }
    }
}

__device__ __forceinline__ void ret_scan(Frame& F) {
    relaunder(F);
    const bf16* Q = (const bf16*)(F.ws + WS_R1); const bf16* K = (const bf16*)(F.ws + WS_R1 + 128 * MiB); const bf16* V = (const bf16*)(F.ws + WS_R1 + 256 * MiB); const bf16* SG = (const bf16*)(F.ws + WS_R1 + 512 * MiB);
    bf16* O = (bf16*)(F.ws + WS_R2);
    LAS bf16* Qs = (LAS bf16*)(F.lds); LAS bf16* Ks = (LAS bf16*)(F.lds + 33792); LAS bf16* Vs = (LAS bf16*)(F.lds + 67584);
    LAS float* St = (LAS float*)(F.lds + 133120); LAS float* wred = (LAS float*)(F.lds + 149504); LAS float* rtab = (LAS float*)(F.lds + 151552);
    for (int u = F.vcu; u < NBATCH * RT_H * 16; u += F.G) {
        const int bh = u >> 4, cp = u & 15, b = bh >> 2, h = bh & 3;
        const float lg2g = log2f(1.0f - exp2f(-5.0f - (float)h));
        for (int half = 0; half < 2; ++half) {
            const int c = half ? 31 - cp : cp; const int row0 = b * SEQ + 64 * c;
            __syncthreads();
#pragma unroll
            for (int i = 0; i < 4; ++i) { const int p = F.tid + 512 * i, r = p >> 5, cc = (p & 31) * 8; *(LAS v4u*)(Qs + r * 264 + cc) = *(const v4u*)(Q + (size_t)(row0 + r) * DM + h * 256 + cc); }
            float acc[64];
#pragma unroll
            for (int n = 0; n < 64; ++n) acc[n] = 0.f;
            for (int cq = 0; cq <= c; ++cq) {
                const int krow0 = b * SEQ + 64 * cq;
                __syncthreads();
#pragma unroll
                for (int i = 0; i < 4; ++i) { const int p = F.tid + 512 * i, r = p >> 5, cc = (p & 31) * 8; *(LAS v4u*)(Ks + r * 264 + cc) = *(const v4u*)(K + (size_t)(krow0 + r) * DM + h * 256 + cc); }
#pragma unroll
                for (int i = 0; i < 8; ++i) { const int p = F.tid + 512 * i, r = p >> 6, cc = (p & 63) * 8; *(LAS v4u*)(Vs + r * 512 + cc) = *(const v4u*)(V + (size_t)(krow0 + r) * 2048 + h * 512 + cc); }
                __syncthreads();
                { float s[8];
#pragma unroll
                  for (int j8 = 0; j8 < 8; ++j8) s[j8] = 0.f;
                  for (int dc = 0; dc < 32; ++dc) {
                      const v4u kv = *(const LAS v4u*)(Ks + F.lane * 264 + dc * 8);
                      const float k0 = bflo(kv.x), k1 = bfhi(kv.x), k2 = bflo(kv.y), k3 = bfhi(kv.y), k4 = bflo(kv.z), k5 = bfhi(kv.z), k6 = bflo(kv.w), k7 = bfhi(kv.w);
#pragma unroll
                      for (int j8 = 0; j8 < 8; ++j8) { const v4u qv = *(const LAS v4u*)(Qs + (8 * F.wave + j8) * 264 + dc * 8);
                          s[j8] += (bflo(qv.x) * k0 + bfhi(qv.x) * k1) + (bflo(qv.y) * k2 + bfhi(qv.y) * k3) + (bflo(qv.z) * k4 + bfhi(qv.z) * k5) + (bflo(qv.w) * k6 + bfhi(qv.w) * k7); }
                  }
                  f32x4 w0, w1;
#pragma unroll
                  for (int j8 = 0; j8 < 8; ++j8) { const float dist = fabsf((float)((64 * c + 8 * F.wave + j8) - (64 * cq + F.lane))); const float val = s[j8] * exp2f(dist * lg2g); if (j8 < 4) w0[j8] = val; else w1[j8 - 4] = val; }
                  *(LAS f32x4*)(St + F.lane * 64 + 8 * F.wave) = w0; *(LAS f32x4*)(St + F.lane * 64 + 8 * F.wave + 4) = w1; }
                __syncthreads();
                for (int m2 = 0; m2 < 64; ++m2) {
                    const float vv = bf2f(Vs[m2 * 512 + F.tid]);
#pragma unroll
                    for (int n4 = 0; n4 < 16; ++n4) { const f32x4 sv = *(const LAS f32x4*)(St + m2 * 64 + 4 * n4); acc[4 * n4 + 0] += sv.x * vv; acc[4 * n4 + 1] += sv.y * vv; acc[4 * n4 + 2] += sv.z * vv; acc[4 * n4 + 3] += sv.w * vv; }
                }
            }
#pragma unroll
            for (int n = 0; n < 64; ++n) { const float p = wave_sum(acc[n] * acc[n]); if (F.lane == 0) wred[F.wave * 64 + n] = p; }
            __syncthreads();
            if (F.tid < 64) { float s = 0.f;
#pragma unroll
                for (int w = 0; w < 8; ++w) s += wred[w * 64 + F.tid];
                rtab[F.tid] = 1.0f / sqrtf(s * (1.0f / 512.f) + EPS); }
            __syncthreads();
#pragma unroll
            for (int n = 0; n < 64; ++n) { const size_t gi = (size_t)(row0 + n) * 2048 + h * 512 + F.tid; const float sg = bf2f(SG[gi]); O[gi] = (bf16)(pk2(acc[n] * rtab[n] * sg, 0.f) & 0xffffu); }
        }
    }
}

typedef short s16x4 __attribute__((ext_vector_type(4)));
__device__ __forceinline__ unsigned off_b(unsigned row, unsigned ch) { return 256u * row + 16u * (ch ^ (((row & 3u) << 2) | ((row >> 2) & 3u))); }
__device__ __forceinline__ bf16x8 row_frag(const LAS unsigned char* tile, unsigned row, unsigned s4, unsigned g) { return *(const LAS bf16x8*)(tile + off_b(row, 4u * s4 + g)); }
__device__ __forceinline__ bf16x8 tr_frag16(const LAS unsigned char* tile, unsigned lane, unsigned c, unsigned ks) {
    const unsigned g = lane >> 4, q = (lane & 15u) >> 2, p = lane & 3u;
    const unsigned a0 = off_b(32u * ks + 8u * g + q, 2u * c + (p >> 1)) + 8u * (p & 1u), a1 = off_b(32u * ks + 8u * g + 4u + q, 2u * c + (p >> 1)) + 8u * (p & 1u);
    const s16x4 lo = __builtin_amdgcn_ds_read_tr16_b64_v4i16((LAS s16x4*)(tile + a0)), hi = __builtin_amdgcn_ds_read_tr16_b64_v4i16((LAS s16x4*)(tile + a1));
    return (bf16x8){lo[0], lo[1], lo[2], lo[3], hi[0], hi[1], hi[2], hi[3]};
}
#define RSB() __builtin_amdgcn_sched_barrier(0)
constexpr unsigned RQS = 528, RVS = 272;
template <unsigned RS> __device__ __forceinline__ bf16x8 tr_lin(const LAS unsigned char* img, unsigned trb, int c, int ks) {
    const s16x4 lo = __builtin_amdgcn_ds_read_tr16_b64_v4i16((LAS s16x4*)(img + trb + (32 * ks) * RS + 32 * c)), hi = __builtin_amdgcn_ds_read_tr16_b64_v4i16((LAS s16x4*)(img + trb + (32 * ks + 4) * RS + 32 * c));
    return (bf16x8){lo[0], lo[1], lo[2], lo[3], hi[0], hi[1], hi[2], hi[3]};
}
__device__ __forceinline__ void ret_scan_mfma(Frame& F) {
    relaunder(F);
    const bf16* Q = (const bf16*)(F.ws + WS_R1); const bf16* K = (const bf16*)(F.ws + WS_R1 + 128 * MiB); const bf16* V = (const bf16*)(F.ws + WS_R1 + 256 * MiB);
    bf16* O = (bf16*)(F.ws + WS_R2); float* SS = (float*)(F.ws + WS_R2 + 256 * MiB);
    LAS unsigned char* Qi = F.lds; LAS unsigned char* Ki = F.lds + 33792; LAS unsigned char* Vi = F.lds + 67584; LAS unsigned char* Si = F.lds + 84992; LAS float* OT = (LAS float*)(F.lds + 94208);
    const unsigned w = (unsigned)F.wave;
    for (int u = F.vcu; u < NBATCH * RT_H * 4; u += F.G) {
        const int bh = u >> 2, vs = u & 3, b = bh >> 2, h = bh & 3;
        const float lg2g = log2f(1.0f - exp2f(-5.0f - (float)h)), cd = exp2f(64.0f * lg2g);
        f32x4 R[16];
#pragma unroll
        for (int i = 0; i < 16; ++i) R[i] = (f32x4){0.f, 0.f, 0.f, 0.f};
        v4u pq[4], pk[4], pv[2];
        { const int row0 = b * SEQ;
#pragma unroll
          for (int i = 0; i < 4; ++i) { const int p = F.tid + 512 * i, r = p >> 5, c32 = p & 31; pq[i] = *(const v4u*)(Q + (size_t)(row0 + r) * DM + h * 256 + c32 * 8); pk[i] = *(const v4u*)(K + (size_t)(row0 + r) * DM + h * 256 + c32 * 8); }
#pragma unroll
          for (int i = 0; i < 2; ++i) { const int p = F.tid + 512 * i, r = p >> 4, c16 = p & 15; pv[i] = *(const v4u*)(V + (size_t)(row0 + r) * 2048 + h * 512 + vs * 128 + c16 * 8); } }
        __syncthreads();
        for (int c = 0; c < SEQ / 64; ++c) {
            const int row0 = b * SEQ + 64 * c;
            unsigned tidl = (unsigned)F.tid; asm volatile("" : "+v"(tidl));
            const unsigned lane = tidl & 63u, g = lane >> 4, li = lane & 15u;
#pragma unroll
            for (int i = 0; i < 4; ++i) { const unsigned p = tidl + 512u * i, r = p >> 5, c32 = p & 31u; const unsigned o = r * RQS + 16u * c32; *(LAS v4u*)(Qi + o) = pq[i]; *(LAS v4u*)(Ki + o) = pk[i]; }
#pragma unroll
            for (int i = 0; i < 2; ++i) { const unsigned p = tidl + 512u * i, r = p >> 4, c16 = p & 15u; *(LAS v4u*)(Vi + r * RVS + 16u * c16) = pv[i]; }
            __syncthreads();
            if (c + 1 < SEQ / 64) { const int rn = row0 + 64;
#pragma unroll
                for (int i = 0; i < 4; ++i) { const unsigned p = tidl + 512u * i, r = p >> 5, c32 = p & 31u; pq[i] = *(const v4u*)(Q + (size_t)(rn + (int)r) * DM + h * 256 + c32 * 8); pk[i] = *(const v4u*)(K + (size_t)(rn + (int)r) * DM + h * 256 + c32 * 8); }
#pragma unroll
                for (int i = 0; i < 2; ++i) { const unsigned p = tidl + 512u * i, r = p >> 4, c16 = p & 15u; pv[i] = *(const v4u*)(V + (size_t)(rn + (int)r) * 2048 + h * 512 + vs * 128 + c16 * 8); } }
            RSB();
            const unsigned rb128 = li * RQS + 16u * g, rb64 = li * RQS + 8u * g, trq = (8u * g + (li >> 2)) * RQS + 8u * (li & 3u), trv = (8u * g + (li >> 2)) * RVS + 8u * (li & 3u);
            { const unsigned mt = w >> 1, nt0 = 2u * (w & 1u); f32x4 sa0 = (f32x4){0.f, 0.f, 0.f, 0.f}, sa1 = sa0;
              const LAS unsigned char* qrow = Qi + rb128 + mt * (16u * RQS); const LAS unsigned char* krow = Ki + rb128 + nt0 * (16u * RQS);
              bf16x8 qa[2][2], kb0[2][2], kb1[2][2];
#define RET_LDS(buf, s8b) do { _Pragma("unroll") for (int k2 = 0; k2 < 2; ++k2) { const int s8 = (s8b) + k2; \
                  qa[buf][k2] = *(const LAS bf16x8*)(qrow + 64 * s8); kb0[buf][k2] = *(const LAS bf16x8*)(krow + 64 * s8); kb1[buf][k2] = *(const LAS bf16x8*)(krow + 16 * RQS + 64 * s8); } } while (0)
              RET_LDS(0, 0); RSB();
#pragma unroll
              for (int bt = 0; bt < 4; ++bt) { if (bt < 3) RET_LDS((bt + 1) & 1, 2 * (bt + 1)); RSB();
#pragma unroll
                  for (int k2 = 0; k2 < 2; ++k2) { sa0 = __builtin_amdgcn_mfma_f32_16x16x32_bf16(qa[bt & 1][k2], kb0[bt & 1][k2], sa0, 0, 0, 0); sa1 = __builtin_amdgcn_mfma_f32_16x16x32_bf16(qa[bt & 1][k2], kb1[bt & 1][k2], sa1, 0, 0, 0); }
                  RSB(); }
#undef RET_LDS
#pragma unroll
              for (int q = 0; q < 4; ++q) { const int n = (int)(16u * mt + 4u * g) + q, m0 = (int)(16u * nt0 + li);
                  const float v0 = sa0[q] * exp2f(fabsf((float)(n - m0)) * lg2g), v1 = sa1[q] * exp2f(fabsf((float)(n - m0 - 16)) * lg2g); const unsigned pk = pk2(v0, v1);
                  *(LAS unsigned short*)(Si + (unsigned)n * 144u + 2u * (unsigned)m0) = (unsigned short)(pk & 0xffffu); *(LAS unsigned short*)(Si + (unsigned)n * 144u + 2u * (unsigned)m0 + 32u) = (unsigned short)(pk >> 16); } }
            RSB();
            f32x4 Oa[4];
#pragma unroll
            for (int mt = 0; mt < 4; ++mt) Oa[mt] = (f32x4){0.f, 0.f, 0.f, 0.f};
            { v2u qlo[2][4], qhi[2][4]; const LAS unsigned char* qp = Qi + rb64;
#define RET_LDQ(buf, s8) do { _Pragma("unroll") for (int mt = 0; mt < 4; ++mt) { qlo[buf][mt] = *(const LAS v2u*)(qp + mt * (16 * RQS) + 64 * (s8)); qhi[buf][mt] = *(const LAS v2u*)(qp + mt * (16 * RQS) + 64 * (s8) + 32); } } while (0)
              RET_LDQ(0, 0); RSB();
#pragma unroll
              for (int s8 = 0; s8 < 8; ++s8) { if (s8 < 7) RET_LDQ((s8 + 1) & 1, s8 + 1); RSB();
                  const v4u rt = (v4u){pk2(R[2 * s8][0], R[2 * s8][1]), pk2(R[2 * s8][2], R[2 * s8][3]), pk2(R[2 * s8 + 1][0], R[2 * s8 + 1][1]), pk2(R[2 * s8 + 1][2], R[2 * s8 + 1][3])}; const bf16x8 Rb = __builtin_bit_cast(bf16x8, rt);
#pragma unroll
                  for (int mt = 0; mt < 4; ++mt) { const v4u av = (v4u){qlo[s8 & 1][mt].x, qlo[s8 & 1][mt].y, qhi[s8 & 1][mt].x, qhi[s8 & 1][mt].y}; Oa[mt] = __builtin_amdgcn_mfma_f32_16x16x32_bf16(__builtin_bit_cast(bf16x8, av), Rb, Oa[mt], 0, 0, 0); }
                  RSB(); }
#undef RET_LDQ
            }
#pragma unroll
            for (int mt = 0; mt < 4; ++mt)
#pragma unroll
                for (int q = 0; q < 4; ++q) Oa[mt][q] *= exp2f((float)(16 * mt + 4 * (int)g + q + 1) * lg2g);
            __syncthreads();
            bf16x8 Vf[2], sf[4][2], ka[2][2][2];
#define RET_LDK(buf, dtb) do { _Pragma("unroll") for (int d2 = 0; d2 < 2; ++d2) _Pragma("unroll") for (int ks = 0; ks < 2; ++ks) ka[buf][d2][ks] = tr_lin<RQS>(Ki, trq, (dtb) + d2, ks); } while (0)
#pragma unroll
            for (int ks = 0; ks < 2; ++ks) Vf[ks] = tr_lin<RVS>(Vi + 32u * w, trv, 0, ks);
#pragma unroll
            for (int mt = 0; mt < 4; ++mt)
#pragma unroll
                for (int ks = 0; ks < 2; ++ks) sf[mt][ks] = *(const LAS bf16x8*)(Si + (16u * mt + li) * 144u + 64u * ks + 16u * g);
            RET_LDK(0, 0); RSB();
#pragma unroll
            for (int mt = 0; mt < 4; ++mt)
#pragma unroll
                for (int ks = 0; ks < 2; ++ks) Oa[mt] = __builtin_amdgcn_mfma_f32_16x16x32_bf16(sf[mt][ks], Vf[ks], Oa[mt], 0, 0, 0);
            bf16x8 Vd[2];
#pragma unroll
            for (int ks = 0; ks < 2; ++ks) { const v4u vv = __builtin_bit_cast(v4u, Vf[ks]); float f[8];
#pragma unroll
                for (int j = 0; j < 8; ++j) f[j] = exp2f((float)(63 - (32 * ks + 8 * (int)g + j)) * lg2g);
                const v4u sv = (v4u){pk2(bflo(vv.x) * f[0], bfhi(vv.x) * f[1]), pk2(bflo(vv.y) * f[2], bfhi(vv.y) * f[3]), pk2(bflo(vv.z) * f[4], bfhi(vv.z) * f[5]), pk2(bflo(vv.w) * f[6], bfhi(vv.w) * f[7])};
                Vd[ks] = __builtin_bit_cast(bf16x8, sv); }
            RSB();
#pragma unroll
            for (int bt = 0; bt < 8; ++bt) { if (bt < 7) RET_LDK((bt + 1) & 1, 2 * (bt + 1)); RSB();
#pragma unroll
                for (int d2 = 0; d2 < 2; ++d2) { const int dt = 2 * bt + d2; R[dt] = R[dt] * cd;
#pragma unroll
                    for (int ks = 0; ks < 2; ++ks) R[dt] = __builtin_amdgcn_mfma_f32_16x16x32_bf16(ka[bt & 1][d2][ks], Vd[ks], R[dt], 0, 0, 0); }
                RSB(); }
#undef RET_LDK
#pragma unroll
            for (int mt = 0; mt < 4; ++mt)
#pragma unroll
                for (int q = 0; q < 4; ++q) OT[(16u * mt + 4u * g + q) * 132u + 16u * w + li] = Oa[mt][q];
            __syncthreads();
            { const unsigned tn = tidl >> 3, vg = tidl & 7u; f32x4 o[4]; float ssq = 0.f;
#pragma unroll
              for (int i = 0; i < 4; ++i) { o[i] = *(const LAS f32x4*)(OT + tn * 132u + 16u * vg + 4u * i); ssq += (o[i].x * o[i].x + o[i].y * o[i].y) + (o[i].z * o[i].z + o[i].w * o[i].w); }
              ssq += __shfl_xor(ssq, 1); ssq += __shfl_xor(ssq, 2); ssq += __shfl_xor(ssq, 4);
              bf16* op = O + (size_t)(row0 + (int)tn) * 2048 + h * 512 + vs * 128 + 16 * vg; *(v4u*)op = pack8(o[0], o[1]); *(v4u*)(op + 8) = pack8(o[2], o[3]);
              if (vg == 0) SS[((size_t)(row0 + (int)tn) * 4 + h) * 4 + vs] = ssq; }
        }
    }
}
__device__ __forceinline__ void ret_norm(Frame& F) {
    relaunder(F);
    bf16* O = (bf16*)(F.ws + WS_R2); const float* SS = (const float*)(F.ws + WS_R2 + 256 * MiB); const bf16* SG = (const bf16*)(F.ws + WS_R1 + 512 * MiB);
    const int gw = F.vcu * NWAVES + F.wave, NGW = F.G * NWAVES;
    for (int row = gw; row < MTOK; row += NGW) {
        float r[4];
#pragma unroll
        for (int h = 0; h < 4; ++h) { const f32x4 p = *(const f32x4*)(SS + ((size_t)row * 4 + h) * 4); r[h] = 1.0f / sqrtf(((p.x + p.y) + (p.z + p.w)) * (1.0f / 512.f) + EPS); }
#pragma unroll
        for (int j = 0; j < 4; ++j) { const size_t gi = (size_t)row * 2048 + 512 * j + 8 * F.lane; const v4u o = *(const v4u*)(O + gi), sg = *(const v4u*)(SG + gi); const float rr = r[j];
            v4u w; w.x = pk2(bflo(o.x) * rr * bflo(sg.x), bfhi(o.x) * rr * bfhi(sg.x)); w.y = pk2(bflo(o.y) * rr * bflo(sg.y), bfhi(o.y) * rr * bfhi(sg.y));
            w.z = pk2(bflo(o.z) * rr * bflo(sg.z), bfhi(o.z) * rr * bfhi(sg.z)); w.w = pk2(bflo(o.w) * rr * bflo(sg.w), bfhi(o.w) * rr * bfhi(sg.w));
            *(v4u*)(O + gi) = w; }
    }
}

__device__ __forceinline__ bf16x8 pad8(s16x4 a) { return (bf16x8){a[0], a[1], a[2], a[3], 0, 0, 0, 0}; }
__device__ __forceinline__ void hgrn_scan_mfma(Frame& F, int j) {
    relaunder(F);
    const bf16* Q = (const bf16*)(F.ws + WS_R1); const bf16* K = (const bf16*)(F.ws + WS_R1 + 128 * MiB); const bf16* V = (const bf16*)(F.ws + WS_R1 + 256 * MiB); const bf16* SG = (const bf16*)(F.ws + WS_R1 + 384 * MiB);
    const float* LF = (const float*)(F.ws + WS_R1 + 512 * MiB); bf16* O = (bf16*)(F.ws + WS_R2);
    LAS unsigned char* QEi = F.lds; LAS unsigned char* QE2i = F.lds + 16384; LAS unsigned char* KEi = F.lds + 32768; LAS unsigned char* Vi = F.lds + 49152;
    LAS float* BL = (LAS float*)(F.lds + 65536); LAS float* OT = (LAS float*)(F.lds + 67584);
    const unsigned w = (unsigned)F.wave;
    for (int u = F.vcu; u < NBATCH * HG_H; u += F.G) {
        const int b = u >> 3, h = u & 7;
        f32x4 S[8];
#pragma unroll
        for (int i = 0; i < 8; ++i) S[i] = (f32x4){0.f, 0.f, 0.f, 0.f};
        float plf[16]; unsigned pqk[16]; v4u pv[2], psg[2];
        { const int kbp = F.tid >> 7, dp = F.tid & 127, row0 = b * SEQ;
#pragma unroll
          for (int t = 0; t < 16; ++t) { const size_t gi = (size_t)(row0 + 16 * kbp + t) * DM + h * 128 + dp; plf[t] = LF[gi]; pqk[t] = (unsigned)Q[gi] | ((unsigned)K[gi] << 16); }
#pragma unroll
          for (int i = 0; i < 2; ++i) { const int p = F.tid + 512 * i, r = p >> 4, c16 = p & 15; pv[i] = *(const v4u*)(V + (size_t)(row0 + r) * DM + h * 128 + c16 * 8); }
#pragma unroll
          for (int i = 0; i < 2; ++i) psg[i] = *(const v4u*)(SG + (size_t)(row0 + (F.tid >> 3)) * DM + h * 128 + 16 * (F.tid & 7) + 8 * i); }
        for (int c = 0; c < SEQ / 64; ++c) {
            const int row0 = b * SEQ + 64 * c;
            unsigned tidl = (unsigned)F.tid; asm volatile("" : "+v"(tidl));
            const unsigned lane = tidl & 63u, g = lane >> 4, li = lane & 15u, kbp = tidl >> 7, dp = tidl & 127u;
            { float bs = 0.f;
#pragma unroll
              for (int t = 0; t < 16; ++t) { bs += plf[t]; plf[t] = bs; }
              const float bl = plf[15];
#pragma unroll
              for (int t = 0; t < 16; ++t) { const float bt = plf[t], q = bflo(pqk[t]), k = bfhi(pqk[t]);
                  const unsigned a = off_b(16u * kbp + t, dp >> 3) + 2u * (dp & 7u);
                  const unsigned w0 = pk2(q * __expf(bt), q * __expf(fminf(bt - bl, 80.f))), w1 = pk2(k * __expf(bl - bt), 0.f);
                  *(LAS unsigned short*)(QEi + a) = (unsigned short)(w0 & 0xffffu); *(LAS unsigned short*)(QE2i + a) = (unsigned short)(w0 >> 16); *(LAS unsigned short*)(KEi + a) = (unsigned short)(w1 & 0xffffu); }
              BL[kbp * 128u + dp] = __expf(bl); }
#pragma unroll
            for (int i = 0; i < 2; ++i) { const unsigned p = tidl + 512u * i, r = p >> 4, c16 = p & 15u; *(LAS v4u*)(Vi + off_b(r, c16)) = pv[i]; }
            const v4u csg0 = psg[0], csg1 = psg[1];
            __syncthreads();
            if (c + 1 < SEQ / 64) { const int rn = row0 + 64;
#pragma unroll
                for (int t = 0; t < 16; ++t) { const size_t gi = (size_t)(rn + 16 * (int)kbp + t) * DM + h * 128 + dp; plf[t] = LF[gi]; pqk[t] = (unsigned)Q[gi] | ((unsigned)K[gi] << 16); }
#pragma unroll
                for (int i = 0; i < 2; ++i) { const unsigned p = tidl + 512u * i, r = p >> 4, c16 = p & 15u; pv[i] = *(const v4u*)(V + (size_t)(rn + (int)r) * DM + h * 128 + c16 * 8); }
#pragma unroll
                for (int i = 0; i < 2; ++i) psg[i] = *(const v4u*)(SG + (size_t)(rn + (int)(tidl >> 3)) * DM + h * 128 + 16 * (tidl & 7u) + 8 * i); }
#pragma unroll 1
            for (unsigned kb = 0; kb < 4; ++kb) {
                const unsigned rowl = 16u * kb + li;
                f32x4 P = (f32x4){0.f, 0.f, 0.f, 0.f};
#pragma unroll
                for (int s4 = 0; s4 < 4; ++s4) P = __builtin_amdgcn_mfma_f32_16x16x32_bf16(row_frag(KEi, rowl, s4, g), row_frag(QE2i, rowl, s4, g), P, 0, 0, 0);
                s16x4 a16;
                { const unsigned lo = pk2((4u * g + 0u <= li) ? P[0] : 0.f, (4u * g + 1u <= li) ? P[1] : 0.f), hi = pk2((4u * g + 2u <= li) ? P[2] : 0.f, (4u * g + 3u <= li) ? P[3] : 0.f); const v2u t2 = (v2u){lo, hi}; a16 = __builtin_bit_cast(s16x4, t2); }
                const unsigned q4 = li >> 2, p4 = li & 3u, trow = 16u * kb + 4u * g + q4;
                const s16x4 Vb = __builtin_amdgcn_ds_read_tr16_b64_v4i16((LAS s16x4*)(Vi + off_b(trow, 2u * w + (p4 >> 1)) + 8u * (p4 & 1u)));
                f32x4 oa = (f32x4){0.f, 0.f, 0.f, 0.f};
#pragma unroll
                for (int s4 = 0; s4 < 4; ++s4) {
                    const v4u st = (v4u){pk2(S[2 * s4][0], S[2 * s4][1]), pk2(S[2 * s4][2], S[2 * s4][3]), pk2(S[2 * s4 + 1][0], S[2 * s4 + 1][1]), pk2(S[2 * s4 + 1][2], S[2 * s4 + 1][3])};
                    const v2u lo = *(const LAS v2u*)(QEi + off_b(rowl, 4u * s4 + (g >> 1)) + 8u * (g & 1u)), hi = *(const LAS v2u*)(QEi + off_b(rowl, 4u * s4 + 2u + (g >> 1)) + 8u * (g & 1u));
                    const v4u av = (v4u){lo.x, lo.y, hi.x, hi.y};
                    oa = __builtin_amdgcn_mfma_f32_16x16x32_bf16(__builtin_bit_cast(bf16x8, av), __builtin_bit_cast(bf16x8, st), oa, 0, 0, 0); }
                oa = __builtin_amdgcn_mfma_f32_16x16x32_bf16(pad8(a16), pad8(Vb), oa, 0, 0, 0);
#pragma unroll
                for (int dt = 0; dt < 8; ++dt) { const f32x4 e4 = *(const LAS f32x4*)(BL + kb * 128u + 16u * dt + 4u * g);
                    const s16x4 kt = __builtin_amdgcn_ds_read_tr16_b64_v4i16((LAS s16x4*)(KEi + off_b(trow, 2u * dt + (p4 >> 1)) + 8u * (p4 & 1u)));
                    S[dt] = __builtin_amdgcn_mfma_f32_16x16x32_bf16(pad8(kt), pad8(Vb), S[dt] * e4, 0, 0, 0); }
#pragma unroll
                for (int q = 0; q < 4; ++q) OT[(16u * kb + 4u * g + q) * 128u + 16u * w + li] = oa[q];
            }
            __syncthreads();
            { const unsigned tn = tidl >> 3, vg = tidl & 7u; f32x4 o[4]; float ss = 0.f;
#pragma unroll
              for (int i = 0; i < 4; ++i) { o[i] = *(const LAS f32x4*)(OT + tn * 128u + 16u * vg + 4u * i); ss += (o[i].x * o[i].x + o[i].y * o[i].y) + (o[i].z * o[i].z + o[i].w * o[i].w); }
              ss += __shfl_xor(ss, 1); ss += __shfl_xor(ss, 2); ss += __shfl_xor(ss, 4);
              const float r = 1.0f / sqrtf(ss * (1.0f / 128.f) + EPS); const float* gp = KIN(I_HGAIN) + j * 128 + 16 * vg;
#pragma unroll
              for (int i = 0; i < 4; ++i) o[i] = o[i] * r * *(const f32x4*)(gp + 4 * i);
              v4u w0, w1;
              w0.x = pk2(o[0].x * bflo(csg0.x), o[0].y * bfhi(csg0.x)); w0.y = pk2(o[0].z * bflo(csg0.y), o[0].w * bfhi(csg0.y)); w0.z = pk2(o[1].x * bflo(csg0.z), o[1].y * bfhi(csg0.z)); w0.w = pk2(o[1].z * bflo(csg0.w), o[1].w * bfhi(csg0.w));
              w1.x = pk2(o[2].x * bflo(csg1.x), o[2].y * bfhi(csg1.x)); w1.y = pk2(o[2].z * bflo(csg1.y), o[2].w * bfhi(csg1.y)); w1.z = pk2(o[3].x * bflo(csg1.z), o[3].y * bfhi(csg1.z)); w1.w = pk2(o[3].z * bflo(csg1.w), o[3].w * bfhi(csg1.w));
              bf16* op = O + (size_t)(row0 + (int)tn) * DM + h * 128 + 16 * vg; *(v4u*)op = w0; *(v4u*)(op + 8) = w1; }
        }
    }
}

struct Args { const void* in[22]; float* out; unsigned char* ws; int ph_lo, ph_hi; };
constexpr int PH_PER_LAYER = 9, NPHASES = 1 + DEPTH * PH_PER_LAYER + 1;

__global__ void __launch_bounds__(NWAVES * 64, 2) hybrid_fwd(Args args) {
    extern __shared__ __attribute__((aligned(16))) unsigned char lds[];
    Frame F;
    F.lds = (LAS unsigned char*)lds;
    F.tid = threadIdx.x; F.lane = F.tid & 63; F.wave = __builtin_amdgcn_readfirstlane(F.tid >> 6);
    F.G = gridDim.x; { const int bx = blockIdx.x; F.vcu = (F.G % 8 == 0) ? (bx % 8) * (F.G / 8) + bx / 8 : bx; }
    F.ws = args.ws; F.out = args.out; F.ctl = (unsigned*)(args.ws + WS_CTL);
    for (int u = F.tid; u < (LDS_BYTES - MISC_OFF) / 4; u += NWAVES * 64) ((LAS unsigned*)(F.lds + MISC_OFF))[u] = 0u;
    __syncthreads();
    const int lo = args.ph_lo, hi = args.ph_hi;
    XcdBarrier bar; bar.bar = F.ctl + CW_BAR; bar.x = 0; bar.st = nullptr;
    if (hi - lo > 1) bar = xcd_barrier_post(F.ctl + CW_BAR, (volatile LAS unsigned*)(F.lds + MISC_OFF) + 8);
#define IN(k) (lo <= (k) && (k) < hi)
#define SEAM(k) do { if (IN(k) && hi > (k) + 1) xcd_barrier(bar); } while (0)

    if (PH_EN(0) && IN(0)) { for (int rep = 0; rep < REPS(0); ++rep) p0_prologue(F); } SEAM(0);

#pragma unroll 1
    for (int l = 0; l < DEPTH; ++l) {
        const int pb = 1 + l * PH_PER_LAYER, j = l >> 1; const bool is_ret = (l & 1);
        if (PH_EN(1) && IN(pb + 0)) row_phase1(F, l, 0);
        SEAM(pb + 0);
        if (IN(pb + 1)) {
            if (PH_EN(2) && !is_ret) {
                pg8::Gemm g{(const bf16*)(F.ws + WS_H), (const bf16*)(F.ws + WS_HWIN) + (size_t)j * HG_N * DM, MTOK, HG_N, DM}; pg8::StaticOrder S; S.init(MTOK, HG_N, F.G, (int)blockIdx.x);
                EpiHgrnIn E{F.ws + WS_R1, (const float*)(F.ws + WS_LBV) + j * DM};
                for (int rep = 0; rep < REPS(2); ++rep) pg8::gemm_phase<EpiHgrnIn, pg8::StaticOrder, true, true>(F.lds + RING_OFF, g, S, E);
            } else if (PH_EN(3)) {
                pg8::Gemm g{(const bf16*)(F.ws + WS_H), (const bf16*)(F.ws + WS_RWIN) + (size_t)j * RT_N * DM, MTOK, RT_N, DM}; pg8::StaticOrder S; S.init(MTOK, RT_N, F.G, (int)blockIdx.x);
                EpiRetIn E{F.ws + WS_R1, (const int*)kin_(I_POS)};
                for (int rep = 0; rep < REPS(3); ++rep) pg8::gemm_phase<EpiRetIn, pg8::StaticOrder, true, true>(F.lds + RING_OFF, g, S, E);
            }
        }
        SEAM(pb + 1);
        if (IN(pb + 2)) { if (!is_ret) { if (PH_EN(4)) { for (int rep = 0; rep < REPS(4); ++rep) { if (HGRN_MFMA) hgrn_scan_mfma(F, j); else hgrn_scan(F, j); } } } else { if (PH_EN(5)) { for (int rep = 0; rep < REPS(5); ++rep) { if (RET_MFMA) ret_scan_mfma(F); else ret_scan(F); } } } }
        SEAM(pb + 2);
        if (RET_MFMA && PH_EN(12) && IN(pb + 3) && is_ret) ret_norm(F);
        if (RET_MFMA && is_ret) SEAM(pb + 3);
        if (PH_EN(6) && IN(pb + 4)) {
            const int Ko = is_ret ? 2048 : DM;
            const bf16* Wt = is_ret ? (const bf16*)(F.ws + WS_RWOUT) + (size_t)j * DM * 2048 : (const bf16*)(F.ws + WS_HWOUT) + (size_t)j * DM * DM;
            pg8::Gemm g{(const bf16*)(F.ws + WS_R2), Wt, MTOK, DM, Ko}; pg8::StaticOrder S; S.init(MTOK, DM, F.G, (int)blockIdx.x);
            EpiOut E{l == 0 ? KIN(I_X) : F.out, F.out, (const float*)(F.ws + WS_MOD) + (size_t)l * NBATCH * 6 * DM + 2 * DM};
            pg8::gemm_phase<EpiOut, pg8::StaticOrder, true, true>(F.lds + RING_OFF, g, S, E);
        }
        SEAM(pb + 4);
        if (PH_EN(7) && IN(pb + 5)) row_phase2(F, l);
        SEAM(pb + 5);
        if (MOE_GATHER_PASS) { if (PH_EN(8) && IN(pb + 6)) { for (int rep = 0; rep < REPS(8); ++rep) moe_gather(F, l); } SEAM(pb + 6); }
        if (PH_EN(9) && IN(pb + 7)) {
            build_tiles(F, l);
            if (!MOE_GATHER_PASS) moe_build_tt(F, 8);
            pg8::MoeOrder S{8, F.G, F.vcu, (const LAS int*)(F.lds + TAB_OFF), (const LAS unsigned short*)(F.lds + 131072)};
            if constexpr (MOE_FP8) {
                static_assert(!MOE_FP8 || !MOE_GATHER_PASS, "the fp8 expert GEMM gathers while staging");
                pg8::Gemm g{(const bf16*)(F.ws + WS_H8), (const bf16*)(F.ws + WS_W1T + (size_t)l * NEXP * 2048 * DM), 0, 0, DM / 2};
                EpiMoe1F8 E{F.ws + WS_R2, KIN(I_B1) + (size_t)l * NEXP * 2048};
                for (int rep = 0; rep < REPS(9); ++rep) pg8::gemm_phase<EpiMoe1F8, pg8::MoeOrder, true, true, true, true>(F.lds + RING_OFF, g, S, E);
            } else {
                pg8::Gemm g{(const bf16*)(F.ws + (MOE_GATHER_PASS ? WS_R1 : WS_H)), (const bf16*)(F.ws + WS_W1T) + (size_t)l * NEXP * 2048 * DM, 0, 0, DM};
                EpiMoe1 E{(bf16*)(F.ws + WS_R2), KIN(I_B1) + (size_t)l * NEXP * 2048};
                for (int rep = 0; rep < REPS(9); ++rep) pg8::gemm_phase<EpiMoe1, pg8::MoeOrder, true, true, !MOE_GATHER_PASS>(F.lds + RING_OFF, g, S, E);
            }
        }
        SEAM(pb + 7);
        if (PH_EN(10) && IN(pb + 8)) {
            build_tiles(F, l);
            pg8::MoeOrder S{4, F.G, F.vcu, (const LAS int*)(F.lds + TAB_OFF), nullptr};
            if constexpr (MOE_FP8) {
                pg8::Gemm g{(const bf16*)(F.ws + WS_R2), (const bf16*)(F.ws + WS_W2T + (size_t)l * NEXP * DM * DM), 0, 0, DM / 2};
                EpiMoe2 E{(bf16*)(F.ws + WS_R1), KIN(I_B2) + (size_t)l * NEXP * DM, 1.0f / 256.f};
                for (int rep = 0; rep < REPS(10); ++rep) pg8::gemm_phase<EpiMoe2, pg8::MoeOrder, true, true, false, true>(F.lds + RING_OFF, g, S, E);
            } else {
                pg8::Gemm g{(const bf16*)(F.ws + WS_R2), (const bf16*)(F.ws + WS_W2T) + (size_t)l * NEXP * DM * DM, 0, 0, DM};
                EpiMoe2 E{(bf16*)(F.ws + WS_R1), KIN(I_B2) + (size_t)l * NEXP * DM, 1.0f};
                for (int rep = 0; rep < REPS(10); ++rep) pg8::gemm_phase<EpiMoe2, pg8::MoeOrder, true, true>(F.lds + RING_OFF, g, S, E);
            }
        }
        SEAM(pb + 8);
    }
    if (PH_EN(11) && IN(NPHASES - 1)) row_phase1(F, DEPTH, 1);
#undef IN
#undef SEAM
}

extern "C" void kernel_launch(void* const* d_in, const int* in_sizes, int n_in, void* d_out, int out_size, void* d_ws, size_t ws_size, hipStream_t stream) {
    static int grid = 0;
    if (grid == 0) {
        if (n_in != 22 || in_sizes[0] != MTOK * DM || out_size != MTOK * DM || ws_size < WS_END) { fprintf(stderr, "kernel_launch: unexpected shapes (n_in %d, in0 %d, out %d, ws %zu < %zu)\n", n_in, n_in > 0 ? in_sizes[0] : -1, out_size, ws_size, (size_t)WS_END); grid = -1; return; }
        int dev = 0, cus = 0, per_cu = 0;
        if (hipGetDevice(&dev) != hipSuccess || hipDeviceGetAttribute(&cus, hipDeviceAttributeMultiprocessorCount, dev) != hipSuccess) { grid = -1; return; }
        if (hipFuncSetAttribute((const void*)hybrid_fwd, hipFuncAttributeMaxDynamicSharedMemorySize, LDS_BYTES) != hipSuccess) { fprintf(stderr, "kernel_launch: hipFuncSetAttribute failed\n"); grid = -1; return; }
        if (hipOccupancyMaxActiveBlocksPerMultiprocessor(&per_cu, (const void*)hybrid_fwd, NWAVES * 64, LDS_BYTES) != hipSuccess || per_cu < 1) { fprintf(stderr, "kernel_launch: occupancy query says %d blocks per CU\n", per_cu); }
        (void)hipGetLastError();
        grid = cus;
    }
    if (grid < 0) return;
    (void)hipMemsetAsync((char*)d_ws + WS_CTL, 0, CTL_ZERO_BYTES, stream);
    Args a{};
    for (int i = 0; i < 22; ++i) a.in[i] = d_in[i];
    a.out = (float*)d_out; a.ws = (unsigned char*)d_ws;
#if MK_SPLIT
    for (int p = 0; p < DBG_LIMIT; ++p) {
        if (p >= 1 && p < NPHASES - 1 && ((p - 1) % PH_PER_LAYER) == 3 && (!RET_MFMA || (((p - 1) / PH_PER_LAYER) & 1) == 0)) continue;
        if (!MOE_GATHER_PASS && p >= 1 && p < NPHASES - 1 && ((p - 1) % PH_PER_LAYER) == 6) continue;
        a.ph_lo = p; a.ph_hi = p + 1;
        hipLaunchKernelGGL(hybrid_fwd, dim3(grid), dim3(NWAVES * 64), LDS_BYTES, stream, a);
    }
#else
    a.ph_lo = 0; a.ph_hi = NPHASES;
    hipLaunchKernelGGL(hybrid_fwd, dim3(grid), dim3(NWAVES * 64), LDS_BYTES, stream, a);
#endif
    const hipError_t le = hipPeekAtLastError();
    if (le != hipSuccess) fprintf(stderr, "kernel_launch: launch failed: %s\n", hipGetErrorName(le));
}
```

```cpp
#include <hip/hip_runtime.h>
#include <cstdio>
#include <cstdint>

#ifndef ONLY_PH
#define ONLY_PH -1
#endif
#define PH_EN(n) (ONLY_PH < 0 || ONLY_PH == (n))
#ifndef DBG_LIMIT
#define DBG_LIMIT NPHASES
#endif
#ifndef RET_MFMA
#define RET_MFMA 1
#endif
#ifndef HGRN_MFMA
#define HGRN_MFMA 1
#endif
#ifndef REPEAT_MASK
#define REPEAT_MASK 0
#endif
#define REPS(k) (1 + ((REPEAT_MASK >> (k)) & 1))
#ifndef MOE_GATHER_PASS
#define MOE_GATHER_PASS 0
#endif
#ifndef MOE_FP8
#define MOE_FP8 1
#endif
#ifndef MK_SPLIT
#define MK_SPLIT 0
#endif

namespace pg8 {
#define PG8_LAS __attribute__((address_space(3)))
typedef unsigned short bf16_t;
typedef short bf16x8 __attribute__((ext_vector_type(8)));
typedef float f32x4 __attribute__((ext_vector_type(4)));
typedef unsigned u32x4 __attribute__((ext_vector_type(4)));
constexpr int BM = 256, BK = 64, HALF = 128, HTB = HALF * BK * 2  , STAGE_BYTES = 8 * HTB, NXCD = 8, WGM = 8;

__host__ __device__ __forceinline__ int lds_byte(int r, int c) { const int st = (r >> 4) * 2 + (c >> 5), rr = r & 15, cc = c & 31, ob = rr * 64 + cc * 2; return st * 1024 + (ob ^ (((ob >> 9) & 1) << 5)); }
__host__ __device__ __forceinline__ void stage_rc(int b, int& R, int& C) { const int st = b / 1024, sb = b % 1024, swz = sb ^ (((sb >> 9) & 1) << 5); R = (st >> 1) * 16 + swz / 64; C = (st & 1) * 32 + (swz % 64) / 2; }
__host__ __device__ __forceinline__ int perm32(int rho) { const int n = rho >> 4, i = rho & 15; return 8 * (i >> 2) + 4 * n + (i & 3); }

struct Unit { int pm, pn, e, nn; };
struct Gemm { const bf16_t* A; const bf16_t* Bt; int M, N, K; };

struct StaticOrder {
    int nM, nN, nwg, G, c;
    __host__ __device__ void init(int M, int N, int G_, int c_) { nM = M / BM; nN = N / BM; nwg = nM * nN; G = G_; c = c_; }
    __host__ __device__ bool next(int i, Unit& u) const {
        const long L = (long)i * G + c; if (L >= nwg) return false;
        int wgid = (int)L; { const int q = nwg / NXCD, r = nwg % NXCD, xcd = wgid % NXCD, off = wgid / NXCD; wgid = (xcd < r ? xcd * (q + 1) : r * (q + 1) + (xcd - r) * q) + off; }
        const int nig = WGM * nN, gid = wgid / nig, fm = gid * WGM, gsz = (nM - fm) < WGM ? (nM - fm) : WGM;
        u.pm = fm + ((wgid % nig) % gsz); u.pn = (wgid % nig) / gsz; u.e = 0; u.nn = u.pn; return true;
    }
    __device__ __forceinline__ unsigned tok(int, int) const { return 0u; }
    __device__ __forceinline__ void a_ready(const Unit&) const {}
    __device__ __forceinline__ void done(const Unit&) const {}
};
struct MoeOrder {
    int nN, G, c; const PG8_LAS int* ts; const PG8_LAS unsigned short* tt;
    __device__ __forceinline__ unsigned tok(int i, int r) const { return tt[i * 256 + r]; }
    __device__ __forceinline__ bool next(int i, Unit& u) const {
        const int NT = ts[32]; const long L = (long)i * G + c; if (L >= (long)NT * nN) return false;
        const int mt = (int)(L / nN), n = (int)(L % nN); int e = 0;
        for (int k = 1; k < 32; ++k) e += (ts[k] <= mt) ? 1 : 0;
        u.pm = mt; u.pn = e * nN + n; u.e = e; u.nn = n; return true;
    }
    __device__ __forceinline__ void a_ready(const Unit&) const {}
    __device__ __forceinline__ void done(const Unit&) const {}
};

__device__ __forceinline__ unsigned cvt_pk_bf16(float lo, float hi) { unsigned r; asm volatile("v_cvt_pk_bf16_f32 %0, %1, %2" : "=v"(r) : "v"(lo), "v"(hi)); return r; }

template <int N> __device__ __forceinline__ void wait_vm() { asm volatile("s_waitcnt vmcnt(%0)" :: "n"(N) : "memory"); }
typedef int v8i32 __attribute__((ext_vector_type(8)));
template <class Epi, class Sched, bool ALIGN_EPI = false, bool SP2 = false, bool GATHER = false, bool FP8 = false, bool NOEPI = false>
__device__ __forceinline__ void gemm_phase(PG8_LAS unsigned char* lds, const Gemm g, const Sched& S, const Epi& E) {
    int tid_ = threadIdx.x; asm volatile("" : "+v"(tid_));
    const int tid = tid_, wid = __builtin_amdgcn_readfirstlane(tid >> 6), lane = tid & 63, wr = wid >> 2, wc = wid & 3, fr = lane & 15, fq = lane >> 4;
    const int K = g.K, nt = K / BK;
    unsigned voffA[2], voffB[2];
#pragma unroll
    for (int i = 0; i < 2; ++i) { int R, C; stage_rc(tid * 16 + i * 8192, R, C); const int Rb = Epi::PERM ? ((R & ~31) + perm32(R & 31)) : R;
        voffA[i] = (unsigned)(R * K + C) * 2u; voffB[i] = (unsigned)(Rb * K + C) * 2u; }
    int gR[2]; unsigned gC[2];
#pragma unroll
    for (int i = 0; i < 2; ++i) { int R, C; stage_rc(tid * 16 + i * 8192, R, C); gR[i] = R; gC[i] = (unsigned)C * 2u; }
#define PG8_GVOFF(v, ui_, h_) do { _Pragma("unroll") for (int _i = 0; _i < 2; ++_i) v[_i] = (S.tok((ui_), gR[_i] + HALF * (h_)) * (unsigned)(K * 2)) + gC[_i]; } while (0)
    const size_t kstep = (size_t)(BK * 2);
    const size_t hstep = (size_t)HALF * K * 2;
    const size_t tstep = 2 * hstep;
    const unsigned ldsw = (unsigned)wid * 1024u;
    const int aoff = FP8 ? lds_byte(wr * 64 + fr, fq * 16) : lds_byte(wr * 64 + fr, fq * 8), boff = FP8 ? lds_byte(wc * 32 + fr, fq * 16) : lds_byte(wc * 32 + fr, fq * 8);

#define PG8_SA(b, h) (((b) * 2 + (h)) * HTB)
#define PG8_SB(b, h) ((4 + (b) * 2 + (h)) * HTB)
#define PG8_STAGE(bufoff, gbase, voff) do { _Pragma("unroll") for (int _i = 0; _i < 2; ++_i) \
        __builtin_amdgcn_global_load_lds((const unsigned*)((const char*)(gbase) + (voff)[_i]), (PG8_LAS unsigned*)(lds + (bufoff) + ldsw + _i * 8192), 16, 0, 0); } while (0)
#define PG8_LDA(dst, b, h) do { if constexpr (FP8) { _Pragma("unroll") for (int m = 0; m < 4; ++m) { const u32x4 p0_ = *(const PG8_LAS u32x4*)(lds + PG8_SA(b, h) + aoff + m * 2048), p1_ = *(const PG8_LAS u32x4*)(lds + PG8_SA(b, h) + aoff + m * 2048 + 16); dst##8[m] = __builtin_bit_cast(v8i32, __builtin_shufflevector(p0_, p1_, 0, 1, 2, 3, 4, 5, 6, 7)); } } \
    else { _Pragma("unroll") for (int m = 0; m < 4; ++m) _Pragma("unroll") for (int k = 0; k < 2; ++k) dst[m][k] = *(const PG8_LAS bf16x8*)(lds + PG8_SA(b, h) + aoff + m * 2048 + k * 1024); } } while (0)
#define PG8_LDB(dst, b, h) do { if constexpr (FP8) { _Pragma("unroll") for (int n = 0; n < 2; ++n) { const u32x4 p0_ = *(const PG8_LAS u32x4*)(lds + PG8_SB(b, h) + boff + n * 2048), p1_ = *(const PG8_LAS u32x4*)(lds + PG8_SB(b, h) + boff + n * 2048 + 16); dst##8[n] = __builtin_bit_cast(v8i32, __builtin_shufflevector(p0_, p1_, 0, 1, 2, 3, 4, 5, 6, 7)); } } \
    else { _Pragma("unroll") for (int n = 0; n < 2; ++n) _Pragma("unroll") for (int k = 0; k < 2; ++k) dst[n][k] = *(const PG8_LAS bf16x8*)(lds + PG8_SB(b, h) + boff + n * 2048 + k * 1024); } } while (0)
#define PG8_CAT(x) __builtin_shufflevector(__builtin_bit_cast(u32x4, (x)[0]), __builtin_bit_cast(u32x4, (x)[1]), 0, 1, 2, 3, 4, 5, 6, 7)
#define PG8_MMA(ai, bj, At, Bt) do { __builtin_amdgcn_s_setprio(1); if constexpr (FP8) { _Pragma("unroll") for (int m = 0; m < 4; ++m) _Pragma("unroll") for (int n = 0; n < 2; ++n) \
        asm volatile("v_mfma_scale_f32_16x16x128_f8f6f4 %0, %1, %2, %0, %3, %3 op_sel_hi:[0,0,0]" : "+v"(acc[ai][bj][m][n]) : "v"(Bt##8[n]), "v"(At##8[m]), "v"(scl1)); } \
    else { _Pragma("unroll") for (int m = 0; m < 4; ++m) _Pragma("unroll") for (int n = 0; n < 2; ++n) _Pragma("unroll") for (int k = 0; k < 2; ++k) \
        acc[ai][bj][m][n] = __builtin_amdgcn_mfma_f32_16x16x32_bf16(Bt[n][k], At[m][k], acc[ai][bj][m][n], 0, 0, 0); } __builtin_amdgcn_s_setprio(0); } while (0)
#define PG8_WAIT_V(n) asm volatile("s_waitcnt vmcnt(" #n ")" ::: "memory")
#define PG8_WAIT_L(n) asm volatile("s_waitcnt lgkmcnt(" #n ")" ::: "memory")
#define PG8_BAR __builtin_amdgcn_s_barrier()
#define PG8_SCHED __builtin_amdgcn_sched_barrier(0)
    Unit cur, nxt; int ui = 0;
    if (!S.next(0, cur)) return;
    f32x4 acc[2][2][4][2];
#pragma unroll
    for (int a = 0; a < 2; ++a)
#pragma unroll
        for (int b = 0; b < 2; ++b)
#pragma unroll
            for (int m = 0; m < 4; ++m)
#pragma unroll
                for (int n = 0; n < 2; ++n) acc[a][b][m][n] = (f32x4){0.f, 0.f, 0.f, 0.f};
    const unsigned scl1 = 0x7f7f7f7fu;
    bf16x8 At[4][2], B0[2][2], B1[2][2]; v8i32 At8[4], B08[2], B18[2];
    const char* cA = GATHER ? (const char*)g.A : (const char*)g.A + (size_t)cur.pm * tstep; const char* cB = (const char*)g.Bt + (size_t)cur.pn * tstep;
    S.a_ready(cur);
    static_assert(!GATHER || SP2, "GATHER is written for the SP2 loop");
    if constexpr (SP2) {
        if constexpr (GATHER) { unsigned v0[2], v1[2]; PG8_GVOFF(v0, 0, 0); PG8_GVOFF(v1, 0, 1); PG8_STAGE(PG8_SB(0, 0), cB, voffB); PG8_STAGE(PG8_SB(0, 1), cB + hstep, voffB); PG8_STAGE(PG8_SA(0, 0), cA, v0); PG8_STAGE(PG8_SA(0, 1), cA, v1); }
        else { PG8_STAGE(PG8_SB(0, 0), cB, voffB); PG8_STAGE(PG8_SB(0, 1), cB + hstep, voffB); PG8_STAGE(PG8_SA(0, 0), cA, voffA); PG8_STAGE(PG8_SA(0, 1), cA + hstep, voffA); }
        if (wr == 1) PG8_BAR;
        PG8_WAIT_V(2); PG8_BAR;
        if constexpr (GATHER) { unsigned v0[2]; PG8_GVOFF(v0, 0, 0); PG8_STAGE(PG8_SB(1, 0), cB + kstep, voffB); PG8_STAGE(PG8_SA(1, 0), cA + kstep, v0); PG8_STAGE(PG8_SB(1, 1), cB + hstep + kstep, voffB); }
        else { PG8_STAGE(PG8_SB(1, 0), cB + kstep, voffB); PG8_STAGE(PG8_SA(1, 0), cA + kstep, voffA); PG8_STAGE(PG8_SB(1, 1), cB + hstep + kstep, voffB); }
        PG8_WAIT_V(6); PG8_BAR;
    } else {
        PG8_STAGE(PG8_SB(0, 0), cB, voffB); PG8_STAGE(PG8_SA(0, 0), cA, voffA); PG8_STAGE(PG8_SB(0, 1), cB + hstep, voffB); PG8_STAGE(PG8_SA(0, 1), cA + hstep, voffA);
        if (wr == 1) PG8_BAR;
        PG8_WAIT_V(4); PG8_BAR;
        PG8_STAGE(PG8_SB(1, 0), cB + kstep, voffB); PG8_STAGE(PG8_SA(1, 0), cA + kstep, voffA); PG8_STAGE(PG8_SB(1, 1), cB + hstep + kstep, voffB);
        PG8_WAIT_V(6); PG8_BAR;
    }
    for (;;) {
        const bool has_next = S.next(ui + 1, nxt);
        const char* nA = GATHER ? cA : (has_next ? (const char*)g.A + (size_t)nxt.pm * tstep : cA); const char* nB = has_next ? (const char*)g.Bt + (size_t)nxt.pn * tstep : cB;
#pragma unroll 1
        for (int t = 0; t < nt; t += 2) {
            asm volatile("" : "+v"(voffA[0]), "+v"(voffA[1]), "+v"(voffB[0]), "+v"(voffB[1]));
            const bool last = (t == nt - 2);
            const char* a1 = cA + (size_t)(t + 1) * kstep;
            const char* a2 = last ? nA : cA + (size_t)(t + 2) * kstep; const char* b2 = last ? nB : cB + (size_t)(t + 2) * kstep;
            const char* a3 = a2 + kstep; const char* b3 = b2 + kstep;
            if (last && has_next) S.a_ready(nxt);
            const bool rlx = (t == 0) && (ui > 0);
#define PG8_WAIT_V8R do { if (rlx) wait_vm<8 + Epi::NST>(); else wait_vm<8>(); } while (0)
            if constexpr (SP2 && GATHER) {
            const int uix = (last && has_next) ? ui + 1 : ui;
            unsigned vc1[2], vx0[2], vx1[2]; PG8_GVOFF(vc1, ui, 1); PG8_GVOFF(vx0, uix, 0); PG8_GVOFF(vx1, uix, 1);
            PG8_LDB(B0, 0, 0); PG8_LDB(B1, 0, 1); PG8_SCHED; PG8_LDA(At, 0, 0); PG8_STAGE(PG8_SA(1, 1), a1, vc1);
            PG8_WAIT_V8R; PG8_WAIT_L(0); PG8_BAR; PG8_MMA(0, 0, At, B0); PG8_MMA(0, 1, At, B1); PG8_BAR; PG8_SCHED;
            PG8_LDA(At, 0, 1); PG8_STAGE(PG8_SB(0, 0), b2, voffB); PG8_STAGE(PG8_SB(0, 1), b2 + hstep, voffB); PG8_STAGE(PG8_SA(0, 0), a2, vx0);
            PG8_WAIT_V8R; PG8_WAIT_L(0); PG8_BAR; PG8_MMA(1, 0, At, B0); PG8_MMA(1, 1, At, B1); PG8_BAR; PG8_SCHED;
            PG8_LDB(B0, 1, 0); PG8_LDB(B1, 1, 1); PG8_SCHED; PG8_LDA(At, 1, 0); PG8_STAGE(PG8_SA(0, 1), a2, vx1);
            PG8_WAIT_V(8); PG8_WAIT_L(0); PG8_BAR; PG8_MMA(0, 0, At, B0); PG8_MMA(0, 1, At, B1); PG8_BAR; PG8_SCHED;
            PG8_LDA(At, 1, 1); PG8_STAGE(PG8_SB(1, 0), b3, voffB); PG8_STAGE(PG8_SB(1, 1), b3 + hstep, voffB); PG8_STAGE(PG8_SA(1, 0), a3, vx0);
            PG8_WAIT_V(8); PG8_WAIT_L(0); PG8_BAR; PG8_MMA(1, 0, At, B0); PG8_MMA(1, 1, At, B1); PG8_BAR; PG8_SCHED;
            } else if constexpr (SP2) {
            PG8_LDB(B0, 0, 0); PG8_LDB(B1, 0, 1); PG8_SCHED; PG8_LDA(At, 0, 0); PG8_STAGE(PG8_SA(1, 1), a1 + hstep, voffA);
            PG8_WAIT_V8R; PG8_WAIT_L(0); PG8_BAR; PG8_MMA(0, 0, At, B0); PG8_MMA(0, 1, At, B1); PG8_BAR; PG8_SCHED;
            PG8_LDA(At, 0, 1); PG8_STAGE(PG8_SB(0, 0), b2, voffB); PG8_STAGE(PG8_SB(0, 1), b2 + hstep, voffB); PG8_STAGE(PG8_SA(0, 0), a2, voffA);
            PG8_WAIT_V8R; PG8_WAIT_L(0); PG8_BAR; PG8_MMA(1, 0, At, B0); PG8_MMA(1, 1, At, B1); PG8_BAR; PG8_SCHED;
            PG8_LDB(B0, 1, 0); PG8_LDB(B1, 1, 1); PG8_SCHED; PG8_LDA(At, 1, 0); PG8_STAGE(PG8_SA(0, 1), a2 + hstep, voffA);
            PG8_WAIT_V(8); PG8_WAIT_L(0); PG8_BAR; PG8_MMA(0, 0, At, B0); PG8_MMA(0, 1, At, B1); PG8_BAR; PG8_SCHED;
            PG8_LDA(At, 1, 1); PG8_STAGE(PG8_SB(1, 0), b3, voffB); PG8_STAGE(PG8_SB(1, 1), b3 + hstep, voffB); PG8_STAGE(PG8_SA(1, 0), a3, voffA);
            PG8_WAIT_V(8); PG8_WAIT_L(0); PG8_BAR; PG8_MMA(1, 0, At, B0); PG8_MMA(1, 1, At, B1); PG8_BAR; PG8_SCHED;
            } else {
            PG8_LDB(B0, 0, 0); PG8_SCHED; PG8_LDA(At, 0, 0); PG8_STAGE(PG8_SA(1, 1), a1 + hstep, voffA);
            PG8_WAIT_L(8); PG8_BAR; PG8_WAIT_L(0); PG8_MMA(0, 0, At, B0); PG8_BAR; PG8_SCHED;
            PG8_LDB(B1, 0, 1); PG8_STAGE(PG8_SB(0, 0), b2, voffB);
            PG8_BAR; PG8_WAIT_L(0); PG8_MMA(0, 1, At, B1); PG8_BAR;
            PG8_LDA(At, 0, 1); PG8_STAGE(PG8_SA(0, 0), a2, voffA);
            PG8_BAR; PG8_WAIT_L(0); PG8_MMA(1, 0, At, B0); PG8_BAR; PG8_SCHED;
            PG8_STAGE(PG8_SB(0, 1), b2 + hstep, voffB);
            PG8_WAIT_V(6); PG8_BAR; PG8_MMA(1, 1, At, B1); PG8_BAR;
            PG8_LDB(B0, 1, 0); PG8_SCHED; PG8_LDA(At, 1, 0); PG8_STAGE(PG8_SA(0, 1), a2 + hstep, voffA);
            PG8_WAIT_L(8); PG8_BAR; PG8_WAIT_L(0); PG8_MMA(0, 0, At, B0); PG8_BAR; PG8_SCHED;
            PG8_LDB(B1, 1, 1); PG8_STAGE(PG8_SB(1, 0), b3, voffB);
            PG8_BAR; PG8_WAIT_L(0); PG8_MMA(0, 1, At, B1); PG8_BAR;
            PG8_LDA(At, 1, 1); PG8_STAGE(PG8_SA(1, 0), a3, voffA);
            PG8_BAR; PG8_WAIT_L(0); PG8_MMA(1, 0, At, B0); PG8_BAR; PG8_SCHED;
            PG8_STAGE(PG8_SB(1, 1), b3 + hstep, voffB);
            PG8_WAIT_V(6); PG8_BAR; PG8_MMA(1, 1, At, B1); PG8_BAR;
            }
        }
        if constexpr (ALIGN_EPI) { if (wr == 0) PG8_BAR; }
        if constexpr (FP8) asm volatile("s_nop 15\n\ts_nop 7" ::: "memory");
        { int te = threadIdx.x; asm volatile("" : "+v"(te));
          if constexpr (!NOEPI) E(acc, cur, wr, wc, te & 15, (te & 63) >> 4); else { float sink_ = 0.f; _Pragma("unroll") for (int a_ = 0; a_ < 2; ++a_) _Pragma("unroll") for (int b_ = 0; b_ < 2; ++b_) _Pragma("unroll") for (int m_ = 0; m_ < 4; ++m_) _Pragma("unroll") for (int n_ = 0; n_ < 2; ++n_) sink_ += acc[a_][b_][m_][n_][0]; asm volatile("" :: "v"(sink_)); } }
        if (!has_next) break;
#pragma unroll
        for (int a = 0; a < 2; ++a)
#pragma unroll
            for (int b = 0; b < 2; ++b)
#pragma unroll
                for (int m = 0; m < 4; ++m)
#pragma unroll
                    for (int n = 0; n < 2; ++n) acc[a][b][m][n] = (f32x4){0.f, 0.f, 0.f, 0.f};
        cur = nxt; cA = nA; cB = nB; ++ui;
        if constexpr (ALIGN_EPI) { if (wr == 1) PG8_BAR; }
    }
    PG8_WAIT_V(0);
    if constexpr (!ALIGN_EPI) { if (wr == 0) PG8_BAR; }
    PG8_BAR;
#undef PG8_GVOFF
#undef PG8_WAIT_V8R
#undef PG8_CAT
#undef PG8_SA
#undef PG8_SB
#undef PG8_STAGE
#undef PG8_LDA
#undef PG8_LDB
#undef PG8_MMA
#undef PG8_WAIT_V
#undef PG8_WAIT_L
#undef PG8_BAR
#undef PG8_SCHED
}
}

constexpr int NWAVES = 8;
constexpr int DM = 1024, NBATCH = 32, SEQ = 2048, MTOK = NBATCH * SEQ, DEPTH = 4, NEXP = 32, TOPK = 4;
constexpr int HG_N = 4096, RT_N = 6144, HG_H = 8, RT_H = 4;
constexpr float EPS = 1e-6f;
constexpr int LCAP = 65536;
constexpr int MAXTILES = 1056;

constexpr size_t MiB = 1u << 20;
constexpr size_t WS_CTL = 0, CTL_ZERO_BYTES = 1 * MiB;
constexpr size_t WS_MOD = 1 * MiB;
constexpr size_t WS_FMOD = 4 * MiB;
constexpr size_t WS_LBV = 4 * MiB + 512 * 1024;
constexpr size_t WS_HWIN = 8 * MiB, WS_HWOUT = 24 * MiB, WS_RWIN = 28 * MiB, WS_RWOUT = 52 * MiB, WS_W1T = 64 * MiB, WS_W2T = 576 * MiB;
constexpr size_t WS_H = 832 * MiB;
constexpr size_t WS_LIST = 960 * MiB;
constexpr size_t WS_TSLOT = 968 * MiB, WS_TGATE = 969 * MiB;
constexpr size_t WS_R1 = 976 * MiB;
constexpr size_t WS_R2 = 1744 * MiB;
constexpr size_t WS_H8 = 2272 * MiB;
constexpr size_t WS_END = 2336 * MiB;
constexpr int CW_BAR = 4096;
constexpr int CW_CNT = 8192;

constexpr int RING_OFF = 0, RING_BYTES = 131072;
constexpr int MISC_OFF = 155648;
constexpr int TAB_OFF = MISC_OFF + 128;
constexpr int LDS_BYTES = 160 * 1024;

#define GAS __attribute__((address_space(1)))
#define LAS __attribute__((address_space(3)))
typedef unsigned short bf16;
typedef unsigned v4u __attribute__((ext_vector_type(4)));
typedef unsigned v2u __attribute__((ext_vector_type(2)));
typedef float f32x4 __attribute__((ext_vector_type(4)));
typedef short bf16x8 __attribute__((ext_vector_type(8)));
#define RLX_AGENT __ATOMIC_RELAXED, __HIP_MEMORY_SCOPE_AGENT
#define LDS_WAIT() asm volatile("s_waitcnt lgkmcnt(0)" ::: "memory")
#define VM_WAIT() asm volatile("s_waitcnt vmcnt(0)" ::: "memory")
__device__ __forceinline__ unsigned pk2(float lo, float hi) { return pg8::cvt_pk_bf16(lo, hi); }
__device__ __forceinline__ unsigned pk4_fp8(float a, float b, float c, float d) { int p = 0; p = __builtin_amdgcn_cvt_pk_fp8_f32(a, b, p, false); p = __builtin_amdgcn_cvt_pk_fp8_f32(c, d, p, true); return (unsigned)p; }
__device__ __forceinline__ float bflo(unsigned w) { return __uint_as_float(w << 16); }
__device__ __forceinline__ float bfhi(unsigned w) { return __uint_as_float(w & 0xffff0000u); }
__device__ __forceinline__ float bf2f(unsigned short h) { return __uint_as_float(((unsigned)h) << 16); }
__device__ __forceinline__ float sigmoidf_(float x) { return __builtin_amdgcn_rcpf(1.f + __expf(-x)); }
__device__ __forceinline__ float siluf_(float x) { return x * sigmoidf_(x); }
__device__ __forceinline__ unsigned ldu_vec(const unsigned* p) { return __hip_atomic_load(p, RLX_AGENT); }

#define XB_TMO      128
#define XB_XCNT(j)  (256  + 64 * (j))
#define XB_XSUB(j)  (1280 + 64 * (j))
#define XB_XGEN(j)  (2304 + 64 * (j))
#define XB_TOP      3328
#define XB_TOPGEN   3392
#define XCD_BAR_WORDS 3456
#define XB_SPIN_CAP (1u << 18)

__device__ __forceinline__ unsigned xb_ld(unsigned* p)              { return __hip_atomic_load(p, __ATOMIC_RELAXED, __HIP_MEMORY_SCOPE_AGENT); }
__device__ __forceinline__ unsigned xb_add(unsigned* p, unsigned v) { return __hip_atomic_fetch_add(p, v, __ATOMIC_RELAXED, __HIP_MEMORY_SCOPE_AGENT); }
__device__ __forceinline__ unsigned xb_xcc_id() { return (unsigned)__builtin_amdgcn_s_getreg((3 << 11) | 20) & 0xFu; }
#define XB_SPIN(cond, bar) do { unsigned _sp = 0; while (cond) { __builtin_amdgcn_s_sleep(1); \
    if ((++_sp & 255u) == 0u) { if (xb_ld(&(bar)[XB_TMO])) break; if (_sp > XB_SPIN_CAP) { atomicAdd(&(bar)[XB_TMO], 1u); break; } } } } while (0)

struct XcdBarrier {
    unsigned* bar; unsigned x;
    volatile LAS unsigned* st;
};
__device__ __forceinline__ XcdBarrier xcd_barrier_post(unsigned* bar, volatile LAS unsigned* st) {
    XcdBarrier b; b.bar = bar; b.x = xb_xcc_id(); b.st = st;
    if (threadIdx.x == 0) (void)xb_add(&bar[XB_XCNT(b.x)], 1u);
    return b;
}
__device__ __forceinline__ void xcd_barrier_complete(unsigned* bar, unsigned x, unsigned& nloc, unsigned& nx) {
    const unsigned G = gridDim.x * gridDim.y * gridDim.z;
    unsigned sum, cnt, mine, sp = 0u;
    for (;;) {
        sum = 0u; cnt = 0u; mine = 0u;
#pragma unroll
        for (unsigned j = 0; j < 16; ++j) { const unsigned c = xb_ld(&bar[XB_XCNT(j)]); sum += c; cnt += (c > 0u) ? 1u : 0u; mine = (j == x) ? c : mine; }
        if (sum == G) break;
        __builtin_amdgcn_s_sleep(1);
        if ((++sp & 255u) == 0u) { if (xb_ld(&bar[XB_TMO])) break; if (sp > XB_SPIN_CAP) { atomicAdd(&bar[XB_TMO], 1u); break; } }
    }
    nloc = mine > 0u ? mine : 1u; nx = cnt > 0u ? cnt : 1u;
}
__device__ __forceinline__ void xcd_barrier(const XcdBarrier& b) {
    asm volatile("s_waitcnt vmcnt(0)" ::: "memory");
    __syncthreads();
    if (threadIdx.x == 0) {
        unsigned* bar = b.bar;
        __builtin_amdgcn_s_waitcnt(0);
        unsigned nloc = b.st[0], nx = b.st[1];
        if (nloc == 0u) { xcd_barrier_complete(bar, b.x, nloc, nx); b.st[0] = nloc; b.st[1] = nx; }
        const unsigned old = xb_add(&bar[XB_XSUB(b.x)], 1u);
        const unsigned gen = old / nloc;
        if (old + 1u == (gen + 1u) * nloc) {
            __builtin_amdgcn_fence(__ATOMIC_RELEASE, "agent");
            asm volatile("s_waitcnt vmcnt(0)" ::: "memory");
            const unsigned og = xb_add(&bar[XB_TOP], 1u);
            const unsigned tg = og / nx;
            if (og + 1u == (tg + 1u) * nx) xb_add(&bar[XB_TOPGEN], 1u);
            else XB_SPIN(xb_ld(&bar[XB_TOPGEN]) == tg, bar);
            __builtin_amdgcn_fence(__ATOMIC_ACQUIRE, "agent");
            xb_add(&bar[XB_XGEN(b.x)], 1u);
            asm volatile("s_waitcnt vmcnt(0)" ::: "memory");
        } else {
            XB_SPIN(xb_ld(&bar[XB_XGEN(b.x)]) == gen, bar);
            __builtin_amdgcn_fence(__ATOMIC_ACQUIRE, "agent");
            asm volatile("s_waitcnt vmcnt(0)" ::: "memory");
        }
    }
    __syncthreads();
}

struct Frame {
    LAS unsigned char* lds;
    unsigned* ctl;
    int tid, lane, wave, vcu, G;
    float* out; unsigned char* ws;
};
__device__ __forceinline__ void relaunder(Frame& F) { int t = threadIdx.x; asm volatile("" : "+v"(t)); F.tid = t; F.lane = t & 63; F.wave = __builtin_amdgcn_readfirstlane(t >> 6); }
#define KAS __attribute__((address_space(4)))
__device__ __forceinline__ const void* kin_(int i) { const KAS char* kp = (const KAS char*)__builtin_amdgcn_kernarg_segment_ptr(); asm volatile("" : "+s"(kp)); return *(const void* const KAS*)(kp + 8 * i); }
enum { I_X = 0, I_C, I_POS, I_ADAW, I_ADAB, I_N1G, I_N2G, I_HWIN, I_HWOUT, I_HGAIN, I_HLB, I_RWIN, I_RWOUT, I_RTW, I_RTB, I_W1, I_B1, I_W2, I_B2, I_FG, I_FADAW, I_FADAB };
#define KIN(i) ((const float*)kin_(i))
__device__ __forceinline__ float wave_sum(float v) {
#pragma unroll
    for (int o = 1; o < 64; o <<= 1) v += __shfl_xor(v, o);
    return v;
}

__device__ __forceinline__ void p0_transpose_item(const float* W, int N, bf16* WT, int K, int k0, int n0, int drow0, LAS float* scr, int lane) {
#pragma unroll 8
    for (int i = 0; i < 32; ++i) { const int kk = 2 * i + (lane >> 5); scr[kk * 33 + (lane & 31)] = W[(size_t)(k0 + kk) * N + n0 + (lane & 31)]; }
    LDS_WAIT(); asm volatile("" ::: "memory");
    const int c = lane & 7;
#pragma unroll
    for (int j = 0; j < 4; ++j) { const int n = (lane >> 3) + 8 * j; const LAS float* s = scr + (8 * c) * 33 + n;
        v4u o; o.x = pk2(s[0 * 33], s[1 * 33]); o.y = pk2(s[2 * 33], s[3 * 33]); o.z = pk2(s[4 * 33], s[5 * 33]); o.w = pk2(s[6 * 33], s[7 * 33]);
        *(GAS v4u*)(WT + (size_t)(drow0 + n) * K + k0 + 8 * c) = o; }
    LDS_WAIT(); asm volatile("" ::: "memory");
}
__device__ __forceinline__ void p0_transpose_item_f8(const float* W, int N, unsigned char* WT, int K, int k0, int n0, int drow0, LAS float* scr, int lane, float scale) {
#pragma unroll 8
    for (int i = 0; i < 32; ++i) { const int kk = 2 * i + (lane >> 5); scr[kk * 33 + (lane & 31)] = W[(size_t)(k0 + kk) * N + n0 + (lane & 31)]; }
    LDS_WAIT(); asm volatile("" ::: "memory");
    const int n = lane >> 1, hf = lane & 1; const LAS float* sp = scr + (32 * hf) * 33 + n;
    v4u o0, o1;
    o0.x = pk4_fp8(sp[0 * 33] * scale, sp[1 * 33] * scale, sp[2 * 33] * scale, sp[3 * 33] * scale); o0.y = pk4_fp8(sp[4 * 33] * scale, sp[5 * 33] * scale, sp[6 * 33] * scale, sp[7 * 33] * scale);
    o0.z = pk4_fp8(sp[8 * 33] * scale, sp[9 * 33] * scale, sp[10 * 33] * scale, sp[11 * 33] * scale); o0.w = pk4_fp8(sp[12 * 33] * scale, sp[13 * 33] * scale, sp[14 * 33] * scale, sp[15 * 33] * scale);
    o1.x = pk4_fp8(sp[16 * 33] * scale, sp[17 * 33] * scale, sp[18 * 33] * scale, sp[19 * 33] * scale); o1.y = pk4_fp8(sp[20 * 33] * scale, sp[21 * 33] * scale, sp[22 * 33] * scale, sp[23 * 33] * scale);
    o1.z = pk4_fp8(sp[24 * 33] * scale, sp[25 * 33] * scale, sp[26 * 33] * scale, sp[27 * 33] * scale); o1.w = pk4_fp8(sp[28 * 33] * scale, sp[29 * 33] * scale, sp[30 * 33] * scale, sp[31 * 33] * scale);
    unsigned char* d = WT + (size_t)(drow0 + n) * K + k0 + 32 * hf; *(GAS v4u*)d = o0; *(GAS v4u*)(d + 16) = o1;
    LDS_WAIT(); asm volatile("" ::: "memory");
}
__device__ __forceinline__ void p0_prologue(Frame& F) {
    relaunder(F);
    __syncthreads();
    const int gw = F.vcu * NWAVES + F.wave, NGW = F.G * NWAVES;
    {
        LAS float* condT = (LAS float*)(F.lds + RING_OFF);
        const float* cin = KIN(I_C);
        for (int idx = F.tid; idx < NBATCH * DM; idx += NWAVES * 64) { const int b = idx >> 10, k = idx & 1023; condT[k * 32 + b] = siluf_(cin[idx]); }
        __syncthreads();
        if ((gw & 3) == 0 && (gw >> 2) < 416) {
            const int u = gw >> 2; const float* W; const float* bias; float* outp; int N, n0, ostride;
            if (u < 384) { const int l = u / 96; n0 = (u % 96) * 64; N = 6 * DM; W = KIN(I_ADAW) + (size_t)l * DM * N; bias = KIN(I_ADAB) + l * N; outp = (float*)(F.ws + WS_MOD) + (size_t)l * NBATCH * N; ostride = N; }
            else { n0 = (u - 384) * 64; N = 2 * DM; W = KIN(I_FADAW); bias = KIN(I_FADAB); outp = (float*)(F.ws + WS_FMOD); ostride = N; }
            float acc[32];
#pragma unroll
            for (int b = 0; b < 32; ++b) acc[b] = 0.f;
#pragma unroll 4
            for (int k = 0; k < DM; ++k) {
                const float w = W[(size_t)k * N + n0 + F.lane];
                const LAS f32x4* cb = (const LAS f32x4*)(condT + k * 32);
#pragma unroll
                for (int q = 0; q < 8; ++q) { const f32x4 cv = cb[q]; acc[4 * q + 0] += cv.x * w; acc[4 * q + 1] += cv.y * w; acc[4 * q + 2] += cv.z * w; acc[4 * q + 3] += cv.w * w; }
            }
            const float bv = bias[n0 + F.lane];
#pragma unroll
            for (int b = 0; b < 32; ++b) outp[(size_t)b * ostride + n0 + F.lane] = acc[b] + bv;
        }
        if (gw == NGW - 1) {
            float* lbv = (float*)(F.ws + WS_LBV); const float* hlb = KIN(I_HLB);
            for (int d = F.lane; d < DM; d += 64) { const float a = hlb[d], b = hlb[DM + d], m = fmaxf(a, b), ea = __expf(a - m), eb = __expf(b - m); lbv[d] = 0.f; lbv[DM + d] = eb / (ea + eb); }
        }
        __syncthreads();
    }
    {
        LAS float* scr = (LAS float*)(F.lds + RING_OFF + F.wave * 16384);
        constexpr int NI_HI = 2 * 16 * 128, NI_HO = 2 * 16 * 32, NI_RI = 2 * 16 * 192, NI_RO = 2 * 32 * 32, NI_W1 = 128 * 16 * 64, NI_W2 = 128 * 16 * 32;
        constexpr int NITEMS = NI_HI + NI_HO + NI_RI + NI_RO + NI_W1 + NI_W2;
        for (int it = gw; it < NITEMS; it += NGW) {
            int r = it;
            if (r < NI_HI) { const int j = r / 2048, q = r % 2048, kb = q / 128, nb = q % 128;
                p0_transpose_item(KIN(I_HWIN) + (size_t)j * DM * HG_N, HG_N, (bf16*)(F.ws + WS_HWIN) + (size_t)j * HG_N * DM, DM, 64 * kb, 32 * nb, 32 * nb, scr, F.lane); continue; } r -= NI_HI;
            if (r < NI_HO) { const int j = r / 512, q = r % 512, kb = q / 32, nb = q % 32;
                p0_transpose_item(KIN(I_HWOUT) + (size_t)j * DM * DM, DM, (bf16*)(F.ws + WS_HWOUT) + (size_t)j * DM * DM, DM, 64 * kb, 32 * nb, 32 * nb, scr, F.lane); continue; } r -= NI_HO;
            if (r < NI_RI) { const int j = r / 3072, q = r % 3072, kb = q / 192, nb = q % 192;
                p0_transpose_item(KIN(I_RWIN) + (size_t)j * DM * RT_N, RT_N, (bf16*)(F.ws + WS_RWIN) + (size_t)j * RT_N * DM, DM, 64 * kb, 32 * nb, 32 * nb, scr, F.lane); continue; } r -= NI_RI;
            if (r < NI_RO) { const int j = r / 1024, q = r % 1024, kb = q / 32, nb = q % 32;
                p0_transpose_item(KIN(I_RWOUT) + (size_t)j * 2048 * DM, DM, (bf16*)(F.ws + WS_RWOUT) + (size_t)j * DM * 2048, 2048, 64 * kb, 32 * nb, 32 * nb, scr, F.lane); continue; } r -= NI_RO;
            if (r < NI_W1) { const int mi = r / 1024, q = r % 1024, kb = q / 64, nb = q % 64; const int n0 = 32 * nb;
                const int cc = n0 & 1023, drow0 = 256 * (cc >> 7) + (cc & 127) + ((n0 >= 1024) ? 128 : 0);
                if (MOE_FP8) p0_transpose_item_f8(KIN(I_W1) + (size_t)mi * DM * 2048, 2048, F.ws + WS_W1T + (size_t)mi * 2048 * DM, DM, 64 * kb, n0, drow0, scr, F.lane, 64.0f);
                else p0_transpose_item(KIN(I_W1) + (size_t)mi * DM * 2048, 2048, (bf16*)(F.ws + WS_W1T) + (size_t)mi * 2048 * DM, DM, 64 * kb, n0, drow0, scr, F.lane);
                continue; } r -= NI_W1;
            { const int mi = r / 512, q = r % 512, kb = q / 32, nb = q % 32;
                if (MOE_FP8) p0_transpose_item_f8(KIN(I_W2) + (size_t)mi * DM * DM, DM, F.ws + WS_W2T + (size_t)mi * DM * DM, DM, 64 * kb, 32 * nb, 32 * nb, scr, F.lane, 64.0f);
                else p0_transpose_item(KIN(I_W2) + (size_t)mi * DM * DM, DM, (bf16*)(F.ws + WS_W2T) + (size_t)mi * DM * DM, DM, 64 * kb, 32 * nb, 32 * nb, scr, F.lane); }
        }
    }
}

__device__ __forceinline__ void build_tiles(Frame& F, int l) {
    LAS int* ts = (LAS int*)(F.lds + TAB_OFF); LAS int* cnt = ts + 40;
    __syncthreads();
    if (F.tid < NEXP) cnt[F.tid] = (int)ldu_vec(F.ctl + CW_CNT + l * 2048 + F.tid * 64);
    __syncthreads();
    if (F.tid == 0) { int a = 0; for (int e = 0; e < NEXP; ++e) { ts[e] = a; a += (cnt[e] + 255) >> 8; } ts[NEXP] = a; }
    __syncthreads();
}

__device__ __forceinline__ void row_phase1(Frame& F, int l, int mode) {
    relaunder(F);
    const LAS int* ts = (const LAS int*)(F.lds + TAB_OFF);
    const bool comb = (l > 0);
    if (comb) build_tiles(F, l - 1);
    const float* xsrc = comb ? F.out : KIN(I_X);
    const bf16* Y = (const bf16*)(F.ws + WS_R1);
    const unsigned* tslot = (const unsigned*)(F.ws + WS_TSLOT); const unsigned* tgate = (const unsigned*)(F.ws + WS_TGATE);
    bf16* H = (bf16*)(F.ws + WS_H);
    for (int rb = F.vcu * 256; rb < MTOK; rb += F.G * 256) {
        const int b = rb / SEQ;
        f32x4 A[4], B[4], G2[4];
#pragma unroll
        for (int j = 0; j < 4; ++j) {
            const int c = 4 * F.lane + 256 * j;
            if (mode == 0) { const float* mv = (const float*)(F.ws + WS_MOD) + (size_t)(l * NBATCH + b) * 6 * DM;
                const f32x4 g = *(const f32x4*)(KIN(I_N1G) + l * DM + c), sc = *(const f32x4*)(mv + 1 * DM + c); A[j] = g * (sc + 1.0f); B[j] = *(const f32x4*)(mv + c); }
            else { const float* fm = (const float*)(F.ws + WS_FMOD) + (size_t)b * 2 * DM;
                const f32x4 g = *(const f32x4*)(KIN(I_FG) + c), sc = *(const f32x4*)(fm + DM + c); A[j] = g * (sc + 1.0f); B[j] = *(const f32x4*)(fm + c); }
            if (comb) G2[j] = *(const f32x4*)((const float*)(F.ws + WS_MOD) + (size_t)((l - 1) * NBATCH + b) * 6 * DM + 5 * DM + c); else G2[j] = (f32x4){0.f, 0.f, 0.f, 0.f};
        }
        for (int r = 0; r < 32; ++r) {
            const int row = rb + 32 * F.wave + r;
            f32x4 v[4];
#pragma unroll
            for (int j = 0; j < 4; ++j) v[j] = *(const f32x4*)(xsrc + (size_t)row * DM + 4 * F.lane + 256 * j);
            if (comb) {
                const unsigned sl = tslot[(size_t)row * 4 + (F.lane & 3)], gt = tgate[(size_t)row * 4 + (F.lane & 3)];
                f32x4 ys[4];
#pragma unroll
                for (int j = 0; j < 4; ++j) ys[j] = (f32x4){0.f, 0.f, 0.f, 0.f};
#pragma unroll
                for (int k = 0; k < TOPK; ++k) {
                    const unsigned s = (unsigned)__shfl((int)sl, k); const float gk = __uint_as_float((unsigned)__shfl((int)gt, k));
                    const int e = (int)(s >> 20), pos = (int)(s & 0xFFFFFu); const size_t yrow = (size_t)ts[e] * 256 + pos;
#pragma unroll
                    for (int j = 0; j < 4; ++j) { const v2u w = *(const v2u*)(Y + yrow * DM + 4 * F.lane + 256 * j);
                        ys[j].x += gk * bflo(w.x); ys[j].y += gk * bfhi(w.x); ys[j].z += gk * bflo(w.y); ys[j].w += gk * bfhi(w.y); }
                }
#pragma unroll
                for (int j = 0; j < 4; ++j) v[j] = v[j] + G2[j] * ys[j];
                if (mode == 0) {
#pragma unroll
                    for (int j = 0; j < 4; ++j) *(f32x4*)(F.out + (size_t)row * DM + 4 * F.lane + 256 * j) = v[j];
                }
            }
            float s2 = 0.f;
#pragma unroll
            for (int j = 0; j < 4; ++j) s2 += (v[j].x * v[j].x + v[j].y * v[j].y) + (v[j].z * v[j].z + v[j].w * v[j].w);
            const float rstd = 1.0f / sqrtf(wave_sum(s2) * (1.0f / DM) + EPS);
            if (mode == 0) {
#pragma unroll
                for (int j = 0; j < 4; ++j) { const f32x4 h = v[j] * rstd * A[j] + B[j]; v2u w; w.x = pk2(h.x, h.y); w.y = pk2(h.z, h.w); *(v2u*)(H + (size_t)row * DM + 4 * F.lane + 256 * j) = w; }
            } else {
#pragma unroll
                for (int j = 0; j < 4; ++j) *(f32x4*)(F.out + (size_t)row * DM + 4 * F.lane + 256 * j) = v[j] * rstd * A[j] + B[j];
            }
        }
    }
}

__device__ __forceinline__ void row_phase2(Frame& F, int l) {
    relaunder(F);
    bf16* H = (bf16*)(F.ws + WS_H);
    LAS unsigned char* frag = F.lds + RING_OFF;
    LAS float* lg = (LAS float*)(F.lds + 131072 + F.wave * 2112);
    LAS int* cntL = (LAS int*)(F.lds + 147968); LAS int* baseL = cntL + 32; LAS float* rbias = (LAS float*)(cntL + 64);
    unsigned* list = (unsigned*)(F.ws + WS_LIST); unsigned* tslot = (unsigned*)(F.ws + WS_TSLOT); float* tgate = (float*)(F.ws + WS_TGATE);
    __syncthreads();
    { const float* rw = KIN(I_RTW) + (size_t)l * DM * NEXP;
      for (int it = F.tid; it < 32 * 2 * 64; it += NWAVES * 64) { const int ln = it & 63, nt = (it >> 6) & 1, s = it >> 7; const int e = 16 * nt + (ln & 15), k0 = 32 * s + 8 * (ln >> 4);
          float w[8], hi[8];
#pragma unroll
          for (int j = 0; j < 8; ++j) { w[j] = rw[(size_t)(k0 + j) * NEXP + e]; }
          v4u ph, pl;
          { unsigned a = pk2(w[0], w[1]), b2 = pk2(w[2], w[3]), c2 = pk2(w[4], w[5]), d2 = pk2(w[6], w[7]); ph = (v4u){a, b2, c2, d2};
            hi[0] = bflo(a); hi[1] = bfhi(a); hi[2] = bflo(b2); hi[3] = bfhi(b2); hi[4] = bflo(c2); hi[5] = bfhi(c2); hi[6] = bflo(d2); hi[7] = bfhi(d2); }
          pl = (v4u){pk2(w[0] - hi[0], w[1] - hi[1]), pk2(w[2] - hi[2], w[3] - hi[3]), pk2(w[4] - hi[4], w[5] - hi[5]), pk2(w[6] - hi[6], w[7] - hi[7])};
          *(LAS v4u*)(frag + ((s * 2 + nt) * 2 + 0) * 1024 + ln * 16) = ph; *(LAS v4u*)(frag + ((s * 2 + nt) * 2 + 1) * 1024 + ln * 16) = pl; }
      if (F.tid < NEXP) rbias[F.tid] = KIN(I_RTB)[l * NEXP + F.tid];
    }
    for (int rb = F.vcu * 256; rb < MTOK; rb += F.G * 256) {
        const int b = rb / SEQ;
        if (F.tid < NEXP) cntL[F.tid] = 0;
        __syncthreads();
        {
            f32x4 A[4], B[4];
            const float* mv = (const float*)(F.ws + WS_MOD) + (size_t)(l * NBATCH + b) * 6 * DM;
#pragma unroll
            for (int j = 0; j < 4; ++j) { const int c = 4 * F.lane + 256 * j; const f32x4 g = *(const f32x4*)(KIN(I_N2G) + l * DM + c), sc = *(const f32x4*)(mv + 4 * DM + c); A[j] = g * (sc + 1.0f); B[j] = *(const f32x4*)(mv + 3 * DM + c); }
            for (int r = 0; r < 32; ++r) {
                const int row = rb + 32 * F.wave + r;
                f32x4 v[4]; float s2 = 0.f;
#pragma unroll
                for (int j = 0; j < 4; ++j) { v[j] = *(const f32x4*)(F.out + (size_t)row * DM + 4 * F.lane + 256 * j); s2 += (v[j].x * v[j].x + v[j].y * v[j].y) + (v[j].z * v[j].z + v[j].w * v[j].w); }
                const float rstd = 1.0f / sqrtf(wave_sum(s2) * (1.0f / DM) + EPS);
#pragma unroll
                for (int j = 0; j < 4; ++j) { const f32x4 h = v[j] * rstd * A[j] + B[j]; v2u w; w.x = pk2(h.x, h.y); w.y = pk2(h.z, h.w); *(v2u*)(H + (size_t)row * DM + 4 * F.lane + 256 * j) = w;
                    if (MOE_FP8) *(unsigned*)(F.ws + WS_H8 + (size_t)row * DM + 4 * F.lane + 256 * j) = pk4_fp8(h.x * 8.0f, h.y * 8.0f, h.z * 8.0f, h.w * 8.0f); }
            }
        }
        VM_WAIT();
        int my_e[2][TOPK], my_lp[2][TOPK]; float my_g[2][TOPK];
#pragma unroll
        for (int grp = 0; grp < 2; ++grp) {
            const int row0 = rb + 32 * F.wave + 16 * grp;
            f32x4 acc0 = (f32x4){0.f, 0.f, 0.f, 0.f}, acc1 = (f32x4){0.f, 0.f, 0.f, 0.f};
            const unsigned long long* ap = (const unsigned long long*)(H + (size_t)(row0 + (F.lane & 15)) * DM + 8 * (F.lane >> 4));
#pragma unroll 4
            for (int s = 0; s < 32; ++s) {
                const unsigned long long lo = __hip_atomic_load(ap + 8 * s, RLX_AGENT), hi = __hip_atomic_load(ap + 8 * s + 1, RLX_AGENT);
                v4u av = (v4u){(unsigned)lo, (unsigned)(lo >> 32), (unsigned)hi, (unsigned)(hi >> 32)}; const bf16x8 a = __builtin_bit_cast(bf16x8, av);
                const bf16x8 b00 = *(const LAS bf16x8*)(frag + ((s * 2 + 0) * 2 + 0) * 1024 + F.lane * 16), b01 = *(const LAS bf16x8*)(frag + ((s * 2 + 0) * 2 + 1) * 1024 + F.lane * 16);
                const bf16x8 b10 = *(const LAS bf16x8*)(frag + ((s * 2 + 1) * 2 + 0) * 1024 + F.lane * 16), b11 = *(const LAS bf16x8*)(frag + ((s * 2 + 1) * 2 + 1) * 1024 + F.lane * 16);
                acc0 = __builtin_amdgcn_mfma_f32_16x16x32_bf16(a, b00, acc0, 0, 0, 0); acc0 = __builtin_amdgcn_mfma_f32_16x16x32_bf16(a, b01, acc0, 0, 0, 0);
                acc1 = __builtin_amdgcn_mfma_f32_16x16x32_bf16(a, b10, acc1, 0, 0, 0); acc1 = __builtin_amdgcn_mfma_f32_16x16x32_bf16(a, b11, acc1, 0, 0, 0);
            }
#pragma unroll
            for (int q = 0; q < 4; ++q) { lg[(4 * (F.lane >> 4) + q) * 33 + (F.lane & 15)] = acc0[q]; lg[(4 * (F.lane >> 4) + q) * 33 + 16 + (F.lane & 15)] = acc1[q]; }
            LDS_WAIT(); asm volatile("" ::: "memory");
            if (F.lane < 16) {
                unsigned taken = 0u; float tl[TOPK];
#pragma unroll
                for (int k = 0; k < TOPK; ++k) {
                    float best = -3.0e38f; int bi = 0;
                    for (int e = 0; e < NEXP; ++e) { const float v = lg[F.lane * 33 + e] + rbias[e]; if (!((taken >> e) & 1u) && v > best) { best = v; bi = e; } }
                    taken |= 1u << bi; my_e[grp][k] = bi; tl[k] = best;
                }
                float den = 0.f, ex[TOPK];
#pragma unroll
                for (int k = 0; k < TOPK; ++k) { ex[k] = __expf(tl[k] - tl[0]); den += ex[k]; }
#pragma unroll
                for (int k = 0; k < TOPK; ++k) { my_g[grp][k] = ex[k] / den; my_lp[grp][k] = __hip_atomic_fetch_add(&cntL[my_e[grp][k]], 1, __ATOMIC_RELAXED, __HIP_MEMORY_SCOPE_WORKGROUP); }
            } else {
#pragma unroll
                for (int k = 0; k < TOPK; ++k) { my_e[grp][k] = 0; my_lp[grp][k] = 0; my_g[grp][k] = 0.f; }
            }
            LDS_WAIT(); asm volatile("" ::: "memory");
        }
        __syncthreads();
        if (F.tid < NEXP) baseL[F.tid] = (int)__hip_atomic_fetch_add(F.ctl + CW_CNT + l * 2048 + F.tid * 64, (unsigned)cntL[F.tid], RLX_AGENT);
        __syncthreads();
        if (F.lane < 16) {
#pragma unroll
            for (int grp = 0; grp < 2; ++grp) {
                const int row = rb + 32 * F.wave + 16 * grp + F.lane;
#pragma unroll
                for (int k = 0; k < TOPK; ++k) { const int e = my_e[grp][k], pos = baseL[e] + my_lp[grp][k];
                    list[(size_t)e * LCAP + pos] = (unsigned)row; tslot[(size_t)row * 4 + k] = ((unsigned)e << 20) | (unsigned)pos; tgate[(size_t)row * 4 + k] = my_g[grp][k]; }
            }
        }
        __syncthreads();
    }
}

__device__ __forceinline__ void moe_gather(Frame& F, int l) {
    relaunder(F);
    build_tiles(F, l);
    const LAS int* ts = (const LAS int*)(F.lds + TAB_OFF); const LAS int* cnt = ts + 40;
    const unsigned* list = (const unsigned*)(F.ws + WS_LIST); const bf16* H = (const bf16*)(F.ws + WS_H); bf16* Xg = (bf16*)(F.ws + WS_R1);
    const int gw = F.vcu * NWAVES + F.wave, NGW = F.G * NWAVES, NR = ts[NEXP] * 256;
    for (int r = gw; r < NR; r += NGW) {
        const int mt = r >> 8; int e = 0;
        for (int k = 1; k < NEXP; ++k) e += (ts[k] <= mt) ? 1 : 0;
        const int pos = r - ts[e] * 256;
        unsigned tok = 0u; if (pos < cnt[e]) tok = ldu_vec(list + (size_t)e * LCAP + pos);
        const v4u* src = (const v4u*)(H + (size_t)tok * DM); v4u* dst = (v4u*)(Xg + (size_t)r * DM);
        dst[F.lane] = src[F.lane]; dst[F.lane + 64] = src[F.lane + 64];
    }
}

__device__ __forceinline__ void moe_build_tt(Frame& F, int nN) {
    const LAS int* ts = (const LAS int*)(F.lds + TAB_OFF); const LAS int* cnt = ts + 40;
    LAS unsigned short* tt = (LAS unsigned short*)(F.lds + 131072);
    const unsigned* list = (const unsigned*)(F.ws + WS_LIST); const long NU = (long)ts[NEXP] * nN;
    for (int j = 0; j < 17; ++j) { const int i = 2 * j + (F.tid >> 8), r = F.tid & 255; const long L = (long)i * F.G + F.vcu;
        if (L < NU) { const int mt = (int)(L / nN); int e = 0;
            for (int k = 1; k < NEXP; ++k) e += (ts[k] <= mt) ? 1 : 0;
            const int pos = (mt - ts[e]) * 256 + r; unsigned tok = 0u; if (pos < cnt[e]) tok = list[(size_t)e * LCAP + pos];
            tt[i * 256 + r] = (unsigned short)tok; } }
    __syncthreads();
}

using pg8::Unit;
__device__ __forceinline__ v4u pack8(const f32x4 a, const f32x4 b) { v4u w; w.x = pk2(a.x, a.y); w.y = pk2(a.z, a.w); w.z = pk2(b.x, b.y); w.w = pk2(b.z, b.w); return w; }

struct EpiHgrnIn {
    static constexpr bool PERM = true; static constexpr int NST = 16;
    unsigned char* r1; const float* lb;
    __device__ __forceinline__ void operator()(const f32x4 (&acc)[2][2][4][2], const Unit& u, int wr, int wc, int fr, int fq) const {
        const int seg = u.pn >> 2, row0 = u.pm * 256 + wr * 64 + fr, cs0 = (u.pn & 3) * 256 + wc * 32 + 8 * fq;
        if (seg == 1) {
            bf16* K = (bf16*)(r1 + 128 * MiB); float* LF = (float*)(r1 + 512 * MiB);
#pragma unroll
            for (int bj = 0; bj < 2; ++bj) {
                f32x4 lbv[2]; lbv[0] = *(const f32x4*)(lb + cs0 + bj * 128); lbv[1] = *(const f32x4*)(lb + cs0 + bj * 128 + 4);
#pragma unroll
                for (int ai = 0; ai < 2; ++ai)
#pragma unroll
                    for (int m = 0; m < 4; ++m) { const size_t ro = (size_t)(row0 + ai * 128 + m * 16) * DM + cs0 + bj * 128; f32x4 kk[2], lf[2];
#pragma unroll
                        for (int n = 0; n < 2; ++n)
#pragma unroll
                            for (int j = 0; j < 4; ++j) { const float f = fminf(fmaxf(acc[ai][bj][m][n][j], -60.f), 60.f), l0 = lbv[n][j], ef = __expf(f);
                                const float sg = ef * __builtin_amdgcn_rcpf(1.f + ef), sgm = __builtin_amdgcn_rcpf(1.f + ef);
                                lf[n][j] = __logf(l0 + (1.f - l0) * sg); kk[n][j] = (1.f - l0) * sgm; }
                        *(v4u*)(K + ro) = pack8(kk[0], kk[1]); *(f32x4*)(LF + ro) = lf[0]; *(f32x4*)(LF + ro + 4) = lf[1];
                        __builtin_amdgcn_sched_barrier(0); }
            }
        } else {
            bf16* dst = (bf16*)(r1 + (seg == 0 ? 0 : (seg == 2 ? 256 * MiB : 384 * MiB))); const bool act = (seg != 2);
#pragma unroll
            for (int ai = 0; ai < 2; ++ai)
#pragma unroll
                for (int m = 0; m < 4; ++m) { const size_t ro = (size_t)(row0 + ai * 128 + m * 16) * DM;
#pragma unroll
                    for (int bj = 0; bj < 2; ++bj) { f32x4 v0 = acc[ai][bj][m][0], v1 = acc[ai][bj][m][1];
                        if (act) {
#pragma unroll
                            for (int j = 0; j < 4; ++j) { v0[j] = siluf_(v0[j]); v1[j] = siluf_(v1[j]); } }
                        *(v4u*)(dst + ro + cs0 + bj * 128) = pack8(v0, v1); }
                    __builtin_amdgcn_sched_barrier(0); }
        }
    }
};

struct EpiRetIn {
    static constexpr bool PERM = true; static constexpr int NST = 16;
    unsigned char* r1; const int* positions;
    __device__ __forceinline__ void operator()(const f32x4 (&acc)[2][2][4][2], const Unit& u, int wr, int wc, int fr, int fq) const {
        const int row0 = u.pm * 256 + wr * 64 + fr, cl = wc * 32 + 8 * fq;
        if (u.pn < 8) {
            bf16* dst = (bf16*)(r1 + ((u.pn < 4) ? 0 : 128 * MiB)); const float sc = (u.pn < 4) ? 1.0f : 0.0625f; const int hh = u.pn & 3;
            float invrev[2][4];
#pragma unroll
            for (int n = 0; n < 2; ++n)
#pragma unroll
                for (int j = 0; j < 4; ++j) invrev[n][j] = exp2f(-(float)(cl + 4 * n + j) * 0.10462765653188542f) * 0.15915494309189535f;
#pragma unroll
            for (int ai = 0; ai < 2; ++ai)
#pragma unroll
                for (int m = 0; m < 4; ++m) { const int row = row0 + ai * 128 + m * 16; const float pos = (float)positions[row]; const size_t ro = (size_t)row * DM + hh * 256 + cl;
                    f32x4 o1[2], o2[2];
#pragma unroll
                    for (int n = 0; n < 2; ++n)
#pragma unroll
                        for (int j = 0; j < 4; ++j) { const float rev = pos * invrev[n][j], fr_ = rev - floorf(rev); const float cs = __builtin_amdgcn_cosf(fr_), sn = __builtin_amdgcn_sinf(fr_);
                            const float x1 = acc[ai][0][m][n][j], x2 = acc[ai][1][m][n][j]; o1[n][j] = (x1 * cs - x2 * sn) * sc; o2[n][j] = (x2 * cs + x1 * sn) * sc; }
                    *(v4u*)(dst + ro) = pack8(o1[0], o1[1]); *(v4u*)(dst + ro + 128) = pack8(o2[0], o2[1]); }
        } else {
            const bool isg = (u.pn >= 16); bf16* dst = (bf16*)(r1 + (isg ? 512 * MiB : 256 * MiB)); const int ct = (isg ? u.pn - 16 : u.pn - 8) * 256 + cl;
#pragma unroll
            for (int ai = 0; ai < 2; ++ai)
#pragma unroll
                for (int m = 0; m < 4; ++m) { const size_t ro = (size_t)(row0 + ai * 128 + m * 16) * 2048 + ct;
#pragma unroll
                    for (int bj = 0; bj < 2; ++bj) { f32x4 v0 = acc[ai][bj][m][0], v1 = acc[ai][bj][m][1];
                        if (isg) {
#pragma unroll
                            for (int j = 0; j < 4; ++j) { v0[j] = siluf_(v0[j]); v1[j] = siluf_(v1[j]); } }
                        *(v4u*)(dst + ro + bj * 128) = pack8(v0, v1); } }
        }
    }
};

struct EpiOut {
    static constexpr bool PERM = false; static constexpr int NST = 8;
    const float* xin; float* xout; const float* gate;
    __device__ __forceinline__ void operator()(const f32x4 (&acc)[2][2][4][2], const Unit& u, int wr, int wc, int fr, int fq) const {
        const int row0 = u.pm * 256 + wr * 64 + fr, col0 = u.pn * 256 + wc * 32 + 4 * fq, b = (u.pm * 256) / SEQ;
        f32x4 gv[2][2];
#pragma unroll
        for (int bj = 0; bj < 2; ++bj)
#pragma unroll
            for (int n = 0; n < 2; ++n) gv[bj][n] = *(const f32x4*)(gate + (size_t)b * 6 * DM + col0 + bj * 128 + n * 16);
#pragma unroll
        for (int ai = 0; ai < 2; ++ai)
#pragma unroll
            for (int mp = 0; mp < 2; ++mp) { f32x4 xi[2][2][2];
#pragma unroll
                for (int mm = 0; mm < 2; ++mm)
#pragma unroll
                    for (int bj = 0; bj < 2; ++bj)
#pragma unroll
                        for (int n = 0; n < 2; ++n) xi[mm][bj][n] = *(const f32x4*)(xin + (size_t)(row0 + ai * 128 + (2 * mp + mm) * 16) * DM + col0 + bj * 128 + n * 16);
#pragma unroll
                for (int mm = 0; mm < 2; ++mm)
#pragma unroll
                    for (int bj = 0; bj < 2; ++bj)
#pragma unroll
                        for (int n = 0; n < 2; ++n) *(f32x4*)(xout + (size_t)(row0 + ai * 128 + (2 * mp + mm) * 16) * DM + col0 + bj * 128 + n * 16) = xi[mm][bj][n] + gv[bj][n] * acc[ai][bj][2 * mp + mm][n];
                asm volatile("" ::: "memory"); }
    }
};

struct EpiMoe1F8 {
    static constexpr bool PERM = true; static constexpr int NST = 8;
    unsigned char* A2; const float* b1;
    __device__ __forceinline__ void operator()(const f32x4 (&acc)[2][2][4][2], const Unit& u, int wr, int wc, int fr, int fq) const {
        const int row0 = u.pm * 256 + wr * 64 + fr, gc = u.nn * 128 + wc * 32 + 8 * fq; const float* bp = b1 + (size_t)u.e * 2048;
        f32x4 bg[2], bl[2];
#pragma unroll
        for (int n = 0; n < 2; ++n) { bg[n] = *(const f32x4*)(bp + gc + 4 * n); bl[n] = *(const f32x4*)(bp + 1024 + gc + 4 * n); }
#pragma unroll
        for (int ai = 0; ai < 2; ++ai)
#pragma unroll
            for (int m = 0; m < 4; ++m) { f32x4 o[2];
#pragma unroll
                for (int n = 0; n < 2; ++n)
#pragma unroll
                    for (int j = 0; j < 4; ++j) { const float g = fminf(acc[ai][0][m][n][j] * (1.0f / 512.f) + bg[n][j], 7.0f), li = fminf(fmaxf(acc[ai][1][m][n][j] * (1.0f / 512.f) + bl[n][j], -7.0f), 7.0f);
                        o[n][j] = g * sigmoidf_(1.702f * g) * (li + 1.0f) * 4.0f; }
                v2u w; w.x = pk4_fp8(o[0].x, o[0].y, o[0].z, o[0].w); w.y = pk4_fp8(o[1].x, o[1].y, o[1].z, o[1].w);
                *(v2u*)(A2 + (size_t)(row0 + ai * 128 + m * 16) * DM + gc) = w; }
    }
};
struct EpiMoe1 {
    static constexpr bool PERM = true; static constexpr int NST = 8;
    bf16* A2; const float* b1;
    __device__ __forceinline__ void operator()(const f32x4 (&acc)[2][2][4][2], const Unit& u, int wr, int wc, int fr, int fq) const {
        const int row0 = u.pm * 256 + wr * 64 + fr, gc = u.nn * 128 + wc * 32 + 8 * fq; const float* bp = b1 + (size_t)u.e * 2048;
        f32x4 bg[2], bl[2];
#pragma unroll
        for (int n = 0; n < 2; ++n) { bg[n] = *(const f32x4*)(bp + gc + 4 * n); bl[n] = *(const f32x4*)(bp + 1024 + gc + 4 * n); }
#pragma unroll
        for (int ai = 0; ai < 2; ++ai)
#pragma unroll
            for (int m = 0; m < 4; ++m) { f32x4 o[2];
#pragma unroll
                for (int n = 0; n < 2; ++n)
#pragma unroll
                    for (int j = 0; j < 4; ++j) { const float g = fminf(acc[ai][0][m][n][j] + bg[n][j], 7.0f), li = fminf(fmaxf(acc[ai][1][m][n][j] + bl[n][j], -7.0f), 7.0f);
                        o[n][j] = g * sigmoidf_(1.702f * g) * (li + 1.0f); }
                *(v4u*)(A2 + (size_t)(row0 + ai * 128 + m * 16) * DM + gc) = pack8(o[0], o[1]); }
    }
};

struct EpiMoe2 {
    static constexpr bool PERM = true; static constexpr int NST = 16;
    bf16* Y; const float* b2; float sc;
    __device__ __forceinline__ void operator()(const f32x4 (&acc)[2][2][4][2], const Unit& u, int wr, int wc, int fr, int fq) const {
        const int row0 = u.pm * 256 + wr * 64 + fr, c0 = u.nn * 256 + wc * 32 + 8 * fq; const float* bp = b2 + (size_t)u.e * DM;
        f32x4 bv[2][2];
#pragma unroll
        for (int bj = 0; bj < 2; ++bj)
#pragma unroll
            for (int n = 0; n < 2; ++n) bv[bj][n] = *(const f32x4*)(bp + c0 + bj * 128 + 4 * n);
#pragma unroll
        for (int ai = 0; ai < 2; ++ai)
#pragma unroll
            for (int m = 0; m < 4; ++m) { const size_t ro = (size_t)(row0 + ai * 128 + m * 16) * DM + c0;
#pragma unroll
                for (int bj = 0; bj < 2; ++bj) *(v4u*)(Y + ro + bj * 128) = pack8(acc[ai][bj][m][0] * sc + bv[bj][0], acc[ai][bj][m][1] * sc + bv[bj][1]); }
    }
};

__device__ __forceinline__ void hgrn_scan(Frame& F, int j) {
    relaunder(F);
    const bf16* Q = (const bf16*)(F.ws + WS_R1); const bf16* K = (const bf16*)(F.ws + WS_R1 + 128 * MiB); const bf16* V = (const bf16*)(F.ws + WS_R1 + 256 * MiB); const bf16* SG = (const bf16*)(F.ws + WS_R1 + 384 * MiB);
    const float* LF = (const float*)(F.ws + WS_R1 + 512 * MiB); bf16* O = (bf16*)(F.ws + WS_R2);
    LAS float* Qs = (LAS float*)(F.lds); LAS float* Ks = Qs + 4096; LAS float* Fs = Qs + 8192; LAS float* Vs = Qs + 12288; LAS float* P = Qs + 16384;
    const int v = F.tid & 127, kq = F.tid >> 7, t16 = F.tid >> 4, c8 = (F.tid & 15) * 8;
    f32x4 gain0 = *(const f32x4*)(KIN(I_HGAIN) + j * 128 + c8), gain1 = *(const f32x4*)(KIN(I_HGAIN) + j * 128 + c8 + 4);
    for (int u = F.vcu; u < NBATCH * HG_H; u += F.G) {
        const int b = u / HG_H, h = u % HG_H;
        float S[32];
#pragma unroll
        for (int i = 0; i < 32; ++i) S[i] = 0.f;
        for (int ch = 0; ch < SEQ / 32; ++ch) {
            const int row0 = b * SEQ + 32 * ch; const size_t gi = (size_t)(row0 + t16) * DM + h * 128 + c8;
            __syncthreads();
            { const v4u q = *(const v4u*)(Q + gi), k = *(const v4u*)(K + gi), vv = *(const v4u*)(V + gi); const f32x4 l0 = *(const f32x4*)(LF + gi), l1 = *(const f32x4*)(LF + gi + 4);
              LAS f32x4* d;
              d = (LAS f32x4*)(Qs + t16 * 128 + c8); d[0] = (f32x4){bflo(q.x), bfhi(q.x), bflo(q.y), bfhi(q.y)}; d[1] = (f32x4){bflo(q.z), bfhi(q.z), bflo(q.w), bfhi(q.w)};
              d = (LAS f32x4*)(Ks + t16 * 128 + c8); d[0] = (f32x4){bflo(k.x), bfhi(k.x), bflo(k.y), bfhi(k.y)}; d[1] = (f32x4){bflo(k.z), bfhi(k.z), bflo(k.w), bfhi(k.w)};
              d = (LAS f32x4*)(Vs + t16 * 128 + c8); d[0] = (f32x4){bflo(vv.x), bfhi(vv.x), bflo(vv.y), bfhi(vv.y)}; d[1] = (f32x4){bflo(vv.z), bfhi(vv.z), bflo(vv.w), bfhi(vv.w)};
              d = (LAS f32x4*)(Fs + t16 * 128 + c8); d[0] = (f32x4){__expf(l0.x), __expf(l0.y), __expf(l0.z), __expf(l0.w)}; d[1] = (f32x4){__expf(l1.x), __expf(l1.y), __expf(l1.z), __expf(l1.w)}; }
            __syncthreads();
            for (int t = 0; t < 32; ++t) {
                const float vt = Vs[t * 128 + v]; float a = 0.f;
#pragma unroll
                for (int i4 = 0; i4 < 8; ++i4) { const f32x4 f4 = *(const LAS f32x4*)(Fs + t * 128 + 32 * kq + 4 * i4), k4 = *(const LAS f32x4*)(Ks + t * 128 + 32 * kq + 4 * i4), q4 = *(const LAS f32x4*)(Qs + t * 128 + 32 * kq + 4 * i4);
#pragma unroll
                    for (int i = 0; i < 4; ++i) { S[4 * i4 + i] = f4[i] * S[4 * i4 + i] + k4[i] * vt; a += q4[i] * S[4 * i4 + i]; } }
                P[(t * 4 + kq) * 128 + v] = a;
            }
            __syncthreads();
            { f32x4 o0 = (f32x4){0.f, 0.f, 0.f, 0.f}, o1 = o0;
#pragma unroll
              for (int q = 0; q < 4; ++q) { o0 += *(const LAS f32x4*)(P + (t16 * 4 + q) * 128 + c8); o1 += *(const LAS f32x4*)(P + (t16 * 4 + q) * 128 + c8 + 4); }
              float ss = (o0.x * o0.x + o0.y * o0.y) + (o0.z * o0.z + o0.w * o0.w) + (o1.x * o1.x + o1.y * o1.y) + (o1.z * o1.z + o1.w * o1.w);
              ss += __shfl_xor(ss, 1); ss += __shfl_xor(ss, 2); ss += __shfl_xor(ss, 4); ss += __shfl_xor(ss, 8);
              const float r = 1.0f / sqrtf(ss * (1.0f / 128.f) + EPS);
              const v4u sg = *(const v4u*)(SG + gi);
              f32x4 a0 = o0 * r * gain0, a1 = o1 * r * gain1;
              a0.x *= bflo(sg.x); a0.y *= bfhi(sg.x); a0.z *= bflo(sg.y); a0.w *= bfhi(sg.y); a1.x *= bflo(sg.z); a1.y *= bfhi(sg.z); a1.z *= bflo(sg.w); a1.w *= bfhi(sg.w);
              *(v4u*)(O + gi) = pack8(a0, a1); }
        }
    }
}

__device__ __forceinline__ void ret_scan(Frame& F) {
    relaunder(F);
    const bf16* Q = (const bf16*)(F.ws + WS_R1); const bf16* K = (const bf16*)(F.ws + WS_R1 + 128 * MiB); const bf16* V = (const bf16*)(F.ws + WS_R1 + 256 * MiB); const bf16* SG = (const bf16*)(F.ws + WS_R1 + 512 * MiB);
    bf16* O = (bf16*)(F.ws + WS_R2);
    LAS bf16* Qs = (LAS bf16*)(F.lds); LAS bf16* Ks = (LAS bf16*)(F.lds + 33792); LAS bf16* Vs = (LAS bf16*)(F.lds + 67584);
    LAS float* St = (LAS float*)(F.lds + 133120); LAS float* wred = (LAS float*)(F.lds + 149504); LAS float* rtab = (LAS float*)(F.lds + 151552);
    for (int u = F.vcu; u < NBATCH * RT_H * 16; u += F.G) {
        const int bh = u >> 4, cp = u & 15, b = bh >> 2, h = bh & 3;
        const float lg2g = log2f(1.0f - exp2f(-5.0f - (float)h));
        for (int half = 0; half < 2; ++half) {
            const int c = half ? 31 - cp : cp; const int row0 = b * SEQ + 64 * c;
            __syncthreads();
#pragma unroll
            for (int i = 0; i < 4; ++i) { const int p = F.tid + 512 * i, r = p >> 5, cc = (p & 31) * 8; *(LAS v4u*)(Qs + r * 264 + cc) = *(const v4u*)(Q + (size_t)(row0 + r) * DM + h * 256 + cc); }
            float acc[64];
#pragma unroll
            for (int n = 0; n < 64; ++n) acc[n] = 0.f;
            for (int cq = 0; cq <= c; ++cq) {
                const int krow0 = b * SEQ + 64 * cq;
                __syncthreads();
#pragma unroll
                for (int i = 0; i < 4; ++i) { const int p = F.tid + 512 * i, r = p >> 5, cc = (p & 31) * 8; *(LAS v4u*)(Ks + r * 264 + cc) = *(const v4u*)(K + (size_t)(krow0 + r) * DM + h * 256 + cc); }
#pragma unroll
                for (int i = 0; i < 8; ++i) { const int p = F.tid + 512 * i, r = p >> 6, cc = (p & 63) * 8; *(LAS v4u*)(Vs + r * 512 + cc) = *(const v4u*)(V + (size_t)(krow0 + r) * 2048 + h * 512 + cc); }
                __syncthreads();
                { float s[8];
#pragma unroll
                  for (int j8 = 0; j8 < 8; ++j8) s[j8] = 0.f;
                  for (int dc = 0; dc < 32; ++dc) {
                      const v4u kv = *(const LAS v4u*)(Ks + F.lane * 264 + dc * 8);
                      const float k0 = bflo(kv.x), k1 = bfhi(kv.x), k2 = bflo(kv.y), k3 = bfhi(kv.y), k4 = bflo(kv.z), k5 = bfhi(kv.z), k6 = bflo(kv.w), k7 = bfhi(kv.w);
#pragma unroll
                      for (int j8 = 0; j8 < 8; ++j8) { const v4u qv = *(const LAS v4u*)(Qs + (8 * F.wave + j8) * 264 + dc * 8);
                          s[j8] += (bflo(qv.x) * k0 + bfhi(qv.x) * k1) + (bflo(qv.y) * k2 + bfhi(qv.y) * k3) + (bflo(qv.z) * k4 + bfhi(qv.z) * k5) + (bflo(qv.w) * k6 + bfhi(qv.w) * k7); }
                  }
                  f32x4 w0, w1;
#pragma unroll
                  for (int j8 = 0; j8 < 8; ++j8) { const float dist = fabsf((float)((64 * c + 8 * F.wave + j8) - (64 * cq + F.lane))); const float val = s[j8] * exp2f(dist * lg2g); if (j8 < 4) w0[j8] = val; else w1[j8 - 4] = val; }
                  *(LAS f32x4*)(St + F.lane * 64 + 8 * F.wave) = w0; *(LAS f32x4*)(St + F.lane * 64 + 8 * F.wave + 4) = w1; }
                __syncthreads();
                for (int m2 = 0; m2 < 64; ++m2) {
                    const float vv = bf2f(Vs[m2 * 512 + F.tid]);
#pragma unroll
                    for (int n4 = 0; n4 < 16; ++n4) { const f32x4 sv = *(const LAS f32x4*)(St + m2 * 64 + 4 * n4); acc[4 * n4 + 0] += sv.x * vv; acc[4 * n4 + 1] += sv.y * vv; acc[4 * n4 + 2] += sv.z * vv; acc[4 * n4 + 3] += sv.w * vv; }
                }
            }
#pragma unroll
            for (int n = 0; n < 64; ++n) { const float p = wave_sum(acc[n] * acc[n]); if (F.lane == 0) wred[F.wave * 64 + n] = p; }
            __syncthreads();
            if (F.tid < 64) { float s = 0.f;
#pragma unroll
                for (int w = 0; w < 8; ++w) s += wred[w * 64 + F.tid];
                rtab[F.tid] = 1.0f / sqrtf(s * (1.0f / 512.f) + EPS); }
            __syncthreads();
#pragma unroll
            for (int n = 0; n < 64; ++n) { const size_t gi = (size_t)(row0 + n) * 2048 + h * 512 + F.tid; const float sg = bf2f(SG[gi]); O[gi] = (bf16)(pk2(acc[n] * rtab[n] * sg, 0.f) & 0xffffu); }
        }
    }
}

typedef short s16x4 __attribute__((ext_vector_type(4)));
__device__ __forceinline__ unsigned off_b(unsigned row, unsigned ch) { return 256u * row + 16u * (ch ^ (((row & 3u) << 2) | ((row >> 2) & 3u))); }
__device__ __forceinline__ bf16x8 row_frag(const LAS unsigned char* tile, unsigned row, unsigned s4, unsigned g) { return *(const LAS bf16x8*)(tile + off_b(row, 4u * s4 + g)); }
__device__ __forceinline__ bf16x8 tr_frag16(const LAS unsigned char* tile, unsigned lane, unsigned c, unsigned ks) {
    const unsigned g = lane >> 4, q = (lane & 15u) >> 2, p = lane & 3u;
    const unsigned a0 = off_b(32u * ks + 8u * g + q, 2u * c + (p >> 1)) + 8u * (p & 1u), a1 = off_b(32u * ks + 8u * g + 4u + q, 2u * c + (p >> 1)) + 8u * (p & 1u);
    const s16x4 lo = __builtin_amdgcn_ds_read_tr16_b64_v4i16((LAS s16x4*)(tile + a0)), hi = __builtin_amdgcn_ds_read_tr16_b64_v4i16((LAS s16x4*)(tile + a1));
    return (bf16x8){lo[0], lo[1], lo[2], lo[3], hi[0], hi[1], hi[2], hi[3]};
}
#define RSB() __builtin_amdgcn_sched_barrier(0)
constexpr unsigned RQS = 528, RVS = 272;
template <unsigned RS> __device__ __forceinline__ bf16x8 tr_lin(const LAS unsigned char* img, unsigned trb, int c, int ks) {
    const s16x4 lo = __builtin_amdgcn_ds_read_tr16_b64_v4i16((LAS s16x4*)(img + trb + (32 * ks) * RS + 32 * c)), hi = __builtin_amdgcn_ds_read_tr16_b64_v4i16((LAS s16x4*)(img + trb + (32 * ks + 4) * RS + 32 * c));
    return (bf16x8){lo[0], lo[1], lo[2], lo[3], hi[0], hi[1], hi[2], hi[3]};
}
__device__ __forceinline__ void ret_scan_mfma(Frame& F) {
    relaunder(F);
    const bf16* Q = (const bf16*)(F.ws + WS_R1); const bf16* K = (const bf16*)(F.ws + WS_R1 + 128 * MiB); const bf16* V = (const bf16*)(F.ws + WS_R1 + 256 * MiB);
    bf16* O = (bf16*)(F.ws + WS_R2); float* SS = (float*)(F.ws + WS_R2 + 256 * MiB);
    LAS unsigned char* Qi = F.lds; LAS unsigned char* Ki = F.lds + 33792; LAS unsigned char* Vi = F.lds + 67584; LAS unsigned char* Si = F.lds + 84992; LAS float* OT = (LAS float*)(F.lds + 94208);
    const unsigned w = (unsigned)F.wave;
    for (int u = F.vcu; u < NBATCH * RT_H * 4; u += F.G) {
        const int bh = u >> 2, vs = u & 3, b = bh >> 2, h = bh & 3;
        const float lg2g = log2f(1.0f - exp2f(-5.0f - (float)h)), cd = exp2f(64.0f * lg2g);
        f32x4 R[16];
#pragma unroll
        for (int i = 0; i < 16; ++i) R[i] = (f32x4){0.f, 0.f, 0.f, 0.f};
        v4u pq[4], pk[4], pv[2];
        { const int row0 = b * SEQ;
#pragma unroll
          for (int i = 0; i < 4; ++i) { const int p = F.tid + 512 * i, r = p >> 5, c32 = p & 31; pq[i] = *(const v4u*)(Q + (size_t)(row0 + r) * DM + h * 256 + c32 * 8); pk[i] = *(const v4u*)(K + (size_t)(row0 + r) * DM + h * 256 + c32 * 8); }
#pragma unroll
          for (int i = 0; i < 2; ++i) { const int p = F.tid + 512 * i, r = p >> 4, c16 = p & 15; pv[i] = *(const v4u*)(V + (size_t)(row0 + r) * 2048 + h * 512 + vs * 128 + c16 * 8); } }
        __syncthreads();
        for (int c = 0; c < SEQ / 64; ++c) {
            const int row0 = b * SEQ + 64 * c;
            unsigned tidl = (unsigned)F.tid; asm volatile("" : "+v"(tidl));
            const unsigned lane = tidl & 63u, g = lane >> 4, li = lane & 15u;
#pragma unroll
            for (int i = 0; i < 4; ++i) { const unsigned p = tidl + 512u * i, r = p >> 5, c32 = p & 31u; const unsigned o = r * RQS + 16u * c32; *(LAS v4u*)(Qi + o) = pq[i]; *(LAS v4u*)(Ki + o) = pk[i]; }
#pragma unroll
            for (int i = 0; i < 2; ++i) { const unsigned p = tidl + 512u * i, r = p >> 4, c16 = p & 15u; *(LAS v4u*)(Vi + r * RVS + 16u * c16) = pv[i]; }
            __syncthreads();
            if (c + 1 < SEQ / 64) { const int rn = row0 + 64;
#pragma unroll
                for (int i = 0; i < 4; ++i) { const unsigned p = tidl + 512u * i, r = p >> 5, c32 = p & 31u; pq[i] = *(const v4u*)(Q + (size_t)(rn + (int)r) * DM + h * 256 + c32 * 8); pk[i] = *(const v4u*)(K + (size_t)(rn + (int)r) * DM + h * 256 + c32 * 8); }
#pragma unroll
                for (int i = 0; i < 2; ++i) { const unsigned p = tidl + 512u * i, r = p >> 4, c16 = p & 15u; pv[i] = *(const v4u*)(V + (size_t)(rn + (int)r) * 2048 + h * 512 + vs * 128 + c16 * 8); } }
            RSB();
            const unsigned rb128 = li * RQS + 16u * g, rb64 = li * RQS + 8u * g, trq = (8u * g + (li >> 2)) * RQS + 8u * (li & 3u), trv = (8u * g + (li >> 2)) * RVS + 8u * (li & 3u);
            { const unsigned mt = w >> 1, nt0 = 2u * (w & 1u); f32x4 sa0 = (f32x4){0.f, 0.f, 0.f, 0.f}, sa1 = sa0;
              const LAS unsigned char* qrow = Qi + rb128 + mt * (16u * RQS); const LAS unsigned char* krow = Ki + rb128 + nt0 * (16u * RQS);
              bf16x8 qa[2][2], kb0[2][2], kb1[2][2];
#define RET_LDS(buf, s8b) do { _Pragma("unroll") for (int k2 = 0; k2 < 2; ++k2) { const int s8 = (s8b) + k2; \
                  qa[buf][k2] = *(const LAS bf16x8*)(qrow + 64 * s8); kb0[buf][k2] = *(const LAS bf16x8*)(krow + 64 * s8); kb1[buf][k2] = *(const LAS bf16x8*)(krow + 16 * RQS + 64 * s8); } } while (0)
              RET_LDS(0, 0); RSB();
#pragma unroll
              for (int bt = 0; bt < 4; ++bt) { if (bt < 3) RET_LDS((bt + 1) & 1, 2 * (bt + 1)); RSB();
#pragma unroll
                  for (int k2 = 0; k2 < 2; ++k2) { sa0 = __builtin_amdgcn_mfma_f32_16x16x32_bf16(qa[bt & 1][k2], kb0[bt & 1][k2], sa0, 0, 0, 0); sa1 = __builtin_amdgcn_mfma_f32_16x16x32_bf16(qa[bt & 1][k2], kb1[bt & 1][k2], sa1, 0, 0, 0); }
                  RSB(); }
#undef RET_LDS
#pragma unroll
              for (int q = 0; q < 4; ++q) { const int n = (int)(16u * mt + 4u * g) + q, m0 = (int)(16u * nt0 + li);
                  const float v0 = sa0[q] * exp2f(fabsf((float)(n - m0)) * lg2g), v1 = sa1[q] * exp2f(fabsf((float)(n - m0 - 16)) * lg2g); const unsigned pk = pk2(v0, v1);
                  *(LAS unsigned short*)(Si + (unsigned)n * 144u + 2u * (unsigned)m0) = (unsigned short)(pk & 0xffffu); *(LAS unsigned short*)(Si + (unsigned)n * 144u + 2u * (unsigned)m0 + 32u) = (unsigned short)(pk >> 16); } }
            RSB();
            f32x4 Oa[4];
#pragma unroll
            for (int mt = 0; mt < 4; ++mt) Oa[mt] = (f32x4){0.f, 0.f, 0.f, 0.f};
            { v2u qlo[2][4], qhi[2][4]; const LAS unsigned char* qp = Qi + rb64;
#define RET_LDQ(buf, s8) do { _Pragma("unroll") for (int mt = 0; mt < 4; ++mt) { qlo[buf][mt] = *(const LAS v2u*)(qp + mt * (16 * RQS) + 64 * (s8)); qhi[buf][mt] = *(const LAS v2u*)(qp + mt * (16 * RQS) + 64 * (s8) + 32); } } while (0)
              RET_LDQ(0, 0); RSB();
#pragma unroll
              for (int s8 = 0; s8 < 8; ++s8) { if (s8 < 7) RET_LDQ((s8 + 1) & 1, s8 + 1); RSB();
                  const v4u rt = (v4u){pk2(R[2 * s8][0], R[2 * s8][1]), pk2(R[2 * s8][2], R[2 * s8][3]), pk2(R[2 * s8 + 1][0], R[2 * s8 + 1][1]), pk2(R[2 * s8 + 1][2], R[2 * s8 + 1][3])}; const bf16x8 Rb = __builtin_bit_cast(bf16x8, rt);
#pragma unroll
                  for (int mt = 0; mt < 4; ++mt) { const v4u av = (v4u){qlo[s8 & 1][mt].x, qlo[s8 & 1][mt].y, qhi[s8 & 1][mt].x, qhi[s8 & 1][mt].y}; Oa[mt] = __builtin_amdgcn_mfma_f32_16x16x32_bf16(__builtin_bit_cast(bf16x8, av), Rb, Oa[mt], 0, 0, 0); }
                  RSB(); }
#undef RET_LDQ
            }
#pragma unroll
            for (int mt = 0; mt < 4; ++mt)
#pragma unroll
                for (int q = 0; q < 4; ++q) Oa[mt][q] *= exp2f((float)(16 * mt + 4 * (int)g + q + 1) * lg2g);
            __syncthreads();
            bf16x8 Vf[2], sf[4][2], ka[2][2][2];
#define RET_LDK(buf, dtb) do { _Pragma("unroll") for (int d2 = 0; d2 < 2; ++d2) _Pragma("unroll") for (int ks = 0; ks < 2; ++ks) ka[buf][d2][ks] = tr_lin<RQS>(Ki, trq, (dtb) + d2, ks); } while (0)
#pragma unroll
            for (int ks = 0; ks < 2; ++ks) Vf[ks] = tr_lin<RVS>(Vi + 32u * w, trv, 0, ks);
#pragma unroll
            for (int mt = 0; mt < 4; ++mt)
#pragma unroll
                for (int ks = 0; ks < 2; ++ks) sf[mt][ks] = *(const LAS bf16x8*)(Si + (16u * mt + li) * 144u + 64u * ks + 16u * g);
            RET_LDK(0, 0); RSB();
#pragma unroll
            for (int mt = 0; mt < 4; ++mt)
#pragma unroll
                for (int ks = 0; ks < 2; ++ks) Oa[mt] = __builtin_amdgcn_mfma_f32_16x16x32_bf16(sf[mt][ks], Vf[ks], Oa[mt], 0, 0, 0);
            bf16x8 Vd[2];
#pragma unroll
            for (int ks = 0; ks < 2; ++ks) { const v4u vv = __builtin_bit_cast(v4u, Vf[ks]); float f[8];
#pragma unroll
                for (int j = 0; j < 8; ++j) f[j] = exp2f((float)(63 - (32 * ks + 8 * (int)g + j)) * lg2g);
                const v4u sv = (v4u){pk2(bflo(vv.x) * f[0], bfhi(vv.x) * f[1]), pk2(bflo(vv.y) * f[2], bfhi(vv.y) * f[3]), pk2(bflo(vv.z) * f[4], bfhi(vv.z) * f[5]), pk2(bflo(vv.w) * f[6], bfhi(vv.w) * f[7])};
                Vd[ks] = __builtin_bit_cast(bf16x8, sv); }
            RSB();
#pragma unroll
            for (int bt = 0; bt < 8; ++bt) { if (bt < 7) RET_LDK((bt + 1) & 1, 2 * (bt + 1)); RSB();
#pragma unroll
                for (int d2 = 0; d2 < 2; ++d2) { const int dt = 2 * bt + d2; R[dt] = R[dt] * cd;
#pragma unroll
                    for (int ks = 0; ks < 2; ++ks) R[dt] = __builtin_amdgcn_mfma_f32_16x16x32_bf16(ka[bt & 1][d2][ks], Vd[ks], R[dt], 0, 0, 0); }
                RSB(); }
#undef RET_LDK
#pragma unroll
            for (int mt = 0; mt < 4; ++mt)
#pragma unroll
                for (int q = 0; q < 4; ++q) OT[(16u * mt + 4u * g + q) * 132u + 16u * w + li] = Oa[mt][q];
            __syncthreads();
            { const unsigned tn = tidl >> 3, vg = tidl & 7u; f32x4 o[4]; float ssq = 0.f;
#pragma unroll
              for (int i = 0; i < 4; ++i) { o[i] = *(const LAS f32x4*)(OT + tn * 132u + 16u * vg + 4u * i); ssq += (o[i].x * o[i].x + o[i].y * o[i].y) + (o[i].z * o[i].z + o[i].w * o[i].w); }
              ssq += __shfl_xor(ssq, 1); ssq += __shfl_xor(ssq, 2); ssq += __shfl_xor(ssq, 4);
              bf16* op = O + (size_t)(row0 + (int)tn) * 2048 + h * 512 + vs * 128 + 16 * vg; *(v4u*)op = pack8(o[0], o[1]); *(v4u*)(op + 8) = pack8(o[2], o[3]);
              if (vg == 0) SS[((size_t)(row0 + (int)tn) * 4 + h) * 4 + vs] = ssq; }
        }
    }
}
__device__ __forceinline__ void ret_norm(Frame& F) {
    relaunder(F);
    bf16* O = (bf16*)(F.ws + WS_R2); const float* SS = (const float*)(F.ws + WS_R2 + 256 * MiB); const bf16* SG = (const bf16*)(F.ws + WS_R1 + 512 * MiB);
    const int gw = F.vcu * NWAVES + F.wave, NGW = F.G * NWAVES;
    for (int row = gw; row < MTOK; row += NGW) {
        float r[4];
#pragma unroll
        for (int h = 0; h < 4; ++h) { const f32x4 p = *(const f32x4*)(SS + ((size_t)row * 4 + h) * 4); r[h] = 1.0f / sqrtf(((p.x + p.y) + (p.z + p.w)) * (1.0f / 512.f) + EPS); }
#pragma unroll
        for (int j = 0; j < 4; ++j) { const size_t gi = (size_t)row * 2048 + 512 * j + 8 * F.lane; const v4u o = *(const v4u*)(O + gi), sg = *(const v4u*)(SG + gi); const float rr = r[j];
            v4u w; w.x = pk2(bflo(o.x) * rr * bflo(sg.x), bfhi(o.x) * rr * bfhi(sg.x)); w.y = pk2(bflo(o.y) * rr * bflo(sg.y), bfhi(o.y) * rr * bfhi(sg.y));
            w.z = pk2(bflo(o.z) * rr * bflo(sg.z), bfhi(o.z) * rr * bfhi(sg.z)); w.w = pk2(bflo(o.w) * rr * bflo(sg.w), bfhi(o.w) * rr * bfhi(sg.w));
            *(v4u*)(O + gi) = w; }
    }
}

__device__ __forceinline__ bf16x8 pad8(s16x4 a) { return (bf16x8){a[0], a[1], a[2], a[3], 0, 0, 0, 0}; }
__device__ __forceinline__ void hgrn_scan_mfma(Frame& F, int j) {
    relaunder(F);
    const bf16* Q = (const bf16*)(F.ws + WS_R1); const bf16* K = (const bf16*)(F.ws + WS_R1 + 128 * MiB); const bf16* V = (const bf16*)(F.ws + WS_R1 + 256 * MiB); const bf16* SG = (const bf16*)(F.ws + WS_R1 + 384 * MiB);
    const float* LF = (const float*)(F.ws + WS_R1 + 512 * MiB); bf16* O = (bf16*)(F.ws + WS_R2);
    LAS unsigned char* QEi = F.lds; LAS unsigned char* QE2i = F.lds + 16384; LAS unsigned char* KEi = F.lds + 32768; LAS unsigned char* Vi = F.lds + 49152;
    LAS float* BL = (LAS float*)(F.lds + 65536); LAS float* OT = (LAS float*)(F.lds + 67584);
    const unsigned w = (unsigned)F.wave;
    for (int u = F.vcu; u < NBATCH * HG_H; u += F.G) {
        const int b = u >> 3, h = u & 7;
        f32x4 S[8];
#pragma unroll
        for (int i = 0; i < 8; ++i) S[i] = (f32x4){0.f, 0.f, 0.f, 0.f};
        float plf[16]; unsigned pqk[16]; v4u pv[2], psg[2];
        { const int kbp = F.tid >> 7, dp = F.tid & 127, row0 = b * SEQ;
#pragma unroll
          for (int t = 0; t < 16; ++t) { const size_t gi = (size_t)(row0 + 16 * kbp + t) * DM + h * 128 + dp; plf[t] = LF[gi]; pqk[t] = (unsigned)Q[gi] | ((unsigned)K[gi] << 16); }
#pragma unroll
          for (int i = 0; i < 2; ++i) { const int p = F.tid + 512 * i, r = p >> 4, c16 = p & 15; pv[i] = *(const v4u*)(V + (size_t)(row0 + r) * DM + h * 128 + c16 * 8); }
#pragma unroll
          for (int i = 0; i < 2; ++i) psg[i] = *(const v4u*)(SG + (size_t)(row0 + (F.tid >> 3)) * DM + h * 128 + 16 * (F.tid & 7) + 8 * i); }
        for (int c = 0; c < SEQ / 64; ++c) {
            const int row0 = b * SEQ + 64 * c;
            unsigned tidl = (unsigned)F.tid; asm volatile("" : "+v"(tidl));
            const unsigned lane = tidl & 63u, g = lane >> 4, li = lane & 15u, kbp = tidl >> 7, dp = tidl & 127u;
            { float bs = 0.f;
#pragma unroll
              for (int t = 0; t < 16; ++t) { bs += plf[t]; plf[t] = bs; }
              const float bl = plf[15];
#pragma unroll
              for (int t = 0; t < 16; ++t) { const float bt = plf[t], q = bflo(pqk[t]), k = bfhi(pqk[t]);
                  const unsigned a = off_b(16u * kbp + t, dp >> 3) + 2u * (dp & 7u);
                  const unsigned w0 = pk2(q * __expf(bt), q * __expf(fminf(bt - bl, 80.f))), w1 = pk2(k * __expf(bl - bt), 0.f);
                  *(LAS unsigned short*)(QEi + a) = (unsigned short)(w0 & 0xffffu); *(LAS unsigned short*)(QE2i + a) = (unsigned short)(w0 >> 16); *(LAS unsigned short*)(KEi + a) = (unsigned short)(w1 & 0xffffu); }
              BL[kbp * 128u + dp] = __expf(bl); }
#pragma unroll
            for (int i = 0; i < 2; ++i) { const unsigned p = tidl + 512u * i, r = p >> 4, c16 = p & 15u; *(LAS v4u*)(Vi + off_b(r, c16)) = pv[i]; }
            const v4u csg0 = psg[0], csg1 = psg[1];
            __syncthreads();
            if (c + 1 < SEQ / 64) { const int rn = row0 + 64;
#pragma unroll
                for (int t = 0; t < 16; ++t) { const size_t gi = (size_t)(rn + 16 * (int)kbp + t) * DM + h * 128 + dp; plf[t] = LF[gi]; pqk[t] = (unsigned)Q[gi] | ((unsigned)K[gi] << 16); }
#pragma unroll
                for (int i = 0; i < 2; ++i) { const unsigned p = tidl + 512u * i, r = p >> 4, c16 = p & 15u; pv[i] = *(const v4u*)(V + (size_t)(rn + (int)r) * DM + h * 128 + c16 * 8); }
#pragma unroll
                for (int i = 0; i < 2; ++i) psg[i] = *(const v4u*)(SG + (size_t)(rn + (int)(tidl >> 3)) * DM + h * 128 + 16 * (tidl & 7u) + 8 * i); }
#pragma unroll 1
            for (unsigned kb = 0; kb < 4; ++kb) {
                const unsigned rowl = 16u * kb + li;
                f32x4 P = (f32x4){0.f, 0.f, 0.f, 0.f};
#pragma unroll
                for (int s4 = 0; s4 < 4; ++s4) P = __builtin_amdgcn_mfma_f32_16x16x32_bf16(row_frag(KEi, rowl, s4, g), row_frag(QE2i, rowl, s4, g), P, 0, 0, 0);
                s16x4 a16;
                { const unsigned lo = pk2((4u * g + 0u <= li) ? P[0] : 0.f, (4u * g + 1u <= li) ? P[1] : 0.f), hi = pk2((4u * g + 2u <= li) ? P[2] : 0.f, (4u * g + 3u <= li) ? P[3] : 0.f); const v2u t2 = (v2u){lo, hi}; a16 = __builtin_bit_cast(s16x4, t2); }
                const unsigned q4 = li >> 2, p4 = li & 3u, trow = 16u * kb + 4u * g + q4;
                const s16x4 Vb = __builtin_amdgcn_ds_read_tr16_b64_v4i16((LAS s16x4*)(Vi + off_b(trow, 2u * w + (p4 >> 1)) + 8u * (p4 & 1u)));
                f32x4 oa = (f32x4){0.f, 0.f, 0.f, 0.f};
#pragma unroll
                for (int s4 = 0; s4 < 4; ++s4) {
                    const v4u st = (v4u){pk2(S[2 * s4][0], S[2 * s4][1]), pk2(S[2 * s4][2], S[2 * s4][3]), pk2(S[2 * s4 + 1][0], S[2 * s4 + 1][1]), pk2(S[2 * s4 + 1][2], S[2 * s4 + 1][3])};
                    const v2u lo = *(const LAS v2u*)(QEi + off_b(rowl, 4u * s4 + (g >> 1)) + 8u * (g & 1u)), hi = *(const LAS v2u*)(QEi + off_b(rowl, 4u * s4 + 2u + (g >> 1)) + 8u * (g & 1u));
                    const v4u av = (v4u){lo.x, lo.y, hi.x, hi.y};
                    oa = __builtin_amdgcn_mfma_f32_16x16x32_bf16(__builtin_bit_cast(bf16x8, av), __builtin_bit_cast(bf16x8, st), oa, 0, 0, 0); }
                oa = __builtin_amdgcn_mfma_f32_16x16x32_bf16(pad8(a16), pad8(Vb), oa, 0, 0, 0);
#pragma unroll
                for (int dt = 0; dt < 8; ++dt) { const f32x4 e4 = *(const LAS f32x4*)(BL + kb * 128u + 16u * dt + 4u * g);
                    const s16x4 kt = __builtin_amdgcn_ds_read_tr16_b64_v4i16((LAS s16x4*)(KEi + off_b(trow, 2u * dt + (p4 >> 1)) + 8u * (p4 & 1u)));
                    S[dt] = __builtin_amdgcn_mfma_f32_16x16x32_bf16(pad8(kt), pad8(Vb), S[dt] * e4, 0, 0, 0); }
#pragma unroll
                for (int q = 0; q < 4; ++q) OT[(16u * kb + 4u * g + q) * 128u + 16u * w + li] = oa[q];
            }
            __syncthreads();
            { const unsigned tn = tidl >> 3, vg = tidl & 7u; f32x4 o[4]; float ss = 0.f;
#pragma unroll
              for (int i = 0; i < 4; ++i) { o[i] = *(const LAS f32x4*)(OT + tn * 128u + 16u * vg + 4u * i); ss += (o[i].x * o[i].x + o[i].y * o[i].y) + (o[i].z * o[i].z + o[i].w * o[i].w); }
              ss += __shfl_xor(ss, 1); ss += __shfl_xor(ss, 2); ss += __shfl_xor(ss, 4);
              const float r = 1.0f / sqrtf(ss * (1.0f / 128.f) + EPS); const float* gp = KIN(I_HGAIN) + j * 128 + 16 * vg;
#pragma unroll
              for (int i = 0; i < 4; ++i) o[i] = o[i] * r * *(const f32x4*)(gp + 4 * i);
              v4u w0, w1;
              w0.x = pk2(o[0].x * bflo(csg0.x), o[0].y * bfhi(csg0.x)); w0.y = pk2(o[0].z * bflo(csg0.y), o[0].w * bfhi(csg0.y)); w0.z = pk2(o[1].x * bflo(csg0.z), o[1].y * bfhi(csg0.z)); w0.w = pk2(o[1].z * bflo(csg0.w), o[1].w * bfhi(csg0.w));
              w1.x = pk2(o[2].x * bflo(csg1.x), o[2].y * bfhi(csg1.x)); w1.y = pk2(o[2].z * bflo(csg1.y), o[2].w * bfhi(csg1.y)); w1.z = pk2(o[3].x * bflo(csg1.z), o[3].y * bfhi(csg1.z)); w1.w = pk2(o[3].z * bflo(csg1.w), o[3].w * bfhi(csg1.w));
              bf16* op = O + (size_t)(row0 + (int)tn) * DM + h * 128 + 16 * vg; *(v4u*)op = w0; *(v4u*)(op + 8) = w1; }
        }
    }
}

struct Args { const void* in[22]; float* out; unsigned char* ws; int ph_lo, ph_hi; };
constexpr int PH_PER_LAYER = 9, NPHASES = 1 + DEPTH * PH_PER_LAYER + 1;

__global__ void __launch_bounds__(NWAVES * 64, 2) hybrid_fwd(Args args) {
    extern __shared__ __attribute__((aligned(16))) unsigned char lds[];
    Frame F;
    F.lds = (LAS unsigned char*)lds;
    F.tid = threadIdx.x; F.lane = F.tid & 63; F.wave = __builtin_amdgcn_readfirstlane(F.tid >> 6);
    F.G = gridDim.x; { const int bx = blockIdx.x; F.vcu = (F.G % 8 == 0) ? (bx % 8) * (F.G / 8) + bx / 8 : bx; }
    F.ws = args.ws; F.out = args.out; F.ctl = (unsigned*)(args.ws + WS_CTL);
    for (int u = F.tid; u < (LDS_BYTES - MISC_OFF) / 4; u += NWAVES * 64) ((LAS unsigned*)(F.lds + MISC_OFF))[u] = 0u;
    __syncthreads();
    const int lo = args.ph_lo, hi = args.ph_hi;
    XcdBarrier bar; bar.bar = F.ctl + CW_BAR; bar.x = 0; bar.st = nullptr;
    if (hi - lo > 1) bar = xcd_barrier_post(F.ctl + CW_BAR, (volatile LAS unsigned*)(F.lds + MISC_OFF) + 8);
#define IN(k) (lo <= (k) && (k) < hi)
#define SEAM(k) do { if (IN(k) && hi > (k) + 1) xcd_barrier(bar); } while (0)

    if (PH_EN(0) && IN(0)) { for (int rep = 0; rep < REPS(0); ++rep) p0_prologue(F); } SEAM(0);

#pragma unroll 1
    for (int l = 0; l < DEPTH; ++l) {
        const int pb = 1 + l * PH_PER_LAYER, j = l >> 1; const bool is_ret = (l & 1);
        if (PH_EN(1) && IN(pb + 0)) row_phase1(F, l, 0);
        SEAM(pb + 0);
        if (IN(pb + 1)) {
            if (PH_EN(2) && !is_ret) {
                pg8::Gemm g{(const bf16*)(F.ws + WS_H), (const bf16*)(F.ws + WS_HWIN) + (size_t)j * HG_N * DM, MTOK, HG_N, DM}; pg8::StaticOrder S; S.init(MTOK, HG_N, F.G, (int)blockIdx.x);
                EpiHgrnIn E{F.ws + WS_R1, (const float*)(F.ws + WS_LBV) + j * DM};
                for (int rep = 0; rep < REPS(2); ++rep) pg8::gemm_phase<EpiHgrnIn, pg8::StaticOrder, true, true>(F.lds + RING_OFF, g, S, E);
            } else if (PH_EN(3)) {
                pg8::Gemm g{(const bf16*)(F.ws + WS_H), (const bf16*)(F.ws + WS_RWIN) + (size_t)j * RT_N * DM, MTOK, RT_N, DM}; pg8::StaticOrder S; S.init(MTOK, RT_N, F.G, (int)blockIdx.x);
                EpiRetIn E{F.ws + WS_R1, (const int*)kin_(I_POS)};
                for (int rep = 0; rep < REPS(3); ++rep) pg8::gemm_phase<EpiRetIn, pg8::StaticOrder, true, true>(F.lds + RING_OFF, g, S, E);
            }
        }
        SEAM(pb + 1);
        if (IN(pb + 2)) { if (!is_ret) { if (PH_EN(4)) { for (int rep = 0; rep < REPS(4); ++rep) { if (HGRN_MFMA) hgrn_scan_mfma(F, j); else hgrn_scan(F, j); } } } else { if (PH_EN(5)) { for (int rep = 0; rep < REPS(5); ++rep) { if (RET_MFMA) ret_scan_mfma(F); else ret_scan(F); } } } }
        SEAM(pb + 2);
        if (RET_MFMA && PH_EN(12) && IN(pb + 3) && is_ret) ret_norm(F);
        if (RET_MFMA && is_ret) SEAM(pb + 3);
        if (PH_EN(6) && IN(pb + 4)) {
            const int Ko = is_ret ? 2048 : DM;
            const bf16* Wt = is_ret ? (const bf16*)(F.ws + WS_RWOUT) + (size_t)j * DM * 2048 : (const bf16*)(F.ws + WS_HWOUT) + (size_t)j * DM * DM;
            pg8::Gemm g{(const bf16*)(F.ws + WS_R2), Wt, MTOK, DM, Ko}; pg8::StaticOrder S; S.init(MTOK, DM, F.G, (int)blockIdx.x);
            EpiOut E{l == 0 ? KIN(I_X) : F.out, F.out, (const float*)(F.ws + WS_MOD) + (size_t)l * NBATCH * 6 * DM + 2 * DM};
            pg8::gemm_phase<EpiOut, pg8::StaticOrder, true, true>(F.lds + RING_OFF, g, S, E);
        }
        SEAM(pb + 4);
        if (PH_EN(7) && IN(pb + 5)) row_phase2(F, l);
        SEAM(pb + 5);
        if (MOE_GATHER_PASS) { if (PH_EN(8) && IN(pb + 6)) { for (int rep = 0; rep < REPS(8); ++rep) moe_gather(F, l); } SEAM(pb + 6); }
        if (PH_EN(9) && IN(pb + 7)) {
            build_tiles(F, l);
            if (!MOE_GATHER_PASS) moe_build_tt(F, 8);
            pg8::MoeOrder S{8, F.G, F.vcu, (const LAS int*)(F.lds + TAB_OFF), (const LAS unsigned short*)(F.lds + 131072)};
            if constexpr (MOE_FP8) {
                static_assert(!MOE_FP8 || !MOE_GATHER_PASS, "the fp8 expert GEMM gathers while staging");
                pg8::Gemm g{(const bf16*)(F.ws + WS_H8), (const bf16*)(F.ws + WS_W1T + (size_t)l * NEXP * 2048 * DM), 0, 0, DM / 2};
                EpiMoe1F8 E{F.ws + WS_R2, KIN(I_B1) + (size_t)l * NEXP * 2048};
                for (int rep = 0; rep < REPS(9); ++rep) pg8::gemm_phase<EpiMoe1F8, pg8::MoeOrder, true, true, true, true>(F.lds + RING_OFF, g, S, E);
                if (REPS(12) > 1) pg8::gemm_phase<EpiMoe1F8, pg8::MoeOrder, true, true, true, true, true>(F.lds + RING_OFF, g, S, E);
            } else {
                pg8::Gemm g{(const bf16*)(F.ws + (MOE_GATHER_PASS ? WS_R1 : WS_H)), (const bf16*)(F.ws + WS_W1T) + (size_t)l * NEXP * 2048 * DM, 0, 0, DM};
                EpiMoe1 E{(bf16*)(F.ws + WS_R2), KIN(I_B1) + (size_t)l * NEXP * 2048};
                for (int rep = 0; rep < REPS(9); ++rep) pg8::gemm_phase<EpiMoe1, pg8::MoeOrder, true, true, !MOE_GATHER_PASS>(F.lds + RING_OFF, g, S, E);
            }
        }
        SEAM(pb + 7);
        if (PH_EN(10) && IN(pb + 8)) {
            build_tiles(F, l);
            pg8::MoeOrder S{4, F.G, F.vcu, (const LAS int*)(F.lds + TAB_OFF), nullptr};
            if constexpr (MOE_FP8) {
                pg8::Gemm g{(const bf16*)(F.ws + WS_R2), (const bf16*)(F.ws + WS_W2T + (size_t)l * NEXP * DM * DM), 0, 0, DM / 2};
                EpiMoe2 E{(bf16*)(F.ws + WS_R1), KIN(I_B2) + (size_t)l * NEXP * DM, 1.0f / 256.f};
                for (int rep = 0; rep < REPS(10); ++rep) pg8::gemm_phase<EpiMoe2, pg8::MoeOrder, true, true, false, true>(F.lds + RING_OFF, g, S, E);
                if (REPS(11) > 1) pg8::gemm_phase<EpiMoe2, pg8::MoeOrder, true, true, false, true, true>(F.lds + RING_OFF, g, S, E);
            } else {
                pg8::Gemm g{(const bf16*)(F.ws + WS_R2), (const bf16*)(F.ws + WS_W2T) + (size_t)l * NEXP * DM * DM, 0, 0, DM};
                EpiMoe2 E{(bf16*)(F.ws + WS_R1), KIN(I_B2) + (size_t)l * NEXP * DM, 1.0f};
                for (int rep = 0; rep < REPS(10); ++rep) pg8::gemm_phase<EpiMoe2, pg8::MoeOrder, true, true>(F.lds + RING_OFF, g, S, E);
            }
        }
        SEAM(pb + 8);
    }
    if (PH_EN(11) && IN(NPHASES - 1)) row_phase1(F, DEPTH, 1);
#undef IN
#undef SEAM
}

extern "C" void kernel_launch(void* const* d_in, const int* in_sizes, int n_in, void* d_out, int out_size, void* d_ws, size_t ws_size, hipStream_t stream) {
    static int grid = 0;
    if (grid == 0) {
        if (n_in != 22 || in_sizes[0] != MTOK * DM || out_size != MTOK * DM || ws_size < WS_END) { fprintf(stderr, "kernel_launch: unexpected shapes (n_in %d, in0 %d, out %d, ws %zu < %zu)\n", n_in, n_in > 0 ? in_sizes[0] : -1, out_size, ws_size, (size_t)WS_END); grid = -1; return; }
        int dev = 0, cus = 0, per_cu = 0;
        if (hipGetDevice(&dev) != hipSuccess || hipDeviceGetAttribute(&cus, hipDeviceAttributeMultiprocessorCount, dev) != hipSuccess) { grid = -1; return; }
        if (hipFuncSetAttribute((const void*)hybrid_fwd, hipFuncAttributeMaxDynamicSharedMemorySize, LDS_BYTES) != hipSuccess) { fprintf(stderr, "kernel_launch: hipFuncSetAttribute failed\n"); grid = -1; return; }
        if (hipOccupancyMaxActiveBlocksPerMultiprocessor(&per_cu, (const void*)hybrid_fwd, NWAVES * 64, LDS_BYTES) != hipSuccess || per_cu < 1) { fprintf(stderr, "kernel_launch: occupancy query says %d blocks per CU\n", per_cu); }
        (void)hipGetLastError();
        grid = cus;
    }
    if (grid < 0) return;
    (void)hipMemsetAsync((char*)d_ws + WS_CTL, 0, CTL_ZERO_BYTES, stream);
    Args a{};
    for (int i = 0; i < 22; ++i) a.in[i] = d_in[i];
    a.out = (float*)d_out; a.ws = (unsigned char*)d_ws;
#if MK_SPLIT
    for (int p = 0; p < DBG_LIMIT; ++p) {
        if (p >= 1 && p < NPHASES - 1 && ((p - 1) % PH_PER_LAYER) == 3 && (!RET_MFMA || (((p - 1) / PH_PER_LAYER) & 1) == 0)) continue;
        if (!MOE_GATHER_PASS && p >= 1 && p < NPHASES - 1 && ((p - 1) % PH_PER_LAYER) == 6) continue;
        a.ph_lo = p; a.ph_hi = p + 1;
        hipLaunchKernelGGL(hybrid_fwd, dim3(grid), dim3(NWAVES * 64), LDS_BYTES, stream, a);
    }
#else
    a.ph_lo = 0; a.ph_hi = NPHASES;
    hipLaunchKernelGGL(hybrid_fwd, dim3(grid), dim3(NWAVES * 64), LDS_BYTES, stream, a);
#endif
    const hipError_t le = hipPeekAtLastError();
    if (le != hipSuccess) fprintf(stderr, "kernel_launch: launch failed: %s\n", hipGetErrorName(le));
}
```

```cpp
#include <hip/hip_runtime.h>
#include <cstdio>
#include <cstdint>

#ifndef ONLY_PH
#define ONLY_PH -1
#endif
#define PH_EN(n) (ONLY_PH < 0 || ONLY_PH == (n))
#ifndef DBG_LIMIT
#define DBG_LIMIT NPHASES
#endif
#ifndef RET_MFMA
#define RET_MFMA 1
#endif
#ifndef HGRN_MFMA
#define HGRN_MFMA 1
#endif
#ifndef REPEAT_MASK
#define REPEAT_MASK 0
#endif
#define REPS(k) (1 + ((REPEAT_MASK >> (k)) & 1))
#ifndef MOE_GATHER_PASS
#define MOE_GATHER_PASS 0
#endif
#ifndef MOE_FP8
#define MOE_FP8 1
#endif
#ifndef MK_SPLIT
#define MK_SPLIT 0
#endif

namespace pg8 {
#define PG8_LAS __attribute__((address_space(3)))
typedef unsigned short bf16_t;
typedef short bf16x8 __attribute__((ext_vector_type(8)));
typedef float f32x4 __attribute__((ext_vector_type(4)));
typedef unsigned u32x4 __attribute__((ext_vector_type(4)));
constexpr int BM = 256, BK = 64, HALF = 128, HTB = HALF * BK * 2  , STAGE_BYTES = 8 * HTB, NXCD = 8, WGM = 8;

__host__ __device__ __forceinline__ int lds_byte(int r, int c) { const int st = (r >> 4) * 2 + (c >> 5), rr = r & 15, cc = c & 31, ob = rr * 64 + cc * 2; return st * 1024 + (ob ^ (((ob >> 9) & 1) << 5)); }
__host__ __device__ __forceinline__ void stage_rc(int b, int& R, int& C) { const int st = b / 1024, sb = b % 1024, swz = sb ^ (((sb >> 9) & 1) << 5); R = (st >> 1) * 16 + swz / 64; C = (st & 1) * 32 + (swz % 64) / 2; }
__host__ __device__ __forceinline__ int perm32(int rho) { const int n = rho >> 4, i = rho & 15; return 8 * (i >> 2) + 4 * n + (i & 3); }

struct Unit { int pm, pn, e, nn; };
struct Gemm { const bf16_t* A; const bf16_t* Bt; int M, N, K; };

struct StaticOrder {
    int nM, nN, nwg, G, c;
    __host__ __device__ void init(int M, int N, int G_, int c_) { nM = M / BM; nN = N / BM; nwg = nM * nN; G = G_; c = c_; }
    __host__ __device__ bool next(int i, Unit& u) const {
        const long L = (long)i * G + c; if (L >= nwg) return false;
        int wgid = (int)L; { const int q = nwg / NXCD, r = nwg % NXCD, xcd = wgid % NXCD, off = wgid / NXCD; wgid = (xcd < r ? xcd * (q + 1) : r * (q + 1) + (xcd - r) * q) + off; }
        const int nig = WGM * nN, gid = wgid / nig, fm = gid * WGM, gsz = (nM - fm) < WGM ? (nM - fm) : WGM;
        u.pm = fm + ((wgid % nig) % gsz); u.pn = (wgid % nig) / gsz; u.e = 0; u.nn = u.pn; return true;
    }
    __device__ __forceinline__ unsigned tok(int, int) const { return 0u; }
    __device__ __forceinline__ void a_ready(const Unit&) const {}
    __device__ __forceinline__ void done(const Unit&) const {}
};
struct MoeOrder {
    int nN, G, c; const PG8_LAS int* ts; const PG8_LAS unsigned short* tt;
    __device__ __forceinline__ unsigned tok(int i, int r) const { return tt[i * 256 + r]; }
    __device__ __forceinline__ bool next(int i, Unit& u) const {
        const int NT = ts[32]; const long L = (long)i * G + c; if (L >= (long)NT * nN) return false;
        const int mt = (int)(L / nN), n = (int)(L % nN); int e = 0;
        for (int k = 1; k < 32; ++k) e += (ts[k] <= mt) ? 1 : 0;
        u.pm = mt; u.pn = e * nN + n; u.e = e; u.nn = n; return true;
    }
    __device__ __forceinline__ void a_ready(const Unit&) const {}
    __device__ __forceinline__ void done(const Unit&) const {}
};

__device__ __forceinline__ unsigned cvt_pk_bf16(float lo, float hi) { unsigned r; asm volatile("v_cvt_pk_bf16_f32 %0, %1, %2" : "=v"(r) : "v"(lo), "v"(hi)); return r; }

template <int N> __device__ __forceinline__ void wait_vm() { asm volatile("s_waitcnt vmcnt(%0)" :: "n"(N) : "memory"); }
typedef int v8i32 __attribute__((ext_vector_type(8)));
template <class Epi, class Sched, bool ALIGN_EPI = false, bool SP2 = false, bool GATHER = false, bool FP8 = false, bool NOEPI = false>
__device__ __forceinline__ void gemm_phase(PG8_LAS unsigned char* lds, const Gemm g, const Sched& S, const Epi& E) {
    int tid_ = threadIdx.x; asm volatile("" : "+v"(tid_));
    const int tid = tid_, wid = __builtin_amdgcn_readfirstlane(tid >> 6), lane = tid & 63, wr = wid >> 2, wc = wid & 3, fr = lane & 15, fq = lane >> 4;
    const int K = g.K, nt = K / BK;
    unsigned voffA[2], voffB[2];
#pragma unroll
    for (int i = 0; i < 2; ++i) { int R, C; stage_rc(tid * 16 + i * 8192, R, C); const int Rb = Epi::PERM ? ((R & ~31) + perm32(R & 31)) : R;
        voffA[i] = (unsigned)(R * K + C) * 2u; voffB[i] = (unsigned)(Rb * K + C) * 2u; }
    int gR[2]; unsigned gC[2];
#pragma unroll
    for (int i = 0; i < 2; ++i) { int R, C; stage_rc(tid * 16 + i * 8192, R, C); gR[i] = R; gC[i] = (unsigned)C * 2u; }
#define PG8_GVOFF(v, ui_, h_) do { _Pragma("unroll") for (int _i = 0; _i < 2; ++_i) v[_i] = (S.tok((ui_), gR[_i] + HALF * (h_)) * (unsigned)(K * 2)) + gC[_i]; } while (0)
    const size_t kstep = (size_t)(BK * 2);
    const size_t hstep = (size_t)HALF * K * 2;
    const size_t tstep = 2 * hstep;
    const unsigned ldsw = (unsigned)wid * 1024u;
    const int aoff = FP8 ? lds_byte(wr * 64 + fr, fq * 16) : lds_byte(wr * 64 + fr, fq * 8), boff = FP8 ? lds_byte(wc * 32 + fr, fq * 16) : lds_byte(wc * 32 + fr, fq * 8);

#define PG8_SA(b, h) (((b) * 2 + (h)) * HTB)
#define PG8_SB(b, h) ((4 + (b) * 2 + (h)) * HTB)
#define PG8_STAGE(bufoff, gbase, voff) do { _Pragma("unroll") for (int _i = 0; _i < 2; ++_i) \
        __builtin_amdgcn_global_load_lds((const unsigned*)((const char*)(gbase) + (voff)[_i]), (PG8_LAS unsigned*)(lds + (bufoff) + ldsw + _i * 8192), 16, 0, 0); } while (0)
#define PG8_LDA(dst, b, h) do { if constexpr (FP8) { _Pragma("unroll") for (int m = 0; m < 4; ++m) { const u32x4 p0_ = *(const PG8_LAS u32x4*)(lds + PG8_SA(b, h) + aoff + m * 2048), p1_ = *(const PG8_LAS u32x4*)(lds + PG8_SA(b, h) + aoff + m * 2048 + 16); dst##8[m] = __builtin_bit_cast(v8i32, __builtin_shufflevector(p0_, p1_, 0, 1, 2, 3, 4, 5, 6, 7)); } } \
    else { _Pragma("unroll") for (int m = 0; m < 4; ++m) _Pragma("unroll") for (int k = 0; k < 2; ++k) dst[m][k] = *(const PG8_LAS bf16x8*)(lds + PG8_SA(b, h) + aoff + m * 2048 + k * 1024); } } while (0)
#define PG8_LDB(dst, b, h) do { if constexpr (FP8) { _Pragma("unroll") for (int n = 0; n < 2; ++n) { const u32x4 p0_ = *(const PG8_LAS u32x4*)(lds + PG8_SB(b, h) + boff + n * 2048), p1_ = *(const PG8_LAS u32x4*)(lds + PG8_SB(b, h) + boff + n * 2048 + 16); dst##8[n] = __builtin_bit_cast(v8i32, __builtin_shufflevector(p0_, p1_, 0, 1, 2, 3, 4, 5, 6, 7)); } } \
    else { _Pragma("unroll") for (int n = 0; n < 2; ++n) _Pragma("unroll") for (int k = 0; k < 2; ++k) dst[n][k] = *(const PG8_LAS bf16x8*)(lds + PG8_SB(b, h) + boff + n * 2048 + k * 1024); } } while (0)
#define PG8_CAT(x) __builtin_shufflevector(__builtin_bit_cast(u32x4, (x)[0]), __builtin_bit_cast(u32x4, (x)[1]), 0, 1, 2, 3, 4, 5, 6, 7)
#define PG8_MMA(ai, bj, At, Bt) do { __builtin_amdgcn_s_setprio(1); if constexpr (FP8) { _Pragma("unroll") for (int m = 0; m < 4; ++m) _Pragma("unroll") for (int n = 0; n < 2; ++n) \
        asm volatile("v_mfma_scale_f32_16x16x128_f8f6f4 %0, %1, %2, %0, %3, %3 op_sel_hi:[0,0,0]" : "+v"(acc[ai][bj][m][n]) : "v"(Bt##8[n]), "v"(At##8[m]), "v"(scl1)); } \
    else { _Pragma("unroll") for (int m = 0; m < 4; ++m) _Pragma("unroll") for (int n = 0; n < 2; ++n) _Pragma("unroll") for (int k = 0; k < 2; ++k) \
        acc[ai][bj][m][n] = __builtin_amdgcn_mfma_f32_16x16x32_bf16(Bt[n][k], At[m][k], acc[ai][bj][m][n], 0, 0, 0); } __builtin_amdgcn_s_setprio(0); } while (0)
#define PG8_WAIT_V(n) asm volatile("s_waitcnt vmcnt(" #n ")" ::: "memory")
#define PG8_WAIT_L(n) asm volatile("s_waitcnt lgkmcnt(" #n ")" ::: "memory")
#define PG8_BAR __builtin_amdgcn_s_barrier()
#define PG8_SCHED __builtin_amdgcn_sched_barrier(0)
    Unit cur, nxt; int ui = 0;
    if (!S.next(0, cur)) return;
    f32x4 acc[2][2][4][2];
#pragma unroll
    for (int a = 0; a < 2; ++a)
#pragma unroll
        for (int b = 0; b < 2; ++b)
#pragma unroll
            for (int m = 0; m < 4; ++m)
#pragma unroll
                for (int n = 0; n < 2; ++n) acc[a][b][m][n] = (f32x4){0.f, 0.f, 0.f, 0.f};
    const unsigned scl1 = 0x7f7f7f7fu;
    bf16x8 At[4][2], B0[2][2], B1[2][2]; v8i32 At8[4], B08[2], B18[2];
    const char* cA = GATHER ? (const char*)g.A : (const char*)g.A + (size_t)cur.pm * tstep; const char* cB = (const char*)g.Bt + (size_t)cur.pn * tstep;
    S.a_ready(cur);
    static_assert(!GATHER || SP2, "GATHER is written for the SP2 loop");
    if constexpr (SP2) {
        if constexpr (GATHER) { unsigned v0[2], v1[2]; PG8_GVOFF(v0, 0, 0); PG8_GVOFF(v1, 0, 1); PG8_STAGE(PG8_SB(0, 0), cB, voffB); PG8_STAGE(PG8_SB(0, 1), cB + hstep, voffB); PG8_STAGE(PG8_SA(0, 0), cA, v0); PG8_STAGE(PG8_SA(0, 1), cA, v1); }
        else { PG8_STAGE(PG8_SB(0, 0), cB, voffB); PG8_STAGE(PG8_SB(0, 1), cB + hstep, voffB); PG8_STAGE(PG8_SA(0, 0), cA, voffA); PG8_STAGE(PG8_SA(0, 1), cA + hstep, voffA); }
        if (wr == 1) PG8_BAR;
        PG8_WAIT_V(2); PG8_BAR;
        if constexpr (GATHER) { unsigned v0[2]; PG8_GVOFF(v0, 0, 0); PG8_STAGE(PG8_SB(1, 0), cB + kstep, voffB); PG8_STAGE(PG8_SA(1, 0), cA + kstep, v0); PG8_STAGE(PG8_SB(1, 1), cB + hstep + kstep, voffB); }
        else { PG8_STAGE(PG8_SB(1, 0), cB + kstep, voffB); PG8_STAGE(PG8_SA(1, 0), cA + kstep, voffA); PG8_STAGE(PG8_SB(1, 1), cB + hstep + kstep, voffB); }
        PG8_WAIT_V(6); PG8_BAR;
    } else {
        PG8_STAGE(PG8_SB(0, 0), cB, voffB); PG8_STAGE(PG8_SA(0, 0), cA, voffA); PG8_STAGE(PG8_SB(0, 1), cB + hstep, voffB); PG8_STAGE(PG8_SA(0, 1), cA + hstep, voffA);
        if (wr == 1) PG8_BAR;
        PG8_WAIT_V(4); PG8_BAR;
        PG8_STAGE(PG8_SB(1, 0), cB + kstep, voffB); PG8_STAGE(PG8_SA(1, 0), cA + kstep, voffA); PG8_STAGE(PG8_SB(1, 1), cB + hstep + kstep, voffB);
        PG8_WAIT_V(6); PG8_BAR;
    }
    for (;;) {
        const bool has_next = S.next(ui + 1, nxt);
        const char* nA = GATHER ? cA : (has_next ? (const char*)g.A + (size_t)nxt.pm * tstep : cA); const char* nB = has_next ? (const char*)g.Bt + (size_t)nxt.pn * tstep : cB;
#pragma unroll 1
        for (int t = 0; t < nt; t += 2) {
            asm volatile("" : "+v"(voffA[0]), "+v"(voffA[1]), "+v"(voffB[0]), "+v"(voffB[1]));
            const bool last = (t == nt - 2);
            const char* a1 = cA + (size_t)(t + 1) * kstep;
            const char* a2 = last ? nA : cA + (size_t)(t + 2) * kstep; const char* b2 = last ? nB : cB + (size_t)(t + 2) * kstep;
            const char* a3 = a2 + kstep; const char* b3 = b2 + kstep;
            if (last && has_next) S.a_ready(nxt);
            const bool rlx = (t == 0) && (ui > 0);
#define PG8_WAIT_V8R do { if (rlx) wait_vm<8 + Epi::NST>(); else wait_vm<8>(); } while (0)
            if constexpr (SP2 && GATHER) {
            const int uix = (last && has_next) ? ui + 1 : ui;
            unsigned vc1[2], vx0[2], vx1[2]; PG8_GVOFF(vc1, ui, 1); PG8_GVOFF(vx0, uix, 0); PG8_GVOFF(vx1, uix, 1);
            PG8_LDB(B0, 0, 0); PG8_LDB(B1, 0, 1); PG8_SCHED; PG8_LDA(At, 0, 0); PG8_STAGE(PG8_SA(1, 1), a1, vc1);
            PG8_WAIT_V8R; PG8_WAIT_L(0); PG8_BAR; PG8_MMA(0, 0, At, B0); PG8_MMA(0, 1, At, B1); PG8_BAR; PG8_SCHED;
            PG8_LDA(At, 0, 1); PG8_STAGE(PG8_SB(0, 0), b2, voffB); PG8_STAGE(PG8_SB(0, 1), b2 + hstep, voffB); PG8_STAGE(PG8_SA(0, 0), a2, vx0);
            PG8_WAIT_V8R; PG8_WAIT_L(0); PG8_BAR; PG8_MMA(1, 0, At, B0); PG8_MMA(1, 1, At, B1); PG8_BAR; PG8_SCHED;
            PG8_LDB(B0, 1, 0); PG8_LDB(B1, 1, 1); PG8_SCHED; PG8_LDA(At, 1, 0); PG8_STAGE(PG8_SA(0, 1), a2, vx1);
            PG8_WAIT_V(8); PG8_WAIT_L(0); PG8_BAR; PG8_MMA(0, 0, At, B0); PG8_MMA(0, 1, At, B1); PG8_BAR; PG8_SCHED;
            PG8_LDA(At, 1, 1); PG8_STAGE(PG8_SB(1, 0), b3, voffB); PG8_STAGE(PG8_SB(1, 1), b3 + hstep, voffB); PG8_STAGE(PG8_SA(1, 0), a3, vx0);
            PG8_WAIT_V(8); PG8_WAIT_L(0); PG8_BAR; PG8_MMA(1, 0, At, B0); PG8_MMA(1, 1, At, B1); PG8_BAR; PG8_SCHED;
            } else if constexpr (SP2) {
            PG8_LDB(B0, 0, 0); PG8_LDB(B1, 0, 1); PG8_SCHED; PG8_LDA(At, 0, 0); PG8_STAGE(PG8_SA(1, 1), a1 + hstep, voffA);
            PG8_WAIT_V8R; PG8_WAIT_L(0); PG8_BAR; PG8_MMA(0, 0, At, B0); PG8_MMA(0, 1, At, B1); PG8_BAR; PG8_SCHED;
            PG8_LDA(At, 0, 1); PG8_STAGE(PG8_SB(0, 0), b2, voffB); PG8_STAGE(PG8_SB(0, 1), b2 + hstep, voffB); PG8_STAGE(PG8_SA(0, 0), a2, voffA);
            PG8_WAIT_V8R; PG8_WAIT_L(0); PG8_BAR; PG8_MMA(1, 0, At, B0); PG8_MMA(1, 1, At, B1); PG8_BAR; PG8_SCHED;
            PG8_LDB(B0, 1, 0); PG8_LDB(B1, 1, 1); PG8_SCHED; PG8_LDA(At, 1, 0); PG8_STAGE(PG8_SA(0, 1), a2 + hstep, voffA);
            PG8_WAIT_V(8); PG8_WAIT_L(0); PG8_BAR; PG8_MMA(0, 0, At, B0); PG8_MMA(0, 1, At, B1); PG8_BAR; PG8_SCHED;
            PG8_LDA(At, 1, 1); PG8_STAGE(PG8_SB(1, 0), b3, voffB); PG8_STAGE(PG8_SB(1, 1), b3 + hstep, voffB); PG8_STAGE(PG8_SA(1, 0), a3, voffA);
            PG8_WAIT_V(8); PG8_WAIT_L(0); PG8_BAR; PG8_MMA(1, 0, At, B0); PG8_MMA(1, 1, At, B1); PG8_BAR; PG8_SCHED;
            } else {
            PG8_LDB(B0, 0, 0); PG8_SCHED; PG8_LDA(At, 0, 0); PG8_STAGE(PG8_SA(1, 1), a1 + hstep, voffA);
            PG8_WAIT_L(8); PG8_BAR; PG8_WAIT_L(0); PG8_MMA(0, 0, At, B0); PG8_BAR; PG8_SCHED;
            PG8_LDB(B1, 0, 1); PG8_STAGE(PG8_SB(0, 0), b2, voffB);
            PG8_BAR; PG8_WAIT_L(0); PG8_MMA(0, 1, At, B1); PG8_BAR;
            PG8_LDA(At, 0, 1); PG8_STAGE(PG8_SA(0, 0), a2, voffA);
            PG8_BAR; PG8_WAIT_L(0); PG8_MMA(1, 0, At, B0); PG8_BAR; PG8_SCHED;
            PG8_STAGE(PG8_SB(0, 1), b2 + hstep, voffB);
            PG8_WAIT_V(6); PG8_BAR; PG8_MMA(1, 1, At, B1); PG8_BAR;
            PG8_LDB(B0, 1, 0); PG8_SCHED; PG8_LDA(At, 1, 0); PG8_STAGE(PG8_SA(0, 1), a2 + hstep, voffA);
            PG8_WAIT_L(8); PG8_BAR; PG8_WAIT_L(0); PG8_MMA(0, 0, At, B0); PG8_BAR; PG8_SCHED;
            PG8_LDB(B1, 1, 1); PG8_STAGE(PG8_SB(1, 0), b3, voffB);
            PG8_BAR; PG8_WAIT_L(0); PG8_MMA(0, 1, At, B1); PG8_BAR;
            PG8_LDA(At, 1, 1); PG8_STAGE(PG8_SA(1, 0), a3, voffA);
            PG8_BAR; PG8_WAIT_L(0); PG8_MMA(1, 0, At, B0); PG8_BAR; PG8_SCHED;
            PG8_STAGE(PG8_SB(1, 1), b3 + hstep, voffB);
            PG8_WAIT_V(6); PG8_BAR; PG8_MMA(1, 1, At, B1); PG8_BAR;
            }
        }
        if constexpr (ALIGN_EPI) { if (wr == 0) PG8_BAR; }
        if constexpr (FP8) asm volatile("s_nop 15\n\ts_nop 7" ::: "memory");
        { int te = threadIdx.x; asm volatile("" : "+v"(te));
          if constexpr (!NOEPI) E(acc, cur, wr, wc, te & 15, (te & 63) >> 4); else { float sink_ = 0.f; _Pragma("unroll") for (int a_ = 0; a_ < 2; ++a_) _Pragma("unroll") for (int b_ = 0; b_ < 2; ++b_) _Pragma("unroll") for (int m_ = 0; m_ < 4; ++m_) _Pragma("unroll") for (int n_ = 0; n_ < 2; ++n_) sink_ += acc[a_][b_][m_][n_][0]; asm volatile("" :: "v"(sink_)); } }
        if (!has_next) break;
#pragma unroll
        for (int a = 0; a < 2; ++a)
#pragma unroll
            for (int b = 0; b < 2; ++b)
#pragma unroll
                for (int m = 0; m < 4; ++m)
#pragma unroll
                    for (int n = 0; n < 2; ++n) acc[a][b][m][n] = (f32x4){0.f, 0.f, 0.f, 0.f};
        cur = nxt; cA = nA; cB = nB; ++ui;
        if constexpr (ALIGN_EPI) { if (wr == 1) PG8_BAR; }
    }
    PG8_WAIT_V(0);
    if constexpr (!ALIGN_EPI) { if (wr == 0) PG8_BAR; }
    PG8_BAR;
#undef PG8_GVOFF
#undef PG8_WAIT_V8R
#undef PG8_CAT
#undef PG8_SA
#undef PG8_SB
#undef PG8_STAGE
#undef PG8_LDA
#undef PG8_LDB
#undef PG8_MMA
#undef PG8_WAIT_V
#undef PG8_WAIT_L
#undef PG8_BAR
#undef PG8_SCHED
}
}

constexpr int NWAVES = 8;
constexpr int DM = 1024, NBATCH = 32, SEQ = 2048, MTOK = NBATCH * SEQ, DEPTH = 4, NEXP = 32, TOPK = 4;
constexpr int HG_N = 4096, RT_N = 6144, HG_H = 8, RT_H = 4;
constexpr float EPS = 1e-6f;
constexpr int LCAP = 65536;
constexpr int MAXTILES = 1056;

constexpr size_t MiB = 1u << 20;
constexpr size_t WS_CTL = 0, CTL_ZERO_BYTES = 1 * MiB;
constexpr size_t WS_MOD = 1 * MiB;
constexpr size_t WS_FMOD = 4 * MiB;
constexpr size_t WS_LBV = 4 * MiB + 512 * 1024;
constexpr size_t WS_HWIN = 8 * MiB, WS_HWOUT = 24 * MiB, WS_RWIN = 28 * MiB, WS_RWOUT = 52 * MiB, WS_W1T = 64 * MiB, WS_W2T = 576 * MiB;
constexpr size_t WS_H = 832 * MiB;
constexpr size_t WS_LIST = 960 * MiB;
constexpr size_t WS_TSLOT = 968 * MiB, WS_TGATE = 969 * MiB;
constexpr size_t WS_R1 = 976 * MiB;
constexpr size_t WS_R2 = 1744 * MiB;
constexpr size_t WS_H8 = 2272 * MiB;
constexpr size_t WS_END = 2336 * MiB;
constexpr int CW_BAR = 4096;
constexpr int CW_CNT = 8192;

constexpr int RING_OFF = 0, RING_BYTES = 131072;
constexpr int MISC_OFF = 155648;
constexpr int TAB_OFF = MISC_OFF + 128;
constexpr int LDS_BYTES = 160 * 1024;

#define GAS __attribute__((address_space(1)))
#define LAS __attribute__((address_space(3)))
typedef unsigned short bf16;
typedef unsigned v4u __attribute__((ext_vector_type(4)));
typedef unsigned v2u __attribute__((ext_vector_type(2)));
typedef float f32x4 __attribute__((ext_vector_type(4)));
typedef short bf16x8 __attribute__((ext_vector_type(8)));
#define RLX_AGENT __ATOMIC_RELAXED, __HIP_MEMORY_SCOPE_AGENT
#define LDS_WAIT() asm volatile("s_waitcnt lgkmcnt(0)" ::: "memory")
#define VM_WAIT() asm volatile("s_waitcnt vmcnt(0)" ::: "memory")
__device__ __forceinline__ unsigned pk2(float lo, float hi) { return pg8::cvt_pk_bf16(lo, hi); }
__device__ __forceinline__ unsigned pk4_fp8(float a, float b, float c, float d) { int p = 0; p = __builtin_amdgcn_cvt_pk_fp8_f32(a, b, p, false); p = __builtin_amdgcn_cvt_pk_fp8_f32(c, d, p, true); return (unsigned)p; }
__device__ __forceinline__ float bflo(unsigned w) { return __uint_as_float(w << 16); }
__device__ __forceinline__ float bfhi(unsigned w) { return __uint_as_float(w & 0xffff0000u); }
__device__ __forceinline__ float bf2f(unsigned short h) { return __uint_as_float(((unsigned)h) << 16); }
__device__ __forceinline__ float sigmoidf_(float x) { return __builtin_amdgcn_rcpf(1.f + __expf(-x)); }
__device__ __forceinline__ float siluf_(float x) { return x * sigmoidf_(x); }
__device__ __forceinline__ unsigned ldu_vec(const unsigned* p) { return __hip_atomic_load(p, RLX_AGENT); }

#define XB_TMO      128
#define XB_XCNT(j)  (256  + 64 * (j))
#define XB_XSUB(j)  (1280 + 64 * (j))
#define XB_XGEN(j)  (2304 + 64 * (j))
#define XB_TOP      3328
#define XB_TOPGEN   3392
#define XCD_BAR_WORDS 3456
#define XB_SPIN_CAP (1u << 18)

__device__ __forceinline__ unsigned xb_ld(unsigned* p)              { return __hip_atomic_load(p, __ATOMIC_RELAXED, __HIP_MEMORY_SCOPE_AGENT); }
__device__ __forceinline__ unsigned xb_add(unsigned* p, unsigned v) { return __hip_atomic_fetch_add(p, v, __ATOMIC_RELAXED, __HIP_MEMORY_SCOPE_AGENT); }
__device__ __forceinline__ unsigned xb_xcc_id() { return (unsigned)__builtin_amdgcn_s_getreg((3 << 11) | 20) & 0xFu; }
#define XB_SPIN(cond, bar) do { unsigned _sp = 0; while (cond) { __builtin_amdgcn_s_sleep(1); \
    if ((++_sp & 255u) == 0u) { if (xb_ld(&(bar)[XB_TMO])) break; if (_sp > XB_SPIN_CAP) { atomicAdd(&(bar)[XB_TMO], 1u); break; } } } } while (0)

struct XcdBarrier {
    unsigned* bar; unsigned x;
    volatile LAS unsigned* st;
};
__device__ __forceinline__ XcdBarrier xcd_barrier_post(unsigned* bar, volatile LAS unsigned* st) {
    XcdBarrier b; b.bar = bar; b.x = xb_xcc_id(); b.st = st;
    if (threadIdx.x == 0) (void)xb_add(&bar[XB_XCNT(b.x)], 1u);
    return b;
}
__device__ __forceinline__ void xcd_barrier_complete(unsigned* bar, unsigned x, unsigned& nloc, unsigned& nx) {
    const unsigned G = gridDim.x * gridDim.y * gridDim.z;
    unsigned sum, cnt, mine, sp = 0u;
    for (;;) {
        sum = 0u; cnt = 0u; mine = 0u;
#pragma unroll
        for (unsigned j = 0; j < 16; ++j) { const unsigned c = xb_ld(&bar[XB_XCNT(j)]); sum += c; cnt += (c > 0u) ? 1u : 0u; mine = (j == x) ? c : mine; }
        if (sum == G) break;
        __builtin_amdgcn_s_sleep(1);
        if ((++sp & 255u) == 0u) { if (xb_ld(&bar[XB_TMO])) break; if (sp > XB_SPIN_CAP) { atomicAdd(&bar[XB_TMO], 1u); break; } }
    }
    nloc = mine > 0u ? mine : 1u; nx = cnt > 0u ? cnt : 1u;
}
__device__ __forceinline__ void xcd_barrier(const XcdBarrier& b) {
    asm volatile("s_waitcnt vmcnt(0)" ::: "memory");
    __syncthreads();
    if (threadIdx.x == 0) {
        unsigned* bar = b.bar;
        __builtin_amdgcn_s_waitcnt(0);
        unsigned nloc = b.st[0], nx = b.st[1];
        if (nloc == 0u) { xcd_barrier_complete(bar, b.x, nloc, nx); b.st[0] = nloc; b.st[1] = nx; }
        const unsigned old = xb_add(&bar[XB_XSUB(b.x)], 1u);
        const unsigned gen = old / nloc;
        if (old + 1u == (gen + 1u) * nloc) {
            __builtin_amdgcn_fence(__ATOMIC_RELEASE, "agent");
            asm volatile("s_waitcnt vmcnt(0)" ::: "memory");
            const unsigned og = xb_add(&bar[XB_TOP], 1u);
            const unsigned tg = og / nx;
            if (og + 1u == (tg + 1u) * nx) xb_add(&bar[XB_TOPGEN], 1u);
            else XB_SPIN(xb_ld(&bar[XB_TOPGEN]) == tg, bar);
            __builtin_amdgcn_fence(__ATOMIC_ACQUIRE, "agent");
            xb_add(&bar[XB_XGEN(b.x)], 1u);
            asm volatile("s_waitcnt vmcnt(0)" ::: "memory");
        } else {
            XB_SPIN(xb_ld(&bar[XB_XGEN(b.x)]) == gen, bar);
            __builtin_amdgcn_fence(__ATOMIC_ACQUIRE, "agent");
            asm volatile("s_waitcnt vmcnt(0)" ::: "memory");
        }
    }
    __syncthreads();
}

struct Frame {
    LAS unsigned char* lds;
    unsigned* ctl;
    int tid, lane, wave, vcu, G;
    float* out; unsigned char* ws;
};
__device__ __forceinline__ void relaunder(Frame& F) { int t = threadIdx.x; asm volatile("" : "+v"(t)); F.tid = t; F.lane = t & 63; F.wave = __builtin_amdgcn_readfirstlane(t >> 6); }
#define KAS __attribute__((address_space(4)))
__device__ __forceinline__ const void* kin_(int i) { const KAS char* kp = (const KAS char*)__builtin_amdgcn_kernarg_segment_ptr(); asm volatile("" : "+s"(kp)); return *(const void* const KAS*)(kp + 8 * i); }
enum { I_X = 0, I_C, I_POS, I_ADAW, I_ADAB, I_N1G, I_N2G, I_HWIN, I_HWOUT, I_HGAIN, I_HLB, I_RWIN, I_RWOUT, I_RTW, I_RTB, I_W1, I_B1, I_W2, I_B2, I_FG, I_FADAW, I_FADAB };
#define KIN(i) ((const float*)kin_(i))
__device__ __forceinline__ float wave_sum(float v) {
#pragma unroll
    for (int o = 1; o < 64; o <<= 1) v += __shfl_xor(v, o);
    return v;
}

__device__ __forceinline__ void p0_transpose_item(const float* W, int N, bf16* WT, int K, int k0, int n0, int drow0, LAS float* scr, int lane) {
#pragma unroll 8
    for (int i = 0; i < 32; ++i) { const int kk = 2 * i + (lane >> 5); scr[kk * 33 + (lane & 31)] = W[(size_t)(k0 + kk) * N + n0 + (lane & 31)]; }
    LDS_WAIT(); asm volatile("" ::: "memory");
    const int c = lane & 7;
#pragma unroll
    for (int j = 0; j < 4; ++j) { const int n = (lane >> 3) + 8 * j; const LAS float* s = scr + (8 * c) * 33 + n;
        v4u o; o.x = pk2(s[0 * 33], s[1 * 33]); o.y = pk2(s[2 * 33], s[3 * 33]); o.z = pk2(s[4 * 33], s[5 * 33]); o.w = pk2(s[6 * 33], s[7 * 33]);
        *(GAS v4u*)(WT + (size_t)(drow0 + n) * K + k0 + 8 * c) = o; }
    LDS_WAIT(); asm volatile("" ::: "memory");
}
__device__ __forceinline__ void p0_transpose_item_f8(const float* W, int N, unsigned char* WT, int K, int k0, int n0, int drow0, LAS float* scr, int lane, float scale) {
#pragma unroll 8
    for (int i = 0; i < 32; ++i) { const int kk = 2 * i + (lane >> 5); scr[kk * 33 + (lane & 31)] = W[(size_t)(k0 + kk) * N + n0 + (lane & 31)]; }
    LDS_WAIT(); asm volatile("" ::: "memory");
    const int n = lane >> 1, hf = lane & 1; const LAS float* sp = scr + (32 * hf) * 33 + n;
    v4u o0, o1;
    o0.x = pk4_fp8(sp[0 * 33] * scale, sp[1 * 33] * scale, sp[2 * 33] * scale, sp[3 * 33] * scale); o0.y = pk4_fp8(sp[4 * 33] * scale, sp[5 * 33] * scale, sp[6 * 33] * scale, sp[7 * 33] * scale);
    o0.z = pk4_fp8(sp[8 * 33] * scale, sp[9 * 33] * scale, sp[10 * 33] * scale, sp[11 * 33] * scale); o0.w = pk4_fp8(sp[12 * 33] * scale, sp[13 * 33] * scale, sp[14 * 33] * scale, sp[15 * 33] * scale);
    o1.x = pk4_fp8(sp[16 * 33] * scale, sp[17 * 33] * scale, sp[18 * 33] * scale, sp[19 * 33] * scale); o1.y = pk4_fp8(sp[20 * 33] * scale, sp[21 * 33] * scale, sp[22 * 33] * scale, sp[23 * 33] * scale);
    o1.z = pk4_fp8(sp[24 * 33] * scale, sp[25 * 33] * scale, sp[26 * 33] * scale, sp[27 * 33] * scale); o1.w = pk4_fp8(sp[28 * 33] * scale, sp[29 * 33] * scale, sp[30 * 33] * scale, sp[31 * 33] * scale);
    unsigned char* d = WT + (size_t)(drow0 + n) * K + k0 + 32 * hf; *(GAS v4u*)d = o0; *(GAS v4u*)(d + 16) = o1;
    LDS_WAIT(); asm volatile("" ::: "memory");
}
__device__ __forceinline__ void p0_prologue(Frame& F) {
    relaunder(F);
    __syncthreads();
    const int gw = F.vcu * NWAVES + F.wave, NGW = F.G * NWAVES;
    {
        LAS float* condT = (LAS float*)(F.lds + RING_OFF);
        const float* cin = KIN(I_C);
        for (int idx = F.tid; idx < NBATCH * DM; idx += NWAVES * 64) { const int b = idx >> 10, k = idx & 1023; condT[k * 32 + b] = siluf_(cin[idx]); }
        __syncthreads();
        if ((gw & 3) == 0 && (gw >> 2) < 416) {
            const int u = gw >> 2; const float* W; const float* bias; float* outp; int N, n0, ostride;
            if (u < 384) { const int l = u / 96; n0 = (u % 96) * 64; N = 6 * DM; W = KIN(I_ADAW) + (size_t)l * DM * N; bias = KIN(I_ADAB) + l * N; outp = (float*)(F.ws + WS_MOD) + (size_t)l * NBATCH * N; ostride = N; }
            else { n0 = (u - 384) * 64; N = 2 * DM; W = KIN(I_FADAW); bias = KIN(I_FADAB); outp = (float*)(F.ws + WS_FMOD); ostride = N; }
            float acc[32];
#pragma unroll
            for (int b = 0; b < 32; ++b) acc[b] = 0.f;
#pragma unroll 4
            for (int k = 0; k < DM; ++k) {
                const float w = W[(size_t)k * N + n0 + F.lane];
                const LAS f32x4* cb = (const LAS f32x4*)(condT + k * 32);
#pragma unroll
                for (int q = 0; q < 8; ++q) { const f32x4 cv = cb[q]; acc[4 * q + 0] += cv.x * w; acc[4 * q + 1] += cv.y * w; acc[4 * q + 2] += cv.z * w; acc[4 * q + 3] += cv.w * w; }
            }
            const float bv = bias[n0 + F.lane];
#pragma unroll
            for (int b = 0; b < 32; ++b) outp[(size_t)b * ostride + n0 + F.lane] = acc[b] + bv;
        }
        if (gw == NGW - 1) {
            float* lbv = (float*)(F.ws + WS_LBV); const float* hlb = KIN(I_HLB);
            for (int d = F.lane; d < DM; d += 64) { const float a = hlb[d], b = hlb[DM + d], m = fmaxf(a, b), ea = __expf(a - m), eb = __expf(b - m); lbv[d] = 0.f; lbv[DM + d] = eb / (ea + eb); }
        }
        __syncthreads();
    }
    {
        LAS float* scr = (LAS float*)(F.lds + RING_OFF + F.wave * 16384);
        constexpr int NI_HI = 2 * 16 * 128, NI_HO = 2 * 16 * 32, NI_RI = 2 * 16 * 192, NI_RO = 2 * 32 * 32, NI_W1 = 128 * 16 * 64, NI_W2 = 128 * 16 * 32;
        constexpr int NITEMS = NI_HI + NI_HO + NI_RI + NI_RO + NI_W1 + NI_W2;
        for (int it = gw; it < NITEMS; it += NGW) {
            int r = it;
            if (r < NI_HI) { const int j = r / 2048, q = r % 2048, kb = q / 128, nb = q % 128;
                p0_transpose_item(KIN(I_HWIN) + (size_t)j * DM * HG_N, HG_N, (bf16*)(F.ws + WS_HWIN) + (size_t)j * HG_N * DM, DM, 64 * kb, 32 * nb, 32 * nb, scr, F.lane); continue; } r -= NI_HI;
            if (r < NI_HO) { const int j = r / 512, q = r % 512, kb = q / 32, nb = q % 32;
                p0_transpose_item(KIN(I_HWOUT) + (size_t)j * DM * DM, DM, (bf16*)(F.ws + WS_HWOUT) + (size_t)j * DM * DM, DM, 64 * kb, 32 * nb, 32 * nb, scr, F.lane); continue; } r -= NI_HO;
            if (r < NI_RI) { const int j = r / 3072, q = r % 3072, kb = q / 192, nb = q % 192;
                p0_transpose_item(KIN(I_RWIN) + (size_t)j * DM * RT_N, RT_N, (bf16*)(F.ws + WS_RWIN) + (size_t)j * RT_N * DM, DM, 64 * kb, 32 * nb, 32 * nb, scr, F.lane); continue; } r -= NI_RI;
            if (r < NI_RO) { const int j = r / 1024, q = r % 1024, kb = q / 32, nb = q % 32;
                p0_transpose_item(KIN(I_RWOUT) + (size_t)j * 2048 * DM, DM, (bf16*)(F.ws + WS_RWOUT) + (size_t)j * DM * 2048, 2048, 64 * kb, 32 * nb, 32 * nb, scr, F.lane); continue; } r -= NI_RO;
            if (r < NI_W1) { const int mi = r / 1024, q = r % 1024, kb = q / 64, nb = q % 64; const int n0 = 32 * nb;
                const int cc = n0 & 1023, drow0 = 256 * (cc >> 7) + (cc & 127) + ((n0 >= 1024) ? 128 : 0);
                if (MOE_FP8) p0_transpose_item_f8(KIN(I_W1) + (size_t)mi * DM * 2048, 2048, F.ws + WS_W1T + (size_t)mi * 2048 * DM, DM, 64 * kb, n0, drow0, scr, F.lane, 64.0f);
                else p0_transpose_item(KIN(I_W1) + (size_t)mi * DM * 2048, 2048, (bf16*)(F.ws + WS_W1T) + (size_t)mi * 2048 * DM, DM, 64 * kb, n0, drow0, scr, F.lane);
                continue; } r -= NI_W1;
            { const int mi = r / 512, q = r % 512, kb = q / 32, nb = q % 32;
                if (MOE_FP8) p0_transpose_item_f8(KIN(I_W2) + (size_t)mi * DM * DM, DM, F.ws + WS_W2T + (size_t)mi * DM * DM, DM, 64 * kb, 32 * nb, 32 * nb, scr, F.lane, 64.0f);
                else p0_transpose_item(KIN(I_W2) + (size_t)mi * DM * DM, DM, (bf16*)(F.ws + WS_W2T) + (size_t)mi * DM * DM, DM, 64 * kb, 32 * nb, 32 * nb, scr, F.lane); }
        }
    }
}

__device__ __forceinline__ void build_tiles(Frame& F, int l) {
    LAS int* ts = (LAS int*)(F.lds + TAB_OFF); LAS int* cnt = ts + 40;
    __syncthreads();
    if (F.tid < NEXP) cnt[F.tid] = (int)ldu_vec(F.ctl + CW_CNT + l * 2048 + F.tid * 64);
    __syncthreads();
    if (F.tid == 0) { int a = 0; for (int e = 0; e < NEXP; ++e) { ts[e] = a; a += (cnt[e] + 255) >> 8; } ts[NEXP] = a; }
    __syncthreads();
}

__device__ __forceinline__ void row_phase1(Frame& F, int l, int mode) {
    relaunder(F);
    const LAS int* ts = (const LAS int*)(F.lds + TAB_OFF);
    const bool comb = (l > 0);
    if (comb) build_tiles(F, l - 1);
    const float* xsrc = comb ? F.out : KIN(I_X);
    const bf16* Y = (const bf16*)(F.ws + WS_R1);
    const unsigned* tslot = (const unsigned*)(F.ws + WS_TSLOT); const unsigned* tgate = (const unsigned*)(F.ws + WS_TGATE);
    bf16* H = (bf16*)(F.ws + WS_H);
    for (int rb = F.vcu * 256; rb < MTOK; rb += F.G * 256) {
        const int b = rb / SEQ;
        f32x4 A[4], B[4], G2[4];
#pragma unroll
        for (int j = 0; j < 4; ++j) {
            const int c = 4 * F.lane + 256 * j;
            if (mode == 0) { const float* mv = (const float*)(F.ws + WS_MOD) + (size_t)(l * NBATCH + b) * 6 * DM;
                const f32x4 g = *(const f32x4*)(KIN(I_N1G) + l * DM + c), sc = *(const f32x4*)(mv + 1 * DM + c); A[j] = g * (sc + 1.0f); B[j] = *(const f32x4*)(mv + c); }
            else { const float* fm = (const float*)(F.ws + WS_FMOD) + (size_t)b * 2 * DM;
                const f32x4 g = *(const f32x4*)(KIN(I_FG) + c), sc = *(const f32x4*)(fm + DM + c); A[j] = g * (sc + 1.0f); B[j] = *(const f32x4*)(fm + c); }
            if (comb) G2[j] = *(const f32x4*)((const float*)(F.ws + WS_MOD) + (size_t)((l - 1) * NBATCH + b) * 6 * DM + 5 * DM + c); else G2[j] = (f32x4){0.f, 0.f, 0.f, 0.f};
        }
        for (int r = 0; r < 32; ++r) {
            const int row = rb + 32 * F.wave + r;
            f32x4 v[4];
#pragma unroll
            for (int j = 0; j < 4; ++j) v[j] = *(const f32x4*)(xsrc + (size_t)row * DM + 4 * F.lane + 256 * j);
            if (comb) {
                const unsigned sl = tslot[(size_t)row * 4 + (F.lane & 3)], gt = tgate[(size_t)row * 4 + (F.lane & 3)];
                f32x4 ys[4];
#pragma unroll
                for (int j = 0; j < 4; ++j) ys[j] = (f32x4){0.f, 0.f, 0.f, 0.f};
#pragma unroll
                for (int k = 0; k < TOPK; ++k) {
                    const unsigned s = (unsigned)__shfl((int)sl, k); const float gk = __uint_as_float((unsigned)__shfl((int)gt, k));
                    const int e = (int)(s >> 20), pos = (int)(s & 0xFFFFFu); const size_t yrow = (size_t)ts[e] * 256 + pos;
#pragma unroll
                    for (int j = 0; j < 4; ++j) { const v2u w = *(const v2u*)(Y + yrow * DM + 4 * F.lane + 256 * j);
                        ys[j].x += gk * bflo(w.x); ys[j].y += gk * bfhi(w.x); ys[j].z += gk * bflo(w.y); ys[j].w += gk * bfhi(w.y); }
                }
#pragma unroll
                for (int j = 0; j < 4; ++j) v[j] = v[j] + G2[j] * ys[j];
                if (mode == 0) {
#pragma unroll
                    for (int j = 0; j < 4; ++j) *(f32x4*)(F.out + (size_t)row * DM + 4 * F.lane + 256 * j) = v[j];
                }
            }
            float s2 = 0.f;
#pragma unroll
            for (int j = 0; j < 4; ++j) s2 += (v[j].x * v[j].x + v[j].y * v[j].y) + (v[j].z * v[j].z + v[j].w * v[j].w);
            const float rstd = 1.0f / sqrtf(wave_sum(s2) * (1.0f / DM) + EPS);
            if (mode == 0) {
#pragma unroll
                for (int j = 0; j < 4; ++j) { const f32x4 h = v[j] * rstd * A[j] + B[j]; v2u w; w.x = pk2(h.x, h.y); w.y = pk2(h.z, h.w); *(v2u*)(H + (size_t)row * DM + 4 * F.lane + 256 * j) = w; }
            } else {
#pragma unroll
                for (int j = 0; j < 4; ++j) *(f32x4*)(F.out + (size_t)row * DM + 4 * F.lane + 256 * j) = v[j] * rstd * A[j] + B[j];
            }
        }
    }
}

__device__ __forceinline__ void row_phase2(Frame& F, int l) {
    relaunder(F);
    bf16* H = (bf16*)(F.ws + WS_H);
    LAS unsigned char* frag = F.lds + RING_OFF;
    LAS float* lg = (LAS float*)(F.lds + 131072 + F.wave * 2112);
    LAS int* cntL = (LAS int*)(F.lds + 147968); LAS int* baseL = cntL + 32; LAS float* rbias = (LAS float*)(cntL + 64);
    unsigned* list = (unsigned*)(F.ws + WS_LIST); unsigned* tslot = (unsigned*)(F.ws + WS_TSLOT); float* tgate = (float*)(F.ws + WS_TGATE);
    __syncthreads();
    { const float* rw = KIN(I_RTW) + (size_t)l * DM * NEXP;
      for (int it = F.tid; it < 32 * 2 * 64; it += NWAVES * 64) { const int ln = it & 63, nt = (it >> 6) & 1, s = it >> 7; const int e = 16 * nt + (ln & 15), k0 = 32 * s + 8 * (ln >> 4);
          float w[8], hi[8];
#pragma unroll
          for (int j = 0; j < 8; ++j) { w[j] = rw[(size_t)(k0 + j) * NEXP + e]; }
          v4u ph, pl;
          { unsigned a = pk2(w[0], w[1]), b2 = pk2(w[2], w[3]), c2 = pk2(w[4], w[5]), d2 = pk2(w[6], w[7]); ph = (v4u){a, b2, c2, d2};
            hi[0] = bflo(a); hi[1] = bfhi(a); hi[2] = bflo(b2); hi[3] = bfhi(b2); hi[4] = bflo(c2); hi[5] = bfhi(c2); hi[6] = bflo(d2); hi[7] = bfhi(d2); }
          pl = (v4u){pk2(w[0] - hi[0], w[1] - hi[1]), pk2(w[2] - hi[2], w[3] - hi[3]), pk2(w[4] - hi[4], w[5] - hi[5]), pk2(w[6] - hi[6], w[7] - hi[7])};
          *(LAS v4u*)(frag + ((s * 2 + nt) * 2 + 0) * 1024 + ln * 16) = ph; *(LAS v4u*)(frag + ((s * 2 + nt) * 2 + 1) * 1024 + ln * 16) = pl; }
      if (F.tid < NEXP) rbias[F.tid] = KIN(I_RTB)[l * NEXP + F.tid];
    }
    for (int rb = F.vcu * 256; rb < MTOK; rb += F.G * 256) {
        const int b = rb / SEQ;
        if (F.tid < NEXP) cntL[F.tid] = 0;
        __syncthreads();
        {
            f32x4 A[4], B[4];
            const float* mv = (const float*)(F.ws + WS_MOD) + (size_t)(l * NBATCH + b) * 6 * DM;
#pragma unroll
            for (int j = 0; j < 4; ++j) { const int c = 4 * F.lane + 256 * j; const f32x4 g = *(const f32x4*)(KIN(I_N2G) + l * DM + c), sc = *(const f32x4*)(mv + 4 * DM + c); A[j] = g * (sc + 1.0f); B[j] = *(const f32x4*)(mv + 3 * DM + c); }
            for (int r = 0; r < 32; ++r) {
                const int row = rb + 32 * F.wave + r;
                f32x4 v[4]; float s2 = 0.f;
#pragma unroll
                for (int j = 0; j < 4; ++j) { v[j] = *(const f32x4*)(F.out + (size_t)row * DM + 4 * F.lane + 256 * j); s2 += (v[j].x * v[j].x + v[j].y * v[j].y) + (v[j].z * v[j].z + v[j].w * v[j].w); }
                const float rstd = 1.0f / sqrtf(wave_sum(s2) * (1.0f / DM) + EPS);
#pragma unroll
                for (int j = 0; j < 4; ++j) { const f32x4 h = v[j] * rstd * A[j] + B[j]; v2u w; w.x = pk2(h.x, h.y); w.y = pk2(h.z, h.w); *(v2u*)(H + (size_t)row * DM + 4 * F.lane + 256 * j) = w;
                    if (MOE_FP8) *(unsigned*)(F.ws + WS_H8 + (size_t)row * DM + 4 * F.lane + 256 * j) = pk4_fp8(h.x * 8.0f, h.y * 8.0f, h.z * 8.0f, h.w * 8.0f); }
            }
        }
        VM_WAIT();
        int my_e[2][TOPK], my_lp[2][TOPK]; float my_g[2][TOPK];
#pragma unroll
        for (int grp = 0; grp < 2; ++grp) {
            const int row0 = rb + 32 * F.wave + 16 * grp;
            f32x4 acc0 = (f32x4){0.f, 0.f, 0.f, 0.f}, acc1 = (f32x4){0.f, 0.f, 0.f, 0.f};
            const unsigned long long* ap = (const unsigned long long*)(H + (size_t)(row0 + (F.lane & 15)) * DM + 8 * (F.lane >> 4));
#pragma unroll 4
            for (int s = 0; s < 32; ++s) {
                const unsigned long long lo = __hip_atomic_load(ap + 8 * s, RLX_AGENT), hi = __hip_atomic_load(ap + 8 * s + 1, RLX_AGENT);
                v4u av = (v4u){(unsigned)lo, (unsigned)(lo >> 32), (unsigned)hi, (unsigned)(hi >> 32)}; const bf16x8 a = __builtin_bit_cast(bf16x8, av);
                const bf16x8 b00 = *(const LAS bf16x8*)(frag + ((s * 2 + 0) * 2 + 0) * 1024 + F.lane * 16), b01 = *(const LAS bf16x8*)(frag + ((s * 2 + 0) * 2 + 1) * 1024 + F.lane * 16);
                const bf16x8 b10 = *(const LAS bf16x8*)(frag + ((s * 2 + 1) * 2 + 0) * 1024 + F.lane * 16), b11 = *(const LAS bf16x8*)(frag + ((s * 2 + 1) * 2 + 1) * 1024 + F.lane * 16);
                acc0 = __builtin_amdgcn_mfma_f32_16x16x32_bf16(a, b00, acc0, 0, 0, 0); acc0 = __builtin_amdgcn_mfma_f32_16x16x32_bf16(a, b01, acc0, 0, 0, 0);
                acc1 = __builtin_amdgcn_mfma_f32_16x16x32_bf16(a, b10, acc1, 0, 0, 0); acc1 = __builtin_amdgcn_mfma_f32_16x16x32_bf16(a, b11, acc1, 0, 0, 0);
            }
#pragma unroll
            for (int q = 0; q < 4; ++q) { lg[(4 * (F.lane >> 4) + q) * 33 + (F.lane & 15)] = acc0[q]; lg[(4 * (F.lane >> 4) + q) * 33 + 16 + (F.lane & 15)] = acc1[q]; }
            LDS_WAIT(); asm volatile("" ::: "memory");
            if (F.lane < 16) {
                unsigned taken = 0u; float tl[TOPK];
#pragma unroll
                for (int k = 0; k < TOPK; ++k) {
                    float best = -3.0e38f; int bi = 0;
                    for (int e = 0; e < NEXP; ++e) { const float v = lg[F.lane * 33 + e] + rbias[e]; if (!((taken >> e) & 1u) && v > best) { best = v; bi = e; } }
                    taken |= 1u << bi; my_e[grp][k] = bi; tl[k] = best;
                }
                float den = 0.f, ex[TOPK];
#pragma unroll
                for (int k = 0; k < TOPK; ++k) { ex[k] = __expf(tl[k] - tl[0]); den += ex[k]; }
#pragma unroll
                for (int k = 0; k < TOPK; ++k) { my_g[grp][k] = ex[k] / den; my_lp[grp][k] = __hip_atomic_fetch_add(&cntL[my_e[grp][k]], 1, __ATOMIC_RELAXED, __HIP_MEMORY_SCOPE_WORKGROUP); }
            } else {
#pragma unroll
                for (int k = 0; k < TOPK; ++k) { my_e[grp][k] = 0; my_lp[grp][k] = 0; my_g[grp][k] = 0.f; }
            }
            LDS_WAIT(); asm volatile("" ::: "memory");
        }
        __syncthreads();
        if (F.tid < NEXP) baseL[F.tid] = (int)__hip_atomic_fetch_add(F.ctl + CW_CNT + l * 2048 + F.tid * 64, (unsigned)cntL[F.tid], RLX_AGENT);
        __syncthreads();
        if (F.lane < 16) {
#pragma unroll
            for (int grp = 0; grp < 2; ++grp) {
                const int row = rb + 32 * F.wave + 16 * grp + F.lane;
#pragma unroll
                for (int k = 0; k < TOPK; ++k) { const int e = my_e[grp][k], pos = baseL[e] + my_lp[grp][k];
                    list[(size_t)e * LCAP + pos] = (unsigned)row; tslot[(size_t)row * 4 + k] = ((unsigned)e << 20) | (unsigned)pos; tgate[(size_t)row * 4 + k] = my_g[grp][k]; }
            }
        }
        __syncthreads();
    }
}

__device__ __forceinline__ void moe_gather(Frame& F, int l) {
    relaunder(F);
    build_tiles(F, l);
    const LAS int* ts = (const LAS int*)(F.lds + TAB_OFF); const LAS int* cnt = ts + 40;
    const unsigned* list = (const unsigned*)(F.ws + WS_LIST); const bf16* H = (const bf16*)(F.ws + WS_H); bf16* Xg = (bf16*)(F.ws + WS_R1);
    const int gw = F.vcu * NWAVES + F.wave, NGW = F.G * NWAVES, NR = ts[NEXP] * 256;
    for (int r = gw; r < NR; r += NGW) {
        const int mt = r >> 8; int e = 0;
        for (int k = 1; k < NEXP; ++k) e += (ts[k] <= mt) ? 1 : 0;
        const int pos = r - ts[e] * 256;
        unsigned tok = 0u; if (pos < cnt[e]) tok = ldu_vec(list + (size_t)e * LCAP + pos);
        const v4u* src = (const v4u*)(H + (size_t)tok * DM); v4u* dst = (v4u*)(Xg + (size_t)r * DM);
        dst[F.lane] = src[F.lane]; dst[F.lane + 64] = src[F.lane + 64];
    }
}

__device__ __forceinline__ void moe_build_tt(Frame& F, int nN) {
    const LAS int* ts = (const LAS int*)(F.lds + TAB_OFF); const LAS int* cnt = ts + 40;
    LAS unsigned short* tt = (LAS unsigned short*)(F.lds + 131072);
    const unsigned* list = (const unsigned*)(F.ws + WS_LIST); const long NU = (long)ts[NEXP] * nN;
    for (int j = 0; j < 17; ++j) { const int i = 2 * j + (F.tid >> 8), r = F.tid & 255; const long L = (long)i * F.G + F.vcu;
        if (L < NU) { const int mt = (int)(L / nN); int e = 0;
            for (int k = 1; k < NEXP; ++k) e += (ts[k] <= mt) ? 1 : 0;
            const int pos = (mt - ts[e]) * 256 + r; unsigned tok = 0u; if (pos < cnt[e]) tok = list[(size_t)e * LCAP + pos];
            tt[i * 256 + r] = (unsigned short)tok; } }
    __syncthreads();
}

using pg8::Unit;
__device__ __forceinline__ v4u pack8(const f32x4 a, const f32x4 b) { v4u w; w.x = pk2(a.x, a.y); w.y = pk2(a.z, a.w); w.z = pk2(b.x, b.y); w.w = pk2(b.z, b.w); return w; }

struct EpiHgrnIn {
    static constexpr bool PERM = true; static constexpr int NST = 16;
    unsigned char* r1; const float* lb;
    __device__ __forceinline__ void operator()(const f32x4 (&acc)[2][2][4][2], const Unit& u, int wr, int wc, int fr, int fq) const {
        const int seg = u.pn >> 2, row0 = u.pm * 256 + wr * 64 + fr, cs0 = (u.pn & 3) * 256 + wc * 32 + 8 * fq;
        if (seg == 1) {
            bf16* K = (bf16*)(r1 + 128 * MiB); float* LF = (float*)(r1 + 512 * MiB);
#pragma unroll
            for (int bj = 0; bj < 2; ++bj) {
                f32x4 lbv[2]; lbv[0] = *(const f32x4*)(lb + cs0 + bj * 128); lbv[1] = *(const f32x4*)(lb + cs0 + bj * 128 + 4);
#pragma unroll
                for (int ai = 0; ai < 2; ++ai)
#pragma unroll
                    for (int m = 0; m < 4; ++m) { const size_t ro = (size_t)(row0 + ai * 128 + m * 16) * DM + cs0 + bj * 128; f32x4 kk[2], lf[2];
#pragma unroll
                        for (int n = 0; n < 2; ++n)
#pragma unroll
                            for (int j = 0; j < 4; ++j) { const float f = fminf(fmaxf(acc[ai][bj][m][n][j], -60.f), 60.f), l0 = lbv[n][j], ef = __expf(f);
                                const float sg = ef * __builtin_amdgcn_rcpf(1.f + ef), sgm = __builtin_amdgcn_rcpf(1.f + ef);
                                lf[n][j] = __logf(l0 + (1.f - l0) * sg); kk[n][j] = (1.f - l0) * sgm; }
                        *(v4u*)(K + ro) = pack8(kk[0], kk[1]); *(f32x4*)(LF + ro) = lf[0]; *(f32x4*)(LF + ro + 4) = lf[1];
                        __builtin_amdgcn_sched_barrier(0); }
            }
        } else {
            bf16* dst = (bf16*)(r1 + (seg == 0 ? 0 : (seg == 2 ? 256 * MiB : 384 * MiB))); const bool act = (seg != 2);
#pragma unroll
            for (int ai = 0; ai < 2; ++ai)
#pragma unroll
                for (int m = 0; m < 4; ++m) { const size_t ro = (size_t)(row0 + ai * 128 + m * 16) * DM;
#pragma unroll
                    for (int bj = 0; bj < 2; ++bj) { f32x4 v0 = acc[ai][bj][m][0], v1 = acc[ai][bj][m][1];
                        if (act) {
#pragma unroll
                            for (int j = 0; j < 4; ++j) { v0[j] = siluf_(v0[j]); v1[j] = siluf_(v1[j]); } }
                        *(v4u*)(dst + ro + cs0 + bj * 128) = pack8(v0, v1); }
                    __builtin_amdgcn_sched_barrier(0); }
        }
    }
};

struct EpiRetIn {
    static constexpr bool PERM = true; static constexpr int NST = 16;
    unsigned char* r1; const int* positions;
    __device__ __forceinline__ void operator()(const f32x4 (&acc)[2][2][4][2], const Unit& u, int wr, int wc, int fr, int fq) const {
        const int row0 = u.pm * 256 + wr * 64 + fr, cl = wc * 32 + 8 * fq;
        if (u.pn < 8) {
            bf16* dst = (bf16*)(r1 + ((u.pn < 4) ? 0 : 128 * MiB)); const float sc = (u.pn < 4) ? 1.0f : 0.0625f; const int hh = u.pn & 3;
            float invrev[2][4];
#pragma unroll
            for (int n = 0; n < 2; ++n)
#pragma unroll
                for (int j = 0; j < 4; ++j) invrev[n][j] = exp2f(-(float)(cl + 4 * n + j) * 0.10462765653188542f) * 0.15915494309189535f;
#pragma unroll
            for (int ai = 0; ai < 2; ++ai)
#pragma unroll
                for (int m = 0; m < 4; ++m) { const int row = row0 + ai * 128 + m * 16; const float pos = (float)positions[row]; const size_t ro = (size_t)row * DM + hh * 256 + cl;
                    f32x4 o1[2], o2[2];
#pragma unroll
                    for (int n = 0; n < 2; ++n)
#pragma unroll
                        for (int j = 0; j < 4; ++j) { const float rev = pos * invrev[n][j], fr_ = rev - floorf(rev); const float cs = __builtin_amdgcn_cosf(fr_), sn = __builtin_amdgcn_sinf(fr_);
                            const float x1 = acc[ai][0][m][n][j], x2 = acc[ai][1][m][n][j]; o1[n][j] = (x1 * cs - x2 * sn) * sc; o2[n][j] = (x2 * cs + x1 * sn) * sc; }
                    *(v4u*)(dst + ro) = pack8(o1[0], o1[1]); *(v4u*)(dst + ro + 128) = pack8(o2[0], o2[1]); }
        } else {
            const bool isg = (u.pn >= 16); bf16* dst = (bf16*)(r1 + (isg ? 512 * MiB : 256 * MiB)); const int ct = (isg ? u.pn - 16 : u.pn - 8) * 256 + cl;
#pragma unroll
            for (int ai = 0; ai < 2; ++ai)
#pragma unroll
                for (int m = 0; m < 4; ++m) { const size_t ro = (size_t)(row0 + ai * 128 + m * 16) * 2048 + ct;
#pragma unroll
                    for (int bj = 0; bj < 2; ++bj) { f32x4 v0 = acc[ai][bj][m][0], v1 = acc[ai][bj][m][1];
                        if (isg) {
#pragma unroll
                            for (int j = 0; j < 4; ++j) { v0[j] = siluf_(v0[j]); v1[j] = siluf_(v1[j]); } }
                        *(v4u*)(dst + ro + bj * 128) = pack8(v0, v1); } }
        }
    }
};

struct EpiOut {
    static constexpr bool PERM = false; static constexpr int NST = 8;
    const float* xin; float* xout; const float* gate;
    __device__ __forceinline__ void operator()(const f32x4 (&acc)[2][2][4][2], const Unit& u, int wr, int wc, int fr, int fq) const {
        const int row0 = u.pm * 256 + wr * 64 + fr, col0 = u.pn * 256 + wc * 32 + 4 * fq, b = (u.pm * 256) / SEQ;
        f32x4 gv[2][2];
#pragma unroll
        for (int bj = 0; bj < 2; ++bj)
#pragma unroll
            for (int n = 0; n < 2; ++n) gv[bj][n] = *(const f32x4*)(gate + (size_t)b * 6 * DM + col0 + bj * 128 + n * 16);
#pragma unroll
        for (int ai = 0; ai < 2; ++ai)
#pragma unroll
            for (int mp = 0; mp < 2; ++mp) { f32x4 xi[2][2][2];
#pragma unroll
                for (int mm = 0; mm < 2; ++mm)
#pragma unroll
                    for (int bj = 0; bj < 2; ++bj)
#pragma unroll
                        for (int n = 0; n < 2; ++n) xi[mm][bj][n] = *(const f32x4*)(xin + (size_t)(row0 + ai * 128 + (2 * mp + mm) * 16) * DM + col0 + bj * 128 + n * 16);
#pragma unroll
                for (int mm = 0; mm < 2; ++mm)
#pragma unroll
                    for (int bj = 0; bj < 2; ++bj)
#pragma unroll
                        for (int n = 0; n < 2; ++n) *(f32x4*)(xout + (size_t)(row0 + ai * 128 + (2 * mp + mm) * 16) * DM + col0 + bj * 128 + n * 16) = xi[mm][bj][n] + gv[bj][n] * acc[ai][bj][2 * mp + mm][n];
                asm volatile("" ::: "memory"); }
    }
};

struct EpiMoe1F8 {
    static constexpr bool PERM = true; static constexpr int NST = 8;
    unsigned char* A2; const float* b1;
    __device__ __forceinline__ void operator()(const f32x4 (&acc)[2][2][4][2], const Unit& u, int wr, int wc, int fr, int fq) const {
        const int row0 = u.pm * 256 + wr * 64 + fr, gc = u.nn * 128 + wc * 32 + 8 * fq; const float* bp = b1 + (size_t)u.e * 2048;
        f32x4 bg[2], bl[2];
#pragma unroll
        for (int n = 0; n < 2; ++n) { bg[n] = *(const f32x4*)(bp + gc + 4 * n); bl[n] = *(const f32x4*)(bp + 1024 + gc + 4 * n); }
#pragma unroll
        for (int ai = 0; ai < 2; ++ai)
#pragma unroll
            for (int m = 0; m < 4; ++m) { f32x4 o[2];
#pragma unroll
                for (int n = 0; n < 2; ++n)
#pragma unroll
                    for (int j = 0; j < 4; ++j) { const float g = fminf(acc[ai][0][m][n][j] * (1.0f / 512.f) + bg[n][j], 7.0f), li = fminf(fmaxf(acc[ai][1][m][n][j] * (1.0f / 512.f) + bl[n][j], -7.0f), 7.0f);
                        o[n][j] = g * sigmoidf_(1.702f * g) * (li + 1.0f) * 4.0f; }
                v2u w; w.x = pk4_fp8(o[0].x, o[0].y, o[0].z, o[0].w); w.y = pk4_fp8(o[1].x, o[1].y, o[1].z, o[1].w);
                *(v2u*)(A2 + (size_t)(row0 + ai * 128 + m * 16) * DM + gc) = w; }
    }
};
struct EpiMoe1 {
    static constexpr bool PERM = true; static constexpr int NST = 8;
    bf16* A2; const float* b1;
    __device__ __forceinline__ void operator()(const f32x4 (&acc)[2][2][4][2], const Unit& u, int wr, int wc, int fr, int fq) const {
        const int row0 = u.pm * 256 + wr * 64 + fr, gc = u.nn * 128 + wc * 32 + 8 * fq; const float* bp = b1 + (size_t)u.e * 2048;
        f32x4 bg[2], bl[2];
#pragma unroll
        for (int n = 0; n < 2; ++n) { bg[n] = *(const f32x4*)(bp + gc + 4 * n); bl[n] = *(const f32x4*)(bp + 1024 + gc + 4 * n); }
#pragma unroll
        for (int ai = 0; ai < 2; ++ai)
#pragma unroll
            for (int m = 0; m < 4; ++m) { f32x4 o[2];
#pragma unroll
                for (int n = 0; n < 2; ++n)
#pragma unroll
                    for (int j = 0; j < 4; ++j) { const float g = fminf(acc[ai][0][m][n][j] + bg[n][j], 7.0f), li = fminf(fmaxf(acc[ai][1][m][n][j] + bl[n][j], -7.0f), 7.0f);
                        o[n][j] = g * sigmoidf_(1.702f * g) * (li + 1.0f); }
                *(v4u*)(A2 + (size_t)(row0 + ai * 128 + m * 16) * DM + gc) = pack8(o[0], o[1]); }
    }
};

struct EpiMoe2 {
    static constexpr bool PERM = true; static constexpr int NST = 16;
    bf16* Y; const float* b2; float sc;
    __device__ __forceinline__ void operator()(const f32x4 (&acc)[2][2][4][2], const Unit& u, int wr, int wc, int fr, int fq) const {
        const int row0 = u.pm * 256 + wr * 64 + fr, c0 = u.nn * 256 + wc * 32 + 8 * fq; const float* bp = b2 + (size_t)u.e * DM;
        f32x4 bv[2][2];
#pragma unroll
        for (int bj = 0; bj < 2; ++bj)
#pragma unroll
            for (int n = 0; n < 2; ++n) bv[bj][n] = *(const f32x4*)(bp + c0 + bj * 128 + 4 * n);
#pragma unroll
        for (int ai = 0; ai < 2; ++ai)
#pragma unroll
            for (int m = 0; m < 4; ++m) { const size_t ro = (size_t)(row0 + ai * 128 + m * 16) * DM + c0;
#pragma unroll
                for (int bj = 0; bj < 2; ++bj) *(v4u*)(Y + ro + bj * 128) = pack8(acc[ai][bj][m][0] * sc + bv[bj][0], acc[ai][bj][m][1] * sc + bv[bj][1]); }
    }
};

__device__ __forceinline__ void hgrn_scan(Frame& F, int j) {
    relaunder(F);
    const bf16* Q = (const bf16*)(F.ws + WS_R1); const bf16* K = (const bf16*)(F.ws + WS_R1 + 128 * MiB); const bf16* V = (const bf16*)(F.ws + WS_R1 + 256 * MiB); const bf16* SG = (const bf16*)(F.ws + WS_R1 + 384 * MiB);
    const float* LF = (const float*)(F.ws + WS_R1 + 512 * MiB); bf16* O = (bf16*)(F.ws + WS_R2);
    LAS float* Qs = (LAS float*)(F.lds); LAS float* Ks = Qs + 4096; LAS float* Fs = Qs + 8192; LAS float* Vs = Qs + 12288; LAS float* P = Qs + 16384;
    const int v = F.tid & 127, kq = F.tid >> 7, t16 = F.tid >> 4, c8 = (F.tid & 15) * 8;
    f32x4 gain0 = *(const f32x4*)(KIN(I_HGAIN) + j * 128 + c8), gain1 = *(const f32x4*)(KIN(I_HGAIN) + j * 128 + c8 + 4);
    for (int u = F.vcu; u < NBATCH * HG_H; u += F.G) {
        const int b = u / HG_H, h = u % HG_H;
        float S[32];
#pragma unroll
        for (int i = 0; i < 32; ++i) S[i] = 0.f;
        for (int ch = 0; ch < SEQ / 32; ++ch) {
            const int row0 = b * SEQ + 32 * ch; const size_t gi = (size_t)(row0 + t16) * DM + h * 128 + c8;
            __syncthreads();
            { const v4u q = *(const v4u*)(Q + gi), k = *(const v4u*)(K + gi), vv = *(const v4u*)(V + gi); const f32x4 l0 = *(const f32x4*)(LF + gi), l1 = *(const f32x4*)(LF + gi + 4);
              LAS f32x4* d;
              d = (LAS f32x4*)(Qs + t16 * 128 + c8); d[0] = (f32x4){bflo(q.x), bfhi(q.x), bflo(q.y), bfhi(q.y)}; d[1] = (f32x4){bflo(q.z), bfhi(q.z), bflo(q.w), bfhi(q.w)};
              d = (LAS f32x4*)(Ks + t16 * 128 + c8); d[0] = (f32x4){bflo(k.x), bfhi(k.x), bflo(k.y), bfhi(k.y)}; d[1] = (f32x4){bflo(k.z), bfhi(k.z), bflo(k.w), bfhi(k.w)};
              d = (LAS f32x4*)(Vs + t16 * 128 + c8); d[0] = (f32x4){bflo(vv.x), bfhi(vv.x), bflo(vv.y), bfhi(vv.y)}; d[1] = (f32x4){bflo(vv.z), bfhi(vv.z), bflo(vv.w), bfhi(vv.w)};
              d = (LAS f32x4*)(Fs + t16 * 128 + c8); d[0] = (f32x4){__expf(l0.x), __expf(l0.y), __expf(l0.z), __expf(l0.w)}; d[1] = (f32x4){__expf(l1.x), __expf(l1.y), __expf(l1.z), __expf(l1.w)}; }
            __syncthreads();
            for (int t = 0; t < 32; ++t) {
                const float vt = Vs[t * 128 + v]; float a = 0.f;
#pragma unroll
                for (int i4 = 0; i4 < 8; ++i4) { const f32x4 f4 = *(const LAS f32x4*)(Fs + t * 128 + 32 * kq + 4 * i4), k4 = *(const LAS f32x4*)(Ks + t * 128 + 32 * kq + 4 * i4), q4 = *(const LAS f32x4*)(Qs + t * 128 + 32 * kq + 4 * i4);
#pragma unroll
                    for (int i = 0; i < 4; ++i) { S[4 * i4 + i] = f4[i] * S[4 * i4 + i] + k4[i] * vt; a += q4[i] * S[4 * i4 + i]; } }
                P[(t * 4 + kq) * 128 + v] = a;
            }
            __syncthreads();
            { f32x4 o0 = (f32x4){0.f, 0.f, 0.f, 0.f}, o1 = o0;
#pragma unroll
              for (int q = 0; q < 4; ++q) { o0 += *(const LAS f32x4*)(P + (t16 * 4 + q) * 128 + c8); o1 += *(const LAS f32x4*)(P + (t16 * 4 + q) * 128 + c8 + 4); }
              float ss = (o0.x * o0.x + o0.y * o0.y) + (o0.z * o0.z + o0.w * o0.w) + (o1.x * o1.x + o1.y * o1.y) + (o1.z * o1.z + o1.w * o1.w);
              ss += __shfl_xor(ss, 1); ss += __shfl_xor(ss, 2); ss += __shfl_xor(ss, 4); ss += __shfl_xor(ss, 8);
              const float r = 1.0f / sqrtf(ss * (1.0f / 128.f) + EPS);
              const v4u sg = *(const v4u*)(SG + gi);
              f32x4 a0 = o0 * r * gain0, a1 = o1 * r * gain1;
              a0.x *= bflo(sg.x); a0.y *= bfhi(sg.x); a0.z *= bflo(sg.y); a0.w *= bfhi(sg.y); a1.x *= bflo(sg.z); a1.y *= bfhi(sg.z); a1.z *= bflo(sg.w); a1.w *= bfhi(sg.w);
              *(v4u*)(O + gi) = pack8(a0, a1); }
        }
    }
}

__device__ __forceinline__ void ret_scan(Frame& F) {
    relaunder(F);
    const bf16* Q = (const bf16*)(F.ws + WS_R1); const bf16* K = (const bf16*)(F.ws + WS_R1 + 128 * MiB); const bf16* V = (const bf16*)(F.ws + WS_R1 + 256 * MiB); const bf16* SG = (const bf16*)(F.ws + WS_R1 + 512 * MiB);
    bf16* O = (bf16*)(F.ws + WS_R2);
    LAS bf16* Qs = (LAS bf16*)(F.lds); LAS bf16* Ks = (LAS bf16*)(F.lds + 33792); LAS bf16* Vs = (LAS bf16*)(F.lds + 67584);
    LAS float* St = (LAS float*)(F.lds + 133120); LAS float* wred = (LAS float*)(F.lds + 149504); LAS float* rtab = (LAS float*)(F.lds + 151552);
    for (int u = F.vcu; u < NBATCH * RT_H * 16; u += F.G) {
        const int bh = u >> 4, cp = u & 15, b = bh >> 2, h = bh & 3;
        const float lg2g = log2f(1.0f - exp2f(-5.0f - (float)h));
        for (int half = 0; half < 2; ++half) {
            const int c = half ? 31 - cp : cp; const int row0 = b * SEQ + 64 * c;
            __syncthreads();
#pragma unroll
            for (int i = 0; i < 4; ++i) { const int p = F.tid + 512 * i, r = p >> 5, cc = (p & 31) * 8; *(LAS v4u*)(Qs + r * 264 + cc) = *(const v4u*)(Q + (size_t)(row0 + r) * DM + h * 256 + cc); }
            float acc[64];
#pragma unroll
            for (int n = 0; n < 64; ++n) acc[n] = 0.f;
            for (int cq = 0; cq <= c; ++cq) {
                const int krow0 = b * SEQ + 64 * cq;
                __syncthreads();
#pragma unroll
                for (int i = 0; i < 4; ++i) { const int p = F.tid + 512 * i, r = p >> 5, cc = (p & 31) * 8; *(LAS v4u*)(Ks + r * 264 + cc) = *(const v4u*)(K + (size_t)(krow0 + r) * DM + h * 256 + cc); }
#pragma unroll
                for (int i = 0; i < 8; ++i) { const int p = F.tid + 512 * i, r = p >> 6, cc = (p & 63) * 8; *(LAS v4u*)(Vs + r * 512 + cc) = *(const v4u*)(V + (size_t)(krow0 + r) * 2048 + h * 512 + cc); }
                __syncthreads();
                { float s[8];
#pragma unroll
                  for (int j8 = 0; j8 < 8; ++j8) s[j8] = 0.f;
                  for (int dc = 0; dc < 32; ++dc) {
                      const v4u kv = *(const LAS v4u*)(Ks + F.lane * 264 + dc * 8);
                      const float k0 = bflo(kv.x), k1 = bfhi(kv.x), k2 = bflo(kv.y), k3 = bfhi(kv.y), k4 = bflo(kv.z), k5 = bfhi(kv.z), k6 = bflo(kv.w), k7 = bfhi(kv.w);
#pragma unroll
                      for (int j8 = 0; j8 < 8; ++j8) { const v4u qv = *(const LAS v4u*)(Qs + (8 * F.wave + j8) * 264 + dc * 8);
                          s[j8] += (bflo(qv.x) * k0 + bfhi(qv.x) * k1) + (bflo(qv.y) * k2 + bfhi(qv.y) * k3) + (bflo(qv.z) * k4 + bfhi(qv.z) * k5) + (bflo(qv.w) * k6 + bfhi(qv.w) * k7); }
                  }
                  f32x4 w0, w1;
#pragma unroll
                  for (int j8 = 0; j8 < 8; ++j8) { const float dist = fabsf((float)((64 * c + 8 * F.wave + j8) - (64 * cq + F.lane))); const float val = s[j8] * exp2f(dist * lg2g); if (j8 < 4) w0[j8] = val; else w1[j8 - 4] = val; }
                  *(LAS f32x4*)(St + F.lane * 64 + 8 * F.wave) = w0; *(LAS f32x4*)(St + F.lane * 64 + 8 * F.wave + 4) = w1; }
                __syncthreads();
                for (int m2 = 0; m2 < 64; ++m2) {
                    const float vv = bf2f(Vs[m2 * 512 + F.tid]);
#pragma unroll
                    for (int n4 = 0; n4 < 16; ++n4) { const f32x4 sv = *(const LAS f32x4*)(St + m2 * 64 + 4 * n4); acc[4 * n4 + 0] += sv.x * vv; acc[4 * n4 + 1] += sv.y * vv; acc[4 * n4 + 2] += sv.z * vv; acc[4 * n4 + 3] += sv.w * vv; }
                }
            }
#pragma unroll
            for (int n = 0; n < 64; ++n) { const float p = wave_sum(acc[n] * acc[n]); if (F.lane == 0) wred[F.wave * 64 + n] = p; }
            __syncthreads();
            if (F.tid < 64) { float s = 0.f;
#pragma unroll
                for (int w = 0; w < 8; ++w) s += wred[w * 64 + F.tid];
                rtab[F.tid] = 1.0f / sqrtf(s * (1.0f / 512.f) + EPS); }
            __syncthreads();
#pragma unroll
            for (int n = 0; n < 64; ++n) { const size_t gi = (size_t)(row0 + n) * 2048 + h * 512 + F.tid; const float sg = bf2f(SG[gi]); O[gi] = (bf16)(pk2(acc[n] * rtab[n] * sg, 0.f) & 0xffffu); }
        }
    }
}

typedef short s16x4 __attribute__((ext_vector_type(4)));
__device__ __forceinline__ unsigned off_b(unsigned row, unsigned ch) { return 256u * row + 16u * (ch ^ (((row & 3u) << 2) | ((row >> 2) & 3u))); }
__device__ __forceinline__ bf16x8 row_frag(const LAS unsigned char* tile, unsigned row, unsigned s4, unsigned g) { return *(const LAS bf16x8*)(tile + off_b(row, 4u * s4 + g)); }
__device__ __forceinline__ bf16x8 tr_frag16(const LAS unsigned char* tile, unsigned lane, unsigned c, unsigned ks) {
    const unsigned g = lane >> 4, q = (lane & 15u) >> 2, p = lane & 3u;
    const unsigned a0 = off_b(32u * ks + 8u * g + q, 2u * c + (p >> 1)) + 8u * (p & 1u), a1 = off_b(32u * ks + 8u * g + 4u + q, 2u * c + (p >> 1)) + 8u * (p & 1u);
    const s16x4 lo = __builtin_amdgcn_ds_read_tr16_b64_v4i16((LAS s16x4*)(tile + a0)), hi = __builtin_amdgcn_ds_read_tr16_b64_v4i16((LAS s16x4*)(tile + a1));
    return (bf16x8){lo[0], lo[1], lo[2], lo[3], hi[0], hi[1], hi[2], hi[3]};
}
#define RSB() __builtin_amdgcn_sched_barrier(0)
constexpr unsigned RQS = 528, RVS = 272;
template <unsigned RS> __device__ __forceinline__ bf16x8 tr_lin(const LAS unsigned char* img, unsigned trb, int c, int ks) {
    const s16x4 lo = __builtin_amdgcn_ds_read_tr16_b64_v4i16((LAS s16x4*)(img + trb + (32 * ks) * RS + 32 * c)), hi = __builtin_amdgcn_ds_read_tr16_b64_v4i16((LAS s16x4*)(img + trb + (32 * ks + 4) * RS + 32 * c));
    return (bf16x8){lo[0], lo[1], lo[2], lo[3], hi[0], hi[1], hi[2], hi[3]};
}
__device__ __forceinline__ void ret_scan_mfma(Frame& F) {
    relaunder(F);
    const bf16* Q = (const bf16*)(F.ws + WS_R1); const bf16* K = (const bf16*)(F.ws + WS_R1 + 128 * MiB); const bf16* V = (const bf16*)(F.ws + WS_R1 + 256 * MiB);
    bf16* O = (bf16*)(F.ws + WS_R2); float* SS = (float*)(F.ws + WS_R2 + 256 * MiB);
    LAS unsigned char* Qi = F.lds; LAS unsigned char* Ki = F.lds + 33792; LAS unsigned char* Vi = F.lds + 67584; LAS unsigned char* Si = F.lds + 84992; LAS float* OT = (LAS float*)(F.lds + 94208);
    const unsigned w = (unsigned)F.wave;
    for (int u = F.vcu; u < NBATCH * RT_H * 4; u += F.G) {
        const int bh = u >> 2, vs = u & 3, b = bh >> 2, h = bh & 3;
        const float lg2g = log2f(1.0f - exp2f(-5.0f - (float)h)), cd = exp2f(64.0f * lg2g);
        f32x4 R[16];
#pragma unroll
        for (int i = 0; i < 16; ++i) R[i] = (f32x4){0.f, 0.f, 0.f, 0.f};
        v4u pq[4], pk[4], pv[2];
        { const int row0 = b * SEQ;
#pragma unroll
          for (int i = 0; i < 4; ++i) { const int p = F.tid + 512 * i, r = p >> 5, c32 = p & 31; pq[i] = *(const v4u*)(Q + (size_t)(row0 + r) * DM + h * 256 + c32 * 8); pk[i] = *(const v4u*)(K + (size_t)(row0 + r) * DM + h * 256 + c32 * 8); }
#pragma unroll
          for (int i = 0; i < 2; ++i) { const int p = F.tid + 512 * i, r = p >> 4, c16 = p & 15; pv[i] = *(const v4u*)(V + (size_t)(row0 + r) * 2048 + h * 512 + vs * 128 + c16 * 8); } }
        __syncthreads();
        for (int c = 0; c < SEQ / 64; ++c) {
            const int row0 = b * SEQ + 64 * c;
            unsigned tidl = (unsigned)F.tid; asm volatile("" : "+v"(tidl));
            const unsigned lane = tidl & 63u, g = lane >> 4, li = lane & 15u;
#pragma unroll
            for (int i = 0; i < 4; ++i) { const unsigned p = tidl + 512u * i, r = p >> 5, c32 = p & 31u; const unsigned o = r * RQS + 16u * c32; *(LAS v4u*)(Qi + o) = pq[i]; *(LAS v4u*)(Ki + o) = pk[i]; }
#pragma unroll
            for (int i = 0; i < 2; ++i) { const unsigned p = tidl + 512u * i, r = p >> 4, c16 = p & 15u; *(LAS v4u*)(Vi + r * RVS + 16u * c16) = pv[i]; }
            __syncthreads();
            if (c + 1 < SEQ / 64) { const int rn = row0 + 64;
#pragma unroll
                for (int i = 0; i < 4; ++i) { const unsigned p = tidl + 512u * i, r = p >> 5, c32 = p & 31u; pq[i] = *(const v4u*)(Q + (size_t)(rn + (int)r) * DM + h * 256 + c32 * 8); pk[i] = *(const v4u*)(K + (size_t)(rn + (int)r) * DM + h * 256 + c32 * 8); }
#pragma unroll
                for (int i = 0; i < 2; ++i) { const unsigned p = tidl + 512u * i, r = p >> 4, c16 = p & 15u; pv[i] = *(const v4u*)(V + (size_t)(rn + (int)r) * 2048 + h * 512 + vs * 128 + c16 * 8); } }
            RSB();
            const unsigned rb128 = li * RQS + 16u * g, rb64 = li * RQS + 8u * g, trq = (8u * g + (li >> 2)) * RQS + 8u * (li & 3u), trv = (8u * g + (li >> 2)) * RVS + 8u * (li & 3u);
            { const unsigned mt = w >> 1, nt0 = 2u * (w & 1u); f32x4 sa0 = (f32x4){0.f, 0.f, 0.f, 0.f}, sa1 = sa0;
              const LAS unsigned char* qrow = Qi + rb128 + mt * (16u * RQS); const LAS unsigned char* krow = Ki + rb128 + nt0 * (16u * RQS);
              bf16x8 qa[2][2], kb0[2][2], kb1[2][2];
#define RET_LDS(buf, s8b) do { _Pragma("unroll") for (int k2 = 0; k2 < 2; ++k2) { const int s8 = (s8b) + k2; \
                  qa[buf][k2] = *(const LAS bf16x8*)(qrow + 64 * s8); kb0[buf][k2] = *(const LAS bf16x8*)(krow + 64 * s8); kb1[buf][k2] = *(const LAS bf16x8*)(krow + 16 * RQS + 64 * s8); } } while (0)
              RET_LDS(0, 0); RSB();
#pragma unroll
              for (int bt = 0; bt < 4; ++bt) { if (bt < 3) RET_LDS((bt + 1) & 1, 2 * (bt + 1)); RSB();
#pragma unroll
                  for (int k2 = 0; k2 < 2; ++k2) { sa0 = __builtin_amdgcn_mfma_f32_16x16x32_bf16(qa[bt & 1][k2], kb0[bt & 1][k2], sa0, 0, 0, 0); sa1 = __builtin_amdgcn_mfma_f32_16x16x32_bf16(qa[bt & 1][k2], kb1[bt & 1][k2], sa1, 0, 0, 0); }
                  RSB(); }
#undef RET_LDS
#pragma unroll
              for (int q = 0; q < 4; ++q) { const int n = (int)(16u * mt + 4u * g) + q, m0 = (int)(16u * nt0 + li);
                  const float v0 = sa0[q] * exp2f(fabsf((float)(n - m0)) * lg2g), v1 = sa1[q] * exp2f(fabsf((float)(n - m0 - 16)) * lg2g); const unsigned pk = pk2(v0, v1);
                  *(LAS unsigned short*)(Si + (unsigned)n * 144u + 2u * (unsigned)m0) = (unsigned short)(pk & 0xffffu); *(LAS unsigned short*)(Si + (unsigned)n * 144u + 2u * (unsigned)m0 + 32u) = (unsigned short)(pk >> 16); } }
            RSB();
            f32x4 Oa[4];
#pragma unroll
            for (int mt = 0; mt < 4; ++mt) Oa[mt] = (f32x4){0.f, 0.f, 0.f, 0.f};
            { v2u qlo[2][4], qhi[2][4]; const LAS unsigned char* qp = Qi + rb64;
#define RET_LDQ(buf, s8) do { _Pragma("unroll") for (int mt = 0; mt < 4; ++mt) { qlo[buf][mt] = *(const LAS v2u*)(qp + mt * (16 * RQS) + 64 * (s8)); qhi[buf][mt] = *(const LAS v2u*)(qp + mt * (16 * RQS) + 64 * (s8) + 32); } } while (0)
              RET_LDQ(0, 0); RSB();
#pragma unroll
              for (int s8 = 0; s8 < 8; ++s8) { if (s8 < 7) RET_LDQ((s8 + 1) & 1, s8 + 1); RSB();
                  const v4u rt = (v4u){pk2(R[2 * s8][0], R[2 * s8][1]), pk2(R[2 * s8][2], R[2 * s8][3]), pk2(R[2 * s8 + 1][0], R[2 * s8 + 1][1]), pk2(R[2 * s8 + 1][2], R[2 * s8 + 1][3])}; const bf16x8 Rb = __builtin_bit_cast(bf16x8, rt);
#pragma unroll
                  for (int mt = 0; mt < 4; ++mt) { const v4u av = (v4u){qlo[s8 & 1][mt].x, qlo[s8 & 1][mt].y, qhi[s8 & 1][mt].x, qhi[s8 & 1][mt].y}; Oa[mt] = __builtin_amdgcn_mfma_f32_16x16x32_bf16(__builtin_bit_cast(bf16x8, av), Rb, Oa[mt], 0, 0, 0); }
                  RSB(); }
#undef RET_LDQ
            }
#pragma unroll
            for (int mt = 0; mt < 4; ++mt)
#pragma unroll
                for (int q = 0; q < 4; ++q) Oa[mt][q] *= exp2f((float)(16 * mt + 4 * (int)g + q + 1) * lg2g);
            __syncthreads();
            bf16x8 Vf[2], sf[4][2], ka[2][2][2];
#define RET_LDK(buf, dtb) do { _Pragma("unroll") for (int d2 = 0; d2 < 2; ++d2) _Pragma("unroll") for (int ks = 0; ks < 2; ++ks) ka[buf][d2][ks] = tr_lin<RQS>(Ki, trq, (dtb) + d2, ks); } while (0)
#pragma unroll
            for (int ks = 0; ks < 2; ++ks) Vf[ks] = tr_lin<RVS>(Vi + 32u * w, trv, 0, ks);
#pragma unroll
            for (int mt = 0; mt < 4; ++mt)
#pragma unroll
                for (int ks = 0; ks < 2; ++ks) sf[mt][ks] = *(const LAS bf16x8*)(Si + (16u * mt + li) * 144u + 64u * ks + 16u * g);
            RET_LDK(0, 0); RSB();
#pragma unroll
            for (int mt = 0; mt < 4; ++mt)
#pragma unroll
                for (int ks = 0; ks < 2; ++ks) Oa[mt] = __builtin_amdgcn_mfma_f32_16x16x32_bf16(sf[mt][ks], Vf[ks], Oa[mt], 0, 0, 0);
            bf16x8 Vd[2];
#pragma unroll
            for (int ks = 0; ks < 2; ++ks) { const v4u vv = __builtin_bit_cast(v4u, Vf[ks]); float f[8];
#pragma unroll
                for (int j = 0; j < 8; ++j) f[j] = exp2f((float)(63 - (32 * ks + 8 * (int)g + j)) * lg2g);
                const v4u sv = (v4u){pk2(bflo(vv.x) * f[0], bfhi(vv.x) * f[1]), pk2(bflo(vv.y) * f[2], bfhi(vv.y) * f[3]), pk2(bflo(vv.z) * f[4], bfhi(vv.z) * f[5]), pk2(bflo(vv.w) * f[6], bfhi(vv.w) * f[7])};
                Vd[ks] = __builtin_bit_cast(bf16x8, sv); }
            RSB();
#pragma unroll
            for (int bt = 0; bt < 8; ++bt) { if (bt < 7) RET_LDK((bt + 1) & 1, 2 * (bt + 1)); RSB();
#pragma unroll
                for (int d2 = 0; d2 < 2; ++d2) { const int dt = 2 * bt + d2; R[dt] = R[dt] * cd;
#pragma unroll
                    for (int ks = 0; ks < 2; ++ks) R[dt] = __builtin_amdgcn_mfma_f32_16x16x32_bf16(ka[bt & 1][d2][ks], Vd[ks], R[dt], 0, 0, 0); }
                RSB(); }
#undef RET_LDK
#pragma unroll
            for (int mt = 0; mt < 4; ++mt)
#pragma unroll
                for (int q = 0; q < 4; ++q) OT[(16u * mt + 4u * g + q) * 132u + 16u * w + li] = Oa[mt][q];
            __syncthreads();
            { const unsigned tn = tidl >> 3, vg = tidl & 7u; f32x4 o[4]; float ssq = 0.f;
#pragma unroll
              for (int i = 0; i < 4; ++i) { o[i] = *(const LAS f32x4*)(OT + tn * 132u + 16u * vg + 4u * i); ssq += (o[i].x * o[i].x + o[i].y * o[i].y) + (o[i].z * o[i].z + o[i].w * o[i].w); }
              ssq += __shfl_xor(ssq, 1); ssq += __shfl_xor(ssq, 2); ssq += __shfl_xor(ssq, 4);
              bf16* op = O + (size_t)(row0 + (int)tn) * 2048 + h * 512 + vs * 128 + 16 * vg; *(v4u*)op = pack8(o[0], o[1]); *(v4u*)(op + 8) = pack8(o[2], o[3]);
              if (vg == 0) SS[((size_t)(row0 + (int)tn) * 4 + h) * 4 + vs] = ssq; }
        }
    }
}
__device__ __forceinline__ void ret_norm(Frame& F) {
    relaunder(F);
    bf16* O = (bf16*)(F.ws + WS_R2); const float* SS = (const float*)(F.ws + WS_R2 + 256 * MiB); const bf16* SG = (const bf16*)(F.ws + WS_R1 + 512 * MiB);
    const int gw = F.vcu * NWAVES + F.wave, NGW = F.G * NWAVES;
    for (int row = gw; row < MTOK; row += NGW) {
        float r[4];
#pragma unroll
        for (int h = 0; h < 4; ++h) { const f32x4 p = *(const f32x4*)(SS + ((size_t)row * 4 + h) * 4); r[h] = 1.0f / sqrtf(((p.x + p.y) + (p.z + p.w)) * (1.0f / 512.f) + EPS); }
#pragma unroll
        for (int j = 0; j < 4; ++j) { const size_t gi = (size_t)row * 2048 + 512 * j + 8 * F.lane; const v4u o = *(const v4u*)(O + gi), sg = *(const v4u*)(SG + gi); const float rr = r[j];
            v4u w; w.x = pk2(bflo(o.x) * rr * bflo(sg.x), bfhi(o.x) * rr * bfhi(sg.x)); w.y = pk2(bflo(o.y) * rr * bflo(sg.y), bfhi(o.y) * rr * bfhi(sg.y));
            w.z = pk2(bflo(o.z) * rr * bflo(sg.z), bfhi(o.z) * rr * bfhi(sg.z)); w.w = pk2(bflo(o.w) * rr * bflo(sg.w), bfhi(o.w) * rr * bfhi(sg.w));
            *(v4u*)(O + gi) = w; }
    }
}

__device__ __forceinline__ bf16x8 pad8(s16x4 a) { return (bf16x8){a[0], a[1], a[2], a[3], 0, 0, 0, 0}; }
__device__ __forceinline__ void hgrn_scan_mfma(Frame& F, int j) {
    relaunder(F);
    const bf16* Q = (const bf16*)(F.ws + WS_R1); const bf16* K = (const bf16*)(F.ws + WS_R1 + 128 * MiB); const bf16* V = (const bf16*)(F.ws + WS_R1 + 256 * MiB); const bf16* SG = (const bf16*)(F.ws + WS_R1 + 384 * MiB);
    const float* LF = (const float*)(F.ws + WS_R1 + 512 * MiB); bf16* O = (bf16*)(F.ws + WS_R2);
    LAS unsigned char* QEi = F.lds; LAS unsigned char* QE2i = F.lds + 17408; LAS unsigned char* KEi = F.lds + 34816; LAS unsigned char* Vi = F.lds + 52224;
    LAS float* BL = (LAS float*)(F.lds + 69632); LAS float* OT = (LAS float*)(F.lds + 71680);
    const unsigned w = (unsigned)F.wave;
    for (int u = F.vcu; u < NBATCH * HG_H; u += F.G) {
        const int b = u >> 3, h = u & 7;
        f32x4 S[8];
#pragma unroll
        for (int i = 0; i < 8; ++i) S[i] = (f32x4){0.f, 0.f, 0.f, 0.f};
        float plf[16]; unsigned short pq[16], pk[16]; v4u pv[2], psg[2];
        { const int kbp = F.tid >> 7, dp = F.tid & 127, row0 = b * SEQ;
#pragma unroll
          for (int t = 0; t < 16; ++t) { const size_t gi = (size_t)(row0 + 16 * kbp + t) * DM + h * 128 + dp; plf[t] = LF[gi]; pq[t] = Q[gi]; pk[t] = K[gi]; }
#pragma unroll
          for (int i = 0; i < 2; ++i) { const int p = F.tid + 512 * i, r = p >> 4, c16 = p & 15; pv[i] = *(const v4u*)(V + (size_t)(row0 + r) * DM + h * 128 + c16 * 8); }
#pragma unroll
          for (int i = 0; i < 2; ++i) psg[i] = *(const v4u*)(SG + (size_t)(row0 + (F.tid >> 3)) * DM + h * 128 + 16 * (F.tid & 7) + 8 * i); }
        __syncthreads();
        for (int c = 0; c < SEQ / 64; ++c) {
            const int row0 = b * SEQ + 64 * c;
            unsigned tidl = (unsigned)F.tid; asm volatile("" : "+v"(tidl));
            const unsigned lane = tidl & 63u, g = lane >> 4, li = lane & 15u, kbp = tidl >> 7, dp = tidl & 127u;
            { float bs = 0.f;
#pragma unroll
              for (int t = 0; t < 16; ++t) { bs += plf[t]; plf[t] = bs; }
              const float bl = plf[15]; const unsigned a0 = (16u * kbp) * RVS + 2u * dp;
#pragma unroll
              for (int t = 0; t < 16; ++t) { const float bt = plf[t], q = bf2f(pq[t]), k = bf2f(pk[t]);
                  const unsigned w0 = pk2(q * __expf(bt), q * __expf(fminf(bt - bl, 80.f))), w1 = pk2(k * __expf(bl - bt), 0.f);
                  *(LAS unsigned short*)(QEi + a0 + t * RVS) = (unsigned short)(w0 & 0xffffu); *(LAS unsigned short*)(QE2i + a0 + t * RVS) = (unsigned short)(w0 >> 16); *(LAS unsigned short*)(KEi + a0 + t * RVS) = (unsigned short)(w1 & 0xffffu); }
              BL[kbp * 128u + dp] = __expf(bl); }
#pragma unroll
            for (int i = 0; i < 2; ++i) { const unsigned p = tidl + 512u * i, r = p >> 4, c16 = p & 15u; *(LAS v4u*)(Vi + r * RVS + 16u * c16) = pv[i]; }
            const v4u csg0 = psg[0], csg1 = psg[1];
            __syncthreads();
            if (c + 1 < SEQ / 64) { const int rn = row0 + 64;
#pragma unroll
                for (int t = 0; t < 16; ++t) { const size_t gi = (size_t)(rn + 16 * (int)kbp + t) * DM + h * 128 + dp; plf[t] = LF[gi]; pq[t] = Q[gi]; pk[t] = K[gi]; }
#pragma unroll
                for (int i = 0; i < 2; ++i) { const unsigned p = tidl + 512u * i, r = p >> 4, c16 = p & 15u; pv[i] = *(const v4u*)(V + (size_t)(rn + (int)r) * DM + h * 128 + c16 * 8); }
#pragma unroll
                for (int i = 0; i < 2; ++i) psg[i] = *(const v4u*)(SG + (size_t)(rn + (int)(tidl >> 3)) * DM + h * 128 + 16 * (tidl & 7u) + 8 * i); }
            RSB();
            const unsigned rb128 = li * RVS + 16u * g, rb64 = li * RVS + 8u * g, trb = (4u * g + (li >> 2)) * RVS + 8u * (li & 3u);
#pragma unroll 1
            for (unsigned kb = 0; kb < 4; ++kb) {
                const unsigned ko = kb * (16u * RVS);
                bf16x8 kef[4], q2f[4]; v2u qlo[4], qhi[4]; s16x4 ktf[8]; f32x4 e4[8];
#pragma unroll
                for (int s4 = 0; s4 < 4; ++s4) { kef[s4] = *(const LAS bf16x8*)(KEi + ko + rb128 + 64 * s4); q2f[s4] = *(const LAS bf16x8*)(QE2i + ko + rb128 + 64 * s4); }
                const s16x4 Vb = __builtin_amdgcn_ds_read_tr16_b64_v4i16((LAS s16x4*)(Vi + ko + trb + 32u * w));
#pragma unroll
                for (int s4 = 0; s4 < 4; ++s4) { qlo[s4] = *(const LAS v2u*)(QEi + ko + rb64 + 64 * s4); qhi[s4] = *(const LAS v2u*)(QEi + ko + rb64 + 64 * s4 + 32); }
                RSB();
                f32x4 P = (f32x4){0.f, 0.f, 0.f, 0.f};
#pragma unroll
                for (int s4 = 0; s4 < 4; ++s4) P = __builtin_amdgcn_mfma_f32_16x16x32_bf16(kef[s4], q2f[s4], P, 0, 0, 0);
                RSB();
#pragma unroll
                for (int dt = 0; dt < 8; ++dt) { ktf[dt] = __builtin_amdgcn_ds_read_tr16_b64_v4i16((LAS s16x4*)(KEi + ko + trb + 32 * dt)); e4[dt] = *(const LAS f32x4*)(BL + kb * 128u + 16u * dt + 4u * g); }
                RSB();
                f32x4 oa = (f32x4){0.f, 0.f, 0.f, 0.f};
#pragma unroll
                for (int s4 = 0; s4 < 4; ++s4) {
                    const v4u st = (v4u){pk2(S[2 * s4][0], S[2 * s4][1]), pk2(S[2 * s4][2], S[2 * s4][3]), pk2(S[2 * s4 + 1][0], S[2 * s4 + 1][1]), pk2(S[2 * s4 + 1][2], S[2 * s4 + 1][3])};
                    const v4u av = (v4u){qlo[s4].x, qlo[s4].y, qhi[s4].x, qhi[s4].y};
                    oa = __builtin_amdgcn_mfma_f32_16x16x32_bf16(__builtin_bit_cast(bf16x8, av), __builtin_bit_cast(bf16x8, st), oa, 0, 0, 0); }
                s16x4 a16;
                { const unsigned lo = pk2((4u * g + 0u <= li) ? P[0] : 0.f, (4u * g + 1u <= li) ? P[1] : 0.f), hi = pk2((4u * g + 2u <= li) ? P[2] : 0.f, (4u * g + 3u <= li) ? P[3] : 0.f); const v2u t2 = (v2u){lo, hi}; a16 = __builtin_bit_cast(s16x4, t2); }
                const bf16x8 Vb8 = pad8(Vb);
                oa = __builtin_amdgcn_mfma_f32_16x16x32_bf16(pad8(a16), Vb8, oa, 0, 0, 0);
#pragma unroll
                for (int dt = 0; dt < 8; ++dt) S[dt] = __builtin_amdgcn_mfma_f32_16x16x32_bf16(pad8(ktf[dt]), Vb8, S[dt] * e4[dt], 0, 0, 0);
#pragma unroll
                for (int q = 0; q < 4; ++q) OT[(16u * kb + 4u * g + q) * 132u + 16u * w + li] = oa[q];
                RSB();
            }
            __syncthreads();
            { const unsigned tn = tidl >> 3, vg = tidl & 7u; f32x4 o[4]; float ss = 0.f;
#pragma unroll
              for (int i = 0; i < 4; ++i) { o[i] = *(const LAS f32x4*)(OT + tn * 132u + 16u * vg + 4u * i); ss += (o[i].x * o[i].x + o[i].y * o[i].y) + (o[i].z * o[i].z + o[i].w * o[i].w); }
              ss += __shfl_xor(ss, 1); ss += __shfl_xor(ss, 2); ss += __shfl_xor(ss, 4);
              const float r = 1.0f / sqrtf(ss * (1.0f / 128.f) + EPS); const float* gp = KIN(I_HGAIN) + j * 128 + 16 * vg;
#pragma unroll
              for (int i = 0; i < 4; ++i) o[i] = o[i] * r * *(const f32x4*)(gp + 4 * i);
              v4u w0, w1;
              w0.x = pk2(o[0].x * bflo(csg0.x), o[0].y * bfhi(csg0.x)); w0.y = pk2(o[0].z * bflo(csg0.y), o[0].w * bfhi(csg0.y)); w0.z = pk2(o[1].x * bflo(csg0.z), o[1].y * bfhi(csg0.z)); w0.w = pk2(o[1].z * bflo(csg0.w), o[1].w * bfhi(csg0.w));
              w1.x = pk2(o[2].x * bflo(csg1.x), o[2].y * bfhi(csg1.x)); w1.y = pk2(o[2].z * bflo(csg1.y), o[2].w * bfhi(csg1.y)); w1.z = pk2(o[3].x * bflo(csg1.z), o[3].y * bfhi(csg1.z)); w1.w = pk2(o[3].z * bflo(csg1.w), o[3].w * bfhi(csg1.w));
              bf16* op = O + (size_t)(row0 + (int)tn) * DM + h * 128 + 16 * vg; *(v4u*)op = w0; *(v4u*)(op + 8) = w1; }
        }
    }
}

struct Args { const void* in[22]; float* out; unsigned char* ws; int ph_lo, ph_hi; };
constexpr int PH_PER_LAYER = 9, NPHASES = 1 + DEPTH * PH_PER_LAYER + 1;

__global__ void __launch_bounds__(NWAVES * 64, 2) hybrid_fwd(Args args) {
    extern __shared__ __attribute__((aligned(16))) unsigned char lds[];
    Frame F;
    F.lds = (LAS unsigned char*)lds;
    F.tid = threadIdx.x; F.lane = F.tid & 63; F.wave = __builtin_amdgcn_readfirstlane(F.tid >> 6);
    F.G = gridDim.x; { const int bx = blockIdx.x; F.vcu = (F.G % 8 == 0) ? (bx % 8) * (F.G / 8) + bx / 8 : bx; }
    F.ws = args.ws; F.out = args.out; F.ctl = (unsigned*)(args.ws + WS_CTL);
    for (int u = F.tid; u < (LDS_BYTES - MISC_OFF) / 4; u += NWAVES * 64) ((LAS unsigned*)(F.lds + MISC_OFF))[u] = 0u;
    __syncthreads();
    const int lo = args.ph_lo, hi = args.ph_hi;
    XcdBarrier bar; bar.bar = F.ctl + CW_BAR; bar.x = 0; bar.st = nullptr;
    if (hi - lo > 1) bar = xcd_barrier_post(F.ctl + CW_BAR, (volatile LAS unsigned*)(F.lds + MISC_OFF) + 8);
#define IN(k) (lo <= (k) && (k) < hi)
#define SEAM(k) do { if (IN(k) && hi > (k) + 1) xcd_barrier(bar); } while (0)

    if (PH_EN(0) && IN(0)) { for (int rep = 0; rep < REPS(0); ++rep) p0_prologue(F); } SEAM(0);

#pragma unroll 1
    for (int l = 0; l < DEPTH; ++l) {
        const int pb = 1 + l * PH_PER_LAYER, j = l >> 1; const bool is_ret = (l & 1);
        if (PH_EN(1) && IN(pb + 0)) row_phase1(F, l, 0);
        SEAM(pb + 0);
        if (IN(pb + 1)) {
            if (PH_EN(2) && !is_ret) {
                pg8::Gemm g{(const bf16*)(F.ws + WS_H), (const bf16*)(F.ws + WS_HWIN) + (size_t)j * HG_N * DM, MTOK, HG_N, DM}; pg8::StaticOrder S; S.init(MTOK, HG_N, F.G, (int)blockIdx.x);
                EpiHgrnIn E{F.ws + WS_R1, (const float*)(F.ws + WS_LBV) + j * DM};
                for (int rep = 0; rep < REPS(2); ++rep) pg8::gemm_phase<EpiHgrnIn, pg8::StaticOrder, true, true>(F.lds + RING_OFF, g, S, E);
            } else if (PH_EN(3)) {
                pg8::Gemm g{(const bf16*)(F.ws + WS_H), (const bf16*)(F.ws + WS_RWIN) + (size_t)j * RT_N * DM, MTOK, RT_N, DM}; pg8::StaticOrder S; S.init(MTOK, RT_N, F.G, (int)blockIdx.x);
                EpiRetIn E{F.ws + WS_R1, (const int*)kin_(I_POS)};
                for (int rep = 0; rep < REPS(3); ++rep) pg8::gemm_phase<EpiRetIn, pg8::StaticOrder, true, true>(F.lds + RING_OFF, g, S, E);
            }
        }
        SEAM(pb + 1);
        if (IN(pb + 2)) { if (!is_ret) { if (PH_EN(4)) { for (int rep = 0; rep < REPS(4); ++rep) { if (HGRN_MFMA) hgrn_scan_mfma(F, j); else hgrn_scan(F, j); } } } else { if (PH_EN(5)) { for (int rep = 0; rep < REPS(5); ++rep) { if (RET_MFMA) ret_scan_mfma(F); else ret_scan(F); } } } }
        SEAM(pb + 2);
        if (RET_MFMA && PH_EN(12) && IN(pb + 3) && is_ret) ret_norm(F);
        if (RET_MFMA && is_ret) SEAM(pb + 3);
        if (PH_EN(6) && IN(pb + 4)) {
            const int Ko = is_ret ? 2048 : DM;
            const bf16* Wt = is_ret ? (const bf16*)(F.ws + WS_RWOUT) + (size_t)j * DM * 2048 : (const bf16*)(F.ws + WS_HWOUT) + (size_t)j * DM * DM;
            pg8::Gemm g{(const bf16*)(F.ws + WS_R2), Wt, MTOK, DM, Ko}; pg8::StaticOrder S; S.init(MTOK, DM, F.G, (int)blockIdx.x);
            EpiOut E{l == 0 ? KIN(I_X) : F.out, F.out, (const float*)(F.ws + WS_MOD) + (size_t)l * NBATCH * 6 * DM + 2 * DM};
            pg8::gemm_phase<EpiOut, pg8::StaticOrder, true, true>(F.lds + RING_OFF, g, S, E);
        }
        SEAM(pb + 4);
        if (PH_EN(7) && IN(pb + 5)) row_phase2(F, l);
        SEAM(pb + 5);
        if (MOE_GATHER_PASS) { if (PH_EN(8) && IN(pb + 6)) { for (int rep = 0; rep < REPS(8); ++rep) moe_gather(F, l); } SEAM(pb + 6); }
        if (PH_EN(9) && IN(pb + 7)) {
            build_tiles(F, l);
            if (!MOE_GATHER_PASS) moe_build_tt(F, 8);
            pg8::MoeOrder S{8, F.G, F.vcu, (const LAS int*)(F.lds + TAB_OFF), (const LAS unsigned short*)(F.lds + 131072)};
            if constexpr (MOE_FP8) {
                static_assert(!MOE_FP8 || !MOE_GATHER_PASS, "the fp8 expert GEMM gathers while staging");
                pg8::Gemm g{(const bf16*)(F.ws + WS_H8), (const bf16*)(F.ws + WS_W1T + (size_t)l * NEXP * 2048 * DM), 0, 0, DM / 2};
                EpiMoe1F8 E{F.ws + WS_R2, KIN(I_B1) + (size_t)l * NEXP * 2048};
                for (int rep = 0; rep < REPS(9); ++rep) pg8::gemm_phase<EpiMoe1F8, pg8::MoeOrder, true, true, true, true>(F.lds + RING_OFF, g, S, E);
                if (REPS(12) > 1) pg8::gemm_phase<EpiMoe1F8, pg8::MoeOrder, true, true, true, true, true>(F.lds + RING_OFF, g, S, E);
            } else {
                pg8::Gemm g{(const bf16*)(F.ws + (MOE_GATHER_PASS ? WS_R1 : WS_H)), (const bf16*)(F.ws + WS_W1T) + (size_t)l * NEXP * 2048 * DM, 0, 0, DM};
                EpiMoe1 E{(bf16*)(F.ws + WS_R2), KIN(I_B1) + (size_t)l * NEXP * 2048};
                for (int rep = 0; rep < REPS(9); ++rep) pg8::gemm_phase<EpiMoe1, pg8::MoeOrder, true, true, !MOE_GATHER_PASS>(F.lds + RING_OFF, g, S, E);
            }
        }
        SEAM(pb + 7);
        if (PH_EN(10) && IN(pb + 8)) {
            build_tiles(F, l);
            pg8::MoeOrder S{4, F.G, F.vcu, (const LAS int*)(F.lds + TAB_OFF), nullptr};
            if constexpr (MOE_FP8) {
                pg8::Gemm g{(const bf16*)(F.ws + WS_R2), (const bf16*)(F.ws + WS_W2T + (size_t)l * NEXP * DM * DM), 0, 0, DM / 2};
                EpiMoe2 E{(bf16*)(F.ws + WS_R1), KIN(I_B2) + (size_t)l * NEXP * DM, 1.0f / 256.f};
                for (int rep = 0; rep < REPS(10); ++rep) pg8::gemm_phase<EpiMoe2, pg8::MoeOrder, true, true, false, true>(F.lds + RING_OFF, g, S, E);
                if (REPS(11) > 1) pg8::gemm_phase<EpiMoe2, pg8::MoeOrder, true, true, false, true, true>(F.lds + RING_OFF, g, S, E);
            } else {
                pg8::Gemm g{(const bf16*)(F.ws + WS_R2), (const bf16*)(F.ws + WS_W2T) + (size_t)l * NEXP * DM * DM, 0, 0, DM};
                EpiMoe2 E{(bf16*)(F.ws + WS_R1), KIN(I_B2) + (size_t)l * NEXP * DM, 1.0f};
                for (int rep = 0; rep < REPS(10); ++rep) pg8::gemm_phase<EpiMoe2, pg8::MoeOrder, true, true>(F.lds + RING_OFF, g, S, E);
            }
        }
        SEAM(pb + 8);
    }
    if (PH_EN(11) && IN(NPHASES - 1)) row_phase1(F, DEPTH, 1);
#undef IN
#undef SEAM
}

extern "C" void kernel_launch(void* const* d_in, const int* in_sizes, int n_in, void* d_out, int out_size, void* d_ws, size_t ws_size, hipStream_t stream) {
    static int grid = 0;
    if (grid == 0) {
        if (n_in != 22 || in_sizes[0] != MTOK * DM || out_size != MTOK * DM || ws_size < WS_END) { fprintf(stderr, "kernel_launch: unexpected shapes (n_in %d, in0 %d, out %d, ws %zu < %zu)\n", n_in, n_in > 0 ? in_sizes[0] : -1, out_size, ws_size, (size_t)WS_END); grid = -1; return; }
        int dev = 0, cus = 0, per_cu = 0;
        if (hipGetDevice(&dev) != hipSuccess || hipDeviceGetAttribute(&cus, hipDeviceAttributeMultiprocessorCount, dev) != hipSuccess) { grid = -1; return; }
        if (hipFuncSetAttribute((const void*)hybrid_fwd, hipFuncAttributeMaxDynamicSharedMemorySize, LDS_BYTES) != hipSuccess) { fprintf(stderr, "kernel_launch: hipFuncSetAttribute failed\n"); grid = -1; return; }
        if (hipOccupancyMaxActiveBlocksPerMultiprocessor(&per_cu, (const void*)hybrid_fwd, NWAVES * 64, LDS_BYTES) != hipSuccess || per_cu < 1) { fprintf(stderr, "kernel_launch: occupancy query says %d blocks per CU\n", per_cu); }
        (void)hipGetLastError();
        grid = cus;
    }
    if (grid < 0) return;
    (void)hipMemsetAsync((char*)d_ws + WS_CTL, 0, CTL_ZERO_BYTES, stream);
    Args a{};
    for (int i = 0; i < 22; ++i) a.in[i] = d_in[i];
    a.out = (float*)d_out; a.ws = (unsigned char*)d_ws;
#if MK_SPLIT
    for (int p = 0; p < DBG_LIMIT; ++p) {
        if (p >= 1 && p < NPHASES - 1 && ((p - 1) % PH_PER_LAYER) == 3 && (!RET_MFMA || (((p - 1) / PH_PER_LAYER) & 1) == 0)) continue;
        if (!MOE_GATHER_PASS && p >= 1 && p < NPHASES - 1 && ((p - 1) % PH_PER_LAYER) == 6) continue;
        a.ph_lo = p; a.ph_hi = p + 1;
        hipLaunchKernelGGL(hybrid_fwd, dim3(grid), dim3(NWAVES * 64), LDS_BYTES, stream, a);
    }
#else
    a.ph_lo = 0; a.ph_hi = NPHASES;
    hipLaunchKernelGGL(hybrid_fwd, dim3(grid), dim3(NWAVES * 64), LDS_BYTES, stream, a);
#endif
    const hipError_t le = hipPeekAtLastError();
    if (le != hipSuccess) fprintf(stderr, "kernel_launch: launch failed: %s\n", hipGetErrorName(le));
}
```

```cpp
#include <hip/hip_runtime.h>
#include <cstdio>
#include <cstdint>

#ifndef ONLY_PH
#define ONLY_PH -1
#endif
#define PH_EN(n) (ONLY_PH < 0 || ONLY_PH == (n))
#ifndef DBG_LIMIT
#define DBG_LIMIT NPHASES
#endif
#ifndef RET_MFMA
#define RET_MFMA 1
#endif
#ifndef HGRN_MFMA
#define HGRN_MFMA 1
#endif
#ifndef REPEAT_MASK
#define REPEAT_MASK 0
#endif
#define REPS(k) (1 + ((REPEAT_MASK >> (k)) & 1))
#ifndef MOE_GATHER_PASS
#define MOE_GATHER_PASS 0
#endif
#ifndef MOE_FP8
#define MOE_FP8 1
#endif
#ifndef SKEW_TICKS
#define SKEW_TICKS 0
#endif
#ifndef HGRN_FP8_MASK
#define HGRN_FP8_MASK 0x0
#endif
#ifndef RET_WIDE
#define RET_WIDE 1
#endif
#ifndef RET_IN_FP8
#define RET_IN_FP8 1
#endif
#ifndef MOE_ALIGN
#define MOE_ALIGN true
#endif
#ifndef RET_FOLD
#define RET_FOLD 1
#endif
#ifndef MK_SPLIT
#define MK_SPLIT 0
#endif

namespace pg8 {
#define PG8_LAS __attribute__((address_space(3)))
typedef unsigned short bf16_t;
typedef short bf16x8 __attribute__((ext_vector_type(8)));
typedef float f32x4 __attribute__((ext_vector_type(4)));
typedef unsigned u32x4 __attribute__((ext_vector_type(4)));
constexpr int BM = 256, BK = 64, HALF = 128, HTB = HALF * BK * 2  , STAGE_BYTES = 8 * HTB, NXCD = 8, WGM = 8;

__host__ __device__ __forceinline__ int lds_byte(int r, int c) { const int st = (r >> 4) * 2 + (c >> 5), rr = r & 15, cc = c & 31, ob = rr * 64 + cc * 2; return st * 1024 + (ob ^ (((ob >> 9) & 1) << 5)); }
__host__ __device__ __forceinline__ void stage_rc(int b, int& R, int& C) { const int st = b / 1024, sb = b % 1024, swz = sb ^ (((sb >> 9) & 1) << 5); R = (st >> 1) * 16 + swz / 64; C = (st & 1) * 32 + (swz % 64) / 2; }
__host__ __device__ __forceinline__ int perm32(int rho) { const int n = rho >> 4, i = rho & 15; return 8 * (i >> 2) + 4 * n + (i & 3); }

struct Unit { int pm, pn, e, nn; };
struct Gemm { const bf16_t* A; const bf16_t* Bt; int M, N, K; };

struct StaticOrder {
    int nM, nN, nwg, G, c;
    __host__ __device__ void init(int M, int N, int G_, int c_) { nM = M / BM; nN = N / BM; nwg = nM * nN; G = G_; c = c_; }
    __host__ __device__ bool next(int i, Unit& u) const {
        const long L = (long)i * G + c; if (L >= nwg) return false;
        int wgid = (int)L; { const int q = nwg / NXCD, r = nwg % NXCD, xcd = wgid % NXCD, off = wgid / NXCD; wgid = (xcd < r ? xcd * (q + 1) : r * (q + 1) + (xcd - r) * q) + off; }
        const int nig = WGM * nN, gid = wgid / nig, fm = gid * WGM, gsz = (nM - fm) < WGM ? (nM - fm) : WGM;
        u.pm = fm + ((wgid % nig) % gsz); u.pn = (wgid % nig) / gsz; u.e = 0; u.nn = u.pn; return true;
    }
    __device__ __forceinline__ unsigned tok(int, int) const { return 0u; }
    __device__ __forceinline__ void a_ready(const Unit&) const {}
    __device__ __forceinline__ void done(const Unit&) const {}
};
struct MoeOrder {
    int nN, G, c; const PG8_LAS int* ts; const PG8_LAS unsigned short* tt;
    __device__ __forceinline__ unsigned tok(int i, int r) const { return tt[i * 256 + r]; }
    __device__ __forceinline__ bool next(int i, Unit& u) const {
        const int NT = ts[32]; const long L = (long)i * G + c; if (L >= (long)NT * nN) return false;
        const int mt = (int)(L / nN), n = (int)(L % nN); int e = 0;
        for (int k = 1; k < 32; ++k) e += (ts[k] <= mt) ? 1 : 0;
        u.pm = mt; u.pn = e * nN + n; u.e = e; u.nn = n; return true;
    }
    __device__ __forceinline__ void a_ready(const Unit&) const {}
    __device__ __forceinline__ void done(const Unit&) const {}
};

typedef float cvt_f2_ __attribute__((ext_vector_type(2)));
typedef __bf16 cvt_b2_ __attribute__((ext_vector_type(2)));
__device__ __forceinline__ unsigned cvt_pk_bf16(float lo, float hi) { const cvt_f2_ v = {lo, hi}; const cvt_b2_ r = __builtin_convertvector(v, cvt_b2_); return __builtin_bit_cast(unsigned, r); }

template <int N> __device__ __forceinline__ void wait_vm() { asm volatile("s_waitcnt vmcnt(%0)" :: "n"(N) : "memory"); }
typedef int v8i32 __attribute__((ext_vector_type(8)));
struct HScale { const float* ss; PG8_LAS float* tab; float eps; };
template <class Epi, class Sched, bool ALIGN_EPI = false, bool SP2 = false, bool GATHER = false, bool FP8 = false, bool NOEPI = false, bool HSCALE = false>
__device__ __forceinline__ void gemm_phase(PG8_LAS unsigned char* lds, const Gemm g, const Sched& S, const Epi& E, const HScale hs = HScale{nullptr, nullptr, 0.f}) {
    int tid_ = threadIdx.x; asm volatile("" : "+v"(tid_));
    const int tid = tid_, wid = __builtin_amdgcn_readfirstlane(tid >> 6), lane = tid & 63, wr = wid >> 2, wc = wid & 3, fr = lane & 15, fq = lane >> 4;
    const int K = g.K, nt = K / BK;
    unsigned voffA[2], voffB[2];
#pragma unroll
    for (int i = 0; i < 2; ++i) { int R, C; stage_rc(tid * 16 + i * 8192, R, C); const int Rb = Epi::PERM ? ((R & ~31) + perm32(R & 31)) : R;
        voffA[i] = (unsigned)(R * K + C) * 2u; voffB[i] = (unsigned)(Rb * K + C) * 2u; }
    int gR[2]; unsigned gC[2];
#pragma unroll
    for (int i = 0; i < 2; ++i) { int R, C; stage_rc(tid * 16 + i * 8192, R, C); gR[i] = R; gC[i] = (unsigned)C * 2u; }
#define PG8_GVOFF(v, ui_, h_) do { _Pragma("unroll") for (int _i = 0; _i < 2; ++_i) v[_i] = (S.tok((ui_), gR[_i] + HALF * (h_)) * (unsigned)(K * 2)) + gC[_i]; } while (0)
    const size_t kstep = (size_t)(BK * 2);
    const size_t hstep = (size_t)HALF * K * 2;
    const size_t tstep = 2 * hstep;
    const unsigned ldsw = (unsigned)wid * 1024u;
    const int aoff = FP8 ? lds_byte(wr * 64 + fr, fq * 16) : lds_byte(wr * 64 + fr, fq * 8), boff = FP8 ? lds_byte(wc * 32 + fr, fq * 16) : lds_byte(wc * 32 + fr, fq * 8);

#define PG8_SA(b, h) (((b) * 2 + (h)) * HTB)
#define PG8_SB(b, h) ((4 + (b) * 2 + (h)) * HTB)
#define PG8_STAGE(bufoff, gbase, voff) do { _Pragma("unroll") for (int _i = 0; _i < 2; ++_i) \
        __builtin_amdgcn_global_load_lds((const unsigned*)((const char*)(gbase) + (voff)[_i]), (PG8_LAS unsigned*)(lds + (bufoff) + ldsw + _i * 8192), 16, 0, 0); } while (0)
#define PG8_LDA(dst, b, h) do { if constexpr (FP8) { _Pragma("unroll") for (int m = 0; m < 4; ++m) { const u32x4 p0_ = *(const PG8_LAS u32x4*)(lds + PG8_SA(b, h) + aoff + m * 2048), p1_ = *(const PG8_LAS u32x4*)(lds + PG8_SA(b, h) + aoff + m * 2048 + 16); dst##8[m] = __builtin_bit_cast(v8i32, __builtin_shufflevector(p0_, p1_, 0, 1, 2, 3, 4, 5, 6, 7)); } } \
    else { _Pragma("unroll") for (int m = 0; m < 4; ++m) _Pragma("unroll") for (int k = 0; k < 2; ++k) dst[m][k] = *(const PG8_LAS bf16x8*)(lds + PG8_SA(b, h) + aoff + m * 2048 + k * 1024); } } while (0)
#define PG8_LDB(dst, b, h) do { if constexpr (FP8) { _Pragma("unroll") for (int n = 0; n < 2; ++n) { const u32x4 p0_ = *(const PG8_LAS u32x4*)(lds + PG8_SB(b, h) + boff + n * 2048), p1_ = *(const PG8_LAS u32x4*)(lds + PG8_SB(b, h) + boff + n * 2048 + 16); dst##8[n] = __builtin_bit_cast(v8i32, __builtin_shufflevector(p0_, p1_, 0, 1, 2, 3, 4, 5, 6, 7)); } } \
    else { _Pragma("unroll") for (int n = 0; n < 2; ++n) _Pragma("unroll") for (int k = 0; k < 2; ++k) dst[n][k] = *(const PG8_LAS bf16x8*)(lds + PG8_SB(b, h) + boff + n * 2048 + k * 1024); } } while (0)
#define PG8_CAT(x) __builtin_shufflevector(__builtin_bit_cast(u32x4, (x)[0]), __builtin_bit_cast(u32x4, (x)[1]), 0, 1, 2, 3, 4, 5, 6, 7)
#define PG8_MMA(ai, bj, At, Bt) do { __builtin_amdgcn_s_setprio(1); if constexpr (FP8) { _Pragma("unroll") for (int m = 0; m < 4; ++m) _Pragma("unroll") for (int n = 0; n < 2; ++n) \
        asm volatile("v_mfma_scale_f32_16x16x128_f8f6f4 %0, %1, %2, %0, %3, %3 op_sel_hi:[0,0,0]" : "+v"(acc[ai][bj][m][n]) : "v"(Bt##8[n]), "v"(At##8[m]), "v"(scl1)); } \
    else { _Pragma("unroll") for (int m = 0; m < 4; ++m) _Pragma("unroll") for (int n = 0; n < 2; ++n) _Pragma("unroll") for (int k = 0; k < 2; ++k) \
        acc[ai][bj][m][n] = __builtin_amdgcn_mfma_f32_16x16x32_bf16(Bt[n][k], At[m][k], acc[ai][bj][m][n], 0, 0, 0); } __builtin_amdgcn_s_setprio(0); } while (0)
#define PG8_WAIT_V(n) asm volatile("s_waitcnt vmcnt(" #n ")" ::: "memory")
#define PG8_WAIT_L(n) asm volatile("s_waitcnt lgkmcnt(" #n ")" ::: "memory")
#define PG8_BAR __builtin_amdgcn_s_barrier()
#define PG8_SCHED __builtin_amdgcn_sched_barrier(0)
    Unit cur, nxt; int ui = 0;
    if (!S.next(0, cur)) return;
    f32x4 acc[2][2][4][2];
#pragma unroll
    for (int a = 0; a < 2; ++a)
#pragma unroll
        for (int b = 0; b < 2; ++b)
#pragma unroll
            for (int m = 0; m < 4; ++m)
#pragma unroll
                for (int n = 0; n < 2; ++n) acc[a][b][m][n] = (f32x4){0.f, 0.f, 0.f, 0.f};
    const unsigned scl1 = 0x7f7f7f7fu;
    bf16x8 At[4][2], B0[2][2], B1[2][2]; v8i32 At8[4], B08[2], B18[2];
    const char* cA = GATHER ? (const char*)g.A : (const char*)g.A + (size_t)cur.pm * tstep; const char* cB = (const char*)g.Bt + (size_t)cur.pn * tstep;
    S.a_ready(cur);
    static_assert(!GATHER || SP2, "GATHER is written for the SP2 loop");
#define PG8_HSTAB(slot, pm_) do { if (tid < 256) { const float* sp_ = hs.ss + ((size_t)(pm_) * BM + tid) * 16; float rr_[4]; \
        _Pragma("unroll") for (int h_ = 0; h_ < 4; ++h_) { const f32x4 p_ = *(const f32x4*)(sp_ + 4 * h_); rr_[h_] = 1.0f / sqrtf(((p_[0] + p_[1]) + (p_[2] + p_[3])) * (1.0f / 512.f) + hs.eps); } \
        *(PG8_LAS f32x4*)(hs.tab + (slot) * 1024 + tid * 4) = (f32x4){rr_[0] / rr_[1], rr_[1] / rr_[2], rr_[2] / rr_[3], rr_[3]}; } } while (0)
#define PG8_HSMUL(slot, h_) do { _Pragma("unroll") for (int ai_ = 0; ai_ < 2; ++ai_) _Pragma("unroll") for (int m_ = 0; m_ < 4; ++m_) { const float f_ = hs.tab[(slot) * 1024 + (ai_ * HALF + wr * 64 + m_ * 16 + fr) * 4 + (h_)]; \
        _Pragma("unroll") for (int bj_ = 0; bj_ < 2; ++bj_) _Pragma("unroll") for (int n_ = 0; n_ < 2; ++n_) acc[ai_][bj_][m_][n_] = acc[ai_][bj_][m_][n_] * f_; } } while (0)
    if constexpr (HSCALE) { PG8_HSTAB(0, cur.pm); PG8_WAIT_L(0); PG8_BAR; }
    if constexpr (SP2) {
        if constexpr (GATHER) { unsigned v0[2], v1[2]; PG8_GVOFF(v0, 0, 0); PG8_GVOFF(v1, 0, 1); PG8_STAGE(PG8_SB(0, 0), cB, voffB); PG8_STAGE(PG8_SB(0, 1), cB + hstep, voffB); PG8_STAGE(PG8_SA(0, 0), cA, v0); PG8_STAGE(PG8_SA(0, 1), cA, v1); }
        else { PG8_STAGE(PG8_SB(0, 0), cB, voffB); PG8_STAGE(PG8_SB(0, 1), cB + hstep, voffB); PG8_STAGE(PG8_SA(0, 0), cA, voffA); PG8_STAGE(PG8_SA(0, 1), cA + hstep, voffA); }
        if (wr == 1) PG8_BAR;
        PG8_WAIT_V(2); PG8_BAR;
        if constexpr (GATHER) { unsigned v0[2]; PG8_GVOFF(v0, 0, 0); PG8_STAGE(PG8_SB(1, 0), cB + kstep, voffB); PG8_STAGE(PG8_SA(1, 0), cA + kstep, v0); PG8_STAGE(PG8_SB(1, 1), cB + hstep + kstep, voffB); }
        else { PG8_STAGE(PG8_SB(1, 0), cB + kstep, voffB); PG8_STAGE(PG8_SA(1, 0), cA + kstep, voffA); PG8_STAGE(PG8_SB(1, 1), cB + hstep + kstep, voffB); }
        PG8_WAIT_V(6); PG8_BAR;
    } else {
        PG8_STAGE(PG8_SB(0, 0), cB, voffB); PG8_STAGE(PG8_SA(0, 0), cA, voffA); PG8_STAGE(PG8_SB(0, 1), cB + hstep, voffB); PG8_STAGE(PG8_SA(0, 1), cA + hstep, voffA);
        if (wr == 1) PG8_BAR;
        PG8_WAIT_V(4); PG8_BAR;
        PG8_STAGE(PG8_SB(1, 0), cB + kstep, voffB); PG8_STAGE(PG8_SA(1, 0), cA + kstep, voffA); PG8_STAGE(PG8_SB(1, 1), cB + hstep + kstep, voffB);
        PG8_WAIT_V(6); PG8_BAR;
    }
    for (;;) {
        const bool has_next = S.next(ui + 1, nxt);
        const char* nA = GATHER ? cA : (has_next ? (const char*)g.A + (size_t)nxt.pm * tstep : cA); const char* nB = has_next ? (const char*)g.Bt + (size_t)nxt.pn * tstep : cB;
#pragma unroll 1
        for (int t = 0; t < nt; t += 2) {
            asm volatile("" : "+v"(voffA[0]), "+v"(voffA[1]), "+v"(voffB[0]), "+v"(voffB[1]));
            const bool last = (t == nt - 2);
            const char* a1 = cA + (size_t)(t + 1) * kstep;
            const char* a2 = last ? nA : cA + (size_t)(t + 2) * kstep; const char* b2 = last ? nB : cB + (size_t)(t + 2) * kstep;
            const char* a3 = a2 + kstep; const char* b3 = b2 + kstep;
            if (last && has_next) S.a_ready(nxt);
            if constexpr (HSCALE) { if (last && has_next) PG8_HSTAB((ui + 1) & 1, nxt.pm);
                                    if (t == 8 || t == 16 || t == 24) PG8_HSMUL(ui & 1, (t >> 3) - 1); }
            const bool rlx = (t == 0) && (ui > 0);
#define PG8_WAIT_V8R do { if (rlx) wait_vm<8 + Epi::NST>(); else wait_vm<8>(); } while (0)
            if constexpr (SP2 && GATHER) {
            const int uix = (last && has_next) ? ui + 1 : ui;
            unsigned vc1[2], vx0[2], vx1[2]; PG8_GVOFF(vc1, ui, 1); PG8_GVOFF(vx0, uix, 0); PG8_GVOFF(vx1, uix, 1);
            PG8_LDB(B0, 0, 0); PG8_LDB(B1, 0, 1); PG8_SCHED; PG8_LDA(At, 0, 0); PG8_STAGE(PG8_SA(1, 1), a1, vc1);
            PG8_WAIT_V8R; PG8_WAIT_L(0); PG8_BAR; PG8_MMA(0, 0, At, B0); PG8_MMA(0, 1, At, B1); PG8_BAR; PG8_SCHED;
            PG8_LDA(At, 0, 1); PG8_STAGE(PG8_SB(0, 0), b2, voffB); PG8_STAGE(PG8_SB(0, 1), b2 + hstep, voffB); PG8_STAGE(PG8_SA(0, 0), a2, vx0);
            PG8_WAIT_V8R; PG8_WAIT_L(0); PG8_BAR; PG8_MMA(1, 0, At, B0); PG8_MMA(1, 1, At, B1); PG8_BAR; PG8_SCHED;
            PG8_LDB(B0, 1, 0); PG8_LDB(B1, 1, 1); PG8_SCHED; PG8_LDA(At, 1, 0); PG8_STAGE(PG8_SA(0, 1), a2, vx1);
            PG8_WAIT_V(8); PG8_WAIT_L(0); PG8_BAR; PG8_MMA(0, 0, At, B0); PG8_MMA(0, 1, At, B1); PG8_BAR; PG8_SCHED;
            PG8_LDA(At, 1, 1); PG8_STAGE(PG8_SB(1, 0), b3, voffB); PG8_STAGE(PG8_SB(1, 1), b3 + hstep, voffB); PG8_STAGE(PG8_SA(1, 0), a3, vx0);
            PG8_WAIT_V(8); PG8_WAIT_L(0); PG8_BAR; PG8_MMA(1, 0, At, B0); PG8_MMA(1, 1, At, B1); PG8_BAR; PG8_SCHED;
            } else if constexpr (SP2) {
            PG8_LDB(B0, 0, 0); PG8_LDB(B1, 0, 1); PG8_SCHED; PG8_LDA(At, 0, 0); PG8_STAGE(PG8_SA(1, 1), a1 + hstep, voffA);
            PG8_WAIT_V8R; PG8_WAIT_L(0); PG8_BAR; PG8_MMA(0, 0, At, B0); PG8_MMA(0, 1, At, B1); PG8_BAR; PG8_SCHED;
            PG8_LDA(At, 0, 1); PG8_STAGE(PG8_SB(0, 0), b2, voffB); PG8_STAGE(PG8_SB(0, 1), b2 + hstep, voffB); PG8_STAGE(PG8_SA(0, 0), a2, voffA);
            PG8_WAIT_V8R; PG8_WAIT_L(0); PG8_BAR; PG8_MMA(1, 0, At, B0); PG8_MMA(1, 1, At, B1); PG8_BAR; PG8_SCHED;
            PG8_LDB(B0, 1, 0); PG8_LDB(B1, 1, 1); PG8_SCHED; PG8_LDA(At, 1, 0); PG8_STAGE(PG8_SA(0, 1), a2 + hstep, voffA);
            PG8_WAIT_V(8); PG8_WAIT_L(0); PG8_BAR; PG8_MMA(0, 0, At, B0); PG8_MMA(0, 1, At, B1); PG8_BAR; PG8_SCHED;
            PG8_LDA(At, 1, 1); PG8_STAGE(PG8_SB(1, 0), b3, voffB); PG8_STAGE(PG8_SB(1, 1), b3 + hstep, voffB); PG8_STAGE(PG8_SA(1, 0), a3, voffA);
            PG8_WAIT_V(8); PG8_WAIT_L(0); PG8_BAR; PG8_MMA(1, 0, At, B0); PG8_MMA(1, 1, At, B1); PG8_BAR; PG8_SCHED;
            } else {
            PG8_LDB(B0, 0, 0); PG8_SCHED; PG8_LDA(At, 0, 0); PG8_STAGE(PG8_SA(1, 1), a1 + hstep, voffA);
            PG8_WAIT_L(8); PG8_BAR; PG8_WAIT_L(0); PG8_MMA(0, 0, At, B0); PG8_BAR; PG8_SCHED;
            PG8_LDB(B1, 0, 1); PG8_STAGE(PG8_SB(0, 0), b2, voffB);
            PG8_BAR; PG8_WAIT_L(0); PG8_MMA(0, 1, At, B1); PG8_BAR;
            PG8_LDA(At, 0, 1); PG8_STAGE(PG8_SA(0, 0), a2, voffA);
            PG8_BAR; PG8_WAIT_L(0); PG8_MMA(1, 0, At, B0); PG8_BAR; PG8_SCHED;
            PG8_STAGE(PG8_SB(0, 1), b2 + hstep, voffB);
            PG8_WAIT_V(6); PG8_BAR; PG8_MMA(1, 1, At, B1); PG8_BAR;
            PG8_LDB(B0, 1, 0); PG8_SCHED; PG8_LDA(At, 1, 0); PG8_STAGE(PG8_SA(0, 1), a2 + hstep, voffA);
            PG8_WAIT_L(8); PG8_BAR; PG8_WAIT_L(0); PG8_MMA(0, 0, At, B0); PG8_BAR; PG8_SCHED;
            PG8_LDB(B1, 1, 1); PG8_STAGE(PG8_SB(1, 0), b3, voffB);
            PG8_BAR; PG8_WAIT_L(0); PG8_MMA(0, 1, At, B1); PG8_BAR;
            PG8_LDA(At, 1, 1); PG8_STAGE(PG8_SA(1, 0), a3, voffA);
            PG8_BAR; PG8_WAIT_L(0); PG8_MMA(1, 0, At, B0); PG8_BAR; PG8_SCHED;
            PG8_STAGE(PG8_SB(1, 1), b3 + hstep, voffB);
            PG8_WAIT_V(6); PG8_BAR; PG8_MMA(1, 1, At, B1); PG8_BAR;
            }
        }
        if constexpr (ALIGN_EPI) { if (wr == 0) PG8_BAR; }
        if constexpr (HSCALE) PG8_HSMUL(ui & 1, 3);
        if constexpr (FP8) asm volatile("s_nop 15\n\ts_nop 7" ::: "memory");
        { int te = threadIdx.x; asm volatile("" : "+v"(te));
          if constexpr (!NOEPI) E(acc, cur, wr, wc, te & 15, (te & 63) >> 4); else { float sink_ = 0.f; _Pragma("unroll") for (int a_ = 0; a_ < 2; ++a_) _Pragma("unroll") for (int b_ = 0; b_ < 2; ++b_) _Pragma("unroll") for (int m_ = 0; m_ < 4; ++m_) _Pragma("unroll") for (int n_ = 0; n_ < 2; ++n_) sink_ += acc[a_][b_][m_][n_][0]; asm volatile("" :: "v"(sink_)); } }
        if (!has_next) break;
#pragma unroll
        for (int a = 0; a < 2; ++a)
#pragma unroll
            for (int b = 0; b < 2; ++b)
#pragma unroll
                for (int m = 0; m < 4; ++m)
#pragma unroll
                    for (int n = 0; n < 2; ++n) acc[a][b][m][n] = (f32x4){0.f, 0.f, 0.f, 0.f};
        cur = nxt; cA = nA; cB = nB; ++ui;
        if constexpr (ALIGN_EPI) { if (wr == 1) PG8_BAR; }
    }
    PG8_WAIT_V(0);
    if constexpr (!ALIGN_EPI) { if (wr == 0) PG8_BAR; }
    PG8_BAR;
#undef PG8_GVOFF
#undef PG8_HSTAB
#undef PG8_HSMUL
#undef PG8_WAIT_V8R
#undef PG8_CAT
#undef PG8_SA
#undef PG8_SB
#undef PG8_STAGE
#undef PG8_LDA
#undef PG8_LDB
#undef PG8_MMA
#undef PG8_WAIT_V
#undef PG8_WAIT_L
#undef PG8_BAR
#undef PG8_SCHED
}
}

constexpr int NWAVES = 8;
constexpr int DM = 1024, NBATCH = 32, SEQ = 2048, MTOK = NBATCH * SEQ, DEPTH = 4, NEXP = 32, TOPK = 4;
constexpr int HG_N = 4096, RT_N = 6144, HG_H = 8, RT_H = 4;
constexpr float EPS = 1e-6f;
constexpr int LCAP = 65536;
constexpr int MAXTILES = 1056;
constexpr float YSC = 32.0f;
constexpr int YLD = DM;

constexpr size_t MiB = 1u << 20;
constexpr size_t WS_CTL = 0, CTL_ZERO_BYTES = 1 * MiB;
constexpr size_t WS_MOD = 1 * MiB;
constexpr size_t WS_FMOD = 4 * MiB;
constexpr size_t WS_LBV = 4 * MiB + 512 * 1024;
constexpr size_t WS_HWIN = 8 * MiB, WS_HWOUT = 24 * MiB, WS_RWIN = 28 * MiB, WS_RWOUT = 52 * MiB, WS_W1T = 64 * MiB, WS_W2T = 576 * MiB;
constexpr size_t WS_H = 832 * MiB;
constexpr size_t WS_LIST = 960 * MiB;
constexpr size_t WS_TSLOT = 968 * MiB, WS_TGATE = 969 * MiB;
constexpr size_t WS_R1 = 976 * MiB;
constexpr size_t WS_R2 = 1744 * MiB;
constexpr size_t WS_H8 = 2272 * MiB;
constexpr size_t WS_XB = 320 * MiB;
static_assert(MOE_FP8 == 1, "WS_XB lies in the half of the W1T region that bf16 expert weights would need");
constexpr size_t WS_END = 2336 * MiB;
constexpr int hg_rank(int s, int mask) { int r = 0; for (int i = 0; i < s; ++i) r += (mask >> i) & 1; return r; }
constexpr unsigned hg_smap(int mask) { unsigned m = 0; int r = 0; for (int i = 0; i < 4; ++i) if ((mask >> i) & 1) { m |= (unsigned)i << (4 * r); ++r; } return m; }
constexpr int HG_N8 = 1024 * hg_rank(4, HGRN_FP8_MASK), HG_N16 = 4096 - HG_N8;
constexpr size_t HG_W16_OFF = (size_t)2 * HG_N8 * DM;
static_assert((size_t)2 * HG_N8 * DM + (size_t)2 * HG_N16 * DM * 2 <= 16 * MiB, "HGRN input-projection weights overflow their workspace region");
constexpr int CW_BAR = 4096;
constexpr int CW_CNT = 8192;

constexpr int RING_OFF = 0, RING_BYTES = 131072;
constexpr int MISC_OFF = 155648;
constexpr int TAB_OFF = MISC_OFF + 128;
constexpr int LDS_BYTES = 160 * 1024;

#define GAS __attribute__((address_space(1)))
#define LAS __attribute__((address_space(3)))
typedef unsigned short bf16;
typedef unsigned v4u __attribute__((ext_vector_type(4)));
typedef unsigned v2u __attribute__((ext_vector_type(2)));
typedef float f32x4 __attribute__((ext_vector_type(4)));
typedef short bf16x8 __attribute__((ext_vector_type(8)));
#define RLX_AGENT __ATOMIC_RELAXED, __HIP_MEMORY_SCOPE_AGENT
#define LDS_WAIT() asm volatile("s_waitcnt lgkmcnt(0)" ::: "memory")
#define VM_WAIT() asm volatile("s_waitcnt vmcnt(0)" ::: "memory")
__device__ __forceinline__ unsigned pk2(float lo, float hi) { return pg8::cvt_pk_bf16(lo, hi); }
__device__ __forceinline__ unsigned pk4_fp8(float a, float b, float c, float d) { int p = 0; p = __builtin_amdgcn_cvt_pk_fp8_f32(a, b, p, false); p = __builtin_amdgcn_cvt_pk_fp8_f32(c, d, p, true); return (unsigned)p; }
__device__ __forceinline__ v4u pack8(const f32x4 a, const f32x4 b) { v4u w; w.x = pk2(a.x, a.y); w.y = pk2(a.z, a.w); w.z = pk2(b.x, b.y); w.w = pk2(b.z, b.w); return w; }
__device__ __forceinline__ float bflo(unsigned w) { return __uint_as_float(w << 16); }
__device__ __forceinline__ float bfhi(unsigned w) { return __uint_as_float(w & 0xffff0000u); }
__device__ __forceinline__ float bf2f(unsigned short h) { return __uint_as_float(((unsigned)h) << 16); }
__device__ __forceinline__ float sigmoidf_(float x) { return __builtin_amdgcn_rcpf(1.f + __expf(-x)); }
__device__ __forceinline__ float siluf_(float x) { return x * sigmoidf_(x); }
__device__ __forceinline__ f32x4 silu4_(const f32x4 x) {
    const f32x4 t = x * -1.4426950408889634f; f32x4 e, r;
#pragma unroll
    for (int j = 0; j < 4; ++j) e[j] = __builtin_amdgcn_exp2f(t[j]);
    const f32x4 d = e + 1.0f;
#pragma unroll
    for (int j = 0; j < 4; ++j) r[j] = __builtin_amdgcn_rcpf(d[j]);
    return x * r;
}
__device__ __forceinline__ unsigned ldu_vec(const unsigned* p) { return __hip_atomic_load(p, RLX_AGENT); }

#define XB_TMO      128
#define XB_XCNT(j)  (256  + 64 * (j))
#define XB_XSUB(j)  (1280 + 64 * (j))
#define XB_XGEN(j)  (2304 + 64 * (j))
#define XB_TOP      3328
#define XB_TOPGEN   3392
#define XCD_BAR_WORDS 3456
#define XB_SPIN_CAP (1u << 18)

__device__ __forceinline__ unsigned xb_ld(unsigned* p)              { return __hip_atomic_load(p, __ATOMIC_RELAXED, __HIP_MEMORY_SCOPE_AGENT); }
__device__ __forceinline__ unsigned xb_add(unsigned* p, unsigned v) { return __hip_atomic_fetch_add(p, v, __ATOMIC_RELAXED, __HIP_MEMORY_SCOPE_AGENT); }
__device__ __forceinline__ unsigned xb_xcc_id() { return (unsigned)__builtin_amdgcn_s_getreg((3 << 11) | 20) & 0xFu; }
#define XB_SPIN(cond, bar) do { unsigned _sp = 0; while (cond) { __builtin_amdgcn_s_sleep(1); \
    if ((++_sp & 255u) == 0u) { if (xb_ld(&(bar)[XB_TMO])) break; if (_sp > XB_SPIN_CAP) { atomicAdd(&(bar)[XB_TMO], 1u); break; } } } } while (0)

struct XcdBarrier {
    unsigned* bar; unsigned x;
    volatile LAS unsigned* st;
};
__device__ __forceinline__ XcdBarrier xcd_barrier_post(unsigned* bar, volatile LAS unsigned* st) {
    XcdBarrier b; b.bar = bar; b.x = xb_xcc_id(); b.st = st;
    if (threadIdx.x == 0) (void)xb_add(&bar[XB_XCNT(b.x)], 1u);
    return b;
}
__device__ __forceinline__ void xcd_barrier_complete(unsigned* bar, unsigned x, unsigned& nloc, unsigned& nx) {
    const unsigned G = gridDim.x * gridDim.y * gridDim.z;
    unsigned sum, cnt, mine, sp = 0u;
    for (;;) {
        sum = 0u; cnt = 0u; mine = 0u;
#pragma unroll
        for (unsigned j = 0; j < 16; ++j) { const unsigned c = xb_ld(&bar[XB_XCNT(j)]); sum += c; cnt += (c > 0u) ? 1u : 0u; mine = (j == x) ? c : mine; }
        if (sum == G) break;
        __builtin_amdgcn_s_sleep(1);
        if ((++sp & 255u) == 0u) { if (xb_ld(&bar[XB_TMO])) break; if (sp > XB_SPIN_CAP) { atomicAdd(&bar[XB_TMO], 1u); break; } }
    }
    nloc = mine > 0u ? mine : 1u; nx = cnt > 0u ? cnt : 1u;
}
__device__ __forceinline__ void xcd_barrier(const XcdBarrier& b) {
    asm volatile("s_waitcnt vmcnt(0)" ::: "memory");
    __syncthreads();
    if (threadIdx.x == 0) {
        unsigned* bar = b.bar;
        __builtin_amdgcn_s_waitcnt(0);
        unsigned nloc = b.st[0], nx = b.st[1];
        if (nloc == 0u) { xcd_barrier_complete(bar, b.x, nloc, nx); b.st[0] = nloc; b.st[1] = nx; }
        const unsigned old = xb_add(&bar[XB_XSUB(b.x)], 1u);
        const unsigned gen = old / nloc;
        if (old + 1u == (gen + 1u) * nloc) {
            __builtin_amdgcn_fence(__ATOMIC_RELEASE, "agent");
            asm volatile("s_waitcnt vmcnt(0)" ::: "memory");
            const unsigned og = xb_add(&bar[XB_TOP], 1u);
            const unsigned tg = og / nx;
            if (og + 1u == (tg + 1u) * nx) xb_add(&bar[XB_TOPGEN], 1u);
            else XB_SPIN(xb_ld(&bar[XB_TOPGEN]) == tg, bar);
            __builtin_amdgcn_fence(__ATOMIC_ACQUIRE, "agent");
            xb_add(&bar[XB_XGEN(b.x)], 1u);
            asm volatile("s_waitcnt vmcnt(0)" ::: "memory");
        } else {
            XB_SPIN(xb_ld(&bar[XB_XGEN(b.x)]) == gen, bar);
            __builtin_amdgcn_fence(__ATOMIC_ACQUIRE, "agent");
            asm volatile("s_waitcnt vmcnt(0)" ::: "memory");
        }
    }
    __syncthreads();
}

struct Frame {
    LAS unsigned char* lds;
    unsigned* ctl;
    int tid, lane, wave, vcu, G;
    float* out; unsigned char* ws;
};
__device__ __forceinline__ void relaunder(Frame& F) { int t = threadIdx.x; asm volatile("" : "+v"(t)); F.tid = t; F.lane = t & 63; F.wave = __builtin_amdgcn_readfirstlane(t >> 6); }
#define KAS __attribute__((address_space(4)))
__device__ __forceinline__ const void* kin_(int i) { const KAS char* kp = (const KAS char*)__builtin_amdgcn_kernarg_segment_ptr(); asm volatile("" : "+s"(kp)); return *(const void* const KAS*)(kp + 8 * i); }
enum { I_X = 0, I_C, I_POS, I_ADAW, I_ADAB, I_N1G, I_N2G, I_HWIN, I_HWOUT, I_HGAIN, I_HLB, I_RWIN, I_RWOUT, I_RTW, I_RTB, I_W1, I_B1, I_W2, I_B2, I_FG, I_FADAW, I_FADAB };
#define KIN(i) ((const float*)kin_(i))
__device__ __forceinline__ float wave_sum(float v) {
#pragma unroll
    for (int o = 1; o < 64; o <<= 1) v += __shfl_xor(v, o);
    return v;
}

__device__ __forceinline__ void p0_transpose_item(const float* W, int N, bf16* WT, int K, int k0, int n0, int drow0, LAS float* scr, int lane) {
    float wv[32];
#pragma unroll
    for (int i = 0; i < 32; ++i) wv[i] = W[(size_t)(k0 + 2 * i + (lane >> 5)) * N + n0 + (lane & 31)];
#pragma unroll
    for (int i = 0; i < 32; ++i) scr[(2 * i + (lane >> 5)) * 33 + (lane & 31)] = wv[i];
    LDS_WAIT(); asm volatile("" ::: "memory");
    const int c = lane & 7;
#pragma unroll
    for (int j = 0; j < 4; ++j) { const int n = (lane >> 3) + 8 * j; const LAS float* s = scr + (8 * c) * 33 + n;
        v4u o; o.x = pk2(s[0 * 33], s[1 * 33]); o.y = pk2(s[2 * 33], s[3 * 33]); o.z = pk2(s[4 * 33], s[5 * 33]); o.w = pk2(s[6 * 33], s[7 * 33]);
        *(GAS v4u*)(WT + (size_t)(drow0 + n) * K + k0 + 8 * c) = o; }
    LDS_WAIT(); asm volatile("" ::: "memory");
}
__device__ __forceinline__ void p0_transpose_item_f8(const float* W, int N, unsigned char* WT, int K, int k0, int n0, int drow0, LAS float* scr, int lane, float scale) {
    float wv[32];
#pragma unroll
    for (int i = 0; i < 32; ++i) wv[i] = W[(size_t)(k0 + 2 * i + (lane >> 5)) * N + n0 + (lane & 31)];
#pragma unroll
    for (int i = 0; i < 32; ++i) scr[(2 * i + (lane >> 5)) * 33 + (lane & 31)] = wv[i];
    LDS_WAIT(); asm volatile("" ::: "memory");
    const int n = lane >> 1, hf = lane & 1; const LAS float* sp = scr + (32 * hf) * 33 + n;
    v4u o0, o1;
    o0.x = pk4_fp8(sp[0 * 33] * scale, sp[1 * 33] * scale, sp[2 * 33] * scale, sp[3 * 33] * scale); o0.y = pk4_fp8(sp[4 * 33] * scale, sp[5 * 33] * scale, sp[6 * 33] * scale, sp[7 * 33] * scale);
    o0.z = pk4_fp8(sp[8 * 33] * scale, sp[9 * 33] * scale, sp[10 * 33] * scale, sp[11 * 33] * scale); o0.w = pk4_fp8(sp[12 * 33] * scale, sp[13 * 33] * scale, sp[14 * 33] * scale, sp[15 * 33] * scale);
    o1.x = pk4_fp8(sp[16 * 33] * scale, sp[17 * 33] * scale, sp[18 * 33] * scale, sp[19 * 33] * scale); o1.y = pk4_fp8(sp[20 * 33] * scale, sp[21 * 33] * scale, sp[22 * 33] * scale, sp[23 * 33] * scale);
    o1.z = pk4_fp8(sp[24 * 33] * scale, sp[25 * 33] * scale, sp[26 * 33] * scale, sp[27 * 33] * scale); o1.w = pk4_fp8(sp[28 * 33] * scale, sp[29 * 33] * scale, sp[30 * 33] * scale, sp[31 * 33] * scale);
    unsigned char* d = WT + (size_t)(drow0 + n) * K + k0 + 32 * hf; *(GAS v4u*)d = o0; *(GAS v4u*)(d + 16) = o1;
    LDS_WAIT(); asm volatile("" ::: "memory");
}
__device__ __forceinline__ void p0_prologue(Frame& F) {
    relaunder(F);
    __syncthreads();
    const int gw = F.vcu * NWAVES + F.wave, NGW = F.G * NWAVES;
    {
        LAS float* condT = (LAS float*)(F.lds + RING_OFF);
        const float* cin = KIN(I_C);
        for (int idx = F.tid; idx < NBATCH * DM; idx += NWAVES * 64) { const int b = idx >> 10, k = idx & 1023; condT[k * 32 + b] = siluf_(cin[idx]); }
        __syncthreads();
        { const int gsel = F.wave >> 2, kq = F.wave & 3, u = 2 * F.vcu + gsel; const bool act = (u < 416);
          const float* W = nullptr; const float* bias = nullptr; float* outp = nullptr; int N = 0, n0 = 0;
          if (act) { if (u < 384) { const int l = u / 96; n0 = (u % 96) * 64; N = 6 * DM; W = KIN(I_ADAW) + (size_t)l * DM * N; bias = KIN(I_ADAB) + l * N; outp = (float*)(F.ws + WS_MOD) + (size_t)l * NBATCH * N; }
                     else { n0 = (u - 384) * 64; N = 2 * DM; W = KIN(I_FADAW); bias = KIN(I_FADAB); outp = (float*)(F.ws + WS_FMOD); } }
          float acc[32];
#pragma unroll
          for (int b = 0; b < 32; ++b) acc[b] = 0.f;
          if (act) {
#pragma unroll 4
              for (int k = 256 * kq; k < 256 * kq + 256; ++k) {
                  const float w = W[(size_t)k * N + n0 + F.lane];
                  const LAS f32x4* cb = (const LAS f32x4*)(condT + k * 32);
#pragma unroll
                  for (int q = 0; q < 8; ++q) { const f32x4 cv = cb[q]; acc[4 * q + 0] += cv.x * w; acc[4 * q + 1] += cv.y * w; acc[4 * q + 2] += cv.z * w; acc[4 * q + 3] += cv.w * w; }
              } }
          __syncthreads();
          LAS float* red = (LAS float*)(F.lds + RING_OFF) + F.wave * 2048;
#pragma unroll
          for (int b = 0; b < 32; ++b) red[b * 64 + F.lane] = acc[b];
          __syncthreads();
          if (act && kq == 0) { const float bv = bias[n0 + F.lane];
#pragma unroll
              for (int b = 0; b < 32; ++b) { const LAS float* r0 = (const LAS float*)(F.lds + RING_OFF) + (4 * gsel) * 2048 + b * 64 + F.lane;
                  outp[(size_t)b * N + n0 + F.lane] = ((r0[0] + r0[2048]) + (r0[4096] + r0[6144])) + bv; } }
        }
        if (gw == NGW - 1) {
            float* lbv = (float*)(F.ws + WS_LBV); const float* hlb = KIN(I_HLB);
            for (int d = F.lane; d < DM; d += 64) { const float a = hlb[d], b = hlb[DM + d], m = fmaxf(a, b), ea = __expf(a - m), eb = __expf(b - m); lbv[d] = 0.f; lbv[DM + d] = eb / (ea + eb); }
        }
        __syncthreads();
    }
    {
        LAS float* scr = (LAS float*)(F.lds + RING_OFF + F.wave * 16384);
        constexpr int NI_HI = 2 * 16 * 128, NI_HO = 2 * 16 * 32, NI_RI = 2 * 16 * 192, NI_RO = 2 * 32 * 32, NI_W1 = 128 * 16 * 64, NI_W2 = 128 * 16 * 32;
        constexpr int NITEMS = NI_HI + NI_HO + NI_RI + NI_RO + NI_W1 + NI_W2;
        for (int it = gw; it < NITEMS; it += NGW) {
            int r = it;
            if (r < NI_HI) { const int j = r / 2048, q = r % 2048, kb = q / 128, nb = q % 128;
                const int sg = nb >> 5, nl = 32 * (nb & 31);
                if ((HGRN_FP8_MASK >> sg) & 1) p0_transpose_item_f8(KIN(I_HWIN) + (size_t)j * DM * HG_N, HG_N, F.ws + WS_HWIN + (size_t)j * HG_N8 * DM, DM, 64 * kb, 32 * nb, 1024 * hg_rank(sg, HGRN_FP8_MASK) + nl, scr, F.lane, 64.0f);
                else p0_transpose_item(KIN(I_HWIN) + (size_t)j * DM * HG_N, HG_N, (bf16*)(F.ws + WS_HWIN + HG_W16_OFF) + (size_t)j * HG_N16 * DM, DM, 64 * kb, 32 * nb, 1024 * hg_rank(sg, 0xF & ~HGRN_FP8_MASK) + nl, scr, F.lane);
                continue; } r -= NI_HI;
            if (r < NI_HO) { const int j = r / 512, q = r % 512, kb = q / 32, nb = q % 32;
                p0_transpose_item(KIN(I_HWOUT) + (size_t)j * DM * DM, DM, (bf16*)(F.ws + WS_HWOUT) + (size_t)j * DM * DM, DM, 64 * kb, 32 * nb, 32 * nb, scr, F.lane); continue; } r -= NI_HO;
            if (r < NI_RI) { const int j = r / 3072, q = r % 3072, kb = q / 192, nb = q % 192;
                if (RET_IN_FP8) p0_transpose_item_f8(KIN(I_RWIN) + (size_t)j * DM * RT_N, RT_N, F.ws + WS_RWIN + (size_t)j * RT_N * DM, DM, 64 * kb, 32 * nb, 32 * nb, scr, F.lane, 64.0f);
                else p0_transpose_item(KIN(I_RWIN) + (size_t)j * DM * RT_N, RT_N, (bf16*)(F.ws + WS_RWIN) + (size_t)j * RT_N * DM, DM, 64 * kb, 32 * nb, 32 * nb, scr, F.lane);
                continue; } r -= NI_RI;
            if (r < NI_RO) { const int j = r / 1024, q = r % 1024, kb = q / 32, nb = q % 32;
                p0_transpose_item(KIN(I_RWOUT) + (size_t)j * 2048 * DM, DM, (bf16*)(F.ws + WS_RWOUT) + (size_t)j * DM * 2048, 2048, 64 * kb, 32 * nb, 32 * nb, scr, F.lane); continue; } r -= NI_RO;
            if (r < NI_W1) { const int mi = r / 1024, q = r % 1024, kb = q / 64, nb = q % 64; const int n0 = 32 * nb;
                const int cc = n0 & 1023, drow0 = 256 * (cc >> 7) + (cc & 127) + ((n0 >= 1024) ? 128 : 0);
                if (MOE_FP8) p0_transpose_item_f8(KIN(I_W1) + (size_t)mi * DM * 2048, 2048, F.ws + WS_W1T + (size_t)mi * 2048 * DM, DM, 64 * kb, n0, drow0, scr, F.lane, 64.0f);
                else p0_transpose_item(KIN(I_W1) + (size_t)mi * DM * 2048, 2048, (bf16*)(F.ws + WS_W1T) + (size_t)mi * 2048 * DM, DM, 64 * kb, n0, drow0, scr, F.lane);
                continue; } r -= NI_W1;
            { const int mi = r / 512, q = r % 512, kb = q / 32, nb = q % 32;
                if (MOE_FP8) p0_transpose_item_f8(KIN(I_W2) + (size_t)mi * DM * DM, DM, F.ws + WS_W2T + (size_t)mi * DM * DM, DM, 64 * kb, 32 * nb, 32 * nb, scr, F.lane, 64.0f);
                else p0_transpose_item(KIN(I_W2) + (size_t)mi * DM * DM, DM, (bf16*)(F.ws + WS_W2T) + (size_t)mi * DM * DM, DM, 64 * kb, 32 * nb, 32 * nb, scr, F.lane); }
        }
    }
}

__device__ __forceinline__ void phase_skew(Frame& F, unsigned ticks) {
    const unsigned long long t0 = __builtin_amdgcn_s_memrealtime(), d = (unsigned long long)((unsigned)F.vcu & 7u) * ticks;
    while (__builtin_amdgcn_s_memrealtime() - t0 < d) __builtin_amdgcn_s_sleep(4);
}
__device__ __forceinline__ void build_tiles(Frame& F, int l) {
    LAS int* ts = (LAS int*)(F.lds + TAB_OFF); LAS int* cnt = ts + 40;
    __syncthreads();
    if (F.tid < NEXP) cnt[F.tid] = (int)ldu_vec(F.ctl + CW_CNT + l * 2048 + F.tid * 64);
    __syncthreads();
    if (F.tid == 0) { int a = 0; for (int e = 0; e < NEXP; ++e) { ts[e] = a; a += (cnt[e] + 255) >> 8; } ts[NEXP] = a; }
    __syncthreads();
}

__device__ __forceinline__ void row_phase1(Frame& F, int l, int mode, bool dry = false) {
    relaunder(F);
    float* xdst = dry ? (float*)(F.ws + WS_R2) : F.out;
    bf16* xbd = dry ? (bf16*)(F.ws + WS_R2) : (bf16*)(F.ws + WS_XB);
    const bf16* xb = (const bf16*)(F.ws + WS_XB);
    const LAS int* ts = (const LAS int*)(F.lds + TAB_OFF);
    const bool comb = (l > 0);
    if (comb) build_tiles(F, l - 1);
    const float* xsrc = KIN(I_X);
    const unsigned char* Y = F.ws + WS_R1;
    const unsigned* tslot = (const unsigned*)(F.ws + WS_TSLOT); const unsigned* tgate = (const unsigned*)(F.ws + WS_TGATE);
    bf16* H = dry ? (bf16*)(F.ws + WS_R2 + 256 * MiB) : (bf16*)(F.ws + WS_H);
    const int cl = 8 * F.lane;
#define RP_COL(j) (cl + 512 * ((j) >> 1) + 4 * ((j) & 1))
    for (int rb = F.vcu * 256; rb < MTOK; rb += F.G * 256) {
        const int b = rb / SEQ;
        f32x4 A[4], B[4], G2[4];
#pragma unroll
        for (int j = 0; j < 4; ++j) {
            const int c = RP_COL(j);
            if (mode == 0) { const float* mv = (const float*)(F.ws + WS_MOD) + (size_t)(l * NBATCH + b) * 6 * DM;
                const f32x4 g = *(const f32x4*)(KIN(I_N1G) + l * DM + c), sc = *(const f32x4*)(mv + 1 * DM + c); A[j] = g * (sc + 1.0f); B[j] = *(const f32x4*)(mv + c); }
            else { const float* fm = (const float*)(F.ws + WS_FMOD) + (size_t)b * 2 * DM;
                const f32x4 g = *(const f32x4*)(KIN(I_FG) + c), sc = *(const f32x4*)(fm + DM + c); A[j] = g * (sc + 1.0f); B[j] = *(const f32x4*)(fm + c); }
            if (comb) G2[j] = *(const f32x4*)((const float*)(F.ws + WS_MOD) + (size_t)((l - 1) * NBATCH + b) * 6 * DM + 5 * DM + c) * (1.0f / YSC); else G2[j] = (f32x4){0.f, 0.f, 0.f, 0.f};
        }
        f32x4 xn[4]; v4u xq[2]; unsigned sln = 0u, gtn = 0u;
        { const int row = rb + 32 * F.wave;
          if (comb) {
#pragma unroll
              for (int p = 0; p < 2; ++p) xq[p] = *(const v4u*)(xb + (size_t)row * DM + cl + 512 * p);
              sln = tslot[(size_t)row * 4 + (F.lane & 3)]; gtn = tgate[(size_t)row * 4 + (F.lane & 3)];
          } else {
#pragma unroll
              for (int j = 0; j < 4; ++j) xn[j] = *(const f32x4*)(xsrc + (size_t)row * DM + RP_COL(j));
          } }
        for (int r = 0; r < 32; ++r) {
            const int row = rb + 32 * F.wave + r;
            f32x4 v[4];
            if (comb) {
#pragma unroll
                for (int p = 0; p < 2; ++p) { const v4u q = xq[p]; v[2 * p] = (f32x4){bflo(q.x), bfhi(q.x), bflo(q.y), bfhi(q.y)}; v[2 * p + 1] = (f32x4){bflo(q.z), bfhi(q.z), bflo(q.w), bfhi(q.w)}; }
            } else {
#pragma unroll
                for (int j = 0; j < 4; ++j) v[j] = xn[j];
            }
            const unsigned sl = sln, gt = gtn;
            v2u yw[TOPK][2]; float gkk[TOPK];
            if (comb) {
#pragma unroll
                for (int k = 0; k < TOPK; ++k) {
                    const unsigned s_ = (unsigned)__shfl((int)sl, k); gkk[k] = __uint_as_float((unsigned)__shfl((int)gt, k));
                    const int e = (int)(s_ >> 20), pos = (int)(s_ & 0xFFFFFu); const size_t yrow = (size_t)ts[e] * 256 + pos;
#pragma unroll
                    for (int p = 0; p < 2; ++p) yw[k][p] = *(const v2u*)(Y + yrow * YLD + cl + 512 * p); }
            }
            if (r + 1 < 32) { const int rn = row + 1;
                if (comb) {
#pragma unroll
                    for (int p = 0; p < 2; ++p) xq[p] = *(const v4u*)(xb + (size_t)rn * DM + cl + 512 * p);
                    sln = tslot[(size_t)rn * 4 + (F.lane & 3)]; gtn = tgate[(size_t)rn * 4 + (F.lane & 3)];
                } else {
#pragma unroll
                    for (int j = 0; j < 4; ++j) xn[j] = *(const f32x4*)(xsrc + (size_t)rn * DM + RP_COL(j));
                } }
            if (comb) {
                f32x4 ys[4];
#pragma unroll
                for (int j = 0; j < 4; ++j) ys[j] = (f32x4){0.f, 0.f, 0.f, 0.f};
#pragma unroll
                for (int k = 0; k < TOPK; ++k) { const float gk = gkk[k];
#pragma unroll
                    for (int p = 0; p < 2; ++p) { const v2u w = yw[k][p];
                        const auto f0 = __builtin_amdgcn_cvt_pk_f32_fp8((int)w.x, false), f1 = __builtin_amdgcn_cvt_pk_f32_fp8((int)w.x, true), f2 = __builtin_amdgcn_cvt_pk_f32_fp8((int)w.y, false), f3 = __builtin_amdgcn_cvt_pk_f32_fp8((int)w.y, true);
                        ys[2 * p].x += gk * f0[0]; ys[2 * p].y += gk * f0[1]; ys[2 * p].z += gk * f1[0]; ys[2 * p].w += gk * f1[1];
                        ys[2 * p + 1].x += gk * f2[0]; ys[2 * p + 1].y += gk * f2[1]; ys[2 * p + 1].z += gk * f3[0]; ys[2 * p + 1].w += gk * f3[1]; } }
#pragma unroll
                for (int j = 0; j < 4; ++j) v[j] = v[j] + G2[j] * ys[j];
                if (mode == 0) {
#pragma unroll
                    for (int p = 0; p < 2; ++p) *(v4u*)(xbd + (size_t)row * DM + cl + 512 * p) = pack8(v[2 * p], v[2 * p + 1]);
                }
            }
            float s2 = 0.f;
#pragma unroll
            for (int j = 0; j < 4; ++j) s2 += (v[j].x * v[j].x + v[j].y * v[j].y) + (v[j].z * v[j].z + v[j].w * v[j].w);
            const float rstd = 1.0f / sqrtf(wave_sum(s2) * (1.0f / DM) + EPS);
            if (mode == 0) {
#pragma unroll
                for (int p = 0; p < 2; ++p) { const f32x4 h0 = v[2 * p] * rstd * A[2 * p] + B[2 * p], h1 = v[2 * p + 1] * rstd * A[2 * p + 1] + B[2 * p + 1];
                    const bool w8 = ((l & 1) ? (RET_IN_FP8 != 0) : (HGRN_FP8_MASK != 0)) && !dry, w16 = ((l & 1) ? (RET_IN_FP8 == 0) : (HGRN_FP8_MASK != 0xF)) || dry;
                    if (w8) { v2u w; w.x = pk4_fp8(h0.x * 8.0f, h0.y * 8.0f, h0.z * 8.0f, h0.w * 8.0f); w.y = pk4_fp8(h1.x * 8.0f, h1.y * 8.0f, h1.z * 8.0f, h1.w * 8.0f); *(v2u*)(F.ws + WS_H8 + (size_t)row * DM + cl + 512 * p) = w; }
                    if (w16) *(v4u*)(H + (size_t)row * DM + cl + 512 * p) = pack8(h0, h1); }
            } else {
#pragma unroll
                for (int j = 0; j < 4; ++j) *(f32x4*)(xdst + (size_t)row * DM + RP_COL(j)) = v[j] * rstd * A[j] + B[j];
            }
        }
    }
#undef RP_COL
}

__device__ __forceinline__ void row_phase2(Frame& F, int l, bool dry = false) {
    relaunder(F);
    bf16* H = dry ? (bf16*)(F.ws + WS_R2) : (bf16*)(F.ws + WS_H); unsigned char* H8p = dry ? F.ws + WS_R2 + 128 * MiB : F.ws + WS_H8;
    LAS unsigned char* frag = F.lds + RING_OFF;
    LAS float* lg = (LAS float*)(F.lds + 131072 + F.wave * 2112);
    LAS int* cntL = (LAS int*)(F.lds + 147968); LAS int* baseL = cntL + 32; LAS float* rbias = (LAS float*)(cntL + 64);
    unsigned* list = (unsigned*)(F.ws + WS_LIST); unsigned* tslot = (unsigned*)(F.ws + WS_TSLOT); float* tgate = (float*)(F.ws + WS_TGATE);
    __syncthreads();
    { const float* rw = KIN(I_RTW) + (size_t)l * DM * NEXP;
#pragma unroll
      for (int it = F.tid; it < 32 * 2 * 64; it += NWAVES * 64) { const int ln = it & 63, nt = (it >> 6) & 1, s = it >> 7; const int e = 16 * nt + (ln & 15), k0 = 32 * s + 8 * (ln >> 4);
          float w[8], hi[8];
#pragma unroll
          for (int j = 0; j < 8; ++j) { w[j] = rw[(size_t)(k0 + j) * NEXP + e]; }
          v4u ph, pl;
          { unsigned a = pk2(w[0], w[1]), b2 = pk2(w[2], w[3]), c2 = pk2(w[4], w[5]), d2 = pk2(w[6], w[7]); ph = (v4u){a, b2, c2, d2};
            hi[0] = bflo(a); hi[1] = bfhi(a); hi[2] = bflo(b2); hi[3] = bfhi(b2); hi[4] = bflo(c2); hi[5] = bfhi(c2); hi[6] = bflo(d2); hi[7] = bfhi(d2); }
          pl = (v4u){pk2(w[0] - hi[0], w[1] - hi[1]), pk2(w[2] - hi[2], w[3] - hi[3]), pk2(w[4] - hi[4], w[5] - hi[5]), pk2(w[6] - hi[6], w[7] - hi[7])};
          *(LAS v4u*)(frag + ((s * 2 + nt) * 2 + 0) * 1024 + ln * 16) = ph; *(LAS v4u*)(frag + ((s * 2 + nt) * 2 + 1) * 1024 + ln * 16) = pl; }
      if (F.tid < NEXP) rbias[F.tid] = KIN(I_RTB)[l * NEXP + F.tid];
    }
    LAS float* modA = (LAS float*)(F.lds + 148480); LAS float* modB = (LAS float*)(F.lds + 156160);
    for (int rb = F.vcu * 256; rb < MTOK; rb += F.G * 256) {
        const int b = rb / SEQ;
        if (F.tid < NEXP) cntL[F.tid] = 0;
        { const float* mv = (const float*)(F.ws + WS_MOD) + (size_t)(l * NBATCH + b) * 6 * DM;
          int t1 = threadIdx.x; asm volatile("" : "+v"(t1));
          for (int c = t1; c < DM; c += NWAVES * 64) { modA[c] = KIN(I_N2G)[l * DM + c] * (mv[4 * DM + c] + 1.0f); modB[c] = mv[3 * DM + c]; } }
        __syncthreads();
        int my_el[2][TOPK]; float my_g[2][TOPK];
#pragma unroll
        for (int grp = 0; grp < 2; ++grp) {
            __builtin_amdgcn_sched_barrier(0);
            const int row0 = rb + 32 * F.wave + 16 * grp, rr = F.lane & 15, gq = F.lane >> 4;
            const bf16* xp = (const bf16*)(F.ws + WS_XB) + (size_t)(row0 + rr) * DM + 8 * gq; unsigned char* h8 = H8p + (size_t)(row0 + rr) * DM + 8 * gq;
            v4u xr[32]; float s2 = 0.f;
#pragma unroll
            for (int s_ = 0; s_ < 32; ++s_) xr[s_] = *(const v4u*)(xp + 32 * s_);
#pragma unroll
            for (int s_ = 0; s_ < 32; ++s_) { const v4u q = xr[s_]; const f32x4 a = (f32x4){bflo(q.x), bfhi(q.x), bflo(q.y), bfhi(q.y)}, c = (f32x4){bflo(q.z), bfhi(q.z), bflo(q.w), bfhi(q.w)}; const f32x4 t = a * a + c * c; s2 += (t.x + t.y) + (t.z + t.w); }
            s2 += __shfl_xor(s2, 16); s2 += __shfl_xor(s2, 32);
            const float rstd = 1.0f / sqrtf(s2 * (1.0f / DM) + EPS);
            f32x4 acc0 = (f32x4){0.f, 0.f, 0.f, 0.f}, acc1 = (f32x4){0.f, 0.f, 0.f, 0.f};
#pragma unroll
            for (int s_ = 0; s_ < 32; ++s_) { v4u q = xr[s_]; asm volatile("" : "+v"(q.x), "+v"(q.y), "+v"(q.z), "+v"(q.w));
                const f32x4 A0 = *(const LAS f32x4*)(modA + 32 * s_ + 8 * gq), A1 = *(const LAS f32x4*)(modA + 32 * s_ + 8 * gq + 4), B0 = *(const LAS f32x4*)(modB + 32 * s_ + 8 * gq), B1 = *(const LAS f32x4*)(modB + 32 * s_ + 8 * gq + 4);
                const f32x4 h0 = ((f32x4){bflo(q.x), bfhi(q.x), bflo(q.y), bfhi(q.y)} * rstd) * A0 + B0, h1 = ((f32x4){bflo(q.z), bfhi(q.z), bflo(q.w), bfhi(q.w)} * rstd) * A1 + B1;
                const v4u av = pack8(h0, h1); const bf16x8 a = __builtin_bit_cast(bf16x8, av);
                if (MOE_FP8) { const f32x4 e0 = h0 * 8.0f, e1 = h1 * 8.0f; v2u w; w.x = pk4_fp8(e0.x, e0.y, e0.z, e0.w); w.y = pk4_fp8(e1.x, e1.y, e1.z, e1.w); *(v2u*)(h8 + 32 * s_) = w; }
                const bf16x8 b00 = *(const LAS bf16x8*)(frag + ((s_ * 2 + 0) * 2 + 0) * 1024 + F.lane * 16), b01 = *(const LAS bf16x8*)(frag + ((s_ * 2 + 0) * 2 + 1) * 1024 + F.lane * 16);
                const bf16x8 b10 = *(const LAS bf16x8*)(frag + ((s_ * 2 + 1) * 2 + 0) * 1024 + F.lane * 16), b11 = *(const LAS bf16x8*)(frag + ((s_ * 2 + 1) * 2 + 1) * 1024 + F.lane * 16);
                acc0 = __builtin_amdgcn_mfma_f32_16x16x32_bf16(a, b00, acc0, 0, 0, 0); acc0 = __builtin_amdgcn_mfma_f32_16x16x32_bf16(a, b01, acc0, 0, 0, 0);
                acc1 = __builtin_amdgcn_mfma_f32_16x16x32_bf16(a, b10, acc1, 0, 0, 0); acc1 = __builtin_amdgcn_mfma_f32_16x16x32_bf16(a, b11, acc1, 0, 0, 0);
                __builtin_amdgcn_sched_barrier(0);
            }
#pragma unroll
            for (int q = 0; q < 4; ++q) { lg[(4 * (F.lane >> 4) + q) * 33 + (F.lane & 15)] = acc0[q]; lg[(4 * (F.lane >> 4) + q) * 33 + 16 + (F.lane & 15)] = acc1[q]; }
            LDS_WAIT(); asm volatile("" ::: "memory");
            if (F.lane < 16) {
                unsigned taken = 0u; float tl[TOPK];
#pragma unroll
                for (int k = 0; k < TOPK; ++k) {
                    float best = -3.0e38f; int bi = 0;
                    for (int e = 0; e < NEXP; ++e) { const float v = lg[F.lane * 33 + e] + rbias[e]; if (!((taken >> e) & 1u) && v > best) { best = v; bi = e; } }
                    taken |= 1u << bi; my_el[grp][k] = bi; tl[k] = best;
                }
                float den = 0.f, ex[TOPK];
#pragma unroll
                for (int k = 0; k < TOPK; ++k) { ex[k] = __expf(tl[k] - tl[0]); den += ex[k]; }
#pragma unroll
                for (int k = 0; k < TOPK; ++k) { my_g[grp][k] = ex[k] / den; my_el[grp][k] |= __hip_atomic_fetch_add(&cntL[my_el[grp][k]], 1, __ATOMIC_RELAXED, __HIP_MEMORY_SCOPE_WORKGROUP) << 8; }
            } else {
#pragma unroll
                for (int k = 0; k < TOPK; ++k) { my_el[grp][k] = 0; my_g[grp][k] = 0.f; }
            }
            LDS_WAIT(); asm volatile("" ::: "memory");
        }
        __syncthreads();
        { int t2 = threadIdx.x; asm volatile("" : "+v"(t2));
          if (t2 < NEXP && !dry) baseL[t2] = (int)__hip_atomic_fetch_add(F.ctl + CW_CNT + l * 2048 + t2 * 64, (unsigned)cntL[t2], RLX_AGENT); }
        __syncthreads();
        int ln2 = threadIdx.x & 63; asm volatile("" : "+v"(ln2));
        if (ln2 < 16 && !dry) {
#pragma unroll
            for (int grp = 0; grp < 2; ++grp) {
                const int row = rb + 32 * F.wave + 16 * grp + ln2;
#pragma unroll
                for (int k = 0; k < TOPK; ++k) { const int e = my_el[grp][k] & 255, pos = baseL[e] + (my_el[grp][k] >> 8);
                    list[(size_t)e * LCAP + pos] = (unsigned)row; tslot[(size_t)row * 4 + k] = ((unsigned)e << 20) | (unsigned)pos; tgate[(size_t)row * 4 + k] = my_g[grp][k]; }
            }
        }
        __syncthreads();
    }
}

__device__ __forceinline__ void moe_gather(Frame& F, int l) {
    relaunder(F);
    build_tiles(F, l);
    const LAS int* ts = (const LAS int*)(F.lds + TAB_OFF); const LAS int* cnt = ts + 40;
    const unsigned* list = (const unsigned*)(F.ws + WS_LIST); const bf16* H = (const bf16*)(F.ws + WS_H); bf16* Xg = (bf16*)(F.ws + WS_R1);
    const int gw = F.vcu * NWAVES + F.wave, NGW = F.G * NWAVES, NR = ts[NEXP] * 256;
    for (int r = gw; r < NR; r += NGW) {
        const int mt = r >> 8; int e = 0;
        for (int k = 1; k < NEXP; ++k) e += (ts[k] <= mt) ? 1 : 0;
        const int pos = r - ts[e] * 256;
        unsigned tok = 0u; if (pos < cnt[e]) tok = ldu_vec(list + (size_t)e * LCAP + pos);
        const v4u* src = (const v4u*)(H + (size_t)tok * DM); v4u* dst = (v4u*)(Xg + (size_t)r * DM);
        dst[F.lane] = src[F.lane]; dst[F.lane + 64] = src[F.lane + 64];
    }
}

__device__ __forceinline__ void moe_build_tt(Frame& F, int nN) {
    const LAS int* ts = (const LAS int*)(F.lds + TAB_OFF); const LAS int* cnt = ts + 40;
    LAS unsigned short* tt = (LAS unsigned short*)(F.lds + 131072);
    const unsigned* list = (const unsigned*)(F.ws + WS_LIST); const int NU = ts[NEXP] * nN;
    const int tsk = (F.lane >= 1 && F.lane < NEXP) ? ts[F.lane] : 0x7fffffff;
#pragma unroll 1
    for (int jo = 0; jo < 18; jo += 3) {
        unsigned tok[3];
#pragma unroll
        for (int ji = 0; ji < 3; ++ji) { const int i = 2 * (jo + ji) + (F.tid >> 8), r = F.tid & 255, L = i * F.G + F.vcu, mt = L / nN;
            const int e = (int)__builtin_popcountll(__ballot(tsk <= mt)); const int pos = (mt - ts[e]) * 256 + r;
            tok[ji] = 0u; if (L < NU && pos < cnt[e]) tok[ji] = list[(size_t)e * LCAP + pos]; }
#pragma unroll
        for (int ji = 0; ji < 3; ++ji) { const int i = 2 * (jo + ji) + (F.tid >> 8), r = F.tid & 255, L = i * F.G + F.vcu;
            if (L < NU) tt[i * 256 + r] = (unsigned short)tok[ji]; }
    }
    __syncthreads();
}

using pg8::Unit;

struct EpiHgrnIn {
    static constexpr bool PERM = true; static constexpr int NST = 16;
    unsigned char* r1; const float* lb; unsigned smap; float asc;
    __device__ __forceinline__ void operator()(const f32x4 (&acc)[2][2][4][2], const Unit& u, int wr, int wc, int fr, int fq) const {
        const int seg = (int)((smap >> (4 * (u.pn >> 2))) & 15u), row0 = u.pm * 256 + wr * 64 + fr, cs0 = (u.pn & 3) * 256 + wc * 32 + 8 * fq;
        if (seg == 1) {
            bf16* LFb = (bf16*)(r1 + 128 * MiB);
#pragma unroll
            for (int bj = 0; bj < 2; ++bj) {
                f32x4 lbv[2]; lbv[0] = *(const f32x4*)(lb + cs0 + bj * 128); lbv[1] = *(const f32x4*)(lb + cs0 + bj * 128 + 4);
#pragma unroll
                for (int ai = 0; ai < 2; ++ai)
#pragma unroll
                    for (int m = 0; m < 4; ++m) { const size_t ro = (size_t)(row0 + ai * 128 + m * 16) * DM + cs0 + bj * 128; f32x4 lf[2];
#pragma unroll
                        for (int n = 0; n < 2; ++n)
#pragma unroll
                            for (int j = 0; j < 4; ++j) { const float f = fminf(fmaxf(acc[ai][bj][m][n][j] * asc, -60.f), 60.f), l0 = lbv[n][j], ef = __expf(f);
                                const float sg = ef * __builtin_amdgcn_rcpf(1.f + ef);
                                lf[n][j] = __log2f(l0 + (1.f - l0) * sg); }
                        *(v4u*)(LFb + ro) = pack8(lf[0], lf[1]);
                        __builtin_amdgcn_sched_barrier(0); }
            }
        } else {
            bf16* dst = (bf16*)(r1 + (seg == 0 ? 0 : (seg == 2 ? 256 * MiB : 384 * MiB))); const bool act = (seg != 2);
#pragma unroll
            for (int ai = 0; ai < 2; ++ai)
#pragma unroll
                for (int m = 0; m < 4; ++m) { const size_t ro = (size_t)(row0 + ai * 128 + m * 16) * DM;
#pragma unroll
                    for (int bj = 0; bj < 2; ++bj) { f32x4 v0 = acc[ai][bj][m][0] * asc, v1 = acc[ai][bj][m][1] * asc;
                        if (act) {
                            v0 = silu4_(v0); v1 = silu4_(v1); }
                        *(v4u*)(dst + ro + cs0 + bj * 128) = pack8(v0, v1); }
                    __builtin_amdgcn_sched_barrier(0); }
        }
    }
};

struct EpiRetIn {
    static constexpr bool PERM = true; static constexpr int NST = 16;
    unsigned char* r1; const int* positions; float asc;
    __device__ __forceinline__ void operator()(const f32x4 (&acc)[2][2][4][2], const Unit& u, int wr, int wc, int fr, int fq) const {
        const int row0 = u.pm * 256 + wr * 64 + fr, cl = wc * 32 + 8 * fq;
        if (u.pn < 8) {
            bf16* dst = (bf16*)(r1 + ((u.pn < 4) ? 0 : 128 * MiB)); const float sc = ((u.pn < 4) ? 1.0f : 0.0625f) * asc; const int hh = u.pn & 3;
            float invrev[2][4];
#pragma unroll
            for (int n = 0; n < 2; ++n)
#pragma unroll
                for (int j = 0; j < 4; ++j) invrev[n][j] = exp2f(-(float)(cl + 4 * n + j) * 0.10462765653188542f) * 0.15915494309189535f;
#pragma unroll
            for (int ai = 0; ai < 2; ++ai)
#pragma unroll
                for (int m = 0; m < 4; ++m) { const int row = row0 + ai * 128 + m * 16; const float pos = (float)positions[row]; const size_t ro = (size_t)row * DM + hh * 256 + cl;
                    f32x4 o1[2], o2[2];
#pragma unroll
                    for (int n = 0; n < 2; ++n)
#pragma unroll
                        for (int j = 0; j < 4; ++j) { const float rev = pos * invrev[n][j], fr_ = rev - floorf(rev); const float cs = __builtin_amdgcn_cosf(fr_), sn = __builtin_amdgcn_sinf(fr_);
                            const float x1 = acc[ai][0][m][n][j], x2 = acc[ai][1][m][n][j]; o1[n][j] = (x1 * cs - x2 * sn) * sc; o2[n][j] = (x2 * cs + x1 * sn) * sc; }
                    *(v4u*)(dst + ro) = pack8(o1[0], o1[1]); *(v4u*)(dst + ro + 128) = pack8(o2[0], o2[1]); }
        } else {
            const bool isg = (u.pn >= 16); bf16* dst = (bf16*)(r1 + (isg ? 512 * MiB : 256 * MiB)); const int ct = (isg ? u.pn - 16 : u.pn - 8) * 256 + cl;
#pragma unroll
            for (int ai = 0; ai < 2; ++ai)
#pragma unroll
                for (int m = 0; m < 4; ++m) { const size_t ro = (size_t)(row0 + ai * 128 + m * 16) * 2048 + ct;
#pragma unroll
                    for (int bj = 0; bj < 2; ++bj) { f32x4 v0 = acc[ai][bj][m][0] * asc, v1 = acc[ai][bj][m][1] * asc;
                        if (isg) {
                            v0 = silu4_(v0); v1 = silu4_(v1); }
                        *(v4u*)(dst + ro + bj * 128) = pack8(v0, v1); } }
        }
    }
};

template <bool XF32>
struct EpiOutT {
    static constexpr bool PERM = true; static constexpr int NST = XF32 ? 4 : 8;
    const void* xin; bf16* xout; const float* gate;
    __device__ __forceinline__ void operator()(const f32x4 (&acc)[2][2][4][2], const Unit& u, int wr, int wc, int fr, int fq) const {
        const int row0 = u.pm * 256 + wr * 64 + fr, c0 = u.pn * 256 + wc * 32 + 8 * fq, b = (u.pm * 256) / SEQ;
        f32x4 gv[2][2];
#pragma unroll
        for (int bj = 0; bj < 2; ++bj)
#pragma unroll
            for (int n = 0; n < 2; ++n) gv[bj][n] = *(const f32x4*)(gate + (size_t)b * 6 * DM + c0 + bj * 128 + 4 * n);
        if constexpr (XF32) {
#pragma unroll
            for (int ai = 0; ai < 2; ++ai)
#pragma unroll
                for (int mp = 0; mp < 2; ++mp) { f32x4 xi[2][2][2];
#pragma unroll
                    for (int mm = 0; mm < 2; ++mm)
#pragma unroll
                        for (int bj = 0; bj < 2; ++bj)
#pragma unroll
                            for (int n = 0; n < 2; ++n) xi[mm][bj][n] = *(const f32x4*)((const float*)xin + (size_t)(row0 + ai * 128 + (2 * mp + mm) * 16) * DM + c0 + bj * 128 + 4 * n);
#pragma unroll
                    for (int mm = 0; mm < 2; ++mm)
#pragma unroll
                        for (int bj = 0; bj < 2; ++bj)
                            *(v4u*)(xout + (size_t)(row0 + ai * 128 + (2 * mp + mm) * 16) * DM + c0 + bj * 128) = pack8(xi[mm][bj][0] + gv[bj][0] * acc[ai][bj][2 * mp + mm][0], xi[mm][bj][1] + gv[bj][1] * acc[ai][bj][2 * mp + mm][1]);
                    asm volatile("" ::: "memory"); }
        } else {
#pragma unroll
            for (int ai = 0; ai < 2; ++ai) { v4u xi[4][2];
#pragma unroll
                for (int m = 0; m < 4; ++m)
#pragma unroll
                    for (int bj = 0; bj < 2; ++bj) xi[m][bj] = *(const v4u*)((const bf16*)xin + (size_t)(row0 + ai * 128 + m * 16) * DM + c0 + bj * 128);
#pragma unroll
                for (int m = 0; m < 4; ++m)
#pragma unroll
                    for (int bj = 0; bj < 2; ++bj) { const v4u q = xi[m][bj];
                        const f32x4 lo = (f32x4){bflo(q.x), bfhi(q.x), bflo(q.y), bfhi(q.y)}, hi = (f32x4){bflo(q.z), bfhi(q.z), bflo(q.w), bfhi(q.w)};
                        *(v4u*)(xout + (size_t)(row0 + ai * 128 + m * 16) * DM + c0 + bj * 128) = pack8(lo + gv[bj][0] * acc[ai][bj][m][0], hi + gv[bj][1] * acc[ai][bj][m][1]); }
                asm volatile("" ::: "memory"); }
        }
    }
};

struct EpiMoe1F8 {
    static constexpr bool PERM = true; static constexpr int NST = 8;
    unsigned char* A2; const float* b1;
    __device__ __forceinline__ void operator()(const f32x4 (&acc)[2][2][4][2], const Unit& u, int wr, int wc, int fr, int fq) const {
        const int row0 = u.pm * 256 + wr * 64 + fr, gc = u.nn * 128 + wc * 32 + 8 * fq; const float* bp = b1 + (size_t)u.e * 2048;
        f32x4 bg[2], bl[2];
#pragma unroll
        for (int n = 0; n < 2; ++n) { bg[n] = *(const f32x4*)(bp + gc + 4 * n); bl[n] = *(const f32x4*)(bp + 1024 + gc + 4 * n); }
#pragma unroll
        for (int ai = 0; ai < 2; ++ai)
#pragma unroll
            for (int m = 0; m < 4; ++m) { f32x4 o[2];
#pragma unroll
                for (int n = 0; n < 2; ++n) {
                    f32x4 g = acc[ai][0][m][n] * (1.0f / 512.f) + bg[n], li = acc[ai][1][m][n] * (1.0f / 512.f) + bl[n];
                    g = __builtin_elementwise_min(g, (f32x4){7.0f, 7.0f, 7.0f, 7.0f});
                    li = __builtin_elementwise_min(__builtin_elementwise_max(li, (f32x4){-7.0f, -7.0f, -7.0f, -7.0f}), (f32x4){7.0f, 7.0f, 7.0f, 7.0f});
                    const f32x4 t = g * (-1.702f * 1.4426950408889634f); f32x4 e, r;
#pragma unroll
                    for (int j = 0; j < 4; ++j) e[j] = __builtin_amdgcn_exp2f(t[j]);
                    const f32x4 d = e + 1.0f;
#pragma unroll
                    for (int j = 0; j < 4; ++j) r[j] = __builtin_amdgcn_rcpf(d[j]);
                    o[n] = (g * r) * (li * 4.0f + 4.0f); }
                v2u w; w.x = pk4_fp8(o[0].x, o[0].y, o[0].z, o[0].w); w.y = pk4_fp8(o[1].x, o[1].y, o[1].z, o[1].w);
                *(v2u*)(A2 + (size_t)(row0 + ai * 128 + m * 16) * DM + gc) = w; }
    }
};
struct EpiMoe1 {
    static constexpr bool PERM = true; static constexpr int NST = 8;
    bf16* A2; const float* b1;
    __device__ __forceinline__ void operator()(const f32x4 (&acc)[2][2][4][2], const Unit& u, int wr, int wc, int fr, int fq) const {
        const int row0 = u.pm * 256 + wr * 64 + fr, gc = u.nn * 128 + wc * 32 + 8 * fq; const float* bp = b1 + (size_t)u.e * 2048;
        f32x4 bg[2], bl[2];
#pragma unroll
        for (int n = 0; n < 2; ++n) { bg[n] = *(const f32x4*)(bp + gc + 4 * n); bl[n] = *(const f32x4*)(bp + 1024 + gc + 4 * n); }
#pragma unroll
        for (int ai = 0; ai < 2; ++ai)
#pragma unroll
            for (int m = 0; m < 4; ++m) { f32x4 o[2];
#pragma unroll
                for (int n = 0; n < 2; ++n)
#pragma unroll
                    for (int j = 0; j < 4; ++j) { const float g = fminf(acc[ai][0][m][n][j] + bg[n][j], 7.0f), li = fminf(fmaxf(acc[ai][1][m][n][j] + bl[n][j], -7.0f), 7.0f);
                        o[n][j] = g * sigmoidf_(1.702f * g) * (li + 1.0f); }
                *(v4u*)(A2 + (size_t)(row0 + ai * 128 + m * 16) * DM + gc) = pack8(o[0], o[1]); }
    }
};

template <int VAR = 0> struct EpiMoe2T {
    static constexpr bool PERM = true; static constexpr int NST = (VAR == 2) ? 0 : 16;
    bf16* Y; const float* b2; float sc;
    __device__ __forceinline__ void operator()(const f32x4 (&acc)[2][2][4][2], const Unit& u, int wr, int wc, int fr, int fq) const {
        const int row0 = u.pm * 256 + wr * 64 + fr, c0 = u.nn * 256 + wc * 32 + 8 * fq; const float* bp = b2 + (size_t)u.e * DM;
        f32x4 bv[2][2];
#pragma unroll
        for (int bj = 0; bj < 2; ++bj)
#pragma unroll
            for (int n = 0; n < 2; ++n) bv[bj][n] = (VAR == 1) ? (f32x4){sc, sc, sc, sc} : *(const f32x4*)(bp + c0 + bj * 128 + 4 * n);
        float sink = 0.f;
#pragma unroll
        for (int ai = 0; ai < 2; ++ai)
#pragma unroll
            for (int m = 0; m < 4; ++m) { const size_t ro = (size_t)(row0 + ai * 128 + m * 16) * YLD + c0;
#pragma unroll
                for (int bj = 0; bj < 2; ++bj) { const f32x4 v0 = acc[ai][bj][m][0] * sc + bv[bj][0], v1 = acc[ai][bj][m][1] * sc + bv[bj][1];
                    if (VAR == 2) { const v4u p = pack8(v0, v1); sink += __uint_as_float(p.x ^ p.y ^ p.z ^ p.w); } else *(v4u*)(Y + ro + bj * 128) = pack8(v0, v1); } }
        if (VAR == 2) asm volatile("" :: "v"(sink));
    }
};
typedef EpiMoe2T<0> EpiMoe2;
struct EpiMoe2Y8 {
    static constexpr bool PERM = true; static constexpr int NST = 16;
    unsigned char* Y; const float* b2; float sc;
    __device__ __forceinline__ void operator()(const f32x4 (&acc)[2][2][4][2], const Unit& u, int wr, int wc, int fr, int fq) const {
        const int row0 = u.pm * 256 + wr * 64 + fr, c0 = u.nn * 256 + wc * 32 + 8 * fq; const float* bp = b2 + (size_t)u.e * DM;
        f32x4 bv[2][2]; const float s32 = sc * YSC;
#pragma unroll
        for (int bj = 0; bj < 2; ++bj)
#pragma unroll
            for (int n = 0; n < 2; ++n) bv[bj][n] = *(const f32x4*)(bp + c0 + bj * 128 + 4 * n) * YSC;
#pragma unroll
        for (int ai = 0; ai < 2; ++ai)
#pragma unroll
            for (int m = 0; m < 4; ++m) { const size_t ro = (size_t)(row0 + ai * 128 + m * 16) * YLD + c0;
#pragma unroll
                for (int bj = 0; bj < 2; ++bj) { f32x4 v0 = acc[ai][bj][m][0] * s32 + bv[bj][0], v1 = acc[ai][bj][m][1] * s32 + bv[bj][1];
#pragma unroll
                    for (int q = 0; q < 4; ++q) { v0[q] = __builtin_fminf(__builtin_fmaxf(v0[q], -448.0f), 448.0f); v1[q] = __builtin_fminf(__builtin_fmaxf(v1[q], -448.0f), 448.0f); }
                    v2u w; w.x = pk4_fp8(v0.x, v0.y, v0.z, v0.w); w.y = pk4_fp8(v1.x, v1.y, v1.z, v1.w);
                    *(v2u*)(Y + ro + bj * 128) = w; } }
    }
};

__device__ __forceinline__ void hgrn_scan(Frame& F, int j) {
    relaunder(F);
    const bf16* Q = (const bf16*)(F.ws + WS_R1); const bf16* LFb = (const bf16*)(F.ws + WS_R1 + 128 * MiB); const bf16* V = (const bf16*)(F.ws + WS_R1 + 256 * MiB); const bf16* SG = (const bf16*)(F.ws + WS_R1 + 384 * MiB);
    bf16* O = (bf16*)(F.ws + WS_R2);
    LAS float* Qs = (LAS float*)(F.lds); LAS float* Ks = Qs + 4096; LAS float* Fs = Qs + 8192; LAS float* Vs = Qs + 12288; LAS float* P = Qs + 16384;
    const int v = F.tid & 127, kq = F.tid >> 7, t16 = F.tid >> 4, c8 = (F.tid & 15) * 8;
    f32x4 gain0 = *(const f32x4*)(KIN(I_HGAIN) + j * 128 + c8), gain1 = *(const f32x4*)(KIN(I_HGAIN) + j * 128 + c8 + 4);
    for (int u = F.vcu; u < NBATCH * HG_H; u += F.G) {
        const int b = u / HG_H, h = u % HG_H;
        float S[32];
#pragma unroll
        for (int i = 0; i < 32; ++i) S[i] = 0.f;
        for (int ch = 0; ch < SEQ / 32; ++ch) {
            const int row0 = b * SEQ + 32 * ch; const size_t gi = (size_t)(row0 + t16) * DM + h * 128 + c8;
            __syncthreads();
            { const v4u q = *(const v4u*)(Q + gi), lw = *(const v4u*)(LFb + gi), vv = *(const v4u*)(V + gi);
              const f32x4 f0 = (f32x4){exp2f(bflo(lw.x)), exp2f(bfhi(lw.x)), exp2f(bflo(lw.y)), exp2f(bfhi(lw.y))}, f1 = (f32x4){exp2f(bflo(lw.z)), exp2f(bfhi(lw.z)), exp2f(bflo(lw.w)), exp2f(bfhi(lw.w))};
              LAS f32x4* d;
              d = (LAS f32x4*)(Qs + t16 * 128 + c8); d[0] = (f32x4){bflo(q.x), bfhi(q.x), bflo(q.y), bfhi(q.y)}; d[1] = (f32x4){bflo(q.z), bfhi(q.z), bflo(q.w), bfhi(q.w)};
              d = (LAS f32x4*)(Ks + t16 * 128 + c8); d[0] = 1.0f - f0; d[1] = 1.0f - f1;
              d = (LAS f32x4*)(Vs + t16 * 128 + c8); d[0] = (f32x4){bflo(vv.x), bfhi(vv.x), bflo(vv.y), bfhi(vv.y)}; d[1] = (f32x4){bflo(vv.z), bfhi(vv.z), bflo(vv.w), bfhi(vv.w)};
              d = (LAS f32x4*)(Fs + t16 * 128 + c8); d[0] = f0; d[1] = f1; }
            __syncthreads();
            for (int t = 0; t < 32; ++t) {
                const float vt = Vs[t * 128 + v]; float a = 0.f;
#pragma unroll
                for (int i4 = 0; i4 < 8; ++i4) { const f32x4 f4 = *(const LAS f32x4*)(Fs + t * 128 + 32 * kq + 4 * i4), k4 = *(const LAS f32x4*)(Ks + t * 128 + 32 * kq + 4 * i4), q4 = *(const LAS f32x4*)(Qs + t * 128 + 32 * kq + 4 * i4);
#pragma unroll
                    for (int i = 0; i < 4; ++i) { S[4 * i4 + i] = f4[i] * S[4 * i4 + i] + k4[i] * vt; a += q4[i] * S[4 * i4 + i]; } }
                P[(t * 4 + kq) * 128 + v] = a;
            }
            __syncthreads();
            { f32x4 o0 = (f32x4){0.f, 0.f, 0.f, 0.f}, o1 = o0;
#pragma unroll
              for (int q = 0; q < 4; ++q) { o0 += *(const LAS f32x4*)(P + (t16 * 4 + q) * 128 + c8); o1 += *(const LAS f32x4*)(P + (t16 * 4 + q) * 128 + c8 + 4); }
              float ss = (o0.x * o0.x + o0.y * o0.y) + (o0.z * o0.z + o0.w * o0.w) + (o1.x * o1.x + o1.y * o1.y) + (o1.z * o1.z + o1.w * o1.w);
              ss += __shfl_xor(ss, 1); ss += __shfl_xor(ss, 2); ss += __shfl_xor(ss, 4); ss += __shfl_xor(ss, 8);
              const float r = 1.0f / sqrtf(ss * (1.0f / 128.f) + EPS);
              const v4u sg = *(const v4u*)(SG + gi);
              f32x4 a0 = o0 * r * gain0, a1 = o1 * r * gain1;
              a0.x *= bflo(sg.x); a0.y *= bfhi(sg.x); a0.z *= bflo(sg.y); a0.w *= bfhi(sg.y); a1.x *= bflo(sg.z); a1.y *= bfhi(sg.z); a1.z *= bflo(sg.w); a1.w *= bfhi(sg.w);
              *(v4u*)(O + gi) = pack8(a0, a1); }
        }
    }
}

__device__ __forceinline__ void ret_scan(Frame& F) {
    relaunder(F);
    const bf16* Q = (const bf16*)(F.ws + WS_R1); const bf16* K = (const bf16*)(F.ws + WS_R1 + 128 * MiB); const bf16* V = (const bf16*)(F.ws + WS_R1 + 256 * MiB); const bf16* SG = (const bf16*)(F.ws + WS_R1 + 512 * MiB);
    bf16* O = (bf16*)(F.ws + WS_R2);
    LAS bf16* Qs = (LAS bf16*)(F.lds); LAS bf16* Ks = (LAS bf16*)(F.lds + 33792); LAS bf16* Vs = (LAS bf16*)(F.lds + 67584);
    LAS float* St = (LAS float*)(F.lds + 133120); LAS float* wred = (LAS float*)(F.lds + 149504); LAS float* rtab = (LAS float*)(F.lds + 151552);
    for (int u = F.vcu; u < NBATCH * RT_H * 16; u += F.G) {
        const int bh = u >> 4, cp = u & 15, b = bh >> 2, h = bh & 3;
        const float lg2g = log2f(1.0f - exp2f(-5.0f - (float)h));
        for (int half = 0; half < 2; ++half) {
            const int c = half ? 31 - cp : cp; const int row0 = b * SEQ + 64 * c;
            __syncthreads();
#pragma unroll
            for (int i = 0; i < 4; ++i) { const int p = F.tid + 512 * i, r = p >> 5, cc = (p & 31) * 8; *(LAS v4u*)(Qs + r * 264 + cc) = *(const v4u*)(Q + (size_t)(row0 + r) * DM + h * 256 + cc); }
            float acc[64];
#pragma unroll
            for (int n = 0; n < 64; ++n) acc[n] = 0.f;
            for (int cq = 0; cq <= c; ++cq) {
                const int krow0 = b * SEQ + 64 * cq;
                __syncthreads();
#pragma unroll
                for (int i = 0; i < 4; ++i) { const int p = F.tid + 512 * i, r = p >> 5, cc = (p & 31) * 8; *(LAS v4u*)(Ks + r * 264 + cc) = *(const v4u*)(K + (size_t)(krow0 + r) * DM + h * 256 + cc); }
#pragma unroll
                for (int i = 0; i < 8; ++i) { const int p = F.tid + 512 * i, r = p >> 6, cc = (p & 63) * 8; *(LAS v4u*)(Vs + r * 512 + cc) = *(const v4u*)(V + (size_t)(krow0 + r) * 2048 + h * 512 + cc); }
                __syncthreads();
                { float s[8];
#pragma unroll
                  for (int j8 = 0; j8 < 8; ++j8) s[j8] = 0.f;
                  for (int dc = 0; dc < 32; ++dc) {
                      const v4u kv = *(const LAS v4u*)(Ks + F.lane * 264 + dc * 8);
                      const float k0 = bflo(kv.x), k1 = bfhi(kv.x), k2 = bflo(kv.y), k3 = bfhi(kv.y), k4 = bflo(kv.z), k5 = bfhi(kv.z), k6 = bflo(kv.w), k7 = bfhi(kv.w);
#pragma unroll
                      for (int j8 = 0; j8 < 8; ++j8) { const v4u qv = *(const LAS v4u*)(Qs + (8 * F.wave + j8) * 264 + dc * 8);
                          s[j8] += (bflo(qv.x) * k0 + bfhi(qv.x) * k1) + (bflo(qv.y) * k2 + bfhi(qv.y) * k3) + (bflo(qv.z) * k4 + bfhi(qv.z) * k5) + (bflo(qv.w) * k6 + bfhi(qv.w) * k7); }
                  }
                  f32x4 w0, w1;
#pragma unroll
                  for (int j8 = 0; j8 < 8; ++j8) { const float dist = fabsf((float)((64 * c + 8 * F.wave + j8) - (64 * cq + F.lane))); const float val = s[j8] * exp2f(dist * lg2g); if (j8 < 4) w0[j8] = val; else w1[j8 - 4] = val; }
                  *(LAS f32x4*)(St + F.lane * 64 + 8 * F.wave) = w0; *(LAS f32x4*)(St + F.lane * 64 + 8 * F.wave + 4) = w1; }
                __syncthreads();
                for (int m2 = 0; m2 < 64; ++m2) {
                    const float vv = bf2f(Vs[m2 * 512 + F.tid]);
#pragma unroll
                    for (int n4 = 0; n4 < 16; ++n4) { const f32x4 sv = *(const LAS f32x4*)(St + m2 * 64 + 4 * n4); acc[4 * n4 + 0] += sv.x * vv; acc[4 * n4 + 1] += sv.y * vv; acc[4 * n4 + 2] += sv.z * vv; acc[4 * n4 + 3] += sv.w * vv; }
                }
            }
#pragma unroll
            for (int n = 0; n < 64; ++n) { const float p = wave_sum(acc[n] * acc[n]); if (F.lane == 0) wred[F.wave * 64 + n] = p; }
            __syncthreads();
            if (F.tid < 64) { float s = 0.f;
#pragma unroll
                for (int w = 0; w < 8; ++w) s += wred[w * 64 + F.tid];
                rtab[F.tid] = 1.0f / sqrtf(s * (1.0f / 512.f) + EPS); }
            __syncthreads();
#pragma unroll
            for (int n = 0; n < 64; ++n) { const size_t gi = (size_t)(row0 + n) * 2048 + h * 512 + F.tid; const float sg = bf2f(SG[gi]); O[gi] = (bf16)(pk2(acc[n] * rtab[n] * sg, 0.f) & 0xffffu); }
        }
    }
}

typedef short s16x4 __attribute__((ext_vector_type(4)));
__device__ __forceinline__ unsigned off_b(unsigned row, unsigned ch) { return 256u * row + 16u * (ch ^ (((row & 3u) << 2) | ((row >> 2) & 3u))); }
__device__ __forceinline__ bf16x8 row_frag(const LAS unsigned char* tile, unsigned row, unsigned s4, unsigned g) { return *(const LAS bf16x8*)(tile + off_b(row, 4u * s4 + g)); }
__device__ __forceinline__ bf16x8 tr_frag16(const LAS unsigned char* tile, unsigned lane, unsigned c, unsigned ks) {
    const unsigned g = lane >> 4, q = (lane & 15u) >> 2, p = lane & 3u;
    const unsigned a0 = off_b(32u * ks + 8u * g + q, 2u * c + (p >> 1)) + 8u * (p & 1u), a1 = off_b(32u * ks + 8u * g + 4u + q, 2u * c + (p >> 1)) + 8u * (p & 1u);
    const s16x4 lo = __builtin_amdgcn_ds_read_tr16_b64_v4i16((LAS s16x4*)(tile + a0)), hi = __builtin_amdgcn_ds_read_tr16_b64_v4i16((LAS s16x4*)(tile + a1));
    return (bf16x8){lo[0], lo[1], lo[2], lo[3], hi[0], hi[1], hi[2], hi[3]};
}
#define RSB() __builtin_amdgcn_sched_barrier(0)
constexpr unsigned RQS = 528, RVS = 272;
template <unsigned RS> __device__ __forceinline__ bf16x8 tr_lin(const LAS unsigned char* img, unsigned trb, int c, int ks) {
    const s16x4 lo = __builtin_amdgcn_ds_read_tr16_b64_v4i16((LAS s16x4*)(img + trb + (32 * ks) * RS + 32 * c)), hi = __builtin_amdgcn_ds_read_tr16_b64_v4i16((LAS s16x4*)(img + trb + (32 * ks + 4) * RS + 32 * c));
    return (bf16x8){lo[0], lo[1], lo[2], lo[3], hi[0], hi[1], hi[2], hi[3]};
}
__device__ __forceinline__ void ret_scan_mfma(Frame& F) {
    relaunder(F);
    const bf16* Q = (const bf16*)(F.ws + WS_R1); const bf16* K = (const bf16*)(F.ws + WS_R1 + 128 * MiB); const bf16* V = (const bf16*)(F.ws + WS_R1 + 256 * MiB);
    bf16* O = (bf16*)(F.ws + WS_R2); float* SS = (float*)(F.ws + WS_R2 + 256 * MiB); const bf16* SGp = (const bf16*)(F.ws + WS_R1 + 512 * MiB);
    LAS unsigned char* Qi = F.lds; LAS unsigned char* Ki = F.lds + 33792; LAS unsigned char* Vi = F.lds + 67584; LAS unsigned char* Si = F.lds + 84992; LAS float* OT = (LAS float*)(F.lds + 94208);
    const unsigned w = (unsigned)F.wave;
    for (int u = F.vcu; u < NBATCH * RT_H * 4; u += F.G) {
        const int bh = u >> 2, vs = u & 3, b = bh >> 2, h = bh & 3;
        const float lg2g = log2f(1.0f - exp2f(-5.0f - (float)h)), cd = exp2f(64.0f * lg2g);
        f32x4 R[16];
#pragma unroll
        for (int i = 0; i < 16; ++i) R[i] = (f32x4){0.f, 0.f, 0.f, 0.f};
        v4u pq[4], pk[4], pv[2];
        { const int row0 = b * SEQ;
#pragma unroll
          for (int i = 0; i < 4; ++i) { const int p = F.tid + 512 * i, r = p >> 5, c32 = p & 31; pq[i] = *(const v4u*)(Q + (size_t)(row0 + r) * DM + h * 256 + c32 * 8); pk[i] = *(const v4u*)(K + (size_t)(row0 + r) * DM + h * 256 + c32 * 8); }
#pragma unroll
          for (int i = 0; i < 2; ++i) { const int p = F.tid + 512 * i, r = p >> 4, c16 = p & 15; pv[i] = *(const v4u*)(V + (size_t)(row0 + r) * 2048 + h * 512 + vs * 128 + c16 * 8); } }
        __syncthreads();
        for (int c = 0; c < SEQ / 64; ++c) {
            const int row0 = b * SEQ + 64 * c;
            unsigned tidl = (unsigned)F.tid; asm volatile("" : "+v"(tidl));
            const unsigned lane = tidl & 63u, g = lane >> 4, li = lane & 15u;
#pragma unroll
            for (int i = 0; i < 4; ++i) { const unsigned p = tidl + 512u * i, r = p >> 5, c32 = p & 31u; const unsigned o = r * RQS + 16u * c32; *(LAS v4u*)(Qi + o) = pq[i]; *(LAS v4u*)(Ki + o) = pk[i]; }
#pragma unroll
            for (int i = 0; i < 2; ++i) { const unsigned p = tidl + 512u * i, r = p >> 4, c16 = p & 15u; *(LAS v4u*)(Vi + r * RVS + 16u * c16) = pv[i]; }
            __syncthreads();
            if (c + 1 < SEQ / 64) { const int rn = row0 + 64;
#pragma unroll
                for (int i = 0; i < 4; ++i) { const unsigned p = tidl + 512u * i, r = p >> 5, c32 = p & 31u; pq[i] = *(const v4u*)(Q + (size_t)(rn + (int)r) * DM + h * 256 + c32 * 8); pk[i] = *(const v4u*)(K + (size_t)(rn + (int)r) * DM + h * 256 + c32 * 8); }
#pragma unroll
                for (int i = 0; i < 2; ++i) { const unsigned p = tidl + 512u * i, r = p >> 4, c16 = p & 15u; pv[i] = *(const v4u*)(V + (size_t)(rn + (int)r) * 2048 + h * 512 + vs * 128 + c16 * 8); } }
            RSB();
            const unsigned rb128 = li * RQS + 16u * g, rb64 = li * RQS + 8u * g, trq = (8u * g + (li >> 2)) * RQS + 8u * (li & 3u), trv = (8u * g + (li >> 2)) * RVS + 8u * (li & 3u);
            { const unsigned mt = w >> 1, nt0 = 2u * (w & 1u); f32x4 sa0 = (f32x4){0.f, 0.f, 0.f, 0.f}, sa1 = sa0;
              const LAS unsigned char* qrow = Qi + rb128 + mt * (16u * RQS); const LAS unsigned char* krow = Ki + rb128 + nt0 * (16u * RQS);
              bf16x8 qa[2][2], kb0[2][2], kb1[2][2];
#define RET_LDS(buf, s8b) do { _Pragma("unroll") for (int k2 = 0; k2 < 2; ++k2) { const int s8 = (s8b) + k2; \
                  qa[buf][k2] = *(const LAS bf16x8*)(qrow + 64 * s8); kb0[buf][k2] = *(const LAS bf16x8*)(krow + 64 * s8); kb1[buf][k2] = *(const LAS bf16x8*)(krow + 16 * RQS + 64 * s8); } } while (0)
              RET_LDS(0, 0); RSB();
#pragma unroll
              for (int bt = 0; bt < 4; ++bt) { if (bt < 3) RET_LDS((bt + 1) & 1, 2 * (bt + 1)); RSB();
#pragma unroll
                  for (int k2 = 0; k2 < 2; ++k2) { sa0 = __builtin_amdgcn_mfma_f32_16x16x32_bf16(qa[bt & 1][k2], kb0[bt & 1][k2], sa0, 0, 0, 0); sa1 = __builtin_amdgcn_mfma_f32_16x16x32_bf16(qa[bt & 1][k2], kb1[bt & 1][k2], sa1, 0, 0, 0); }
                  RSB(); }
#undef RET_LDS
#pragma unroll
              for (int q = 0; q < 4; ++q) { const int n = (int)(16u * mt + 4u * g) + q, m0 = (int)(16u * nt0 + li);
                  const float v0 = sa0[q] * exp2f(fabsf((float)(n - m0)) * lg2g), v1 = sa1[q] * exp2f(fabsf((float)(n - m0 - 16)) * lg2g); const unsigned pk = pk2(v0, v1);
                  *(LAS unsigned short*)(Si + (unsigned)n * 144u + 2u * (unsigned)m0) = (unsigned short)(pk & 0xffffu); *(LAS unsigned short*)(Si + (unsigned)n * 144u + 2u * (unsigned)m0 + 32u) = (unsigned short)(pk >> 16); } }
            RSB();
            f32x4 Oa[4];
#pragma unroll
            for (int mt = 0; mt < 4; ++mt) Oa[mt] = (f32x4){0.f, 0.f, 0.f, 0.f};
            { v2u qlo[2][4], qhi[2][4]; const LAS unsigned char* qp = Qi + rb64;
#define RET_LDQ(buf, s8) do { _Pragma("unroll") for (int mt = 0; mt < 4; ++mt) { qlo[buf][mt] = *(const LAS v2u*)(qp + mt * (16 * RQS) + 64 * (s8)); qhi[buf][mt] = *(const LAS v2u*)(qp + mt * (16 * RQS) + 64 * (s8) + 32); } } while (0)
              RET_LDQ(0, 0); RSB();
#pragma unroll
              for (int s8 = 0; s8 < 8; ++s8) { if (s8 < 7) RET_LDQ((s8 + 1) & 1, s8 + 1); RSB();
                  const v4u rt = (v4u){pk2(R[2 * s8][0], R[2 * s8][1]), pk2(R[2 * s8][2], R[2 * s8][3]), pk2(R[2 * s8 + 1][0], R[2 * s8 + 1][1]), pk2(R[2 * s8 + 1][2], R[2 * s8 + 1][3])}; const bf16x8 Rb = __builtin_bit_cast(bf16x8, rt);
#pragma unroll
                  for (int mt = 0; mt < 4; ++mt) { const v4u av = (v4u){qlo[s8 & 1][mt].x, qlo[s8 & 1][mt].y, qhi[s8 & 1][mt].x, qhi[s8 & 1][mt].y}; Oa[mt] = __builtin_amdgcn_mfma_f32_16x16x32_bf16(__builtin_bit_cast(bf16x8, av), Rb, Oa[mt], 0, 0, 0); }
                  RSB(); }
#undef RET_LDQ
            }
#pragma unroll
            for (int mt = 0; mt < 4; ++mt)
#pragma unroll
                for (int q = 0; q < 4; ++q) Oa[mt][q] *= exp2f((float)(16 * mt + 4 * (int)g + q + 1) * lg2g);
            __syncthreads();
            bf16x8 Vf[2], sf[4][2], ka[2][2][2];
#define RET_LDK(buf, dtb) do { _Pragma("unroll") for (int d2 = 0; d2 < 2; ++d2) _Pragma("unroll") for (int ks = 0; ks < 2; ++ks) ka[buf][d2][ks] = tr_lin<RQS>(Ki, trq, (dtb) + d2, ks); } while (0)
#pragma unroll
            for (int ks = 0; ks < 2; ++ks) Vf[ks] = tr_lin<RVS>(Vi + 32u * w, trv, 0, ks);
#pragma unroll
            for (int mt = 0; mt < 4; ++mt)
#pragma unroll
                for (int ks = 0; ks < 2; ++ks) sf[mt][ks] = *(const LAS bf16x8*)(Si + (16u * mt + li) * 144u + 64u * ks + 16u * g);
            RET_LDK(0, 0); RSB();
#pragma unroll
            for (int mt = 0; mt < 4; ++mt)
#pragma unroll
                for (int ks = 0; ks < 2; ++ks) Oa[mt] = __builtin_amdgcn_mfma_f32_16x16x32_bf16(sf[mt][ks], Vf[ks], Oa[mt], 0, 0, 0);
            bf16x8 Vd[2];
#pragma unroll
            for (int ks = 0; ks < 2; ++ks) { const v4u vv = __builtin_bit_cast(v4u, Vf[ks]); float f[8];
#pragma unroll
                for (int j = 0; j < 8; ++j) f[j] = exp2f((float)(63 - (32 * ks + 8 * (int)g + j)) * lg2g);
                const v4u sv = (v4u){pk2(bflo(vv.x) * f[0], bfhi(vv.x) * f[1]), pk2(bflo(vv.y) * f[2], bfhi(vv.y) * f[3]), pk2(bflo(vv.z) * f[4], bfhi(vv.z) * f[5]), pk2(bflo(vv.w) * f[6], bfhi(vv.w) * f[7])};
                Vd[ks] = __builtin_bit_cast(bf16x8, sv); }
            RSB();
#pragma unroll
            for (int bt = 0; bt < 8; ++bt) { if (bt < 7) RET_LDK((bt + 1) & 1, 2 * (bt + 1)); RSB();
#pragma unroll
                for (int d2 = 0; d2 < 2; ++d2) { const int dt = 2 * bt + d2; R[dt] = R[dt] * cd;
#pragma unroll
                    for (int ks = 0; ks < 2; ++ks) R[dt] = __builtin_amdgcn_mfma_f32_16x16x32_bf16(ka[bt & 1][d2][ks], Vd[ks], R[dt], 0, 0, 0); }
                RSB(); }
#undef RET_LDK
#pragma unroll
            for (int mt = 0; mt < 4; ++mt)
#pragma unroll
                for (int q = 0; q < 4; ++q) OT[(16u * mt + 4u * g + q) * 132u + 16u * w + li] = Oa[mt][q];
            __syncthreads();
            { const unsigned tn = tidl >> 3, vg = tidl & 7u; f32x4 o[4]; float ssq = 0.f;
#pragma unroll
              for (int i = 0; i < 4; ++i) { o[i] = *(const LAS f32x4*)(OT + tn * 132u + 16u * vg + 4u * i); ssq += (o[i].x * o[i].x + o[i].y * o[i].y) + (o[i].z * o[i].z + o[i].w * o[i].w); }
              ssq += __shfl_xor(ssq, 1); ssq += __shfl_xor(ssq, 2); ssq += __shfl_xor(ssq, 4);
              const size_t go = (size_t)(row0 + (int)tn) * 2048 + h * 512 + vs * 128 + 16 * vg; bf16* op = O + go;
              if (RET_FOLD) { const v4u g0 = *(const v4u*)(SGp + go), g1 = *(const v4u*)(SGp + go + 8);
                  o[0].x *= bflo(g0.x); o[0].y *= bfhi(g0.x); o[0].z *= bflo(g0.y); o[0].w *= bfhi(g0.y); o[1].x *= bflo(g0.z); o[1].y *= bfhi(g0.z); o[1].z *= bflo(g0.w); o[1].w *= bfhi(g0.w);
                  o[2].x *= bflo(g1.x); o[2].y *= bfhi(g1.x); o[2].z *= bflo(g1.y); o[2].w *= bfhi(g1.y); o[3].x *= bflo(g1.z); o[3].y *= bfhi(g1.z); o[3].z *= bflo(g1.w); o[3].w *= bfhi(g1.w); }
              *(v4u*)op = pack8(o[0], o[1]); *(v4u*)(op + 8) = pack8(o[2], o[3]);
              if (vg == 0) SS[((size_t)(row0 + (int)tn) * 4 + h) * 4 + vs] = ssq; }
        }
    }
}
__device__ __forceinline__ void ret_scan_mfma2(Frame& F) {
    relaunder(F);
    const bf16* Q = (const bf16*)(F.ws + WS_R1); const bf16* K = (const bf16*)(F.ws + WS_R1 + 128 * MiB); const bf16* V = (const bf16*)(F.ws + WS_R1 + 256 * MiB);
    bf16* O = (bf16*)(F.ws + WS_R2); float* SS = (float*)(F.ws + WS_R2 + 256 * MiB); const bf16* SGp = (const bf16*)(F.ws + WS_R1 + 512 * MiB);
    LAS unsigned char* Qi = F.lds; LAS unsigned char* Ki = F.lds + 33792; LAS unsigned char* Vi = F.lds + 67584; LAS unsigned char* Si = F.lds + 101376; LAS unsigned char* OT = F.lds + 110592;
    const unsigned w = (unsigned)F.wave;
    for (int u = F.vcu; u < NBATCH * RT_H * 2; u += F.G) {
        const int bh = u >> 1, vs2 = u & 1, b = bh >> 2, h = bh & 3, cbase = h * 512 + vs2 * 256;
        const float lg2g = log2f(1.0f - exp2f(-5.0f - (float)h)), cd = exp2f(64.0f * lg2g);
        f32x4 R[2][16];
#pragma unroll
        for (int cb = 0; cb < 2; ++cb)
#pragma unroll
            for (int i = 0; i < 16; ++i) R[cb][i] = (f32x4){0.f, 0.f, 0.f, 0.f};
        v4u pq[4], pk[4], pv[4];
        { const int row0 = b * SEQ;
#pragma unroll
          for (int i = 0; i < 4; ++i) { const int p = F.tid + 512 * i, r = p >> 5, c32 = p & 31; pq[i] = *(const v4u*)(Q + (size_t)(row0 + r) * DM + h * 256 + c32 * 8); pk[i] = *(const v4u*)(K + (size_t)(row0 + r) * DM + h * 256 + c32 * 8);
              pv[i] = *(const v4u*)(V + (size_t)(row0 + r) * 2048 + cbase + c32 * 8); } }
        __syncthreads();
        for (int c = 0; c < SEQ / 64; ++c) {
            const int row0 = b * SEQ + 64 * c;
            unsigned tidl = (unsigned)F.tid; asm volatile("" : "+v"(tidl));
            const unsigned lane = tidl & 63u, g = lane >> 4, li = lane & 15u;
#pragma unroll
            for (int i = 0; i < 4; ++i) { const unsigned p = tidl + 512u * i, r = p >> 5, c32 = p & 31u; const unsigned o = r * RQS + 16u * c32; *(LAS v4u*)(Qi + o) = pq[i]; *(LAS v4u*)(Ki + o) = pk[i]; *(LAS v4u*)(Vi + o) = pv[i]; }
            __syncthreads();
            RSB();
            const unsigned rb128 = li * RQS + 16u * g, rb64 = li * RQS + 8u * g, trq = (8u * g + (li >> 2)) * RQS + 8u * (li & 3u);
            { const unsigned mt = w >> 1, nt0 = 2u * (w & 1u); f32x4 sa0 = (f32x4){0.f, 0.f, 0.f, 0.f}, sa1 = sa0;
              const LAS unsigned char* qrow = Qi + rb128 + mt * (16u * RQS); const LAS unsigned char* krow = Ki + rb128 + nt0 * (16u * RQS);
              bf16x8 qa[2][2], kb0[2][2], kb1[2][2];
#define RET_LDS(buf, s8b) do { _Pragma("unroll") for (int k2 = 0; k2 < 2; ++k2) { const int s8 = (s8b) + k2; \
                  qa[buf][k2] = *(const LAS bf16x8*)(qrow + 64 * s8); kb0[buf][k2] = *(const LAS bf16x8*)(krow + 64 * s8); kb1[buf][k2] = *(const LAS bf16x8*)(krow + 16 * RQS + 64 * s8); } } while (0)
              RET_LDS(0, 0); RSB();
#pragma unroll
              for (int bt = 0; bt < 4; ++bt) { if (bt < 3) RET_LDS((bt + 1) & 1, 2 * (bt + 1)); RSB();
#pragma unroll
                  for (int k2 = 0; k2 < 2; ++k2) { sa0 = __builtin_amdgcn_mfma_f32_16x16x32_bf16(qa[bt & 1][k2], kb0[bt & 1][k2], sa0, 0, 0, 0); sa1 = __builtin_amdgcn_mfma_f32_16x16x32_bf16(qa[bt & 1][k2], kb1[bt & 1][k2], sa1, 0, 0, 0); }
                  RSB(); }
#undef RET_LDS
#pragma unroll
              for (int q = 0; q < 4; ++q) { const int n = (int)(16u * mt + 4u * g) + q, m0 = (int)(16u * nt0 + li);
                  const float v0 = sa0[q] * __builtin_amdgcn_exp2f(fabsf((float)(n - m0)) * lg2g), v1 = sa1[q] * __builtin_amdgcn_exp2f(fabsf((float)(n - m0 - 16)) * lg2g); const unsigned pk_ = pk2(v0, v1);
                  *(LAS unsigned short*)(Si + (unsigned)n * 144u + 2u * (unsigned)m0) = (unsigned short)(pk_ & 0xffffu); *(LAS unsigned short*)(Si + (unsigned)n * 144u + 2u * (unsigned)m0 + 32u) = (unsigned short)(pk_ >> 16); } }
            RSB();
            f32x4 Oa[4][2];
#pragma unroll
            for (int mt = 0; mt < 4; ++mt) { Oa[mt][0] = (f32x4){0.f, 0.f, 0.f, 0.f}; Oa[mt][1] = Oa[mt][0]; }
            { v2u qlo[2][4], qhi[2][4]; const LAS unsigned char* qp = Qi + rb64;
#define RET_LDQ(buf, s8) do { _Pragma("unroll") for (int mt = 0; mt < 4; ++mt) { qlo[buf][mt] = *(const LAS v2u*)(qp + mt * (16 * RQS) + 64 * (s8)); qhi[buf][mt] = *(const LAS v2u*)(qp + mt * (16 * RQS) + 64 * (s8) + 32); } } while (0)
              RET_LDQ(0, 0); RSB();
#pragma unroll
              for (int s8 = 0; s8 < 8; ++s8) { if (s8 < 7) RET_LDQ((s8 + 1) & 1, s8 + 1); RSB();
                  bf16x8 Rb[2];
#pragma unroll
                  for (int cb = 0; cb < 2; ++cb) { const v4u rt = (v4u){pk2(R[cb][2 * s8][0], R[cb][2 * s8][1]), pk2(R[cb][2 * s8][2], R[cb][2 * s8][3]), pk2(R[cb][2 * s8 + 1][0], R[cb][2 * s8 + 1][1]), pk2(R[cb][2 * s8 + 1][2], R[cb][2 * s8 + 1][3])}; Rb[cb] = __builtin_bit_cast(bf16x8, rt); }
#pragma unroll
                  for (int mt = 0; mt < 4; ++mt) { const v4u av = (v4u){qlo[s8 & 1][mt].x, qlo[s8 & 1][mt].y, qhi[s8 & 1][mt].x, qhi[s8 & 1][mt].y};
                      Oa[mt][0] = __builtin_amdgcn_mfma_f32_16x16x32_bf16(__builtin_bit_cast(bf16x8, av), Rb[0], Oa[mt][0], 0, 0, 0); Oa[mt][1] = __builtin_amdgcn_mfma_f32_16x16x32_bf16(__builtin_bit_cast(bf16x8, av), Rb[1], Oa[mt][1], 0, 0, 0); }
                  RSB(); }
#undef RET_LDQ
            }
#pragma unroll
            for (int mt = 0; mt < 4; ++mt)
#pragma unroll
                for (int q = 0; q < 4; ++q) { const float sc = __builtin_amdgcn_exp2f((float)(16 * mt + 4 * (int)g + q + 1) * lg2g); Oa[mt][0][q] *= sc; Oa[mt][1][q] *= sc; }
            __syncthreads();
            RSB();
            bf16x8 Vf[2][2];
#pragma unroll
            for (int cb = 0; cb < 2; ++cb)
#pragma unroll
                for (int ks = 0; ks < 2; ++ks) Vf[cb][ks] = tr_lin<RQS>(Vi + 64u * w + 32u * cb, trq, 0, ks);
#pragma unroll
            for (int mt = 0; mt < 4; ++mt) { const bf16x8 s0 = *(const LAS bf16x8*)(Si + (16u * mt + li) * 144u + 16u * g), s1 = *(const LAS bf16x8*)(Si + (16u * mt + li) * 144u + 64u + 16u * g);
#pragma unroll
                for (int cb = 0; cb < 2; ++cb) { Oa[mt][cb] = __builtin_amdgcn_mfma_f32_16x16x32_bf16(s0, Vf[cb][0], Oa[mt][cb], 0, 0, 0); Oa[mt][cb] = __builtin_amdgcn_mfma_f32_16x16x32_bf16(s1, Vf[cb][1], Oa[mt][cb], 0, 0, 0); } }
#pragma unroll
            for (int mt = 0; mt < 4; ++mt)
#pragma unroll
                for (int cb = 0; cb < 2; ++cb) { LAS unsigned char* op = OT + (16u * mt + 4u * g) * RQS + 2u * (32u * w + 16u * cb + li); const unsigned p0 = pk2(Oa[mt][cb][0], Oa[mt][cb][1]), p1 = pk2(Oa[mt][cb][2], Oa[mt][cb][3]);
                    *(LAS unsigned short*)(op) = (unsigned short)(p0 & 0xffffu); *(LAS unsigned short*)(op + RQS) = (unsigned short)(p0 >> 16); *(LAS unsigned short*)(op + 2 * RQS) = (unsigned short)(p1 & 0xffffu); *(LAS unsigned short*)(op + 3 * RQS) = (unsigned short)(p1 >> 16); }
            { const int rn = (c + 1 < SEQ / 64) ? row0 + 64 : row0;
#pragma unroll
                for (int i = 0; i < 4; ++i) { const unsigned p = tidl + 512u * i, r = p >> 5, c32 = p & 31u; pq[i] = *(const v4u*)(Q + (size_t)(rn + (int)r) * DM + h * 256 + c32 * 8); pk[i] = *(const v4u*)(K + (size_t)(rn + (int)r) * DM + h * 256 + c32 * 8);
                    pv[i] = *(const v4u*)(V + (size_t)(rn + (int)r) * 2048 + cbase + c32 * 8); } }
            RSB();
            bf16x8 Vd[2][2];
#pragma unroll
            for (int ks = 0; ks < 2; ++ks) { float f[8];
#pragma unroll
                for (int j = 0; j < 8; ++j) f[j] = __builtin_amdgcn_exp2f((float)(63 - (32 * ks + 8 * (int)g + j)) * lg2g);
#pragma unroll
                for (int cb = 0; cb < 2; ++cb) { const v4u vv = __builtin_bit_cast(v4u, Vf[cb][ks]);
                    const v4u sv = (v4u){pk2(bflo(vv.x) * f[0], bfhi(vv.x) * f[1]), pk2(bflo(vv.y) * f[2], bfhi(vv.y) * f[3]), pk2(bflo(vv.z) * f[4], bfhi(vv.z) * f[5]), pk2(bflo(vv.w) * f[6], bfhi(vv.w) * f[7])};
                    Vd[cb][ks] = __builtin_bit_cast(bf16x8, sv); } }
            {
#pragma unroll
              for (int bt = 0; bt < 8; ++bt) { bf16x8 ka[2][2];
#pragma unroll
                  for (int d2 = 0; d2 < 2; ++d2)
#pragma unroll
                      for (int ks = 0; ks < 2; ++ks) ka[d2][ks] = tr_lin<RQS>(Ki, trq, 2 * bt + d2, ks);
#pragma unroll
                  for (int d2 = 0; d2 < 2; ++d2) { const int dt = 2 * bt + d2;
#pragma unroll
                      for (int cb = 0; cb < 2; ++cb) { R[cb][dt] = R[cb][dt] * cd;
#pragma unroll
                          for (int ks = 0; ks < 2; ++ks) R[cb][dt] = __builtin_amdgcn_mfma_f32_16x16x32_bf16(ka[d2][ks], Vd[cb][ks], R[cb][dt], 0, 0, 0); } }
              }
            }
            __syncthreads();
            { const unsigned tn = tidl >> 3, vg = tidl & 7u; float ssq = 0.f;
              const size_t go = (size_t)(row0 + (int)tn) * 2048 + cbase + 32 * vg; bf16* op = O + go;
              v4u sg[4];
#pragma unroll
              for (int i = 0; i < 4; ++i) sg[i] = *(const v4u*)(SGp + go + 8 * i);
#pragma unroll
              for (int i = 0; i < 4; ++i) { const v4u r_ = *(const LAS v4u*)(OT + tn * RQS + 64u * vg + 16u * i); f32x4 o0 = (f32x4){bflo(r_.x), bfhi(r_.x), bflo(r_.y), bfhi(r_.y)}, o1 = (f32x4){bflo(r_.z), bfhi(r_.z), bflo(r_.w), bfhi(r_.w)};
                  ssq += (o0.x * o0.x + o0.y * o0.y) + (o0.z * o0.z + o0.w * o0.w) + (o1.x * o1.x + o1.y * o1.y) + (o1.z * o1.z + o1.w * o1.w);
                  const v4u gq = sg[i]; o0.x *= bflo(gq.x); o0.y *= bfhi(gq.x); o0.z *= bflo(gq.y); o0.w *= bfhi(gq.y); o1.x *= bflo(gq.z); o1.y *= bfhi(gq.z); o1.z *= bflo(gq.w); o1.w *= bfhi(gq.w);
                  *(v4u*)(op + 8 * i) = pack8(o0, o1); }
              ssq += __shfl_xor(ssq, 1); ssq += __shfl_xor(ssq, 2);
              if ((vg & 3u) == 0u) SS[((size_t)(row0 + (int)tn) * 4 + h) * 4 + 2 * vs2 + (int)(vg >> 2)] = ssq; }
        }
    }
}
__device__ __forceinline__ void ret_norm(Frame& F, bool dry = false) {
    relaunder(F);
    bf16* O = (bf16*)(F.ws + WS_R2); bf16* Od = dry ? (bf16*)(F.ws + WS_R2 + 288 * MiB) : O; const float* SS = (const float*)(F.ws + WS_R2 + 256 * MiB); const bf16* SG = (const bf16*)(F.ws + WS_R1 + 512 * MiB);
    const int gw = F.vcu * NWAVES + F.wave, NGW = F.G * NWAVES;
    for (int row = gw; row < MTOK; row += NGW) {
        float r[4];
#pragma unroll
        for (int h = 0; h < 4; ++h) { const f32x4 p = *(const f32x4*)(SS + ((size_t)row * 4 + h) * 4); r[h] = 1.0f / sqrtf(((p.x + p.y) + (p.z + p.w)) * (1.0f / 512.f) + EPS); }
#pragma unroll
        for (int j = 0; j < 4; ++j) { const size_t gi = (size_t)row * 2048 + 512 * j + 8 * F.lane; const v4u o = *(const v4u*)(O + gi), sg = *(const v4u*)(SG + gi); const float rr = r[j];
            v4u w; w.x = pk2(bflo(o.x) * rr * bflo(sg.x), bfhi(o.x) * rr * bfhi(sg.x)); w.y = pk2(bflo(o.y) * rr * bflo(sg.y), bfhi(o.y) * rr * bfhi(sg.y));
            w.z = pk2(bflo(o.z) * rr * bflo(sg.z), bfhi(o.z) * rr * bfhi(sg.z)); w.w = pk2(bflo(o.w) * rr * bflo(sg.w), bfhi(o.w) * rr * bfhi(sg.w));
            *(v4u*)(Od + gi) = w; }
    }
}

__device__ __forceinline__ bf16x8 pad8(s16x4 a) { return (bf16x8){a[0], a[1], a[2], a[3], 0, 0, 0, 0}; }
__device__ __forceinline__ void hgrn_scan_mfma(Frame& F, int j) {
    relaunder(F);
    const bf16* Q = (const bf16*)(F.ws + WS_R1); const bf16* LFb = (const bf16*)(F.ws + WS_R1 + 128 * MiB); const bf16* V = (const bf16*)(F.ws + WS_R1 + 256 * MiB); const bf16* SG = (const bf16*)(F.ws + WS_R1 + 384 * MiB);
    bf16* O = (bf16*)(F.ws + WS_R2);
    LAS unsigned char* QEi = F.lds; LAS unsigned char* QE2i = F.lds + 17408; LAS unsigned char* KEi = F.lds + 34816; LAS unsigned char* Vi = F.lds + 52224;
    LAS float* BL = (LAS float*)(F.lds + 69632); LAS float* OT = (LAS float*)(F.lds + 71680);
    const unsigned w = (unsigned)F.wave;
    LAS float* GT = (LAS float*)(F.lds + 105472);
    if (F.tid < 128) GT[F.tid] = KIN(I_HGAIN)[j * 128 + F.tid];
    for (int u = F.vcu; u < NBATCH * HG_H; u += F.G) {
        const int b = u >> 3, h = u & 7;
        f32x4 S[8];
#pragma unroll
        for (int i = 0; i < 8; ++i) S[i] = (f32x4){0.f, 0.f, 0.f, 0.f};
        unsigned short plf[16], pq[16]; v4u pv[2];
        { const int kbp = F.tid >> 7, dp = F.tid & 127, row0 = b * SEQ;
#pragma unroll
          for (int t = 0; t < 16; ++t) { const size_t gi = (size_t)(row0 + 16 * kbp + t) * DM + h * 128 + dp; plf[t] = LFb[gi]; pq[t] = Q[gi]; }
#pragma unroll
          for (int i = 0; i < 2; ++i) { const int p = F.tid + 512 * i, r = p >> 4, c16 = p & 15; pv[i] = *(const v4u*)(V + (size_t)(row0 + r) * DM + h * 128 + c16 * 8); }
        }
        __syncthreads();
        for (int c = 0; c < SEQ / 64; ++c) {
            const int row0 = b * SEQ + 64 * c;
            unsigned tidl = (unsigned)F.tid; asm volatile("" : "+v"(tidl));
            const unsigned lane = tidl & 63u, g = lane >> 4, li = lane & 15u, kbp = tidl >> 7, dp = tidl & 127u;
            { float bs = 0.f, bsv[16];
#pragma unroll
              for (int t = 0; t < 16; ++t) { bs += bf2f(plf[t]); bsv[t] = bs; }
              const float bl = bsv[15], ebl = __builtin_amdgcn_exp2f(bl); const unsigned a0 = (16u * kbp) * RVS + 2u * dp;
              float eprev = ebl;
#pragma unroll
              for (int t = 0; t < 16; ++t) { const float bt = bsv[t], q = bf2f(pq[t]), e1 = __builtin_amdgcn_exp2f(bl - bt), ke = e1 - eprev; eprev = e1;
                  const unsigned w0 = pk2(q * __builtin_amdgcn_exp2f(bt), q * __builtin_amdgcn_exp2f(fminf(bt - bl, 115.f))), w1 = pk2(ke, 0.f);
                  *(LAS unsigned short*)(QEi + a0 + t * RVS) = (unsigned short)(w0 & 0xffffu); *(LAS unsigned short*)(QE2i + a0 + t * RVS) = (unsigned short)(w0 >> 16); *(LAS unsigned short*)(KEi + a0 + t * RVS) = (unsigned short)(w1 & 0xffffu); }
              BL[kbp * 128u + dp] = ebl; }
#pragma unroll
            for (int i = 0; i < 2; ++i) { const unsigned p = tidl + 512u * i, r = p >> 4, c16 = p & 15u; *(LAS v4u*)(Vi + r * RVS + 16u * c16) = pv[i]; }
            __syncthreads();
            const v4u csg0 = *(const v4u*)(SG + (size_t)(row0 + (int)(tidl >> 3)) * DM + h * 128 + 16 * (tidl & 7u)), csg1 = *(const v4u*)(SG + (size_t)(row0 + (int)(tidl >> 3)) * DM + h * 128 + 16 * (tidl & 7u) + 8);
            asm volatile("" ::: "memory");
            { const int rn = (c + 1 < SEQ / 64) ? row0 + 64 : row0;
#pragma unroll
                for (int t = 0; t < 16; ++t) { const unsigned vo = ((16u * kbp + (unsigned)t) * DM + dp) * 2u;
                    plf[t] = *(const unsigned short*)((const char*)(LFb + (size_t)rn * DM + h * 128) + vo); pq[t] = *(const unsigned short*)((const char*)(Q + (size_t)rn * DM + h * 128) + vo); }
#pragma unroll
                for (int i = 0; i < 2; ++i) { const unsigned p = tidl + 512u * i, r = p >> 4, c16 = p & 15u; pv[i] = *(const v4u*)(V + (size_t)(rn + (int)r) * DM + h * 128 + c16 * 8); }
            }
            RSB();
            const unsigned rb128 = li * RVS + 16u * g, rb64 = li * RVS + 8u * g, trb = (4u * g + (li >> 2)) * RVS + 8u * (li & 3u);
            f32x4 P[4];
            { bf16x8 kef[2][4], q2f[2][4];
#define HG_LDP(buf, kb_) do { _Pragma("unroll") for (int s4 = 0; s4 < 4; ++s4) { kef[buf][s4] = *(const LAS bf16x8*)(KEi + (kb_) * (16u * RVS) + rb128 + 64 * s4); q2f[buf][s4] = *(const LAS bf16x8*)(QE2i + (kb_) * (16u * RVS) + rb128 + 64 * s4); } } while (0)
              HG_LDP(0, 0); RSB();
#pragma unroll
              for (int kb = 0; kb < 4; ++kb) { if (kb < 3) HG_LDP((kb + 1) & 1, kb + 1); RSB();
                  f32x4 p_ = (f32x4){0.f, 0.f, 0.f, 0.f};
#pragma unroll
                  for (int s4 = 0; s4 < 4; ++s4) p_ = __builtin_amdgcn_mfma_f32_16x16x32_bf16(kef[kb & 1][s4], q2f[kb & 1][s4], p_, 0, 0, 0);
                  P[kb] = p_; RSB(); }
#undef HG_LDP
            }
            { v2u qlo[2][4], qhi[2][4]; s16x4 Vbb[2];
#define HG_LDQ(buf, kb_) do { Vbb[buf] = __builtin_amdgcn_ds_read_tr16_b64_v4i16((LAS s16x4*)(Vi + (kb_) * (16u * RVS) + trb + 32u * w)); \
                  _Pragma("unroll") for (int s4 = 0; s4 < 4; ++s4) { qlo[buf][s4] = *(const LAS v2u*)(QEi + (kb_) * (16u * RVS) + rb64 + 64 * s4); qhi[buf][s4] = *(const LAS v2u*)(QEi + (kb_) * (16u * RVS) + rb64 + 64 * s4 + 32); } } while (0)
              HG_LDQ(0, 0); RSB();
#pragma unroll
              for (int kb = 0; kb < 4; ++kb) {
                  const unsigned ko = kb * (16u * RVS);
                  s16x4 ktf[8]; f32x4 e4[8];
#pragma unroll
                  for (int dt = 0; dt < 8; ++dt) { ktf[dt] = __builtin_amdgcn_ds_read_tr16_b64_v4i16((LAS s16x4*)(KEi + ko + trb + 32 * dt)); e4[dt] = *(const LAS f32x4*)(BL + kb * 128u + 16u * dt + 4u * g); }
                  if (kb < 3) HG_LDQ((kb + 1) & 1, kb + 1);
                  RSB();
                  f32x4 oa = (f32x4){0.f, 0.f, 0.f, 0.f};
#pragma unroll
                  for (int s4 = 0; s4 < 4; ++s4) {
                      const v4u st = (v4u){pk2(S[2 * s4][0], S[2 * s4][1]), pk2(S[2 * s4][2], S[2 * s4][3]), pk2(S[2 * s4 + 1][0], S[2 * s4 + 1][1]), pk2(S[2 * s4 + 1][2], S[2 * s4 + 1][3])};
                      const v4u av = (v4u){qlo[kb & 1][s4].x, qlo[kb & 1][s4].y, qhi[kb & 1][s4].x, qhi[kb & 1][s4].y};
                      oa = __builtin_amdgcn_mfma_f32_16x16x32_bf16(__builtin_bit_cast(bf16x8, av), __builtin_bit_cast(bf16x8, st), oa, 0, 0, 0); }
                  s16x4 a16;
                  { const f32x4 Pk = P[kb]; const unsigned lo = pk2((4u * g + 0u <= li) ? Pk[0] : 0.f, (4u * g + 1u <= li) ? Pk[1] : 0.f), hi = pk2((4u * g + 2u <= li) ? Pk[2] : 0.f, (4u * g + 3u <= li) ? Pk[3] : 0.f); const v2u t2 = (v2u){lo, hi}; a16 = __builtin_bit_cast(s16x4, t2); }
                  const bf16x8 Vb8 = pad8(Vbb[kb & 1]);
                  oa = __builtin_amdgcn_mfma_f32_16x16x32_bf16(pad8(a16), Vb8, oa, 0, 0, 0);
#pragma unroll
                  for (int dt = 0; dt < 8; ++dt) S[dt] = __builtin_amdgcn_mfma_f32_16x16x32_bf16(pad8(ktf[dt]), Vb8, S[dt] * e4[dt], 0, 0, 0);
#pragma unroll
                  for (int q = 0; q < 4; ++q) OT[(16u * kb + 4u * g + q) * 132u + 16u * w + li] = oa[q];
                  RSB();
              }
#undef HG_LDQ
            }
            __syncthreads();
            { const unsigned tn = tidl >> 3, vg = tidl & 7u; f32x4 o[4]; float ss = 0.f;
#pragma unroll
              for (int i = 0; i < 4; ++i) { o[i] = *(const LAS f32x4*)(OT + tn * 132u + 16u * vg + 4u * i); ss += (o[i].x * o[i].x + o[i].y * o[i].y) + (o[i].z * o[i].z + o[i].w * o[i].w); }
              ss += __shfl_xor(ss, 1); ss += __shfl_xor(ss, 2); ss += __shfl_xor(ss, 4);
              const float r = 1.0f / sqrtf(ss * (1.0f / 128.f) + EPS);
#pragma unroll
              for (int i = 0; i < 4; ++i) o[i] = o[i] * r * *(const LAS f32x4*)(GT + 16u * vg + 4u * i);
              v4u w0, w1;
              w0.x = pk2(o[0].x * bflo(csg0.x), o[0].y * bfhi(csg0.x)); w0.y = pk2(o[0].z * bflo(csg0.y), o[0].w * bfhi(csg0.y)); w0.z = pk2(o[1].x * bflo(csg0.z), o[1].y * bfhi(csg0.z)); w0.w = pk2(o[1].z * bflo(csg0.w), o[1].w * bfhi(csg0.w));
              w1.x = pk2(o[2].x * bflo(csg1.x), o[2].y * bfhi(csg1.x)); w1.y = pk2(o[2].z * bflo(csg1.y), o[2].w * bfhi(csg1.y)); w1.z = pk2(o[3].x * bflo(csg1.z), o[3].y * bfhi(csg1.z)); w1.w = pk2(o[3].z * bflo(csg1.w), o[3].w * bfhi(csg1.w));
              bf16* op = O + (size_t)(row0 + (int)tn) * DM + h * 128 + 16 * vg; *(v4u*)op = w0; *(v4u*)(op + 8) = w1; }
        }
    }
}

struct Args { const void* in[22]; float* out; unsigned char* ws; int ph_lo, ph_hi; };
constexpr int PH_PER_LAYER = 9, NPHASES = 1 + DEPTH * PH_PER_LAYER + 1;

__global__ void __launch_bounds__(NWAVES * 64, 2) hybrid_fwd(Args args) {
    extern __shared__ __attribute__((aligned(16))) unsigned char lds[];
    Frame F;
    F.lds = (LAS unsigned char*)lds;
    F.tid = threadIdx.x; F.lane = F.tid & 63; F.wave = __builtin_amdgcn_readfirstlane(F.tid >> 6);
    F.G = gridDim.x; { const int bx = blockIdx.x; F.vcu = (F.G % 8 == 0) ? (bx % 8) * (F.G / 8) + bx / 8 : bx; }
    F.ws = args.ws; F.out = args.out; F.ctl = (unsigned*)(args.ws + WS_CTL);
    for (int u = F.tid; u < (LDS_BYTES - MISC_OFF) / 4; u += NWAVES * 64) ((LAS unsigned*)(F.lds + MISC_OFF))[u] = 0u;
    __syncthreads();
    const int lo = args.ph_lo, hi = args.ph_hi;
    XcdBarrier bar; bar.bar = F.ctl + CW_BAR; bar.x = 0; bar.st = nullptr;
    if (hi - lo > 1) bar = xcd_barrier_post(F.ctl + CW_BAR, (volatile LAS unsigned*)(F.lds + MISC_OFF) + 8);
#define IN(k) (lo <= (k) && (k) < hi)
#define SEAM(k) do { if (IN(k) && hi > (k) + 1) xcd_barrier(bar); } while (0)

    if (PH_EN(0) && IN(0)) { for (int rep = 0; rep < REPS(0); ++rep) p0_prologue(F); } SEAM(0);

#pragma unroll 1
    for (int l = 0; l < DEPTH; ++l) {
        const int pb = 1 + l * PH_PER_LAYER, j = l >> 1; const bool is_ret = (l & 1);
        if (PH_EN(1) && IN(pb + 0)) { row_phase1(F, l, 0); if (REPS(13) > 1 && l > 0) { __syncthreads(); row_phase1(F, l, 0, true); } }
        SEAM(pb + 0);
        if (IN(pb + 1)) {
            if (PH_EN(2) && !is_ret) {
                for (int rep = 0; rep < REPS(2); ++rep) {
                    if constexpr (HG_N8 > 0) {
                        pg8::Gemm g{(const bf16*)(F.ws + WS_H8), (const bf16*)(F.ws + WS_HWIN + (size_t)j * HG_N8 * DM), MTOK, HG_N8, DM / 2}; pg8::StaticOrder S; S.init(MTOK, HG_N8, F.G, (int)blockIdx.x);
                        const EpiHgrnIn E{F.ws + WS_R1, (const float*)(F.ws + WS_LBV) + j * DM, hg_smap(HGRN_FP8_MASK), 1.0f / 512.f};
                        pg8::gemm_phase<EpiHgrnIn, pg8::StaticOrder, true, true, false, true>(F.lds + RING_OFF, g, S, E); }
                    if constexpr (HG_N16 > 0) {
                        pg8::Gemm g{(const bf16*)(F.ws + WS_H), (const bf16*)(F.ws + WS_HWIN + HG_W16_OFF) + (size_t)j * HG_N16 * DM, MTOK, HG_N16, DM}; pg8::StaticOrder S; S.init(MTOK, HG_N16, F.G, (int)blockIdx.x);
                        const EpiHgrnIn E{F.ws + WS_R1, (const float*)(F.ws + WS_LBV) + j * DM, hg_smap(0xF & ~HGRN_FP8_MASK), 1.0f};
                        pg8::gemm_phase<EpiHgrnIn, pg8::StaticOrder, true, true>(F.lds + RING_OFF, g, S, E); }
                }
            } else if (PH_EN(3)) {
                pg8::StaticOrder S; S.init(MTOK, RT_N, F.G, (int)blockIdx.x);
                if constexpr (RET_IN_FP8) {
                    pg8::Gemm g{(const bf16*)(F.ws + WS_H8), (const bf16*)(F.ws + WS_RWIN + (size_t)j * RT_N * DM), MTOK, RT_N, DM / 2};
                    EpiRetIn E{F.ws + WS_R1, (const int*)kin_(I_POS), 1.0f / 512.f};
                    for (int rep = 0; rep < REPS(3); ++rep) pg8::gemm_phase<EpiRetIn, pg8::StaticOrder, true, true, false, true>(F.lds + RING_OFF, g, S, E);
                } else {
                    pg8::Gemm g{(const bf16*)(F.ws + WS_H), (const bf16*)(F.ws + WS_RWIN) + (size_t)j * RT_N * DM, MTOK, RT_N, DM};
                    EpiRetIn E{F.ws + WS_R1, (const int*)kin_(I_POS), 1.0f};
                    for (int rep = 0; rep < REPS(3); ++rep) pg8::gemm_phase<EpiRetIn, pg8::StaticOrder, true, true>(F.lds + RING_OFF, g, S, E);
                }
            }
        }
        SEAM(pb + 1);
        if (IN(pb + 2)) { if (!is_ret) { if (PH_EN(4)) { for (int rep = 0; rep < REPS(4); ++rep) { if (HGRN_MFMA) hgrn_scan_mfma(F, j); else hgrn_scan(F, j); } } } else { if (PH_EN(5)) { for (int rep = 0; rep < REPS(5); ++rep) { if (RET_MFMA && RET_WIDE && RET_FOLD) ret_scan_mfma2(F); else if (RET_MFMA) ret_scan_mfma(F); else ret_scan(F); } } } }
        SEAM(pb + 2);
        if (RET_MFMA && !RET_FOLD && PH_EN(12) && IN(pb + 3) && is_ret) { if (REPS(14) > 1) ret_norm(F, true); ret_norm(F); }
        if (RET_MFMA && !RET_FOLD && is_ret) SEAM(pb + 3);
        if (PH_EN(6) && IN(pb + 4)) {
            const int Ko = is_ret ? 2048 : DM;
            const bf16* Wt = is_ret ? (const bf16*)(F.ws + WS_RWOUT) + (size_t)j * DM * 2048 : (const bf16*)(F.ws + WS_HWOUT) + (size_t)j * DM * DM;
            pg8::Gemm g{(const bf16*)(F.ws + WS_R2), Wt, MTOK, DM, Ko}; pg8::StaticOrder S; S.init(MTOK, DM, F.G, (int)blockIdx.x);
            const float* gate1 = (const float*)(F.ws + WS_MOD) + (size_t)l * NBATCH * 6 * DM + 2 * DM; bf16* xb = (bf16*)(F.ws + WS_XB);
            if (REPS(15) > 1) { EpiOutT<false> Ed{l == 0 ? (const void*)(F.ws + WS_R1 + 512 * MiB) : (const void*)xb, (bf16*)(F.ws + WS_R1), gate1}; pg8::gemm_phase<EpiOutT<false>, pg8::StaticOrder, true, true>(F.lds + RING_OFF, g, S, Ed); }
            if (RET_MFMA && RET_FOLD && is_ret) { const pg8::HScale hs{(const float*)(F.ws + WS_R2 + 256 * MiB), (LAS float*)(F.lds + 131072), EPS}; const EpiOutT<false> E{xb, xb, gate1};
                pg8::gemm_phase<EpiOutT<false>, pg8::StaticOrder, true, true, false, false, false, true>(F.lds + RING_OFF, g, S, E, hs); }
            else if (l == 0) { const EpiOutT<true> E{KIN(I_X), xb, gate1}; pg8::gemm_phase<EpiOutT<true>, pg8::StaticOrder, true, true>(F.lds + RING_OFF, g, S, E); }
            else { const EpiOutT<false> E{xb, xb, gate1}; pg8::gemm_phase<EpiOutT<false>, pg8::StaticOrder, true, true>(F.lds + RING_OFF, g, S, E); }
        }
        SEAM(pb + 4);
        if (PH_EN(7) && IN(pb + 5)) { if (REPS(18) > 1) row_phase2(F, l, true); row_phase2(F, l); }
        SEAM(pb + 5);
        if (MOE_GATHER_PASS) { if (PH_EN(8) && IN(pb + 6)) { for (int rep = 0; rep < REPS(8); ++rep) moe_gather(F, l); } SEAM(pb + 6); }
        if (PH_EN(9) && IN(pb + 7)) {
            build_tiles(F, l);
            if (!MOE_GATHER_PASS) moe_build_tt(F, 8);
            pg8::MoeOrder S{8, F.G, F.vcu, (const LAS int*)(F.lds + TAB_OFF), (const LAS unsigned short*)(F.lds + 131072)};
            if constexpr (MOE_FP8) {
                static_assert(!MOE_FP8 || !MOE_GATHER_PASS, "the fp8 expert GEMM gathers while staging");
                pg8::Gemm g{(const bf16*)(F.ws + WS_H8), (const bf16*)(F.ws + WS_W1T + (size_t)l * NEXP * 2048 * DM), 0, 0, DM / 2};
                EpiMoe1F8 E{F.ws + WS_R2, KIN(I_B1) + (size_t)l * NEXP * 2048};
                for (int rep = 0; rep < REPS(9); ++rep) pg8::gemm_phase<EpiMoe1F8, pg8::MoeOrder, MOE_ALIGN, true, true, true>(F.lds + RING_OFF, g, S, E);
                if (REPS(12) > 1) pg8::gemm_phase<EpiMoe1F8, pg8::MoeOrder, true, true, true, true, true>(F.lds + RING_OFF, g, S, E);
            } else {
                pg8::Gemm g{(const bf16*)(F.ws + (MOE_GATHER_PASS ? WS_R1 : WS_H)), (const bf16*)(F.ws + WS_W1T) + (size_t)l * NEXP * 2048 * DM, 0, 0, DM};
                EpiMoe1 E{(bf16*)(F.ws + WS_R2), KIN(I_B1) + (size_t)l * NEXP * 2048};
                for (int rep = 0; rep < REPS(9); ++rep) pg8::gemm_phase<EpiMoe1, pg8::MoeOrder, true, true, !MOE_GATHER_PASS>(F.lds + RING_OFF, g, S, E);
            }
        }
        SEAM(pb + 7);
        if (PH_EN(10) && IN(pb + 8)) {
            build_tiles(F, l);
            pg8::MoeOrder S{4, F.G, F.vcu, (const LAS int*)(F.lds + TAB_OFF), nullptr};
            if (SKEW_TICKS) phase_skew(F, SKEW_TICKS);
            if constexpr (MOE_FP8) {
                pg8::Gemm g{(const bf16*)(F.ws + WS_R2), (const bf16*)(F.ws + WS_W2T + (size_t)l * NEXP * DM * DM), 0, 0, DM / 2};
                EpiMoe2Y8 E{F.ws + WS_R1, KIN(I_B2) + (size_t)l * NEXP * DM, 1.0f / 256.f};
                for (int rep = 0; rep < REPS(10); ++rep) pg8::gemm_phase<EpiMoe2Y8, pg8::MoeOrder, MOE_ALIGN, true, false, true>(F.lds + RING_OFF, g, S, E);
            } else {
                pg8::Gemm g{(const bf16*)(F.ws + WS_R2), (const bf16*)(F.ws + WS_W2T) + (size_t)l * NEXP * DM * DM, 0, 0, DM};
                EpiMoe2 E{(bf16*)(F.ws + WS_R1), KIN(I_B2) + (size_t)l * NEXP * DM, 1.0f};
                for (int rep = 0; rep < REPS(10); ++rep) pg8::gemm_phase<EpiMoe2, pg8::MoeOrder, true, true>(F.lds + RING_OFF, g, S, E);
            }
        }
        SEAM(pb + 8);
    }
    if (PH_EN(11) && IN(NPHASES - 1)) row_phase1(F, DEPTH, 1);
#undef IN
#undef SEAM
}

extern "C" void kernel_launch(void* const* d_in, const int* in_sizes, int n_in, void* d_out, int out_size, void* d_ws, size_t ws_size, hipStream_t stream) {
    static int grid = 0;
    if (grid == 0) {
        if (n_in != 22 || in_sizes[0] != MTOK * DM || out_size != MTOK * DM || ws_size < WS_END) { fprintf(stderr, "kernel_launch: unexpected shapes (n_in %d, in0 %d, out %d, ws %zu < %zu)\n", n_in, n_in > 0 ? in_sizes[0] : -1, out_size, ws_size, (size_t)WS_END); grid = -1; return; }
        int dev = 0, cus = 0, per_cu = 0;
        if (hipGetDevice(&dev) != hipSuccess || hipDeviceGetAttribute(&cus, hipDeviceAttributeMultiprocessorCount, dev) != hipSuccess) { grid = -1; return; }
        if (hipFuncSetAttribute((const void*)hybrid_fwd, hipFuncAttributeMaxDynamicSharedMemorySize, LDS_BYTES) != hipSuccess) { fprintf(stderr, "kernel_launch: hipFuncSetAttribute failed\n"); grid = -1; return; }
        if (hipOccupancyMaxActiveBlocksPerMultiprocessor(&per_cu, (const void*)hybrid_fwd, NWAVES * 64, LDS_BYTES) != hipSuccess || per_cu < 1) { fprintf(stderr, "kernel_launch: occupancy query says %d blocks per CU\n", per_cu); }
        (void)hipGetLastError();
        if (cus != 256) { fprintf(stderr, "kernel_launch: built for a 256-CU device (one workgroup per CU); this one reports %d; nothing launched\n", cus); grid = -1; return; }
        grid = cus;
    }
    if (grid < 0) return;
    (void)hipMemsetAsync((char*)d_ws + WS_CTL, 0, CTL_ZERO_BYTES, stream);
    Args a{};
    for (int i = 0; i < 22; ++i) a.in[i] = d_in[i];
    a.out = (float*)d_out; a.ws = (unsigned char*)d_ws;
#if MK_SPLIT
    for (int p = 0; p < DBG_LIMIT; ++p) {
        if (p >= 1 && p < NPHASES - 1 && ((p - 1) % PH_PER_LAYER) == 3 && (!RET_MFMA || RET_FOLD || (((p - 1) / PH_PER_LAYER) & 1) == 0)) continue;
        if (!MOE_GATHER_PASS && p >= 1 && p < NPHASES - 1 && ((p - 1) % PH_PER_LAYER) == 6) continue;
        a.ph_lo = p; a.ph_hi = p + 1;
        hipLaunchKernelGGL(hybrid_fwd, dim3(grid), dim3(NWAVES * 64), LDS_BYTES, stream, a);
    }
#else
    a.ph_lo = 0; a.ph_hi = NPHASES;
    hipLaunchKernelGGL(hybrid_fwd, dim3(grid), dim3(NWAVES * 64), LDS_BYTES, stream, a);
#endif
    const hipError_t le = hipPeekAtLastError();
    if (le != hipSuccess) fprintf(stderr, "kernel_launch: launch failed: %s\n", hipGetErrorName(le));
}
```

```cpp
#include <hip/hip_runtime.h>
#include <cstdio>
#include <cstdint>

#ifndef ONLY_PH
#define ONLY_PH -1
#endif
#define PH_EN(n) (ONLY_PH < 0 || ONLY_PH == (n))
#ifndef DBG_LIMIT
#define DBG_LIMIT NPHASES
#endif
#ifndef RET_MFMA
#define RET_MFMA 1
#endif
#ifndef HGRN_MFMA
#define HGRN_MFMA 1
#endif
#ifndef REPEAT_MASK
#define REPEAT_MASK 0
#endif
#define REPS(k) (1 + ((REPEAT_MASK >> (k)) & 1))
#ifndef MOE_GATHER_PASS
#define MOE_GATHER_PASS 0
#endif
#ifndef MOE_FP8
#define MOE_FP8 1
#endif
#ifndef SKEW_TICKS
#define SKEW_TICKS 0
#endif
#ifndef HGRN_FP8_MASK
#define HGRN_FP8_MASK 0xF
#endif
#ifndef RET_WIDE
#define RET_WIDE 1
#endif
#ifndef HGRN_OUT_FP8
#define HGRN_OUT_FP8 1
#endif
#ifndef RET_IN_FP8
#define RET_IN_FP8 1
#endif
#ifndef MOE_ALIGN
#define MOE_ALIGN true
#endif
#ifndef RET_FOLD
#define RET_FOLD 1
#endif
#ifndef MK_SPLIT
#define MK_SPLIT 0
#endif

namespace pg8 {
#define PG8_LAS __attribute__((address_space(3)))
typedef unsigned short bf16_t;
typedef short bf16x8 __attribute__((ext_vector_type(8)));
typedef float f32x4 __attribute__((ext_vector_type(4)));
typedef unsigned u32x4 __attribute__((ext_vector_type(4)));
constexpr int BM = 256, BK = 64, HALF = 128, HTB = HALF * BK * 2  , STAGE_BYTES = 8 * HTB, NXCD = 8, WGM = 8;

__host__ __device__ __forceinline__ int lds_byte(int r, int c) { const int st = (r >> 4) * 2 + (c >> 5), rr = r & 15, cc = c & 31, ob = rr * 64 + cc * 2; return st * 1024 + (ob ^ (((ob >> 9) & 1) << 5)); }
__host__ __device__ __forceinline__ void stage_rc(int b, int& R, int& C) { const int st = b / 1024, sb = b % 1024, swz = sb ^ (((sb >> 9) & 1) << 5); R = (st >> 1) * 16 + swz / 64; C = (st & 1) * 32 + (swz % 64) / 2; }
__host__ __device__ __forceinline__ int perm32(int rho) { const int n = rho >> 4, i = rho & 15; return 8 * (i >> 2) + 4 * n + (i & 3); }

struct Unit { int pm, pn, e, nn; };
struct Gemm { const bf16_t* A; const bf16_t* Bt; int M, N, K; };

struct StaticOrder {
    int nM, nN, nwg, G, c;
    __host__ __device__ void init(int M, int N, int G_, int c_) { nM = M / BM; nN = N / BM; nwg = nM * nN; G = G_; c = c_; }
    __host__ __device__ bool next(int i, Unit& u) const {
        const long L = (long)i * G + c; if (L >= nwg) return false;
        int wgid = (int)L; { const int q = nwg / NXCD, r = nwg % NXCD, xcd = wgid % NXCD, off = wgid / NXCD; wgid = (xcd < r ? xcd * (q + 1) : r * (q + 1) + (xcd - r) * q) + off; }
        const int nig = WGM * nN, gid = wgid / nig, fm = gid * WGM, gsz = (nM - fm) < WGM ? (nM - fm) : WGM;
        u.pm = fm + ((wgid % nig) % gsz); u.pn = (wgid % nig) / gsz; u.e = 0; u.nn = u.pn; return true;
    }
    __device__ __forceinline__ unsigned tok(int, int) const { return 0u; }
    __device__ __forceinline__ void a_ready(const Unit&) const {}
    __device__ __forceinline__ void done(const Unit&) const {}
};
struct MoeOrder {
    int nN, G, c; const PG8_LAS int* ts; const PG8_LAS unsigned short* tt;
    __device__ __forceinline__ unsigned tok(int i, int r) const { return tt[i * 256 + r]; }
    __device__ __forceinline__ bool next(int i, Unit& u) const {
        const int NT = ts[32]; const long L = (long)i * G + c; if (L >= (long)NT * nN) return false;
        const int mt = (int)(L / nN), n = (int)(L % nN); int e = 0;
        for (int k = 1; k < 32; ++k) e += (ts[k] <= mt) ? 1 : 0;
        u.pm = mt; u.pn = e * nN + n; u.e = e; u.nn = n; return true;
    }
    __device__ __forceinline__ void a_ready(const Unit&) const {}
    __device__ __forceinline__ void done(const Unit&) const {}
};

typedef float cvt_f2_ __attribute__((ext_vector_type(2)));
typedef __bf16 cvt_b2_ __attribute__((ext_vector_type(2)));
__device__ __forceinline__ unsigned cvt_pk_bf16(float lo, float hi) { const cvt_f2_ v = {lo, hi}; const cvt_b2_ r = __builtin_convertvector(v, cvt_b2_); return __builtin_bit_cast(unsigned, r); }

template <int N> __device__ __forceinline__ void wait_vm() { asm volatile("s_waitcnt vmcnt(%0)" :: "n"(N) : "memory"); }
typedef int v8i32 __attribute__((ext_vector_type(8)));
struct HScale { const float* ss; PG8_LAS float* tab; float eps; };
template <class Epi, class Sched, bool ALIGN_EPI = false, bool SP2 = false, bool GATHER = false, bool FP8 = false, bool NOEPI = false, bool HSCALE = false>
__device__ __forceinline__ void gemm_phase(PG8_LAS unsigned char* lds, const Gemm g, const Sched& S, const Epi& E, const HScale hs = HScale{nullptr, nullptr, 0.f}) {
    int tid_ = threadIdx.x; asm volatile("" : "+v"(tid_));
    const int tid = tid_, wid = __builtin_amdgcn_readfirstlane(tid >> 6), lane = tid & 63, wr = wid >> 2, wc = wid & 3, fr = lane & 15, fq = lane >> 4;
    const int K = g.K, nt = K / BK;
    unsigned voffA[2], voffB[2];
#pragma unroll
    for (int i = 0; i < 2; ++i) { int R, C; stage_rc(tid * 16 + i * 8192, R, C); const int Rb = Epi::PERM ? ((R & ~31) + perm32(R & 31)) : R;
        voffA[i] = (unsigned)(R * K + C) * 2u; voffB[i] = (unsigned)(Rb * K + C) * 2u; }
    int gR[2]; unsigned gC[2];
#pragma unroll
    for (int i = 0; i < 2; ++i) { int R, C; stage_rc(tid * 16 + i * 8192, R, C); gR[i] = R; gC[i] = (unsigned)C * 2u; }
#define PG8_GVOFF(v, ui_, h_) do { _Pragma("unroll") for (int _i = 0; _i < 2; ++_i) v[_i] = (S.tok((ui_), gR[_i] + HALF * (h_)) * (unsigned)(K * 2)) + gC[_i]; } while (0)
    const size_t kstep = (size_t)(BK * 2);
    const size_t hstep = (size_t)HALF * K * 2;
    const size_t tstep = 2 * hstep;
    const unsigned ldsw = (unsigned)wid * 1024u;
    const int aoff = FP8 ? lds_byte(wr * 64 + fr, fq * 16) : lds_byte(wr * 64 + fr, fq * 8), boff = FP8 ? lds_byte(wc * 32 + fr, fq * 16) : lds_byte(wc * 32 + fr, fq * 8);

#define PG8_SA(b, h) (((b) * 2 + (h)) * HTB)
#define PG8_SB(b, h) ((4 + (b) * 2 + (h)) * HTB)
#define PG8_STAGE(bufoff, gbase, voff) do { _Pragma("unroll") for (int _i = 0; _i < 2; ++_i) \
        __builtin_amdgcn_global_load_lds((const unsigned*)((const char*)(gbase) + (voff)[_i]), (PG8_LAS unsigned*)(lds + (bufoff) + ldsw + _i * 8192), 16, 0, 0); } while (0)
#define PG8_LDA(dst, b, h) do { if constexpr (FP8) { _Pragma("unroll") for (int m = 0; m < 4; ++m) { const u32x4 p0_ = *(const PG8_LAS u32x4*)(lds + PG8_SA(b, h) + aoff + m * 2048), p1_ = *(const PG8_LAS u32x4*)(lds + PG8_SA(b, h) + aoff + m * 2048 + 16); dst##8[m] = __builtin_bit_cast(v8i32, __builtin_shufflevector(p0_, p1_, 0, 1, 2, 3, 4, 5, 6, 7)); } } \
    else { _Pragma("unroll") for (int m = 0; m < 4; ++m) _Pragma("unroll") for (int k = 0; k < 2; ++k) dst[m][k] = *(const PG8_LAS bf16x8*)(lds + PG8_SA(b, h) + aoff + m * 2048 + k * 1024); } } while (0)
#define PG8_LDB(dst, b, h) do { if constexpr (FP8) { _Pragma("unroll") for (int n = 0; n < 2; ++n) { const u32x4 p0_ = *(const PG8_LAS u32x4*)(lds + PG8_SB(b, h) + boff + n * 2048), p1_ = *(const PG8_LAS u32x4*)(lds + PG8_SB(b, h) + boff + n * 2048 + 16); dst##8[n] = __builtin_bit_cast(v8i32, __builtin_shufflevector(p0_, p1_, 0, 1, 2, 3, 4, 5, 6, 7)); } } \
    else { _Pragma("unroll") for (int n = 0; n < 2; ++n) _Pragma("unroll") for (int k = 0; k < 2; ++k) dst[n][k] = *(const PG8_LAS bf16x8*)(lds + PG8_SB(b, h) + boff + n * 2048 + k * 1024); } } while (0)
#define PG8_CAT(x) __builtin_shufflevector(__builtin_bit_cast(u32x4, (x)[0]), __builtin_bit_cast(u32x4, (x)[1]), 0, 1, 2, 3, 4, 5, 6, 7)
#define PG8_MMA(ai, bj, At, Bt) do { __builtin_amdgcn_s_setprio(1); if constexpr (FP8) { _Pragma("unroll") for (int m = 0; m < 4; ++m) _Pragma("unroll") for (int n = 0; n < 2; ++n) \
        asm volatile("v_mfma_scale_f32_16x16x128_f8f6f4 %0, %1, %2, %0, %3, %3 op_sel_hi:[0,0,0]" : "+v"(acc[ai][bj][m][n]) : "v"(Bt##8[n]), "v"(At##8[m]), "v"(scl1)); } \
    else { _Pragma("unroll") for (int m = 0; m < 4; ++m) _Pragma("unroll") for (int n = 0; n < 2; ++n) _Pragma("unroll") for (int k = 0; k < 2; ++k) \
        acc[ai][bj][m][n] = __builtin_amdgcn_mfma_f32_16x16x32_bf16(Bt[n][k], At[m][k], acc[ai][bj][m][n], 0, 0, 0); } __builtin_amdgcn_s_setprio(0); } while (0)
#define PG8_WAIT_V(n) asm volatile("s_waitcnt vmcnt(" #n ")" ::: "memory")
#define PG8_WAIT_L(n) asm volatile("s_waitcnt lgkmcnt(" #n ")" ::: "memory")
#define PG8_BAR __builtin_amdgcn_s_barrier()
#define PG8_SCHED __builtin_amdgcn_sched_barrier(0)
    Unit cur, nxt; int ui = 0;
    if (!S.next(0, cur)) return;
    f32x4 acc[2][2][4][2];
#pragma unroll
    for (int a = 0; a < 2; ++a)
#pragma unroll
        for (int b = 0; b < 2; ++b)
#pragma unroll
            for (int m = 0; m < 4; ++m)
#pragma unroll
                for (int n = 0; n < 2; ++n) acc[a][b][m][n] = (f32x4){0.f, 0.f, 0.f, 0.f};
    const unsigned scl1 = 0x7f7f7f7fu;
    bf16x8 At[4][2], B0[2][2], B1[2][2]; v8i32 At8[4], B08[2], B18[2];
    const char* cA = GATHER ? (const char*)g.A : (const char*)g.A + (size_t)cur.pm * tstep; const char* cB = (const char*)g.Bt + (size_t)cur.pn * tstep;
    S.a_ready(cur);
    static_assert(!GATHER || SP2, "GATHER is written for the SP2 loop");
#define PG8_HSTAB(slot, pm_) do { if (tid < 256) { const float* sp_ = hs.ss + ((size_t)(pm_) * BM + tid) * 16; float rr_[4]; \
        _Pragma("unroll") for (int h_ = 0; h_ < 4; ++h_) { const f32x4 p_ = *(const f32x4*)(sp_ + 4 * h_); rr_[h_] = 1.0f / sqrtf(((p_[0] + p_[1]) + (p_[2] + p_[3])) * (1.0f / 512.f) + hs.eps); } \
        *(PG8_LAS f32x4*)(hs.tab + (slot) * 1024 + tid * 4) = (f32x4){rr_[0] / rr_[1], rr_[1] / rr_[2], rr_[2] / rr_[3], rr_[3]}; } } while (0)
#define PG8_HSMUL(slot, h_) do { _Pragma("unroll") for (int ai_ = 0; ai_ < 2; ++ai_) _Pragma("unroll") for (int m_ = 0; m_ < 4; ++m_) { const float f_ = hs.tab[(slot) * 1024 + (ai_ * HALF + wr * 64 + m_ * 16 + fr) * 4 + (h_)]; \
        _Pragma("unroll") for (int bj_ = 0; bj_ < 2; ++bj_) _Pragma("unroll") for (int n_ = 0; n_ < 2; ++n_) acc[ai_][bj_][m_][n_] = acc[ai_][bj_][m_][n_] * f_; } } while (0)
    if constexpr (HSCALE) { PG8_HSTAB(0, cur.pm); PG8_WAIT_L(0); PG8_BAR; }
    if constexpr (SP2) {
        if constexpr (GATHER) { unsigned v0[2], v1[2]; PG8_GVOFF(v0, 0, 0); PG8_GVOFF(v1, 0, 1); PG8_STAGE(PG8_SB(0, 0), cB, voffB); PG8_STAGE(PG8_SB(0, 1), cB + hstep, voffB); PG8_STAGE(PG8_SA(0, 0), cA, v0); PG8_STAGE(PG8_SA(0, 1), cA, v1); }
        else { PG8_STAGE(PG8_SB(0, 0), cB, voffB); PG8_STAGE(PG8_SB(0, 1), cB + hstep, voffB); PG8_STAGE(PG8_SA(0, 0), cA, voffA); PG8_STAGE(PG8_SA(0, 1), cA + hstep, voffA); }
        if (wr == 1) PG8_BAR;
        PG8_WAIT_V(2); PG8_BAR;
        if constexpr (GATHER) { unsigned v0[2]; PG8_GVOFF(v0, 0, 0); PG8_STAGE(PG8_SB(1, 0), cB + kstep, voffB); PG8_STAGE(PG8_SA(1, 0), cA + kstep, v0); PG8_STAGE(PG8_SB(1, 1), cB + hstep + kstep, voffB); }
        else { PG8_STAGE(PG8_SB(1, 0), cB + kstep, voffB); PG8_STAGE(PG8_SA(1, 0), cA + kstep, voffA); PG8_STAGE(PG8_SB(1, 1), cB + hstep + kstep, voffB); }
        PG8_WAIT_V(6); PG8_BAR;
    } else {
        PG8_STAGE(PG8_SB(0, 0), cB, voffB); PG8_STAGE(PG8_SA(0, 0), cA, voffA); PG8_STAGE(PG8_SB(0, 1), cB + hstep, voffB); PG8_STAGE(PG8_SA(0, 1), cA + hstep, voffA);
        if (wr == 1) PG8_BAR;
        PG8_WAIT_V(4); PG8_BAR;
        PG8_STAGE(PG8_SB(1, 0), cB + kstep, voffB); PG8_STAGE(PG8_SA(1, 0), cA + kstep, voffA); PG8_STAGE(PG8_SB(1, 1), cB + hstep + kstep, voffB);
        PG8_WAIT_V(6); PG8_BAR;
    }
    for (;;) {
        const bool has_next = S.next(ui + 1, nxt);
        const char* nA = GATHER ? cA : (has_next ? (const char*)g.A + (size_t)nxt.pm * tstep : cA); const char* nB = has_next ? (const char*)g.Bt + (size_t)nxt.pn * tstep : cB;
#pragma unroll 1
        for (int t = 0; t < nt; t += 2) {
            asm volatile("" : "+v"(voffA[0]), "+v"(voffA[1]), "+v"(voffB[0]), "+v"(voffB[1]));
            const bool last = (t == nt - 2);
            const char* a1 = cA + (size_t)(t + 1) * kstep;
            const char* a2 = last ? nA : cA + (size_t)(t + 2) * kstep; const char* b2 = last ? nB : cB + (size_t)(t + 2) * kstep;
            const char* a3 = a2 + kstep; const char* b3 = b2 + kstep;
            if (last && has_next) S.a_ready(nxt);
            if constexpr (HSCALE) { if (last && has_next) PG8_HSTAB((ui + 1) & 1, nxt.pm);
                                    if (t == 8 || t == 16 || t == 24) PG8_HSMUL(ui & 1, (t >> 3) - 1); }
            const bool rlx = (t == 0) && (ui > 0);
#define PG8_WAIT_V8R do { if (rlx) wait_vm<8 + Epi::NST>(); else wait_vm<8>(); } while (0)
            if constexpr (SP2 && GATHER) {
            const int uix = (last && has_next) ? ui + 1 : ui;
            unsigned vc1[2], vx0[2], vx1[2]; PG8_GVOFF(vc1, ui, 1); PG8_GVOFF(vx0, uix, 0); PG8_GVOFF(vx1, uix, 1);
            PG8_LDB(B0, 0, 0); PG8_LDB(B1, 0, 1); PG8_SCHED; PG8_LDA(At, 0, 0); PG8_STAGE(PG8_SA(1, 1), a1, vc1);
            PG8_WAIT_V8R; PG8_WAIT_L(0); PG8_BAR; PG8_MMA(0, 0, At, B0); PG8_MMA(0, 1, At, B1); PG8_BAR; PG8_SCHED;
            PG8_LDA(At, 0, 1); PG8_STAGE(PG8_SB(0, 0), b2, voffB); PG8_STAGE(PG8_SB(0, 1), b2 + hstep, voffB); PG8_STAGE(PG8_SA(0, 0), a2, vx0);
            PG8_WAIT_V8R; PG8_WAIT_L(0); PG8_BAR; PG8_MMA(1, 0, At, B0); PG8_MMA(1, 1, At, B1); PG8_BAR; PG8_SCHED;
            PG8_LDB(B0, 1, 0); PG8_LDB(B1, 1, 1); PG8_SCHED; PG8_LDA(At, 1, 0); PG8_STAGE(PG8_SA(0, 1), a2, vx1);
            PG8_WAIT_V(8); PG8_WAIT_L(0); PG8_BAR; PG8_MMA(0, 0, At, B0); PG8_MMA(0, 1, At, B1); PG8_BAR; PG8_SCHED;
            PG8_LDA(At, 1, 1); PG8_STAGE(PG8_SB(1, 0), b3, voffB); PG8_STAGE(PG8_SB(1, 1), b3 + hstep, voffB); PG8_STAGE(PG8_SA(1, 0), a3, vx0);
            PG8_WAIT_V(8); PG8_WAIT_L(0); PG8_BAR; PG8_MMA(1, 0, At, B0); PG8_MMA(1, 1, At, B1); PG8_BAR; PG8_SCHED;
            } else if constexpr (SP2) {
            PG8_LDB(B0, 0, 0); PG8_LDB(B1, 0, 1); PG8_SCHED; PG8_LDA(At, 0, 0); PG8_STAGE(PG8_SA(1, 1), a1 + hstep, voffA);
            PG8_WAIT_V8R; PG8_WAIT_L(0); PG8_BAR; PG8_MMA(0, 0, At, B0); PG8_MMA(0, 1, At, B1); PG8_BAR; PG8_SCHED;
            PG8_LDA(At, 0, 1); PG8_STAGE(PG8_SB(0, 0), b2, voffB); PG8_STAGE(PG8_SB(0, 1), b2 + hstep, voffB); PG8_STAGE(PG8_SA(0, 0), a2, voffA);
            PG8_WAIT_V8R; PG8_WAIT_L(0); PG8_BAR; PG8_MMA(1, 0, At, B0); PG8_MMA(1, 1, At, B1); PG8_BAR; PG8_SCHED;
            PG8_LDB(B0, 1, 0); PG8_LDB(B1, 1, 1); PG8_SCHED; PG8_LDA(At, 1, 0); PG8_STAGE(PG8_SA(0, 1), a2 + hstep, voffA);
            PG8_WAIT_V(8); PG8_WAIT_L(0); PG8_BAR; PG8_MMA(0, 0, At, B0); PG8_MMA(0, 1, At, B1); PG8_BAR; PG8_SCHED;
            PG8_LDA(At, 1, 1); PG8_STAGE(PG8_SB(1, 0), b3, voffB); PG8_STAGE(PG8_SB(1, 1), b3 + hstep, voffB); PG8_STAGE(PG8_SA(1, 0), a3, voffA);
            PG8_WAIT_V(8); PG8_WAIT_L(0); PG8_BAR; PG8_MMA(1, 0, At, B0); PG8_MMA(1, 1, At, B1); PG8_BAR; PG8_SCHED;
            } else {
            PG8_LDB(B0, 0, 0); PG8_SCHED; PG8_LDA(At, 0, 0); PG8_STAGE(PG8_SA(1, 1), a1 + hstep, voffA);
            PG8_WAIT_L(8); PG8_BAR; PG8_WAIT_L(0); PG8_MMA(0, 0, At, B0); PG8_BAR; PG8_SCHED;
            PG8_LDB(B1, 0, 1); PG8_STAGE(PG8_SB(0, 0), b2, voffB);
            PG8_BAR; PG8_WAIT_L(0); PG8_MMA(0, 1, At, B1); PG8_BAR;
            PG8_LDA(At, 0, 1); PG8_STAGE(PG8_SA(0, 0), a2, voffA);
            PG8_BAR; PG8_WAIT_L(0); PG8_MMA(1, 0, At, B0); PG8_BAR; PG8_SCHED;
            PG8_STAGE(PG8_SB(0, 1), b2 + hstep, voffB);
            PG8_WAIT_V(6); PG8_BAR; PG8_MMA(1, 1, At, B1); PG8_BAR;
            PG8_LDB(B0, 1, 0); PG8_SCHED; PG8_LDA(At, 1, 0); PG8_STAGE(PG8_SA(0, 1), a2 + hstep, voffA);
            PG8_WAIT_L(8); PG8_BAR; PG8_WAIT_L(0); PG8_MMA(0, 0, At, B0); PG8_BAR; PG8_SCHED;
            PG8_LDB(B1, 1, 1); PG8_STAGE(PG8_SB(1, 0), b3, voffB);
            PG8_BAR; PG8_WAIT_L(0); PG8_MMA(0, 1, At, B1); PG8_BAR;
            PG8_LDA(At, 1, 1); PG8_STAGE(PG8_SA(1, 0), a3, voffA);
            PG8_BAR; PG8_WAIT_L(0); PG8_MMA(1, 0, At, B0); PG8_BAR; PG8_SCHED;
            PG8_STAGE(PG8_SB(1, 1), b3 + hstep, voffB);
            PG8_WAIT_V(6); PG8_BAR; PG8_MMA(1, 1, At, B1); PG8_BAR;
            }
        }
        if constexpr (ALIGN_EPI) { if (wr == 0) PG8_BAR; }
        if constexpr (HSCALE) PG8_HSMUL(ui & 1, 3);
        if constexpr (FP8) asm volatile("s_nop 15\n\ts_nop 7" ::: "memory");
        { int te = threadIdx.x; asm volatile("" : "+v"(te));
          if constexpr (!NOEPI) E(acc, cur, wr, wc, te & 15, (te & 63) >> 4); else { float sink_ = 0.f; _Pragma("unroll") for (int a_ = 0; a_ < 2; ++a_) _Pragma("unroll") for (int b_ = 0; b_ < 2; ++b_) _Pragma("unroll") for (int m_ = 0; m_ < 4; ++m_) _Pragma("unroll") for (int n_ = 0; n_ < 2; ++n_) sink_ += acc[a_][b_][m_][n_][0]; asm volatile("" :: "v"(sink_)); } }
        if (!has_next) break;
#pragma unroll
        for (int a = 0; a < 2; ++a)
#pragma unroll
            for (int b = 0; b < 2; ++b)
#pragma unroll
                for (int m = 0; m < 4; ++m)
#pragma unroll
                    for (int n = 0; n < 2; ++n) acc[a][b][m][n] = (f32x4){0.f, 0.f, 0.f, 0.f};
        cur = nxt; cA = nA; cB = nB; ++ui;
        if constexpr (ALIGN_EPI) { if (wr == 1) PG8_BAR; }
    }
    PG8_WAIT_V(0);
    if constexpr (!ALIGN_EPI) { if (wr == 0) PG8_BAR; }
    PG8_BAR;
#undef PG8_GVOFF
#undef PG8_HSTAB
#undef PG8_HSMUL
#undef PG8_WAIT_V8R
#undef PG8_CAT
#undef PG8_SA
#undef PG8_SB
#undef PG8_STAGE
#undef PG8_LDA
#undef PG8_LDB
#undef PG8_MMA
#undef PG8_WAIT_V
#undef PG8_WAIT_L
#undef PG8_BAR
#undef PG8_SCHED
}
}

constexpr int NWAVES = 8;
constexpr int DM = 1024, NBATCH = 32, SEQ = 2048, MTOK = NBATCH * SEQ, DEPTH = 4, NEXP = 32, TOPK = 4;
constexpr int HG_N = 4096, RT_N = 6144, HG_H = 8, RT_H = 4;
constexpr float EPS = 1e-6f;
constexpr int LCAP = 65536;
constexpr int MAXTILES = 1056;
constexpr float YSC = 32.0f;
constexpr int YLD = DM;

constexpr size_t MiB = 1u << 20;
constexpr size_t WS_CTL = 0, CTL_ZERO_BYTES = 1 * MiB;
constexpr size_t WS_MOD = 1 * MiB;
constexpr size_t WS_FMOD = 4 * MiB;
constexpr size_t WS_LBV = 4 * MiB + 512 * 1024;
constexpr size_t WS_HWIN = 8 * MiB, WS_HWOUT = 24 * MiB, WS_RWIN = 28 * MiB, WS_RWOUT = 52 * MiB, WS_W1T = 64 * MiB, WS_W2T = 576 * MiB;
constexpr size_t WS_H = 832 * MiB;
constexpr size_t WS_LIST = 960 * MiB;
constexpr size_t WS_TSLOT = 968 * MiB, WS_TGATE = 969 * MiB;
constexpr size_t WS_R1 = 976 * MiB;
constexpr size_t WS_R2 = 1744 * MiB;
constexpr size_t WS_H8 = 2272 * MiB;
constexpr size_t WS_XB = 320 * MiB;
static_assert(MOE_FP8 == 1, "WS_XB lies in the half of the W1T region that bf16 expert weights would need");
constexpr size_t WS_END = 2336 * MiB;
constexpr int hg_rank(int s, int mask) { int r = 0; for (int i = 0; i < s; ++i) r += (mask >> i) & 1; return r; }
constexpr unsigned hg_smap(int mask) { unsigned m = 0; int r = 0; for (int i = 0; i < 4; ++i) if ((mask >> i) & 1) { m |= (unsigned)i << (4 * r); ++r; } return m; }
constexpr int HG_N8 = 1024 * hg_rank(4, HGRN_FP8_MASK), HG_N16 = 4096 - HG_N8;
constexpr int CW_BAR = 4096;
constexpr int CW_CNT = 8192;

constexpr int RING_OFF = 0, RING_BYTES = 131072;
constexpr int MISC_OFF = 155648;
constexpr int TAB_OFF = MISC_OFF + 128;
constexpr int LDS_BYTES = 160 * 1024;

#define GAS __attribute__((address_space(1)))
#define LAS __attribute__((address_space(3)))
typedef unsigned short bf16;
typedef unsigned v4u __attribute__((ext_vector_type(4)));
typedef unsigned v2u __attribute__((ext_vector_type(2)));
typedef float f32x4 __attribute__((ext_vector_type(4)));
typedef short bf16x8 __attribute__((ext_vector_type(8)));
#define RLX_AGENT __ATOMIC_RELAXED, __HIP_MEMORY_SCOPE_AGENT
#define LDS_WAIT() asm volatile("s_waitcnt lgkmcnt(0)" ::: "memory")
#define VM_WAIT() asm volatile("s_waitcnt vmcnt(0)" ::: "memory")
__device__ __forceinline__ unsigned pk2(float lo, float hi) { return pg8::cvt_pk_bf16(lo, hi); }
__device__ __forceinline__ unsigned pk4_fp8(float a, float b, float c, float d) { int p = 0; p = __builtin_amdgcn_cvt_pk_fp8_f32(a, b, p, false); p = __builtin_amdgcn_cvt_pk_fp8_f32(c, d, p, true); return (unsigned)p; }
__device__ __forceinline__ v4u pack8(const f32x4 a, const f32x4 b) { v4u w; w.x = pk2(a.x, a.y); w.y = pk2(a.z, a.w); w.z = pk2(b.x, b.y); w.w = pk2(b.z, b.w); return w; }
__device__ __forceinline__ float bflo(unsigned w) { return __uint_as_float(w << 16); }
__device__ __forceinline__ float bfhi(unsigned w) { return __uint_as_float(w & 0xffff0000u); }
__device__ __forceinline__ float bf2f(unsigned short h) { return __uint_as_float(((unsigned)h) << 16); }
__device__ __forceinline__ float sigmoidf_(float x) { return __builtin_amdgcn_rcpf(1.f + __expf(-x)); }
__device__ __forceinline__ float siluf_(float x) { return x * sigmoidf_(x); }
__device__ __forceinline__ f32x4 silu4_(const f32x4 x) {
    const f32x4 t = x * -1.4426950408889634f; f32x4 e, r;
#pragma unroll
    for (int j = 0; j < 4; ++j) e[j] = __builtin_amdgcn_exp2f(t[j]);
    const f32x4 d = e + 1.0f;
#pragma unroll
    for (int j = 0; j < 4; ++j) r[j] = __builtin_amdgcn_rcpf(d[j]);
    return x * r;
}
__device__ __forceinline__ unsigned ldu_vec(const unsigned* p) { return __hip_atomic_load(p, RLX_AGENT); }

#define XB_TMO      128
#define XB_XCNT(j)  (256  + 64 * (j))
#define XB_XSUB(j)  (1280 + 64 * (j))
#define XB_XGEN(j)  (2304 + 64 * (j))
#define XB_TOP      3328
#define XB_TOPGEN   3392
#define XCD_BAR_WORDS 3456
#define XB_SPIN_CAP (1u << 18)

__device__ __forceinline__ unsigned xb_ld(unsigned* p)              { return __hip_atomic_load(p, __ATOMIC_RELAXED, __HIP_MEMORY_SCOPE_AGENT); }
__device__ __forceinline__ unsigned xb_add(unsigned* p, unsigned v) { return __hip_atomic_fetch_add(p, v, __ATOMIC_RELAXED, __HIP_MEMORY_SCOPE_AGENT); }
__device__ __forceinline__ unsigned xb_xcc_id() { return (unsigned)__builtin_amdgcn_s_getreg((3 << 11) | 20) & 0xFu; }
#define XB_SPIN(cond, bar) do { unsigned _sp = 0; while (cond) { __builtin_amdgcn_s_sleep(1); \
    if ((++_sp & 255u) == 0u) { if (xb_ld(&(bar)[XB_TMO])) break; if (_sp > XB_SPIN_CAP) { atomicAdd(&(bar)[XB_TMO], 1u); break; } } } } while (0)

struct XcdBarrier {
    unsigned* bar; unsigned x;
    volatile LAS unsigned* st;
};
__device__ __forceinline__ XcdBarrier xcd_barrier_post(unsigned* bar, volatile LAS unsigned* st) {
    XcdBarrier b; b.bar = bar; b.x = xb_xcc_id(); b.st = st;
    if (threadIdx.x == 0) (void)xb_add(&bar[XB_XCNT(b.x)], 1u);
    return b;
}
__device__ __forceinline__ void xcd_barrier_complete(unsigned* bar, unsigned x, unsigned& nloc, unsigned& nx) {
    const unsigned G = gridDim.x * gridDim.y * gridDim.z;
    unsigned sum, cnt, mine, sp = 0u;
    for (;;) {
        sum = 0u; cnt = 0u; mine = 0u;
#pragma unroll
        for (unsigned j = 0; j < 16; ++j) { const unsigned c = xb_ld(&bar[XB_XCNT(j)]); sum += c; cnt += (c > 0u) ? 1u : 0u; mine = (j == x) ? c : mine; }
        if (sum == G) break;
        __builtin_amdgcn_s_sleep(1);
        if ((++sp & 255u) == 0u) { if (xb_ld(&bar[XB_TMO])) break; if (sp > XB_SPIN_CAP) { atomicAdd(&bar[XB_TMO], 1u); break; } }
    }
    nloc = mine > 0u ? mine : 1u; nx = cnt > 0u ? cnt : 1u;
}
__device__ __forceinline__ void xcd_barrier(const XcdBarrier& b) {
    asm volatile("s_waitcnt vmcnt(0)" ::: "memory");
    __syncthreads();
    if (threadIdx.x == 0) {
        unsigned* bar = b.bar;
        __builtin_amdgcn_s_waitcnt(0);
        unsigned nloc = b.st[0], nx = b.st[1];
        if (nloc == 0u) { xcd_barrier_complete(bar, b.x, nloc, nx); b.st[0] = nloc; b.st[1] = nx; }
        const unsigned old = xb_add(&bar[XB_XSUB(b.x)], 1u);
        const unsigned gen = old / nloc;
        if (old + 1u == (gen + 1u) * nloc) {
            __builtin_amdgcn_fence(__ATOMIC_RELEASE, "agent");
            asm volatile("s_waitcnt vmcnt(0)" ::: "memory");
            const unsigned og = xb_add(&bar[XB_TOP], 1u);
            const unsigned tg = og / nx;
            if (og + 1u == (tg + 1u) * nx) xb_add(&bar[XB_TOPGEN], 1u);
            else XB_SPIN(xb_ld(&bar[XB_TOPGEN]) == tg, bar);
            __builtin_amdgcn_fence(__ATOMIC_ACQUIRE, "agent");
            xb_add(&bar[XB_XGEN(b.x)], 1u);
            asm volatile("s_waitcnt vmcnt(0)" ::: "memory");
        } else {
            XB_SPIN(xb_ld(&bar[XB_XGEN(b.x)]) == gen, bar);
            __builtin_amdgcn_fence(__ATOMIC_ACQUIRE, "agent");
            asm volatile("s_waitcnt vmcnt(0)" ::: "memory");
        }
    }
    __syncthreads();
}

struct Frame {
    LAS unsigned char* lds;
    unsigned* ctl;
    int tid, lane, wave, vcu, G;
    float* out; unsigned char* ws;
};
__device__ __forceinline__ void relaunder(Frame& F) { int t = threadIdx.x; asm volatile("" : "+v"(t)); F.tid = t; F.lane = t & 63; F.wave = __builtin_amdgcn_readfirstlane(t >> 6); }
#define KAS __attribute__((address_space(4)))
__device__ __forceinline__ const void* kin_(int i) { const KAS char* kp = (const KAS char*)__builtin_amdgcn_kernarg_segment_ptr(); asm volatile("" : "+s"(kp)); return *(const void* const KAS*)(kp + 8 * i); }
enum { I_X = 0, I_C, I_POS, I_ADAW, I_ADAB, I_N1G, I_N2G, I_HWIN, I_HWOUT, I_HGAIN, I_HLB, I_RWIN, I_RWOUT, I_RTW, I_RTB, I_W1, I_B1, I_W2, I_B2, I_FG, I_FADAW, I_FADAB };
#define KIN(i) ((const float*)kin_(i))
__device__ __forceinline__ float wave_sum(float v) {
#pragma unroll
    for (int o = 1; o < 64; o <<= 1) v += __shfl_xor(v, o);
    return v;
}

__device__ __forceinline__ void p0_transpose_item(const float* W, int N, bf16* WT, int K, int k0, int n0, int drow0, LAS float* scr, int lane) {
    float wv[32];
#pragma unroll
    for (int i = 0; i < 32; ++i) wv[i] = W[(size_t)(k0 + 2 * i + (lane >> 5)) * N + n0 + (lane & 31)];
#pragma unroll
    for (int i = 0; i < 32; ++i) scr[(2 * i + (lane >> 5)) * 33 + (lane & 31)] = wv[i];
    LDS_WAIT(); asm volatile("" ::: "memory");
    const int c = lane & 7;
#pragma unroll
    for (int j = 0; j < 4; ++j) { const int n = (lane >> 3) + 8 * j; const LAS float* s = scr + (8 * c) * 33 + n;
        v4u o; o.x = pk2(s[0 * 33], s[1 * 33]); o.y = pk2(s[2 * 33], s[3 * 33]); o.z = pk2(s[4 * 33], s[5 * 33]); o.w = pk2(s[6 * 33], s[7 * 33]);
        *(GAS v4u*)(WT + (size_t)(drow0 + n) * K + k0 + 8 * c) = o; }
    LDS_WAIT(); asm volatile("" ::: "memory");
}
__device__ __forceinline__ void p0_transpose_item_f8(const float* W, int N, unsigned char* WT, int K, int k0, int n0, int drow0, LAS float* scr, int lane, float scale) {
    float wv[32];
#pragma unroll
    for (int i = 0; i < 32; ++i) wv[i] = W[(size_t)(k0 + 2 * i + (lane >> 5)) * N + n0 + (lane & 31)];
#pragma unroll
    for (int i = 0; i < 32; ++i) scr[(2 * i + (lane >> 5)) * 33 + (lane & 31)] = wv[i];
    LDS_WAIT(); asm volatile("" ::: "memory");
    const int n = lane >> 1, hf = lane & 1; const LAS float* sp = scr + (32 * hf) * 33 + n;
    v4u o0, o1;
    o0.x = pk4_fp8(sp[0 * 33] * scale, sp[1 * 33] * scale, sp[2 * 33] * scale, sp[3 * 33] * scale); o0.y = pk4_fp8(sp[4 * 33] * scale, sp[5 * 33] * scale, sp[6 * 33] * scale, sp[7 * 33] * scale);
    o0.z = pk4_fp8(sp[8 * 33] * scale, sp[9 * 33] * scale, sp[10 * 33] * scale, sp[11 * 33] * scale); o0.w = pk4_fp8(sp[12 * 33] * scale, sp[13 * 33] * scale, sp[14 * 33] * scale, sp[15 * 33] * scale);
    o1.x = pk4_fp8(sp[16 * 33] * scale, sp[17 * 33] * scale, sp[18 * 33] * scale, sp[19 * 33] * scale); o1.y = pk4_fp8(sp[20 * 33] * scale, sp[21 * 33] * scale, sp[22 * 33] * scale, sp[23 * 33] * scale);
    o1.z = pk4_fp8(sp[24 * 33] * scale, sp[25 * 33] * scale, sp[26 * 33] * scale, sp[27 * 33] * scale); o1.w = pk4_fp8(sp[28 * 33] * scale, sp[29 * 33] * scale, sp[30 * 33] * scale, sp[31 * 33] * scale);
    unsigned char* d = WT + (size_t)(drow0 + n) * K + k0 + 32 * hf; *(GAS v4u*)d = o0; *(GAS v4u*)(d + 16) = o1;
    LDS_WAIT(); asm volatile("" ::: "memory");
}
__device__ __forceinline__ void p0_prologue(Frame& F) {
    relaunder(F);
    __syncthreads();
    const int gw = F.vcu * NWAVES + F.wave, NGW = F.G * NWAVES;
    {
        LAS float* condT = (LAS float*)(F.lds + RING_OFF);
        const float* cin = KIN(I_C);
        for (int idx = F.tid; idx < NBATCH * DM; idx += NWAVES * 64) { const int b = idx >> 10, k = idx & 1023; condT[k * 32 + b] = siluf_(cin[idx]); }
        __syncthreads();
        { const int gsel = F.wave >> 2, kq = F.wave & 3, u = 2 * F.vcu + gsel; const bool act = (u < 416);
          const float* W = nullptr; const float* bias = nullptr; float* outp = nullptr; int N = 0, n0 = 0;
          if (act) { if (u < 384) { const int l = u / 96; n0 = (u % 96) * 64; N = 6 * DM; W = KIN(I_ADAW) + (size_t)l * DM * N; bias = KIN(I_ADAB) + l * N; outp = (float*)(F.ws + WS_MOD) + (size_t)l * NBATCH * N; }
                     else { n0 = (u - 384) * 64; N = 2 * DM; W = KIN(I_FADAW); bias = KIN(I_FADAB); outp = (float*)(F.ws + WS_FMOD); } }
          float acc[32];
#pragma unroll
          for (int b = 0; b < 32; ++b) acc[b] = 0.f;
          if (act) {
#pragma unroll 4
              for (int k = 256 * kq; k < 256 * kq + 256; ++k) {
                  const float w = W[(size_t)k * N + n0 + F.lane];
                  const LAS f32x4* cb = (const LAS f32x4*)(condT + k * 32);
#pragma unroll
                  for (int q = 0; q < 8; ++q) { const f32x4 cv = cb[q]; acc[4 * q + 0] += cv.x * w; acc[4 * q + 1] += cv.y * w; acc[4 * q + 2] += cv.z * w; acc[4 * q + 3] += cv.w * w; }
              } }
          __syncthreads();
          LAS float* red = (LAS float*)(F.lds + RING_OFF) + F.wave * 2048;
#pragma unroll
          for (int b = 0; b < 32; ++b) red[b * 64 + F.lane] = acc[b];
          __syncthreads();
          if (act && kq == 0) { const float bv = bias[n0 + F.lane];
#pragma unroll
              for (int b = 0; b < 32; ++b) { const LAS float* r0 = (const LAS float*)(F.lds + RING_OFF) + (4 * gsel) * 2048 + b * 64 + F.lane;
                  outp[(size_t)b * N + n0 + F.lane] = ((r0[0] + r0[2048]) + (r0[4096] + r0[6144])) + bv; } }
        }
        if (gw == NGW - 1) {
            float* lbv = (float*)(F.ws + WS_LBV); const float* hlb = KIN(I_HLB);
            for (int d = F.lane; d < DM; d += 64) { const float a = hlb[d], b = hlb[DM + d], m = fmaxf(a, b), ea = __expf(a - m), eb = __expf(b - m); lbv[d] = 0.f; lbv[DM + d] = eb / (ea + eb); }
        }
        __syncthreads();
    }
    {
        LAS float* scr = (LAS float*)(F.lds + RING_OFF + F.wave * 16384);
        constexpr int NI_HI = 2 * 16 * 128, NI_HO = 2 * 16 * 32, NI_RI = 2 * 16 * 192, NI_RO = 2 * 32 * 32, NI_W1 = 128 * 16 * 64, NI_W2 = 128 * 16 * 32;
        constexpr int NITEMS = NI_HI + NI_HO + NI_RI + NI_RO + NI_W1 + NI_W2;
        for (int it = gw; it < NITEMS; it += NGW) {
            int r = it;
            if (r < NI_HI) { const int j = r / 2048, q = r % 2048, kb = q / 128, nb = q % 128;
                const int sg = nb >> 5, nl = 32 * (nb & 31);
                if ((HGRN_FP8_MASK >> sg) & 1) p0_transpose_item_f8(KIN(I_HWIN) + (size_t)j * DM * HG_N, HG_N, F.ws + WS_HWIN + (size_t)j * HG_N8 * DM, DM, 64 * kb, 32 * nb, 1024 * hg_rank(sg, HGRN_FP8_MASK) + nl, scr, F.lane, 64.0f);
                else p0_transpose_item(KIN(I_HWIN) + (size_t)j * DM * HG_N, HG_N, (bf16*)(F.ws + WS_HWIN + 8 * MiB) + (size_t)j * HG_N16 * DM, DM, 64 * kb, 32 * nb, 1024 * hg_rank(sg, 0xF & ~HGRN_FP8_MASK) + nl, scr, F.lane);
                continue; } r -= NI_HI;
            if (r < NI_HO) { const int j = r / 512, q = r % 512, kb = q / 32, nb = q % 32;
                if (HGRN_OUT_FP8) p0_transpose_item_f8(KIN(I_HWOUT) + (size_t)j * DM * DM, DM, F.ws + WS_HWOUT + (size_t)j * DM * DM, DM, 64 * kb, 32 * nb, 32 * nb, scr, F.lane, 64.0f);
                else p0_transpose_item(KIN(I_HWOUT) + (size_t)j * DM * DM, DM, (bf16*)(F.ws + WS_HWOUT) + (size_t)j * DM * DM, DM, 64 * kb, 32 * nb, 32 * nb, scr, F.lane);
                continue; } r -= NI_HO;
            if (r < NI_RI) { const int j = r / 3072, q = r % 3072, kb = q / 192, nb = q % 192;
                if (RET_IN_FP8) p0_transpose_item_f8(KIN(I_RWIN) + (size_t)j * DM * RT_N, RT_N, F.ws + WS_RWIN + (size_t)j * RT_N * DM, DM, 64 * kb, 32 * nb, 32 * nb, scr, F.lane, 64.0f);
                else p0_transpose_item(KIN(I_RWIN) + (size_t)j * DM * RT_N, RT_N, (bf16*)(F.ws + WS_RWIN) + (size_t)j * RT_N * DM, DM, 64 * kb, 32 * nb, 32 * nb, scr, F.lane);
                continue; } r -= NI_RI;
            if (r < NI_RO) { const int j = r / 1024, q = r % 1024, kb = q / 32, nb = q % 32;
                p0_transpose_item(KIN(I_RWOUT) + (size_t)j * 2048 * DM, DM, (bf16*)(F.ws + WS_RWOUT) + (size_t)j * DM * 2048, 2048, 64 * kb, 32 * nb, 32 * nb, scr, F.lane); continue; } r -= NI_RO;
            if (r < NI_W1) { const int mi = r / 1024, q = r % 1024, kb = q / 64, nb = q % 64; const int n0 = 32 * nb;
                const int cc = n0 & 1023, drow0 = 256 * (cc >> 7) + (cc & 127) + ((n0 >= 1024) ? 128 : 0);
                if (MOE_FP8) p0_transpose_item_f8(KIN(I_W1) + (size_t)mi * DM * 2048, 2048, F.ws + WS_W1T + (size_t)mi * 2048 * DM, DM, 64 * kb, n0, drow0, scr, F.lane, 64.0f);
                else p0_transpose_item(KIN(I_W1) + (size_t)mi * DM * 2048, 2048, (bf16*)(F.ws + WS_W1T) + (size_t)mi * 2048 * DM, DM, 64 * kb, n0, drow0, scr, F.lane);
                continue; } r -= NI_W1;
            { const int mi = r / 512, q = r % 512, kb = q / 32, nb = q % 32;
                if (MOE_FP8) p0_transpose_item_f8(KIN(I_W2) + (size_t)mi * DM * DM, DM, F.ws + WS_W2T + (size_t)mi * DM * DM, DM, 64 * kb, 32 * nb, 32 * nb, scr, F.lane, 64.0f);
                else p0_transpose_item(KIN(I_W2) + (size_t)mi * DM * DM, DM, (bf16*)(F.ws + WS_W2T) + (size_t)mi * DM * DM, DM, 64 * kb, 32 * nb, 32 * nb, scr, F.lane); }
        }
    }
}

__device__ __forceinline__ void phase_skew(Frame& F, unsigned ticks) {
    const unsigned long long t0 = __builtin_amdgcn_s_memrealtime(), d = (unsigned long long)((unsigned)F.vcu & 7u) * ticks;
    while (__builtin_amdgcn_s_memrealtime() - t0 < d) __builtin_amdgcn_s_sleep(4);
}
__device__ __forceinline__ void build_tiles(Frame& F, int l) {
    LAS int* ts = (LAS int*)(F.lds + TAB_OFF); LAS int* cnt = ts + 40;
    __syncthreads();
    if (F.tid < NEXP) cnt[F.tid] = (int)ldu_vec(F.ctl + CW_CNT + l * 2048 + F.tid * 64);
    __syncthreads();
    if (F.tid == 0) { int a = 0; for (int e = 0; e < NEXP; ++e) { ts[e] = a; a += (cnt[e] + 255) >> 8; } ts[NEXP] = a; }
    __syncthreads();
}

__device__ __forceinline__ void row_phase1(Frame& F, int l, int mode, bool dry = false) {
    relaunder(F);
    float* xdst = dry ? (float*)(F.ws + WS_R2) : F.out;
    bf16* xbd = dry ? (bf16*)(F.ws + WS_R2) : (bf16*)(F.ws + WS_XB);
    const bf16* xb = (const bf16*)(F.ws + WS_XB);
    const LAS int* ts = (const LAS int*)(F.lds + TAB_OFF);
    const bool comb = (l > 0);
    if (comb) build_tiles(F, l - 1);
    const float* xsrc = KIN(I_X);
    const unsigned char* Y = F.ws + WS_R1;
    const unsigned* tslot = (const unsigned*)(F.ws + WS_TSLOT); const unsigned* tgate = (const unsigned*)(F.ws + WS_TGATE);
    bf16* H = dry ? (bf16*)(F.ws + WS_R2 + 256 * MiB) : (bf16*)(F.ws + WS_H);
    const int cl = 8 * F.lane;
#define RP_COL(j) (cl + 512 * ((j) >> 1) + 4 * ((j) & 1))
    for (int rb = F.vcu * 256; rb < MTOK; rb += F.G * 256) {
        const int b = rb / SEQ;
        f32x4 A[4], B[4], G2[4];
#pragma unroll
        for (int j = 0; j < 4; ++j) {
            const int c = RP_COL(j);
            if (mode == 0) { const float* mv = (const float*)(F.ws + WS_MOD) + (size_t)(l * NBATCH + b) * 6 * DM;
                const f32x4 g = *(const f32x4*)(KIN(I_N1G) + l * DM + c), sc = *(const f32x4*)(mv + 1 * DM + c); A[j] = g * (sc + 1.0f); B[j] = *(const f32x4*)(mv + c); }
            else { const float* fm = (const float*)(F.ws + WS_FMOD) + (size_t)b * 2 * DM;
                const f32x4 g = *(const f32x4*)(KIN(I_FG) + c), sc = *(const f32x4*)(fm + DM + c); A[j] = g * (sc + 1.0f); B[j] = *(const f32x4*)(fm + c); }
            if (comb) G2[j] = *(const f32x4*)((const float*)(F.ws + WS_MOD) + (size_t)((l - 1) * NBATCH + b) * 6 * DM + 5 * DM + c) * (1.0f / YSC); else G2[j] = (f32x4){0.f, 0.f, 0.f, 0.f};
        }
        f32x4 xn[4]; v4u xq[2]; unsigned sln = 0u, gtn = 0u;
        { const int row = rb + 32 * F.wave;
          if (comb) {
#pragma unroll
              for (int p = 0; p < 2; ++p) xq[p] = *(const v4u*)(xb + (size_t)row * DM + cl + 512 * p);
              sln = tslot[(size_t)row * 4 + (F.lane & 3)]; gtn = tgate[(size_t)row * 4 + (F.lane & 3)];
          } else {
#pragma unroll
              for (int j = 0; j < 4; ++j) xn[j] = *(const f32x4*)(xsrc + (size_t)row * DM + RP_COL(j));
          } }
        for (int r = 0; r < 32; ++r) {
            const int row = rb + 32 * F.wave + r;
            f32x4 v[4];
            if (comb) {
#pragma unroll
                for (int p = 0; p < 2; ++p) { const v4u q = xq[p]; v[2 * p] = (f32x4){bflo(q.x), bfhi(q.x), bflo(q.y), bfhi(q.y)}; v[2 * p + 1] = (f32x4){bflo(q.z), bfhi(q.z), bflo(q.w), bfhi(q.w)}; }
            } else {
#pragma unroll
                for (int j = 0; j < 4; ++j) v[j] = xn[j];
            }
            const unsigned sl = sln, gt = gtn;
            v2u yw[TOPK][2]; float gkk[TOPK];
            if (comb) {
#pragma unroll
                for (int k = 0; k < TOPK; ++k) {
                    const unsigned s_ = (unsigned)__shfl((int)sl, k); gkk[k] = __uint_as_float((unsigned)__shfl((int)gt, k));
                    const int e = (int)(s_ >> 20), pos = (int)(s_ & 0xFFFFFu); const size_t yrow = (size_t)ts[e] * 256 + pos;
#pragma unroll
                    for (int p = 0; p < 2; ++p) yw[k][p] = *(const v2u*)(Y + yrow * YLD + cl + 512 * p); }
            }
            if (r + 1 < 32) { const int rn = row + 1;
                if (comb) {
#pragma unroll
                    for (int p = 0; p < 2; ++p) xq[p] = *(const v4u*)(xb + (size_t)rn * DM + cl + 512 * p);
                    sln = tslot[(size_t)rn * 4 + (F.lane & 3)]; gtn = tgate[(size_t)rn * 4 + (F.lane & 3)];
                } else {
#pragma unroll
                    for (int j = 0; j < 4; ++j) xn[j] = *(const f32x4*)(xsrc + (size_t)rn * DM + RP_COL(j));
                } }
            if (comb) {
                f32x4 ys[4];
#pragma unroll
                for (int j = 0; j < 4; ++j) ys[j] = (f32x4){0.f, 0.f, 0.f, 0.f};
#pragma unroll
                for (int k = 0; k < TOPK; ++k) { const float gk = gkk[k];
#pragma unroll
                    for (int p = 0; p < 2; ++p) { const v2u w = yw[k][p];
                        const auto f0 = __builtin_amdgcn_cvt_pk_f32_fp8((int)w.x, false), f1 = __builtin_amdgcn_cvt_pk_f32_fp8((int)w.x, true), f2 = __builtin_amdgcn_cvt_pk_f32_fp8((int)w.y, false), f3 = __builtin_amdgcn_cvt_pk_f32_fp8((int)w.y, true);
                        ys[2 * p].x += gk * f0[0]; ys[2 * p].y += gk * f0[1]; ys[2 * p].z += gk * f1[0]; ys[2 * p].w += gk * f1[1];
                        ys[2 * p + 1].x += gk * f2[0]; ys[2 * p + 1].y += gk * f2[1]; ys[2 * p + 1].z += gk * f3[0]; ys[2 * p + 1].w += gk * f3[1]; } }
#pragma unroll
                for (int j = 0; j < 4; ++j) v[j] = v[j] + G2[j] * ys[j];
                if (mode == 0) {
#pragma unroll
                    for (int p = 0; p < 2; ++p) *(v4u*)(xbd + (size_t)row * DM + cl + 512 * p) = pack8(v[2 * p], v[2 * p + 1]);
                }
            }
            float s2 = 0.f;
#pragma unroll
            for (int j = 0; j < 4; ++j) s2 += (v[j].x * v[j].x + v[j].y * v[j].y) + (v[j].z * v[j].z + v[j].w * v[j].w);
            const float rstd = 1.0f / sqrtf(wave_sum(s2) * (1.0f / DM) + EPS);
            if (mode == 0) {
#pragma unroll
                for (int p = 0; p < 2; ++p) { const f32x4 h0 = v[2 * p] * rstd * A[2 * p] + B[2 * p], h1 = v[2 * p + 1] * rstd * A[2 * p + 1] + B[2 * p + 1];
                    const bool w8 = ((l & 1) ? (RET_IN_FP8 != 0) : (HGRN_FP8_MASK != 0)) && !dry, w16 = ((l & 1) ? (RET_IN_FP8 == 0) : (HGRN_FP8_MASK != 0xF)) || dry;
                    if (w8) { v2u w; w.x = pk4_fp8(h0.x * 8.0f, h0.y * 8.0f, h0.z * 8.0f, h0.w * 8.0f); w.y = pk4_fp8(h1.x * 8.0f, h1.y * 8.0f, h1.z * 8.0f, h1.w * 8.0f); *(v2u*)(F.ws + WS_H8 + (size_t)row * DM + cl + 512 * p) = w; }
                    if (w16) *(v4u*)(H + (size_t)row * DM + cl + 512 * p) = pack8(h0, h1); }
            } else {
#pragma unroll
                for (int j = 0; j < 4; ++j) *(f32x4*)(xdst + (size_t)row * DM + RP_COL(j)) = v[j] * rstd * A[j] + B[j];
            }
        }
    }
#undef RP_COL
}

__device__ __forceinline__ void row_phase2(Frame& F, int l, bool dry = false) {
    relaunder(F);
    bf16* H = dry ? (bf16*)(F.ws + WS_R2) : (bf16*)(F.ws + WS_H); unsigned char* H8p = dry ? F.ws + WS_R2 + 128 * MiB : F.ws + WS_H8;
    LAS unsigned char* frag = F.lds + RING_OFF;
    LAS float* lg = (LAS float*)(F.lds + 131072 + F.wave * 2112);
    LAS int* cntL = (LAS int*)(F.lds + 147968); LAS int* baseL = cntL + 32; LAS float* rbias = (LAS float*)(cntL + 64);
    unsigned* list = (unsigned*)(F.ws + WS_LIST); unsigned* tslot = (unsigned*)(F.ws + WS_TSLOT); float* tgate = (float*)(F.ws + WS_TGATE);
    __syncthreads();
    { const float* rw = KIN(I_RTW) + (size_t)l * DM * NEXP;
#pragma unroll
      for (int it = F.tid; it < 32 * 2 * 64; it += NWAVES * 64) { const int ln = it & 63, nt = (it >> 6) & 1, s = it >> 7; const int e = 16 * nt + (ln & 15), k0 = 32 * s + 8 * (ln >> 4);
          float w[8], hi[8];
#pragma unroll
          for (int j = 0; j < 8; ++j) { w[j] = rw[(size_t)(k0 + j) * NEXP + e]; }
          v4u ph, pl;
          { unsigned a = pk2(w[0], w[1]), b2 = pk2(w[2], w[3]), c2 = pk2(w[4], w[5]), d2 = pk2(w[6], w[7]); ph = (v4u){a, b2, c2, d2};
            hi[0] = bflo(a); hi[1] = bfhi(a); hi[2] = bflo(b2); hi[3] = bfhi(b2); hi[4] = bflo(c2); hi[5] = bfhi(c2); hi[6] = bflo(d2); hi[7] = bfhi(d2); }
          pl = (v4u){pk2(w[0] - hi[0], w[1] - hi[1]), pk2(w[2] - hi[2], w[3] - hi[3]), pk2(w[4] - hi[4], w[5] - hi[5]), pk2(w[6] - hi[6], w[7] - hi[7])};
          *(LAS v4u*)(frag + ((s * 2 + nt) * 2 + 0) * 1024 + ln * 16) = ph; *(LAS v4u*)(frag + ((s * 2 + nt) * 2 + 1) * 1024 + ln * 16) = pl; }
      if (F.tid < NEXP) rbias[F.tid] = KIN(I_RTB)[l * NEXP + F.tid];
    }
    LAS float* modA = (LAS float*)(F.lds + 148480); LAS float* modB = (LAS float*)(F.lds + 156160);
    for (int rb = F.vcu * 256; rb < MTOK; rb += F.G * 256) {
        const int b = rb / SEQ;
        if (F.tid < NEXP) cntL[F.tid] = 0;
        { const float* mv = (const float*)(F.ws + WS_MOD) + (size_t)(l * NBATCH + b) * 6 * DM;
          int t1 = threadIdx.x; asm volatile("" : "+v"(t1));
          for (int c = t1; c < DM; c += NWAVES * 64) { modA[c] = KIN(I_N2G)[l * DM + c] * (mv[4 * DM + c] + 1.0f); modB[c] = mv[3 * DM + c]; } }
        __syncthreads();
        int my_el[2][TOPK]; float my_g[2][TOPK];
#pragma unroll
        for (int grp = 0; grp < 2; ++grp) {
            __builtin_amdgcn_sched_barrier(0);
            const int row0 = rb + 32 * F.wave + 16 * grp, rr = F.lane & 15, gq = F.lane >> 4;
            const bf16* xp = (const bf16*)(F.ws + WS_XB) + (size_t)(row0 + rr) * DM + 8 * gq; unsigned char* h8 = H8p + (size_t)(row0 + rr) * DM + 8 * gq;
            v4u xr[32]; float s2 = 0.f;
#pragma unroll
            for (int s_ = 0; s_ < 32; ++s_) xr[s_] = *(const v4u*)(xp + 32 * s_);
#pragma unroll
            for (int s_ = 0; s_ < 32; ++s_) { const v4u q = xr[s_]; const f32x4 a = (f32x4){bflo(q.x), bfhi(q.x), bflo(q.y), bfhi(q.y)}, c = (f32x4){bflo(q.z), bfhi(q.z), bflo(q.w), bfhi(q.w)}; const f32x4 t = a * a + c * c; s2 += (t.x + t.y) + (t.z + t.w); }
            s2 += __shfl_xor(s2, 16); s2 += __shfl_xor(s2, 32);
            const float rstd = 1.0f / sqrtf(s2 * (1.0f / DM) + EPS);
            f32x4 acc0 = (f32x4){0.f, 0.f, 0.f, 0.f}, acc1 = (f32x4){0.f, 0.f, 0.f, 0.f};
#pragma unroll
            for (int s_ = 0; s_ < 32; ++s_) { v4u q = xr[s_]; asm volatile("" : "+v"(q.x), "+v"(q.y), "+v"(q.z), "+v"(q.w));
                const f32x4 A0 = *(const LAS f32x4*)(modA + 32 * s_ + 8 * gq), A1 = *(const LAS f32x4*)(modA + 32 * s_ + 8 * gq + 4), B0 = *(const LAS f32x4*)(modB + 32 * s_ + 8 * gq), B1 = *(const LAS f32x4*)(modB + 32 * s_ + 8 * gq + 4);
                const f32x4 h0 = ((f32x4){bflo(q.x), bfhi(q.x), bflo(q.y), bfhi(q.y)} * rstd) * A0 + B0, h1 = ((f32x4){bflo(q.z), bfhi(q.z), bflo(q.w), bfhi(q.w)} * rstd) * A1 + B1;
                const v4u av = pack8(h0, h1); const bf16x8 a = __builtin_bit_cast(bf16x8, av);
                if (MOE_FP8) { const f32x4 e0 = h0 * 8.0f, e1 = h1 * 8.0f; v2u w; w.x = pk4_fp8(e0.x, e0.y, e0.z, e0.w); w.y = pk4_fp8(e1.x, e1.y, e1.z, e1.w); *(v2u*)(h8 + 32 * s_) = w; }
                const bf16x8 b00 = *(const LAS bf16x8*)(frag + ((s_ * 2 + 0) * 2 + 0) * 1024 + F.lane * 16), b01 = *(const LAS bf16x8*)(frag + ((s_ * 2 + 0) * 2 + 1) * 1024 + F.lane * 16);
                const bf16x8 b10 = *(const LAS bf16x8*)(frag + ((s_ * 2 + 1) * 2 + 0) * 1024 + F.lane * 16), b11 = *(const LAS bf16x8*)(frag + ((s_ * 2 + 1) * 2 + 1) * 1024 + F.lane * 16);
                acc0 = __builtin_amdgcn_mfma_f32_16x16x32_bf16(a, b00, acc0, 0, 0, 0); acc0 = __builtin_amdgcn_mfma_f32_16x16x32_bf16(a, b01, acc0, 0, 0, 0);
                acc1 = __builtin_amdgcn_mfma_f32_16x16x32_bf16(a, b10, acc1, 0, 0, 0); acc1 = __builtin_amdgcn_mfma_f32_16x16x32_bf16(a, b11, acc1, 0, 0, 0);
                __builtin_amdgcn_sched_barrier(0);
            }
#pragma unroll
            for (int q = 0; q < 4; ++q) { lg[(4 * (F.lane >> 4) + q) * 33 + (F.lane & 15)] = acc0[q]; lg[(4 * (F.lane >> 4) + q) * 33 + 16 + (F.lane & 15)] = acc1[q]; }
            LDS_WAIT(); asm volatile("" ::: "memory");
            if (F.lane < 16) {
                unsigned taken = 0u; float tl[TOPK];
#pragma unroll
                for (int k = 0; k < TOPK; ++k) {
                    float best = -3.0e38f; int bi = 0;
                    for (int e = 0; e < NEXP; ++e) { const float v = lg[F.lane * 33 + e] + rbias[e]; if (!((taken >> e) & 1u) && v > best) { best = v; bi = e; } }
                    taken |= 1u << bi; my_el[grp][k] = bi; tl[k] = best;
                }
                float den = 0.f, ex[TOPK];
#pragma unroll
                for (int k = 0; k < TOPK; ++k) { ex[k] = __expf(tl[k] - tl[0]); den += ex[k]; }
#pragma unroll
                for (int k = 0; k < TOPK; ++k) { my_g[grp][k] = ex[k] / den; my_el[grp][k] |= __hip_atomic_fetch_add(&cntL[my_el[grp][k]], 1, __ATOMIC_RELAXED, __HIP_MEMORY_SCOPE_WORKGROUP) << 8; }
            } else {
#pragma unroll
                for (int k = 0; k < TOPK; ++k) { my_el[grp][k] = 0; my_g[grp][k] = 0.f; }
            }
            LDS_WAIT(); asm volatile("" ::: "memory");
        }
        __syncthreads();
        { int t2 = threadIdx.x; asm volatile("" : "+v"(t2));
          if (t2 < NEXP && !dry) baseL[t2] = (int)__hip_atomic_fetch_add(F.ctl + CW_CNT + l * 2048 + t2 * 64, (unsigned)cntL[t2], RLX_AGENT); }
        __syncthreads();
        int ln2 = threadIdx.x & 63; asm volatile("" : "+v"(ln2));
        if (ln2 < 16 && !dry) {
#pragma unroll
            for (int grp = 0; grp < 2; ++grp) {
                const int row = rb + 32 * F.wave + 16 * grp + ln2;
#pragma unroll
                for (int k = 0; k < TOPK; ++k) { const int e = my_el[grp][k] & 255, pos = baseL[e] + (my_el[grp][k] >> 8);
                    list[(size_t)e * LCAP + pos] = (unsigned)row; tslot[(size_t)row * 4 + k] = ((unsigned)e << 20) | (unsigned)pos; tgate[(size_t)row * 4 + k] = my_g[grp][k]; }
            }
        }
        __syncthreads();
    }
}

__device__ __forceinline__ void moe_gather(Frame& F, int l) {
    relaunder(F);
    build_tiles(F, l);
    const LAS int* ts = (const LAS int*)(F.lds + TAB_OFF); const LAS int* cnt = ts + 40;
    const unsigned* list = (const unsigned*)(F.ws + WS_LIST); const bf16* H = (const bf16*)(F.ws + WS_H); bf16* Xg = (bf16*)(F.ws + WS_R1);
    const int gw = F.vcu * NWAVES + F.wave, NGW = F.G * NWAVES, NR = ts[NEXP] * 256;
    for (int r = gw; r < NR; r += NGW) {
        const int mt = r >> 8; int e = 0;
        for (int k = 1; k < NEXP; ++k) e += (ts[k] <= mt) ? 1 : 0;
        const int pos = r - ts[e] * 256;
        unsigned tok = 0u; if (pos < cnt[e]) tok = ldu_vec(list + (size_t)e * LCAP + pos);
        const v4u* src = (const v4u*)(H + (size_t)tok * DM); v4u* dst = (v4u*)(Xg + (size_t)r * DM);
        dst[F.lane] = src[F.lane]; dst[F.lane + 64] = src[F.lane + 64];
    }
}

__device__ __forceinline__ void moe_build_tt(Frame& F, int nN) {
    const LAS int* ts = (const LAS int*)(F.lds + TAB_OFF); const LAS int* cnt = ts + 40;
    LAS unsigned short* tt = (LAS unsigned short*)(F.lds + 131072);
    const unsigned* list = (const unsigned*)(F.ws + WS_LIST); const int NU = ts[NEXP] * nN;
    const int tsk = (F.lane >= 1 && F.lane < NEXP) ? ts[F.lane] : 0x7fffffff;
#pragma unroll 1
    for (int jo = 0; jo < 18; jo += 3) {
        unsigned tok[3];
#pragma unroll
        for (int ji = 0; ji < 3; ++ji) { const int i = 2 * (jo + ji) + (F.tid >> 8), r = F.tid & 255, L = i * F.G + F.vcu, mt = L / nN;
            const int e = (int)__builtin_popcountll(__ballot(tsk <= mt)); const int pos = (mt - ts[e]) * 256 + r;
            tok[ji] = 0u; if (L < NU && pos < cnt[e]) tok[ji] = list[(size_t)e * LCAP + pos]; }
#pragma unroll
        for (int ji = 0; ji < 3; ++ji) { const int i = 2 * (jo + ji) + (F.tid >> 8), r = F.tid & 255, L = i * F.G + F.vcu;
            if (L < NU) tt[i * 256 + r] = (unsigned short)tok[ji]; }
    }
    __syncthreads();
}

using pg8::Unit;

struct EpiHgrnIn {
    static constexpr bool PERM = true; static constexpr int NST = 16;
    unsigned char* r1; const float* lb; unsigned smap; float asc;
    __device__ __forceinline__ void operator()(const f32x4 (&acc)[2][2][4][2], const Unit& u, int wr, int wc, int fr, int fq) const {
        const int seg = (int)((smap >> (4 * (u.pn >> 2))) & 15u), row0 = u.pm * 256 + wr * 64 + fr, cs0 = (u.pn & 3) * 256 + wc * 32 + 8 * fq;
        if (seg == 1) {
            bf16* LFb = (bf16*)(r1 + 128 * MiB);
#pragma unroll
            for (int bj = 0; bj < 2; ++bj) {
                f32x4 lbv[2]; lbv[0] = *(const f32x4*)(lb + cs0 + bj * 128); lbv[1] = *(const f32x4*)(lb + cs0 + bj * 128 + 4);
#pragma unroll
                for (int ai = 0; ai < 2; ++ai)
#pragma unroll
                    for (int m = 0; m < 4; ++m) { const size_t ro = (size_t)(row0 + ai * 128 + m * 16) * DM + cs0 + bj * 128; f32x4 lf[2];
#pragma unroll
                        for (int n = 0; n < 2; ++n)
#pragma unroll
                            for (int j = 0; j < 4; ++j) { const float f = fminf(fmaxf(acc[ai][bj][m][n][j] * asc, -60.f), 60.f), l0 = lbv[n][j], ef = __expf(f);
                                const float sg = ef * __builtin_amdgcn_rcpf(1.f + ef);
                                lf[n][j] = __log2f(l0 + (1.f - l0) * sg); }
                        *(v4u*)(LFb + ro) = pack8(lf[0], lf[1]);
                        __builtin_amdgcn_sched_barrier(0); }
            }
        } else {
            bf16* dst = (bf16*)(r1 + (seg == 0 ? 0 : (seg == 2 ? 256 * MiB : 384 * MiB))); const bool act = (seg != 2);
#pragma unroll
            for (int ai = 0; ai < 2; ++ai)
#pragma unroll
                for (int m = 0; m < 4; ++m) { const size_t ro = (size_t)(row0 + ai * 128 + m * 16) * DM;
#pragma unroll
                    for (int bj = 0; bj < 2; ++bj) { f32x4 v0 = acc[ai][bj][m][0] * asc, v1 = acc[ai][bj][m][1] * asc;
                        if (act) {
                            v0 = silu4_(v0); v1 = silu4_(v1); }
                        *(v4u*)(dst + ro + cs0 + bj * 128) = pack8(v0, v1); }
                    __builtin_amdgcn_sched_barrier(0); }
        }
    }
};

struct EpiRetIn {
    static constexpr bool PERM = true; static constexpr int NST = 16;
    unsigned char* r1; const int* positions; float asc;
    __device__ __forceinline__ void operator()(const f32x4 (&acc)[2][2][4][2], const Unit& u, int wr, int wc, int fr, int fq) const {
        const int row0 = u.pm * 256 + wr * 64 + fr, cl = wc * 32 + 8 * fq;
        if (u.pn < 8) {
            bf16* dst = (bf16*)(r1 + ((u.pn < 4) ? 0 : 128 * MiB)); const float sc = ((u.pn < 4) ? 1.0f : 0.0625f) * asc; const int hh = u.pn & 3;
            float invrev[2][4];
#pragma unroll
            for (int n = 0; n < 2; ++n)
#pragma unroll
                for (int j = 0; j < 4; ++j) invrev[n][j] = exp2f(-(float)(cl + 4 * n + j) * 0.10462765653188542f) * 0.15915494309189535f;
#pragma unroll
            for (int ai = 0; ai < 2; ++ai)
#pragma unroll
                for (int m = 0; m < 4; ++m) { const int row = row0 + ai * 128 + m * 16; const float pos = (float)positions[row]; const size_t ro = (size_t)row * DM + hh * 256 + cl;
                    f32x4 o1[2], o2[2];
#pragma unroll
                    for (int n = 0; n < 2; ++n)
#pragma unroll
                        for (int j = 0; j < 4; ++j) { const float rev = pos * invrev[n][j], fr_ = rev - floorf(rev); const float cs = __builtin_amdgcn_cosf(fr_), sn = __builtin_amdgcn_sinf(fr_);
                            const float x1 = acc[ai][0][m][n][j], x2 = acc[ai][1][m][n][j]; o1[n][j] = (x1 * cs - x2 * sn) * sc; o2[n][j] = (x2 * cs + x1 * sn) * sc; }
                    *(v4u*)(dst + ro) = pack8(o1[0], o1[1]); *(v4u*)(dst + ro + 128) = pack8(o2[0], o2[1]); }
        } else {
            const bool isg = (u.pn >= 16); bf16* dst = (bf16*)(r1 + (isg ? 512 * MiB : 256 * MiB)); const int ct = (isg ? u.pn - 16 : u.pn - 8) * 256 + cl;
#pragma unroll
            for (int ai = 0; ai < 2; ++ai)
#pragma unroll
                for (int m = 0; m < 4; ++m) { const size_t ro = (size_t)(row0 + ai * 128 + m * 16) * 2048 + ct;
#pragma unroll
                    for (int bj = 0; bj < 2; ++bj) { f32x4 v0 = acc[ai][bj][m][0] * asc, v1 = acc[ai][bj][m][1] * asc;
                        if (isg) {
                            v0 = silu4_(v0); v1 = silu4_(v1); }
                        *(v4u*)(dst + ro + bj * 128) = pack8(v0, v1); } }
        }
    }
};

template <bool XF32>
struct EpiOutT {
    static constexpr bool PERM = true; static constexpr int NST = XF32 ? 4 : 8;
    const void* xin; bf16* xout; const float* gate; float asc;
    __device__ __forceinline__ void operator()(const f32x4 (&acc)[2][2][4][2], const Unit& u, int wr, int wc, int fr, int fq) const {
        const int row0 = u.pm * 256 + wr * 64 + fr, c0 = u.pn * 256 + wc * 32 + 8 * fq, b = (u.pm * 256) / SEQ;
        f32x4 gv[2][2];
#pragma unroll
        for (int bj = 0; bj < 2; ++bj)
#pragma unroll
            for (int n = 0; n < 2; ++n) gv[bj][n] = *(const f32x4*)(gate + (size_t)b * 6 * DM + c0 + bj * 128 + 4 * n) * asc;
        if constexpr (XF32) {
#pragma unroll
            for (int ai = 0; ai < 2; ++ai)
#pragma unroll
                for (int mp = 0; mp < 2; ++mp) { f32x4 xi[2][2][2];
#pragma unroll
                    for (int mm = 0; mm < 2; ++mm)
#pragma unroll
                        for (int bj = 0; bj < 2; ++bj)
#pragma unroll
                            for (int n = 0; n < 2; ++n) xi[mm][bj][n] = *(const f32x4*)((const float*)xin + (size_t)(row0 + ai * 128 + (2 * mp + mm) * 16) * DM + c0 + bj * 128 + 4 * n);
#pragma unroll
                    for (int mm = 0; mm < 2; ++mm)
#pragma unroll
                        for (int bj = 0; bj < 2; ++bj)
                            *(v4u*)(xout + (size_t)(row0 + ai * 128 + (2 * mp + mm) * 16) * DM + c0 + bj * 128) = pack8(xi[mm][bj][0] + gv[bj][0] * acc[ai][bj][2 * mp + mm][0], xi[mm][bj][1] + gv[bj][1] * acc[ai][bj][2 * mp + mm][1]);
                    asm volatile("" ::: "memory"); }
        } else {
#pragma unroll
            for (int ai = 0; ai < 2; ++ai) { v4u xi[4][2];
#pragma unroll
                for (int m = 0; m < 4; ++m)
#pragma unroll
                    for (int bj = 0; bj < 2; ++bj) xi[m][bj] = *(const v4u*)((const bf16*)xin + (size_t)(row0 + ai * 128 + m * 16) * DM + c0 + bj * 128);
#pragma unroll
                for (int m = 0; m < 4; ++m)
#pragma unroll
                    for (int bj = 0; bj < 2; ++bj) { const v4u q = xi[m][bj];
                        const f32x4 lo = (f32x4){bflo(q.x), bfhi(q.x), bflo(q.y), bfhi(q.y)}, hi = (f32x4){bflo(q.z), bfhi(q.z), bflo(q.w), bfhi(q.w)};
                        *(v4u*)(xout + (size_t)(row0 + ai * 128 + m * 16) * DM + c0 + bj * 128) = pack8(lo + gv[bj][0] * acc[ai][bj][m][0], hi + gv[bj][1] * acc[ai][bj][m][1]); }
                asm volatile("" ::: "memory"); }
        }
    }
};

struct EpiMoe1F8 {
    static constexpr bool PERM = true; static constexpr int NST = 8;
    unsigned char* A2; const float* b1;
    __device__ __forceinline__ void operator()(const f32x4 (&acc)[2][2][4][2], const Unit& u, int wr, int wc, int fr, int fq) const {
        const int row0 = u.pm * 256 + wr * 64 + fr, gc = u.nn * 128 + wc * 32 + 8 * fq; const float* bp = b1 + (size_t)u.e * 2048;
        f32x4 bg[2], bl[2];
#pragma unroll
        for (int n = 0; n < 2; ++n) { bg[n] = *(const f32x4*)(bp + gc + 4 * n); bl[n] = *(const f32x4*)(bp + 1024 + gc + 4 * n); }
#pragma unroll
        for (int ai = 0; ai < 2; ++ai)
#pragma unroll
            for (int m = 0; m < 4; ++m) { f32x4 o[2];
#pragma unroll
                for (int n = 0; n < 2; ++n) {
                    f32x4 g = acc[ai][0][m][n] * (1.0f / 512.f) + bg[n], li = acc[ai][1][m][n] * (1.0f / 512.f) + bl[n];
                    g = __builtin_elementwise_min(g, (f32x4){7.0f, 7.0f, 7.0f, 7.0f});
                    li = __builtin_elementwise_min(__builtin_elementwise_max(li, (f32x4){-7.0f, -7.0f, -7.0f, -7.0f}), (f32x4){7.0f, 7.0f, 7.0f, 7.0f});
                    const f32x4 t = g * (-1.702f * 1.4426950408889634f); f32x4 e, r;
#pragma unroll
                    for (int j = 0; j < 4; ++j) e[j] = __builtin_amdgcn_exp2f(t[j]);
                    const f32x4 d = e + 1.0f;
#pragma unroll
                    for (int j = 0; j < 4; ++j) r[j] = __builtin_amdgcn_rcpf(d[j]);
                    o[n] = (g * r) * (li * 4.0f + 4.0f); }
                v2u w; w.x = pk4_fp8(o[0].x, o[0].y, o[0].z, o[0].w); w.y = pk4_fp8(o[1].x, o[1].y, o[1].z, o[1].w);
                *(v2u*)(A2 + (size_t)(row0 + ai * 128 + m * 16) * DM + gc) = w; }
    }
};
struct EpiMoe1 {
    static constexpr bool PERM = true; static constexpr int NST = 8;
    bf16* A2; const float* b1;
    __device__ __forceinline__ void operator()(const f32x4 (&acc)[2][2][4][2], const Unit& u, int wr, int wc, int fr, int fq) const {
        const int row0 = u.pm * 256 + wr * 64 + fr, gc = u.nn * 128 + wc * 32 + 8 * fq; const float* bp = b1 + (size_t)u.e * 2048;
        f32x4 bg[2], bl[2];
#pragma unroll
        for (int n = 0; n < 2; ++n) { bg[n] = *(const f32x4*)(bp + gc + 4 * n); bl[n] = *(const f32x4*)(bp + 1024 + gc + 4 * n); }
#pragma unroll
        for (int ai = 0; ai < 2; ++ai)
#pragma unroll
            for (int m = 0; m < 4; ++m) { f32x4 o[2];
#pragma unroll
                for (int n = 0; n < 2; ++n)
#pragma unroll
                    for (int j = 0; j < 4; ++j) { const float g = fminf(acc[ai][0][m][n][j] + bg[n][j], 7.0f), li = fminf(fmaxf(acc[ai][1][m][n][j] + bl[n][j], -7.0f), 7.0f);
                        o[n][j] = g * sigmoidf_(1.702f * g) * (li + 1.0f); }
                *(v4u*)(A2 + (size_t)(row0 + ai * 128 + m * 16) * DM + gc) = pack8(o[0], o[1]); }
    }
};

template <int VAR = 0> struct EpiMoe2T {
    static constexpr bool PERM = true; static constexpr int NST = (VAR == 2) ? 0 : 16;
    bf16* Y; const float* b2; float sc;
    __device__ __forceinline__ void operator()(const f32x4 (&acc)[2][2][4][2], const Unit& u, int wr, int wc, int fr, int fq) const {
        const int row0 = u.pm * 256 + wr * 64 + fr, c0 = u.nn * 256 + wc * 32 + 8 * fq; const float* bp = b2 + (size_t)u.e * DM;
        f32x4 bv[2][2];
#pragma unroll
        for (int bj = 0; bj < 2; ++bj)
#pragma unroll
            for (int n = 0; n < 2; ++n) bv[bj][n] = (VAR == 1) ? (f32x4){sc, sc, sc, sc} : *(const f32x4*)(bp + c0 + bj * 128 + 4 * n);
        float sink = 0.f;
#pragma unroll
        for (int ai = 0; ai < 2; ++ai)
#pragma unroll
            for (int m = 0; m < 4; ++m) { const size_t ro = (size_t)(row0 + ai * 128 + m * 16) * YLD + c0;
#pragma unroll
                for (int bj = 0; bj < 2; ++bj) { const f32x4 v0 = acc[ai][bj][m][0] * sc + bv[bj][0], v1 = acc[ai][bj][m][1] * sc + bv[bj][1];
                    if (VAR == 2) { const v4u p = pack8(v0, v1); sink += __uint_as_float(p.x ^ p.y ^ p.z ^ p.w); } else *(v4u*)(Y + ro + bj * 128) = pack8(v0, v1); } }
        if (VAR == 2) asm volatile("" :: "v"(sink));
    }
};
typedef EpiMoe2T<0> EpiMoe2;
struct EpiMoe2Y8 {
    static constexpr bool PERM = true; static constexpr int NST = 16;
    unsigned char* Y; const float* b2; float sc;
    __device__ __forceinline__ void operator()(const f32x4 (&acc)[2][2][4][2], const Unit& u, int wr, int wc, int fr, int fq) const {
        const int row0 = u.pm * 256 + wr * 64 + fr, c0 = u.nn * 256 + wc * 32 + 8 * fq; const float* bp = b2 + (size_t)u.e * DM;
        f32x4 bv[2][2]; const float s32 = sc * YSC;
#pragma unroll
        for (int bj = 0; bj < 2; ++bj)
#pragma unroll
            for (int n = 0; n < 2; ++n) bv[bj][n] = *(const f32x4*)(bp + c0 + bj * 128 + 4 * n) * YSC;
#pragma unroll
        for (int ai = 0; ai < 2; ++ai)
#pragma unroll
            for (int m = 0; m < 4; ++m) { const size_t ro = (size_t)(row0 + ai * 128 + m * 16) * YLD + c0;
#pragma unroll
                for (int bj = 0; bj < 2; ++bj) { f32x4 v0 = acc[ai][bj][m][0] * s32 + bv[bj][0], v1 = acc[ai][bj][m][1] * s32 + bv[bj][1];
#pragma unroll
                    for (int q = 0; q < 4; ++q) { v0[q] = __builtin_fminf(__builtin_fmaxf(v0[q], -448.0f), 448.0f); v1[q] = __builtin_fminf(__builtin_fmaxf(v1[q], -448.0f), 448.0f); }
                    v2u w; w.x = pk4_fp8(v0.x, v0.y, v0.z, v0.w); w.y = pk4_fp8(v1.x, v1.y, v1.z, v1.w);
                    *(v2u*)(Y + ro + bj * 128) = w; } }
    }
};

__device__ __forceinline__ void hgrn_scan(Frame& F, int j) {
    relaunder(F);
    const bf16* Q = (const bf16*)(F.ws + WS_R1); const bf16* LFb = (const bf16*)(F.ws + WS_R1 + 128 * MiB); const bf16* V = (const bf16*)(F.ws + WS_R1 + 256 * MiB); const bf16* SG = (const bf16*)(F.ws + WS_R1 + 384 * MiB);
    bf16* O = (bf16*)(F.ws + WS_R2);
    LAS float* Qs = (LAS float*)(F.lds); LAS float* Ks = Qs + 4096; LAS float* Fs = Qs + 8192; LAS float* Vs = Qs + 12288; LAS float* P = Qs + 16384;
    const int v = F.tid & 127, kq = F.tid >> 7, t16 = F.tid >> 4, c8 = (F.tid & 15) * 8;
    f32x4 gain0 = *(const f32x4*)(KIN(I_HGAIN) + j * 128 + c8), gain1 = *(const f32x4*)(KIN(I_HGAIN) + j * 128 + c8 + 4);
    for (int u = F.vcu; u < NBATCH * HG_H; u += F.G) {
        const int b = u / HG_H, h = u % HG_H;
        float S[32];
#pragma unroll
        for (int i = 0; i < 32; ++i) S[i] = 0.f;
        for (int ch = 0; ch < SEQ / 32; ++ch) {
            const int row0 = b * SEQ + 32 * ch; const size_t gi = (size_t)(row0 + t16) * DM + h * 128 + c8;
            __syncthreads();
            { const v4u q = *(const v4u*)(Q + gi), lw = *(const v4u*)(LFb + gi), vv = *(const v4u*)(V + gi);
              const f32x4 f0 = (f32x4){exp2f(bflo(lw.x)), exp2f(bfhi(lw.x)), exp2f(bflo(lw.y)), exp2f(bfhi(lw.y))}, f1 = (f32x4){exp2f(bflo(lw.z)), exp2f(bfhi(lw.z)), exp2f(bflo(lw.w)), exp2f(bfhi(lw.w))};
              LAS f32x4* d;
              d = (LAS f32x4*)(Qs + t16 * 128 + c8); d[0] = (f32x4){bflo(q.x), bfhi(q.x), bflo(q.y), bfhi(q.y)}; d[1] = (f32x4){bflo(q.z), bfhi(q.z), bflo(q.w), bfhi(q.w)};
              d = (LAS f32x4*)(Ks + t16 * 128 + c8); d[0] = 1.0f - f0; d[1] = 1.0f - f1;
              d = (LAS f32x4*)(Vs + t16 * 128 + c8); d[0] = (f32x4){bflo(vv.x), bfhi(vv.x), bflo(vv.y), bfhi(vv.y)}; d[1] = (f32x4){bflo(vv.z), bfhi(vv.z), bflo(vv.w), bfhi(vv.w)};
              d = (LAS f32x4*)(Fs + t16 * 128 + c8); d[0] = f0; d[1] = f1; }
            __syncthreads();
            for (int t = 0; t < 32; ++t) {
                const float vt = Vs[t * 128 + v]; float a = 0.f;
#pragma unroll
                for (int i4 = 0; i4 < 8; ++i4) { const f32x4 f4 = *(const LAS f32x4*)(Fs + t * 128 + 32 * kq + 4 * i4), k4 = *(const LAS f32x4*)(Ks + t * 128 + 32 * kq + 4 * i4), q4 = *(const LAS f32x4*)(Qs + t * 128 + 32 * kq + 4 * i4);
#pragma unroll
                    for (int i = 0; i < 4; ++i) { S[4 * i4 + i] = f4[i] * S[4 * i4 + i] + k4[i] * vt; a += q4[i] * S[4 * i4 + i]; } }
                P[(t * 4 + kq) * 128 + v] = a;
            }
            __syncthreads();
            { f32x4 o0 = (f32x4){0.f, 0.f, 0.f, 0.f}, o1 = o0;
#pragma unroll
              for (int q = 0; q < 4; ++q) { o0 += *(const LAS f32x4*)(P + (t16 * 4 + q) * 128 + c8); o1 += *(const LAS f32x4*)(P + (t16 * 4 + q) * 128 + c8 + 4); }
              float ss = (o0.x * o0.x + o0.y * o0.y) + (o0.z * o0.z + o0.w * o0.w) + (o1.x * o1.x + o1.y * o1.y) + (o1.z * o1.z + o1.w * o1.w);
              ss += __shfl_xor(ss, 1); ss += __shfl_xor(ss, 2); ss += __shfl_xor(ss, 4); ss += __shfl_xor(ss, 8);
              const float r = 1.0f / sqrtf(ss * (1.0f / 128.f) + EPS);
              const v4u sg = *(const v4u*)(SG + gi);
              f32x4 a0 = o0 * r * gain0, a1 = o1 * r * gain1;
              a0.x *= bflo(sg.x); a0.y *= bfhi(sg.x); a0.z *= bflo(sg.y); a0.w *= bfhi(sg.y); a1.x *= bflo(sg.z); a1.y *= bfhi(sg.z); a1.z *= bflo(sg.w); a1.w *= bfhi(sg.w);
              *(v4u*)(O + gi) = pack8(a0, a1); }
        }
    }
}

__device__ __forceinline__ void ret_scan(Frame& F) {
    relaunder(F);
    const bf16* Q = (const bf16*)(F.ws + WS_R1); const bf16* K = (const bf16*)(F.ws + WS_R1 + 128 * MiB); const bf16* V = (const bf16*)(F.ws + WS_R1 + 256 * MiB); const bf16* SG = (const bf16*)(F.ws + WS_R1 + 512 * MiB);
    bf16* O = (bf16*)(F.ws + WS_R2);
    LAS bf16* Qs = (LAS bf16*)(F.lds); LAS bf16* Ks = (LAS bf16*)(F.lds + 33792); LAS bf16* Vs = (LAS bf16*)(F.lds + 67584);
    LAS float* St = (LAS float*)(F.lds + 133120); LAS float* wred = (LAS float*)(F.lds + 149504); LAS float* rtab = (LAS float*)(F.lds + 151552);
    for (int u = F.vcu; u < NBATCH * RT_H * 16; u += F.G) {
        const int bh = u >> 4, cp = u & 15, b = bh >> 2, h = bh & 3;
        const float lg2g = log2f(1.0f - exp2f(-5.0f - (float)h));
        for (int half = 0; half < 2; ++half) {
            const int c = half ? 31 - cp : cp; const int row0 = b * SEQ + 64 * c;
            __syncthreads();
#pragma unroll
            for (int i = 0; i < 4; ++i) { const int p = F.tid + 512 * i, r = p >> 5, cc = (p & 31) * 8; *(LAS v4u*)(Qs + r * 264 + cc) = *(const v4u*)(Q + (size_t)(row0 + r) * DM + h * 256 + cc); }
            float acc[64];
#pragma unroll
            for (int n = 0; n < 64; ++n) acc[n] = 0.f;
            for (int cq = 0; cq <= c; ++cq) {
                const int krow0 = b * SEQ + 64 * cq;
                __syncthreads();
#pragma unroll
                for (int i = 0; i < 4; ++i) { const int p = F.tid + 512 * i, r = p >> 5, cc = (p & 31) * 8; *(LAS v4u*)(Ks + r * 264 + cc) = *(const v4u*)(K + (size_t)(krow0 + r) * DM + h * 256 + cc); }
#pragma unroll
                for (int i = 0; i < 8; ++i) { const int p = F.tid + 512 * i, r = p >> 6, cc = (p & 63) * 8; *(LAS v4u*)(Vs + r * 512 + cc) = *(const v4u*)(V + (size_t)(krow0 + r) * 2048 + h * 512 + cc); }
                __syncthreads();
                { float s[8];
#pragma unroll
                  for (int j8 = 0; j8 < 8; ++j8) s[j8] = 0.f;
                  for (int dc = 0; dc < 32; ++dc) {
                      const v4u kv = *(const LAS v4u*)(Ks + F.lane * 264 + dc * 8);
                      const float k0 = bflo(kv.x), k1 = bfhi(kv.x), k2 = bflo(kv.y), k3 = bfhi(kv.y), k4 = bflo(kv.z), k5 = bfhi(kv.z), k6 = bflo(kv.w), k7 = bfhi(kv.w);
#pragma unroll
                      for (int j8 = 0; j8 < 8; ++j8) { const v4u qv = *(const LAS v4u*)(Qs + (8 * F.wave + j8) * 264 + dc * 8);
                          s[j8] += (bflo(qv.x) * k0 + bfhi(qv.x) * k1) + (bflo(qv.y) * k2 + bfhi(qv.y) * k3) + (bflo(qv.z) * k4 + bfhi(qv.z) * k5) + (bflo(qv.w) * k6 + bfhi(qv.w) * k7); }
                  }
                  f32x4 w0, w1;
#pragma unroll
                  for (int j8 = 0; j8 < 8; ++j8) { const float dist = fabsf((float)((64 * c + 8 * F.wave + j8) - (64 * cq + F.lane))); const float val = s[j8] * exp2f(dist * lg2g); if (j8 < 4) w0[j8] = val; else w1[j8 - 4] = val; }
                  *(LAS f32x4*)(St + F.lane * 64 + 8 * F.wave) = w0; *(LAS f32x4*)(St + F.lane * 64 + 8 * F.wave + 4) = w1; }
                __syncthreads();
                for (int m2 = 0; m2 < 64; ++m2) {
                    const float vv = bf2f(Vs[m2 * 512 + F.tid]);
#pragma unroll
                    for (int n4 = 0; n4 < 16; ++n4) { const f32x4 sv = *(const LAS f32x4*)(St + m2 * 64 + 4 * n4); acc[4 * n4 + 0] += sv.x * vv; acc[4 * n4 + 1] += sv.y * vv; acc[4 * n4 + 2] += sv.z * vv; acc[4 * n4 + 3] += sv.w * vv; }
                }
            }
#pragma unroll
            for (int n = 0; n < 64; ++n) { const float p = wave_sum(acc[n] * acc[n]); if (F.lane == 0) wred[F.wave * 64 + n] = p; }
            __syncthreads();
            if (F.tid < 64) { float s = 0.f;
#pragma unroll
                for (int w = 0; w < 8; ++w) s += wred[w * 64 + F.tid];
                rtab[F.tid] = 1.0f / sqrtf(s * (1.0f / 512.f) + EPS); }
            __syncthreads();
#pragma unroll
            for (int n = 0; n < 64; ++n) { const size_t gi = (size_t)(row0 + n) * 2048 + h * 512 + F.tid; const float sg = bf2f(SG[gi]); O[gi] = (bf16)(pk2(acc[n] * rtab[n] * sg, 0.f) & 0xffffu); }
        }
    }
}

typedef short s16x4 __attribute__((ext_vector_type(4)));
__device__ __forceinline__ unsigned off_b(unsigned row, unsigned ch) { return 256u * row + 16u * (ch ^ (((row & 3u) << 2) | ((row >> 2) & 3u))); }
__device__ __forceinline__ bf16x8 row_frag(const LAS unsigned char* tile, unsigned row, unsigned s4, unsigned g) { return *(const LAS bf16x8*)(tile + off_b(row, 4u * s4 + g)); }
__device__ __forceinline__ bf16x8 tr_frag16(const LAS unsigned char* tile, unsigned lane, unsigned c, unsigned ks) {
    const unsigned g = lane >> 4, q = (lane & 15u) >> 2, p = lane & 3u;
    const unsigned a0 = off_b(32u * ks + 8u * g + q, 2u * c + (p >> 1)) + 8u * (p & 1u), a1 = off_b(32u * ks + 8u * g + 4u + q, 2u * c + (p >> 1)) + 8u * (p & 1u);
    const s16x4 lo = __builtin_amdgcn_ds_read_tr16_b64_v4i16((LAS s16x4*)(tile + a0)), hi = __builtin_amdgcn_ds_read_tr16_b64_v4i16((LAS s16x4*)(tile + a1));
    return (bf16x8){lo[0], lo[1], lo[2], lo[3], hi[0], hi[1], hi[2], hi[3]};
}
#define RSB() __builtin_amdgcn_sched_barrier(0)
constexpr unsigned RQS = 528, RVS = 272;
template <unsigned RS> __device__ __forceinline__ bf16x8 tr_lin(const LAS unsigned char* img, unsigned trb, int c, int ks) {
    const s16x4 lo = __builtin_amdgcn_ds_read_tr16_b64_v4i16((LAS s16x4*)(img + trb + (32 * ks) * RS + 32 * c)), hi = __builtin_amdgcn_ds_read_tr16_b64_v4i16((LAS s16x4*)(img + trb + (32 * ks + 4) * RS + 32 * c));
    return (bf16x8){lo[0], lo[1], lo[2], lo[3], hi[0], hi[1], hi[2], hi[3]};
}
__device__ __forceinline__ void ret_scan_mfma(Frame& F) {
    relaunder(F);
    const bf16* Q = (const bf16*)(F.ws + WS_R1); const bf16* K = (const bf16*)(F.ws + WS_R1 + 128 * MiB); const bf16* V = (const bf16*)(F.ws + WS_R1 + 256 * MiB);
    bf16* O = (bf16*)(F.ws + WS_R2); float* SS = (float*)(F.ws + WS_R2 + 256 * MiB); const bf16* SGp = (const bf16*)(F.ws + WS_R1 + 512 * MiB);
    LAS unsigned char* Qi = F.lds; LAS unsigned char* Ki = F.lds + 33792; LAS unsigned char* Vi = F.lds + 67584; LAS unsigned char* Si = F.lds + 84992; LAS float* OT = (LAS float*)(F.lds + 94208);
    const unsigned w = (unsigned)F.wave;
    for (int u = F.vcu; u < NBATCH * RT_H * 4; u += F.G) {
        const int bh = u >> 2, vs = u & 3, b = bh >> 2, h = bh & 3;
        const float lg2g = log2f(1.0f - exp2f(-5.0f - (float)h)), cd = exp2f(64.0f * lg2g);
        f32x4 R[16];
#pragma unroll
        for (int i = 0; i < 16; ++i) R[i] = (f32x4){0.f, 0.f, 0.f, 0.f};
        v4u pq[4], pk[4], pv[2];
        { const int row0 = b * SEQ;
#pragma unroll
          for (int i = 0; i < 4; ++i) { const int p = F.tid + 512 * i, r = p >> 5, c32 = p & 31; pq[i] = *(const v4u*)(Q + (size_t)(row0 + r) * DM + h * 256 + c32 * 8); pk[i] = *(const v4u*)(K + (size_t)(row0 + r) * DM + h * 256 + c32 * 8); }
#pragma unroll
          for (int i = 0; i < 2; ++i) { const int p = F.tid + 512 * i, r = p >> 4, c16 = p & 15; pv[i] = *(const v4u*)(V + (size_t)(row0 + r) * 2048 + h * 512 + vs * 128 + c16 * 8); } }
        __syncthreads();
        for (int c = 0; c < SEQ / 64; ++c) {
            const int row0 = b * SEQ + 64 * c;
            unsigned tidl = (unsigned)F.tid; asm volatile("" : "+v"(tidl));
            const unsigned lane = tidl & 63u, g = lane >> 4, li = lane & 15u;
#pragma unroll
            for (int i = 0; i < 4; ++i) { const unsigned p = tidl + 512u * i, r = p >> 5, c32 = p & 31u; const unsigned o = r * RQS + 16u * c32; *(LAS v4u*)(Qi + o) = pq[i]; *(LAS v4u*)(Ki + o) = pk[i]; }
#pragma unroll
            for (int i = 0; i < 2; ++i) { const unsigned p = tidl + 512u * i, r = p >> 4, c16 = p & 15u; *(LAS v4u*)(Vi + r * RVS + 16u * c16) = pv[i]; }
            __syncthreads();
            if (c + 1 < SEQ / 64) { const int rn = row0 + 64;
#pragma unroll
                for (int i = 0; i < 4; ++i) { const unsigned p = tidl + 512u * i, r = p >> 5, c32 = p & 31u; pq[i] = *(const v4u*)(Q + (size_t)(rn + (int)r) * DM + h * 256 + c32 * 8); pk[i] = *(const v4u*)(K + (size_t)(rn + (int)r) * DM + h * 256 + c32 * 8); }
#pragma unroll
                for (int i = 0; i < 2; ++i) { const unsigned p = tidl + 512u * i, r = p >> 4, c16 = p & 15u; pv[i] = *(const v4u*)(V + (size_t)(rn + (int)r) * 2048 + h * 512 + vs * 128 + c16 * 8); } }
            RSB();
            const unsigned rb128 = li * RQS + 16u * g, rb64 = li * RQS + 8u * g, trq = (8u * g + (li >> 2)) * RQS + 8u * (li & 3u), trv = (8u * g + (li >> 2)) * RVS + 8u * (li & 3u);
            { const unsigned mt = w >> 1, nt0 = 2u * (w & 1u); f32x4 sa0 = (f32x4){0.f, 0.f, 0.f, 0.f}, sa1 = sa0;
              const LAS unsigned char* qrow = Qi + rb128 + mt * (16u * RQS); const LAS unsigned char* krow = Ki + rb128 + nt0 * (16u * RQS);
              bf16x8 qa[2][2], kb0[2][2], kb1[2][2];
#define RET_LDS(buf, s8b) do { _Pragma("unroll") for (int k2 = 0; k2 < 2; ++k2) { const int s8 = (s8b) + k2; \
                  qa[buf][k2] = *(const LAS bf16x8*)(qrow + 64 * s8); kb0[buf][k2] = *(const LAS bf16x8*)(krow + 64 * s8); kb1[buf][k2] = *(const LAS bf16x8*)(krow + 16 * RQS + 64 * s8); } } while (0)
              RET_LDS(0, 0); RSB();
#pragma unroll
              for (int bt = 0; bt < 4; ++bt) { if (bt < 3) RET_LDS((bt + 1) & 1, 2 * (bt + 1)); RSB();
#pragma unroll
                  for (int k2 = 0; k2 < 2; ++k2) { sa0 = __builtin_amdgcn_mfma_f32_16x16x32_bf16(qa[bt & 1][k2], kb0[bt & 1][k2], sa0, 0, 0, 0); sa1 = __builtin_amdgcn_mfma_f32_16x16x32_bf16(qa[bt & 1][k2], kb1[bt & 1][k2], sa1, 0, 0, 0); }
                  RSB(); }
#undef RET_LDS
#pragma unroll
              for (int q = 0; q < 4; ++q) { const int n = (int)(16u * mt + 4u * g) + q, m0 = (int)(16u * nt0 + li);
                  const float v0 = sa0[q] * exp2f(fabsf((float)(n - m0)) * lg2g), v1 = sa1[q] * exp2f(fabsf((float)(n - m0 - 16)) * lg2g); const unsigned pk = pk2(v0, v1);
                  *(LAS unsigned short*)(Si + (unsigned)n * 144u + 2u * (unsigned)m0) = (unsigned short)(pk & 0xffffu); *(LAS unsigned short*)(Si + (unsigned)n * 144u + 2u * (unsigned)m0 + 32u) = (unsigned short)(pk >> 16); } }
            RSB();
            f32x4 Oa[4];
#pragma unroll
            for (int mt = 0; mt < 4; ++mt) Oa[mt] = (f32x4){0.f, 0.f, 0.f, 0.f};
            { v2u qlo[2][4], qhi[2][4]; const LAS unsigned char* qp = Qi + rb64;
#define RET_LDQ(buf, s8) do { _Pragma("unroll") for (int mt = 0; mt < 4; ++mt) { qlo[buf][mt] = *(const LAS v2u*)(qp + mt * (16 * RQS) + 64 * (s8)); qhi[buf][mt] = *(const LAS v2u*)(qp + mt * (16 * RQS) + 64 * (s8) + 32); } } while (0)
              RET_LDQ(0, 0); RSB();
#pragma unroll
              for (int s8 = 0; s8 < 8; ++s8) { if (s8 < 7) RET_LDQ((s8 + 1) & 1, s8 + 1); RSB();
                  const v4u rt = (v4u){pk2(R[2 * s8][0], R[2 * s8][1]), pk2(R[2 * s8][2], R[2 * s8][3]), pk2(R[2 * s8 + 1][0], R[2 * s8 + 1][1]), pk2(R[2 * s8 + 1][2], R[2 * s8 + 1][3])}; const bf16x8 Rb = __builtin_bit_cast(bf16x8, rt);
#pragma unroll
                  for (int mt = 0; mt < 4; ++mt) { const v4u av = (v4u){qlo[s8 & 1][mt].x, qlo[s8 & 1][mt].y, qhi[s8 & 1][mt].x, qhi[s8 & 1][mt].y}; Oa[mt] = __builtin_amdgcn_mfma_f32_16x16x32_bf16(__builtin_bit_cast(bf16x8, av), Rb, Oa[mt], 0, 0, 0); }
                  RSB(); }
#undef RET_LDQ
            }
#pragma unroll
            for (int mt = 0; mt < 4; ++mt)
#pragma unroll
                for (int q = 0; q < 4; ++q) Oa[mt][q] *= exp2f((float)(16 * mt + 4 * (int)g + q + 1) * lg2g);
            __syncthreads();
            bf16x8 Vf[2], sf[4][2], ka[2][2][2];
#define RET_LDK(buf, dtb) do { _Pragma("unroll") for (int d2 = 0; d2 < 2; ++d2) _Pragma("unroll") for (int ks = 0; ks < 2; ++ks) ka[buf][d2][ks] = tr_lin<RQS>(Ki, trq, (dtb) + d2, ks); } while (0)
#pragma unroll
            for (int ks = 0; ks < 2; ++ks) Vf[ks] = tr_lin<RVS>(Vi + 32u * w, trv, 0, ks);
#pragma unroll
            for (int mt = 0; mt < 4; ++mt)
#pragma unroll
                for (int ks = 0; ks < 2; ++ks) sf[mt][ks] = *(const LAS bf16x8*)(Si + (16u * mt + li) * 144u + 64u * ks + 16u * g);
            RET_LDK(0, 0); RSB();
#pragma unroll
            for (int mt = 0; mt < 4; ++mt)
#pragma unroll
                for (int ks = 0; ks < 2; ++ks) Oa[mt] = __builtin_amdgcn_mfma_f32_16x16x32_bf16(sf[mt][ks], Vf[ks], Oa[mt], 0, 0, 0);
            bf16x8 Vd[2];
#pragma unroll
            for (int ks = 0; ks < 2; ++ks) { const v4u vv = __builtin_bit_cast(v4u, Vf[ks]); float f[8];
#pragma unroll
                for (int j = 0; j < 8; ++j) f[j] = exp2f((float)(63 - (32 * ks + 8 * (int)g + j)) * lg2g);
                const v4u sv = (v4u){pk2(bflo(vv.x) * f[0], bfhi(vv.x) * f[1]), pk2(bflo(vv.y) * f[2], bfhi(vv.y) * f[3]), pk2(bflo(vv.z) * f[4], bfhi(vv.z) * f[5]), pk2(bflo(vv.w) * f[6], bfhi(vv.w) * f[7])};
                Vd[ks] = __builtin_bit_cast(bf16x8, sv); }
            RSB();
#pragma unroll
            for (int bt = 0; bt < 8; ++bt) { if (bt < 7) RET_LDK((bt + 1) & 1, 2 * (bt + 1)); RSB();
#pragma unroll
                for (int d2 = 0; d2 < 2; ++d2) { const int dt = 2 * bt + d2; R[dt] = R[dt] * cd;
#pragma unroll
                    for (int ks = 0; ks < 2; ++ks) R[dt] = __builtin_amdgcn_mfma_f32_16x16x32_bf16(ka[bt & 1][d2][ks], Vd[ks], R[dt], 0, 0, 0); }
                RSB(); }
#undef RET_LDK
#pragma unroll
            for (int mt = 0; mt < 4; ++mt)
#pragma unroll
                for (int q = 0; q < 4; ++q) OT[(16u * mt + 4u * g + q) * 132u + 16u * w + li] = Oa[mt][q];
            __syncthreads();
            { const unsigned tn = tidl >> 3, vg = tidl & 7u; f32x4 o[4]; float ssq = 0.f;
#pragma unroll
              for (int i = 0; i < 4; ++i) { o[i] = *(const LAS f32x4*)(OT + tn * 132u + 16u * vg + 4u * i); ssq += (o[i].x * o[i].x + o[i].y * o[i].y) + (o[i].z * o[i].z + o[i].w * o[i].w); }
              ssq += __shfl_xor(ssq, 1); ssq += __shfl_xor(ssq, 2); ssq += __shfl_xor(ssq, 4);
              const size_t go = (size_t)(row0 + (int)tn) * 2048 + h * 512 + vs * 128 + 16 * vg; bf16* op = O + go;
              if (RET_FOLD) { const v4u g0 = *(const v4u*)(SGp + go), g1 = *(const v4u*)(SGp + go + 8);
                  o[0].x *= bflo(g0.x); o[0].y *= bfhi(g0.x); o[0].z *= bflo(g0.y); o[0].w *= bfhi(g0.y); o[1].x *= bflo(g0.z); o[1].y *= bfhi(g0.z); o[1].z *= bflo(g0.w); o[1].w *= bfhi(g0.w);
                  o[2].x *= bflo(g1.x); o[2].y *= bfhi(g1.x); o[2].z *= bflo(g1.y); o[2].w *= bfhi(g1.y); o[3].x *= bflo(g1.z); o[3].y *= bfhi(g1.z); o[3].z *= bflo(g1.w); o[3].w *= bfhi(g1.w); }
              *(v4u*)op = pack8(o[0], o[1]); *(v4u*)(op + 8) = pack8(o[2], o[3]);
              if (vg == 0) SS[((size_t)(row0 + (int)tn) * 4 + h) * 4 + vs] = ssq; }
        }
    }
}
__device__ __forceinline__ void ret_scan_mfma2(Frame& F) {
    relaunder(F);
    const bf16* Q = (const bf16*)(F.ws + WS_R1); const bf16* K = (const bf16*)(F.ws + WS_R1 + 128 * MiB); const bf16* V = (const bf16*)(F.ws + WS_R1 + 256 * MiB);
    bf16* O = (bf16*)(F.ws + WS_R2); float* SS = (float*)(F.ws + WS_R2 + 256 * MiB); const bf16* SGp = (const bf16*)(F.ws + WS_R1 + 512 * MiB);
    LAS unsigned char* Qi = F.lds; LAS unsigned char* Ki = F.lds + 33792; LAS unsigned char* Vi = F.lds + 67584; LAS unsigned char* Si = F.lds + 101376; LAS unsigned char* OT = F.lds + 110592;
    const unsigned w = (unsigned)F.wave;
    for (int u = F.vcu; u < NBATCH * RT_H * 2; u += F.G) {
        const int bh = u >> 1, vs2 = u & 1, b = bh >> 2, h = bh & 3, cbase = h * 512 + vs2 * 256;
        const float lg2g = log2f(1.0f - exp2f(-5.0f - (float)h)), cd = exp2f(64.0f * lg2g);
        f32x4 R[2][16];
#pragma unroll
        for (int cb = 0; cb < 2; ++cb)
#pragma unroll
            for (int i = 0; i < 16; ++i) R[cb][i] = (f32x4){0.f, 0.f, 0.f, 0.f};
        v4u pq[4], pk[4], pv[4];
        { const int row0 = b * SEQ;
#pragma unroll
          for (int i = 0; i < 4; ++i) { const int p = F.tid + 512 * i, r = p >> 5, c32 = p & 31; pq[i] = *(const v4u*)(Q + (size_t)(row0 + r) * DM + h * 256 + c32 * 8); pk[i] = *(const v4u*)(K + (size_t)(row0 + r) * DM + h * 256 + c32 * 8);
              pv[i] = *(const v4u*)(V + (size_t)(row0 + r) * 2048 + cbase + c32 * 8); } }
        __syncthreads();
        for (int c = 0; c < SEQ / 64; ++c) {
            const int row0 = b * SEQ + 64 * c;
            unsigned tidl = (unsigned)F.tid; asm volatile("" : "+v"(tidl));
            const unsigned lane = tidl & 63u, g = lane >> 4, li = lane & 15u;
#pragma unroll
            for (int i = 0; i < 4; ++i) { const unsigned p = tidl + 512u * i, r = p >> 5, c32 = p & 31u; const unsigned o = r * RQS + 16u * c32; *(LAS v4u*)(Qi + o) = pq[i]; *(LAS v4u*)(Ki + o) = pk[i]; *(LAS v4u*)(Vi + o) = pv[i]; }
            __syncthreads();
            RSB();
            const unsigned rb128 = li * RQS + 16u * g, rb64 = li * RQS + 8u * g, trq = (8u * g + (li >> 2)) * RQS + 8u * (li & 3u);
            { const unsigned mt = w >> 1, nt0 = 2u * (w & 1u); f32x4 sa0 = (f32x4){0.f, 0.f, 0.f, 0.f}, sa1 = sa0;
              const LAS unsigned char* qrow = Qi + rb128 + mt * (16u * RQS); const LAS unsigned char* krow = Ki + rb128 + nt0 * (16u * RQS);
              bf16x8 qa[2][2], kb0[2][2], kb1[2][2];
#define RET_LDS(buf, s8b) do { _Pragma("unroll") for (int k2 = 0; k2 < 2; ++k2) { const int s8 = (s8b) + k2; \
                  qa[buf][k2] = *(const LAS bf16x8*)(qrow + 64 * s8); kb0[buf][k2] = *(const LAS bf16x8*)(krow + 64 * s8); kb1[buf][k2] = *(const LAS bf16x8*)(krow + 16 * RQS + 64 * s8); } } while (0)
              RET_LDS(0, 0); RSB();
#pragma unroll
              for (int bt = 0; bt < 4; ++bt) { if (bt < 3) RET_LDS((bt + 1) & 1, 2 * (bt + 1)); RSB();
#pragma unroll
                  for (int k2 = 0; k2 < 2; ++k2) { sa0 = __builtin_amdgcn_mfma_f32_16x16x32_bf16(qa[bt & 1][k2], kb0[bt & 1][k2], sa0, 0, 0, 0); sa1 = __builtin_amdgcn_mfma_f32_16x16x32_bf16(qa[bt & 1][k2], kb1[bt & 1][k2], sa1, 0, 0, 0); }
                  RSB(); }
#undef RET_LDS
#pragma unroll
              for (int q = 0; q < 4; ++q) { const int n = (int)(16u * mt + 4u * g) + q, m0 = (int)(16u * nt0 + li);
                  const float v0 = sa0[q] * __builtin_amdgcn_exp2f(fabsf((float)(n - m0)) * lg2g), v1 = sa1[q] * __builtin_amdgcn_exp2f(fabsf((float)(n - m0 - 16)) * lg2g); const unsigned pk_ = pk2(v0, v1);
                  *(LAS unsigned short*)(Si + (unsigned)n * 144u + 2u * (unsigned)m0) = (unsigned short)(pk_ & 0xffffu); *(LAS unsigned short*)(Si + (unsigned)n * 144u + 2u * (unsigned)m0 + 32u) = (unsigned short)(pk_ >> 16); } }
            RSB();
            f32x4 Oa[4][2];
#pragma unroll
            for (int mt = 0; mt < 4; ++mt) { Oa[mt][0] = (f32x4){0.f, 0.f, 0.f, 0.f}; Oa[mt][1] = Oa[mt][0]; }
            { v2u qlo[2][4], qhi[2][4]; const LAS unsigned char* qp = Qi + rb64;
#define RET_LDQ(buf, s8) do { _Pragma("unroll") for (int mt = 0; mt < 4; ++mt) { qlo[buf][mt] = *(const LAS v2u*)(qp + mt * (16 * RQS) + 64 * (s8)); qhi[buf][mt] = *(const LAS v2u*)(qp + mt * (16 * RQS) + 64 * (s8) + 32); } } while (0)
              RET_LDQ(0, 0); RSB();
#pragma unroll
              for (int s8 = 0; s8 < 8; ++s8) { if (s8 < 7) RET_LDQ((s8 + 1) & 1, s8 + 1); RSB();
                  bf16x8 Rb[2];
#pragma unroll
                  for (int cb = 0; cb < 2; ++cb) { const v4u rt = (v4u){pk2(R[cb][2 * s8][0], R[cb][2 * s8][1]), pk2(R[cb][2 * s8][2], R[cb][2 * s8][3]), pk2(R[cb][2 * s8 + 1][0], R[cb][2 * s8 + 1][1]), pk2(R[cb][2 * s8 + 1][2], R[cb][2 * s8 + 1][3])}; Rb[cb] = __builtin_bit_cast(bf16x8, rt); }
#pragma unroll
                  for (int mt = 0; mt < 4; ++mt) { const v4u av = (v4u){qlo[s8 & 1][mt].x, qlo[s8 & 1][mt].y, qhi[s8 & 1][mt].x, qhi[s8 & 1][mt].y};
                      Oa[mt][0] = __builtin_amdgcn_mfma_f32_16x16x32_bf16(__builtin_bit_cast(bf16x8, av), Rb[0], Oa[mt][0], 0, 0, 0); Oa[mt][1] = __builtin_amdgcn_mfma_f32_16x16x32_bf16(__builtin_bit_cast(bf16x8, av), Rb[1], Oa[mt][1], 0, 0, 0); }
                  RSB(); }
#undef RET_LDQ
            }
#pragma unroll
            for (int mt = 0; mt < 4; ++mt)
#pragma unroll
                for (int q = 0; q < 4; ++q) { const float sc = __builtin_amdgcn_exp2f((float)(16 * mt + 4 * (int)g + q + 1) * lg2g); Oa[mt][0][q] *= sc; Oa[mt][1][q] *= sc; }
            __syncthreads();
            RSB();
            bf16x8 Vf[2][2];
#pragma unroll
            for (int cb = 0; cb < 2; ++cb)
#pragma unroll
                for (int ks = 0; ks < 2; ++ks) Vf[cb][ks] = tr_lin<RQS>(Vi + 64u * w + 32u * cb, trq, 0, ks);
#pragma unroll
            for (int mt = 0; mt < 4; ++mt) { const bf16x8 s0 = *(const LAS bf16x8*)(Si + (16u * mt + li) * 144u + 16u * g), s1 = *(const LAS bf16x8*)(Si + (16u * mt + li) * 144u + 64u + 16u * g);
#pragma unroll
                for (int cb = 0; cb < 2; ++cb) { Oa[mt][cb] = __builtin_amdgcn_mfma_f32_16x16x32_bf16(s0, Vf[cb][0], Oa[mt][cb], 0, 0, 0); Oa[mt][cb] = __builtin_amdgcn_mfma_f32_16x16x32_bf16(s1, Vf[cb][1], Oa[mt][cb], 0, 0, 0); } }
#pragma unroll
            for (int mt = 0; mt < 4; ++mt)
#pragma unroll
                for (int cb = 0; cb < 2; ++cb) { LAS unsigned char* op = OT + (16u * mt + 4u * g) * RQS + 2u * (32u * w + 16u * cb + li); const unsigned p0 = pk2(Oa[mt][cb][0], Oa[mt][cb][1]), p1 = pk2(Oa[mt][cb][2], Oa[mt][cb][3]);
                    *(LAS unsigned short*)(op) = (unsigned short)(p0 & 0xffffu); *(LAS unsigned short*)(op + RQS) = (unsigned short)(p0 >> 16); *(LAS unsigned short*)(op + 2 * RQS) = (unsigned short)(p1 & 0xffffu); *(LAS unsigned short*)(op + 3 * RQS) = (unsigned short)(p1 >> 16); }
            { const int rn = (c + 1 < SEQ / 64) ? row0 + 64 : row0;
#pragma unroll
                for (int i = 0; i < 4; ++i) { const unsigned p = tidl + 512u * i, r = p >> 5, c32 = p & 31u; pq[i] = *(const v4u*)(Q + (size_t)(rn + (int)r) * DM + h * 256 + c32 * 8); pk[i] = *(const v4u*)(K + (size_t)(rn + (int)r) * DM + h * 256 + c32 * 8);
                    pv[i] = *(const v4u*)(V + (size_t)(rn + (int)r) * 2048 + cbase + c32 * 8); } }
            RSB();
            bf16x8 Vd[2][2];
#pragma unroll
            for (int ks = 0; ks < 2; ++ks) { float f[8];
#pragma unroll
                for (int j = 0; j < 8; ++j) f[j] = __builtin_amdgcn_exp2f((float)(63 - (32 * ks + 8 * (int)g + j)) * lg2g);
#pragma unroll
                for (int cb = 0; cb < 2; ++cb) { const v4u vv = __builtin_bit_cast(v4u, Vf[cb][ks]);
                    const v4u sv = (v4u){pk2(bflo(vv.x) * f[0], bfhi(vv.x) * f[1]), pk2(bflo(vv.y) * f[2], bfhi(vv.y) * f[3]), pk2(bflo(vv.z) * f[4], bfhi(vv.z) * f[5]), pk2(bflo(vv.w) * f[6], bfhi(vv.w) * f[7])};
                    Vd[cb][ks] = __builtin_bit_cast(bf16x8, sv); } }
            {
#pragma unroll
              for (int bt = 0; bt < 8; ++bt) { bf16x8 ka[2][2];
#pragma unroll
                  for (int d2 = 0; d2 < 2; ++d2)
#pragma unroll
                      for (int ks = 0; ks < 2; ++ks) ka[d2][ks] = tr_lin<RQS>(Ki, trq, 2 * bt + d2, ks);
#pragma unroll
                  for (int d2 = 0; d2 < 2; ++d2) { const int dt = 2 * bt + d2;
#pragma unroll
                      for (int cb = 0; cb < 2; ++cb) { R[cb][dt] = R[cb][dt] * cd;
#pragma unroll
                          for (int ks = 0; ks < 2; ++ks) R[cb][dt] = __builtin_amdgcn_mfma_f32_16x16x32_bf16(ka[d2][ks], Vd[cb][ks], R[cb][dt], 0, 0, 0); } }
              }
            }
            __syncthreads();
            { const unsigned tn = tidl >> 3, vg = tidl & 7u; float ssq = 0.f;
              const size_t go = (size_t)(row0 + (int)tn) * 2048 + cbase + 32 * vg; bf16* op = O + go;
              v4u sg[4];
#pragma unroll
              for (int i = 0; i < 4; ++i) sg[i] = *(const v4u*)(SGp + go + 8 * i);
#pragma unroll
              for (int i = 0; i < 4; ++i) { const v4u r_ = *(const LAS v4u*)(OT + tn * RQS + 64u * vg + 16u * i); f32x4 o0 = (f32x4){bflo(r_.x), bfhi(r_.x), bflo(r_.y), bfhi(r_.y)}, o1 = (f32x4){bflo(r_.z), bfhi(r_.z), bflo(r_.w), bfhi(r_.w)};
                  ssq += (o0.x * o0.x + o0.y * o0.y) + (o0.z * o0.z + o0.w * o0.w) + (o1.x * o1.x + o1.y * o1.y) + (o1.z * o1.z + o1.w * o1.w);
                  const v4u gq = sg[i]; o0.x *= bflo(gq.x); o0.y *= bfhi(gq.x); o0.z *= bflo(gq.y); o0.w *= bfhi(gq.y); o1.x *= bflo(gq.z); o1.y *= bfhi(gq.z); o1.z *= bflo(gq.w); o1.w *= bfhi(gq.w);
                  *(v4u*)(op + 8 * i) = pack8(o0, o1); }
              ssq += __shfl_xor(ssq, 1); ssq += __shfl_xor(ssq, 2);
              if ((vg & 3u) == 0u) SS[((size_t)(row0 + (int)tn) * 4 + h) * 4 + 2 * vs2 + (int)(vg >> 2)] = ssq; }
        }
    }
}
__device__ __forceinline__ void ret_norm(Frame& F, bool dry = false) {
    relaunder(F);
    bf16* O = (bf16*)(F.ws + WS_R2); bf16* Od = dry ? (bf16*)(F.ws + WS_R2 + 288 * MiB) : O; const float* SS = (const float*)(F.ws + WS_R2 + 256 * MiB); const bf16* SG = (const bf16*)(F.ws + WS_R1 + 512 * MiB);
    const int gw = F.vcu * NWAVES + F.wave, NGW = F.G * NWAVES;
    for (int row = gw; row < MTOK; row += NGW) {
        float r[4];
#pragma unroll
        for (int h = 0; h < 4; ++h) { const f32x4 p = *(const f32x4*)(SS + ((size_t)row * 4 + h) * 4); r[h] = 1.0f / sqrtf(((p.x + p.y) + (p.z + p.w)) * (1.0f / 512.f) + EPS); }
#pragma unroll
        for (int j = 0; j < 4; ++j) { const size_t gi = (size_t)row * 2048 + 512 * j + 8 * F.lane; const v4u o = *(const v4u*)(O + gi), sg = *(const v4u*)(SG + gi); const float rr = r[j];
            v4u w; w.x = pk2(bflo(o.x) * rr * bflo(sg.x), bfhi(o.x) * rr * bfhi(sg.x)); w.y = pk2(bflo(o.y) * rr * bflo(sg.y), bfhi(o.y) * rr * bfhi(sg.y));
            w.z = pk2(bflo(o.z) * rr * bflo(sg.z), bfhi(o.z) * rr * bfhi(sg.z)); w.w = pk2(bflo(o.w) * rr * bflo(sg.w), bfhi(o.w) * rr * bfhi(sg.w));
            *(v4u*)(Od + gi) = w; }
    }
}

__device__ __forceinline__ bf16x8 pad8(s16x4 a) { return (bf16x8){a[0], a[1], a[2], a[3], 0, 0, 0, 0}; }
__device__ __forceinline__ void hgrn_scan_mfma(Frame& F, int j) {
    relaunder(F);
    const bf16* Q = (const bf16*)(F.ws + WS_R1); const bf16* LFb = (const bf16*)(F.ws + WS_R1 + 128 * MiB); const bf16* V = (const bf16*)(F.ws + WS_R1 + 256 * MiB); const bf16* SG = (const bf16*)(F.ws + WS_R1 + 384 * MiB);
    bf16* O = (bf16*)(F.ws + WS_R2);
    LAS unsigned char* QEi = F.lds; LAS unsigned char* QE2i = F.lds + 17408; LAS unsigned char* KEi = F.lds + 34816; LAS unsigned char* Vi = F.lds + 52224;
    LAS float* BL = (LAS float*)(F.lds + 69632); LAS float* OT = (LAS float*)(F.lds + 71680);
    const unsigned w = (unsigned)F.wave;
    LAS float* GT = (LAS float*)(F.lds + 105472);
    if (F.tid < 128) GT[F.tid] = KIN(I_HGAIN)[j * 128 + F.tid];
    for (int u = F.vcu; u < NBATCH * HG_H; u += F.G) {
        const int b = u >> 3, h = u & 7;
        f32x4 S[8];
#pragma unroll
        for (int i = 0; i < 8; ++i) S[i] = (f32x4){0.f, 0.f, 0.f, 0.f};
        unsigned short plf[16], pq[16]; v4u pv[2];
        { const int kbp = F.tid >> 7, dp = F.tid & 127, row0 = b * SEQ;
#pragma unroll
          for (int t = 0; t < 16; ++t) { const size_t gi = (size_t)(row0 + 16 * kbp + t) * DM + h * 128 + dp; plf[t] = LFb[gi]; pq[t] = Q[gi]; }
#pragma unroll
          for (int i = 0; i < 2; ++i) { const int p = F.tid + 512 * i, r = p >> 4, c16 = p & 15; pv[i] = *(const v4u*)(V + (size_t)(row0 + r) * DM + h * 128 + c16 * 8); }
        }
        __syncthreads();
        for (int c = 0; c < SEQ / 64; ++c) {
            const int row0 = b * SEQ + 64 * c;
            unsigned tidl = (unsigned)F.tid; asm volatile("" : "+v"(tidl));
            const unsigned lane = tidl & 63u, g = lane >> 4, li = lane & 15u, kbp = tidl >> 7, dp = tidl & 127u;
            { float bs = 0.f, bsv[16];
#pragma unroll
              for (int t = 0; t < 16; ++t) { bs += bf2f(plf[t]); bsv[t] = bs; }
              const float bl = bsv[15], ebl = __builtin_amdgcn_exp2f(bl); const unsigned a0 = (16u * kbp) * RVS + 2u * dp;
              float eprev = ebl;
#pragma unroll
              for (int t = 0; t < 16; ++t) { const float bt = bsv[t], q = bf2f(pq[t]), e1 = __builtin_amdgcn_exp2f(bl - bt), ke = e1 - eprev; eprev = e1;
                  const unsigned w0 = pk2(q * __builtin_amdgcn_exp2f(bt), q * __builtin_amdgcn_exp2f(fminf(bt - bl, 115.f))), w1 = pk2(ke, 0.f);
                  *(LAS unsigned short*)(QEi + a0 + t * RVS) = (unsigned short)(w0 & 0xffffu); *(LAS unsigned short*)(QE2i + a0 + t * RVS) = (unsigned short)(w0 >> 16); *(LAS unsigned short*)(KEi + a0 + t * RVS) = (unsigned short)(w1 & 0xffffu); }
              BL[kbp * 128u + dp] = ebl; }
#pragma unroll
            for (int i = 0; i < 2; ++i) { const unsigned p = tidl + 512u * i, r = p >> 4, c16 = p & 15u; *(LAS v4u*)(Vi + r * RVS + 16u * c16) = pv[i]; }
            __syncthreads();
            const v4u csg0 = *(const v4u*)(SG + (size_t)(row0 + (int)(tidl >> 3)) * DM + h * 128 + 16 * (tidl & 7u)), csg1 = *(const v4u*)(SG + (size_t)(row0 + (int)(tidl >> 3)) * DM + h * 128 + 16 * (tidl & 7u) + 8);
            asm volatile("" ::: "memory");
            { const int rn = (c + 1 < SEQ / 64) ? row0 + 64 : row0;
#pragma unroll
                for (int t = 0; t < 16; ++t) { const unsigned vo = ((16u * kbp + (unsigned)t) * DM + dp) * 2u;
                    plf[t] = *(const unsigned short*)((const char*)(LFb + (size_t)rn * DM + h * 128) + vo); pq[t] = *(const unsigned short*)((const char*)(Q + (size_t)rn * DM + h * 128) + vo); }
#pragma unroll
                for (int i = 0; i < 2; ++i) { const unsigned p = tidl + 512u * i, r = p >> 4, c16 = p & 15u; pv[i] = *(const v4u*)(V + (size_t)(rn + (int)r) * DM + h * 128 + c16 * 8); }
            }
            RSB();
            const unsigned rb128 = li * RVS + 16u * g, rb64 = li * RVS + 8u * g, trb = (4u * g + (li >> 2)) * RVS + 8u * (li & 3u);
            f32x4 P[4];
            { bf16x8 kef[2][4], q2f[2][4];
#define HG_LDP(buf, kb_) do { _Pragma("unroll") for (int s4 = 0; s4 < 4; ++s4) { kef[buf][s4] = *(const LAS bf16x8*)(KEi + (kb_) * (16u * RVS) + rb128 + 64 * s4); q2f[buf][s4] = *(const LAS bf16x8*)(QE2i + (kb_) * (16u * RVS) + rb128 + 64 * s4); } } while (0)
              HG_LDP(0, 0); RSB();
#pragma unroll
              for (int kb = 0; kb < 4; ++kb) { if (kb < 3) HG_LDP((kb + 1) & 1, kb + 1); RSB();
                  f32x4 p_ = (f32x4){0.f, 0.f, 0.f, 0.f};
#pragma unroll
                  for (int s4 = 0; s4 < 4; ++s4) p_ = __builtin_amdgcn_mfma_f32_16x16x32_bf16(kef[kb & 1][s4], q2f[kb & 1][s4], p_, 0, 0, 0);
                  P[kb] = p_; RSB(); }
#undef HG_LDP
            }
            { v2u qlo[2][4], qhi[2][4]; s16x4 Vbb[2];
#define HG_LDQ(buf, kb_) do { Vbb[buf] = __builtin_amdgcn_ds_read_tr16_b64_v4i16((LAS s16x4*)(Vi + (kb_) * (16u * RVS) + trb + 32u * w)); \
                  _Pragma("unroll") for (int s4 = 0; s4 < 4; ++s4) { qlo[buf][s4] = *(const LAS v2u*)(QEi + (kb_) * (16u * RVS) + rb64 + 64 * s4); qhi[buf][s4] = *(const LAS v2u*)(QEi + (kb_) * (16u * RVS) + rb64 + 64 * s4 + 32); } } while (0)
              HG_LDQ(0, 0); RSB();
#pragma unroll
              for (int kb = 0; kb < 4; ++kb) {
                  const unsigned ko = kb * (16u * RVS);
                  s16x4 ktf[8]; f32x4 e4[8];
#pragma unroll
                  for (int dt = 0; dt < 8; ++dt) { ktf[dt] = __builtin_amdgcn_ds_read_tr16_b64_v4i16((LAS s16x4*)(KEi + ko + trb + 32 * dt)); e4[dt] = *(const LAS f32x4*)(BL + kb * 128u + 16u * dt + 4u * g); }
                  if (kb < 3) HG_LDQ((kb + 1) & 1, kb + 1);
                  RSB();
                  f32x4 oa = (f32x4){0.f, 0.f, 0.f, 0.f};
#pragma unroll
                  for (int s4 = 0; s4 < 4; ++s4) {
                      const v4u st = (v4u){pk2(S[2 * s4][0], S[2 * s4][1]), pk2(S[2 * s4][2], S[2 * s4][3]), pk2(S[2 * s4 + 1][0], S[2 * s4 + 1][1]), pk2(S[2 * s4 + 1][2], S[2 * s4 + 1][3])};
                      const v4u av = (v4u){qlo[kb & 1][s4].x, qlo[kb & 1][s4].y, qhi[kb & 1][s4].x, qhi[kb & 1][s4].y};
                      oa = __builtin_amdgcn_mfma_f32_16x16x32_bf16(__builtin_bit_cast(bf16x8, av), __builtin_bit_cast(bf16x8, st), oa, 0, 0, 0); }
                  s16x4 a16;
                  { const f32x4 Pk = P[kb]; const unsigned lo = pk2((4u * g + 0u <= li) ? Pk[0] : 0.f, (4u * g + 1u <= li) ? Pk[1] : 0.f), hi = pk2((4u * g + 2u <= li) ? Pk[2] : 0.f, (4u * g + 3u <= li) ? Pk[3] : 0.f); const v2u t2 = (v2u){lo, hi}; a16 = __builtin_bit_cast(s16x4, t2); }
                  const bf16x8 Vb8 = pad8(Vbb[kb & 1]);
                  oa = __builtin_amdgcn_mfma_f32_16x16x32_bf16(pad8(a16), Vb8, oa, 0, 0, 0);
#pragma unroll
                  for (int dt = 0; dt < 8; ++dt) S[dt] = __builtin_amdgcn_mfma_f32_16x16x32_bf16(pad8(ktf[dt]), Vb8, S[dt] * e4[dt], 0, 0, 0);
#pragma unroll
                  for (int q = 0; q < 4; ++q) OT[(16u * kb + 4u * g + q) * 132u + 16u * w + li] = oa[q];
                  RSB();
              }
#undef HG_LDQ
            }
            __syncthreads();
            { const unsigned tn = tidl >> 3, vg = tidl & 7u; f32x4 o[4]; float ss = 0.f;
#pragma unroll
              for (int i = 0; i < 4; ++i) { o[i] = *(const LAS f32x4*)(OT + tn * 132u + 16u * vg + 4u * i); ss += (o[i].x * o[i].x + o[i].y * o[i].y) + (o[i].z * o[i].z + o[i].w * o[i].w); }
              ss += __shfl_xor(ss, 1); ss += __shfl_xor(ss, 2); ss += __shfl_xor(ss, 4);
              const float r = 1.0f / sqrtf(ss * (1.0f / 128.f) + EPS);
#pragma unroll
              for (int i = 0; i < 4; ++i) o[i] = o[i] * r * *(const LAS f32x4*)(GT + 16u * vg + 4u * i);
              if (HGRN_OUT_FP8) {
                  f32x4 sgv[4] = {(f32x4){bflo(csg0.x), bfhi(csg0.x), bflo(csg0.y), bfhi(csg0.y)}, (f32x4){bflo(csg0.z), bfhi(csg0.z), bflo(csg0.w), bfhi(csg0.w)}, (f32x4){bflo(csg1.x), bfhi(csg1.x), bflo(csg1.y), bfhi(csg1.y)}, (f32x4){bflo(csg1.z), bfhi(csg1.z), bflo(csg1.w), bfhi(csg1.w)}};
                  v4u w8;
#pragma unroll
                  for (int i = 0; i < 4; ++i) { f32x4 t = o[i] * sgv[i] * 8.0f; t = __builtin_elementwise_min(__builtin_elementwise_max(t, (f32x4){-448.f, -448.f, -448.f, -448.f}), (f32x4){448.f, 448.f, 448.f, 448.f}); w8[i] = pk4_fp8(t.x, t.y, t.z, t.w); }
                  *(v4u*)((unsigned char*)O + (size_t)(row0 + (int)tn) * DM + h * 128 + 16 * vg) = w8;
              } else {
              v4u w0, w1;
              w0.x = pk2(o[0].x * bflo(csg0.x), o[0].y * bfhi(csg0.x)); w0.y = pk2(o[0].z * bflo(csg0.y), o[0].w * bfhi(csg0.y)); w0.z = pk2(o[1].x * bflo(csg0.z), o[1].y * bfhi(csg0.z)); w0.w = pk2(o[1].z * bflo(csg0.w), o[1].w * bfhi(csg0.w));
              w1.x = pk2(o[2].x * bflo(csg1.x), o[2].y * bfhi(csg1.x)); w1.y = pk2(o[2].z * bflo(csg1.y), o[2].w * bfhi(csg1.y)); w1.z = pk2(o[3].x * bflo(csg1.z), o[3].y * bfhi(csg1.z)); w1.w = pk2(o[3].z * bflo(csg1.w), o[3].w * bfhi(csg1.w));
              bf16* op = O + (size_t)(row0 + (int)tn) * DM + h * 128 + 16 * vg; *(v4u*)op = w0; *(v4u*)(op + 8) = w1; } }
        }
    }
}

struct Args { const void* in[22]; float* out; unsigned char* ws; int ph_lo, ph_hi; };
constexpr int PH_PER_LAYER = 9, NPHASES = 1 + DEPTH * PH_PER_LAYER + 1;

__global__ void __launch_bounds__(NWAVES * 64, 2) hybrid_fwd(Args args) {
    extern __shared__ __attribute__((aligned(16))) unsigned char lds[];
    Frame F;
    F.lds = (LAS unsigned char*)lds;
    F.tid = threadIdx.x; F.lane = F.tid & 63; F.wave = __builtin_amdgcn_readfirstlane(F.tid >> 6);
    F.G = gridDim.x; { const int bx = blockIdx.x; F.vcu = (F.G % 8 == 0) ? (bx % 8) * (F.G / 8) + bx / 8 : bx; }
    F.ws = args.ws; F.out = args.out; F.ctl = (unsigned*)(args.ws + WS_CTL);
    for (int u = F.tid; u < (LDS_BYTES - MISC_OFF) / 4; u += NWAVES * 64) ((LAS unsigned*)(F.lds + MISC_OFF))[u] = 0u;
    __syncthreads();
    const int lo = args.ph_lo, hi = args.ph_hi;
    XcdBarrier bar; bar.bar = F.ctl + CW_BAR; bar.x = 0; bar.st = nullptr;
    if (hi - lo > 1) bar = xcd_barrier_post(F.ctl + CW_BAR, (volatile LAS unsigned*)(F.lds + MISC_OFF) + 8);
#define IN(k) (lo <= (k) && (k) < hi)
#define SEAM(k) do { if (IN(k) && hi > (k) + 1) xcd_barrier(bar); } while (0)

    if (PH_EN(0) && IN(0)) { for (int rep = 0; rep < REPS(0); ++rep) p0_prologue(F); } SEAM(0);

#pragma unroll 1
    for (int l = 0; l < DEPTH; ++l) {
        const int pb = 1 + l * PH_PER_LAYER, j = l >> 1; const bool is_ret = (l & 1);
        if (PH_EN(1) && IN(pb + 0)) { row_phase1(F, l, 0); if (REPS(13) > 1 && l > 0) { __syncthreads(); row_phase1(F, l, 0, true); } }
        SEAM(pb + 0);
        if (IN(pb + 1)) {
            if (PH_EN(2) && !is_ret) {
                for (int rep = 0; rep < REPS(2); ++rep) {
                    if constexpr (HG_N8 > 0) {
                        pg8::Gemm g{(const bf16*)(F.ws + WS_H8), (const bf16*)(F.ws + WS_HWIN + (size_t)j * HG_N8 * DM), MTOK, HG_N8, DM / 2}; pg8::StaticOrder S; S.init(MTOK, HG_N8, F.G, (int)blockIdx.x);
                        const EpiHgrnIn E{F.ws + WS_R1, (const float*)(F.ws + WS_LBV) + j * DM, hg_smap(HGRN_FP8_MASK), 1.0f / 512.f};
                        pg8::gemm_phase<EpiHgrnIn, pg8::StaticOrder, true, true, false, true>(F.lds + RING_OFF, g, S, E); }
                    if constexpr (HG_N16 > 0) {
                        pg8::Gemm g{(const bf16*)(F.ws + WS_H), (const bf16*)(F.ws + WS_HWIN + 8 * MiB) + (size_t)j * HG_N16 * DM, MTOK, HG_N16, DM}; pg8::StaticOrder S; S.init(MTOK, HG_N16, F.G, (int)blockIdx.x);
                        const EpiHgrnIn E{F.ws + WS_R1, (const float*)(F.ws + WS_LBV) + j * DM, hg_smap(0xF & ~HGRN_FP8_MASK), 1.0f};
                        pg8::gemm_phase<EpiHgrnIn, pg8::StaticOrder, true, true>(F.lds + RING_OFF, g, S, E); }
                }
            } else if (PH_EN(3)) {
                pg8::StaticOrder S; S.init(MTOK, RT_N, F.G, (int)blockIdx.x);
                if constexpr (RET_IN_FP8) {
                    pg8::Gemm g{(const bf16*)(F.ws + WS_H8), (const bf16*)(F.ws + WS_RWIN + (size_t)j * RT_N * DM), MTOK, RT_N, DM / 2};
                    EpiRetIn E{F.ws + WS_R1, (const int*)kin_(I_POS), 1.0f / 512.f};
                    for (int rep = 0; rep < REPS(3); ++rep) pg8::gemm_phase<EpiRetIn, pg8::StaticOrder, true, true, false, true>(F.lds + RING_OFF, g, S, E);
                } else {
                    pg8::Gemm g{(const bf16*)(F.ws + WS_H), (const bf16*)(F.ws + WS_RWIN) + (size_t)j * RT_N * DM, MTOK, RT_N, DM};
                    EpiRetIn E{F.ws + WS_R1, (const int*)kin_(I_POS), 1.0f};
                    for (int rep = 0; rep < REPS(3); ++rep) pg8::gemm_phase<EpiRetIn, pg8::StaticOrder, true, true>(F.lds + RING_OFF, g, S, E);
                }
            }
        }
        SEAM(pb + 1);
        if (IN(pb + 2)) { if (!is_ret) { if (PH_EN(4)) { for (int rep = 0; rep < REPS(4); ++rep) { if (HGRN_MFMA) hgrn_scan_mfma(F, j); else hgrn_scan(F, j); } } } else { if (PH_EN(5)) { for (int rep = 0; rep < REPS(5); ++rep) { if (RET_MFMA && RET_WIDE && RET_FOLD) ret_scan_mfma2(F); else if (RET_MFMA) ret_scan_mfma(F); else ret_scan(F); } } } }
        SEAM(pb + 2);
        if (RET_MFMA && !RET_FOLD && PH_EN(12) && IN(pb + 3) && is_ret) { if (REPS(14) > 1) ret_norm(F, true); ret_norm(F); }
        if (RET_MFMA && !RET_FOLD && is_ret) SEAM(pb + 3);
        if (PH_EN(6) && IN(pb + 4)) {
            const int Ko = is_ret ? 2048 : DM;
            const bf16* Wt = is_ret ? (const bf16*)(F.ws + WS_RWOUT) + (size_t)j * DM * 2048 : (const bf16*)(F.ws + WS_HWOUT) + (size_t)j * DM * DM;
            pg8::Gemm g{(const bf16*)(F.ws + WS_R2), Wt, MTOK, DM, Ko}; pg8::StaticOrder S; S.init(MTOK, DM, F.G, (int)blockIdx.x);
            const float* gate1 = (const float*)(F.ws + WS_MOD) + (size_t)l * NBATCH * 6 * DM + 2 * DM; bf16* xb = (bf16*)(F.ws + WS_XB);
            if (REPS(15) > 1) { EpiOutT<false> Ed{l == 0 ? (const void*)(F.ws + WS_R1 + 512 * MiB) : (const void*)xb, (bf16*)(F.ws + WS_R1), gate1, 1.0f}; pg8::gemm_phase<EpiOutT<false>, pg8::StaticOrder, true, true>(F.lds + RING_OFF, g, S, Ed); }
            if (RET_MFMA && RET_FOLD && is_ret) { const pg8::HScale hs{(const float*)(F.ws + WS_R2 + 256 * MiB), (LAS float*)(F.lds + 131072), EPS}; const EpiOutT<false> E{xb, xb, gate1, 1.0f};
                pg8::gemm_phase<EpiOutT<false>, pg8::StaticOrder, true, true, false, false, false, true>(F.lds + RING_OFF, g, S, E, hs); }
            else if (HGRN_OUT_FP8 && !is_ret) { const pg8::Gemm g8{(const bf16*)(F.ws + WS_R2), (const bf16*)(F.ws + WS_HWOUT + (size_t)j * DM * DM), MTOK, DM, DM / 2};
                if (l == 0) { const EpiOutT<true> E{KIN(I_X), xb, gate1, 1.0f / 512.f}; pg8::gemm_phase<EpiOutT<true>, pg8::StaticOrder, true, true, false, true>(F.lds + RING_OFF, g8, S, E); }
                else { const EpiOutT<false> E{xb, xb, gate1, 1.0f / 512.f}; pg8::gemm_phase<EpiOutT<false>, pg8::StaticOrder, true, true, false, true>(F.lds + RING_OFF, g8, S, E); } }
            else if (l == 0) { const EpiOutT<true> E{KIN(I_X), xb, gate1, 1.0f}; pg8::gemm_phase<EpiOutT<true>, pg8::StaticOrder, true, true>(F.lds + RING_OFF, g, S, E); }
            else { const EpiOutT<false> E{xb, xb, gate1, 1.0f}; pg8::gemm_phase<EpiOutT<false>, pg8::StaticOrder, true, true>(F.lds + RING_OFF, g, S, E); }
        }
        SEAM(pb + 4);
        if (PH_EN(7) && IN(pb + 5)) { if (REPS(18) > 1) row_phase2(F, l, true); row_phase2(F, l); }
        SEAM(pb + 5);
        if (MOE_GATHER_PASS) { if (PH_EN(8) && IN(pb + 6)) { for (int rep = 0; rep < REPS(8); ++rep) moe_gather(F, l); } SEAM(pb + 6); }
        if (PH_EN(9) && IN(pb + 7)) {
            build_tiles(F, l);
            if (!MOE_GATHER_PASS) moe_build_tt(F, 8);
            pg8::MoeOrder S{8, F.G, F.vcu, (const LAS int*)(F.lds + TAB_OFF), (const LAS unsigned short*)(F.lds + 131072)};
            if constexpr (MOE_FP8) {
                static_assert(!MOE_FP8 || !MOE_GATHER_PASS, "the fp8 expert GEMM gathers while staging");
                pg8::Gemm g{(const bf16*)(F.ws + WS_H8), (const bf16*)(F.ws + WS_W1T + (size_t)l * NEXP * 2048 * DM), 0, 0, DM / 2};
                EpiMoe1F8 E{F.ws + WS_R2, KIN(I_B1) + (size_t)l * NEXP * 2048};
                for (int rep = 0; rep < REPS(9); ++rep) pg8::gemm_phase<EpiMoe1F8, pg8::MoeOrder, MOE_ALIGN, true, true, true>(F.lds + RING_OFF, g, S, E);
                if (REPS(12) > 1) pg8::gemm_phase<EpiMoe1F8, pg8::MoeOrder, true, true, true, true, true>(F.lds + RING_OFF, g, S, E);
            } else {
                pg8::Gemm g{(const bf16*)(F.ws + (MOE_GATHER_PASS ? WS_R1 : WS_H)), (const bf16*)(F.ws + WS_W1T) + (size_t)l * NEXP * 2048 * DM, 0, 0, DM};
                EpiMoe1 E{(bf16*)(F.ws + WS_R2), KIN(I_B1) + (size_t)l * NEXP * 2048};
                for (int rep = 0; rep < REPS(9); ++rep) pg8::gemm_phase<EpiMoe1, pg8::MoeOrder, true, true, !MOE_GATHER_PASS>(F.lds + RING_OFF, g, S, E);
            }
        }
        SEAM(pb + 7);
        if (PH_EN(10) && IN(pb + 8)) {
            build_tiles(F, l);
            pg8::MoeOrder S{4, F.G, F.vcu, (const LAS int*)(F.lds + TAB_OFF), nullptr};
            if (SKEW_TICKS) phase_skew(F, SKEW_TICKS);
            if constexpr (MOE_FP8) {
                pg8::Gemm g{(const bf16*)(F.ws + WS_R2), (const bf16*)(F.ws + WS_W2T + (size_t)l * NEXP * DM * DM), 0, 0, DM / 2};
                EpiMoe2Y8 E{F.ws + WS_R1, KIN(I_B2) + (size_t)l * NEXP * DM, 1.0f / 256.f};
                for (int rep = 0; rep < REPS(10); ++rep) pg8::gemm_phase<EpiMoe2Y8, pg8::MoeOrder, MOE_ALIGN, true, false, true>(F.lds + RING_OFF, g, S, E);
            } else {
                pg8::Gemm g{(const bf16*)(F.ws + WS_R2), (const bf16*)(F.ws + WS_W2T) + (size_t)l * NEXP * DM * DM, 0, 0, DM};
                EpiMoe2 E{(bf16*)(F.ws + WS_R1), KIN(I_B2) + (size_t)l * NEXP * DM, 1.0f};
                for (int rep = 0; rep < REPS(10); ++rep) pg8::gemm_phase<EpiMoe2, pg8::MoeOrder, true, true>(F.lds + RING_OFF, g, S, E);
            }
        }
        SEAM(pb + 8);
    }
    if (PH_EN(11) && IN(NPHASES - 1)) row_phase1(F, DEPTH, 1);
#undef IN
#undef SEAM
}

extern "C" void kernel_launch(void* const* d_in, const int* in_sizes, int n_in, void* d_out, int out_size, void* d_ws, size_t ws_size, hipStream_t stream) {
    static int grid = 0;
    if (grid == 0) {
        if (n_in != 22 || in_sizes[0] != MTOK * DM || out_size != MTOK * DM || ws_size < WS_END) { fprintf(stderr, "kernel_launch: unexpected shapes (n_in %d, in0 %d, out %d, ws %zu < %zu)\n", n_in, n_in > 0 ? in_sizes[0] : -1, out_size, ws_size, (size_t)WS_END); grid = -1; return; }
        int dev = 0, cus = 0, per_cu = 0;
        if (hipGetDevice(&dev) != hipSuccess || hipDeviceGetAttribute(&cus, hipDeviceAttributeMultiprocessorCount, dev) != hipSuccess) { grid = -1; return; }
        if (hipFuncSetAttribute((const void*)hybrid_fwd, hipFuncAttributeMaxDynamicSharedMemorySize, LDS_BYTES) != hipSuccess) { fprintf(stderr, "kernel_launch: hipFuncSetAttribute failed\n"); grid = -1; return; }
        if (hipOccupancyMaxActiveBlocksPerMultiprocessor(&per_cu, (const void*)hybrid_fwd, NWAVES * 64, LDS_BYTES) != hipSuccess || per_cu < 1) { fprintf(stderr, "kernel_launch: occupancy query says %d blocks per CU\n", per_cu); }
        (void)hipGetLastError();
        if (cus != 256) { fprintf(stderr, "kernel_launch: built for a 256-CU device (one workgroup per CU); this one reports %d; nothing launched\n", cus); grid = -1; return; }
        grid = cus;
    }
    if (grid < 0) return;
    (void)hipMemsetAsync((char*)d_ws + WS_CTL, 0, CTL_ZERO_BYTES, stream);
    Args a{};
    for (int i = 0; i < 22; ++i) a.in[i] = d_in[i];
    a.out = (float*)d_out; a.ws = (unsigned char*)d_ws;
#if MK_SPLIT
    for (int p = 0; p < DBG_LIMIT; ++p) {
        if (p >= 1 && p < NPHASES - 1 && ((p - 1) % PH_PER_LAYER) == 3 && (!RET_MFMA || RET_FOLD || (((p - 1) / PH_PER_LAYER) & 1) == 0)) continue;
        if (!MOE_GATHER_PASS && p >= 1 && p < NPHASES - 1 && ((p - 1) % PH_PER_LAYER) == 6) continue;
        a.ph_lo = p; a.ph_hi = p + 1;
        hipLaunchKernelGGL(hybrid_fwd, dim3(grid), dim3(NWAVES * 64), LDS_BYTES, stream, a);
    }
#else
    a.ph_lo = 0; a.ph_hi = NPHASES;
    hipLaunchKernelGGL(hybrid_fwd, dim3(grid), dim3(NWAVES * 64), LDS_BYTES, stream, a);
#endif
    const hipError_t le = hipPeekAtLastError();
    if (le != hipSuccess) fprintf(stderr, "kernel_launch: launch failed: %s\n", hipGetErrorName(le));
}
```

```cpp
#include <hip/hip_runtime.h>
#include <cstdio>
#include <cstdint>

#ifndef ONLY_PH
#define ONLY_PH -1
#endif
#define PH_EN(n) (ONLY_PH < 0 || ONLY_PH == (n))
#ifndef DBG_LIMIT
#define DBG_LIMIT NPHASES
#endif
#ifndef RET_MFMA
#define RET_MFMA 1
#endif
#ifndef HGRN_MFMA
#define HGRN_MFMA 1
#endif
#ifndef REPEAT_MASK
#define REPEAT_MASK 0
#endif
#define REPS(k) (1 + ((REPEAT_MASK >> (k)) & 1))
#ifndef MOE_GATHER_PASS
#define MOE_GATHER_PASS 0
#endif
#ifndef MOE_FP8
#define MOE_FP8 1
#endif
#ifndef SKEW_TICKS
#define SKEW_TICKS 0
#endif
#ifndef HGRN_FP8_MASK
#define HGRN_FP8_MASK 0xF
#endif
#ifndef RET_WIDE
#define RET_WIDE 1
#endif
#ifndef HGRN_OUT_FP8
#define HGRN_OUT_FP8 1
#endif
#ifndef RET_IN_FP8
#define RET_IN_FP8 1
#endif
#ifndef MOE_ALIGN
#define MOE_ALIGN true
#endif
#ifndef RET_FOLD
#define RET_FOLD 1
#endif
#ifndef MK_SPLIT
#define MK_SPLIT 0
#endif

namespace pg8 {
#define PG8_LAS __attribute__((address_space(3)))
typedef unsigned short bf16_t;
typedef short bf16x8 __attribute__((ext_vector_type(8)));
typedef float f32x4 __attribute__((ext_vector_type(4)));
typedef unsigned u32x4 __attribute__((ext_vector_type(4)));
constexpr int BM = 256, BK = 64, HALF = 128, HTB = HALF * BK * 2  , STAGE_BYTES = 8 * HTB, NXCD = 8, WGM = 8;

__host__ __device__ __forceinline__ int lds_byte(int r, int c) { const int st = (r >> 4) * 2 + (c >> 5), rr = r & 15, cc = c & 31, ob = rr * 64 + cc * 2; return st * 1024 + (ob ^ (((ob >> 9) & 1) << 5)); }
__host__ __device__ __forceinline__ void stage_rc(int b, int& R, int& C) { const int st = b / 1024, sb = b % 1024, swz = sb ^ (((sb >> 9) & 1) << 5); R = (st >> 1) * 16 + swz / 64; C = (st & 1) * 32 + (swz % 64) / 2; }
__host__ __device__ __forceinline__ int perm32(int rho) { const int n = rho >> 4, i = rho & 15; return 8 * (i >> 2) + 4 * n + (i & 3); }

struct Unit { int pm, pn, e, nn; };
struct Gemm { const bf16_t* A; const bf16_t* Bt; int M, N, K; };

struct StaticOrder {
    int nM, nN, nwg, G, c;
    __host__ __device__ void init(int M, int N, int G_, int c_) { nM = M / BM; nN = N / BM; nwg = nM * nN; G = G_; c = c_; }
    __host__ __device__ bool next(int i, Unit& u) const {
        const long L = (long)i * G + c; if (L >= nwg) return false;
        int wgid = (int)L; { const int q = nwg / NXCD, r = nwg % NXCD, xcd = wgid % NXCD, off = wgid / NXCD; wgid = (xcd < r ? xcd * (q + 1) : r * (q + 1) + (xcd - r) * q) + off; }
        const int nig = WGM * nN, gid = wgid / nig, fm = gid * WGM, gsz = (nM - fm) < WGM ? (nM - fm) : WGM;
        u.pm = fm + ((wgid % nig) % gsz); u.pn = (wgid % nig) / gsz; u.e = 0; u.nn = u.pn; return true;
    }
    __device__ __forceinline__ unsigned tok(int, int) const { return 0u; }
    __device__ __forceinline__ void a_ready(const Unit&) const {}
    __device__ __forceinline__ void done(const Unit&) const {}
};
struct MoeOrder {
    int nN, G, c; const PG8_LAS int* ts; const PG8_LAS unsigned short* tt;
    __device__ __forceinline__ unsigned tok(int i, int r) const { return tt[i * 256 + r]; }
    __device__ __forceinline__ bool next(int i, Unit& u) const {
        const int NT = ts[32]; const long L = (long)i * G + c; if (L >= (long)NT * nN) return false;
        const int mt = (int)(L / nN), n = (int)(L % nN); int e = 0;
        for (int k = 1; k < 32; ++k) e += (ts[k] <= mt) ? 1 : 0;
        u.pm = mt; u.pn = e * nN + n; u.e = e; u.nn = n; return true;
    }
    __device__ __forceinline__ void a_ready(const Unit&) const {}
    __device__ __forceinline__ void done(const Unit&) const {}
};

typedef float cvt_f2_ __attribute__((ext_vector_type(2)));
typedef __bf16 cvt_b2_ __attribute__((ext_vector_type(2)));
__device__ __forceinline__ unsigned cvt_pk_bf16(float lo, float hi) { const cvt_f2_ v = {lo, hi}; const cvt_b2_ r = __builtin_convertvector(v, cvt_b2_); return __builtin_bit_cast(unsigned, r); }

template <int N> __device__ __forceinline__ void wait_vm() { asm volatile("s_waitcnt vmcnt(%0)" :: "n"(N) : "memory"); }
typedef int v8i32 __attribute__((ext_vector_type(8)));
struct HScale { const float* ss; PG8_LAS float* tab; float eps; };
template <int OFF> __device__ __forceinline__ v8i32 lds_frag32_asm(unsigned addr) {
    u32x4 lo, hi;
    asm volatile("ds_read_b128 %0, %2 offset:%3\n\tds_read_b128 %1, %2 offset:%4" : "=&v"(lo), "=&v"(hi) : "v"(addr), "n"(OFF), "n"(OFF + 1024));
    return __builtin_bit_cast(v8i32, __builtin_shufflevector(lo, hi, 0, 1, 2, 3, 4, 5, 6, 7));
}
template <class Epi, class Sched, bool ALIGN_EPI = false, bool SP2 = false, bool GATHER = false, bool FP8 = false, bool NOEPI = false, bool HSCALE = false>
__device__ __forceinline__ void gemm_phase(PG8_LAS unsigned char* lds, const Gemm g, const Sched& S, const Epi& E, const HScale hs = HScale{nullptr, nullptr, 0.f}) {
    int tid_ = threadIdx.x; asm volatile("" : "+v"(tid_));
    const int tid = tid_, wid = __builtin_amdgcn_readfirstlane(tid >> 6), lane = tid & 63, wr = wid >> 2, wc = wid & 3, fr = lane & 15, fq = lane >> 4;
    const int K = g.K, nt = K / BK;
    unsigned voffA[2], voffB[2];
#pragma unroll
    for (int i = 0; i < 2; ++i) { int R, C; stage_rc(tid * 16 + i * 8192, R, C); const int Rb = Epi::PERM ? ((R & ~31) + perm32(R & 31)) : R;
        voffA[i] = (unsigned)(R * K + C) * 2u; voffB[i] = (unsigned)(Rb * K + C) * 2u; }
    int gR[2]; unsigned gC[2];
#pragma unroll
    for (int i = 0; i < 2; ++i) { int R, C; stage_rc(tid * 16 + i * 8192, R, C); gR[i] = R; gC[i] = (unsigned)C * 2u; }
#define PG8_GVOFF(v, ui_, h_) do { _Pragma("unroll") for (int _i = 0; _i < 2; ++_i) v[_i] = (S.tok((ui_), gR[_i] + HALF * (h_)) * (unsigned)(K * 2)) + gC[_i]; } while (0)
    const size_t kstep = (size_t)(BK * 2);
    const size_t hstep = (size_t)HALF * K * 2;
    const size_t tstep = 2 * hstep;
    const unsigned ldsw = (unsigned)wid * 1024u;
    const int aoff = lds_byte(wr * 64 + fr, fq * 8), boff = lds_byte(wc * 32 + fr, fq * 8);
    const unsigned lda_ = (unsigned)(__UINTPTR_TYPE__)(lds + aoff), ldb_ = (unsigned)(__UINTPTR_TYPE__)(lds + boff) + 65536u;

#define PG8_SA(b, h) (((b) * 2 + (h)) * HTB)
#define PG8_SB(b, h) ((4 + (b) * 2 + (h)) * HTB)
#define PG8_STAGE(bufoff, gbase, voff) do { _Pragma("unroll") for (int _i = 0; _i < 2; ++_i) \
        __builtin_amdgcn_global_load_lds((const unsigned*)((const char*)(gbase) + (voff)[_i]), (PG8_LAS unsigned*)(lds + (bufoff) + ldsw + _i * 8192), 16, 0, 0); } while (0)
#define PG8_LDA(dst, b, h) do { if constexpr (FP8) { dst##8[0] = lds_frag32_asm<PG8_SA(b, h)>(lda_); dst##8[1] = lds_frag32_asm<PG8_SA(b, h) + 2048>(lda_); dst##8[2] = lds_frag32_asm<PG8_SA(b, h) + 4096>(lda_); dst##8[3] = lds_frag32_asm<PG8_SA(b, h) + 6144>(lda_); } \
    else { _Pragma("unroll") for (int m = 0; m < 4; ++m) _Pragma("unroll") for (int k = 0; k < 2; ++k) dst[m][k] = *(const PG8_LAS bf16x8*)(lds + PG8_SA(b, h) + aoff + m * 2048 + k * 1024); } } while (0)
#define PG8_LDB(dst, b, h) do { if constexpr (FP8) { dst##8[0] = lds_frag32_asm<PG8_SB(b, h) - 65536>(ldb_); dst##8[1] = lds_frag32_asm<PG8_SB(b, h) - 65536 + 2048>(ldb_); } \
    else { _Pragma("unroll") for (int n = 0; n < 2; ++n) _Pragma("unroll") for (int k = 0; k < 2; ++k) dst[n][k] = *(const PG8_LAS bf16x8*)(lds + PG8_SB(b, h) + boff + n * 2048 + k * 1024); } } while (0)
#define PG8_CAT(x) __builtin_shufflevector(__builtin_bit_cast(u32x4, (x)[0]), __builtin_bit_cast(u32x4, (x)[1]), 0, 1, 2, 3, 4, 5, 6, 7)
#define PG8_MMA(ai, bj, At, Bt) do { __builtin_amdgcn_s_setprio(1); if constexpr (FP8) { _Pragma("unroll") for (int m = 0; m < 4; ++m) _Pragma("unroll") for (int n = 0; n < 2; ++n) \
        asm volatile("v_mfma_scale_f32_16x16x128_f8f6f4 %0, %1, %2, %0, %3, %3 op_sel_hi:[0,0,0]" : "+v"(acc[ai][bj][m][n]) : "v"(Bt##8[n]), "v"(At##8[m]), "v"(scl1)); } \
    else { _Pragma("unroll") for (int m = 0; m < 4; ++m) _Pragma("unroll") for (int n = 0; n < 2; ++n) _Pragma("unroll") for (int k = 0; k < 2; ++k) \
        acc[ai][bj][m][n] = __builtin_amdgcn_mfma_f32_16x16x32_bf16(Bt[n][k], At[m][k], acc[ai][bj][m][n], 0, 0, 0); } __builtin_amdgcn_s_setprio(0); } while (0)
#define PG8_WAIT_V(n) asm volatile("s_waitcnt vmcnt(" #n ")" ::: "memory")
#define PG8_WAIT_L(n) asm volatile("s_waitcnt lgkmcnt(" #n ")" ::: "memory")
#define PG8_BAR __builtin_amdgcn_s_barrier()
#define PG8_SCHED __builtin_amdgcn_sched_barrier(0)
    Unit cur, nxt; int ui = 0;
    if (!S.next(0, cur)) return;
    f32x4 acc[2][2][4][2];
#pragma unroll
    for (int a = 0; a < 2; ++a)
#pragma unroll
        for (int b = 0; b < 2; ++b)
#pragma unroll
            for (int m = 0; m < 4; ++m)
#pragma unroll
                for (int n = 0; n < 2; ++n) acc[a][b][m][n] = (f32x4){0.f, 0.f, 0.f, 0.f};
    const unsigned scl1 = 0x7f7f7f7fu;
    bf16x8 At[4][2], B0[2][2], B1[2][2]; v8i32 At8[4], B08[2], B18[2];
    const char* cA = GATHER ? (const char*)g.A : (const char*)g.A + (size_t)cur.pm * tstep; const char* cB = (const char*)g.Bt + (size_t)cur.pn * tstep;
    S.a_ready(cur);
    static_assert(!GATHER || SP2, "GATHER is written for the SP2 loop");
#define PG8_HSTAB(slot, pm_) do { if (tid < 256) { const float* sp_ = hs.ss + ((size_t)(pm_) * BM + tid) * 16; float rr_[4]; \
        _Pragma("unroll") for (int h_ = 0; h_ < 4; ++h_) { const f32x4 p_ = *(const f32x4*)(sp_ + 4 * h_); rr_[h_] = 1.0f / sqrtf(((p_[0] + p_[1]) + (p_[2] + p_[3])) * (1.0f / 512.f) + hs.eps); } \
        *(PG8_LAS f32x4*)(hs.tab + (slot) * 1024 + tid * 4) = (f32x4){rr_[0] / rr_[1], rr_[1] / rr_[2], rr_[2] / rr_[3], rr_[3]}; } } while (0)
#define PG8_HSMUL(slot, h_) do { _Pragma("unroll") for (int ai_ = 0; ai_ < 2; ++ai_) _Pragma("unroll") for (int m_ = 0; m_ < 4; ++m_) { const float f_ = hs.tab[(slot) * 1024 + (ai_ * HALF + wr * 64 + m_ * 16 + fr) * 4 + (h_)]; \
        _Pragma("unroll") for (int bj_ = 0; bj_ < 2; ++bj_) _Pragma("unroll") for (int n_ = 0; n_ < 2; ++n_) acc[ai_][bj_][m_][n_] = acc[ai_][bj_][m_][n_] * f_; } } while (0)
    if constexpr (HSCALE) { PG8_HSTAB(0, cur.pm); PG8_WAIT_L(0); PG8_BAR; }
    if constexpr (SP2) {
        if constexpr (GATHER) { unsigned v0[2], v1[2]; PG8_GVOFF(v0, 0, 0); PG8_GVOFF(v1, 0, 1); PG8_STAGE(PG8_SB(0, 0), cB, voffB); PG8_STAGE(PG8_SB(0, 1), cB + hstep, voffB); PG8_STAGE(PG8_SA(0, 0), cA, v0); PG8_STAGE(PG8_SA(0, 1), cA, v1); }
        else { PG8_STAGE(PG8_SB(0, 0), cB, voffB); PG8_STAGE(PG8_SB(0, 1), cB + hstep, voffB); PG8_STAGE(PG8_SA(0, 0), cA, voffA); PG8_STAGE(PG8_SA(0, 1), cA + hstep, voffA); }
        if (wr == 1) PG8_BAR;
        PG8_WAIT_V(2); PG8_BAR;
        if constexpr (GATHER) { unsigned v0[2]; PG8_GVOFF(v0, 0, 0); PG8_STAGE(PG8_SB(1, 0), cB + kstep, voffB); PG8_STAGE(PG8_SA(1, 0), cA + kstep, v0); PG8_STAGE(PG8_SB(1, 1), cB + hstep + kstep, voffB); }
        else { PG8_STAGE(PG8_SB(1, 0), cB + kstep, voffB); PG8_STAGE(PG8_SA(1, 0), cA + kstep, voffA); PG8_STAGE(PG8_SB(1, 1), cB + hstep + kstep, voffB); }
        PG8_WAIT_V(6); PG8_BAR;
    } else {
        PG8_STAGE(PG8_SB(0, 0), cB, voffB); PG8_STAGE(PG8_SA(0, 0), cA, voffA); PG8_STAGE(PG8_SB(0, 1), cB + hstep, voffB); PG8_STAGE(PG8_SA(0, 1), cA + hstep, voffA);
        if (wr == 1) PG8_BAR;
        PG8_WAIT_V(4); PG8_BAR;
        PG8_STAGE(PG8_SB(1, 0), cB + kstep, voffB); PG8_STAGE(PG8_SA(1, 0), cA + kstep, voffA); PG8_STAGE(PG8_SB(1, 1), cB + hstep + kstep, voffB);
        PG8_WAIT_V(6); PG8_BAR;
    }
    for (;;) {
        const bool has_next = S.next(ui + 1, nxt);
        const char* nA = GATHER ? cA : (has_next ? (const char*)g.A + (size_t)nxt.pm * tstep : cA); const char* nB = has_next ? (const char*)g.Bt + (size_t)nxt.pn * tstep : cB;
#pragma unroll 1
        for (int t = 0; t < nt; t += 2) {
            asm volatile("" : "+v"(voffA[0]), "+v"(voffA[1]), "+v"(voffB[0]), "+v"(voffB[1]));
            const bool last = (t == nt - 2);
            const char* a1 = cA + (size_t)(t + 1) * kstep;
            const char* a2 = last ? nA : cA + (size_t)(t + 2) * kstep; const char* b2 = last ? nB : cB + (size_t)(t + 2) * kstep;
            const char* a3 = a2 + kstep; const char* b3 = b2 + kstep;
            if (last && has_next) S.a_ready(nxt);
            if constexpr (HSCALE) { if (last && has_next) PG8_HSTAB((ui + 1) & 1, nxt.pm);
                                    if (t == 8 || t == 16 || t == 24) PG8_HSMUL(ui & 1, (t >> 3) - 1); }
            const bool rlx = (t == 0) && (ui > 0);
#define PG8_WAIT_V8R do { if (rlx) wait_vm<8 + Epi::NST>(); else wait_vm<8>(); } while (0)
            if constexpr (SP2 && GATHER) {
            const int uix = (last && has_next) ? ui + 1 : ui;
            unsigned vc1[2], vx0[2], vx1[2]; PG8_GVOFF(vc1, ui, 1); PG8_GVOFF(vx0, uix, 0); PG8_GVOFF(vx1, uix, 1);
            if constexpr (FP8) { asm volatile("" :: "v"(vc1[0]), "v"(vc1[1]), "v"(vx0[0]), "v"(vx0[1]), "v"(vx1[0]), "v"(vx1[1]));
                PG8_LDB(B0, 0, 0); PG8_LDA(At, 0, 0); PG8_LDB(B1, 0, 1); PG8_STAGE(PG8_SA(1, 1), a1, vc1);
                PG8_WAIT_V8R; PG8_WAIT_L(4); PG8_BAR; PG8_MMA(0, 0, At, B0); PG8_WAIT_L(0); PG8_MMA(0, 1, At, B1); PG8_BAR; PG8_SCHED; }
            else { PG8_LDB(B0, 0, 0); PG8_LDB(B1, 0, 1); PG8_SCHED; PG8_LDA(At, 0, 0); PG8_STAGE(PG8_SA(1, 1), a1, vc1);
                PG8_WAIT_V8R; PG8_WAIT_L(0); PG8_BAR; PG8_MMA(0, 0, At, B0); PG8_MMA(0, 1, At, B1); PG8_BAR; PG8_SCHED; }
            PG8_LDA(At, 0, 1); PG8_STAGE(PG8_SB(0, 0), b2, voffB); PG8_STAGE(PG8_SB(0, 1), b2 + hstep, voffB); PG8_STAGE(PG8_SA(0, 0), a2, vx0);
            PG8_WAIT_V8R; PG8_WAIT_L(0); PG8_BAR; PG8_MMA(1, 0, At, B0); PG8_MMA(1, 1, At, B1); PG8_BAR; PG8_SCHED;
            if constexpr (FP8) { PG8_LDB(B0, 1, 0); PG8_LDA(At, 1, 0); PG8_LDB(B1, 1, 1); PG8_STAGE(PG8_SA(0, 1), a2, vx1);
                PG8_WAIT_V(8); PG8_WAIT_L(4); PG8_BAR; PG8_MMA(0, 0, At, B0); PG8_WAIT_L(0); PG8_MMA(0, 1, At, B1); PG8_BAR; PG8_SCHED; }
            else { PG8_LDB(B0, 1, 0); PG8_LDB(B1, 1, 1); PG8_SCHED; PG8_LDA(At, 1, 0); PG8_STAGE(PG8_SA(0, 1), a2, vx1);
                PG8_WAIT_V(8); PG8_WAIT_L(0); PG8_BAR; PG8_MMA(0, 0, At, B0); PG8_MMA(0, 1, At, B1); PG8_BAR; PG8_SCHED; }
            PG8_LDA(At, 1, 1); PG8_STAGE(PG8_SB(1, 0), b3, voffB); PG8_STAGE(PG8_SB(1, 1), b3 + hstep, voffB); PG8_STAGE(PG8_SA(1, 0), a3, vx0);
            PG8_WAIT_V(8); PG8_WAIT_L(0); PG8_BAR; PG8_MMA(1, 0, At, B0); PG8_MMA(1, 1, At, B1); PG8_BAR; PG8_SCHED;
            } else if constexpr (SP2) {
            if constexpr (FP8) { PG8_LDB(B0, 0, 0); PG8_LDA(At, 0, 0); PG8_LDB(B1, 0, 1); PG8_STAGE(PG8_SA(1, 1), a1 + hstep, voffA);
                PG8_WAIT_V8R; PG8_WAIT_L(4); PG8_BAR; PG8_MMA(0, 0, At, B0); PG8_WAIT_L(0); PG8_MMA(0, 1, At, B1); PG8_BAR; PG8_SCHED; }
            else { PG8_LDB(B0, 0, 0); PG8_LDB(B1, 0, 1); PG8_SCHED; PG8_LDA(At, 0, 0); PG8_STAGE(PG8_SA(1, 1), a1 + hstep, voffA);
                PG8_WAIT_V8R; PG8_WAIT_L(0); PG8_BAR; PG8_MMA(0, 0, At, B0); PG8_MMA(0, 1, At, B1); PG8_BAR; PG8_SCHED; }
            PG8_LDA(At, 0, 1); PG8_STAGE(PG8_SB(0, 0), b2, voffB); PG8_STAGE(PG8_SB(0, 1), b2 + hstep, voffB); PG8_STAGE(PG8_SA(0, 0), a2, voffA);
            PG8_WAIT_V8R; PG8_WAIT_L(0); PG8_BAR; PG8_MMA(1, 0, At, B0); PG8_MMA(1, 1, At, B1); PG8_BAR; PG8_SCHED;
            if constexpr (FP8) { PG8_LDB(B0, 1, 0); PG8_LDA(At, 1, 0); PG8_LDB(B1, 1, 1); PG8_STAGE(PG8_SA(0, 1), a2 + hstep, voffA);
                PG8_WAIT_V(8); PG8_WAIT_L(4); PG8_BAR; PG8_MMA(0, 0, At, B0); PG8_WAIT_L(0); PG8_MMA(0, 1, At, B1); PG8_BAR; PG8_SCHED; }
            else { PG8_LDB(B0, 1, 0); PG8_LDB(B1, 1, 1); PG8_SCHED; PG8_LDA(At, 1, 0); PG8_STAGE(PG8_SA(0, 1), a2 + hstep, voffA);
                PG8_WAIT_V(8); PG8_WAIT_L(0); PG8_BAR; PG8_MMA(0, 0, At, B0); PG8_MMA(0, 1, At, B1); PG8_BAR; PG8_SCHED; }
            PG8_LDA(At, 1, 1); PG8_STAGE(PG8_SB(1, 0), b3, voffB); PG8_STAGE(PG8_SB(1, 1), b3 + hstep, voffB); PG8_STAGE(PG8_SA(1, 0), a3, voffA);
            PG8_WAIT_V(8); PG8_WAIT_L(0); PG8_BAR; PG8_MMA(1, 0, At, B0); PG8_MMA(1, 1, At, B1); PG8_BAR; PG8_SCHED;
            } else {
            PG8_LDB(B0, 0, 0); PG8_SCHED; PG8_LDA(At, 0, 0); PG8_STAGE(PG8_SA(1, 1), a1 + hstep, voffA);
            PG8_WAIT_L(8); PG8_BAR; PG8_WAIT_L(0); PG8_MMA(0, 0, At, B0); PG8_BAR; PG8_SCHED;
            PG8_LDB(B1, 0, 1); PG8_STAGE(PG8_SB(0, 0), b2, voffB);
            PG8_BAR; PG8_WAIT_L(0); PG8_MMA(0, 1, At, B1); PG8_BAR;
            PG8_LDA(At, 0, 1); PG8_STAGE(PG8_SA(0, 0), a2, voffA);
            PG8_BAR; PG8_WAIT_L(0); PG8_MMA(1, 0, At, B0); PG8_BAR; PG8_SCHED;
            PG8_STAGE(PG8_SB(0, 1), b2 + hstep, voffB);
            PG8_WAIT_V(6); PG8_BAR; PG8_MMA(1, 1, At, B1); PG8_BAR;
            PG8_LDB(B0, 1, 0); PG8_SCHED; PG8_LDA(At, 1, 0); PG8_STAGE(PG8_SA(0, 1), a2 + hstep, voffA);
            PG8_WAIT_L(8); PG8_BAR; PG8_WAIT_L(0); PG8_MMA(0, 0, At, B0); PG8_BAR; PG8_SCHED;
            PG8_LDB(B1, 1, 1); PG8_STAGE(PG8_SB(1, 0), b3, voffB);
            PG8_BAR; PG8_WAIT_L(0); PG8_MMA(0, 1, At, B1); PG8_BAR;
            PG8_LDA(At, 1, 1); PG8_STAGE(PG8_SA(1, 0), a3, voffA);
            PG8_BAR; PG8_WAIT_L(0); PG8_MMA(1, 0, At, B0); PG8_BAR; PG8_SCHED;
            PG8_STAGE(PG8_SB(1, 1), b3 + hstep, voffB);
            PG8_WAIT_V(6); PG8_BAR; PG8_MMA(1, 1, At, B1); PG8_BAR;
            }
        }
        if constexpr (ALIGN_EPI) { if (wr == 0) PG8_BAR; }
        if constexpr (HSCALE) PG8_HSMUL(ui & 1, 3);
        if constexpr (FP8) asm volatile("s_nop 15\n\ts_nop 7" ::: "memory");
        { int te = threadIdx.x; asm volatile("" : "+v"(te));
          if constexpr (!NOEPI) E(acc, cur, wr, wc, te & 15, (te & 63) >> 4); else { float sink_ = 0.f; _Pragma("unroll") for (int a_ = 0; a_ < 2; ++a_) _Pragma("unroll") for (int b_ = 0; b_ < 2; ++b_) _Pragma("unroll") for (int m_ = 0; m_ < 4; ++m_) _Pragma("unroll") for (int n_ = 0; n_ < 2; ++n_) sink_ += acc[a_][b_][m_][n_][0]; asm volatile("" :: "v"(sink_)); } }
        if (!has_next) break;
#pragma unroll
        for (int a = 0; a < 2; ++a)
#pragma unroll
            for (int b = 0; b < 2; ++b)
#pragma unroll
                for (int m = 0; m < 4; ++m)
#pragma unroll
                    for (int n = 0; n < 2; ++n) acc[a][b][m][n] = (f32x4){0.f, 0.f, 0.f, 0.f};
        cur = nxt; cA = nA; cB = nB; ++ui;
        if constexpr (ALIGN_EPI) { if (wr == 1) PG8_BAR; }
    }
    PG8_WAIT_V(0);
    if constexpr (!ALIGN_EPI) { if (wr == 0) PG8_BAR; }
    PG8_BAR;
#undef PG8_GVOFF
#undef PG8_HSTAB
#undef PG8_HSMUL
#undef PG8_WAIT_V8R
#undef PG8_CAT
#undef PG8_SA
#undef PG8_SB
#undef PG8_STAGE
#undef PG8_LDA
#undef PG8_LDB
#undef PG8_MMA
#undef PG8_WAIT_V
#undef PG8_WAIT_L
#undef PG8_BAR
#undef PG8_SCHED
}
}

constexpr int NWAVES = 8;
constexpr int DM = 1024, NBATCH = 32, SEQ = 2048, MTOK = NBATCH * SEQ, DEPTH = 4, NEXP = 32, TOPK = 4;
constexpr int HG_N = 4096, RT_N = 6144, HG_H = 8, RT_H = 4;
constexpr float EPS = 1e-6f;
constexpr int LCAP = 65536;
constexpr int MAXTILES = 1056;
constexpr float YSC = 32.0f;
constexpr int YLD = DM;

constexpr size_t MiB = 1u << 20;
constexpr size_t WS_CTL = 0, CTL_ZERO_BYTES = 1 * MiB;
constexpr size_t WS_MOD = 1 * MiB;
constexpr size_t WS_FMOD = 4 * MiB;
constexpr size_t WS_LBV = 4 * MiB + 512 * 1024;
constexpr size_t WS_HWIN = 8 * MiB, WS_HWOUT = 24 * MiB, WS_RWIN = 28 * MiB, WS_RWOUT = 52 * MiB, WS_W1T = 64 * MiB, WS_W2T = 576 * MiB;
constexpr size_t WS_H = 832 * MiB;
constexpr size_t WS_LIST = 960 * MiB;
constexpr size_t WS_TSLOT = 968 * MiB, WS_TGATE = 969 * MiB;
constexpr size_t WS_R1 = 976 * MiB;
constexpr size_t WS_R2 = 1744 * MiB;
constexpr size_t WS_H8 = 2272 * MiB;
constexpr size_t WS_XB = 320 * MiB;
static_assert(MOE_FP8 == 1, "WS_XB lies in the half of the W1T region that bf16 expert weights would need");
constexpr size_t WS_END = 2336 * MiB;
constexpr int hg_rank(int s, int mask) { int r = 0; for (int i = 0; i < s; ++i) r += (mask >> i) & 1; return r; }
constexpr unsigned hg_smap(int mask) { unsigned m = 0; int r = 0; for (int i = 0; i < 4; ++i) if ((mask >> i) & 1) { m |= (unsigned)i << (4 * r); ++r; } return m; }
constexpr int HG_N8 = 1024 * hg_rank(4, HGRN_FP8_MASK), HG_N16 = 4096 - HG_N8;
constexpr int CW_BAR = 4096;
constexpr int CW_CNT = 8192;

constexpr int RING_OFF = 0, RING_BYTES = 131072;
constexpr int MISC_OFF = 155648;
constexpr int TAB_OFF = MISC_OFF + 128;
constexpr int LDS_BYTES = 160 * 1024;

#define GAS __attribute__((address_space(1)))
#define LAS __attribute__((address_space(3)))
typedef unsigned short bf16;
typedef unsigned v4u __attribute__((ext_vector_type(4)));
typedef unsigned v2u __attribute__((ext_vector_type(2)));
typedef float f32x4 __attribute__((ext_vector_type(4)));
typedef short bf16x8 __attribute__((ext_vector_type(8)));
#define RLX_AGENT __ATOMIC_RELAXED, __HIP_MEMORY_SCOPE_AGENT
#define LDS_WAIT() asm volatile("s_waitcnt lgkmcnt(0)" ::: "memory")
#define VM_WAIT() asm volatile("s_waitcnt vmcnt(0)" ::: "memory")
__device__ __forceinline__ unsigned pk2(float lo, float hi) { return pg8::cvt_pk_bf16(lo, hi); }
__device__ __forceinline__ unsigned pk4_fp8(float a, float b, float c, float d) { int p = 0; p = __builtin_amdgcn_cvt_pk_fp8_f32(a, b, p, false); p = __builtin_amdgcn_cvt_pk_fp8_f32(c, d, p, true); return (unsigned)p; }
__device__ __forceinline__ v4u pack8(const f32x4 a, const f32x4 b) { v4u w; w.x = pk2(a.x, a.y); w.y = pk2(a.z, a.w); w.z = pk2(b.x, b.y); w.w = pk2(b.z, b.w); return w; }
__device__ __forceinline__ float bflo(unsigned w) { return __uint_as_float(w << 16); }
__device__ __forceinline__ float bfhi(unsigned w) { return __uint_as_float(w & 0xffff0000u); }
__device__ __forceinline__ float bf2f(unsigned short h) { return __uint_as_float(((unsigned)h) << 16); }
__device__ __forceinline__ float sigmoidf_(float x) { return __builtin_amdgcn_rcpf(1.f + __expf(-x)); }
__device__ __forceinline__ float siluf_(float x) { return x * sigmoidf_(x); }
__device__ __forceinline__ f32x4 silu4_(const f32x4 x) {
    const f32x4 t = x * -1.4426950408889634f; f32x4 e, r;
#pragma unroll
    for (int j = 0; j < 4; ++j) e[j] = __builtin_amdgcn_exp2f(t[j]);
    const f32x4 d = e + 1.0f;
#pragma unroll
    for (int j = 0; j < 4; ++j) r[j] = __builtin_amdgcn_rcpf(d[j]);
    return x * r;
}
__device__ __forceinline__ unsigned ldu_vec(const unsigned* p) { return __hip_atomic_load(p, RLX_AGENT); }

#define XB_TMO      128
#define XB_XCNT(j)  (256  + 64 * (j))
#define XB_XSUB(j)  (1280 + 64 * (j))
#define XB_XGEN(j)  (2304 + 64 * (j))
#define XB_TOP      3328
#define XB_TOPGEN   3392
#define XCD_BAR_WORDS 3456
#define XB_SPIN_CAP (1u << 18)

__device__ __forceinline__ unsigned xb_ld(unsigned* p)              { return __hip_atomic_load(p, __ATOMIC_RELAXED, __HIP_MEMORY_SCOPE_AGENT); }
__device__ __forceinline__ unsigned xb_add(unsigned* p, unsigned v) { return __hip_atomic_fetch_add(p, v, __ATOMIC_RELAXED, __HIP_MEMORY_SCOPE_AGENT); }
__device__ __forceinline__ unsigned xb_xcc_id() { return (unsigned)__builtin_amdgcn_s_getreg((3 << 11) | 20) & 0xFu; }
#define XB_SPIN(cond, bar) do { unsigned _sp = 0; while (cond) { __builtin_amdgcn_s_sleep(1); \
    if ((++_sp & 255u) == 0u) { if (xb_ld(&(bar)[XB_TMO])) break; if (_sp > XB_SPIN_CAP) { atomicAdd(&(bar)[XB_TMO], 1u); break; } } } } while (0)

struct XcdBarrier {
    unsigned* bar; unsigned x;
    volatile LAS unsigned* st;
};
__device__ __forceinline__ XcdBarrier xcd_barrier_post(unsigned* bar, volatile LAS unsigned* st) {
    XcdBarrier b; b.bar = bar; b.x = xb_xcc_id(); b.st = st;
    if (threadIdx.x == 0) (void)xb_add(&bar[XB_XCNT(b.x)], 1u);
    return b;
}
__device__ __forceinline__ void xcd_barrier_complete(unsigned* bar, unsigned x, unsigned& nloc, unsigned& nx) {
    const unsigned G = gridDim.x * gridDim.y * gridDim.z;
    unsigned sum, cnt, mine, sp = 0u;
    for (;;) {
        sum = 0u; cnt = 0u; mine = 0u;
#pragma unroll
        for (unsigned j = 0; j < 16; ++j) { const unsigned c = xb_ld(&bar[XB_XCNT(j)]); sum += c; cnt += (c > 0u) ? 1u : 0u; mine = (j == x) ? c : mine; }
        if (sum == G) break;
        __builtin_amdgcn_s_sleep(1);
        if ((++sp & 255u) == 0u) { if (xb_ld(&bar[XB_TMO])) break; if (sp > XB_SPIN_CAP) { atomicAdd(&bar[XB_TMO], 1u); break; } }
    }
    nloc = mine > 0u ? mine : 1u; nx = cnt > 0u ? cnt : 1u;
}
__device__ __forceinline__ void xcd_barrier(const XcdBarrier& b) {
    asm volatile("s_waitcnt vmcnt(0)" ::: "memory");
    __syncthreads();
    if (threadIdx.x == 0) {
        unsigned* bar = b.bar;
        __builtin_amdgcn_s_waitcnt(0);
        unsigned nloc = b.st[0], nx = b.st[1];
        if (nloc == 0u) { xcd_barrier_complete(bar, b.x, nloc, nx); b.st[0] = nloc; b.st[1] = nx; }
        const unsigned old = xb_add(&bar[XB_XSUB(b.x)], 1u);
        const unsigned gen = old / nloc;
        if (old + 1u == (gen + 1u) * nloc) {
            __builtin_amdgcn_fence(__ATOMIC_RELEASE, "agent");
            asm volatile("s_waitcnt vmcnt(0)" ::: "memory");
            const unsigned og = xb_add(&bar[XB_TOP], 1u);
            const unsigned tg = og / nx;
            if (og + 1u == (tg + 1u) * nx) xb_add(&bar[XB_TOPGEN], 1u);
            else XB_SPIN(xb_ld(&bar[XB_TOPGEN]) == tg, bar);
            __builtin_amdgcn_fence(__ATOMIC_ACQUIRE, "agent");
            xb_add(&bar[XB_XGEN(b.x)], 1u);
            asm volatile("s_waitcnt vmcnt(0)" ::: "memory");
        } else {
            XB_SPIN(xb_ld(&bar[XB_XGEN(b.x)]) == gen, bar);
            __builtin_amdgcn_fence(__ATOMIC_ACQUIRE, "agent");
            asm volatile("s_waitcnt vmcnt(0)" ::: "memory");
        }
    }
    __syncthreads();
}

struct Frame {
    LAS unsigned char* lds;
    unsigned* ctl;
    int tid, lane, wave, vcu, G;
    float* out; unsigned char* ws;
};
__device__ __forceinline__ void relaunder(Frame& F) { int t = threadIdx.x; asm volatile("" : "+v"(t)); F.tid = t; F.lane = t & 63; F.wave = __builtin_amdgcn_readfirstlane(t >> 6); }
#define KAS __attribute__((address_space(4)))
__device__ __forceinline__ const void* kin_(int i) { const KAS char* kp = (const KAS char*)__builtin_amdgcn_kernarg_segment_ptr(); asm volatile("" : "+s"(kp)); return *(const void* const KAS*)(kp + 8 * i); }
enum { I_X = 0, I_C, I_POS, I_ADAW, I_ADAB, I_N1G, I_N2G, I_HWIN, I_HWOUT, I_HGAIN, I_HLB, I_RWIN, I_RWOUT, I_RTW, I_RTB, I_W1, I_B1, I_W2, I_B2, I_FG, I_FADAW, I_FADAB };
#define KIN(i) ((const float*)kin_(i))
__device__ __forceinline__ float wave_sum(float v) {
#pragma unroll
    for (int o = 1; o < 64; o <<= 1) v += __shfl_xor(v, o);
    return v;
}

__device__ __forceinline__ void p0_transpose_item(const float* W, int N, bf16* WT, int K, int k0, int n0, int drow0, LAS float* scr, int lane) {
    float wv[32];
#pragma unroll
    for (int i = 0; i < 32; ++i) wv[i] = W[(size_t)(k0 + 2 * i + (lane >> 5)) * N + n0 + (lane & 31)];
#pragma unroll
    for (int i = 0; i < 32; ++i) scr[(2 * i + (lane >> 5)) * 33 + (lane & 31)] = wv[i];
    LDS_WAIT(); asm volatile("" ::: "memory");
    const int c = lane & 7;
#pragma unroll
    for (int j = 0; j < 4; ++j) { const int n = (lane >> 3) + 8 * j; const LAS float* s = scr + (8 * c) * 33 + n;
        v4u o; o.x = pk2(s[0 * 33], s[1 * 33]); o.y = pk2(s[2 * 33], s[3 * 33]); o.z = pk2(s[4 * 33], s[5 * 33]); o.w = pk2(s[6 * 33], s[7 * 33]);
        *(GAS v4u*)(WT + (size_t)(drow0 + n) * K + k0 + 8 * c) = o; }
    LDS_WAIT(); asm volatile("" ::: "memory");
}
__device__ __forceinline__ void p0_transpose_item_f8(const float* W, int N, unsigned char* WT, int K, int k0, int n0, int drow0, LAS float* scr, int lane, float scale) {
    float wv[32];
#pragma unroll
    for (int i = 0; i < 32; ++i) wv[i] = W[(size_t)(k0 + 2 * i + (lane >> 5)) * N + n0 + (lane & 31)];
#pragma unroll
    for (int i = 0; i < 32; ++i) scr[(2 * i + (lane >> 5)) * 33 + (lane & 31)] = wv[i];
    LDS_WAIT(); asm volatile("" ::: "memory");
    const int n = lane >> 1, hf = lane & 1; const LAS float* sp = scr + (32 * hf) * 33 + n;
    v4u o0, o1;
    o0.x = pk4_fp8(sp[0 * 33] * scale, sp[1 * 33] * scale, sp[2 * 33] * scale, sp[3 * 33] * scale); o0.y = pk4_fp8(sp[4 * 33] * scale, sp[5 * 33] * scale, sp[6 * 33] * scale, sp[7 * 33] * scale);
    o0.z = pk4_fp8(sp[8 * 33] * scale, sp[9 * 33] * scale, sp[10 * 33] * scale, sp[11 * 33] * scale); o0.w = pk4_fp8(sp[12 * 33] * scale, sp[13 * 33] * scale, sp[14 * 33] * scale, sp[15 * 33] * scale);
    o1.x = pk4_fp8(sp[16 * 33] * scale, sp[17 * 33] * scale, sp[18 * 33] * scale, sp[19 * 33] * scale); o1.y = pk4_fp8(sp[20 * 33] * scale, sp[21 * 33] * scale, sp[22 * 33] * scale, sp[23 * 33] * scale);
    o1.z = pk4_fp8(sp[24 * 33] * scale, sp[25 * 33] * scale, sp[26 * 33] * scale, sp[27 * 33] * scale); o1.w = pk4_fp8(sp[28 * 33] * scale, sp[29 * 33] * scale, sp[30 * 33] * scale, sp[31 * 33] * scale);
    unsigned char* d = WT + (size_t)(drow0 + n) * K + k0 + 32 * hf; *(GAS v4u*)d = o0; *(GAS v4u*)(d + 16) = o1;
    LDS_WAIT(); asm volatile("" ::: "memory");
}
__device__ __forceinline__ void p0_prologue(Frame& F) {
    relaunder(F);
    __syncthreads();
    const int gw = F.vcu * NWAVES + F.wave, NGW = F.G * NWAVES;
    {
        LAS float* condT = (LAS float*)(F.lds + RING_OFF);
        const float* cin = KIN(I_C);
        for (int idx = F.tid; idx < NBATCH * DM; idx += NWAVES * 64) { const int b = idx >> 10, k = idx & 1023; condT[k * 32 + b] = siluf_(cin[idx]); }
        __syncthreads();
        { const int gsel = F.wave >> 2, kq = F.wave & 3, u = 2 * F.vcu + gsel; const bool act = (u < 416);
          const float* W = nullptr; const float* bias = nullptr; float* outp = nullptr; int N = 0, n0 = 0;
          if (act) { if (u < 384) { const int l = u / 96; n0 = (u % 96) * 64; N = 6 * DM; W = KIN(I_ADAW) + (size_t)l * DM * N; bias = KIN(I_ADAB) + l * N; outp = (float*)(F.ws + WS_MOD) + (size_t)l * NBATCH * N; }
                     else { n0 = (u - 384) * 64; N = 2 * DM; W = KIN(I_FADAW); bias = KIN(I_FADAB); outp = (float*)(F.ws + WS_FMOD); } }
          float acc[32];
#pragma unroll
          for (int b = 0; b < 32; ++b) acc[b] = 0.f;
          if (act) {
#pragma unroll 4
              for (int k = 256 * kq; k < 256 * kq + 256; ++k) {
                  const float w = W[(size_t)k * N + n0 + F.lane];
                  const LAS f32x4* cb = (const LAS f32x4*)(condT + k * 32);
#pragma unroll
                  for (int q = 0; q < 8; ++q) { const f32x4 cv = cb[q]; acc[4 * q + 0] += cv.x * w; acc[4 * q + 1] += cv.y * w; acc[4 * q + 2] += cv.z * w; acc[4 * q + 3] += cv.w * w; }
              } }
          __syncthreads();
          LAS float* red = (LAS float*)(F.lds + RING_OFF) + F.wave * 2048;
#pragma unroll
          for (int b = 0; b < 32; ++b) red[b * 64 + F.lane] = acc[b];
          __syncthreads();
          if (act && kq == 0) { const float bv = bias[n0 + F.lane];
#pragma unroll
              for (int b = 0; b < 32; ++b) { const LAS float* r0 = (const LAS float*)(F.lds + RING_OFF) + (4 * gsel) * 2048 + b * 64 + F.lane;
                  outp[(size_t)b * N + n0 + F.lane] = ((r0[0] + r0[2048]) + (r0[4096] + r0[6144])) + bv; } }
        }
        if (gw == NGW - 1) {
            float* lbv = (float*)(F.ws + WS_LBV); const float* hlb = KIN(I_HLB);
            for (int d = F.lane; d < DM; d += 64) { const float a = hlb[d], b = hlb[DM + d], m = fmaxf(a, b), ea = __expf(a - m), eb = __expf(b - m); lbv[d] = 0.f; lbv[DM + d] = eb / (ea + eb); }
        }
        __syncthreads();
    }
    {
        LAS float* scr = (LAS float*)(F.lds + RING_OFF + F.wave * 16384);
        constexpr int NI_HI = 2 * 16 * 128, NI_HO = 2 * 16 * 32, NI_RI = 2 * 16 * 192, NI_RO = 2 * 32 * 32, NI_W1 = 128 * 16 * 64, NI_W2 = 128 * 16 * 32;
        constexpr int NITEMS = NI_HI + NI_HO + NI_RI + NI_RO + NI_W1 + NI_W2;
        for (int it = gw; it < NITEMS; it += NGW) {
            int r = it;
            if (r < NI_HI) { const int j = r / 2048, q = r % 2048, kb = q / 128, nb = q % 128;
                const int sg = nb >> 5, nl = 32 * (nb & 31);
                if ((HGRN_FP8_MASK >> sg) & 1) p0_transpose_item_f8(KIN(I_HWIN) + (size_t)j * DM * HG_N, HG_N, F.ws + WS_HWIN + (size_t)j * HG_N8 * DM, DM, 64 * kb, 32 * nb, 1024 * hg_rank(sg, HGRN_FP8_MASK) + nl, scr, F.lane, 64.0f);
                else p0_transpose_item(KIN(I_HWIN) + (size_t)j * DM * HG_N, HG_N, (bf16*)(F.ws + WS_HWIN + 8 * MiB) + (size_t)j * HG_N16 * DM, DM, 64 * kb, 32 * nb, 1024 * hg_rank(sg, 0xF & ~HGRN_FP8_MASK) + nl, scr, F.lane);
                continue; } r -= NI_HI;
            if (r < NI_HO) { const int j = r / 512, q = r % 512, kb = q / 32, nb = q % 32;
                if (HGRN_OUT_FP8) p0_transpose_item_f8(KIN(I_HWOUT) + (size_t)j * DM * DM, DM, F.ws + WS_HWOUT + (size_t)j * DM * DM, DM, 64 * kb, 32 * nb, 32 * nb, scr, F.lane, 64.0f);
                else p0_transpose_item(KIN(I_HWOUT) + (size_t)j * DM * DM, DM, (bf16*)(F.ws + WS_HWOUT) + (size_t)j * DM * DM, DM, 64 * kb, 32 * nb, 32 * nb, scr, F.lane);
                continue; } r -= NI_HO;
            if (r < NI_RI) { const int j = r / 3072, q = r % 3072, kb = q / 192, nb = q % 192;
                if (RET_IN_FP8) p0_transpose_item_f8(KIN(I_RWIN) + (size_t)j * DM * RT_N, RT_N, F.ws + WS_RWIN + (size_t)j * RT_N * DM, DM, 64 * kb, 32 * nb, 32 * nb, scr, F.lane, 64.0f);
                else p0_transpose_item(KIN(I_RWIN) + (size_t)j * DM * RT_N, RT_N, (bf16*)(F.ws + WS_RWIN) + (size_t)j * RT_N * DM, DM, 64 * kb, 32 * nb, 32 * nb, scr, F.lane);
                continue; } r -= NI_RI;
            if (r < NI_RO) { const int j = r / 1024, q = r % 1024, kb = q / 32, nb = q % 32;
                p0_transpose_item(KIN(I_RWOUT) + (size_t)j * 2048 * DM, DM, (bf16*)(F.ws + WS_RWOUT) + (size_t)j * DM * 2048, 2048, 64 * kb, 32 * nb, 32 * nb, scr, F.lane); continue; } r -= NI_RO;
            if (r < NI_W1) { const int mi = r / 1024, q = r % 1024, kb = q / 64, nb = q % 64; const int n0 = 32 * nb;
                const int cc = n0 & 1023, drow0 = 256 * (cc >> 7) + (cc & 127) + ((n0 >= 1024) ? 128 : 0);
                if (MOE_FP8) p0_transpose_item_f8(KIN(I_W1) + (size_t)mi * DM * 2048, 2048, F.ws + WS_W1T + (size_t)mi * 2048 * DM, DM, 64 * kb, n0, drow0, scr, F.lane, 64.0f);
                else p0_transpose_item(KIN(I_W1) + (size_t)mi * DM * 2048, 2048, (bf16*)(F.ws + WS_W1T) + (size_t)mi * 2048 * DM, DM, 64 * kb, n0, drow0, scr, F.lane);
                continue; } r -= NI_W1;
            { const int mi = r / 512, q = r % 512, kb = q / 32, nb = q % 32;
                if (MOE_FP8) p0_transpose_item_f8(KIN(I_W2) + (size_t)mi * DM * DM, DM, F.ws + WS_W2T + (size_t)mi * DM * DM, DM, 64 * kb, 32 * nb, 32 * nb, scr, F.lane, 64.0f);
                else p0_transpose_item(KIN(I_W2) + (size_t)mi * DM * DM, DM, (bf16*)(F.ws + WS_W2T) + (size_t)mi * DM * DM, DM, 64 * kb, 32 * nb, 32 * nb, scr, F.lane); }
        }
    }
}

__device__ __forceinline__ void phase_skew(Frame& F, unsigned ticks) {
    const unsigned long long t0 = __builtin_amdgcn_s_memrealtime(), d = (unsigned long long)((unsigned)F.vcu & 7u) * ticks;
    while (__builtin_amdgcn_s_memrealtime() - t0 < d) __builtin_amdgcn_s_sleep(4);
}
__device__ __forceinline__ void build_tiles(Frame& F, int l) {
    LAS int* ts = (LAS int*)(F.lds + TAB_OFF); LAS int* cnt = ts + 40;
    __syncthreads();
    if (F.tid < NEXP) cnt[F.tid] = (int)ldu_vec(F.ctl + CW_CNT + l * 2048 + F.tid * 64);
    __syncthreads();
    if (F.tid == 0) { int a = 0; for (int e = 0; e < NEXP; ++e) { ts[e] = a; a += (cnt[e] + 255) >> 8; } ts[NEXP] = a; }
    __syncthreads();
}

__device__ __forceinline__ void row_phase1(Frame& F, int l, int mode, bool dry = false) {
    relaunder(F);
    float* xdst = dry ? (float*)(F.ws + WS_R2) : F.out;
    bf16* xbd = dry ? (bf16*)(F.ws + WS_R2) : (bf16*)(F.ws + WS_XB);
    const bf16* xb = (const bf16*)(F.ws + WS_XB);
    const LAS int* ts = (const LAS int*)(F.lds + TAB_OFF);
    const bool comb = (l > 0);
    if (comb) build_tiles(F, l - 1);
    const float* xsrc = KIN(I_X);
    const unsigned char* Y = F.ws + WS_R1;
    const unsigned* tslot = (const unsigned*)(F.ws + WS_TSLOT); const unsigned* tgate = (const unsigned*)(F.ws + WS_TGATE);
    bf16* H = dry ? (bf16*)(F.ws + WS_R2 + 256 * MiB) : (bf16*)(F.ws + WS_H);
    const int cl = 8 * F.lane;
#define RP_COL(j) (cl + 512 * ((j) >> 1) + 4 * ((j) & 1))
    for (int rb = F.vcu * 256; rb < MTOK; rb += F.G * 256) {
        const int b = rb / SEQ;
        f32x4 A[4], B[4], G2[4];
#pragma unroll
        for (int j = 0; j < 4; ++j) {
            const int c = RP_COL(j);
            if (mode == 0) { const float* mv = (const float*)(F.ws + WS_MOD) + (size_t)(l * NBATCH + b) * 6 * DM;
                const f32x4 g = *(const f32x4*)(KIN(I_N1G) + l * DM + c), sc = *(const f32x4*)(mv + 1 * DM + c); A[j] = g * (sc + 1.0f); B[j] = *(const f32x4*)(mv + c); }
            else { const float* fm = (const float*)(F.ws + WS_FMOD) + (size_t)b * 2 * DM;
                const f32x4 g = *(const f32x4*)(KIN(I_FG) + c), sc = *(const f32x4*)(fm + DM + c); A[j] = g * (sc + 1.0f); B[j] = *(const f32x4*)(fm + c); }
            if (comb) G2[j] = *(const f32x4*)((const float*)(F.ws + WS_MOD) + (size_t)((l - 1) * NBATCH + b) * 6 * DM + 5 * DM + c) * (1.0f / YSC); else G2[j] = (f32x4){0.f, 0.f, 0.f, 0.f};
        }
        f32x4 xn[4]; v4u xq[2]; unsigned sln = 0u, gtn = 0u;
        { const int row = rb + 32 * F.wave;
          if (comb) {
#pragma unroll
              for (int p = 0; p < 2; ++p) xq[p] = *(const v4u*)(xb + (size_t)row * DM + cl + 512 * p);
              sln = tslot[(size_t)row * 4 + (F.lane & 3)]; gtn = tgate[(size_t)row * 4 + (F.lane & 3)];
          } else {
#pragma unroll
              for (int j = 0; j < 4; ++j) xn[j] = *(const f32x4*)(xsrc + (size_t)row * DM + RP_COL(j));
          } }
        for (int r = 0; r < 32; ++r) {
            const int row = rb + 32 * F.wave + r;
            f32x4 v[4];
            if (comb) {
#pragma unroll
                for (int p = 0; p < 2; ++p) { const v4u q = xq[p]; v[2 * p] = (f32x4){bflo(q.x), bfhi(q.x), bflo(q.y), bfhi(q.y)}; v[2 * p + 1] = (f32x4){bflo(q.z), bfhi(q.z), bflo(q.w), bfhi(q.w)}; }
            } else {
#pragma unroll
                for (int j = 0; j < 4; ++j) v[j] = xn[j];
            }
            const unsigned sl = sln, gt = gtn;
            v2u yw[TOPK][2]; float gkk[TOPK];
            if (comb) {
#pragma unroll
                for (int k = 0; k < TOPK; ++k) {
                    const unsigned s_ = (unsigned)__shfl((int)sl, k); gkk[k] = __uint_as_float((unsigned)__shfl((int)gt, k));
                    const int e = (int)(s_ >> 20), pos = (int)(s_ & 0xFFFFFu); const size_t yrow = (size_t)ts[e] * 256 + pos;
#pragma unroll
                    for (int p = 0; p < 2; ++p) yw[k][p] = *(const v2u*)(Y + yrow * YLD + cl + 512 * p); }
            }
            if (r + 1 < 32) { const int rn = row + 1;
                if (comb) {
#pragma unroll
                    for (int p = 0; p < 2; ++p) xq[p] = *(const v4u*)(xb + (size_t)rn * DM + cl + 512 * p);
                    sln = tslot[(size_t)rn * 4 + (F.lane & 3)]; gtn = tgate[(size_t)rn * 4 + (F.lane & 3)];
                } else {
#pragma unroll
                    for (int j = 0; j < 4; ++j) xn[j] = *(const f32x4*)(xsrc + (size_t)rn * DM + RP_COL(j));
                } }
            if (comb) {
                f32x4 ys[4];
#pragma unroll
                for (int j = 0; j < 4; ++j) ys[j] = (f32x4){0.f, 0.f, 0.f, 0.f};
#pragma unroll
                for (int k = 0; k < TOPK; ++k) { const float gk = gkk[k];
#pragma unroll
                    for (int p = 0; p < 2; ++p) { const v2u w = yw[k][p];
                        const auto f0 = __builtin_amdgcn_cvt_pk_f32_fp8((int)w.x, false), f1 = __builtin_amdgcn_cvt_pk_f32_fp8((int)w.x, true), f2 = __builtin_amdgcn_cvt_pk_f32_fp8((int)w.y, false), f3 = __builtin_amdgcn_cvt_pk_f32_fp8((int)w.y, true);
                        ys[2 * p].x += gk * f0[0]; ys[2 * p].y += gk * f0[1]; ys[2 * p].z += gk * f1[0]; ys[2 * p].w += gk * f1[1];
                        ys[2 * p + 1].x += gk * f2[0]; ys[2 * p + 1].y += gk * f2[1]; ys[2 * p + 1].z += gk * f3[0]; ys[2 * p + 1].w += gk * f3[1]; } }
#pragma unroll
                for (int j = 0; j < 4; ++j) v[j] = v[j] + G2[j] * ys[j];
                if (mode == 0) {
#pragma unroll
                    for (int p = 0; p < 2; ++p) *(v4u*)(xbd + (size_t)row * DM + cl + 512 * p) = pack8(v[2 * p], v[2 * p + 1]);
                }
            }
            float s2 = 0.f;
#pragma unroll
            for (int j = 0; j < 4; ++j) s2 += (v[j].x * v[j].x + v[j].y * v[j].y) + (v[j].z * v[j].z + v[j].w * v[j].w);
            const float rstd = 1.0f / sqrtf(wave_sum(s2) * (1.0f / DM) + EPS);
            if (mode == 0) {
#pragma unroll
                for (int p = 0; p < 2; ++p) { const f32x4 h0 = v[2 * p] * rstd * A[2 * p] + B[2 * p], h1 = v[2 * p + 1] * rstd * A[2 * p + 1] + B[2 * p + 1];
                    const bool w8 = ((l & 1) ? (RET_IN_FP8 != 0) : (HGRN_FP8_MASK != 0)) && !dry, w16 = ((l & 1) ? (RET_IN_FP8 == 0) : (HGRN_FP8_MASK != 0xF)) || dry;
                    if (w8) { v2u w; w.x = pk4_fp8(h0.x * 8.0f, h0.y * 8.0f, h0.z * 8.0f, h0.w * 8.0f); w.y = pk4_fp8(h1.x * 8.0f, h1.y * 8.0f, h1.z * 8.0f, h1.w * 8.0f); *(v2u*)(F.ws + WS_H8 + (size_t)row * DM + cl + 512 * p) = w; }
                    if (w16) *(v4u*)(H + (size_t)row * DM + cl + 512 * p) = pack8(h0, h1); }
            } else {
#pragma unroll
                for (int j = 0; j < 4; ++j) *(f32x4*)(xdst + (size_t)row * DM + RP_COL(j)) = v[j] * rstd * A[j] + B[j];
            }
        }
    }
#undef RP_COL
}

__device__ __forceinline__ void row_phase2(Frame& F, int l, bool dry = false) {
    relaunder(F);
    bf16* H = dry ? (bf16*)(F.ws + WS_R2) : (bf16*)(F.ws + WS_H); unsigned char* H8p = dry ? F.ws + WS_R2 + 128 * MiB : F.ws + WS_H8;
    LAS unsigned char* frag = F.lds + RING_OFF;
    LAS float* lg = (LAS float*)(F.lds + 131072 + F.wave * 2112);
    LAS int* cntL = (LAS int*)(F.lds + 147968); LAS int* baseL = cntL + 32; LAS float* rbias = (LAS float*)(cntL + 64);
    unsigned* list = (unsigned*)(F.ws + WS_LIST); unsigned* tslot = (unsigned*)(F.ws + WS_TSLOT); float* tgate = (float*)(F.ws + WS_TGATE);
    __syncthreads();
    { const float* rw = KIN(I_RTW) + (size_t)l * DM * NEXP;
#pragma unroll
      for (int it = F.tid; it < 32 * 2 * 64; it += NWAVES * 64) { const int ln = it & 63, nt = (it >> 6) & 1, s = it >> 7; const int e = 16 * nt + (ln & 15), k0 = 32 * s + 8 * (ln >> 4);
          float w[8], hi[8];
#pragma unroll
          for (int j = 0; j < 8; ++j) { w[j] = rw[(size_t)(k0 + j) * NEXP + e]; }
          v4u ph, pl;
          { unsigned a = pk2(w[0], w[1]), b2 = pk2(w[2], w[3]), c2 = pk2(w[4], w[5]), d2 = pk2(w[6], w[7]); ph = (v4u){a, b2, c2, d2};
            hi[0] = bflo(a); hi[1] = bfhi(a); hi[2] = bflo(b2); hi[3] = bfhi(b2); hi[4] = bflo(c2); hi[5] = bfhi(c2); hi[6] = bflo(d2); hi[7] = bfhi(d2); }
          pl = (v4u){pk2(w[0] - hi[0], w[1] - hi[1]), pk2(w[2] - hi[2], w[3] - hi[3]), pk2(w[4] - hi[4], w[5] - hi[5]), pk2(w[6] - hi[6], w[7] - hi[7])};
          *(LAS v4u*)(frag + ((s * 2 + nt) * 2 + 0) * 1024 + ln * 16) = ph; *(LAS v4u*)(frag + ((s * 2 + nt) * 2 + 1) * 1024 + ln * 16) = pl; }
      if (F.tid < NEXP) rbias[F.tid] = KIN(I_RTB)[l * NEXP + F.tid];
    }
    LAS float* modA = (LAS float*)(F.lds + 148480); LAS float* modB = (LAS float*)(F.lds + 156160);
    for (int rb = F.vcu * 256; rb < MTOK; rb += F.G * 256) {
        const int b = rb / SEQ;
        if (F.tid < NEXP) cntL[F.tid] = 0;
        { const float* mv = (const float*)(F.ws + WS_MOD) + (size_t)(l * NBATCH + b) * 6 * DM;
          int t1 = threadIdx.x; asm volatile("" : "+v"(t1));
          for (int c = t1; c < DM; c += NWAVES * 64) { modA[c] = KIN(I_N2G)[l * DM + c] * (mv[4 * DM + c] + 1.0f); modB[c] = mv[3 * DM + c]; } }
        __syncthreads();
        int my_el[2][TOPK]; float my_g[2][TOPK];
#pragma unroll
        for (int grp = 0; grp < 2; ++grp) {
            __builtin_amdgcn_sched_barrier(0);
            const int row0 = rb + 32 * F.wave + 16 * grp, rr = F.lane & 15, gq = F.lane >> 4;
            const bf16* xp = (const bf16*)(F.ws + WS_XB) + (size_t)(row0 + rr) * DM + 8 * gq; unsigned char* h8 = H8p + (size_t)(row0 + rr) * DM + 8 * gq;
            v4u xr[32]; float s2 = 0.f;
#pragma unroll
            for (int s_ = 0; s_ < 32; ++s_) xr[s_] = *(const v4u*)(xp + 32 * s_);
#pragma unroll
            for (int s_ = 0; s_ < 32; ++s_) { const v4u q = xr[s_]; const f32x4 a = (f32x4){bflo(q.x), bfhi(q.x), bflo(q.y), bfhi(q.y)}, c = (f32x4){bflo(q.z), bfhi(q.z), bflo(q.w), bfhi(q.w)}; const f32x4 t = a * a + c * c; s2 += (t.x + t.y) + (t.z + t.w); }
            s2 += __shfl_xor(s2, 16); s2 += __shfl_xor(s2, 32);
            const float rstd = 1.0f / sqrtf(s2 * (1.0f / DM) + EPS);
            f32x4 acc0 = (f32x4){0.f, 0.f, 0.f, 0.f}, acc1 = (f32x4){0.f, 0.f, 0.f, 0.f};
#pragma unroll
            for (int s_ = 0; s_ < 32; ++s_) { v4u q = xr[s_]; asm volatile("" : "+v"(q.x), "+v"(q.y), "+v"(q.z), "+v"(q.w));
                const f32x4 A0 = *(const LAS f32x4*)(modA + 32 * s_ + 8 * gq), A1 = *(const LAS f32x4*)(modA + 32 * s_ + 8 * gq + 4), B0 = *(const LAS f32x4*)(modB + 32 * s_ + 8 * gq), B1 = *(const LAS f32x4*)(modB + 32 * s_ + 8 * gq + 4);
                const f32x4 h0 = ((f32x4){bflo(q.x), bfhi(q.x), bflo(q.y), bfhi(q.y)} * rstd) * A0 + B0, h1 = ((f32x4){bflo(q.z), bfhi(q.z), bflo(q.w), bfhi(q.w)} * rstd) * A1 + B1;
                const v4u av = pack8(h0, h1); const bf16x8 a = __builtin_bit_cast(bf16x8, av);
                if (MOE_FP8) { const f32x4 e0 = h0 * 8.0f, e1 = h1 * 8.0f; v2u w; w.x = pk4_fp8(e0.x, e0.y, e0.z, e0.w); w.y = pk4_fp8(e1.x, e1.y, e1.z, e1.w); *(v2u*)(h8 + 32 * s_) = w; }
                const bf16x8 b00 = *(const LAS bf16x8*)(frag + ((s_ * 2 + 0) * 2 + 0) * 1024 + F.lane * 16), b01 = *(const LAS bf16x8*)(frag + ((s_ * 2 + 0) * 2 + 1) * 1024 + F.lane * 16);
                const bf16x8 b10 = *(const LAS bf16x8*)(frag + ((s_ * 2 + 1) * 2 + 0) * 1024 + F.lane * 16), b11 = *(const LAS bf16x8*)(frag + ((s_ * 2 + 1) * 2 + 1) * 1024 + F.lane * 16);
                acc0 = __builtin_amdgcn_mfma_f32_16x16x32_bf16(a, b00, acc0, 0, 0, 0); acc0 = __builtin_amdgcn_mfma_f32_16x16x32_bf16(a, b01, acc0, 0, 0, 0);
                acc1 = __builtin_amdgcn_mfma_f32_16x16x32_bf16(a, b10, acc1, 0, 0, 0); acc1 = __builtin_amdgcn_mfma_f32_16x16x32_bf16(a, b11, acc1, 0, 0, 0);
                __builtin_amdgcn_sched_barrier(0);
            }
#pragma unroll
            for (int q = 0; q < 4; ++q) { lg[(4 * (F.lane >> 4) + q) * 33 + (F.lane & 15)] = acc0[q]; lg[(4 * (F.lane >> 4) + q) * 33 + 16 + (F.lane & 15)] = acc1[q]; }
            LDS_WAIT(); asm volatile("" ::: "memory");
            if (F.lane < 16) {
                unsigned taken = 0u; float tl[TOPK];
#pragma unroll
                for (int k = 0; k < TOPK; ++k) {
                    float best = -3.0e38f; int bi = 0;
                    for (int e = 0; e < NEXP; ++e) { const float v = lg[F.lane * 33 + e] + rbias[e]; if (!((taken >> e) & 1u) && v > best) { best = v; bi = e; } }
                    taken |= 1u << bi; my_el[grp][k] = bi; tl[k] = best;
                }
                float den = 0.f, ex[TOPK];
#pragma unroll
                for (int k = 0; k < TOPK; ++k) { ex[k] = __expf(tl[k] - tl[0]); den += ex[k]; }
#pragma unroll
                for (int k = 0; k < TOPK; ++k) { my_g[grp][k] = ex[k] / den; my_el[grp][k] |= __hip_atomic_fetch_add(&cntL[my_el[grp][k]], 1, __ATOMIC_RELAXED, __HIP_MEMORY_SCOPE_WORKGROUP) << 8; }
            } else {
#pragma unroll
                for (int k = 0; k < TOPK; ++k) { my_el[grp][k] = 0; my_g[grp][k] = 0.f; }
            }
            LDS_WAIT(); asm volatile("" ::: "memory");
        }
        __syncthreads();
        { int t2 = threadIdx.x; asm volatile("" : "+v"(t2));
          if (t2 < NEXP && !dry) baseL[t2] = (int)__hip_atomic_fetch_add(F.ctl + CW_CNT + l * 2048 + t2 * 64, (unsigned)cntL[t2], RLX_AGENT); }
        __syncthreads();
        int ln2 = threadIdx.x & 63; asm volatile("" : "+v"(ln2));
        if (ln2 < 16 && !dry) {
#pragma unroll
            for (int grp = 0; grp < 2; ++grp) {
                const int row = rb + 32 * F.wave + 16 * grp + ln2;
#pragma unroll
                for (int k = 0; k < TOPK; ++k) { const int e = my_el[grp][k] & 255, pos = baseL[e] + (my_el[grp][k] >> 8);
                    list[(size_t)e * LCAP + pos] = (unsigned)row; tslot[(size_t)row * 4 + k] = ((unsigned)e << 20) | (unsigned)pos; tgate[(size_t)row * 4 + k] = my_g[grp][k]; }
            }
        }
        __syncthreads();
    }
}

__device__ __forceinline__ void moe_gather(Frame& F, int l) {
    relaunder(F);
    build_tiles(F, l);
    const LAS int* ts = (const LAS int*)(F.lds + TAB_OFF); const LAS int* cnt = ts + 40;
    const unsigned* list = (const unsigned*)(F.ws + WS_LIST); const bf16* H = (const bf16*)(F.ws + WS_H); bf16* Xg = (bf16*)(F.ws + WS_R1);
    const int gw = F.vcu * NWAVES + F.wave, NGW = F.G * NWAVES, NR = ts[NEXP] * 256;
    for (int r = gw; r < NR; r += NGW) {
        const int mt = r >> 8; int e = 0;
        for (int k = 1; k < NEXP; ++k) e += (ts[k] <= mt) ? 1 : 0;
        const int pos = r - ts[e] * 256;
        unsigned tok = 0u; if (pos < cnt[e]) tok = ldu_vec(list + (size_t)e * LCAP + pos);
        const v4u* src = (const v4u*)(H + (size_t)tok * DM); v4u* dst = (v4u*)(Xg + (size_t)r * DM);
        dst[F.lane] = src[F.lane]; dst[F.lane + 64] = src[F.lane + 64];
    }
}

__device__ __forceinline__ void moe_build_tt(Frame& F, int nN) {
    const LAS int* ts = (const LAS int*)(F.lds + TAB_OFF); const LAS int* cnt = ts + 40;
    LAS unsigned short* tt = (LAS unsigned short*)(F.lds + 131072);
    const unsigned* list = (const unsigned*)(F.ws + WS_LIST); const int NU = ts[NEXP] * nN;
    const int tsk = (F.lane >= 1 && F.lane < NEXP) ? ts[F.lane] : 0x7fffffff;
#pragma unroll 1
    for (int jo = 0; jo < 18; jo += 3) {
        unsigned tok[3];
#pragma unroll
        for (int ji = 0; ji < 3; ++ji) { const int i = 2 * (jo + ji) + (F.tid >> 8), r = F.tid & 255, L = i * F.G + F.vcu, mt = L / nN;
            const int e = (int)__builtin_popcountll(__ballot(tsk <= mt)); const int pos = (mt - ts[e]) * 256 + r;
            tok[ji] = 0u; if (L < NU && pos < cnt[e]) tok[ji] = list[(size_t)e * LCAP + pos]; }
#pragma unroll
        for (int ji = 0; ji < 3; ++ji) { const int i = 2 * (jo + ji) + (F.tid >> 8), r = F.tid & 255, L = i * F.G + F.vcu;
            if (L < NU) tt[i * 256 + r] = (unsigned short)tok[ji]; }
    }
    __syncthreads();
}

using pg8::Unit;

struct EpiHgrnIn {
    static constexpr bool PERM = true; static constexpr int NST = 16;
    unsigned char* r1; const float* lb; unsigned smap; float asc;
    __device__ __forceinline__ void operator()(const f32x4 (&acc)[2][2][4][2], const Unit& u, int wr, int wc, int fr, int fq) const {
        const int seg = (int)((smap >> (4 * (u.pn >> 2))) & 15u), row0 = u.pm * 256 + wr * 64 + fr, cs0 = (u.pn & 3) * 256 + wc * 32 + 8 * fq;
        if (seg == 1) {
            bf16* LFb = (bf16*)(r1 + 128 * MiB);
#pragma unroll
            for (int bj = 0; bj < 2; ++bj) {
                f32x4 lbv[2]; lbv[0] = *(const f32x4*)(lb + cs0 + bj * 128); lbv[1] = *(const f32x4*)(lb + cs0 + bj * 128 + 4);
#pragma unroll
                for (int ai = 0; ai < 2; ++ai)
#pragma unroll
                    for (int m = 0; m < 4; ++m) { const size_t ro = (size_t)(row0 + ai * 128 + m * 16) * DM + cs0 + bj * 128; f32x4 lf[2];
#pragma unroll
                        for (int n = 0; n < 2; ++n)
#pragma unroll
                            for (int j = 0; j < 4; ++j) { const float f = fminf(fmaxf(acc[ai][bj][m][n][j] * asc, -60.f), 60.f), l0 = lbv[n][j], ef = __expf(f);
                                const float sg = ef * __builtin_amdgcn_rcpf(1.f + ef);
                                lf[n][j] = __log2f(l0 + (1.f - l0) * sg); }
                        *(v4u*)(LFb + ro) = pack8(lf[0], lf[1]);
                        __builtin_amdgcn_sched_barrier(0); }
            }
        } else {
            bf16* dst = (bf16*)(r1 + (seg == 0 ? 0 : (seg == 2 ? 256 * MiB : 384 * MiB))); const bool act = (seg != 2);
#pragma unroll
            for (int ai = 0; ai < 2; ++ai)
#pragma unroll
                for (int m = 0; m < 4; ++m) { const size_t ro = (size_t)(row0 + ai * 128 + m * 16) * DM;
#pragma unroll
                    for (int bj = 0; bj < 2; ++bj) { f32x4 v0 = acc[ai][bj][m][0] * asc, v1 = acc[ai][bj][m][1] * asc;
                        if (act) {
                            v0 = silu4_(v0); v1 = silu4_(v1); }
                        *(v4u*)(dst + ro + cs0 + bj * 128) = pack8(v0, v1); }
                    __builtin_amdgcn_sched_barrier(0); }
        }
    }
};

struct EpiRetIn {
    static constexpr bool PERM = true; static constexpr int NST = 16;
    unsigned char* r1; const int* positions; float asc;
    __device__ __forceinline__ void operator()(const f32x4 (&acc)[2][2][4][2], const Unit& u, int wr, int wc, int fr, int fq) const {
        const int row0 = u.pm * 256 + wr * 64 + fr, cl = wc * 32 + 8 * fq;
        if (u.pn < 8) {
            bf16* dst = (bf16*)(r1 + ((u.pn < 4) ? 0 : 128 * MiB)); const float sc = ((u.pn < 4) ? 1.0f : 0.0625f) * asc; const int hh = u.pn & 3;
            float invrev[2][4];
#pragma unroll
            for (int n = 0; n < 2; ++n)
#pragma unroll
                for (int j = 0; j < 4; ++j) invrev[n][j] = exp2f(-(float)(cl + 4 * n + j) * 0.10462765653188542f) * 0.15915494309189535f;
#pragma unroll
            for (int ai = 0; ai < 2; ++ai)
#pragma unroll
                for (int m = 0; m < 4; ++m) { const int row = row0 + ai * 128 + m * 16; const float pos = (float)positions[row]; const size_t ro = (size_t)row * DM + hh * 256 + cl;
                    f32x4 o1[2], o2[2];
#pragma unroll
                    for (int n = 0; n < 2; ++n)
#pragma unroll
                        for (int j = 0; j < 4; ++j) { const float rev = pos * invrev[n][j], fr_ = rev - floorf(rev); const float cs = __builtin_amdgcn_cosf(fr_), sn = __builtin_amdgcn_sinf(fr_);
                            const float x1 = acc[ai][0][m][n][j], x2 = acc[ai][1][m][n][j]; o1[n][j] = (x1 * cs - x2 * sn) * sc; o2[n][j] = (x2 * cs + x1 * sn) * sc; }
                    *(v4u*)(dst + ro) = pack8(o1[0], o1[1]); *(v4u*)(dst + ro + 128) = pack8(o2[0], o2[1]); }
        } else {
            const bool isg = (u.pn >= 16); bf16* dst = (bf16*)(r1 + (isg ? 512 * MiB : 256 * MiB)); const int ct = (isg ? u.pn - 16 : u.pn - 8) * 256 + cl;
#pragma unroll
            for (int ai = 0; ai < 2; ++ai)
#pragma unroll
                for (int m = 0; m < 4; ++m) { const size_t ro = (size_t)(row0 + ai * 128 + m * 16) * 2048 + ct;
#pragma unroll
                    for (int bj = 0; bj < 2; ++bj) { f32x4 v0 = acc[ai][bj][m][0] * asc, v1 = acc[ai][bj][m][1] * asc;
                        if (isg) {
                            v0 = silu4_(v0); v1 = silu4_(v1); }
                        *(v4u*)(dst + ro + bj * 128) = pack8(v0, v1); } }
        }
    }
};

template <bool XF32>
struct EpiOutT {
    static constexpr bool PERM = true; static constexpr int NST = XF32 ? 4 : 8;
    const void* xin; bf16* xout; const float* gate; float asc;
    __device__ __forceinline__ void operator()(const f32x4 (&acc)[2][2][4][2], const Unit& u, int wr, int wc, int fr, int fq) const {
        const int row0 = u.pm * 256 + wr * 64 + fr, c0 = u.pn * 256 + wc * 32 + 8 * fq, b = (u.pm * 256) / SEQ;
        f32x4 gv[2][2];
#pragma unroll
        for (int bj = 0; bj < 2; ++bj)
#pragma unroll
            for (int n = 0; n < 2; ++n) gv[bj][n] = *(const f32x4*)(gate + (size_t)b * 6 * DM + c0 + bj * 128 + 4 * n) * asc;
        if constexpr (XF32) {
#pragma unroll
            for (int ai = 0; ai < 2; ++ai)
#pragma unroll
                for (int mp = 0; mp < 2; ++mp) { f32x4 xi[2][2][2];
#pragma unroll
                    for (int mm = 0; mm < 2; ++mm)
#pragma unroll
                        for (int bj = 0; bj < 2; ++bj)
#pragma unroll
                            for (int n = 0; n < 2; ++n) xi[mm][bj][n] = *(const f32x4*)((const float*)xin + (size_t)(row0 + ai * 128 + (2 * mp + mm) * 16) * DM + c0 + bj * 128 + 4 * n);
#pragma unroll
                    for (int mm = 0; mm < 2; ++mm)
#pragma unroll
                        for (int bj = 0; bj < 2; ++bj)
                            *(v4u*)(xout + (size_t)(row0 + ai * 128 + (2 * mp + mm) * 16) * DM + c0 + bj * 128) = pack8(xi[mm][bj][0] + gv[bj][0] * acc[ai][bj][2 * mp + mm][0], xi[mm][bj][1] + gv[bj][1] * acc[ai][bj][2 * mp + mm][1]);
                    asm volatile("" ::: "memory"); }
        } else {
#pragma unroll
            for (int ai = 0; ai < 2; ++ai) { v4u xi[4][2];
#pragma unroll
                for (int m = 0; m < 4; ++m)
#pragma unroll
                    for (int bj = 0; bj < 2; ++bj) xi[m][bj] = *(const v4u*)((const bf16*)xin + (size_t)(row0 + ai * 128 + m * 16) * DM + c0 + bj * 128);
#pragma unroll
                for (int m = 0; m < 4; ++m)
#pragma unroll
                    for (int bj = 0; bj < 2; ++bj) { const v4u q = xi[m][bj];
                        const f32x4 lo = (f32x4){bflo(q.x), bfhi(q.x), bflo(q.y), bfhi(q.y)}, hi = (f32x4){bflo(q.z), bfhi(q.z), bflo(q.w), bfhi(q.w)};
                        *(v4u*)(xout + (size_t)(row0 + ai * 128 + m * 16) * DM + c0 + bj * 128) = pack8(lo + gv[bj][0] * acc[ai][bj][m][0], hi + gv[bj][1] * acc[ai][bj][m][1]); }
                asm volatile("" ::: "memory"); }
        }
    }
};

struct EpiMoe1F8 {
    static constexpr bool PERM = true; static constexpr int NST = 8;
    unsigned char* A2; const float* b1;
    __device__ __forceinline__ void operator()(const f32x4 (&acc)[2][2][4][2], const Unit& u, int wr, int wc, int fr, int fq) const {
        const int row0 = u.pm * 256 + wr * 64 + fr, gc = u.nn * 128 + wc * 32 + 8 * fq; const float* bp = b1 + (size_t)u.e * 2048;
        f32x4 bg[2], bl[2];
#pragma unroll
        for (int n = 0; n < 2; ++n) { bg[n] = *(const f32x4*)(bp + gc + 4 * n); bl[n] = *(const f32x4*)(bp + 1024 + gc + 4 * n); }
#pragma unroll
        for (int ai = 0; ai < 2; ++ai)
#pragma unroll
            for (int m = 0; m < 4; ++m) { f32x4 o[2];
#pragma unroll
                for (int n = 0; n < 2; ++n) {
                    f32x4 g = acc[ai][0][m][n] * (1.0f / 512.f) + bg[n], li = acc[ai][1][m][n] * (1.0f / 512.f) + bl[n];
                    g = __builtin_elementwise_min(g, (f32x4){7.0f, 7.0f, 7.0f, 7.0f});
                    li = __builtin_elementwise_min(__builtin_elementwise_max(li, (f32x4){-7.0f, -7.0f, -7.0f, -7.0f}), (f32x4){7.0f, 7.0f, 7.0f, 7.0f});
                    const f32x4 t = g * (-1.702f * 1.4426950408889634f); f32x4 e, r;
#pragma unroll
                    for (int j = 0; j < 4; ++j) e[j] = __builtin_amdgcn_exp2f(t[j]);
                    const f32x4 d = e + 1.0f;
#pragma unroll
                    for (int j = 0; j < 4; ++j) r[j] = __builtin_amdgcn_rcpf(d[j]);
                    o[n] = (g * r) * (li * 4.0f + 4.0f); }
                v2u w; w.x = pk4_fp8(o[0].x, o[0].y, o[0].z, o[0].w); w.y = pk4_fp8(o[1].x, o[1].y, o[1].z, o[1].w);
                *(v2u*)(A2 + (size_t)(row0 + ai * 128 + m * 16) * DM + gc) = w; }
    }
};
struct EpiMoe1 {
    static constexpr bool PERM = true; static constexpr int NST = 8;
    bf16* A2; const float* b1;
    __device__ __forceinline__ void operator()(const f32x4 (&acc)[2][2][4][2], const Unit& u, int wr, int wc, int fr, int fq) const {
        const int row0 = u.pm * 256 + wr * 64 + fr, gc = u.nn * 128 + wc * 32 + 8 * fq; const float* bp = b1 + (size_t)u.e * 2048;
        f32x4 bg[2], bl[2];
#pragma unroll
        for (int n = 0; n < 2; ++n) { bg[n] = *(const f32x4*)(bp + gc + 4 * n); bl[n] = *(const f32x4*)(bp + 1024 + gc + 4 * n); }
#pragma unroll
        for (int ai = 0; ai < 2; ++ai)
#pragma unroll
            for (int m = 0; m < 4; ++m) { f32x4 o[2];
#pragma unroll
                for (int n = 0; n < 2; ++n)
#pragma unroll
                    for (int j = 0; j < 4; ++j) { const float g = fminf(acc[ai][0][m][n][j] + bg[n][j], 7.0f), li = fminf(fmaxf(acc[ai][1][m][n][j] + bl[n][j], -7.0f), 7.0f);
                        o[n][j] = g * sigmoidf_(1.702f * g) * (li + 1.0f); }
                *(v4u*)(A2 + (size_t)(row0 + ai * 128 + m * 16) * DM + gc) = pack8(o[0], o[1]); }
    }
};

template <int VAR = 0> struct EpiMoe2T {
    static constexpr bool PERM = true; static constexpr int NST = (VAR == 2) ? 0 : 16;
    bf16* Y; const float* b2; float sc;
    __device__ __forceinline__ void operator()(const f32x4 (&acc)[2][2][4][2], const Unit& u, int wr, int wc, int fr, int fq) const {
        const int row0 = u.pm * 256 + wr * 64 + fr, c0 = u.nn * 256 + wc * 32 + 8 * fq; const float* bp = b2 + (size_t)u.e * DM;
        f32x4 bv[2][2];
#pragma unroll
        for (int bj = 0; bj < 2; ++bj)
#pragma unroll
            for (int n = 0; n < 2; ++n) bv[bj][n] = (VAR == 1) ? (f32x4){sc, sc, sc, sc} : *(const f32x4*)(bp + c0 + bj * 128 + 4 * n);
        float sink = 0.f;
#pragma unroll
        for (int ai = 0; ai < 2; ++ai)
#pragma unroll
            for (int m = 0; m < 4; ++m) { const size_t ro = (size_t)(row0 + ai * 128 + m * 16) * YLD + c0;
#pragma unroll
                for (int bj = 0; bj < 2; ++bj) { const f32x4 v0 = acc[ai][bj][m][0] * sc + bv[bj][0], v1 = acc[ai][bj][m][1] * sc + bv[bj][1];
                    if (VAR == 2) { const v4u p = pack8(v0, v1); sink += __uint_as_float(p.x ^ p.y ^ p.z ^ p.w); } else *(v4u*)(Y + ro + bj * 128) = pack8(v0, v1); } }
        if (VAR == 2) asm volatile("" :: "v"(sink));
    }
};
typedef EpiMoe2T<0> EpiMoe2;
struct EpiMoe2Y8 {
    static constexpr bool PERM = true; static constexpr int NST = 16;
    unsigned char* Y; const float* b2; float sc;
    __device__ __forceinline__ void operator()(const f32x4 (&acc)[2][2][4][2], const Unit& u, int wr, int wc, int fr, int fq) const {
        const int row0 = u.pm * 256 + wr * 64 + fr, c0 = u.nn * 256 + wc * 32 + 8 * fq; const float* bp = b2 + (size_t)u.e * DM;
        f32x4 bv[2][2]; const float s32 = sc * YSC;
#pragma unroll
        for (int bj = 0; bj < 2; ++bj)
#pragma unroll
            for (int n = 0; n < 2; ++n) bv[bj][n] = *(const f32x4*)(bp + c0 + bj * 128 + 4 * n) * YSC;
#pragma unroll
        for (int ai = 0; ai < 2; ++ai)
#pragma unroll
            for (int m = 0; m < 4; ++m) { const size_t ro = (size_t)(row0 + ai * 128 + m * 16) * YLD + c0;
#pragma unroll
                for (int bj = 0; bj < 2; ++bj) { f32x4 v0 = acc[ai][bj][m][0] * s32 + bv[bj][0], v1 = acc[ai][bj][m][1] * s32 + bv[bj][1];
#pragma unroll
                    for (int q = 0; q < 4; ++q) { v0[q] = __builtin_fminf(__builtin_fmaxf(v0[q], -448.0f), 448.0f); v1[q] = __builtin_fminf(__builtin_fmaxf(v1[q], -448.0f), 448.0f); }
                    v2u w; w.x = pk4_fp8(v0.x, v0.y, v0.z, v0.w); w.y = pk4_fp8(v1.x, v1.y, v1.z, v1.w);
                    *(v2u*)(Y + ro + bj * 128) = w; } }
    }
};

__device__ __forceinline__ void hgrn_scan(Frame& F, int j) {
    relaunder(F);
    const bf16* Q = (const bf16*)(F.ws + WS_R1); const bf16* LFb = (const bf16*)(F.ws + WS_R1 + 128 * MiB); const bf16* V = (const bf16*)(F.ws + WS_R1 + 256 * MiB); const bf16* SG = (const bf16*)(F.ws + WS_R1 + 384 * MiB);
    bf16* O = (bf16*)(F.ws + WS_R2);
    LAS float* Qs = (LAS float*)(F.lds); LAS float* Ks = Qs + 4096; LAS float* Fs = Qs + 8192; LAS float* Vs = Qs + 12288; LAS float* P = Qs + 16384;
    const int v = F.tid & 127, kq = F.tid >> 7, t16 = F.tid >> 4, c8 = (F.tid & 15) * 8;
    f32x4 gain0 = *(const f32x4*)(KIN(I_HGAIN) + j * 128 + c8), gain1 = *(const f32x4*)(KIN(I_HGAIN) + j * 128 + c8 + 4);
    for (int u = F.vcu; u < NBATCH * HG_H; u += F.G) {
        const int b = u / HG_H, h = u % HG_H;
        float S[32];
#pragma unroll
        for (int i = 0; i < 32; ++i) S[i] = 0.f;
        for (int ch = 0; ch < SEQ / 32; ++ch) {
            const int row0 = b * SEQ + 32 * ch; const size_t gi = (size_t)(row0 + t16) * DM + h * 128 + c8;
            __syncthreads();
            { const v4u q = *(const v4u*)(Q + gi), lw = *(const v4u*)(LFb + gi), vv = *(const v4u*)(V + gi);
              const f32x4 f0 = (f32x4){exp2f(bflo(lw.x)), exp2f(bfhi(lw.x)), exp2f(bflo(lw.y)), exp2f(bfhi(lw.y))}, f1 = (f32x4){exp2f(bflo(lw.z)), exp2f(bfhi(lw.z)), exp2f(bflo(lw.w)), exp2f(bfhi(lw.w))};
              LAS f32x4* d;
              d = (LAS f32x4*)(Qs + t16 * 128 + c8); d[0] = (f32x4){bflo(q.x), bfhi(q.x), bflo(q.y), bfhi(q.y)}; d[1] = (f32x4){bflo(q.z), bfhi(q.z), bflo(q.w), bfhi(q.w)};
              d = (LAS f32x4*)(Ks + t16 * 128 + c8); d[0] = 1.0f - f0; d[1] = 1.0f - f1;
              d = (LAS f32x4*)(Vs + t16 * 128 + c8); d[0] = (f32x4){bflo(vv.x), bfhi(vv.x), bflo(vv.y), bfhi(vv.y)}; d[1] = (f32x4){bflo(vv.z), bfhi(vv.z), bflo(vv.w), bfhi(vv.w)};
              d = (LAS f32x4*)(Fs + t16 * 128 + c8); d[0] = f0; d[1] = f1; }
            __syncthreads();
            for (int t = 0; t < 32; ++t) {
                const float vt = Vs[t * 128 + v]; float a = 0.f;
#pragma unroll
                for (int i4 = 0; i4 < 8; ++i4) { const f32x4 f4 = *(const LAS f32x4*)(Fs + t * 128 + 32 * kq + 4 * i4), k4 = *(const LAS f32x4*)(Ks + t * 128 + 32 * kq + 4 * i4), q4 = *(const LAS f32x4*)(Qs + t * 128 + 32 * kq + 4 * i4);
#pragma unroll
                    for (int i = 0; i < 4; ++i) { S[4 * i4 + i] = f4[i] * S[4 * i4 + i] + k4[i] * vt; a += q4[i] * S[4 * i4 + i]; } }
                P[(t * 4 + kq) * 128 + v] = a;
            }
            __syncthreads();
            { f32x4 o0 = (f32x4){0.f, 0.f, 0.f, 0.f}, o1 = o0;
#pragma unroll
              for (int q = 0; q < 4; ++q) { o0 += *(const LAS f32x4*)(P + (t16 * 4 + q) * 128 + c8); o1 += *(const LAS f32x4*)(P + (t16 * 4 + q) * 128 + c8 + 4); }
              float ss = (o0.x * o0.x + o0.y * o0.y) + (o0.z * o0.z + o0.w * o0.w) + (o1.x * o1.x + o1.y * o1.y) + (o1.z * o1.z + o1.w * o1.w);
              ss += __shfl_xor(ss, 1); ss += __shfl_xor(ss, 2); ss += __shfl_xor(ss, 4); ss += __shfl_xor(ss, 8);
              const float r = 1.0f / sqrtf(ss * (1.0f / 128.f) + EPS);
              const v4u sg = *(const v4u*)(SG + gi);
              f32x4 a0 = o0 * r * gain0, a1 = o1 * r * gain1;
              a0.x *= bflo(sg.x); a0.y *= bfhi(sg.x); a0.z *= bflo(sg.y); a0.w *= bfhi(sg.y); a1.x *= bflo(sg.z); a1.y *= bfhi(sg.z); a1.z *= bflo(sg.w); a1.w *= bfhi(sg.w);
              *(v4u*)(O + gi) = pack8(a0, a1); }
        }
    }
}

__device__ __forceinline__ void ret_scan(Frame& F) {
    relaunder(F);
    const bf16* Q = (const bf16*)(F.ws + WS_R1); const bf16* K = (const bf16*)(F.ws + WS_R1 + 128 * MiB); const bf16* V = (const bf16*)(F.ws + WS_R1 + 256 * MiB); const bf16* SG = (const bf16*)(F.ws + WS_R1 + 512 * MiB);
    bf16* O = (bf16*)(F.ws + WS_R2);
    LAS bf16* Qs = (LAS bf16*)(F.lds); LAS bf16* Ks = (LAS bf16*)(F.lds + 33792); LAS bf16* Vs = (LAS bf16*)(F.lds + 67584);
    LAS float* St = (LAS float*)(F.lds + 133120); LAS float* wred = (LAS float*)(F.lds + 149504); LAS float* rtab = (LAS float*)(F.lds + 151552);
    for (int u = F.vcu; u < NBATCH * RT_H * 16; u += F.G) {
        const int bh = u >> 4, cp = u & 15, b = bh >> 2, h = bh & 3;
        const float lg2g = log2f(1.0f - exp2f(-5.0f - (float)h));
        for (int half = 0; half < 2; ++half) {
            const int c = half ? 31 - cp : cp; const int row0 = b * SEQ + 64 * c;
            __syncthreads();
#pragma unroll
            for (int i = 0; i < 4; ++i) { const int p = F.tid + 512 * i, r = p >> 5, cc = (p & 31) * 8; *(LAS v4u*)(Qs + r * 264 + cc) = *(const v4u*)(Q + (size_t)(row0 + r) * DM + h * 256 + cc); }
            float acc[64];
#pragma unroll
            for (int n = 0; n < 64; ++n) acc[n] = 0.f;
            for (int cq = 0; cq <= c; ++cq) {
                const int krow0 = b * SEQ + 64 * cq;
                __syncthreads();
#pragma unroll
                for (int i = 0; i < 4; ++i) { const int p = F.tid + 512 * i, r = p >> 5, cc = (p & 31) * 8; *(LAS v4u*)(Ks + r * 264 + cc) = *(const v4u*)(K + (size_t)(krow0 + r) * DM + h * 256 + cc); }
#pragma unroll
                for (int i = 0; i < 8; ++i) { const int p = F.tid + 512 * i, r = p >> 6, cc = (p & 63) * 8; *(LAS v4u*)(Vs + r * 512 + cc) = *(const v4u*)(V + (size_t)(krow0 + r) * 2048 + h * 512 + cc); }
                __syncthreads();
                { float s[8];
#pragma unroll
                  for (int j8 = 0; j8 < 8; ++j8) s[j8] = 0.f;
                  for (int dc = 0; dc < 32; ++dc) {
                      const v4u kv = *(const LAS v4u*)(Ks + F.lane * 264 + dc * 8);
                      const float k0 = bflo(kv.x), k1 = bfhi(kv.x), k2 = bflo(kv.y), k3 = bfhi(kv.y), k4 = bflo(kv.z), k5 = bfhi(kv.z), k6 = bflo(kv.w), k7 = bfhi(kv.w);
#pragma unroll
                      for (int j8 = 0; j8 < 8; ++j8) { const v4u qv = *(const LAS v4u*)(Qs + (8 * F.wave + j8) * 264 + dc * 8);
                          s[j8] += (bflo(qv.x) * k0 + bfhi(qv.x) * k1) + (bflo(qv.y) * k2 + bfhi(qv.y) * k3) + (bflo(qv.z) * k4 + bfhi(qv.z) * k5) + (bflo(qv.w) * k6 + bfhi(qv.w) * k7); }
                  }
                  f32x4 w0, w1;
#pragma unroll
                  for (int j8 = 0; j8 < 8; ++j8) { const float dist = fabsf((float)((64 * c + 8 * F.wave + j8) - (64 * cq + F.lane))); const float val = s[j8] * exp2f(dist * lg2g); if (j8 < 4) w0[j8] = val; else w1[j8 - 4] = val; }
                  *(LAS f32x4*)(St + F.lane * 64 + 8 * F.wave) = w0; *(LAS f32x4*)(St + F.lane * 64 + 8 * F.wave + 4) = w1; }
                __syncthreads();
                for (int m2 = 0; m2 < 64; ++m2) {
                    const float vv = bf2f(Vs[m2 * 512 + F.tid]);
#pragma unroll
                    for (int n4 = 0; n4 < 16; ++n4) { const f32x4 sv = *(const LAS f32x4*)(St + m2 * 64 + 4 * n4); acc[4 * n4 + 0] += sv.x * vv; acc[4 * n4 + 1] += sv.y * vv; acc[4 * n4 + 2] += sv.z * vv; acc[4 * n4 + 3] += sv.w * vv; }
                }
            }
#pragma unroll
            for (int n = 0; n < 64; ++n) { const float p = wave_sum(acc[n] * acc[n]); if (F.lane == 0) wred[F.wave * 64 + n] = p; }
            __syncthreads();
            if (F.tid < 64) { float s = 0.f;
#pragma unroll
                for (int w = 0; w < 8; ++w) s += wred[w * 64 + F.tid];
                rtab[F.tid] = 1.0f / sqrtf(s * (1.0f / 512.f) + EPS); }
            __syncthreads();
#pragma unroll
            for (int n = 0; n < 64; ++n) { const size_t gi = (size_t)(row0 + n) * 2048 + h * 512 + F.tid; const float sg = bf2f(SG[gi]); O[gi] = (bf16)(pk2(acc[n] * rtab[n] * sg, 0.f) & 0xffffu); }
        }
    }
}

typedef short s16x4 __attribute__((ext_vector_type(4)));
__device__ __forceinline__ unsigned off_b(unsigned row, unsigned ch) { return 256u * row + 16u * (ch ^ (((row & 3u) << 2) | ((row >> 2) & 3u))); }
__device__ __forceinline__ bf16x8 row_frag(const LAS unsigned char* tile, unsigned row, unsigned s4, unsigned g) { return *(const LAS bf16x8*)(tile + off_b(row, 4u * s4 + g)); }
__device__ __forceinline__ bf16x8 tr_frag16(const LAS unsigned char* tile, unsigned lane, unsigned c, unsigned ks) {
    const unsigned g = lane >> 4, q = (lane & 15u) >> 2, p = lane & 3u;
    const unsigned a0 = off_b(32u * ks + 8u * g + q, 2u * c + (p >> 1)) + 8u * (p & 1u), a1 = off_b(32u * ks + 8u * g + 4u + q, 2u * c + (p >> 1)) + 8u * (p & 1u);
    const s16x4 lo = __builtin_amdgcn_ds_read_tr16_b64_v4i16((LAS s16x4*)(tile + a0)), hi = __builtin_amdgcn_ds_read_tr16_b64_v4i16((LAS s16x4*)(tile + a1));
    return (bf16x8){lo[0], lo[1], lo[2], lo[3], hi[0], hi[1], hi[2], hi[3]};
}
#define RSB() __builtin_amdgcn_sched_barrier(0)
constexpr unsigned RQS = 528, RVS = 272;
template <unsigned RS> __device__ __forceinline__ bf16x8 tr_lin(const LAS unsigned char* img, unsigned trb, int c, int ks) {
    const s16x4 lo = __builtin_amdgcn_ds_read_tr16_b64_v4i16((LAS s16x4*)(img + trb + (32 * ks) * RS + 32 * c)), hi = __builtin_amdgcn_ds_read_tr16_b64_v4i16((LAS s16x4*)(img + trb + (32 * ks + 4) * RS + 32 * c));
    return (bf16x8){lo[0], lo[1], lo[2], lo[3], hi[0], hi[1], hi[2], hi[3]};
}
__device__ __forceinline__ void ret_scan_mfma(Frame& F) {
    relaunder(F);
    const bf16* Q = (const bf16*)(F.ws + WS_R1); const bf16* K = (const bf16*)(F.ws + WS_R1 + 128 * MiB); const bf16* V = (const bf16*)(F.ws + WS_R1 + 256 * MiB);
    bf16* O = (bf16*)(F.ws + WS_R2); float* SS = (float*)(F.ws + WS_R2 + 256 * MiB); const bf16* SGp = (const bf16*)(F.ws + WS_R1 + 512 * MiB);
    LAS unsigned char* Qi = F.lds; LAS unsigned char* Ki = F.lds + 33792; LAS unsigned char* Vi = F.lds + 67584; LAS unsigned char* Si = F.lds + 84992; LAS float* OT = (LAS float*)(F.lds + 94208);
    const unsigned w = (unsigned)F.wave;
    for (int u = F.vcu; u < NBATCH * RT_H * 4; u += F.G) {
        const int bh = u >> 2, vs = u & 3, b = bh >> 2, h = bh & 3;
        const float lg2g = log2f(1.0f - exp2f(-5.0f - (float)h)), cd = exp2f(64.0f * lg2g);
        f32x4 R[16];
#pragma unroll
        for (int i = 0; i < 16; ++i) R[i] = (f32x4){0.f, 0.f, 0.f, 0.f};
        v4u pq[4], pk[4], pv[2];
        { const int row0 = b * SEQ;
#pragma unroll
          for (int i = 0; i < 4; ++i) { const int p = F.tid + 512 * i, r = p >> 5, c32 = p & 31; pq[i] = *(const v4u*)(Q + (size_t)(row0 + r) * DM + h * 256 + c32 * 8); pk[i] = *(const v4u*)(K + (size_t)(row0 + r) * DM + h * 256 + c32 * 8); }
#pragma unroll
          for (int i = 0; i < 2; ++i) { const int p = F.tid + 512 * i, r = p >> 4, c16 = p & 15; pv[i] = *(const v4u*)(V + (size_t)(row0 + r) * 2048 + h * 512 + vs * 128 + c16 * 8); } }
        __syncthreads();
        for (int c = 0; c < SEQ / 64; ++c) {
            const int row0 = b * SEQ + 64 * c;
            unsigned tidl = (unsigned)F.tid; asm volatile("" : "+v"(tidl));
            const unsigned lane = tidl & 63u, g = lane >> 4, li = lane & 15u;
#pragma unroll
            for (int i = 0; i < 4; ++i) { const unsigned p = tidl + 512u * i, r = p >> 5, c32 = p & 31u; const unsigned o = r * RQS + 16u * c32; *(LAS v4u*)(Qi + o) = pq[i]; *(LAS v4u*)(Ki + o) = pk[i]; }
#pragma unroll
            for (int i = 0; i < 2; ++i) { const unsigned p = tidl + 512u * i, r = p >> 4, c16 = p & 15u; *(LAS v4u*)(Vi + r * RVS + 16u * c16) = pv[i]; }
            __syncthreads();
            if (c + 1 < SEQ / 64) { const int rn = row0 + 64;
#pragma unroll
                for (int i = 0; i < 4; ++i) { const unsigned p = tidl + 512u * i, r = p >> 5, c32 = p & 31u; pq[i] = *(const v4u*)(Q + (size_t)(rn + (int)r) * DM + h * 256 + c32 * 8); pk[i] = *(const v4u*)(K + (size_t)(rn + (int)r) * DM + h * 256 + c32 * 8); }
#pragma unroll
                for (int i = 0; i < 2; ++i) { const unsigned p = tidl + 512u * i, r = p >> 4, c16 = p & 15u; pv[i] = *(const v4u*)(V + (size_t)(rn + (int)r) * 2048 + h * 512 + vs * 128 + c16 * 8); } }
            RSB();
            const unsigned rb128 = li * RQS + 16u * g, rb64 = li * RQS + 8u * g, trq = (8u * g + (li >> 2)) * RQS + 8u * (li & 3u), trv = (8u * g + (li >> 2)) * RVS + 8u * (li & 3u);
            { const unsigned mt = w >> 1, nt0 = 2u * (w & 1u); f32x4 sa0 = (f32x4){0.f, 0.f, 0.f, 0.f}, sa1 = sa0;
              const LAS unsigned char* qrow = Qi + rb128 + mt * (16u * RQS); const LAS unsigned char* krow = Ki + rb128 + nt0 * (16u * RQS);
              bf16x8 qa[2][2], kb0[2][2], kb1[2][2];
#define RET_LDS(buf, s8b) do { _Pragma("unroll") for (int k2 = 0; k2 < 2; ++k2) { const int s8 = (s8b) + k2; \
                  qa[buf][k2] = *(const LAS bf16x8*)(qrow + 64 * s8); kb0[buf][k2] = *(const LAS bf16x8*)(krow + 64 * s8); kb1[buf][k2] = *(const LAS bf16x8*)(krow + 16 * RQS + 64 * s8); } } while (0)
              RET_LDS(0, 0); RSB();
#pragma unroll
              for (int bt = 0; bt < 4; ++bt) { if (bt < 3) RET_LDS((bt + 1) & 1, 2 * (bt + 1)); RSB();
#pragma unroll
                  for (int k2 = 0; k2 < 2; ++k2) { sa0 = __builtin_amdgcn_mfma_f32_16x16x32_bf16(qa[bt & 1][k2], kb0[bt & 1][k2], sa0, 0, 0, 0); sa1 = __builtin_amdgcn_mfma_f32_16x16x32_bf16(qa[bt & 1][k2], kb1[bt & 1][k2], sa1, 0, 0, 0); }
                  RSB(); }
#undef RET_LDS
#pragma unroll
              for (int q = 0; q < 4; ++q) { const int n = (int)(16u * mt + 4u * g) + q, m0 = (int)(16u * nt0 + li);
                  const float v0 = sa0[q] * exp2f(fabsf((float)(n - m0)) * lg2g), v1 = sa1[q] * exp2f(fabsf((float)(n - m0 - 16)) * lg2g); const unsigned pk = pk2(v0, v1);
                  *(LAS unsigned short*)(Si + (unsigned)n * 144u + 2u * (unsigned)m0) = (unsigned short)(pk & 0xffffu); *(LAS unsigned short*)(Si + (unsigned)n * 144u + 2u * (unsigned)m0 + 32u) = (unsigned short)(pk >> 16); } }
            RSB();
            f32x4 Oa[4];
#pragma unroll
            for (int mt = 0; mt < 4; ++mt) Oa[mt] = (f32x4){0.f, 0.f, 0.f, 0.f};
            { v2u qlo[2][4], qhi[2][4]; const LAS unsigned char* qp = Qi + rb64;
#define RET_LDQ(buf, s8) do { _Pragma("unroll") for (int mt = 0; mt < 4; ++mt) { qlo[buf][mt] = *(const LAS v2u*)(qp + mt * (16 * RQS) + 64 * (s8)); qhi[buf][mt] = *(const LAS v2u*)(qp + mt * (16 * RQS) + 64 * (s8) + 32); } } while (0)
              RET_LDQ(0, 0); RSB();
#pragma unroll
              for (int s8 = 0; s8 < 8; ++s8) { if (s8 < 7) RET_LDQ((s8 + 1) & 1, s8 + 1); RSB();
                  const v4u rt = (v4u){pk2(R[2 * s8][0], R[2 * s8][1]), pk2(R[2 * s8][2], R[2 * s8][3]), pk2(R[2 * s8 + 1][0], R[2 * s8 + 1][1]), pk2(R[2 * s8 + 1][2], R[2 * s8 + 1][3])}; const bf16x8 Rb = __builtin_bit_cast(bf16x8, rt);
#pragma unroll
                  for (int mt = 0; mt < 4; ++mt) { const v4u av = (v4u){qlo[s8 & 1][mt].x, qlo[s8 & 1][mt].y, qhi[s8 & 1][mt].x, qhi[s8 & 1][mt].y}; Oa[mt] = __builtin_amdgcn_mfma_f32_16x16x32_bf16(__builtin_bit_cast(bf16x8, av), Rb, Oa[mt], 0, 0, 0); }
                  RSB(); }
#undef RET_LDQ
            }
#pragma unroll
            for (int mt = 0; mt < 4; ++mt)
#pragma unroll
                for (int q = 0; q < 4; ++q) Oa[mt][q] *= exp2f((float)(16 * mt + 4 * (int)g + q + 1) * lg2g);
            __syncthreads();
            bf16x8 Vf[2], sf[4][2], ka[2][2][2];
#define RET_LDK(buf, dtb) do { _Pragma("unroll") for (int d2 = 0; d2 < 2; ++d2) _Pragma("unroll") for (int ks = 0; ks < 2; ++ks) ka[buf][d2][ks] = tr_lin<RQS>(Ki, trq, (dtb) + d2, ks); } while (0)
#pragma unroll
            for (int ks = 0; ks < 2; ++ks) Vf[ks] = tr_lin<RVS>(Vi + 32u * w, trv, 0, ks);
#pragma unroll
            for (int mt = 0; mt < 4; ++mt)
#pragma unroll
                for (int ks = 0; ks < 2; ++ks) sf[mt][ks] = *(const LAS bf16x8*)(Si + (16u * mt + li) * 144u + 64u * ks + 16u * g);
            RET_LDK(0, 0); RSB();
#pragma unroll
            for (int mt = 0; mt < 4; ++mt)
#pragma unroll
                for (int ks = 0; ks < 2; ++ks) Oa[mt] = __builtin_amdgcn_mfma_f32_16x16x32_bf16(sf[mt][ks], Vf[ks], Oa[mt], 0, 0, 0);
            bf16x8 Vd[2];
#pragma unroll
            for (int ks = 0; ks < 2; ++ks) { const v4u vv = __builtin_bit_cast(v4u, Vf[ks]); float f[8];
#pragma unroll
                for (int j = 0; j < 8; ++j) f[j] = exp2f((float)(63 - (32 * ks + 8 * (int)g + j)) * lg2g);
                const v4u sv = (v4u){pk2(bflo(vv.x) * f[0], bfhi(vv.x) * f[1]), pk2(bflo(vv.y) * f[2], bfhi(vv.y) * f[3]), pk2(bflo(vv.z) * f[4], bfhi(vv.z) * f[5]), pk2(bflo(vv.w) * f[6], bfhi(vv.w) * f[7])};
                Vd[ks] = __builtin_bit_cast(bf16x8, sv); }
            RSB();
#pragma unroll
            for (int bt = 0; bt < 8; ++bt) { if (bt < 7) RET_LDK((bt + 1) & 1, 2 * (bt + 1)); RSB();
#pragma unroll
                for (int d2 = 0; d2 < 2; ++d2) { const int dt = 2 * bt + d2; R[dt] = R[dt] * cd;
#pragma unroll
                    for (int ks = 0; ks < 2; ++ks) R[dt] = __builtin_amdgcn_mfma_f32_16x16x32_bf16(ka[bt & 1][d2][ks], Vd[ks], R[dt], 0, 0, 0); }
                RSB(); }
#undef RET_LDK
#pragma unroll
            for (int mt = 0; mt < 4; ++mt)
#pragma unroll
                for (int q = 0; q < 4; ++q) OT[(16u * mt + 4u * g + q) * 132u + 16u * w + li] = Oa[mt][q];
            __syncthreads();
            { const unsigned tn = tidl >> 3, vg = tidl & 7u; f32x4 o[4]; float ssq = 0.f;
#pragma unroll
              for (int i = 0; i < 4; ++i) { o[i] = *(const LAS f32x4*)(OT + tn * 132u + 16u * vg + 4u * i); ssq += (o[i].x * o[i].x + o[i].y * o[i].y) + (o[i].z * o[i].z + o[i].w * o[i].w); }
              ssq += __shfl_xor(ssq, 1); ssq += __shfl_xor(ssq, 2); ssq += __shfl_xor(ssq, 4);
              const size_t go = (size_t)(row0 + (int)tn) * 2048 + h * 512 + vs * 128 + 16 * vg; bf16* op = O + go;
              if (RET_FOLD) { const v4u g0 = *(const v4u*)(SGp + go), g1 = *(const v4u*)(SGp + go + 8);
                  o[0].x *= bflo(g0.x); o[0].y *= bfhi(g0.x); o[0].z *= bflo(g0.y); o[0].w *= bfhi(g0.y); o[1].x *= bflo(g0.z); o[1].y *= bfhi(g0.z); o[1].z *= bflo(g0.w); o[1].w *= bfhi(g0.w);
                  o[2].x *= bflo(g1.x); o[2].y *= bfhi(g1.x); o[2].z *= bflo(g1.y); o[2].w *= bfhi(g1.y); o[3].x *= bflo(g1.z); o[3].y *= bfhi(g1.z); o[3].z *= bflo(g1.w); o[3].w *= bfhi(g1.w); }
              *(v4u*)op = pack8(o[0], o[1]); *(v4u*)(op + 8) = pack8(o[2], o[3]);
              if (vg == 0) SS[((size_t)(row0 + (int)tn) * 4 + h) * 4 + vs] = ssq; }
        }
    }
}
__device__ __forceinline__ void ret_scan_mfma2(Frame& F) {
    relaunder(F);
    const bf16* Q = (const bf16*)(F.ws + WS_R1); const bf16* K = (const bf16*)(F.ws + WS_R1 + 128 * MiB); const bf16* V = (const bf16*)(F.ws + WS_R1 + 256 * MiB);
    bf16* O = (bf16*)(F.ws + WS_R2); float* SS = (float*)(F.ws + WS_R2 + 256 * MiB); const bf16* SGp = (const bf16*)(F.ws + WS_R1 + 512 * MiB);
    LAS unsigned char* Qi = F.lds; LAS unsigned char* Ki = F.lds + 33792; LAS unsigned char* Vi = F.lds + 67584; LAS unsigned char* Si = F.lds + 101376; LAS unsigned char* OT = F.lds + 110592;
    const unsigned w = (unsigned)F.wave;
    for (int u = F.vcu; u < NBATCH * RT_H * 2; u += F.G) {
        const int bh = u >> 1, vs2 = u & 1, b = bh >> 2, h = bh & 3, cbase = h * 512 + vs2 * 256;
        const float lg2g = log2f(1.0f - exp2f(-5.0f - (float)h)), cd = exp2f(64.0f * lg2g);
        f32x4 R[2][16];
#pragma unroll
        for (int cb = 0; cb < 2; ++cb)
#pragma unroll
            for (int i = 0; i < 16; ++i) R[cb][i] = (f32x4){0.f, 0.f, 0.f, 0.f};
        v4u pq[4], pk[4], pv[4];
        { const int row0 = b * SEQ;
#pragma unroll
          for (int i = 0; i < 4; ++i) { const int p = F.tid + 512 * i, r = p >> 5, c32 = p & 31; pq[i] = *(const v4u*)(Q + (size_t)(row0 + r) * DM + h * 256 + c32 * 8); pk[i] = *(const v4u*)(K + (size_t)(row0 + r) * DM + h * 256 + c32 * 8);
              pv[i] = *(const v4u*)(V + (size_t)(row0 + r) * 2048 + cbase + c32 * 8); } }
        __syncthreads();
        for (int c = 0; c < SEQ / 64; ++c) {
            const int row0 = b * SEQ + 64 * c;
            unsigned tidl = (unsigned)F.tid; asm volatile("" : "+v"(tidl));
            const unsigned lane = tidl & 63u, g = lane >> 4, li = lane & 15u;
#pragma unroll
            for (int i = 0; i < 4; ++i) { const unsigned p = tidl + 512u * i, r = p >> 5, c32 = p & 31u; const unsigned o = r * RQS + 16u * c32; *(LAS v4u*)(Qi + o) = pq[i]; *(LAS v4u*)(Ki + o) = pk[i]; *(LAS v4u*)(Vi + o) = pv[i]; }
            __syncthreads();
            RSB();
            const unsigned rb128 = li * RQS + 16u * g, rb64 = li * RQS + 8u * g, trq = (8u * g + (li >> 2)) * RQS + 8u * (li & 3u);
            { const unsigned mt = w >> 1, nt0 = 2u * (w & 1u); f32x4 sa0 = (f32x4){0.f, 0.f, 0.f, 0.f}, sa1 = sa0;
              const LAS unsigned char* qrow = Qi + rb128 + mt * (16u * RQS); const LAS unsigned char* krow = Ki + rb128 + nt0 * (16u * RQS);
              bf16x8 qa[2][2], kb0[2][2], kb1[2][2];
#define RET_LDS(buf, s8b) do { _Pragma("unroll") for (int k2 = 0; k2 < 2; ++k2) { const int s8 = (s8b) + k2; \
                  qa[buf][k2] = *(const LAS bf16x8*)(qrow + 64 * s8); kb0[buf][k2] = *(const LAS bf16x8*)(krow + 64 * s8); kb1[buf][k2] = *(const LAS bf16x8*)(krow + 16 * RQS + 64 * s8); } } while (0)
              RET_LDS(0, 0); RSB();
#pragma unroll
              for (int bt = 0; bt < 4; ++bt) { if (bt < 3) RET_LDS((bt + 1) & 1, 2 * (bt + 1)); RSB();
#pragma unroll
                  for (int k2 = 0; k2 < 2; ++k2) { sa0 = __builtin_amdgcn_mfma_f32_16x16x32_bf16(qa[bt & 1][k2], kb0[bt & 1][k2], sa0, 0, 0, 0); sa1 = __builtin_amdgcn_mfma_f32_16x16x32_bf16(qa[bt & 1][k2], kb1[bt & 1][k2], sa1, 0, 0, 0); }
                  RSB(); }
#undef RET_LDS
#pragma unroll
              for (int q = 0; q < 4; ++q) { const int n = (int)(16u * mt + 4u * g) + q, m0 = (int)(16u * nt0 + li);
                  const float v0 = sa0[q] * __builtin_amdgcn_exp2f(fabsf((float)(n - m0)) * lg2g), v1 = sa1[q] * __builtin_amdgcn_exp2f(fabsf((float)(n - m0 - 16)) * lg2g); const unsigned pk_ = pk2(v0, v1);
                  *(LAS unsigned short*)(Si + (unsigned)n * 144u + 2u * (unsigned)m0) = (unsigned short)(pk_ & 0xffffu); *(LAS unsigned short*)(Si + (unsigned)n * 144u + 2u * (unsigned)m0 + 32u) = (unsigned short)(pk_ >> 16); } }
            RSB();
            f32x4 Oa[4][2];
#pragma unroll
            for (int mt = 0; mt < 4; ++mt) { Oa[mt][0] = (f32x4){0.f, 0.f, 0.f, 0.f}; Oa[mt][1] = Oa[mt][0]; }
            { v2u qlo[2][4], qhi[2][4]; const LAS unsigned char* qp = Qi + rb64;
#define RET_LDQ(buf, s8) do { _Pragma("unroll") for (int mt = 0; mt < 4; ++mt) { qlo[buf][mt] = *(const LAS v2u*)(qp + mt * (16 * RQS) + 64 * (s8)); qhi[buf][mt] = *(const LAS v2u*)(qp + mt * (16 * RQS) + 64 * (s8) + 32); } } while (0)
              RET_LDQ(0, 0); RSB();
#pragma unroll
              for (int s8 = 0; s8 < 8; ++s8) { if (s8 < 7) RET_LDQ((s8 + 1) & 1, s8 + 1); RSB();
                  bf16x8 Rb[2];
#pragma unroll
                  for (int cb = 0; cb < 2; ++cb) { const v4u rt = (v4u){pk2(R[cb][2 * s8][0], R[cb][2 * s8][1]), pk2(R[cb][2 * s8][2], R[cb][2 * s8][3]), pk2(R[cb][2 * s8 + 1][0], R[cb][2 * s8 + 1][1]), pk2(R[cb][2 * s8 + 1][2], R[cb][2 * s8 + 1][3])}; Rb[cb] = __builtin_bit_cast(bf16x8, rt); }
#pragma unroll
                  for (int mt = 0; mt < 4; ++mt) { const v4u av = (v4u){qlo[s8 & 1][mt].x, qlo[s8 & 1][mt].y, qhi[s8 & 1][mt].x, qhi[s8 & 1][mt].y};
                      Oa[mt][0] = __builtin_amdgcn_mfma_f32_16x16x32_bf16(__builtin_bit_cast(bf16x8, av), Rb[0], Oa[mt][0], 0, 0, 0); Oa[mt][1] = __builtin_amdgcn_mfma_f32_16x16x32_bf16(__builtin_bit_cast(bf16x8, av), Rb[1], Oa[mt][1], 0, 0, 0); }
                  RSB(); }
#undef RET_LDQ
            }
#pragma unroll
            for (int mt = 0; mt < 4; ++mt)
#pragma unroll
                for (int q = 0; q < 4; ++q) { const float sc = __builtin_amdgcn_exp2f((float)(16 * mt + 4 * (int)g + q + 1) * lg2g); Oa[mt][0][q] *= sc; Oa[mt][1][q] *= sc; }
            __syncthreads();
            RSB();
            bf16x8 Vf[2][2];
#pragma unroll
            for (int cb = 0; cb < 2; ++cb)
#pragma unroll
                for (int ks = 0; ks < 2; ++ks) Vf[cb][ks] = tr_lin<RQS>(Vi + 64u * w + 32u * cb, trq, 0, ks);
#pragma unroll
            for (int mt = 0; mt < 4; ++mt) { const bf16x8 s0 = *(const LAS bf16x8*)(Si + (16u * mt + li) * 144u + 16u * g), s1 = *(const LAS bf16x8*)(Si + (16u * mt + li) * 144u + 64u + 16u * g);
#pragma unroll
                for (int cb = 0; cb < 2; ++cb) { Oa[mt][cb] = __builtin_amdgcn_mfma_f32_16x16x32_bf16(s0, Vf[cb][0], Oa[mt][cb], 0, 0, 0); Oa[mt][cb] = __builtin_amdgcn_mfma_f32_16x16x32_bf16(s1, Vf[cb][1], Oa[mt][cb], 0, 0, 0); } }
#pragma unroll
            for (int mt = 0; mt < 4; ++mt)
#pragma unroll
                for (int cb = 0; cb < 2; ++cb) { LAS unsigned char* op = OT + (16u * mt + 4u * g) * RQS + 2u * (32u * w + 16u * cb + li); const unsigned p0 = pk2(Oa[mt][cb][0], Oa[mt][cb][1]), p1 = pk2(Oa[mt][cb][2], Oa[mt][cb][3]);
                    *(LAS unsigned short*)(op) = (unsigned short)(p0 & 0xffffu); *(LAS unsigned short*)(op + RQS) = (unsigned short)(p0 >> 16); *(LAS unsigned short*)(op + 2 * RQS) = (unsigned short)(p1 & 0xffffu); *(LAS unsigned short*)(op + 3 * RQS) = (unsigned short)(p1 >> 16); }
            { const int rn = (c + 1 < SEQ / 64) ? row0 + 64 : row0;
#pragma unroll
                for (int i = 0; i < 4; ++i) { const unsigned p = tidl + 512u * i, r = p >> 5, c32 = p & 31u; pq[i] = *(const v4u*)(Q + (size_t)(rn + (int)r) * DM + h * 256 + c32 * 8); pk[i] = *(const v4u*)(K + (size_t)(rn + (int)r) * DM + h * 256 + c32 * 8);
                    pv[i] = *(const v4u*)(V + (size_t)(rn + (int)r) * 2048 + cbase + c32 * 8); } }
            RSB();
            bf16x8 Vd[2][2];
#pragma unroll
            for (int ks = 0; ks < 2; ++ks) { float f[8];
#pragma unroll
                for (int j = 0; j < 8; ++j) f[j] = __builtin_amdgcn_exp2f((float)(63 - (32 * ks + 8 * (int)g + j)) * lg2g);
#pragma unroll
                for (int cb = 0; cb < 2; ++cb) { const v4u vv = __builtin_bit_cast(v4u, Vf[cb][ks]);
                    const v4u sv = (v4u){pk2(bflo(vv.x) * f[0], bfhi(vv.x) * f[1]), pk2(bflo(vv.y) * f[2], bfhi(vv.y) * f[3]), pk2(bflo(vv.z) * f[4], bfhi(vv.z) * f[5]), pk2(bflo(vv.w) * f[6], bfhi(vv.w) * f[7])};
                    Vd[cb][ks] = __builtin_bit_cast(bf16x8, sv); } }
            {
#pragma unroll
              for (int bt = 0; bt < 8; ++bt) { bf16x8 ka[2][2];
#pragma unroll
                  for (int d2 = 0; d2 < 2; ++d2)
#pragma unroll
                      for (int ks = 0; ks < 2; ++ks) ka[d2][ks] = tr_lin<RQS>(Ki, trq, 2 * bt + d2, ks);
#pragma unroll
                  for (int d2 = 0; d2 < 2; ++d2) { const int dt = 2 * bt + d2;
#pragma unroll
                      for (int cb = 0; cb < 2; ++cb) { R[cb][dt] = R[cb][dt] * cd;
#pragma unroll
                          for (int ks = 0; ks < 2; ++ks) R[cb][dt] = __builtin_amdgcn_mfma_f32_16x16x32_bf16(ka[d2][ks], Vd[cb][ks], R[cb][dt], 0, 0, 0); } }
              }
            }
            __syncthreads();
            { const unsigned tn = tidl >> 3, vg = tidl & 7u; float ssq = 0.f;
              const size_t go = (size_t)(row0 + (int)tn) * 2048 + cbase + 32 * vg; bf16* op = O + go;
              v4u sg[4];
#pragma unroll
              for (int i = 0; i < 4; ++i) sg[i] = *(const v4u*)(SGp + go + 8 * i);
#pragma unroll
              for (int i = 0; i < 4; ++i) { const v4u r_ = *(const LAS v4u*)(OT + tn * RQS + 64u * vg + 16u * i); f32x4 o0 = (f32x4){bflo(r_.x), bfhi(r_.x), bflo(r_.y), bfhi(r_.y)}, o1 = (f32x4){bflo(r_.z), bfhi(r_.z), bflo(r_.w), bfhi(r_.w)};
                  ssq += (o0.x * o0.x + o0.y * o0.y) + (o0.z * o0.z + o0.w * o0.w) + (o1.x * o1.x + o1.y * o1.y) + (o1.z * o1.z + o1.w * o1.w);
                  const v4u gq = sg[i]; o0.x *= bflo(gq.x); o0.y *= bfhi(gq.x); o0.z *= bflo(gq.y); o0.w *= bfhi(gq.y); o1.x *= bflo(gq.z); o1.y *= bfhi(gq.z); o1.z *= bflo(gq.w); o1.w *= bfhi(gq.w);
                  *(v4u*)(op + 8 * i) = pack8(o0, o1); }
              ssq += __shfl_xor(ssq, 1); ssq += __shfl_xor(ssq, 2);
              if ((vg & 3u) == 0u) SS[((size_t)(row0 + (int)tn) * 4 + h) * 4 + 2 * vs2 + (int)(vg >> 2)] = ssq; }
        }
    }
}
__device__ __forceinline__ void ret_norm(Frame& F, bool dry = false) {
    relaunder(F);
    bf16* O = (bf16*)(F.ws + WS_R2); bf16* Od = dry ? (bf16*)(F.ws + WS_R2 + 288 * MiB) : O; const float* SS = (const float*)(F.ws + WS_R2 + 256 * MiB); const bf16* SG = (const bf16*)(F.ws + WS_R1 + 512 * MiB);
    const int gw = F.vcu * NWAVES + F.wave, NGW = F.G * NWAVES;
    for (int row = gw; row < MTOK; row += NGW) {
        float r[4];
#pragma unroll
        for (int h = 0; h < 4; ++h) { const f32x4 p = *(const f32x4*)(SS + ((size_t)row * 4 + h) * 4); r[h] = 1.0f / sqrtf(((p.x + p.y) + (p.z + p.w)) * (1.0f / 512.f) + EPS); }
#pragma unroll
        for (int j = 0; j < 4; ++j) { const size_t gi = (size_t)row * 2048 + 512 * j + 8 * F.lane; const v4u o = *(const v4u*)(O + gi), sg = *(const v4u*)(SG + gi); const float rr = r[j];
            v4u w; w.x = pk2(bflo(o.x) * rr * bflo(sg.x), bfhi(o.x) * rr * bfhi(sg.x)); w.y = pk2(bflo(o.y) * rr * bflo(sg.y), bfhi(o.y) * rr * bfhi(sg.y));
            w.z = pk2(bflo(o.z) * rr * bflo(sg.z), bfhi(o.z) * rr * bfhi(sg.z)); w.w = pk2(bflo(o.w) * rr * bflo(sg.w), bfhi(o.w) * rr * bfhi(sg.w));
            *(v4u*)(Od + gi) = w; }
    }
}

__device__ __forceinline__ bf16x8 pad8(s16x4 a) { return (bf16x8){a[0], a[1], a[2], a[3], 0, 0, 0, 0}; }
__device__ __forceinline__ void hgrn_scan_mfma(Frame& F, int j) {
    relaunder(F);
    const bf16* Q = (const bf16*)(F.ws + WS_R1); const bf16* LFb = (const bf16*)(F.ws + WS_R1 + 128 * MiB); const bf16* V = (const bf16*)(F.ws + WS_R1 + 256 * MiB); const bf16* SG = (const bf16*)(F.ws + WS_R1 + 384 * MiB);
    bf16* O = (bf16*)(F.ws + WS_R2);
    LAS unsigned char* QEi = F.lds; LAS unsigned char* QE2i = F.lds + 17408; LAS unsigned char* KEi = F.lds + 34816; LAS unsigned char* Vi = F.lds + 52224;
    LAS float* BL = (LAS float*)(F.lds + 69632); LAS float* OT = (LAS float*)(F.lds + 71680);
    const unsigned w = (unsigned)F.wave;
    LAS float* GT = (LAS float*)(F.lds + 105472);
    if (F.tid < 128) GT[F.tid] = KIN(I_HGAIN)[j * 128 + F.tid];
    for (int u = F.vcu; u < NBATCH * HG_H; u += F.G) {
        const int b = u >> 3, h = u & 7;
        f32x4 S[8];
#pragma unroll
        for (int i = 0; i < 8; ++i) S[i] = (f32x4){0.f, 0.f, 0.f, 0.f};
        unsigned short plf[16], pq[16]; v4u pv[2];
        { const int kbp = F.tid >> 7, dp = F.tid & 127, row0 = b * SEQ;
#pragma unroll
          for (int t = 0; t < 16; ++t) { const size_t gi = (size_t)(row0 + 16 * kbp + t) * DM + h * 128 + dp; plf[t] = LFb[gi]; pq[t] = Q[gi]; }
#pragma unroll
          for (int i = 0; i < 2; ++i) { const int p = F.tid + 512 * i, r = p >> 4, c16 = p & 15; pv[i] = *(const v4u*)(V + (size_t)(row0 + r) * DM + h * 128 + c16 * 8); }
        }
        __syncthreads();
        for (int c = 0; c < SEQ / 64; ++c) {
            const int row0 = b * SEQ + 64 * c;
            unsigned tidl = (unsigned)F.tid; asm volatile("" : "+v"(tidl));
            const unsigned lane = tidl & 63u, g = lane >> 4, li = lane & 15u, kbp = tidl >> 7, dp = tidl & 127u;
            { float bs = 0.f, bsv[16];
#pragma unroll
              for (int t = 0; t < 16; ++t) { bs += bf2f(plf[t]); bsv[t] = bs; }
              const float bl = bsv[15], ebl = __builtin_amdgcn_exp2f(bl); const unsigned a0 = (16u * kbp) * RVS + 2u * dp;
              float eprev = ebl;
#pragma unroll
              for (int t = 0; t < 16; ++t) { const float bt = bsv[t], q = bf2f(pq[t]), e1 = __builtin_amdgcn_exp2f(bl - bt), ke = e1 - eprev; eprev = e1;
                  const unsigned w0 = pk2(q * __builtin_amdgcn_exp2f(bt), q * __builtin_amdgcn_exp2f(fminf(bt - bl, 115.f))), w1 = pk2(ke, 0.f);
                  *(LAS unsigned short*)(QEi + a0 + t * RVS) = (unsigned short)(w0 & 0xffffu); *(LAS unsigned short*)(QE2i + a0 + t * RVS) = (unsigned short)(w0 >> 16); *(LAS unsigned short*)(KEi + a0 + t * RVS) = (unsigned short)(w1 & 0xffffu); }
              BL[kbp * 128u + dp] = ebl; }
#pragma unroll
            for (int i = 0; i < 2; ++i) { const unsigned p = tidl + 512u * i, r = p >> 4, c16 = p & 15u; *(LAS v4u*)(Vi + r * RVS + 16u * c16) = pv[i]; }
            __syncthreads();
            const v4u csg0 = *(const v4u*)(SG + (size_t)(row0 + (int)(tidl >> 3)) * DM + h * 128 + 16 * (tidl & 7u)), csg1 = *(const v4u*)(SG + (size_t)(row0 + (int)(tidl >> 3)) * DM + h * 128 + 16 * (tidl & 7u) + 8);
            asm volatile("" ::: "memory");
            { const int rn = (c + 1 < SEQ / 64) ? row0 + 64 : row0;
#pragma unroll
                for (int t = 0; t < 16; ++t) { const unsigned vo = ((16u * kbp + (unsigned)t) * DM + dp) * 2u;
                    plf[t] = *(const unsigned short*)((const char*)(LFb + (size_t)rn * DM + h * 128) + vo); pq[t] = *(const unsigned short*)((const char*)(Q + (size_t)rn * DM + h * 128) + vo); }
#pragma unroll
                for (int i = 0; i < 2; ++i) { const unsigned p = tidl + 512u * i, r = p >> 4, c16 = p & 15u; pv[i] = *(const v4u*)(V + (size_t)(rn + (int)r) * DM + h * 128 + c16 * 8); }
            }
            RSB();
            const unsigned rb128 = li * RVS + 16u * g, rb64 = li * RVS + 8u * g, trb = (4u * g + (li >> 2)) * RVS + 8u * (li & 3u);
            f32x4 P[4];
            { bf16x8 kef[2][4], q2f[2][4];
#define HG_LDP(buf, kb_) do { _Pragma("unroll") for (int s4 = 0; s4 < 4; ++s4) { kef[buf][s4] = *(const LAS bf16x8*)(KEi + (kb_) * (16u * RVS) + rb128 + 64 * s4); q2f[buf][s4] = *(const LAS bf16x8*)(QE2i + (kb_) * (16u * RVS) + rb128 + 64 * s4); } } while (0)
              HG_LDP(0, 0); RSB();
#pragma unroll
              for (int kb = 0; kb < 4; ++kb) { if (kb < 3) HG_LDP((kb + 1) & 1, kb + 1); RSB();
                  f32x4 p_ = (f32x4){0.f, 0.f, 0.f, 0.f};
#pragma unroll
                  for (int s4 = 0; s4 < 4; ++s4) p_ = __builtin_amdgcn_mfma_f32_16x16x32_bf16(kef[kb & 1][s4], q2f[kb & 1][s4], p_, 0, 0, 0);
                  P[kb] = p_; RSB(); }
#undef HG_LDP
            }
            { v2u qlo[2][4], qhi[2][4]; s16x4 Vbb[2];
#define HG_LDQ(buf, kb_) do { Vbb[buf] = __builtin_amdgcn_ds_read_tr16_b64_v4i16((LAS s16x4*)(Vi + (kb_) * (16u * RVS) + trb + 32u * w)); \
                  _Pragma("unroll") for (int s4 = 0; s4 < 4; ++s4) { qlo[buf][s4] = *(const LAS v2u*)(QEi + (kb_) * (16u * RVS) + rb64 + 64 * s4); qhi[buf][s4] = *(const LAS v2u*)(QEi + (kb_) * (16u * RVS) + rb64 + 64 * s4 + 32); } } while (0)
              HG_LDQ(0, 0); RSB();
#pragma unroll
              for (int kb = 0; kb < 4; ++kb) {
                  const unsigned ko = kb * (16u * RVS);
                  s16x4 ktf[8]; f32x4 e4[8];
#pragma unroll
                  for (int dt = 0; dt < 8; ++dt) { ktf[dt] = __builtin_amdgcn_ds_read_tr16_b64_v4i16((LAS s16x4*)(KEi + ko + trb + 32 * dt)); e4[dt] = *(const LAS f32x4*)(BL + kb * 128u + 16u * dt + 4u * g); }
                  if (kb < 3) HG_LDQ((kb + 1) & 1, kb + 1);
                  RSB();
                  f32x4 oa = (f32x4){0.f, 0.f, 0.f, 0.f};
#pragma unroll
                  for (int s4 = 0; s4 < 4; ++s4) {
                      const v4u st = (v4u){pk2(S[2 * s4][0], S[2 * s4][1]), pk2(S[2 * s4][2], S[2 * s4][3]), pk2(S[2 * s4 + 1][0], S[2 * s4 + 1][1]), pk2(S[2 * s4 + 1][2], S[2 * s4 + 1][3])};
                      const v4u av = (v4u){qlo[kb & 1][s4].x, qlo[kb & 1][s4].y, qhi[kb & 1][s4].x, qhi[kb & 1][s4].y};
                      oa = __builtin_amdgcn_mfma_f32_16x16x32_bf16(__builtin_bit_cast(bf16x8, av), __builtin_bit_cast(bf16x8, st), oa, 0, 0, 0); }
                  s16x4 a16;
                  { const f32x4 Pk = P[kb]; const unsigned lo = pk2((4u * g + 0u <= li) ? Pk[0] : 0.f, (4u * g + 1u <= li) ? Pk[1] : 0.f), hi = pk2((4u * g + 2u <= li) ? Pk[2] : 0.f, (4u * g + 3u <= li) ? Pk[3] : 0.f); const v2u t2 = (v2u){lo, hi}; a16 = __builtin_bit_cast(s16x4, t2); }
                  const bf16x8 Vb8 = pad8(Vbb[kb & 1]);
                  oa = __builtin_amdgcn_mfma_f32_16x16x32_bf16(pad8(a16), Vb8, oa, 0, 0, 0);
#pragma unroll
                  for (int dt = 0; dt < 8; ++dt) S[dt] = __builtin_amdgcn_mfma_f32_16x16x32_bf16(pad8(ktf[dt]), Vb8, S[dt] * e4[dt], 0, 0, 0);
#pragma unroll
                  for (int q = 0; q < 4; ++q) OT[(16u * kb + 4u * g + q) * 132u + 16u * w + li] = oa[q];
                  RSB();
              }
#undef HG_LDQ
            }
            __syncthreads();
            { const unsigned tn = tidl >> 3, vg = tidl & 7u; f32x4 o[4]; float ss = 0.f;
#pragma unroll
              for (int i = 0; i < 4; ++i) { o[i] = *(const LAS f32x4*)(OT + tn * 132u + 16u * vg + 4u * i); ss += (o[i].x * o[i].x + o[i].y * o[i].y) + (o[i].z * o[i].z + o[i].w * o[i].w); }
              ss += __shfl_xor(ss, 1); ss += __shfl_xor(ss, 2); ss += __shfl_xor(ss, 4);
              const float r = 1.0f / sqrtf(ss * (1.0f / 128.f) + EPS);
#pragma unroll
              for (int i = 0; i < 4; ++i) o[i] = o[i] * r * *(const LAS f32x4*)(GT + 16u * vg + 4u * i);
              if (HGRN_OUT_FP8) {
                  f32x4 sgv[4] = {(f32x4){bflo(csg0.x), bfhi(csg0.x), bflo(csg0.y), bfhi(csg0.y)}, (f32x4){bflo(csg0.z), bfhi(csg0.z), bflo(csg0.w), bfhi(csg0.w)}, (f32x4){bflo(csg1.x), bfhi(csg1.x), bflo(csg1.y), bfhi(csg1.y)}, (f32x4){bflo(csg1.z), bfhi(csg1.z), bflo(csg1.w), bfhi(csg1.w)}};
                  v4u w8;
#pragma unroll
                  for (int i = 0; i < 4; ++i) { f32x4 t = o[i] * sgv[i] * 8.0f; t = __builtin_elementwise_min(__builtin_elementwise_max(t, (f32x4){-448.f, -448.f, -448.f, -448.f}), (f32x4){448.f, 448.f, 448.f, 448.f}); w8[i] = pk4_fp8(t.x, t.y, t.z, t.w); }
                  *(v4u*)((unsigned char*)O + (size_t)(row0 + (int)tn) * DM + h * 128 + 16 * vg) = w8;
              } else {
              v4u w0, w1;
              w0.x = pk2(o[0].x * bflo(csg0.x), o[0].y * bfhi(csg0.x)); w0.y = pk2(o[0].z * bflo(csg0.y), o[0].w * bfhi(csg0.y)); w0.z = pk2(o[1].x * bflo(csg0.z), o[1].y * bfhi(csg0.z)); w0.w = pk2(o[1].z * bflo(csg0.w), o[1].w * bfhi(csg0.w));
              w1.x = pk2(o[2].x * bflo(csg1.x), o[2].y * bfhi(csg1.x)); w1.y = pk2(o[2].z * bflo(csg1.y), o[2].w * bfhi(csg1.y)); w1.z = pk2(o[3].x * bflo(csg1.z), o[3].y * bfhi(csg1.z)); w1.w = pk2(o[3].z * bflo(csg1.w), o[3].w * bfhi(csg1.w));
              bf16* op = O + (size_t)(row0 + (int)tn) * DM + h * 128 + 16 * vg; *(v4u*)op = w0; *(v4u*)(op + 8) = w1; } }
        }
    }
}

struct Args { const void* in[22]; float* out; unsigned char* ws; int ph_lo, ph_hi; };
constexpr int PH_PER_LAYER = 9, NPHASES = 1 + DEPTH * PH_PER_LAYER + 1;

__global__ void __launch_bounds__(NWAVES * 64, 2) hybrid_fwd(Args args) {
    extern __shared__ __attribute__((aligned(16))) unsigned char lds[];
    Frame F;
    F.lds = (LAS unsigned char*)lds;
    F.tid = threadIdx.x; F.lane = F.tid & 63; F.wave = __builtin_amdgcn_readfirstlane(F.tid >> 6);
    F.G = gridDim.x; { const int bx = blockIdx.x; F.vcu = (F.G % 8 == 0) ? (bx % 8) * (F.G / 8) + bx / 8 : bx; }
    F.ws = args.ws; F.out = args.out; F.ctl = (unsigned*)(args.ws + WS_CTL);
    for (int u = F.tid; u < (LDS_BYTES - MISC_OFF) / 4; u += NWAVES * 64) ((LAS unsigned*)(F.lds + MISC_OFF))[u] = 0u;
    __syncthreads();
    const int lo = args.ph_lo, hi = args.ph_hi;
    XcdBarrier bar; bar.bar = F.ctl + CW_BAR; bar.x = 0; bar.st = nullptr;
    if (hi - lo > 1) bar = xcd_barrier_post(F.ctl + CW_BAR, (volatile LAS unsigned*)(F.lds + MISC_OFF) + 8);
#define IN(k) (lo <= (k) && (k) < hi)
#define SEAM(k) do { if (IN(k) && hi > (k) + 1) xcd_barrier(bar); } while (0)

    if (PH_EN(0) && IN(0)) { for (int rep = 0; rep < REPS(0); ++rep) p0_prologue(F); } SEAM(0);

#pragma unroll 1
    for (int l = 0; l < DEPTH; ++l) {
        const int pb = 1 + l * PH_PER_LAYER, j = l >> 1; const bool is_ret = (l & 1);
        if (PH_EN(1) && IN(pb + 0)) { row_phase1(F, l, 0); if (REPS(13) > 1 && l > 0) { __syncthreads(); row_phase1(F, l, 0, true); } }
        SEAM(pb + 0);
        if (IN(pb + 1)) {
            if (PH_EN(2) && !is_ret) {
                for (int rep = 0; rep < REPS(2); ++rep) {
                    if constexpr (HG_N8 > 0) {
                        pg8::Gemm g{(const bf16*)(F.ws + WS_H8), (const bf16*)(F.ws + WS_HWIN + (size_t)j * HG_N8 * DM), MTOK, HG_N8, DM / 2}; pg8::StaticOrder S; S.init(MTOK, HG_N8, F.G, (int)blockIdx.x);
                        const EpiHgrnIn E{F.ws + WS_R1, (const float*)(F.ws + WS_LBV) + j * DM, hg_smap(HGRN_FP8_MASK), 1.0f / 512.f};
                        pg8::gemm_phase<EpiHgrnIn, pg8::StaticOrder, true, true, false, true>(F.lds + RING_OFF, g, S, E); }
                    if constexpr (HG_N16 > 0) {
                        pg8::Gemm g{(const bf16*)(F.ws + WS_H), (const bf16*)(F.ws + WS_HWIN + 8 * MiB) + (size_t)j * HG_N16 * DM, MTOK, HG_N16, DM}; pg8::StaticOrder S; S.init(MTOK, HG_N16, F.G, (int)blockIdx.x);
                        const EpiHgrnIn E{F.ws + WS_R1, (const float*)(F.ws + WS_LBV) + j * DM, hg_smap(0xF & ~HGRN_FP8_MASK), 1.0f};
                        pg8::gemm_phase<EpiHgrnIn, pg8::StaticOrder, true, true>(F.lds + RING_OFF, g, S, E); }
                }
            } else if (PH_EN(3)) {
                pg8::StaticOrder S; S.init(MTOK, RT_N, F.G, (int)blockIdx.x);
                if constexpr (RET_IN_FP8) {
                    pg8::Gemm g{(const bf16*)(F.ws + WS_H8), (const bf16*)(F.ws + WS_RWIN + (size_t)j * RT_N * DM), MTOK, RT_N, DM / 2};
                    EpiRetIn E{F.ws + WS_R1, (const int*)kin_(I_POS), 1.0f / 512.f};
                    for (int rep = 0; rep < REPS(3); ++rep) pg8::gemm_phase<EpiRetIn, pg8::StaticOrder, true, true, false, true>(F.lds + RING_OFF, g, S, E);
                } else {
                    pg8::Gemm g{(const bf16*)(F.ws + WS_H), (const bf16*)(F.ws + WS_RWIN) + (size_t)j * RT_N * DM, MTOK, RT_N, DM};
                    EpiRetIn E{F.ws + WS_R1, (const int*)kin_(I_POS), 1.0f};
                    for (int rep = 0; rep < REPS(3); ++rep) pg8::gemm_phase<EpiRetIn, pg8::StaticOrder, true, true>(F.lds + RING_OFF, g, S, E);
                }
            }
        }
        SEAM(pb + 1);
        if (IN(pb + 2)) { if (!is_ret) { if (PH_EN(4)) { for (int rep = 0; rep < REPS(4); ++rep) { if (HGRN_MFMA) hgrn_scan_mfma(F, j); else hgrn_scan(F, j); } } } else { if (PH_EN(5)) { for (int rep = 0; rep < REPS(5); ++rep) { if (RET_MFMA && RET_WIDE && RET_FOLD) ret_scan_mfma2(F); else if (RET_MFMA) ret_scan_mfma(F); else ret_scan(F); } } } }
        SEAM(pb + 2);
        if (RET_MFMA && !RET_FOLD && PH_EN(12) && IN(pb + 3) && is_ret) { if (REPS(14) > 1) ret_norm(F, true); ret_norm(F); }
        if (RET_MFMA && !RET_FOLD && is_ret) SEAM(pb + 3);
        if (PH_EN(6) && IN(pb + 4)) {
            const int Ko = is_ret ? 2048 : DM;
            const bf16* Wt = is_ret ? (const bf16*)(F.ws + WS_RWOUT) + (size_t)j * DM * 2048 : (const bf16*)(F.ws + WS_HWOUT) + (size_t)j * DM * DM;
            pg8::Gemm g{(const bf16*)(F.ws + WS_R2), Wt, MTOK, DM, Ko}; pg8::StaticOrder S; S.init(MTOK, DM, F.G, (int)blockIdx.x);
            const float* gate1 = (const float*)(F.ws + WS_MOD) + (size_t)l * NBATCH * 6 * DM + 2 * DM; bf16* xb = (bf16*)(F.ws + WS_XB);
            if (REPS(15) > 1) { EpiOutT<false> Ed{l == 0 ? (const void*)(F.ws + WS_R1 + 512 * MiB) : (const void*)xb, (bf16*)(F.ws + WS_R1), gate1, 1.0f}; pg8::gemm_phase<EpiOutT<false>, pg8::StaticOrder, true, true>(F.lds + RING_OFF, g, S, Ed); }
            if (RET_MFMA && RET_FOLD && is_ret) { const pg8::HScale hs{(const float*)(F.ws + WS_R2 + 256 * MiB), (LAS float*)(F.lds + 131072), EPS}; const EpiOutT<false> E{xb, xb, gate1, 1.0f};
                pg8::gemm_phase<EpiOutT<false>, pg8::StaticOrder, true, true, false, false, false, true>(F.lds + RING_OFF, g, S, E, hs); }
            else if (HGRN_OUT_FP8 && !is_ret) { const pg8::Gemm g8{(const bf16*)(F.ws + WS_R2), (const bf16*)(F.ws + WS_HWOUT + (size_t)j * DM * DM), MTOK, DM, DM / 2};
                if (l == 0) { const EpiOutT<true> E{KIN(I_X), xb, gate1, 1.0f / 512.f}; pg8::gemm_phase<EpiOutT<true>, pg8::StaticOrder, true, true, false, true>(F.lds + RING_OFF, g8, S, E); }
                else { const EpiOutT<false> E{xb, xb, gate1, 1.0f / 512.f}; pg8::gemm_phase<EpiOutT<false>, pg8::StaticOrder, true, true, false, true>(F.lds + RING_OFF, g8, S, E); } }
            else if (l == 0) { const EpiOutT<true> E{KIN(I_X), xb, gate1, 1.0f}; pg8::gemm_phase<EpiOutT<true>, pg8::StaticOrder, true, true>(F.lds + RING_OFF, g, S, E); }
            else { const EpiOutT<false> E{xb, xb, gate1, 1.0f}; pg8::gemm_phase<EpiOutT<false>, pg8::StaticOrder, true, true>(F.lds + RING_OFF, g, S, E); }
        }
        SEAM(pb + 4);
        if (PH_EN(7) && IN(pb + 5)) { if (REPS(18) > 1) row_phase2(F, l, true); row_phase2(F, l); }
        SEAM(pb + 5);
        if (MOE_GATHER_PASS) { if (PH_EN(8) && IN(pb + 6)) { for (int rep = 0; rep < REPS(8); ++rep) moe_gather(F, l); } SEAM(pb + 6); }
        if (PH_EN(9) && IN(pb + 7)) {
            build_tiles(F, l);
            if (!MOE_GATHER_PASS) moe_build_tt(F, 8);
            pg8::MoeOrder S{8, F.G, F.vcu, (const LAS int*)(F.lds + TAB_OFF), (const LAS unsigned short*)(F.lds + 131072)};
            if constexpr (MOE_FP8) {
                static_assert(!MOE_FP8 || !MOE_GATHER_PASS, "the fp8 expert GEMM gathers while staging");
                pg8::Gemm g{(const bf16*)(F.ws + WS_H8), (const bf16*)(F.ws + WS_W1T + (size_t)l * NEXP * 2048 * DM), 0, 0, DM / 2};
                EpiMoe1F8 E{F.ws + WS_R2, KIN(I_B1) + (size_t)l * NEXP * 2048};
                for (int rep = 0; rep < REPS(9); ++rep) pg8::gemm_phase<EpiMoe1F8, pg8::MoeOrder, MOE_ALIGN, true, true, true>(F.lds + RING_OFF, g, S, E);
                if (REPS(12) > 1) pg8::gemm_phase<EpiMoe1F8, pg8::MoeOrder, true, true, true, true, true>(F.lds + RING_OFF, g, S, E);
            } else {
                pg8::Gemm g{(const bf16*)(F.ws + (MOE_GATHER_PASS ? WS_R1 : WS_H)), (const bf16*)(F.ws + WS_W1T) + (size_t)l * NEXP * 2048 * DM, 0, 0, DM};
                EpiMoe1 E{(bf16*)(F.ws + WS_R2), KIN(I_B1) + (size_t)l * NEXP * 2048};
                for (int rep = 0; rep < REPS(9); ++rep) pg8::gemm_phase<EpiMoe1, pg8::MoeOrder, true, true, !MOE_GATHER_PASS>(F.lds + RING_OFF, g, S, E);
            }
        }
        SEAM(pb + 7);
        if (PH_EN(10) && IN(pb + 8)) {
            build_tiles(F, l);
            pg8::MoeOrder S{4, F.G, F.vcu, (const LAS int*)(F.lds + TAB_OFF), nullptr};
            if (SKEW_TICKS) phase_skew(F, SKEW_TICKS);
            if constexpr (MOE_FP8) {
                pg8::Gemm g{(const bf16*)(F.ws + WS_R2), (const bf16*)(F.ws + WS_W2T + (size_t)l * NEXP * DM * DM), 0, 0, DM / 2};
                EpiMoe2Y8 E{F.ws + WS_R1, KIN(I_B2) + (size_t)l * NEXP * DM, 1.0f / 256.f};
                for (int rep = 0; rep < REPS(10); ++rep) pg8::gemm_phase<EpiMoe2Y8, pg8::MoeOrder, MOE_ALIGN, true, false, true>(F.lds + RING_OFF, g, S, E);
            } else {
                pg8::Gemm g{(const bf16*)(F.ws + WS_R2), (const bf16*)(F.ws + WS_W2T) + (size_t)l * NEXP * DM * DM, 0, 0, DM};
                EpiMoe2 E{(bf16*)(F.ws + WS_R1), KIN(I_B2) + (size_t)l * NEXP * DM, 1.0f};
                for (int rep = 0; rep < REPS(10); ++rep) pg8::gemm_phase<EpiMoe2, pg8::MoeOrder, true, true>(F.lds + RING_OFF, g, S, E);
            }
        }
        SEAM(pb + 8);
    }
    if (PH_EN(11) && IN(NPHASES - 1)) row_phase1(F, DEPTH, 1);
#undef IN
#undef SEAM
}

extern "C" void kernel_launch(void* const* d_in, const int* in_sizes, int n_in, void* d_out, int out_size, void* d_ws, size_t ws_size, hipStream_t stream) {
    static int grid = 0;
    if (grid == 0) {
        if (n_in != 22 || in_sizes[0] != MTOK * DM || out_size != MTOK * DM || ws_size < WS_END) { fprintf(stderr, "kernel_launch: unexpected shapes (n_in %d, in0 %d, out %d, ws %zu < %zu)\n", n_in, n_in > 0 ? in_sizes[0] : -1, out_size, ws_size, (size_t)WS_END); grid = -1; return; }
        int dev = 0, cus = 0, per_cu = 0;
        if (hipGetDevice(&dev) != hipSuccess || hipDeviceGetAttribute(&cus, hipDeviceAttributeMultiprocessorCount, dev) != hipSuccess) { grid = -1; return; }
        if (hipFuncSetAttribute((const void*)hybrid_fwd, hipFuncAttributeMaxDynamicSharedMemorySize, LDS_BYTES) != hipSuccess) { fprintf(stderr, "kernel_launch: hipFuncSetAttribute failed\n"); grid = -1; return; }
        if (hipOccupancyMaxActiveBlocksPerMultiprocessor(&per_cu, (const void*)hybrid_fwd, NWAVES * 64, LDS_BYTES) != hipSuccess || per_cu < 1) { fprintf(stderr, "kernel_launch: occupancy query says %d blocks per CU\n", per_cu); }
        (void)hipGetLastError();
        if (cus != 256) { fprintf(stderr, "kernel_launch: built for a 256-CU device (one workgroup per CU); this one reports %d; nothing launched\n", cus); grid = -1; return; }
        grid = cus;
    }
    if (grid < 0) return;
    (void)hipMemsetAsync((char*)d_ws + WS_CTL, 0, CTL_ZERO_BYTES, stream);
    Args a{};
    for (int i = 0; i < 22; ++i) a.in[i] = d_in[i];
    a.out = (float*)d_out; a.ws = (unsigned char*)d_ws;
#if MK_SPLIT
    for (int p = 0; p < DBG_LIMIT; ++p) {
        if (p >= 1 && p < NPHASES - 1 && ((p - 1) % PH_PER_LAYER) == 3 && (!RET_MFMA || RET_FOLD || (((p - 1) / PH_PER_LAYER) & 1) == 0)) continue;
        if (!MOE_GATHER_PASS && p >= 1 && p < NPHASES - 1 && ((p - 1) % PH_PER_LAYER) == 6) continue;
        a.ph_lo = p; a.ph_hi = p + 1;
        hipLaunchKernelGGL(hybrid_fwd, dim3(grid), dim3(NWAVES * 64), LDS_BYTES, stream, a);
    }
#else
    a.ph_lo = 0; a.ph_hi = NPHASES;
    hipLaunchKernelGGL(hybrid_fwd, dim3(grid), dim3(NWAVES * 64), LDS_BYTES, stream, a);
#endif
    const hipError_t le = hipPeekAtLastError();
    if (le != hipSuccess) fprintf(stderr, "kernel_launch: launch failed: %s\n", hipGetErrorName(le));
}
```

```cpp
#include <hip/hip_runtime.h>
#include <cstdio>
#include <cstdint>

#ifndef ONLY_PH
#define ONLY_PH -1
#endif
#define PH_EN(n) (ONLY_PH < 0 || ONLY_PH == (n))
#ifndef DBG_LIMIT
#define DBG_LIMIT NPHASES
#endif
#ifndef RET_MFMA
#define RET_MFMA 1
#endif
#ifndef HGRN_MFMA
#define HGRN_MFMA 1
#endif
#ifndef REPEAT_MASK
#define REPEAT_MASK 0
#endif
#define REPS(k) (1 + ((REPEAT_MASK >> (k)) & 1))
#ifndef MOE_GATHER_PASS
#define MOE_GATHER_PASS 0
#endif
#ifndef MOE_FP8
#define MOE_FP8 1
#endif
#ifndef SKEW_TICKS
#define SKEW_TICKS 0
#endif
#ifndef HGRN_FP8_MASK
#define HGRN_FP8_MASK 0xF
#endif
#ifndef RET_WIDE
#define RET_WIDE 1
#endif
#ifndef HGRN_OUT_FP8
#define HGRN_OUT_FP8 1
#endif
#ifndef RET_IN_FP8
#define RET_IN_FP8 1
#endif
#ifndef MOE_ALIGN
#define MOE_ALIGN true
#endif
#ifndef RET_FOLD
#define RET_FOLD 1
#endif
#ifndef MK_SPLIT
#define MK_SPLIT 0
#endif

namespace pg8 {
#define PG8_LAS __attribute__((address_space(3)))
typedef unsigned short bf16_t;
typedef short bf16x8 __attribute__((ext_vector_type(8)));
typedef float f32x4 __attribute__((ext_vector_type(4)));
typedef unsigned u32x4 __attribute__((ext_vector_type(4)));
constexpr int BM = 256, BK = 64, HALF = 128, HTB = HALF * BK * 2  , STAGE_BYTES = 8 * HTB, NXCD = 8, WGM = 8;

__host__ __device__ __forceinline__ int lds_byte(int r, int c) { const int st = (r >> 4) * 2 + (c >> 5), rr = r & 15, cc = c & 31, ob = rr * 64 + cc * 2; return st * 1024 + (ob ^ (((ob >> 9) & 1) << 5)); }
__host__ __device__ __forceinline__ void stage_rc(int b, int& R, int& C) { const int st = b / 1024, sb = b % 1024, swz = sb ^ (((sb >> 9) & 1) << 5); R = (st >> 1) * 16 + swz / 64; C = (st & 1) * 32 + (swz % 64) / 2; }
__host__ __device__ __forceinline__ int perm32(int rho) { const int n = rho >> 4, i = rho & 15; return 8 * (i >> 2) + 4 * n + (i & 3); }

struct Unit { int pm, pn, e, nn; };
struct Gemm { const bf16_t* A; const bf16_t* Bt; int M, N, K; };

struct StaticOrder {
    int nM, nN, nwg, G, c;
    __host__ __device__ void init(int M, int N, int G_, int c_) { nM = M / BM; nN = N / BM; nwg = nM * nN; G = G_; c = c_; }
    __host__ __device__ bool next(int i, Unit& u) const {
        const long L = (long)i * G + c; if (L >= nwg) return false;
        int wgid = (int)L; { const int q = nwg / NXCD, r = nwg % NXCD, xcd = wgid % NXCD, off = wgid / NXCD; wgid = (xcd < r ? xcd * (q + 1) : r * (q + 1) + (xcd - r) * q) + off; }
        const int nig = WGM * nN, gid = wgid / nig, fm = gid * WGM, gsz = (nM - fm) < WGM ? (nM - fm) : WGM;
        u.pm = fm + ((wgid % nig) % gsz); u.pn = (wgid % nig) / gsz; u.e = 0; u.nn = u.pn; return true;
    }
    __device__ __forceinline__ unsigned tok(int, int) const { return 0u; }
    __device__ __forceinline__ void a_ready(const Unit&) const {}
    __device__ __forceinline__ void done(const Unit&) const {}
};
struct MoeOrder {
    int nN, G, c; const PG8_LAS int* ts; const PG8_LAS unsigned short* tt;
    __device__ __forceinline__ unsigned tok(int i, int r) const { return tt[i * 256 + r]; }
    __device__ __forceinline__ bool next(int i, Unit& u) const {
        const int NT = ts[32]; const long L = (long)i * G + c; if (L >= (long)NT * nN) return false;
        const int mt = (int)(L / nN), n = (int)(L % nN); int e = 0;
        for (int k = 1; k < 32; ++k) e += (ts[k] <= mt) ? 1 : 0;
        u.pm = mt; u.pn = e * nN + n; u.e = e; u.nn = n; return true;
    }
    __device__ __forceinline__ void a_ready(const Unit&) const {}
    __device__ __forceinline__ void done(const Unit&) const {}
};

typedef float cvt_f2_ __attribute__((ext_vector_type(2)));
typedef __bf16 cvt_b2_ __attribute__((ext_vector_type(2)));
__device__ __forceinline__ unsigned cvt_pk_bf16(float lo, float hi) { const cvt_f2_ v = {lo, hi}; const cvt_b2_ r = __builtin_convertvector(v, cvt_b2_); return __builtin_bit_cast(unsigned, r); }

template <int N> __device__ __forceinline__ void wait_vm() { asm volatile("s_waitcnt vmcnt(%0)" :: "n"(N) : "memory"); }
typedef int v8i32 __attribute__((ext_vector_type(8)));
struct HScale { const float* ss; PG8_LAS float* tab; float eps; };
template <int OFF> __device__ __forceinline__ v8i32 lds_frag32_asm(unsigned addr) {
    u32x4 lo, hi;
    asm volatile("ds_read_b128 %0, %2 offset:%3\n\tds_read_b128 %1, %2 offset:%4" : "=&v"(lo), "=&v"(hi) : "v"(addr), "n"(OFF), "n"(OFF + 1024));
    return __builtin_bit_cast(v8i32, __builtin_shufflevector(lo, hi, 0, 1, 2, 3, 4, 5, 6, 7));
}
template <class Epi, class Sched, bool ALIGN_EPI = false, bool SP2 = false, bool GATHER = false, bool FP8 = false, bool NOEPI = false, bool HSCALE = false>
__device__ __forceinline__ void gemm_phase(PG8_LAS unsigned char* lds, const Gemm g, const Sched& S, const Epi& E, const HScale hs = HScale{nullptr, nullptr, 0.f}) {
    int tid_ = threadIdx.x; asm volatile("" : "+v"(tid_));
    const int tid = tid_, wid = __builtin_amdgcn_readfirstlane(tid >> 6), lane = tid & 63, wr = wid >> 2, wc = wid & 3, fr = lane & 15, fq = lane >> 4;
    const int K = g.K, nt = K / BK;
    unsigned voffA[2], voffB[2];
#pragma unroll
    for (int i = 0; i < 2; ++i) { int R, C; stage_rc(tid * 16 + i * 8192, R, C); const int Rb = Epi::PERM ? ((R & ~31) + perm32(R & 31)) : R;
        voffA[i] = (unsigned)(R * K + C) * 2u; voffB[i] = (unsigned)(Rb * K + C) * 2u; }
    int gR[2]; unsigned gC[2];
#pragma unroll
    for (int i = 0; i < 2; ++i) { int R, C; stage_rc(tid * 16 + i * 8192, R, C); gR[i] = R; gC[i] = (unsigned)C * 2u; }
#define PG8_GVOFF(v, ui_, h_) do { _Pragma("unroll") for (int _i = 0; _i < 2; ++_i) v[_i] = (S.tok((ui_), gR[_i] + HALF * (h_)) * (unsigned)(K * 2)) + gC[_i]; } while (0)
    const size_t kstep = (size_t)(BK * 2);
    const size_t hstep = (size_t)HALF * K * 2;
    const size_t tstep = 2 * hstep;
    const unsigned ldsw = (unsigned)wid * 1024u;
    const int aoff = lds_byte(wr * 64 + fr, fq * 8), boff = lds_byte(wc * 32 + fr, fq * 8);
    const unsigned lda_ = (unsigned)(__UINTPTR_TYPE__)(lds + aoff), ldb_ = (unsigned)(__UINTPTR_TYPE__)(lds + boff) + 65536u;

#define PG8_SA(b, h) (((b) * 2 + (h)) * HTB)
#define PG8_SB(b, h) ((4 + (b) * 2 + (h)) * HTB)
#define PG8_STAGE(bufoff, gbase, voff) do { _Pragma("unroll") for (int _i = 0; _i < 2; ++_i) \
        __builtin_amdgcn_global_load_lds((const unsigned*)((const char*)(gbase) + (voff)[_i]), (PG8_LAS unsigned*)(lds + (bufoff) + ldsw + _i * 8192), 16, 0, 0); } while (0)
#define PG8_LDA(dst, b, h) do { if constexpr (FP8) { dst##8[0] = lds_frag32_asm<PG8_SA(b, h)>(lda_); dst##8[1] = lds_frag32_asm<PG8_SA(b, h) + 2048>(lda_); dst##8[2] = lds_frag32_asm<PG8_SA(b, h) + 4096>(lda_); dst##8[3] = lds_frag32_asm<PG8_SA(b, h) + 6144>(lda_); } \
    else { _Pragma("unroll") for (int m = 0; m < 4; ++m) _Pragma("unroll") for (int k = 0; k < 2; ++k) dst[m][k] = *(const PG8_LAS bf16x8*)(lds + PG8_SA(b, h) + aoff + m * 2048 + k * 1024); } } while (0)
#define PG8_LDB(dst, b, h) do { if constexpr (FP8) { dst##8[0] = lds_frag32_asm<PG8_SB(b, h) - 65536>(ldb_); dst##8[1] = lds_frag32_asm<PG8_SB(b, h) - 65536 + 2048>(ldb_); } \
    else { _Pragma("unroll") for (int n = 0; n < 2; ++n) _Pragma("unroll") for (int k = 0; k < 2; ++k) dst[n][k] = *(const PG8_LAS bf16x8*)(lds + PG8_SB(b, h) + boff + n * 2048 + k * 1024); } } while (0)
#define PG8_CAT(x) __builtin_shufflevector(__builtin_bit_cast(u32x4, (x)[0]), __builtin_bit_cast(u32x4, (x)[1]), 0, 1, 2, 3, 4, 5, 6, 7)
#define PG8_MMA(ai, bj, At, Bt) do { __builtin_amdgcn_s_setprio(1); if constexpr (FP8) { _Pragma("unroll") for (int m = 0; m < 4; ++m) _Pragma("unroll") for (int n = 0; n < 2; ++n) \
        asm volatile("v_mfma_scale_f32_16x16x128_f8f6f4 %0, %1, %2, %0, %3, %3 op_sel_hi:[0,0,0]" : "+v"(acc[ai][bj][m][n]) : "v"(Bt##8[n]), "v"(At##8[m]), "v"(scl1)); } \
    else { _Pragma("unroll") for (int m = 0; m < 4; ++m) _Pragma("unroll") for (int n = 0; n < 2; ++n) _Pragma("unroll") for (int k = 0; k < 2; ++k) \
        acc[ai][bj][m][n] = __builtin_amdgcn_mfma_f32_16x16x32_bf16(Bt[n][k], At[m][k], acc[ai][bj][m][n], 0, 0, 0); } __builtin_amdgcn_s_setprio(0); } while (0)
#define PG8_WAIT_V(n) asm volatile("s_waitcnt vmcnt(" #n ")" ::: "memory")
#define PG8_WAIT_L(n) asm volatile("s_waitcnt lgkmcnt(" #n ")" ::: "memory")
#define PG8_BAR __builtin_amdgcn_s_barrier()
#define PG8_SCHED __builtin_amdgcn_sched_barrier(0)
    Unit cur, nxt; int ui = 0;
    if (!S.next(0, cur)) return;
    f32x4 acc[2][2][4][2];
#pragma unroll
    for (int a = 0; a < 2; ++a)
#pragma unroll
        for (int b = 0; b < 2; ++b)
#pragma unroll
            for (int m = 0; m < 4; ++m)
#pragma unroll
                for (int n = 0; n < 2; ++n) acc[a][b][m][n] = (f32x4){0.f, 0.f, 0.f, 0.f};
    const unsigned scl1 = 0x7f7f7f7fu;
    bf16x8 At[4][2], B0[2][2], B1[2][2]; v8i32 At8[4], B08[2], B18[2];
    const char* cA = GATHER ? (const char*)g.A : (const char*)g.A + (size_t)cur.pm * tstep; const char* cB = (const char*)g.Bt + (size_t)cur.pn * tstep;
    S.a_ready(cur);
    static_assert(!GATHER || SP2, "GATHER is written for the SP2 loop");
#define PG8_HSTAB(slot, pm_) do { if (tid < 256) { const float* sp_ = hs.ss + ((size_t)(pm_) * BM + tid) * 16; float rr_[4]; \
        _Pragma("unroll") for (int h_ = 0; h_ < 4; ++h_) { const f32x4 p_ = *(const f32x4*)(sp_ + 4 * h_); rr_[h_] = 1.0f / sqrtf(((p_[0] + p_[1]) + (p_[2] + p_[3])) * (1.0f / 512.f) + hs.eps); } \
        *(PG8_LAS f32x4*)(hs.tab + (slot) * 1024 + tid * 4) = (f32x4){rr_[0] / rr_[1], rr_[1] / rr_[2], rr_[2] / rr_[3], rr_[3]}; } } while (0)
#define PG8_HSMUL(slot, h_) do { _Pragma("unroll") for (int ai_ = 0; ai_ < 2; ++ai_) _Pragma("unroll") for (int m_ = 0; m_ < 4; ++m_) { const float f_ = hs.tab[(slot) * 1024 + (ai_ * HALF + wr * 64 + m_ * 16 + fr) * 4 + (h_)]; \
        _Pragma("unroll") for (int bj_ = 0; bj_ < 2; ++bj_) _Pragma("unroll") for (int n_ = 0; n_ < 2; ++n_) acc[ai_][bj_][m_][n_] = acc[ai_][bj_][m_][n_] * f_; } } while (0)
    if constexpr (HSCALE) { PG8_HSTAB(0, cur.pm); PG8_WAIT_L(0); PG8_BAR; }
    if constexpr (SP2) {
        if constexpr (GATHER) { unsigned v0[2], v1[2]; PG8_GVOFF(v0, 0, 0); PG8_GVOFF(v1, 0, 1); PG8_STAGE(PG8_SB(0, 0), cB, voffB); PG8_STAGE(PG8_SB(0, 1), cB + hstep, voffB); PG8_STAGE(PG8_SA(0, 0), cA, v0); PG8_STAGE(PG8_SA(0, 1), cA, v1); }
        else { PG8_STAGE(PG8_SB(0, 0), cB, voffB); PG8_STAGE(PG8_SB(0, 1), cB + hstep, voffB); PG8_STAGE(PG8_SA(0, 0), cA, voffA); PG8_STAGE(PG8_SA(0, 1), cA + hstep, voffA); }
        if (wr == 1) PG8_BAR;
        PG8_WAIT_V(2); PG8_BAR;
        if constexpr (GATHER) { unsigned v0[2]; PG8_GVOFF(v0, 0, 0); PG8_STAGE(PG8_SB(1, 0), cB + kstep, voffB); PG8_STAGE(PG8_SA(1, 0), cA + kstep, v0); PG8_STAGE(PG8_SB(1, 1), cB + hstep + kstep, voffB); }
        else { PG8_STAGE(PG8_SB(1, 0), cB + kstep, voffB); PG8_STAGE(PG8_SA(1, 0), cA + kstep, voffA); PG8_STAGE(PG8_SB(1, 1), cB + hstep + kstep, voffB); }
        PG8_WAIT_V(6); PG8_BAR;
    } else {
        PG8_STAGE(PG8_SB(0, 0), cB, voffB); PG8_STAGE(PG8_SA(0, 0), cA, voffA); PG8_STAGE(PG8_SB(0, 1), cB + hstep, voffB); PG8_STAGE(PG8_SA(0, 1), cA + hstep, voffA);
        if (wr == 1) PG8_BAR;
        PG8_WAIT_V(4); PG8_BAR;
        PG8_STAGE(PG8_SB(1, 0), cB + kstep, voffB); PG8_STAGE(PG8_SA(1, 0), cA + kstep, voffA); PG8_STAGE(PG8_SB(1, 1), cB + hstep + kstep, voffB);
        PG8_WAIT_V(6); PG8_BAR;
    }
    for (;;) {
        const bool has_next = S.next(ui + 1, nxt);
        const char* nA = GATHER ? cA : (has_next ? (const char*)g.A + (size_t)nxt.pm * tstep : cA); const char* nB = has_next ? (const char*)g.Bt + (size_t)nxt.pn * tstep : cB;
#pragma unroll 1
        for (int t = 0; t < nt; t += 2) {
            asm volatile("" : "+v"(voffA[0]), "+v"(voffA[1]), "+v"(voffB[0]), "+v"(voffB[1]));
            const bool last = (t == nt - 2);
            const char* a1 = cA + (size_t)(t + 1) * kstep;
            const char* a2 = last ? nA : cA + (size_t)(t + 2) * kstep; const char* b2 = last ? nB : cB + (size_t)(t + 2) * kstep;
            const char* a3 = a2 + kstep; const char* b3 = b2 + kstep;
            if (last && has_next) S.a_ready(nxt);
            if constexpr (HSCALE) { if (last && has_next) PG8_HSTAB((ui + 1) & 1, nxt.pm);
                                    if (t == 8 || t == 16 || t == 24) PG8_HSMUL(ui & 1, (t >> 3) - 1); }
            const bool rlx = (t == 0) && (ui > 0);
#define PG8_WAIT_V8R do { if (rlx) wait_vm<8 + Epi::NST>(); else wait_vm<8>(); } while (0)
            if constexpr (SP2 && GATHER) {
            const int uix = (last && has_next) ? ui + 1 : ui;
            unsigned vc1[2], vx0[2], vx1[2]; PG8_GVOFF(vc1, ui, 1); PG8_GVOFF(vx0, uix, 0); PG8_GVOFF(vx1, uix, 1);
            if constexpr (FP8) { asm volatile("" :: "v"(vc1[0]), "v"(vc1[1]), "v"(vx0[0]), "v"(vx0[1]), "v"(vx1[0]), "v"(vx1[1]));
                PG8_LDB(B0, 0, 0); PG8_LDA(At, 0, 0); PG8_LDB(B1, 0, 1); PG8_STAGE(PG8_SA(1, 1), a1, vc1);
                PG8_WAIT_V8R; PG8_WAIT_L(4); PG8_BAR; PG8_MMA(0, 0, At, B0); PG8_WAIT_L(0); PG8_MMA(0, 1, At, B1); PG8_BAR; PG8_SCHED; }
            else { PG8_LDB(B0, 0, 0); PG8_LDB(B1, 0, 1); PG8_SCHED; PG8_LDA(At, 0, 0); PG8_STAGE(PG8_SA(1, 1), a1, vc1);
                PG8_WAIT_V8R; PG8_WAIT_L(0); PG8_BAR; PG8_MMA(0, 0, At, B0); PG8_MMA(0, 1, At, B1); PG8_BAR; PG8_SCHED; }
            PG8_LDA(At, 0, 1); PG8_STAGE(PG8_SB(0, 0), b2, voffB); PG8_STAGE(PG8_SB(0, 1), b2 + hstep, voffB); PG8_STAGE(PG8_SA(0, 0), a2, vx0);
            PG8_WAIT_V8R; PG8_WAIT_L(0); PG8_BAR; PG8_MMA(1, 0, At, B0); PG8_MMA(1, 1, At, B1); PG8_BAR; PG8_SCHED;
            if constexpr (FP8) { PG8_LDB(B0, 1, 0); PG8_LDA(At, 1, 0); PG8_LDB(B1, 1, 1); PG8_STAGE(PG8_SA(0, 1), a2, vx1);
                PG8_WAIT_V(8); PG8_WAIT_L(4); PG8_BAR; PG8_MMA(0, 0, At, B0); PG8_WAIT_L(0); PG8_MMA(0, 1, At, B1); PG8_BAR; PG8_SCHED; }
            else { PG8_LDB(B0, 1, 0); PG8_LDB(B1, 1, 1); PG8_SCHED; PG8_LDA(At, 1, 0); PG8_STAGE(PG8_SA(0, 1), a2, vx1);
                PG8_WAIT_V(8); PG8_WAIT_L(0); PG8_BAR; PG8_MMA(0, 0, At, B0); PG8_MMA(0, 1, At, B1); PG8_BAR; PG8_SCHED; }
            PG8_LDA(At, 1, 1); PG8_STAGE(PG8_SB(1, 0), b3, voffB); PG8_STAGE(PG8_SB(1, 1), b3 + hstep, voffB); PG8_STAGE(PG8_SA(1, 0), a3, vx0);
            PG8_WAIT_V(8); PG8_WAIT_L(0); PG8_BAR; PG8_MMA(1, 0, At, B0); PG8_MMA(1, 1, At, B1); PG8_BAR; PG8_SCHED;
            } else if constexpr (SP2) {
            if constexpr (FP8) { PG8_LDB(B0, 0, 0); PG8_LDA(At, 0, 0); PG8_LDB(B1, 0, 1); PG8_STAGE(PG8_SA(1, 1), a1 + hstep, voffA);
                PG8_WAIT_V8R; PG8_WAIT_L(4); PG8_BAR; PG8_MMA(0, 0, At, B0); PG8_WAIT_L(0); PG8_MMA(0, 1, At, B1); PG8_BAR; PG8_SCHED; }
            else { PG8_LDB(B0, 0, 0); PG8_LDB(B1, 0, 1); PG8_SCHED; PG8_LDA(At, 0, 0); PG8_STAGE(PG8_SA(1, 1), a1 + hstep, voffA);
                PG8_WAIT_V8R; PG8_WAIT_L(0); PG8_BAR; PG8_MMA(0, 0, At, B0); PG8_MMA(0, 1, At, B1); PG8_BAR; PG8_SCHED; }
            PG8_LDA(At, 0, 1); PG8_STAGE(PG8_SB(0, 0), b2, voffB); PG8_STAGE(PG8_SB(0, 1), b2 + hstep, voffB); PG8_STAGE(PG8_SA(0, 0), a2, voffA);
            PG8_WAIT_V8R; PG8_WAIT_L(0); PG8_BAR; PG8_MMA(1, 0, At, B0); PG8_MMA(1, 1, At, B1); PG8_BAR; PG8_SCHED;
            if constexpr (FP8) { PG8_LDB(B0, 1, 0); PG8_LDA(At, 1, 0); PG8_LDB(B1, 1, 1); PG8_STAGE(PG8_SA(0, 1), a2 + hstep, voffA);
                PG8_WAIT_V(8); PG8_WAIT_L(4); PG8_BAR; PG8_MMA(0, 0, At, B0); PG8_WAIT_L(0); PG8_MMA(0, 1, At, B1); PG8_BAR; PG8_SCHED; }
            else { PG8_LDB(B0, 1, 0); PG8_LDB(B1, 1, 1); PG8_SCHED; PG8_LDA(At, 1, 0); PG8_STAGE(PG8_SA(0, 1), a2 + hstep, voffA);
                PG8_WAIT_V(8); PG8_WAIT_L(0); PG8_BAR; PG8_MMA(0, 0, At, B0); PG8_MMA(0, 1, At, B1); PG8_BAR; PG8_SCHED; }
            PG8_LDA(At, 1, 1); PG8_STAGE(PG8_SB(1, 0), b3, voffB); PG8_STAGE(PG8_SB(1, 1), b3 + hstep, voffB); PG8_STAGE(PG8_SA(1, 0), a3, voffA);
            PG8_WAIT_V(8); PG8_WAIT_L(0); PG8_BAR; PG8_MMA(1, 0, At, B0); PG8_MMA(1, 1, At, B1); PG8_BAR; PG8_SCHED;
            } else {
            PG8_LDB(B0, 0, 0); PG8_SCHED; PG8_LDA(At, 0, 0); PG8_STAGE(PG8_SA(1, 1), a1 + hstep, voffA);
            PG8_WAIT_L(8); PG8_BAR; PG8_WAIT_L(0); PG8_MMA(0, 0, At, B0); PG8_BAR; PG8_SCHED;
            PG8_LDB(B1, 0, 1); PG8_STAGE(PG8_SB(0, 0), b2, voffB);
            PG8_BAR; PG8_WAIT_L(0); PG8_MMA(0, 1, At, B1); PG8_BAR;
            PG8_LDA(At, 0, 1); PG8_STAGE(PG8_SA(0, 0), a2, voffA);
            PG8_BAR; PG8_WAIT_L(0); PG8_MMA(1, 0, At, B0); PG8_BAR; PG8_SCHED;
            PG8_STAGE(PG8_SB(0, 1), b2 + hstep, voffB);
            PG8_WAIT_V(6); PG8_BAR; PG8_MMA(1, 1, At, B1); PG8_BAR;
            PG8_LDB(B0, 1, 0); PG8_SCHED; PG8_LDA(At, 1, 0); PG8_STAGE(PG8_SA(0, 1), a2 + hstep, voffA);
            PG8_WAIT_L(8); PG8_BAR; PG8_WAIT_L(0); PG8_MMA(0, 0, At, B0); PG8_BAR; PG8_SCHED;
            PG8_LDB(B1, 1, 1); PG8_STAGE(PG8_SB(1, 0), b3, voffB);
            PG8_BAR; PG8_WAIT_L(0); PG8_MMA(0, 1, At, B1); PG8_BAR;
            PG8_LDA(At, 1, 1); PG8_STAGE(PG8_SA(1, 0), a3, voffA);
            PG8_BAR; PG8_WAIT_L(0); PG8_MMA(1, 0, At, B0); PG8_BAR; PG8_SCHED;
            PG8_STAGE(PG8_SB(1, 1), b3 + hstep, voffB);
            PG8_WAIT_V(6); PG8_BAR; PG8_MMA(1, 1, At, B1); PG8_BAR;
            }
        }
        if constexpr (ALIGN_EPI) { if (wr == 0) PG8_BAR; }
        if constexpr (HSCALE) PG8_HSMUL(ui & 1, 3);
        if constexpr (FP8) asm volatile("s_nop 15\n\ts_nop 7" ::: "memory");
        { int te = threadIdx.x; asm volatile("" : "+v"(te));
          if constexpr (!NOEPI) E(acc, cur, wr, wc, te & 15, (te & 63) >> 4); else { float sink_ = 0.f; _Pragma("unroll") for (int a_ = 0; a_ < 2; ++a_) _Pragma("unroll") for (int b_ = 0; b_ < 2; ++b_) _Pragma("unroll") for (int m_ = 0; m_ < 4; ++m_) _Pragma("unroll") for (int n_ = 0; n_ < 2; ++n_) sink_ += acc[a_][b_][m_][n_][0]; asm volatile("" :: "v"(sink_)); } }
        if (!has_next) break;
#pragma unroll
        for (int a = 0; a < 2; ++a)
#pragma unroll
            for (int b = 0; b < 2; ++b)
#pragma unroll
                for (int m = 0; m < 4; ++m)
#pragma unroll
                    for (int n = 0; n < 2; ++n) acc[a][b][m][n] = (f32x4){0.f, 0.f, 0.f, 0.f};
        cur = nxt; cA = nA; cB = nB; ++ui;
        if constexpr (ALIGN_EPI) { if (wr == 1) PG8_BAR; }
    }
    PG8_WAIT_V(0);
    if constexpr (!ALIGN_EPI) { if (wr == 0) PG8_BAR; }
    PG8_BAR;
#undef PG8_GVOFF
#undef PG8_HSTAB
#undef PG8_HSMUL
#undef PG8_WAIT_V8R
#undef PG8_CAT
#undef PG8_SA
#undef PG8_SB
#undef PG8_STAGE
#undef PG8_LDA
#undef PG8_LDB
#undef PG8_MMA
#undef PG8_WAIT_V
#undef PG8_WAIT_L
#undef PG8_BAR
#undef PG8_SCHED
}
}

constexpr int NWAVES = 8;
constexpr int DM = 1024, NBATCH = 32, SEQ = 2048, MTOK = NBATCH * SEQ, DEPTH = 4, NEXP = 32, TOPK = 4;
constexpr int HG_N = 4096, RT_N = 6144, HG_H = 8, RT_H = 4;
constexpr float EPS = 1e-6f;
constexpr int LCAP = 65536;
constexpr int MAXTILES = 1056;
constexpr float YSC = 32.0f;
constexpr int YLD = DM;

constexpr size_t MiB = 1u << 20;
constexpr size_t WS_CTL = 0, CTL_ZERO_BYTES = 1 * MiB;
constexpr size_t WS_MOD = 1 * MiB;
constexpr size_t WS_FMOD = 4 * MiB;
constexpr size_t WS_LBV = 4 * MiB + 512 * 1024;
constexpr size_t WS_HWIN = 8 * MiB, WS_HWOUT = 24 * MiB, WS_RWIN = 28 * MiB, WS_RWOUT = 52 * MiB, WS_W1T = 64 * MiB, WS_W2T = 576 * MiB;
constexpr size_t WS_H = 832 * MiB;
constexpr size_t WS_LIST = 960 * MiB;
constexpr size_t WS_TSLOT = 968 * MiB, WS_TGATE = 969 * MiB;
constexpr size_t WS_R1 = 976 * MiB;
constexpr size_t WS_R2 = 1744 * MiB;
constexpr size_t WS_H8 = 2272 * MiB;
constexpr size_t WS_XB = 320 * MiB;
static_assert(MOE_FP8 == 1, "WS_XB lies in the half of the W1T region that bf16 expert weights would need");
constexpr size_t WS_END = 2336 * MiB;
constexpr int hg_rank(int s, int mask) { int r = 0; for (int i = 0; i < s; ++i) r += (mask >> i) & 1; return r; }
constexpr unsigned hg_smap(int mask) { unsigned m = 0; int r = 0; for (int i = 0; i < 4; ++i) if ((mask >> i) & 1) { m |= (unsigned)i << (4 * r); ++r; } return m; }
constexpr int HG_N8 = 1024 * hg_rank(4, HGRN_FP8_MASK), HG_N16 = 4096 - HG_N8;
constexpr int CW_BAR = 4096;
constexpr int CW_CNT = 8192;

constexpr int RING_OFF = 0, RING_BYTES = 131072;
constexpr int MISC_OFF = 155648;
constexpr int TAB_OFF = MISC_OFF + 128;
constexpr int LDS_BYTES = 160 * 1024;

#define GAS __attribute__((address_space(1)))
#define LAS __attribute__((address_space(3)))
typedef unsigned short bf16;
typedef unsigned v4u __attribute__((ext_vector_type(4)));
typedef unsigned v2u __attribute__((ext_vector_type(2)));
typedef float f32x4 __attribute__((ext_vector_type(4)));
typedef short bf16x8 __attribute__((ext_vector_type(8)));
#define RLX_AGENT __ATOMIC_RELAXED, __HIP_MEMORY_SCOPE_AGENT
#define LDS_WAIT() asm volatile("s_waitcnt lgkmcnt(0)" ::: "memory")
#define VM_WAIT() asm volatile("s_waitcnt vmcnt(0)" ::: "memory")
__device__ __forceinline__ unsigned pk2(float lo, float hi) { return pg8::cvt_pk_bf16(lo, hi); }
__device__ __forceinline__ unsigned pk4_fp8(float a, float b, float c, float d) { int p = 0; p = __builtin_amdgcn_cvt_pk_fp8_f32(a, b, p, false); p = __builtin_amdgcn_cvt_pk_fp8_f32(c, d, p, true); return (unsigned)p; }
__device__ __forceinline__ v4u pack8(const f32x4 a, const f32x4 b) { v4u w; w.x = pk2(a.x, a.y); w.y = pk2(a.z, a.w); w.z = pk2(b.x, b.y); w.w = pk2(b.z, b.w); return w; }
__device__ __forceinline__ float bflo(unsigned w) { return __uint_as_float(w << 16); }
__device__ __forceinline__ float bfhi(unsigned w) { return __uint_as_float(w & 0xffff0000u); }
__device__ __forceinline__ float bf2f(unsigned short h) { return __uint_as_float(((unsigned)h) << 16); }
__device__ __forceinline__ float sigmoidf_(float x) { return __builtin_amdgcn_rcpf(1.f + __expf(-x)); }
__device__ __forceinline__ float siluf_(float x) { return x * sigmoidf_(x); }
__device__ __forceinline__ f32x4 silu4_(const f32x4 x) {
    const f32x4 t = x * -1.4426950408889634f; f32x4 e, r;
#pragma unroll
    for (int j = 0; j < 4; ++j) e[j] = __builtin_amdgcn_exp2f(t[j]);
    const f32x4 d = e + 1.0f;
#pragma unroll
    for (int j = 0; j < 4; ++j) r[j] = __builtin_amdgcn_rcpf(d[j]);
    return x * r;
}
__device__ __forceinline__ unsigned ldu_vec(const unsigned* p) { return __hip_atomic_load(p, RLX_AGENT); }

#define XB_TMO      128
#define XB_XCNT(j)  (256  + 64 * (j))
#define XB_XSUB(j)  (1280 + 64 * (j))
#define XB_XGEN(j)  (2304 + 64 * (j))
#define XB_TOP      3328
#define XB_TOPGEN   3392
#define XCD_BAR_WORDS 3456
#define XB_SPIN_CAP (1u << 18)

__device__ __forceinline__ unsigned xb_ld(unsigned* p)              { return __hip_atomic_load(p, __ATOMIC_RELAXED, __HIP_MEMORY_SCOPE_AGENT); }
__device__ __forceinline__ unsigned xb_add(unsigned* p, unsigned v) { return __hip_atomic_fetch_add(p, v, __ATOMIC_RELAXED, __HIP_MEMORY_SCOPE_AGENT); }
__device__ __forceinline__ unsigned xb_xcc_id() { return (unsigned)__builtin_amdgcn_s_getreg((3 << 11) | 20) & 0xFu; }
#define XB_SPIN(cond, bar) do { unsigned _sp = 0; while (cond) { __builtin_amdgcn_s_sleep(1); \
    if ((++_sp & 255u) == 0u) { if (xb_ld(&(bar)[XB_TMO])) break; if (_sp > XB_SPIN_CAP) { atomicAdd(&(bar)[XB_TMO], 1u); break; } } } } while (0)

struct XcdBarrier {
    unsigned* bar; unsigned x;
    volatile LAS unsigned* st;
};
__device__ __forceinline__ XcdBarrier xcd_barrier_post(unsigned* bar, volatile LAS unsigned* st) {
    XcdBarrier b; b.bar = bar; b.x = xb_xcc_id(); b.st = st;
    if (threadIdx.x == 0) (void)xb_add(&bar[XB_XCNT(b.x)], 1u);
    return b;
}
__device__ __forceinline__ void xcd_barrier_complete(unsigned* bar, unsigned x, unsigned& nloc, unsigned& nx) {
    const unsigned G = gridDim.x * gridDim.y * gridDim.z;
    unsigned sum, cnt, mine, sp = 0u;
    for (;;) {
        sum = 0u; cnt = 0u; mine = 0u;
#pragma unroll
        for (unsigned j = 0; j < 16; ++j) { const unsigned c = xb_ld(&bar[XB_XCNT(j)]); sum += c; cnt += (c > 0u) ? 1u : 0u; mine = (j == x) ? c : mine; }
        if (sum == G) break;
        __builtin_amdgcn_s_sleep(1);
        if ((++sp & 255u) == 0u) { if (xb_ld(&bar[XB_TMO])) break; if (sp > XB_SPIN_CAP) { atomicAdd(&bar[XB_TMO], 1u); break; } }
    }
    nloc = mine > 0u ? mine : 1u; nx = cnt > 0u ? cnt : 1u;
}
__device__ __forceinline__ void xcd_barrier(const XcdBarrier& b) {
    asm volatile("s_waitcnt vmcnt(0)" ::: "memory");
    __syncthreads();
    if (threadIdx.x == 0) {
        unsigned* bar = b.bar;
        __builtin_amdgcn_s_waitcnt(0);
        unsigned nloc = b.st[0], nx = b.st[1];
        if (nloc == 0u) { xcd_barrier_complete(bar, b.x, nloc, nx); b.st[0] = nloc; b.st[1] = nx; }
        const unsigned old = xb_add(&bar[XB_XSUB(b.x)], 1u);
        const unsigned gen = old / nloc;
        if (old + 1u == (gen + 1u) * nloc) {
            __builtin_amdgcn_fence(__ATOMIC_RELEASE, "agent");
            asm volatile("s_waitcnt vmcnt(0)" ::: "memory");
            const unsigned og = xb_add(&bar[XB_TOP], 1u);
            const unsigned tg = og / nx;
            if (og + 1u == (tg + 1u) * nx) xb_add(&bar[XB_TOPGEN], 1u);
            else XB_SPIN(xb_ld(&bar[XB_TOPGEN]) == tg, bar);
            __builtin_amdgcn_fence(__ATOMIC_ACQUIRE, "agent");
            xb_add(&bar[XB_XGEN(b.x)], 1u);
            asm volatile("s_waitcnt vmcnt(0)" ::: "memory");
        } else {
            XB_SPIN(xb_ld(&bar[XB_XGEN(b.x)]) == gen, bar);
            __builtin_amdgcn_fence(__ATOMIC_ACQUIRE, "agent");
            asm volatile("s_waitcnt vmcnt(0)" ::: "memory");
        }
    }
    __syncthreads();
}

struct Frame {
    LAS unsigned char* lds;
    unsigned* ctl;
    int tid, lane, wave, vcu, G;
    float* out; unsigned char* ws;
};
__device__ __forceinline__ void relaunder(Frame& F) { int t = threadIdx.x; asm volatile("" : "+v"(t)); F.tid = t; F.lane = t & 63; F.wave = __builtin_amdgcn_readfirstlane(t >> 6); }
#define KAS __attribute__((address_space(4)))
__device__ __forceinline__ const void* kin_(int i) { const KAS char* kp = (const KAS char*)__builtin_amdgcn_kernarg_segment_ptr(); asm volatile("" : "+s"(kp)); return *(const void* const KAS*)(kp + 8 * i); }
enum { I_X = 0, I_C, I_POS, I_ADAW, I_ADAB, I_N1G, I_N2G, I_HWIN, I_HWOUT, I_HGAIN, I_HLB, I_RWIN, I_RWOUT, I_RTW, I_RTB, I_W1, I_B1, I_W2, I_B2, I_FG, I_FADAW, I_FADAB };
#define KIN(i) ((const float*)kin_(i))
__device__ __forceinline__ float wave_sum(float v) {
#pragma unroll
    for (int o = 1; o < 64; o <<= 1) v += __shfl_xor(v, o);
    return v;
}

__device__ __forceinline__ void p0_transpose_item(const float* W, int N, bf16* WT, int K, int k0, int n0, int drow0, LAS float* scr, int lane) {
    float wv[32];
#pragma unroll
    for (int i = 0; i < 32; ++i) wv[i] = W[(size_t)(k0 + 2 * i + (lane >> 5)) * N + n0 + (lane & 31)];
#pragma unroll
    for (int i = 0; i < 32; ++i) scr[(2 * i + (lane >> 5)) * 33 + (lane & 31)] = wv[i];
    LDS_WAIT(); asm volatile("" ::: "memory");
    const int c = lane & 7;
#pragma unroll
    for (int j = 0; j < 4; ++j) { const int n = (lane >> 3) + 8 * j; const LAS float* s = scr + (8 * c) * 33 + n;
        v4u o; o.x = pk2(s[0 * 33], s[1 * 33]); o.y = pk2(s[2 * 33], s[3 * 33]); o.z = pk2(s[4 * 33], s[5 * 33]); o.w = pk2(s[6 * 33], s[7 * 33]);
        *(GAS v4u*)(WT + (size_t)(drow0 + n) * K + k0 + 8 * c) = o; }
    LDS_WAIT(); asm volatile("" ::: "memory");
}
__device__ __forceinline__ void p0_transpose_item_f8(const float* W, int N, unsigned char* WT, int K, int k0, int n0, int drow0, LAS float* scr, int lane, float scale) {
    float wv[32];
#pragma unroll
    for (int i = 0; i < 32; ++i) wv[i] = W[(size_t)(k0 + 2 * i + (lane >> 5)) * N + n0 + (lane & 31)];
#pragma unroll
    for (int i = 0; i < 32; ++i) scr[(2 * i + (lane >> 5)) * 33 + (lane & 31)] = wv[i];
    LDS_WAIT(); asm volatile("" ::: "memory");
    const int n = lane >> 1, hf = lane & 1; const LAS float* sp = scr + (32 * hf) * 33 + n;
    v4u o0, o1;
    o0.x = pk4_fp8(sp[0 * 33] * scale, sp[1 * 33] * scale, sp[2 * 33] * scale, sp[3 * 33] * scale); o0.y = pk4_fp8(sp[4 * 33] * scale, sp[5 * 33] * scale, sp[6 * 33] * scale, sp[7 * 33] * scale);
    o0.z = pk4_fp8(sp[8 * 33] * scale, sp[9 * 33] * scale, sp[10 * 33] * scale, sp[11 * 33] * scale); o0.w = pk4_fp8(sp[12 * 33] * scale, sp[13 * 33] * scale, sp[14 * 33] * scale, sp[15 * 33] * scale);
    o1.x = pk4_fp8(sp[16 * 33] * scale, sp[17 * 33] * scale, sp[18 * 33] * scale, sp[19 * 33] * scale); o1.y = pk4_fp8(sp[20 * 33] * scale, sp[21 * 33] * scale, sp[22 * 33] * scale, sp[23 * 33] * scale);
    o1.z = pk4_fp8(sp[24 * 33] * scale, sp[25 * 33] * scale, sp[26 * 33] * scale, sp[27 * 33] * scale); o1.w = pk4_fp8(sp[28 * 33] * scale, sp[29 * 33] * scale, sp[30 * 33] * scale, sp[31 * 33] * scale);
    unsigned char* d = WT + (size_t)(drow0 + n) * K + k0 + 32 * hf; *(GAS v4u*)d = o0; *(GAS v4u*)(d + 16) = o1;
    LDS_WAIT(); asm volatile("" ::: "memory");
}
__device__ __forceinline__ void p0_prologue(Frame& F) {
    relaunder(F);
    __syncthreads();
    const int gw = F.vcu * NWAVES + F.wave, NGW = F.G * NWAVES;
    {
        LAS float* condT = (LAS float*)(F.lds + RING_OFF);
        const float* cin = KIN(I_C);
        for (int idx = F.tid; idx < NBATCH * DM; idx += NWAVES * 64) { const int b = idx >> 10, k = idx & 1023; condT[k * 32 + b] = siluf_(cin[idx]); }
        __syncthreads();
        { const int gsel = F.wave >> 2, kq = F.wave & 3, u = 2 * F.vcu + gsel; const bool act = (u < 416);
          const float* W = nullptr; const float* bias = nullptr; float* outp = nullptr; int N = 0, n0 = 0;
          if (act) { if (u < 384) { const int l = u / 96; n0 = (u % 96) * 64; N = 6 * DM; W = KIN(I_ADAW) + (size_t)l * DM * N; bias = KIN(I_ADAB) + l * N; outp = (float*)(F.ws + WS_MOD) + (size_t)l * NBATCH * N; }
                     else { n0 = (u - 384) * 64; N = 2 * DM; W = KIN(I_FADAW); bias = KIN(I_FADAB); outp = (float*)(F.ws + WS_FMOD); } }
          float acc[32];
#pragma unroll
          for (int b = 0; b < 32; ++b) acc[b] = 0.f;
          if (act) {
#pragma unroll 4
              for (int k = 256 * kq; k < 256 * kq + 256; ++k) {
                  const float w = W[(size_t)k * N + n0 + F.lane];
                  const LAS f32x4* cb = (const LAS f32x4*)(condT + k * 32);
#pragma unroll
                  for (int q = 0; q < 8; ++q) { const f32x4 cv = cb[q]; acc[4 * q + 0] += cv.x * w; acc[4 * q + 1] += cv.y * w; acc[4 * q + 2] += cv.z * w; acc[4 * q + 3] += cv.w * w; }
              } }
          __syncthreads();
          LAS float* red = (LAS float*)(F.lds + RING_OFF) + F.wave * 2048;
#pragma unroll
          for (int b = 0; b < 32; ++b) red[b * 64 + F.lane] = acc[b];
          __syncthreads();
          if (act && kq == 0) { const float bv = bias[n0 + F.lane];
#pragma unroll
              for (int b = 0; b < 32; ++b) { const LAS float* r0 = (const LAS float*)(F.lds + RING_OFF) + (4 * gsel) * 2048 + b * 64 + F.lane;
                  outp[(size_t)b * N + n0 + F.lane] = ((r0[0] + r0[2048]) + (r0[4096] + r0[6144])) + bv; } }
        }
        if (gw == NGW - 1) {
            float* lbv = (float*)(F.ws + WS_LBV); const float* hlb = KIN(I_HLB);
            for (int d = F.lane; d < DM; d += 64) { const float a = hlb[d], b = hlb[DM + d], m = fmaxf(a, b), ea = __expf(a - m), eb = __expf(b - m); lbv[d] = 0.f; lbv[DM + d] = eb / (ea + eb); }
        }
        __syncthreads();
    }
    {
        LAS float* scr = (LAS float*)(F.lds + RING_OFF + F.wave * 16384);
        constexpr int NI_HI = 2 * 16 * 128, NI_HO = 2 * 16 * 32, NI_RI = 2 * 16 * 192, NI_RO = 2 * 32 * 32, NI_W1 = 128 * 16 * 64, NI_W2 = 128 * 16 * 32;
        constexpr int NITEMS = NI_HI + NI_HO + NI_RI + NI_RO + NI_W1 + NI_W2;
        for (int it = gw; it < NITEMS; it += NGW) {
            int r = it;
            if (r < NI_HI) { const int j = r / 2048, q = r % 2048, kb = q / 128, nb = q % 128;
                const int sg = nb >> 5, nl = 32 * (nb & 31);
                if ((HGRN_FP8_MASK >> sg) & 1) p0_transpose_item_f8(KIN(I_HWIN) + (size_t)j * DM * HG_N, HG_N, F.ws + WS_HWIN + (size_t)j * HG_N8 * DM, DM, 64 * kb, 32 * nb, 1024 * hg_rank(sg, HGRN_FP8_MASK) + nl, scr, F.lane, 64.0f);
                else p0_transpose_item(KIN(I_HWIN) + (size_t)j * DM * HG_N, HG_N, (bf16*)(F.ws + WS_HWIN + 8 * MiB) + (size_t)j * HG_N16 * DM, DM, 64 * kb, 32 * nb, 1024 * hg_rank(sg, 0xF & ~HGRN_FP8_MASK) + nl, scr, F.lane);
                continue; } r -= NI_HI;
            if (r < NI_HO) { const int j = r / 512, q = r % 512, kb = q / 32, nb = q % 32;
                if (HGRN_OUT_FP8) p0_transpose_item_f8(KIN(I_HWOUT) + (size_t)j * DM * DM, DM, F.ws + WS_HWOUT + (size_t)j * DM * DM, DM, 64 * kb, 32 * nb, 32 * nb, scr, F.lane, 64.0f);
                else p0_transpose_item(KIN(I_HWOUT) + (size_t)j * DM * DM, DM, (bf16*)(F.ws + WS_HWOUT) + (size_t)j * DM * DM, DM, 64 * kb, 32 * nb, 32 * nb, scr, F.lane);
                continue; } r -= NI_HO;
            if (r < NI_RI) { const int j = r / 3072, q = r % 3072, kb = q / 192, nb = q % 192;
                if (RET_IN_FP8) p0_transpose_item_f8(KIN(I_RWIN) + (size_t)j * DM * RT_N, RT_N, F.ws + WS_RWIN + (size_t)j * RT_N * DM, DM, 64 * kb, 32 * nb, 32 * nb, scr, F.lane, 64.0f);
                else p0_transpose_item(KIN(I_RWIN) + (size_t)j * DM * RT_N, RT_N, (bf16*)(F.ws + WS_RWIN) + (size_t)j * RT_N * DM, DM, 64 * kb, 32 * nb, 32 * nb, scr, F.lane);
                continue; } r -= NI_RI;
            if (r < NI_RO) { const int j = r / 1024, q = r % 1024, kb = q / 32, nb = q % 32;
                p0_transpose_item(KIN(I_RWOUT) + (size_t)j * 2048 * DM, DM, (bf16*)(F.ws + WS_RWOUT) + (size_t)j * DM * 2048, 2048, 64 * kb, 32 * nb, 32 * nb, scr, F.lane); continue; } r -= NI_RO;
            if (r < NI_W1) { const int mi = r / 1024, q = r % 1024, kb = q / 64, nb = q % 64; const int n0 = 32 * nb;
                const int cc = n0 & 1023, drow0 = 256 * (cc >> 7) + (cc & 127) + ((n0 >= 1024) ? 128 : 0);
                if (MOE_FP8) p0_transpose_item_f8(KIN(I_W1) + (size_t)mi * DM * 2048, 2048, F.ws + WS_W1T + (size_t)mi * 2048 * DM, DM, 64 * kb, n0, drow0, scr, F.lane, 64.0f);
                else p0_transpose_item(KIN(I_W1) + (size_t)mi * DM * 2048, 2048, (bf16*)(F.ws + WS_W1T) + (size_t)mi * 2048 * DM, DM, 64 * kb, n0, drow0, scr, F.lane);
                continue; } r -= NI_W1;
            { const int mi = r / 512, q = r % 512, kb = q / 32, nb = q % 32;
                if (MOE_FP8) p0_transpose_item_f8(KIN(I_W2) + (size_t)mi * DM * DM, DM, F.ws + WS_W2T + (size_t)mi * DM * DM, DM, 64 * kb, 32 * nb, 32 * nb, scr, F.lane, 64.0f);
                else p0_transpose_item(KIN(I_W2) + (size_t)mi * DM * DM, DM, (bf16*)(F.ws + WS_W2T) + (size_t)mi * DM * DM, DM, 64 * kb, 32 * nb, 32 * nb, scr, F.lane); }
        }
    }
}

__device__ __forceinline__ void phase_skew(Frame& F, unsigned ticks) {
    const unsigned long long t0 = __builtin_amdgcn_s_memrealtime(), d = (unsigned long long)((unsigned)F.vcu & 7u) * ticks;
    while (__builtin_amdgcn_s_memrealtime() - t0 < d) __builtin_amdgcn_s_sleep(4);
}
__device__ __forceinline__ void build_tiles(Frame& F, int l) {
    LAS int* ts = (LAS int*)(F.lds + TAB_OFF); LAS int* cnt = ts + 40;
    __syncthreads();
    if (F.tid < NEXP) cnt[F.tid] = (int)ldu_vec(F.ctl + CW_CNT + l * 2048 + F.tid * 64);
    __syncthreads();
    if (F.tid == 0) { int a = 0; for (int e = 0; e < NEXP; ++e) { ts[e] = a; a += (cnt[e] + 255) >> 8; } ts[NEXP] = a; }
    __syncthreads();
}

__device__ __forceinline__ void row_phase1(Frame& F, int l, int mode, bool dry = false) {
    relaunder(F);
    float* xdst = dry ? (float*)(F.ws + WS_R2) : F.out;
    bf16* xbd = dry ? (bf16*)(F.ws + WS_R2) : (bf16*)(F.ws + WS_XB);
    const bf16* xb = (const bf16*)(F.ws + WS_XB);
    const LAS int* ts = (const LAS int*)(F.lds + TAB_OFF);
    const bool comb = (l > 0);
    if (comb) build_tiles(F, l - 1);
    const float* xsrc = KIN(I_X);
    const unsigned char* Y = F.ws + WS_R1;
    const unsigned* tslot = (const unsigned*)(F.ws + WS_TSLOT); const unsigned* tgate = (const unsigned*)(F.ws + WS_TGATE);
    bf16* H = dry ? (bf16*)(F.ws + WS_R2 + 256 * MiB) : (bf16*)(F.ws + WS_H);
    const int cl = 8 * F.lane;
#define RP_COL(j) (cl + 512 * ((j) >> 1) + 4 * ((j) & 1))
    for (int rb = F.vcu * 256; rb < MTOK; rb += F.G * 256) {
        const int b = rb / SEQ;
        f32x4 A[4], B[4], G2[4];
#pragma unroll
        for (int j = 0; j < 4; ++j) {
            const int c = RP_COL(j);
            if (mode == 0) { const float* mv = (const float*)(F.ws + WS_MOD) + (size_t)(l * NBATCH + b) * 6 * DM;
                const f32x4 g = *(const f32x4*)(KIN(I_N1G) + l * DM + c), sc = *(const f32x4*)(mv + 1 * DM + c); A[j] = g * (sc + 1.0f); B[j] = *(const f32x4*)(mv + c); }
            else { const float* fm = (const float*)(F.ws + WS_FMOD) + (size_t)b * 2 * DM;
                const f32x4 g = *(const f32x4*)(KIN(I_FG) + c), sc = *(const f32x4*)(fm + DM + c); A[j] = g * (sc + 1.0f); B[j] = *(const f32x4*)(fm + c); }
            if (comb) G2[j] = *(const f32x4*)((const float*)(F.ws + WS_MOD) + (size_t)((l - 1) * NBATCH + b) * 6 * DM + 5 * DM + c) * (1.0f / YSC); else G2[j] = (f32x4){0.f, 0.f, 0.f, 0.f};
        }
        f32x4 xn[4]; v4u xq[2]; unsigned sln = 0u, gtn = 0u;
        { const int row = rb + 32 * F.wave;
          if (comb) {
#pragma unroll
              for (int p = 0; p < 2; ++p) xq[p] = *(const v4u*)(xb + (size_t)row * DM + cl + 512 * p);
              sln = tslot[(size_t)row * 4 + (F.lane & 3)]; gtn = tgate[(size_t)row * 4 + (F.lane & 3)];
          } else {
#pragma unroll
              for (int j = 0; j < 4; ++j) xn[j] = *(const f32x4*)(xsrc + (size_t)row * DM + RP_COL(j));
          } }
        for (int r = 0; r < 32; ++r) {
            const int row = rb + 32 * F.wave + r;
            f32x4 v[4];
            if (comb) {
#pragma unroll
                for (int p = 0; p < 2; ++p) { const v4u q = xq[p]; v[2 * p] = (f32x4){bflo(q.x), bfhi(q.x), bflo(q.y), bfhi(q.y)}; v[2 * p + 1] = (f32x4){bflo(q.z), bfhi(q.z), bflo(q.w), bfhi(q.w)}; }
            } else {
#pragma unroll
                for (int j = 0; j < 4; ++j) v[j] = xn[j];
            }
            const unsigned sl = sln, gt = gtn;
            v2u yw[TOPK][2]; float gkk[TOPK];
            if (comb) {
#pragma unroll
                for (int k = 0; k < TOPK; ++k) {
                    const unsigned s_ = (unsigned)__shfl((int)sl, k); gkk[k] = __uint_as_float((unsigned)__shfl((int)gt, k));
                    const int e = (int)(s_ >> 20), pos = (int)(s_ & 0xFFFFFu); const size_t yrow = (size_t)ts[e] * 256 + pos;
#pragma unroll
                    for (int p = 0; p < 2; ++p) yw[k][p] = *(const v2u*)(Y + yrow * YLD + cl + 512 * p); }
            }
            if (r + 1 < 32) { const int rn = row + 1;
                if (comb) {
#pragma unroll
                    for (int p = 0; p < 2; ++p) xq[p] = *(const v4u*)(xb + (size_t)rn * DM + cl + 512 * p);
                    sln = tslot[(size_t)rn * 4 + (F.lane & 3)]; gtn = tgate[(size_t)rn * 4 + (F.lane & 3)];
                } else {
#pragma unroll
                    for (int j = 0; j < 4; ++j) xn[j] = *(const f32x4*)(xsrc + (size_t)rn * DM + RP_COL(j));
                } }
            if (comb) {
                f32x4 ys[4];
#pragma unroll
                for (int j = 0; j < 4; ++j) ys[j] = (f32x4){0.f, 0.f, 0.f, 0.f};
#pragma unroll
                for (int k = 0; k < TOPK; ++k) { const float gk = gkk[k];
#pragma unroll
                    for (int p = 0; p < 2; ++p) { const v2u w = yw[k][p];
                        const auto f0 = __builtin_amdgcn_cvt_pk_f32_fp8((int)w.x, false), f1 = __builtin_amdgcn_cvt_pk_f32_fp8((int)w.x, true), f2 = __builtin_amdgcn_cvt_pk_f32_fp8((int)w.y, false), f3 = __builtin_amdgcn_cvt_pk_f32_fp8((int)w.y, true);
                        ys[2 * p].x += gk * f0[0]; ys[2 * p].y += gk * f0[1]; ys[2 * p].z += gk * f1[0]; ys[2 * p].w += gk * f1[1];
                        ys[2 * p + 1].x += gk * f2[0]; ys[2 * p + 1].y += gk * f2[1]; ys[2 * p + 1].z += gk * f3[0]; ys[2 * p + 1].w += gk * f3[1]; } }
#pragma unroll
                for (int j = 0; j < 4; ++j) v[j] = v[j] + G2[j] * ys[j];
                if (mode == 0) {
#pragma unroll
                    for (int p = 0; p < 2; ++p) *(v4u*)(xbd + (size_t)row * DM + cl + 512 * p) = pack8(v[2 * p], v[2 * p + 1]);
                }
            }
            float s2 = 0.f;
#pragma unroll
            for (int j = 0; j < 4; ++j) s2 += (v[j].x * v[j].x + v[j].y * v[j].y) + (v[j].z * v[j].z + v[j].w * v[j].w);
            const float rstd = 1.0f / sqrtf(wave_sum(s2) * (1.0f / DM) + EPS);
            if (mode == 0) {
#pragma unroll
                for (int p = 0; p < 2; ++p) { const f32x4 h0 = v[2 * p] * rstd * A[2 * p] + B[2 * p], h1 = v[2 * p + 1] * rstd * A[2 * p + 1] + B[2 * p + 1];
                    const bool w8 = ((l & 1) ? (RET_IN_FP8 != 0) : (HGRN_FP8_MASK != 0)) && !dry, w16 = ((l & 1) ? (RET_IN_FP8 == 0) : (HGRN_FP8_MASK != 0xF)) || dry;
                    if (w8) { v2u w; w.x = pk4_fp8(h0.x * 8.0f, h0.y * 8.0f, h0.z * 8.0f, h0.w * 8.0f); w.y = pk4_fp8(h1.x * 8.0f, h1.y * 8.0f, h1.z * 8.0f, h1.w * 8.0f); *(v2u*)(F.ws + WS_H8 + (size_t)row * DM + cl + 512 * p) = w; }
                    if (w16) *(v4u*)(H + (size_t)row * DM + cl + 512 * p) = pack8(h0, h1); }
            } else {
#pragma unroll
                for (int j = 0; j < 4; ++j) *(f32x4*)(xdst + (size_t)row * DM + RP_COL(j)) = v[j] * rstd * A[j] + B[j];
            }
        }
    }
#undef RP_COL
}

__device__ __forceinline__ void row_phase2(Frame& F, int l, bool dry = false) {
    relaunder(F);
    bf16* H = dry ? (bf16*)(F.ws + WS_R2) : (bf16*)(F.ws + WS_H); unsigned char* H8p = dry ? F.ws + WS_R2 + 128 * MiB : F.ws + WS_H8;
    LAS unsigned char* frag = F.lds + RING_OFF;
    LAS float* lg = (LAS float*)(F.lds + 131072 + F.wave * 2112);
    LAS int* cntL = (LAS int*)(F.lds + 147968); LAS int* baseL = cntL + 32; LAS float* rbias = (LAS float*)(cntL + 64);
    unsigned* list = (unsigned*)(F.ws + WS_LIST); unsigned* tslot = (unsigned*)(F.ws + WS_TSLOT); float* tgate = (float*)(F.ws + WS_TGATE);
    __syncthreads();
    { const float* rw = KIN(I_RTW) + (size_t)l * DM * NEXP;
#pragma unroll
      for (int it = F.tid; it < 32 * 2 * 64; it += NWAVES * 64) { const int ln = it & 63, nt = (it >> 6) & 1, s = it >> 7; const int e = 16 * nt + (ln & 15), k0 = 32 * s + 8 * (ln >> 4);
          float w[8], hi[8];
#pragma unroll
          for (int j = 0; j < 8; ++j) { w[j] = rw[(size_t)(k0 + j) * NEXP + e]; }
          v4u ph, pl;
          { unsigned a = pk2(w[0], w[1]), b2 = pk2(w[2], w[3]), c2 = pk2(w[4], w[5]), d2 = pk2(w[6], w[7]); ph = (v4u){a, b2, c2, d2};
            hi[0] = bflo(a); hi[1] = bfhi(a); hi[2] = bflo(b2); hi[3] = bfhi(b2); hi[4] = bflo(c2); hi[5] = bfhi(c2); hi[6] = bflo(d2); hi[7] = bfhi(d2); }
          pl = (v4u){pk2(w[0] - hi[0], w[1] - hi[1]), pk2(w[2] - hi[2], w[3] - hi[3]), pk2(w[4] - hi[4], w[5] - hi[5]), pk2(w[6] - hi[6], w[7] - hi[7])};
          *(LAS v4u*)(frag + ((s * 2 + nt) * 2 + 0) * 1024 + ln * 16) = ph; *(LAS v4u*)(frag + ((s * 2 + nt) * 2 + 1) * 1024 + ln * 16) = pl; }
      if (F.tid < NEXP) rbias[F.tid] = KIN(I_RTB)[l * NEXP + F.tid];
    }
    LAS float* modA = (LAS float*)(F.lds + 148480); LAS float* modB = (LAS float*)(F.lds + 156160);
    for (int rb = F.vcu * 256; rb < MTOK; rb += F.G * 256) {
        const int b = rb / SEQ;
        if (F.tid < NEXP) cntL[F.tid] = 0;
        { const float* mv = (const float*)(F.ws + WS_MOD) + (size_t)(l * NBATCH + b) * 6 * DM;
          int t1 = threadIdx.x; asm volatile("" : "+v"(t1));
          for (int c = t1; c < DM; c += NWAVES * 64) { modA[c] = KIN(I_N2G)[l * DM + c] * (mv[4 * DM + c] + 1.0f); modB[c] = mv[3 * DM + c]; } }
        __syncthreads();
        int my_el[2][TOPK]; float my_g[2][TOPK];
#pragma unroll
        for (int grp = 0; grp < 2; ++grp) {
            __builtin_amdgcn_sched_barrier(0);
            const int row0 = rb + 32 * F.wave + 16 * grp, rr = F.lane & 15, gq = F.lane >> 4;
            const bf16* xp = (const bf16*)(F.ws + WS_XB) + (size_t)(row0 + rr) * DM + 8 * gq; unsigned char* h8 = H8p + (size_t)(row0 + rr) * DM + 8 * gq;
            v4u xr[32]; float s2 = 0.f;
#pragma unroll
            for (int s_ = 0; s_ < 32; ++s_) xr[s_] = *(const v4u*)(xp + 32 * s_);
#pragma unroll
            for (int s_ = 0; s_ < 32; ++s_) { const v4u q = xr[s_]; const f32x4 a = (f32x4){bflo(q.x), bfhi(q.x), bflo(q.y), bfhi(q.y)}, c = (f32x4){bflo(q.z), bfhi(q.z), bflo(q.w), bfhi(q.w)}; const f32x4 t = a * a + c * c; s2 += (t.x + t.y) + (t.z + t.w); }
            s2 += __shfl_xor(s2, 16); s2 += __shfl_xor(s2, 32);
            const float rstd = 1.0f / sqrtf(s2 * (1.0f / DM) + EPS);
            f32x4 acc0 = (f32x4){0.f, 0.f, 0.f, 0.f}, acc1 = (f32x4){0.f, 0.f, 0.f, 0.f};
#pragma unroll
            for (int s_ = 0; s_ < 32; ++s_) { v4u q = xr[s_]; asm volatile("" : "+v"(q.x), "+v"(q.y), "+v"(q.z), "+v"(q.w));
                const f32x4 A0 = *(const LAS f32x4*)(modA + 32 * s_ + 8 * gq), A1 = *(const LAS f32x4*)(modA + 32 * s_ + 8 * gq + 4), B0 = *(const LAS f32x4*)(modB + 32 * s_ + 8 * gq), B1 = *(const LAS f32x4*)(modB + 32 * s_ + 8 * gq + 4);
                const f32x4 h0 = ((f32x4){bflo(q.x), bfhi(q.x), bflo(q.y), bfhi(q.y)} * rstd) * A0 + B0, h1 = ((f32x4){bflo(q.z), bfhi(q.z), bflo(q.w), bfhi(q.w)} * rstd) * A1 + B1;
                const v4u av = pack8(h0, h1); const bf16x8 a = __builtin_bit_cast(bf16x8, av);
                if (MOE_FP8) { const f32x4 e0 = h0 * 8.0f, e1 = h1 * 8.0f; v2u w; w.x = pk4_fp8(e0.x, e0.y, e0.z, e0.w); w.y = pk4_fp8(e1.x, e1.y, e1.z, e1.w); *(v2u*)(h8 + 32 * s_) = w; }
                const bf16x8 b00 = *(const LAS bf16x8*)(frag + ((s_ * 2 + 0) * 2 + 0) * 1024 + F.lane * 16), b01 = *(const LAS bf16x8*)(frag + ((s_ * 2 + 0) * 2 + 1) * 1024 + F.lane * 16);
                const bf16x8 b10 = *(const LAS bf16x8*)(frag + ((s_ * 2 + 1) * 2 + 0) * 1024 + F.lane * 16), b11 = *(const LAS bf16x8*)(frag + ((s_ * 2 + 1) * 2 + 1) * 1024 + F.lane * 16);
                acc0 = __builtin_amdgcn_mfma_f32_16x16x32_bf16(a, b00, acc0, 0, 0, 0); acc0 = __builtin_amdgcn_mfma_f32_16x16x32_bf16(a, b01, acc0, 0, 0, 0);
                acc1 = __builtin_amdgcn_mfma_f32_16x16x32_bf16(a, b10, acc1, 0, 0, 0); acc1 = __builtin_amdgcn_mfma_f32_16x16x32_bf16(a, b11, acc1, 0, 0, 0);
                __builtin_amdgcn_sched_barrier(0);
            }
#pragma unroll
            for (int q = 0; q < 4; ++q) { lg[(4 * (F.lane >> 4) + q) * 33 + (F.lane & 15)] = acc0[q]; lg[(4 * (F.lane >> 4) + q) * 33 + 16 + (F.lane & 15)] = acc1[q]; }
            LDS_WAIT(); asm volatile("" ::: "memory");
            if (F.lane < 16) {
                unsigned taken = 0u; float tl[TOPK];
#pragma unroll
                for (int k = 0; k < TOPK; ++k) {
                    float best = -3.0e38f; int bi = 0;
                    for (int e = 0; e < NEXP; ++e) { const float v = lg[F.lane * 33 + e] + rbias[e]; if (!((taken >> e) & 1u) && v > best) { best = v; bi = e; } }
                    taken |= 1u << bi; my_el[grp][k] = bi; tl[k] = best;
                }
                float den = 0.f, ex[TOPK];
#pragma unroll
                for (int k = 0; k < TOPK; ++k) { ex[k] = __expf(tl[k] - tl[0]); den += ex[k]; }
#pragma unroll
                for (int k = 0; k < TOPK; ++k) { my_g[grp][k] = ex[k] / den; my_el[grp][k] |= __hip_atomic_fetch_add(&cntL[my_el[grp][k]], 1, __ATOMIC_RELAXED, __HIP_MEMORY_SCOPE_WORKGROUP) << 8; }
            } else {
#pragma unroll
                for (int k = 0; k < TOPK; ++k) { my_el[grp][k] = 0; my_g[grp][k] = 0.f; }
            }
            LDS_WAIT(); asm volatile("" ::: "memory");
        }
        __syncthreads();
        { int t2 = threadIdx.x; asm volatile("" : "+v"(t2));
          if (t2 < NEXP && !dry) baseL[t2] = (int)__hip_atomic_fetch_add(F.ctl + CW_CNT + l * 2048 + t2 * 64, (unsigned)cntL[t2], RLX_AGENT); }
        __syncthreads();
        int ln2 = threadIdx.x & 63; asm volatile("" : "+v"(ln2));
        if (ln2 < 16 && !dry) {
#pragma unroll
            for (int grp = 0; grp < 2; ++grp) {
                const int row = rb + 32 * F.wave + 16 * grp + ln2;
#pragma unroll
                for (int k = 0; k < TOPK; ++k) { const int e = my_el[grp][k] & 255, pos = baseL[e] + (my_el[grp][k] >> 8);
                    list[(size_t)e * LCAP + pos] = (unsigned)row; tslot[(size_t)row * 4 + k] = ((unsigned)e << 20) | (unsigned)pos; tgate[(size_t)row * 4 + k] = my_g[grp][k]; }
            }
        }
        __syncthreads();
    }
}

__device__ __forceinline__ void moe_gather(Frame& F, int l) {
    relaunder(F);
    build_tiles(F, l);
    const LAS int* ts = (const LAS int*)(F.lds + TAB_OFF); const LAS int* cnt = ts + 40;
    const unsigned* list = (const unsigned*)(F.ws + WS_LIST); const bf16* H = (const bf16*)(F.ws + WS_H); bf16* Xg = (bf16*)(F.ws + WS_R1);
    const int gw = F.vcu * NWAVES + F.wave, NGW = F.G * NWAVES, NR = ts[NEXP] * 256;
    for (int r = gw; r < NR; r += NGW) {
        const int mt = r >> 8; int e = 0;
        for (int k = 1; k < NEXP; ++k) e += (ts[k] <= mt) ? 1 : 0;
        const int pos = r - ts[e] * 256;
        unsigned tok = 0u; if (pos < cnt[e]) tok = ldu_vec(list + (size_t)e * LCAP + pos);
        const v4u* src = (const v4u*)(H + (size_t)tok * DM); v4u* dst = (v4u*)(Xg + (size_t)r * DM);
        dst[F.lane] = src[F.lane]; dst[F.lane + 64] = src[F.lane + 64];
    }
}

__device__ __forceinline__ void moe_build_tt(Frame& F, int nN) {
    const LAS int* ts = (const LAS int*)(F.lds + TAB_OFF); const LAS int* cnt = ts + 40;
    LAS unsigned short* tt = (LAS unsigned short*)(F.lds + 131072);
    const unsigned* list = (const unsigned*)(F.ws + WS_LIST); const int NU = ts[NEXP] * nN;
    const int tsk = (F.lane >= 1 && F.lane < NEXP) ? ts[F.lane] : 0x7fffffff;
#pragma unroll 1
    for (int jo = 0; jo < 18; jo += 3) {
        unsigned tok[3];
#pragma unroll
        for (int ji = 0; ji < 3; ++ji) { const int i = 2 * (jo + ji) + (F.tid >> 8), r = F.tid & 255, L = i * F.G + F.vcu, mt = L / nN;
            const int e = (int)__builtin_popcountll(__ballot(tsk <= mt)); const int pos = (mt - ts[e]) * 256 + r;
            tok[ji] = 0u; if (L < NU && pos < cnt[e]) tok[ji] = list[(size_t)e * LCAP + pos]; }
#pragma unroll
        for (int ji = 0; ji < 3; ++ji) { const int i = 2 * (jo + ji) + (F.tid >> 8), r = F.tid & 255, L = i * F.G + F.vcu;
            if (L < NU) tt[i * 256 + r] = (unsigned short)tok[ji]; }
    }
    __syncthreads();
}

using pg8::Unit;

struct EpiHgrnIn {
    static constexpr bool PERM = true; static constexpr int NST = 16;
    unsigned char* r1; const float* lb; unsigned smap; float asc;
    __device__ __forceinline__ void operator()(const f32x4 (&acc)[2][2][4][2], const Unit& u, int wr, int wc, int fr, int fq) const {
        const int seg = (int)((smap >> (4 * (u.pn >> 2))) & 15u), row0 = u.pm * 256 + wr * 64 + fr, cs0 = (u.pn & 3) * 256 + wc * 32 + 8 * fq;
        if (seg == 1) {
            bf16* LFb = (bf16*)(r1 + 128 * MiB);
#pragma unroll
            for (int bj = 0; bj < 2; ++bj) {
                f32x4 lbv[2]; lbv[0] = *(const f32x4*)(lb + cs0 + bj * 128); lbv[1] = *(const f32x4*)(lb + cs0 + bj * 128 + 4);
#pragma unroll
                for (int ai = 0; ai < 2; ++ai)
#pragma unroll
                    for (int m = 0; m < 4; ++m) { const size_t ro = (size_t)(row0 + ai * 128 + m * 16) * DM + cs0 + bj * 128; f32x4 lf[2];
#pragma unroll
                        for (int n = 0; n < 2; ++n)
#pragma unroll
                            for (int j = 0; j < 4; ++j) { const float f = fminf(fmaxf(acc[ai][bj][m][n][j] * asc, -60.f), 60.f), l0 = lbv[n][j], ef = __expf(f);
                                const float sg = ef * __builtin_amdgcn_rcpf(1.f + ef);
                                lf[n][j] = __log2f(l0 + (1.f - l0) * sg); }
                        *(v4u*)(LFb + ro) = pack8(lf[0], lf[1]);
                        __builtin_amdgcn_sched_barrier(0); }
            }
        } else {
            bf16* dst = (bf16*)(r1 + (seg == 0 ? 0 : (seg == 2 ? 256 * MiB : 384 * MiB))); const bool act = (seg != 2);
#pragma unroll
            for (int ai = 0; ai < 2; ++ai)
#pragma unroll
                for (int m = 0; m < 4; ++m) { const size_t ro = (size_t)(row0 + ai * 128 + m * 16) * DM;
#pragma unroll
                    for (int bj = 0; bj < 2; ++bj) { f32x4 v0 = acc[ai][bj][m][0] * asc, v1 = acc[ai][bj][m][1] * asc;
                        if (act) {
                            v0 = silu4_(v0); v1 = silu4_(v1); }
                        *(v4u*)(dst + ro + cs0 + bj * 128) = pack8(v0, v1); }
                    __builtin_amdgcn_sched_barrier(0); }
        }
    }
};

struct EpiRetIn {
    static constexpr bool PERM = true; static constexpr int NST = 16;
    unsigned char* r1; const int* positions; float asc;
    __device__ __forceinline__ void operator()(const f32x4 (&acc)[2][2][4][2], const Unit& u, int wr, int wc, int fr, int fq) const {
        const int row0 = u.pm * 256 + wr * 64 + fr, cl = wc * 32 + 8 * fq;
        if (u.pn < 8) {
            bf16* dst = (bf16*)(r1 + ((u.pn < 4) ? 0 : 128 * MiB)); const float sc = ((u.pn < 4) ? 1.0f : 0.0625f) * asc; const int hh = u.pn & 3;
            float invrev[2][4];
#pragma unroll
            for (int n = 0; n < 2; ++n)
#pragma unroll
                for (int j = 0; j < 4; ++j) invrev[n][j] = exp2f(-(float)(cl + 4 * n + j) * 0.10462765653188542f) * 0.15915494309189535f;
#pragma unroll
            for (int ai = 0; ai < 2; ++ai)
#pragma unroll
                for (int m = 0; m < 4; ++m) { const int row = row0 + ai * 128 + m * 16; const float pos = (float)positions[row]; const size_t ro = (size_t)row * DM + hh * 256 + cl;
                    f32x4 o1[2], o2[2];
#pragma unroll
                    for (int n = 0; n < 2; ++n)
#pragma unroll
                        for (int j = 0; j < 4; ++j) { const float rev = pos * invrev[n][j], fr_ = rev - floorf(rev); const float cs = __builtin_amdgcn_cosf(fr_), sn = __builtin_amdgcn_sinf(fr_);
                            const float x1 = acc[ai][0][m][n][j], x2 = acc[ai][1][m][n][j]; o1[n][j] = (x1 * cs - x2 * sn) * sc; o2[n][j] = (x2 * cs + x1 * sn) * sc; }
                    *(v4u*)(dst + ro) = pack8(o1[0], o1[1]); *(v4u*)(dst + ro + 128) = pack8(o2[0], o2[1]); }
        } else {
            const bool isg = (u.pn >= 16); bf16* dst = (bf16*)(r1 + (isg ? 512 * MiB : 256 * MiB)); const int ct = (isg ? u.pn - 16 : u.pn - 8) * 256 + cl;
#pragma unroll
            for (int ai = 0; ai < 2; ++ai)
#pragma unroll
                for (int m = 0; m < 4; ++m) { const size_t ro = (size_t)(row0 + ai * 128 + m * 16) * 2048 + ct;
#pragma unroll
                    for (int bj = 0; bj < 2; ++bj) { f32x4 v0 = acc[ai][bj][m][0] * asc, v1 = acc[ai][bj][m][1] * asc;
                        if (isg) {
                            v0 = silu4_(v0); v1 = silu4_(v1); }
                        *(v4u*)(dst + ro + bj * 128) = pack8(v0, v1); } }
        }
    }
};

template <bool XF32>
struct EpiOutT {
    static constexpr bool PERM = true; static constexpr int NST = XF32 ? 4 : 8;
    const void* xin; bf16* xout; const float* gate; float asc;
    __device__ __forceinline__ void operator()(const f32x4 (&acc)[2][2][4][2], const Unit& u, int wr, int wc, int fr, int fq) const {
        const int row0 = u.pm * 256 + wr * 64 + fr, c0 = u.pn * 256 + wc * 32 + 8 * fq, b = (u.pm * 256) / SEQ;
        f32x4 gv[2][2];
#pragma unroll
        for (int bj = 0; bj < 2; ++bj)
#pragma unroll
            for (int n = 0; n < 2; ++n) gv[bj][n] = *(const f32x4*)(gate + (size_t)b * 6 * DM + c0 + bj * 128 + 4 * n) * asc;
        if constexpr (XF32) {
#pragma unroll
            for (int ai = 0; ai < 2; ++ai)
#pragma unroll
                for (int mp = 0; mp < 2; ++mp) { f32x4 xi[2][2][2];
#pragma unroll
                    for (int mm = 0; mm < 2; ++mm)
#pragma unroll
                        for (int bj = 0; bj < 2; ++bj)
#pragma unroll
                            for (int n = 0; n < 2; ++n) xi[mm][bj][n] = *(const f32x4*)((const float*)xin + (size_t)(row0 + ai * 128 + (2 * mp + mm) * 16) * DM + c0 + bj * 128 + 4 * n);
#pragma unroll
                    for (int mm = 0; mm < 2; ++mm)
#pragma unroll
                        for (int bj = 0; bj < 2; ++bj)
                            *(v4u*)(xout + (size_t)(row0 + ai * 128 + (2 * mp + mm) * 16) * DM + c0 + bj * 128) = pack8(xi[mm][bj][0] + gv[bj][0] * acc[ai][bj][2 * mp + mm][0], xi[mm][bj][1] + gv[bj][1] * acc[ai][bj][2 * mp + mm][1]);
                    asm volatile("" ::: "memory"); }
        } else {
#pragma unroll
            for (int ai = 0; ai < 2; ++ai) { v4u xi[4][2];
#pragma unroll
                for (int m = 0; m < 4; ++m)
#pragma unroll
                    for (int bj = 0; bj < 2; ++bj) xi[m][bj] = *(const v4u*)((const bf16*)xin + (size_t)(row0 + ai * 128 + m * 16) * DM + c0 + bj * 128);
#pragma unroll
                for (int m = 0; m < 4; ++m)
#pragma unroll
                    for (int bj = 0; bj < 2; ++bj) { const v4u q = xi[m][bj];
                        const f32x4 lo = (f32x4){bflo(q.x), bfhi(q.x), bflo(q.y), bfhi(q.y)}, hi = (f32x4){bflo(q.z), bfhi(q.z), bflo(q.w), bfhi(q.w)};
                        *(v4u*)(xout + (size_t)(row0 + ai * 128 + m * 16) * DM + c0 + bj * 128) = pack8(lo + gv[bj][0] * acc[ai][bj][m][0], hi + gv[bj][1] * acc[ai][bj][m][1]); }
                asm volatile("" ::: "memory"); }
        }
    }
};

struct EpiMoe1F8 {
    static constexpr bool PERM = true; static constexpr int NST = 4;
    unsigned char* A2; const float* b1;
    __device__ __forceinline__ void operator()(const f32x4 (&acc)[2][2][4][2], const Unit& u, int wr, int wc, int fr, int fq) const {
        const int row0 = u.pm * 256 + wr * 64 + fr, gc = u.nn * 128 + wc * 32 + 8 * fq; const float* bp = b1 + (size_t)u.e * 2048;
        f32x4 bg[2], bl[2];
#pragma unroll
        for (int n = 0; n < 2; ++n) { bg[n] = *(const f32x4*)(bp + gc + 4 * n); bl[n] = *(const f32x4*)(bp + 1024 + gc + 4 * n); }
        const int od = fq & 1;
#pragma unroll
        for (int ai = 0; ai < 2; ++ai)
#pragma unroll
            for (int p = 0; p < 2; ++p) { v2u w2[2];
#pragma unroll
                for (int q2 = 0; q2 < 2; ++q2) { const int m = 2 * p + q2; f32x4 o[2];
#pragma unroll
                for (int n = 0; n < 2; ++n) {
                    f32x4 g = acc[ai][0][m][n] * (1.0f / 512.f) + bg[n], li = acc[ai][1][m][n] * (1.0f / 512.f) + bl[n];
                    g = __builtin_elementwise_min(g, (f32x4){7.0f, 7.0f, 7.0f, 7.0f});
                    li = __builtin_elementwise_min(__builtin_elementwise_max(li, (f32x4){-7.0f, -7.0f, -7.0f, -7.0f}), (f32x4){7.0f, 7.0f, 7.0f, 7.0f});
                    const f32x4 t = g * (-1.702f * 1.4426950408889634f); f32x4 e, r;
#pragma unroll
                    for (int j = 0; j < 4; ++j) e[j] = __builtin_amdgcn_exp2f(t[j]);
                    const f32x4 d = e + 1.0f;
#pragma unroll
                    for (int j = 0; j < 4; ++j) r[j] = __builtin_amdgcn_rcpf(d[j]);
                    o[n] = (g * r) * (li * 4.0f + 4.0f); }
                    w2[q2].x = pk4_fp8(o[0].x, o[0].y, o[0].z, o[0].w); w2[q2].y = pk4_fp8(o[1].x, o[1].y, o[1].z, o[1].w); }
                const auto sx = __builtin_amdgcn_permlane16_swap(w2[0].x, w2[1].x, false, false), sy = __builtin_amdgcn_permlane16_swap(w2[0].y, w2[1].y, false, false);
                *(v4u*)(A2 + (size_t)(row0 + ai * 128 + (2 * p + od) * 16) * DM + gc - 8 * od) = (v4u){sx[0], sy[0], sx[1], sy[1]}; }
    }
};
struct EpiMoe1 {
    static constexpr bool PERM = true; static constexpr int NST = 8;
    bf16* A2; const float* b1;
    __device__ __forceinline__ void operator()(const f32x4 (&acc)[2][2][4][2], const Unit& u, int wr, int wc, int fr, int fq) const {
        const int row0 = u.pm * 256 + wr * 64 + fr, gc = u.nn * 128 + wc * 32 + 8 * fq; const float* bp = b1 + (size_t)u.e * 2048;
        f32x4 bg[2], bl[2];
#pragma unroll
        for (int n = 0; n < 2; ++n) { bg[n] = *(const f32x4*)(bp + gc + 4 * n); bl[n] = *(const f32x4*)(bp + 1024 + gc + 4 * n); }
#pragma unroll
        for (int ai = 0; ai < 2; ++ai)
#pragma unroll
            for (int m = 0; m < 4; ++m) { f32x4 o[2];
#pragma unroll
                for (int n = 0; n < 2; ++n)
#pragma unroll
                    for (int j = 0; j < 4; ++j) { const float g = fminf(acc[ai][0][m][n][j] + bg[n][j], 7.0f), li = fminf(fmaxf(acc[ai][1][m][n][j] + bl[n][j], -7.0f), 7.0f);
                        o[n][j] = g * sigmoidf_(1.702f * g) * (li + 1.0f); }
                *(v4u*)(A2 + (size_t)(row0 + ai * 128 + m * 16) * DM + gc) = pack8(o[0], o[1]); }
    }
};

template <int VAR = 0> struct EpiMoe2T {
    static constexpr bool PERM = true; static constexpr int NST = (VAR == 2) ? 0 : 16;
    bf16* Y; const float* b2; float sc;
    __device__ __forceinline__ void operator()(const f32x4 (&acc)[2][2][4][2], const Unit& u, int wr, int wc, int fr, int fq) const {
        const int row0 = u.pm * 256 + wr * 64 + fr, c0 = u.nn * 256 + wc * 32 + 8 * fq; const float* bp = b2 + (size_t)u.e * DM;
        f32x4 bv[2][2];
#pragma unroll
        for (int bj = 0; bj < 2; ++bj)
#pragma unroll
            for (int n = 0; n < 2; ++n) bv[bj][n] = (VAR == 1) ? (f32x4){sc, sc, sc, sc} : *(const f32x4*)(bp + c0 + bj * 128 + 4 * n);
        float sink = 0.f;
#pragma unroll
        for (int ai = 0; ai < 2; ++ai)
#pragma unroll
            for (int m = 0; m < 4; ++m) { const size_t ro = (size_t)(row0 + ai * 128 + m * 16) * YLD + c0;
#pragma unroll
                for (int bj = 0; bj < 2; ++bj) { const f32x4 v0 = acc[ai][bj][m][0] * sc + bv[bj][0], v1 = acc[ai][bj][m][1] * sc + bv[bj][1];
                    if (VAR == 2) { const v4u p = pack8(v0, v1); sink += __uint_as_float(p.x ^ p.y ^ p.z ^ p.w); } else *(v4u*)(Y + ro + bj * 128) = pack8(v0, v1); } }
        if (VAR == 2) asm volatile("" :: "v"(sink));
    }
};
typedef EpiMoe2T<0> EpiMoe2;
struct EpiMoe2Y8 {
    static constexpr bool PERM = true; static constexpr int NST = 8;
    unsigned char* Y; const float* b2; float sc;
    __device__ __forceinline__ void operator()(const f32x4 (&acc)[2][2][4][2], const Unit& u, int wr, int wc, int fr, int fq) const {
        const int od = fq & 1, row0 = u.pm * 256 + wr * 64 + fr + 16 * od, c0 = u.nn * 256 + wc * 32 + 8 * fq; const float* bp = b2 + (size_t)u.e * DM;
        f32x4 bv[2][2]; const float s32 = sc * YSC;
#pragma unroll
        for (int bj = 0; bj < 2; ++bj)
#pragma unroll
            for (int n = 0; n < 2; ++n) bv[bj][n] = *(const f32x4*)(bp + c0 + bj * 128 + 4 * n) * YSC;
#pragma unroll
        for (int ai = 0; ai < 2; ++ai)
#pragma unroll
            for (int p = 0; p < 2; ++p) { const size_t ro = (size_t)(row0 + ai * 128 + p * 32) * YLD + c0 - 8 * od;
#pragma unroll
                for (int bj = 0; bj < 2; ++bj) { v2u w[2];
#pragma unroll
                    for (int q2 = 0; q2 < 2; ++q2) { f32x4 v0 = acc[ai][bj][2 * p + q2][0] * s32 + bv[bj][0], v1 = acc[ai][bj][2 * p + q2][1] * s32 + bv[bj][1];
#pragma unroll
                        for (int q = 0; q < 4; ++q) { v0[q] = __builtin_fminf(__builtin_fmaxf(v0[q], -448.0f), 448.0f); v1[q] = __builtin_fminf(__builtin_fmaxf(v1[q], -448.0f), 448.0f); }
                        w[q2].x = pk4_fp8(v0.x, v0.y, v0.z, v0.w); w[q2].y = pk4_fp8(v1.x, v1.y, v1.z, v1.w); }
                    const auto sx = __builtin_amdgcn_permlane16_swap(w[0].x, w[1].x, false, false), sy = __builtin_amdgcn_permlane16_swap(w[0].y, w[1].y, false, false);
                    *(v4u*)(Y + ro + bj * 128) = (v4u){sx[0], sy[0], sx[1], sy[1]}; } }
    }
};

__device__ __forceinline__ void hgrn_scan(Frame& F, int j) {
    relaunder(F);
    const bf16* Q = (const bf16*)(F.ws + WS_R1); const bf16* LFb = (const bf16*)(F.ws + WS_R1 + 128 * MiB); const bf16* V = (const bf16*)(F.ws + WS_R1 + 256 * MiB); const bf16* SG = (const bf16*)(F.ws + WS_R1 + 384 * MiB);
    bf16* O = (bf16*)(F.ws + WS_R2);
    LAS float* Qs = (LAS float*)(F.lds); LAS float* Ks = Qs + 4096; LAS float* Fs = Qs + 8192; LAS float* Vs = Qs + 12288; LAS float* P = Qs + 16384;
    const int v = F.tid & 127, kq = F.tid >> 7, t16 = F.tid >> 4, c8 = (F.tid & 15) * 8;
    f32x4 gain0 = *(const f32x4*)(KIN(I_HGAIN) + j * 128 + c8), gain1 = *(const f32x4*)(KIN(I_HGAIN) + j * 128 + c8 + 4);
    for (int u = F.vcu; u < NBATCH * HG_H; u += F.G) {
        const int b = u / HG_H, h = u % HG_H;
        float S[32];
#pragma unroll
        for (int i = 0; i < 32; ++i) S[i] = 0.f;
        for (int ch = 0; ch < SEQ / 32; ++ch) {
            const int row0 = b * SEQ + 32 * ch; const size_t gi = (size_t)(row0 + t16) * DM + h * 128 + c8;
            __syncthreads();
            { const v4u q = *(const v4u*)(Q + gi), lw = *(const v4u*)(LFb + gi), vv = *(const v4u*)(V + gi);
              const f32x4 f0 = (f32x4){exp2f(bflo(lw.x)), exp2f(bfhi(lw.x)), exp2f(bflo(lw.y)), exp2f(bfhi(lw.y))}, f1 = (f32x4){exp2f(bflo(lw.z)), exp2f(bfhi(lw.z)), exp2f(bflo(lw.w)), exp2f(bfhi(lw.w))};
              LAS f32x4* d;
              d = (LAS f32x4*)(Qs + t16 * 128 + c8); d[0] = (f32x4){bflo(q.x), bfhi(q.x), bflo(q.y), bfhi(q.y)}; d[1] = (f32x4){bflo(q.z), bfhi(q.z), bflo(q.w), bfhi(q.w)};
              d = (LAS f32x4*)(Ks + t16 * 128 + c8); d[0] = 1.0f - f0; d[1] = 1.0f - f1;
              d = (LAS f32x4*)(Vs + t16 * 128 + c8); d[0] = (f32x4){bflo(vv.x), bfhi(vv.x), bflo(vv.y), bfhi(vv.y)}; d[1] = (f32x4){bflo(vv.z), bfhi(vv.z), bflo(vv.w), bfhi(vv.w)};
              d = (LAS f32x4*)(Fs + t16 * 128 + c8); d[0] = f0; d[1] = f1; }
            __syncthreads();
            for (int t = 0; t < 32; ++t) {
                const float vt = Vs[t * 128 + v]; float a = 0.f;
#pragma unroll
                for (int i4 = 0; i4 < 8; ++i4) { const f32x4 f4 = *(const LAS f32x4*)(Fs + t * 128 + 32 * kq + 4 * i4), k4 = *(const LAS f32x4*)(Ks + t * 128 + 32 * kq + 4 * i4), q4 = *(const LAS f32x4*)(Qs + t * 128 + 32 * kq + 4 * i4);
#pragma unroll
                    for (int i = 0; i < 4; ++i) { S[4 * i4 + i] = f4[i] * S[4 * i4 + i] + k4[i] * vt; a += q4[i] * S[4 * i4 + i]; } }
                P[(t * 4 + kq) * 128 + v] = a;
            }
            __syncthreads();
            { f32x4 o0 = (f32x4){0.f, 0.f, 0.f, 0.f}, o1 = o0;
#pragma unroll
              for (int q = 0; q < 4; ++q) { o0 += *(const LAS f32x4*)(P + (t16 * 4 + q) * 128 + c8); o1 += *(const LAS f32x4*)(P + (t16 * 4 + q) * 128 + c8 + 4); }
              float ss = (o0.x * o0.x + o0.y * o0.y) + (o0.z * o0.z + o0.w * o0.w) + (o1.x * o1.x + o1.y * o1.y) + (o1.z * o1.z + o1.w * o1.w);
              ss += __shfl_xor(ss, 1); ss += __shfl_xor(ss, 2); ss += __shfl_xor(ss, 4); ss += __shfl_xor(ss, 8);
              const float r = 1.0f / sqrtf(ss * (1.0f / 128.f) + EPS);
              const v4u sg = *(const v4u*)(SG + gi);
              f32x4 a0 = o0 * r * gain0, a1 = o1 * r * gain1;
              a0.x *= bflo(sg.x); a0.y *= bfhi(sg.x); a0.z *= bflo(sg.y); a0.w *= bfhi(sg.y); a1.x *= bflo(sg.z); a1.y *= bfhi(sg.z); a1.z *= bflo(sg.w); a1.w *= bfhi(sg.w);
              *(v4u*)(O + gi) = pack8(a0, a1); }
        }
    }
}

__device__ __forceinline__ void ret_scan(Frame& F) {
    relaunder(F);
    const bf16* Q = (const bf16*)(F.ws + WS_R1); const bf16* K = (const bf16*)(F.ws + WS_R1 + 128 * MiB); const bf16* V = (const bf16*)(F.ws + WS_R1 + 256 * MiB); const bf16* SG = (const bf16*)(F.ws + WS_R1 + 512 * MiB);
    bf16* O = (bf16*)(F.ws + WS_R2);
    LAS bf16* Qs = (LAS bf16*)(F.lds); LAS bf16* Ks = (LAS bf16*)(F.lds + 33792); LAS bf16* Vs = (LAS bf16*)(F.lds + 67584);
    LAS float* St = (LAS float*)(F.lds + 133120); LAS float* wred = (LAS float*)(F.lds + 149504); LAS float* rtab = (LAS float*)(F.lds + 151552);
    for (int u = F.vcu; u < NBATCH * RT_H * 16; u += F.G) {
        const int bh = u >> 4, cp = u & 15, b = bh >> 2, h = bh & 3;
        const float lg2g = log2f(1.0f - exp2f(-5.0f - (float)h));
        for (int half = 0; half < 2; ++half) {
            const int c = half ? 31 - cp : cp; const int row0 = b * SEQ + 64 * c;
            __syncthreads();
#pragma unroll
            for (int i = 0; i < 4; ++i) { const int p = F.tid + 512 * i, r = p >> 5, cc = (p & 31) * 8; *(LAS v4u*)(Qs + r * 264 + cc) = *(const v4u*)(Q + (size_t)(row0 + r) * DM + h * 256 + cc); }
            float acc[64];
#pragma unroll
            for (int n = 0; n < 64; ++n) acc[n] = 0.f;
            for (int cq = 0; cq <= c; ++cq) {
                const int krow0 = b * SEQ + 64 * cq;
                __syncthreads();
#pragma unroll
                for (int i = 0; i < 4; ++i) { const int p = F.tid + 512 * i, r = p >> 5, cc = (p & 31) * 8; *(LAS v4u*)(Ks + r * 264 + cc) = *(const v4u*)(K + (size_t)(krow0 + r) * DM + h * 256 + cc); }
#pragma unroll
                for (int i = 0; i < 8; ++i) { const int p = F.tid + 512 * i, r = p >> 6, cc = (p & 63) * 8; *(LAS v4u*)(Vs + r * 512 + cc) = *(const v4u*)(V + (size_t)(krow0 + r) * 2048 + h * 512 + cc); }
                __syncthreads();
                { float s[8];
#pragma unroll
                  for (int j8 = 0; j8 < 8; ++j8) s[j8] = 0.f;
                  for (int dc = 0; dc < 32; ++dc) {
                      const v4u kv = *(const LAS v4u*)(Ks + F.lane * 264 + dc * 8);
                      const float k0 = bflo(kv.x), k1 = bfhi(kv.x), k2 = bflo(kv.y), k3 = bfhi(kv.y), k4 = bflo(kv.z), k5 = bfhi(kv.z), k6 = bflo(kv.w), k7 = bfhi(kv.w);
#pragma unroll
                      for (int j8 = 0; j8 < 8; ++j8) { const v4u qv = *(const LAS v4u*)(Qs + (8 * F.wave + j8) * 264 + dc * 8);
                          s[j8] += (bflo(qv.x) * k0 + bfhi(qv.x) * k1) + (bflo(qv.y) * k2 + bfhi(qv.y) * k3) + (bflo(qv.z) * k4 + bfhi(qv.z) * k5) + (bflo(qv.w) * k6 + bfhi(qv.w) * k7); }
                  }
                  f32x4 w0, w1;
#pragma unroll
                  for (int j8 = 0; j8 < 8; ++j8) { const float dist = fabsf((float)((64 * c + 8 * F.wave + j8) - (64 * cq + F.lane))); const float val = s[j8] * exp2f(dist * lg2g); if (j8 < 4) w0[j8] = val; else w1[j8 - 4] = val; }
                  *(LAS f32x4*)(St + F.lane * 64 + 8 * F.wave) = w0; *(LAS f32x4*)(St + F.lane * 64 + 8 * F.wave + 4) = w1; }
                __syncthreads();
                for (int m2 = 0; m2 < 64; ++m2) {
                    const float vv = bf2f(Vs[m2 * 512 + F.tid]);
#pragma unroll
                    for (int n4 = 0; n4 < 16; ++n4) { const f32x4 sv = *(const LAS f32x4*)(St + m2 * 64 + 4 * n4); acc[4 * n4 + 0] += sv.x * vv; acc[4 * n4 + 1] += sv.y * vv; acc[4 * n4 + 2] += sv.z * vv; acc[4 * n4 + 3] += sv.w * vv; }
                }
            }
#pragma unroll
            for (int n = 0; n < 64; ++n) { const float p = wave_sum(acc[n] * acc[n]); if (F.lane == 0) wred[F.wave * 64 + n] = p; }
            __syncthreads();
            if (F.tid < 64) { float s = 0.f;
#pragma unroll
                for (int w = 0; w < 8; ++w) s += wred[w * 64 + F.tid];
                rtab[F.tid] = 1.0f / sqrtf(s * (1.0f / 512.f) + EPS); }
            __syncthreads();
#pragma unroll
            for (int n = 0; n < 64; ++n) { const size_t gi = (size_t)(row0 + n) * 2048 + h * 512 + F.tid; const float sg = bf2f(SG[gi]); O[gi] = (bf16)(pk2(acc[n] * rtab[n] * sg, 0.f) & 0xffffu); }
        }
    }
}

typedef short s16x4 __attribute__((ext_vector_type(4)));
__device__ __forceinline__ unsigned off_b(unsigned row, unsigned ch) { return 256u * row + 16u * (ch ^ (((row & 3u) << 2) | ((row >> 2) & 3u))); }
__device__ __forceinline__ bf16x8 row_frag(const LAS unsigned char* tile, unsigned row, unsigned s4, unsigned g) { return *(const LAS bf16x8*)(tile + off_b(row, 4u * s4 + g)); }
__device__ __forceinline__ bf16x8 tr_frag16(const LAS unsigned char* tile, unsigned lane, unsigned c, unsigned ks) {
    const unsigned g = lane >> 4, q = (lane & 15u) >> 2, p = lane & 3u;
    const unsigned a0 = off_b(32u * ks + 8u * g + q, 2u * c + (p >> 1)) + 8u * (p & 1u), a1 = off_b(32u * ks + 8u * g + 4u + q, 2u * c + (p >> 1)) + 8u * (p & 1u);
    const s16x4 lo = __builtin_amdgcn_ds_read_tr16_b64_v4i16((LAS s16x4*)(tile + a0)), hi = __builtin_amdgcn_ds_read_tr16_b64_v4i16((LAS s16x4*)(tile + a1));
    return (bf16x8){lo[0], lo[1], lo[2], lo[3], hi[0], hi[1], hi[2], hi[3]};
}
#define RSB() __builtin_amdgcn_sched_barrier(0)
constexpr unsigned RQS = 528, RVS = 272;
template <unsigned RS> __device__ __forceinline__ bf16x8 tr_lin(const LAS unsigned char* img, unsigned trb, int c, int ks) {
    const s16x4 lo = __builtin_amdgcn_ds_read_tr16_b64_v4i16((LAS s16x4*)(img + trb + (32 * ks) * RS + 32 * c)), hi = __builtin_amdgcn_ds_read_tr16_b64_v4i16((LAS s16x4*)(img + trb + (32 * ks + 4) * RS + 32 * c));
    return (bf16x8){lo[0], lo[1], lo[2], lo[3], hi[0], hi[1], hi[2], hi[3]};
}
__device__ __forceinline__ void ret_scan_mfma(Frame& F) {
    relaunder(F);
    const bf16* Q = (const bf16*)(F.ws + WS_R1); const bf16* K = (const bf16*)(F.ws + WS_R1 + 128 * MiB); const bf16* V = (const bf16*)(F.ws + WS_R1 + 256 * MiB);
    bf16* O = (bf16*)(F.ws + WS_R2); float* SS = (float*)(F.ws + WS_R2 + 256 * MiB); const bf16* SGp = (const bf16*)(F.ws + WS_R1 + 512 * MiB);
    LAS unsigned char* Qi = F.lds; LAS unsigned char* Ki = F.lds + 33792; LAS unsigned char* Vi = F.lds + 67584; LAS unsigned char* Si = F.lds + 84992; LAS float* OT = (LAS float*)(F.lds + 94208);
    const unsigned w = (unsigned)F.wave;
    for (int u = F.vcu; u < NBATCH * RT_H * 4; u += F.G) {
        const int bh = u >> 2, vs = u & 3, b = bh >> 2, h = bh & 3;
        const float lg2g = log2f(1.0f - exp2f(-5.0f - (float)h)), cd = exp2f(64.0f * lg2g);
        f32x4 R[16];
#pragma unroll
        for (int i = 0; i < 16; ++i) R[i] = (f32x4){0.f, 0.f, 0.f, 0.f};
        v4u pq[4], pk[4], pv[2];
        { const int row0 = b * SEQ;
#pragma unroll
          for (int i = 0; i < 4; ++i) { const int p = F.tid + 512 * i, r = p >> 5, c32 = p & 31; pq[i] = *(const v4u*)(Q + (size_t)(row0 + r) * DM + h * 256 + c32 * 8); pk[i] = *(const v4u*)(K + (size_t)(row0 + r) * DM + h * 256 + c32 * 8); }
#pragma unroll
          for (int i = 0; i < 2; ++i) { const int p = F.tid + 512 * i, r = p >> 4, c16 = p & 15; pv[i] = *(const v4u*)(V + (size_t)(row0 + r) * 2048 + h * 512 + vs * 128 + c16 * 8); } }
        __syncthreads();
        for (int c = 0; c < SEQ / 64; ++c) {
            const int row0 = b * SEQ + 64 * c;
            unsigned tidl = (unsigned)F.tid; asm volatile("" : "+v"(tidl));
            const unsigned lane = tidl & 63u, g = lane >> 4, li = lane & 15u;
#pragma unroll
            for (int i = 0; i < 4; ++i) { const unsigned p = tidl + 512u * i, r = p >> 5, c32 = p & 31u; const unsigned o = r * RQS + 16u * c32; *(LAS v4u*)(Qi + o) = pq[i]; *(LAS v4u*)(Ki + o) = pk[i]; }
#pragma unroll
            for (int i = 0; i < 2; ++i) { const unsigned p = tidl + 512u * i, r = p >> 4, c16 = p & 15u; *(LAS v4u*)(Vi + r * RVS + 16u * c16) = pv[i]; }
            __syncthreads();
            if (c + 1 < SEQ / 64) { const int rn = row0 + 64;
#pragma unroll
                for (int i = 0; i < 4; ++i) { const unsigned p = tidl + 512u * i, r = p >> 5, c32 = p & 31u; pq[i] = *(const v4u*)(Q + (size_t)(rn + (int)r) * DM + h * 256 + c32 * 8); pk[i] = *(const v4u*)(K + (size_t)(rn + (int)r) * DM + h * 256 + c32 * 8); }
#pragma unroll
                for (int i = 0; i < 2; ++i) { const unsigned p = tidl + 512u * i, r = p >> 4, c16 = p & 15u; pv[i] = *(const v4u*)(V + (size_t)(rn + (int)r) * 2048 + h * 512 + vs * 128 + c16 * 8); } }
            RSB();
            const unsigned rb128 = li * RQS + 16u * g, rb64 = li * RQS + 8u * g, trq = (8u * g + (li >> 2)) * RQS + 8u * (li & 3u), trv = (8u * g + (li >> 2)) * RVS + 8u * (li & 3u);
            { const unsigned mt = w >> 1, nt0 = 2u * (w & 1u); f32x4 sa0 = (f32x4){0.f, 0.f, 0.f, 0.f}, sa1 = sa0;
              const LAS unsigned char* qrow = Qi + rb128 + mt * (16u * RQS); const LAS unsigned char* krow = Ki + rb128 + nt0 * (16u * RQS);
              bf16x8 qa[2][2], kb0[2][2], kb1[2][2];
#define RET_LDS(buf, s8b) do { _Pragma("unroll") for (int k2 = 0; k2 < 2; ++k2) { const int s8 = (s8b) + k2; \
                  qa[buf][k2] = *(const LAS bf16x8*)(qrow + 64 * s8); kb0[buf][k2] = *(const LAS bf16x8*)(krow + 64 * s8); kb1[buf][k2] = *(const LAS bf16x8*)(krow + 16 * RQS + 64 * s8); } } while (0)
              RET_LDS(0, 0); RSB();
#pragma unroll
              for (int bt = 0; bt < 4; ++bt) { if (bt < 3) RET_LDS((bt + 1) & 1, 2 * (bt + 1)); RSB();
#pragma unroll
                  for (int k2 = 0; k2 < 2; ++k2) { sa0 = __builtin_amdgcn_mfma_f32_16x16x32_bf16(qa[bt & 1][k2], kb0[bt & 1][k2], sa0, 0, 0, 0); sa1 = __builtin_amdgcn_mfma_f32_16x16x32_bf16(qa[bt & 1][k2], kb1[bt & 1][k2], sa1, 0, 0, 0); }
                  RSB(); }
#undef RET_LDS
#pragma unroll
              for (int q = 0; q < 4; ++q) { const int n = (int)(16u * mt + 4u * g) + q, m0 = (int)(16u * nt0 + li);
                  const float v0 = sa0[q] * exp2f(fabsf((float)(n - m0)) * lg2g), v1 = sa1[q] * exp2f(fabsf((float)(n - m0 - 16)) * lg2g); const unsigned pk = pk2(v0, v1);
                  *(LAS unsigned short*)(Si + (unsigned)n * 144u + 2u * (unsigned)m0) = (unsigned short)(pk & 0xffffu); *(LAS unsigned short*)(Si + (unsigned)n * 144u + 2u * (unsigned)m0 + 32u) = (unsigned short)(pk >> 16); } }
            RSB();
            f32x4 Oa[4];
#pragma unroll
            for (int mt = 0; mt < 4; ++mt) Oa[mt] = (f32x4){0.f, 0.f, 0.f, 0.f};
            { v2u qlo[2][4], qhi[2][4]; const LAS unsigned char* qp = Qi + rb64;
#define RET_LDQ(buf, s8) do { _Pragma("unroll") for (int mt = 0; mt < 4; ++mt) { qlo[buf][mt] = *(const LAS v2u*)(qp + mt * (16 * RQS) + 64 * (s8)); qhi[buf][mt] = *(const LAS v2u*)(qp + mt * (16 * RQS) + 64 * (s8) + 32); } } while (0)
              RET_LDQ(0, 0); RSB();
#pragma unroll
              for (int s8 = 0; s8 < 8; ++s8) { if (s8 < 7) RET_LDQ((s8 + 1) & 1, s8 + 1); RSB();
                  const v4u rt = (v4u){pk2(R[2 * s8][0], R[2 * s8][1]), pk2(R[2 * s8][2], R[2 * s8][3]), pk2(R[2 * s8 + 1][0], R[2 * s8 + 1][1]), pk2(R[2 * s8 + 1][2], R[2 * s8 + 1][3])}; const bf16x8 Rb = __builtin_bit_cast(bf16x8, rt);
#pragma unroll
                  for (int mt = 0; mt < 4; ++mt) { const v4u av = (v4u){qlo[s8 & 1][mt].x, qlo[s8 & 1][mt].y, qhi[s8 & 1][mt].x, qhi[s8 & 1][mt].y}; Oa[mt] = __builtin_amdgcn_mfma_f32_16x16x32_bf16(__builtin_bit_cast(bf16x8, av), Rb, Oa[mt], 0, 0, 0); }
                  RSB(); }
#undef RET_LDQ
            }
#pragma unroll
            for (int mt = 0; mt < 4; ++mt)
#pragma unroll
                for (int q = 0; q < 4; ++q) Oa[mt][q] *= exp2f((float)(16 * mt + 4 * (int)g + q + 1) * lg2g);
            __syncthreads();
            bf16x8 Vf[2], sf[4][2], ka[2][2][2];
#define RET_LDK(buf, dtb) do { _Pragma("unroll") for (int d2 = 0; d2 < 2; ++d2) _Pragma("unroll") for (int ks = 0; ks < 2; ++ks) ka[buf][d2][ks] = tr_lin<RQS>(Ki, trq, (dtb) + d2, ks); } while (0)
#pragma unroll
            for (int ks = 0; ks < 2; ++ks) Vf[ks] = tr_lin<RVS>(Vi + 32u * w, trv, 0, ks);
#pragma unroll
            for (int mt = 0; mt < 4; ++mt)
#pragma unroll
                for (int ks = 0; ks < 2; ++ks) sf[mt][ks] = *(const LAS bf16x8*)(Si + (16u * mt + li) * 144u + 64u * ks + 16u * g);
            RET_LDK(0, 0); RSB();
#pragma unroll
            for (int mt = 0; mt < 4; ++mt)
#pragma unroll
                for (int ks = 0; ks < 2; ++ks) Oa[mt] = __builtin_amdgcn_mfma_f32_16x16x32_bf16(sf[mt][ks], Vf[ks], Oa[mt], 0, 0, 0);
            bf16x8 Vd[2];
#pragma unroll
            for (int ks = 0; ks < 2; ++ks) { const v4u vv = __builtin_bit_cast(v4u, Vf[ks]); float f[8];
#pragma unroll
                for (int j = 0; j < 8; ++j) f[j] = exp2f((float)(63 - (32 * ks + 8 * (int)g + j)) * lg2g);
                const v4u sv = (v4u){pk2(bflo(vv.x) * f[0], bfhi(vv.x) * f[1]), pk2(bflo(vv.y) * f[2], bfhi(vv.y) * f[3]), pk2(bflo(vv.z) * f[4], bfhi(vv.z) * f[5]), pk2(bflo(vv.w) * f[6], bfhi(vv.w) * f[7])};
                Vd[ks] = __builtin_bit_cast(bf16x8, sv); }
            RSB();
#pragma unroll
            for (int bt = 0; bt < 8; ++bt) { if (bt < 7) RET_LDK((bt + 1) & 1, 2 * (bt + 1)); RSB();
#pragma unroll
                for (int d2 = 0; d2 < 2; ++d2) { const int dt = 2 * bt + d2; R[dt] = R[dt] * cd;
#pragma unroll
                    for (int ks = 0; ks < 2; ++ks) R[dt] = __builtin_amdgcn_mfma_f32_16x16x32_bf16(ka[bt & 1][d2][ks], Vd[ks], R[dt], 0, 0, 0); }
                RSB(); }
#undef RET_LDK
#pragma unroll
            for (int mt = 0; mt < 4; ++mt)
#pragma unroll
                for (int q = 0; q < 4; ++q) OT[(16u * mt + 4u * g + q) * 132u + 16u * w + li] = Oa[mt][q];
            __syncthreads();
            { const unsigned tn = tidl >> 3, vg = tidl & 7u; f32x4 o[4]; float ssq = 0.f;
#pragma unroll
              for (int i = 0; i < 4; ++i) { o[i] = *(const LAS f32x4*)(OT + tn * 132u + 16u * vg + 4u * i); ssq += (o[i].x * o[i].x + o[i].y * o[i].y) + (o[i].z * o[i].z + o[i].w * o[i].w); }
              ssq += __shfl_xor(ssq, 1); ssq += __shfl_xor(ssq, 2); ssq += __shfl_xor(ssq, 4);
              const size_t go = (size_t)(row0 + (int)tn) * 2048 + h * 512 + vs * 128 + 16 * vg; bf16* op = O + go;
              if (RET_FOLD) { const v4u g0 = *(const v4u*)(SGp + go), g1 = *(const v4u*)(SGp + go + 8);
                  o[0].x *= bflo(g0.x); o[0].y *= bfhi(g0.x); o[0].z *= bflo(g0.y); o[0].w *= bfhi(g0.y); o[1].x *= bflo(g0.z); o[1].y *= bfhi(g0.z); o[1].z *= bflo(g0.w); o[1].w *= bfhi(g0.w);
                  o[2].x *= bflo(g1.x); o[2].y *= bfhi(g1.x); o[2].z *= bflo(g1.y); o[2].w *= bfhi(g1.y); o[3].x *= bflo(g1.z); o[3].y *= bfhi(g1.z); o[3].z *= bflo(g1.w); o[3].w *= bfhi(g1.w); }
              *(v4u*)op = pack8(o[0], o[1]); *(v4u*)(op + 8) = pack8(o[2], o[3]);
              if (vg == 0) SS[((size_t)(row0 + (int)tn) * 4 + h) * 4 + vs] = ssq; }
        }
    }
}
__device__ __forceinline__ void ret_scan_mfma2(Frame& F) {
    relaunder(F);
    const bf16* Q = (const bf16*)(F.ws + WS_R1); const bf16* K = (const bf16*)(F.ws + WS_R1 + 128 * MiB); const bf16* V = (const bf16*)(F.ws + WS_R1 + 256 * MiB);
    bf16* O = (bf16*)(F.ws + WS_R2); float* SS = (float*)(F.ws + WS_R2 + 256 * MiB); const bf16* SGp = (const bf16*)(F.ws + WS_R1 + 512 * MiB);
    LAS unsigned char* Qi = F.lds; LAS unsigned char* Ki = F.lds + 33792; LAS unsigned char* Vi = F.lds + 67584; LAS unsigned char* Si = F.lds + 101376; LAS unsigned char* OT = F.lds + 110592;
    const unsigned w = (unsigned)F.wave;
    for (int u = F.vcu; u < NBATCH * RT_H * 2; u += F.G) {
        const int bh = u >> 1, vs2 = u & 1, b = bh >> 2, h = bh & 3, cbase = h * 512 + vs2 * 256;
        const float lg2g = log2f(1.0f - exp2f(-5.0f - (float)h)), cd = exp2f(64.0f * lg2g);
        f32x4 R[2][16];
#pragma unroll
        for (int cb = 0; cb < 2; ++cb)
#pragma unroll
            for (int i = 0; i < 16; ++i) R[cb][i] = (f32x4){0.f, 0.f, 0.f, 0.f};
        v4u pq[4], pk[4], pv[4];
        { const int row0 = b * SEQ;
#pragma unroll
          for (int i = 0; i < 4; ++i) { const int p = F.tid + 512 * i, r = p >> 5, c32 = p & 31; pq[i] = *(const v4u*)(Q + (size_t)(row0 + r) * DM + h * 256 + c32 * 8); pk[i] = *(const v4u*)(K + (size_t)(row0 + r) * DM + h * 256 + c32 * 8);
              pv[i] = *(const v4u*)(V + (size_t)(row0 + r) * 2048 + cbase + c32 * 8); } }
        __syncthreads();
        for (int c = 0; c < SEQ / 64; ++c) {
            const int row0 = b * SEQ + 64 * c;
            unsigned tidl = (unsigned)F.tid; asm volatile("" : "+v"(tidl));
            const unsigned lane = tidl & 63u, g = lane >> 4, li = lane & 15u;
#pragma unroll
            for (int i = 0; i < 4; ++i) { const unsigned p = tidl + 512u * i, r = p >> 5, c32 = p & 31u; const unsigned o = r * RQS + 16u * c32; *(LAS v4u*)(Qi + o) = pq[i]; *(LAS v4u*)(Ki + o) = pk[i]; *(LAS v4u*)(Vi + o) = pv[i]; }
            __syncthreads();
            RSB();
            const unsigned rb128 = li * RQS + 16u * g, rb64 = li * RQS + 8u * g, trq = (8u * g + (li >> 2)) * RQS + 8u * (li & 3u);
            { const unsigned mt = w >> 1, nt0 = 2u * (w & 1u); f32x4 sa0 = (f32x4){0.f, 0.f, 0.f, 0.f}, sa1 = sa0;
              const LAS unsigned char* qrow = Qi + rb128 + mt * (16u * RQS); const LAS unsigned char* krow = Ki + rb128 + nt0 * (16u * RQS);
              bf16x8 qa[2][2], kb0[2][2], kb1[2][2];
#define RET_LDS(buf, s8b) do { _Pragma("unroll") for (int k2 = 0; k2 < 2; ++k2) { const int s8 = (s8b) + k2; \
                  qa[buf][k2] = *(const LAS bf16x8*)(qrow + 64 * s8); kb0[buf][k2] = *(const LAS bf16x8*)(krow + 64 * s8); kb1[buf][k2] = *(const LAS bf16x8*)(krow + 16 * RQS + 64 * s8); } } while (0)
              RET_LDS(0, 0); RSB();
#pragma unroll
              for (int bt = 0; bt < 4; ++bt) { if (bt < 3) RET_LDS((bt + 1) & 1, 2 * (bt + 1)); RSB();
#pragma unroll
                  for (int k2 = 0; k2 < 2; ++k2) { sa0 = __builtin_amdgcn_mfma_f32_16x16x32_bf16(qa[bt & 1][k2], kb0[bt & 1][k2], sa0, 0, 0, 0); sa1 = __builtin_amdgcn_mfma_f32_16x16x32_bf16(qa[bt & 1][k2], kb1[bt & 1][k2], sa1, 0, 0, 0); }
                  RSB(); }
#undef RET_LDS
#pragma unroll
              for (int q = 0; q < 4; ++q) { const int n = (int)(16u * mt + 4u * g) + q, m0 = (int)(16u * nt0 + li);
                  const float v0 = sa0[q] * __builtin_amdgcn_exp2f(fabsf((float)(n - m0)) * lg2g), v1 = sa1[q] * __builtin_amdgcn_exp2f(fabsf((float)(n - m0 - 16)) * lg2g); const unsigned pk_ = pk2(v0, v1);
                  *(LAS unsigned short*)(Si + (unsigned)n * 144u + 2u * (unsigned)m0) = (unsigned short)(pk_ & 0xffffu); *(LAS unsigned short*)(Si + (unsigned)n * 144u + 2u * (unsigned)m0 + 32u) = (unsigned short)(pk_ >> 16); } }
            RSB();
            f32x4 Oa[4][2];
#pragma unroll
            for (int mt = 0; mt < 4; ++mt) { Oa[mt][0] = (f32x4){0.f, 0.f, 0.f, 0.f}; Oa[mt][1] = Oa[mt][0]; }
            { v2u qlo[2][4], qhi[2][4]; const LAS unsigned char* qp = Qi + rb64;
#define RET_LDQ(buf, s8) do { _Pragma("unroll") for (int mt = 0; mt < 4; ++mt) { qlo[buf][mt] = *(const LAS v2u*)(qp + mt * (16 * RQS) + 64 * (s8)); qhi[buf][mt] = *(const LAS v2u*)(qp + mt * (16 * RQS) + 64 * (s8) + 32); } } while (0)
              RET_LDQ(0, 0); RSB();
#pragma unroll
              for (int s8 = 0; s8 < 8; ++s8) { if (s8 < 7) RET_LDQ((s8 + 1) & 1, s8 + 1); RSB();
                  bf16x8 Rb[2];
#pragma unroll
                  for (int cb = 0; cb < 2; ++cb) { const v4u rt = (v4u){pk2(R[cb][2 * s8][0], R[cb][2 * s8][1]), pk2(R[cb][2 * s8][2], R[cb][2 * s8][3]), pk2(R[cb][2 * s8 + 1][0], R[cb][2 * s8 + 1][1]), pk2(R[cb][2 * s8 + 1][2], R[cb][2 * s8 + 1][3])}; Rb[cb] = __builtin_bit_cast(bf16x8, rt); }
#pragma unroll
                  for (int mt = 0; mt < 4; ++mt) { const v4u av = (v4u){qlo[s8 & 1][mt].x, qlo[s8 & 1][mt].y, qhi[s8 & 1][mt].x, qhi[s8 & 1][mt].y};
                      Oa[mt][0] = __builtin_amdgcn_mfma_f32_16x16x32_bf16(__builtin_bit_cast(bf16x8, av), Rb[0], Oa[mt][0], 0, 0, 0); Oa[mt][1] = __builtin_amdgcn_mfma_f32_16x16x32_bf16(__builtin_bit_cast(bf16x8, av), Rb[1], Oa[mt][1], 0, 0, 0); }
                  RSB(); }
#undef RET_LDQ
            }
#pragma unroll
            for (int mt = 0; mt < 4; ++mt)
#pragma unroll
                for (int q = 0; q < 4; ++q) { const float sc = __builtin_amdgcn_exp2f((float)(16 * mt + 4 * (int)g + q + 1) * lg2g); Oa[mt][0][q] *= sc; Oa[mt][1][q] *= sc; }
            __syncthreads();
            RSB();
            bf16x8 Vf[2][2];
#pragma unroll
            for (int cb = 0; cb < 2; ++cb)
#pragma unroll
                for (int ks = 0; ks < 2; ++ks) Vf[cb][ks] = tr_lin<RQS>(Vi + 64u * w + 32u * cb, trq, 0, ks);
#pragma unroll
            for (int mt = 0; mt < 4; ++mt) { const bf16x8 s0 = *(const LAS bf16x8*)(Si + (16u * mt + li) * 144u + 16u * g), s1 = *(const LAS bf16x8*)(Si + (16u * mt + li) * 144u + 64u + 16u * g);
#pragma unroll
                for (int cb = 0; cb < 2; ++cb) { Oa[mt][cb] = __builtin_amdgcn_mfma_f32_16x16x32_bf16(s0, Vf[cb][0], Oa[mt][cb], 0, 0, 0); Oa[mt][cb] = __builtin_amdgcn_mfma_f32_16x16x32_bf16(s1, Vf[cb][1], Oa[mt][cb], 0, 0, 0); } }
#pragma unroll
            for (int mt = 0; mt < 4; ++mt)
#pragma unroll
                for (int cb = 0; cb < 2; ++cb) { LAS unsigned char* op = OT + (16u * mt + 4u * g) * RQS + 2u * (32u * w + 16u * cb + li); const unsigned p0 = pk2(Oa[mt][cb][0], Oa[mt][cb][1]), p1 = pk2(Oa[mt][cb][2], Oa[mt][cb][3]);
                    *(LAS unsigned short*)(op) = (unsigned short)(p0 & 0xffffu); *(LAS unsigned short*)(op + RQS) = (unsigned short)(p0 >> 16); *(LAS unsigned short*)(op + 2 * RQS) = (unsigned short)(p1 & 0xffffu); *(LAS unsigned short*)(op + 3 * RQS) = (unsigned short)(p1 >> 16); }
            { const int rn = (c + 1 < SEQ / 64) ? row0 + 64 : row0;
#pragma unroll
                for (int i = 0; i < 4; ++i) { const unsigned p = tidl + 512u * i, r = p >> 5, c32 = p & 31u; pq[i] = *(const v4u*)(Q + (size_t)(rn + (int)r) * DM + h * 256 + c32 * 8); pk[i] = *(const v4u*)(K + (size_t)(rn + (int)r) * DM + h * 256 + c32 * 8);
                    pv[i] = *(const v4u*)(V + (size_t)(rn + (int)r) * 2048 + cbase + c32 * 8); } }
            RSB();
            bf16x8 Vd[2][2];
#pragma unroll
            for (int ks = 0; ks < 2; ++ks) { float f[8];
#pragma unroll
                for (int j = 0; j < 8; ++j) f[j] = __builtin_amdgcn_exp2f((float)(63 - (32 * ks + 8 * (int)g + j)) * lg2g);
#pragma unroll
                for (int cb = 0; cb < 2; ++cb) { const v4u vv = __builtin_bit_cast(v4u, Vf[cb][ks]);
                    const v4u sv = (v4u){pk2(bflo(vv.x) * f[0], bfhi(vv.x) * f[1]), pk2(bflo(vv.y) * f[2], bfhi(vv.y) * f[3]), pk2(bflo(vv.z) * f[4], bfhi(vv.z) * f[5]), pk2(bflo(vv.w) * f[6], bfhi(vv.w) * f[7])};
                    Vd[cb][ks] = __builtin_bit_cast(bf16x8, sv); } }
            {
#pragma unroll
              for (int bt = 0; bt < 8; ++bt) { bf16x8 ka[2][2];
#pragma unroll
                  for (int d2 = 0; d2 < 2; ++d2)
#pragma unroll
                      for (int ks = 0; ks < 2; ++ks) ka[d2][ks] = tr_lin<RQS>(Ki, trq, 2 * bt + d2, ks);
#pragma unroll
                  for (int d2 = 0; d2 < 2; ++d2) { const int dt = 2 * bt + d2;
#pragma unroll
                      for (int cb = 0; cb < 2; ++cb) { R[cb][dt] = R[cb][dt] * cd;
#pragma unroll
                          for (int ks = 0; ks < 2; ++ks) R[cb][dt] = __builtin_amdgcn_mfma_f32_16x16x32_bf16(ka[d2][ks], Vd[cb][ks], R[cb][dt], 0, 0, 0); } }
              }
            }
            __syncthreads();
            { const unsigned tn = tidl >> 3, vg = tidl & 7u; float ssq = 0.f;
              const size_t go = (size_t)(row0 + (int)tn) * 2048 + cbase + 32 * vg; bf16* op = O + go;
              v4u sg[4];
#pragma unroll
              for (int i = 0; i < 4; ++i) sg[i] = *(const v4u*)(SGp + go + 8 * i);
#pragma unroll
              for (int i = 0; i < 4; ++i) { const v4u r_ = *(const LAS v4u*)(OT + tn * RQS + 64u * vg + 16u * i); f32x4 o0 = (f32x4){bflo(r_.x), bfhi(r_.x), bflo(r_.y), bfhi(r_.y)}, o1 = (f32x4){bflo(r_.z), bfhi(r_.z), bflo(r_.w), bfhi(r_.w)};
                  ssq += (o0.x * o0.x + o0.y * o0.y) + (o0.z * o0.z + o0.w * o0.w) + (o1.x * o1.x + o1.y * o1.y) + (o1.z * o1.z + o1.w * o1.w);
                  const v4u gq = sg[i]; o0.x *= bflo(gq.x); o0.y *= bfhi(gq.x); o0.z *= bflo(gq.y); o0.w *= bfhi(gq.y); o1.x *= bflo(gq.z); o1.y *= bfhi(gq.z); o1.z *= bflo(gq.w); o1.w *= bfhi(gq.w);
                  *(v4u*)(op + 8 * i) = pack8(o0, o1); }
              ssq += __shfl_xor(ssq, 1); ssq += __shfl_xor(ssq, 2);
              if ((vg & 3u) == 0u) SS[((size_t)(row0 + (int)tn) * 4 + h) * 4 + 2 * vs2 + (int)(vg >> 2)] = ssq; }
        }
    }
}
__device__ __forceinline__ void ret_norm(Frame& F, bool dry = false) {
    relaunder(F);
    bf16* O = (bf16*)(F.ws + WS_R2); bf16* Od = dry ? (bf16*)(F.ws + WS_R2 + 288 * MiB) : O; const float* SS = (const float*)(F.ws + WS_R2 + 256 * MiB); const bf16* SG = (const bf16*)(F.ws + WS_R1 + 512 * MiB);
    const int gw = F.vcu * NWAVES + F.wave, NGW = F.G * NWAVES;
    for (int row = gw; row < MTOK; row += NGW) {
        float r[4];
#pragma unroll
        for (int h = 0; h < 4; ++h) { const f32x4 p = *(const f32x4*)(SS + ((size_t)row * 4 + h) * 4); r[h] = 1.0f / sqrtf(((p.x + p.y) + (p.z + p.w)) * (1.0f / 512.f) + EPS); }
#pragma unroll
        for (int j = 0; j < 4; ++j) { const size_t gi = (size_t)row * 2048 + 512 * j + 8 * F.lane; const v4u o = *(const v4u*)(O + gi), sg = *(const v4u*)(SG + gi); const float rr = r[j];
            v4u w; w.x = pk2(bflo(o.x) * rr * bflo(sg.x), bfhi(o.x) * rr * bfhi(sg.x)); w.y = pk2(bflo(o.y) * rr * bflo(sg.y), bfhi(o.y) * rr * bfhi(sg.y));
            w.z = pk2(bflo(o.z) * rr * bflo(sg.z), bfhi(o.z) * rr * bfhi(sg.z)); w.w = pk2(bflo(o.w) * rr * bflo(sg.w), bfhi(o.w) * rr * bfhi(sg.w));
            *(v4u*)(Od + gi) = w; }
    }
}

__device__ __forceinline__ bf16x8 pad8(s16x4 a) { return (bf16x8){a[0], a[1], a[2], a[3], 0, 0, 0, 0}; }
__device__ __forceinline__ void hgrn_scan_mfma(Frame& F, int j) {
    relaunder(F);
    const bf16* Q = (const bf16*)(F.ws + WS_R1); const bf16* LFb = (const bf16*)(F.ws + WS_R1 + 128 * MiB); const bf16* V = (const bf16*)(F.ws + WS_R1 + 256 * MiB); const bf16* SG = (const bf16*)(F.ws + WS_R1 + 384 * MiB);
    bf16* O = (bf16*)(F.ws + WS_R2);
    LAS unsigned char* QEi = F.lds; LAS unsigned char* QE2i = F.lds + 17408; LAS unsigned char* KEi = F.lds + 34816; LAS unsigned char* Vi = F.lds + 52224;
    LAS float* BL = (LAS float*)(F.lds + 69632); LAS float* OT = (LAS float*)(F.lds + 71680);
    const unsigned w = (unsigned)F.wave;
    LAS float* GT = (LAS float*)(F.lds + 105472);
    if (F.tid < 128) GT[F.tid] = KIN(I_HGAIN)[j * 128 + F.tid];
    for (int u = F.vcu; u < NBATCH * HG_H; u += F.G) {
        const int b = u >> 3, h = u & 7;
        f32x4 S[8];
#pragma unroll
        for (int i = 0; i < 8; ++i) S[i] = (f32x4){0.f, 0.f, 0.f, 0.f};
        unsigned short plf[16], pq[16]; v4u pv[2];
        { const int kbp = F.tid >> 7, dp = F.tid & 127, row0 = b * SEQ;
#pragma unroll
          for (int t = 0; t < 16; ++t) { const size_t gi = (size_t)(row0 + 16 * kbp + t) * DM + h * 128 + dp; plf[t] = LFb[gi]; pq[t] = Q[gi]; }
#pragma unroll
          for (int i = 0; i < 2; ++i) { const int p = F.tid + 512 * i, r = p >> 4, c16 = p & 15; pv[i] = *(const v4u*)(V + (size_t)(row0 + r) * DM + h * 128 + c16 * 8); }
        }
        __syncthreads();
        for (int c = 0; c < SEQ / 64; ++c) {
            const int row0 = b * SEQ + 64 * c;
            unsigned tidl = (unsigned)F.tid; asm volatile("" : "+v"(tidl));
            const unsigned lane = tidl & 63u, g = lane >> 4, li = lane & 15u, kbp = tidl >> 7, dp = tidl & 127u;
            { float bs = 0.f, bsv[16];
#pragma unroll
              for (int t = 0; t < 16; ++t) { bs += bf2f(plf[t]); bsv[t] = bs; }
              const float bl = bsv[15], ebl = __builtin_amdgcn_exp2f(bl); const unsigned a0 = (16u * kbp) * RVS + 2u * dp;
              float eprev = ebl;
#pragma unroll
              for (int t = 0; t < 16; ++t) { const float bt = bsv[t], q = bf2f(pq[t]), e1 = __builtin_amdgcn_exp2f(bl - bt), ke = e1 - eprev; eprev = e1;
                  const unsigned w0 = pk2(q * __builtin_amdgcn_exp2f(bt), q * __builtin_amdgcn_exp2f(fminf(bt - bl, 115.f))), w1 = pk2(ke, 0.f);
                  *(LAS unsigned short*)(QEi + a0 + t * RVS) = (unsigned short)(w0 & 0xffffu); *(LAS unsigned short*)(QE2i + a0 + t * RVS) = (unsigned short)(w0 >> 16); *(LAS unsigned short*)(KEi + a0 + t * RVS) = (unsigned short)(w1 & 0xffffu); }
              BL[kbp * 128u + dp] = ebl; }
#pragma unroll
            for (int i = 0; i < 2; ++i) { const unsigned p = tidl + 512u * i, r = p >> 4, c16 = p & 15u; *(LAS v4u*)(Vi + r * RVS + 16u * c16) = pv[i]; }
            __syncthreads();
            const v4u csg0 = *(const v4u*)(SG + (size_t)(row0 + (int)(tidl >> 3)) * DM + h * 128 + 16 * (tidl & 7u)), csg1 = *(const v4u*)(SG + (size_t)(row0 + (int)(tidl >> 3)) * DM + h * 128 + 16 * (tidl & 7u) + 8);
            asm volatile("" ::: "memory");
            { const int rn = (c + 1 < SEQ / 64) ? row0 + 64 : row0;
#pragma unroll
                for (int t = 0; t < 16; ++t) { const unsigned vo = ((16u * kbp + (unsigned)t) * DM + dp) * 2u;
                    plf[t] = *(const unsigned short*)((const char*)(LFb + (size_t)rn * DM + h * 128) + vo); pq[t] = *(const unsigned short*)((const char*)(Q + (size_t)rn * DM + h * 128) + vo); }
#pragma unroll
                for (int i = 0; i < 2; ++i) { const unsigned p = tidl + 512u * i, r = p >> 4, c16 = p & 15u; pv[i] = *(const v4u*)(V + (size_t)(rn + (int)r) * DM + h * 128 + c16 * 8); }
            }
            RSB();
            const unsigned rb128 = li * RVS + 16u * g, rb64 = li * RVS + 8u * g, trb = (4u * g + (li >> 2)) * RVS + 8u * (li & 3u);
            f32x4 P[4];
            { bf16x8 kef[2][4], q2f[2][4];
#define HG_LDP(buf, kb_) do { _Pragma("unroll") for (int s4 = 0; s4 < 4; ++s4) { kef[buf][s4] = *(const LAS bf16x8*)(KEi + (kb_) * (16u * RVS) + rb128 + 64 * s4); q2f[buf][s4] = *(const LAS bf16x8*)(QE2i + (kb_) * (16u * RVS) + rb128 + 64 * s4); } } while (0)
              HG_LDP(0, 0); RSB();
#pragma unroll
              for (int kb = 0; kb < 4; ++kb) { if (kb < 3) HG_LDP((kb + 1) & 1, kb + 1); RSB();
                  f32x4 p_ = (f32x4){0.f, 0.f, 0.f, 0.f};
#pragma unroll
                  for (int s4 = 0; s4 < 4; ++s4) p_ = __builtin_amdgcn_mfma_f32_16x16x32_bf16(kef[kb & 1][s4], q2f[kb & 1][s4], p_, 0, 0, 0);
                  P[kb] = p_; RSB(); }
#undef HG_LDP
            }
            { v2u qlo[2][4], qhi[2][4]; s16x4 Vbb[2];
#define HG_LDQ(buf, kb_) do { Vbb[buf] = __builtin_amdgcn_ds_read_tr16_b64_v4i16((LAS s16x4*)(Vi + (kb_) * (16u * RVS) + trb + 32u * w)); \
                  _Pragma("unroll") for (int s4 = 0; s4 < 4; ++s4) { qlo[buf][s4] = *(const LAS v2u*)(QEi + (kb_) * (16u * RVS) + rb64 + 64 * s4); qhi[buf][s4] = *(const LAS v2u*)(QEi + (kb_) * (16u * RVS) + rb64 + 64 * s4 + 32); } } while (0)
              HG_LDQ(0, 0); RSB();
#pragma unroll
              for (int kb = 0; kb < 4; ++kb) {
                  const unsigned ko = kb * (16u * RVS);
                  s16x4 ktf[8]; f32x4 e4[8];
#pragma unroll
                  for (int dt = 0; dt < 8; ++dt) { ktf[dt] = __builtin_amdgcn_ds_read_tr16_b64_v4i16((LAS s16x4*)(KEi + ko + trb + 32 * dt)); e4[dt] = *(const LAS f32x4*)(BL + kb * 128u + 16u * dt + 4u * g); }
                  if (kb < 3) HG_LDQ((kb + 1) & 1, kb + 1);
                  RSB();
                  f32x4 oa = (f32x4){0.f, 0.f, 0.f, 0.f};
#pragma unroll
                  for (int s4 = 0; s4 < 4; ++s4) {
                      const v4u st = (v4u){pk2(S[2 * s4][0], S[2 * s4][1]), pk2(S[2 * s4][2], S[2 * s4][3]), pk2(S[2 * s4 + 1][0], S[2 * s4 + 1][1]), pk2(S[2 * s4 + 1][2], S[2 * s4 + 1][3])};
                      const v4u av = (v4u){qlo[kb & 1][s4].x, qlo[kb & 1][s4].y, qhi[kb & 1][s4].x, qhi[kb & 1][s4].y};
                      oa = __builtin_amdgcn_mfma_f32_16x16x32_bf16(__builtin_bit_cast(bf16x8, av), __builtin_bit_cast(bf16x8, st), oa, 0, 0, 0); }
                  s16x4 a16;
                  { const f32x4 Pk = P[kb]; const unsigned lo = pk2((4u * g + 0u <= li) ? Pk[0] : 0.f, (4u * g + 1u <= li) ? Pk[1] : 0.f), hi = pk2((4u * g + 2u <= li) ? Pk[2] : 0.f, (4u * g + 3u <= li) ? Pk[3] : 0.f); const v2u t2 = (v2u){lo, hi}; a16 = __builtin_bit_cast(s16x4, t2); }
                  const bf16x8 Vb8 = pad8(Vbb[kb & 1]);
                  oa = __builtin_amdgcn_mfma_f32_16x16x32_bf16(pad8(a16), Vb8, oa, 0, 0, 0);
#pragma unroll
                  for (int dt = 0; dt < 8; ++dt) S[dt] = __builtin_amdgcn_mfma_f32_16x16x32_bf16(pad8(ktf[dt]), Vb8, S[dt] * e4[dt], 0, 0, 0);
#pragma unroll
                  for (int q = 0; q < 4; ++q) OT[(16u * kb + 4u * g + q) * 132u + 16u * w + li] = oa[q];
                  RSB();
              }
#undef HG_LDQ
            }
            __syncthreads();
            { const unsigned tn = tidl >> 3, vg = tidl & 7u; f32x4 o[4]; float ss = 0.f;
#pragma unroll
              for (int i = 0; i < 4; ++i) { o[i] = *(const LAS f32x4*)(OT + tn * 132u + 16u * vg + 4u * i); ss += (o[i].x * o[i].x + o[i].y * o[i].y) + (o[i].z * o[i].z + o[i].w * o[i].w); }
              ss += __shfl_xor(ss, 1); ss += __shfl_xor(ss, 2); ss += __shfl_xor(ss, 4);
              const float r = 1.0f / sqrtf(ss * (1.0f / 128.f) + EPS);
#pragma unroll
              for (int i = 0; i < 4; ++i) o[i] = o[i] * r * *(const LAS f32x4*)(GT + 16u * vg + 4u * i);
              if (HGRN_OUT_FP8) {
                  f32x4 sgv[4] = {(f32x4){bflo(csg0.x), bfhi(csg0.x), bflo(csg0.y), bfhi(csg0.y)}, (f32x4){bflo(csg0.z), bfhi(csg0.z), bflo(csg0.w), bfhi(csg0.w)}, (f32x4){bflo(csg1.x), bfhi(csg1.x), bflo(csg1.y), bfhi(csg1.y)}, (f32x4){bflo(csg1.z), bfhi(csg1.z), bflo(csg1.w), bfhi(csg1.w)}};
                  v4u w8;
#pragma unroll
                  for (int i = 0; i < 4; ++i) { f32x4 t = o[i] * sgv[i] * 8.0f; t = __builtin_elementwise_min(__builtin_elementwise_max(t, (f32x4){-448.f, -448.f, -448.f, -448.f}), (f32x4){448.f, 448.f, 448.f, 448.f}); w8[i] = pk4_fp8(t.x, t.y, t.z, t.w); }
                  *(v4u*)((unsigned char*)O + (size_t)(row0 + (int)tn) * DM + h * 128 + 16 * vg) = w8;
              } else {
              v4u w0, w1;
              w0.x = pk2(o[0].x * bflo(csg0.x), o[0].y * bfhi(csg0.x)); w0.y = pk2(o[0].z * bflo(csg0.y), o[0].w * bfhi(csg0.y)); w0.z = pk2(o[1].x * bflo(csg0.z), o[1].y * bfhi(csg0.z)); w0.w = pk2(o[1].z * bflo(csg0.w), o[1].w * bfhi(csg0.w));
              w1.x = pk2(o[2].x * bflo(csg1.x), o[2].y * bfhi(csg1.x)); w1.y = pk2(o[2].z * bflo(csg1.y), o[2].w * bfhi(csg1.y)); w1.z = pk2(o[3].x * bflo(csg1.z), o[3].y * bfhi(csg1.z)); w1.w = pk2(o[3].z * bflo(csg1.w), o[3].w * bfhi(csg1.w));
              bf16* op = O + (size_t)(row0 + (int)tn) * DM + h * 128 + 16 * vg; *(v4u*)op = w0; *(v4u*)(op + 8) = w1; } }
        }
    }
}

struct Args { const void* in[22]; float* out; unsigned char* ws; int ph_lo, ph_hi; };
constexpr int PH_PER_LAYER = 9, NPHASES = 1 + DEPTH * PH_PER_LAYER + 1;

__global__ void __launch_bounds__(NWAVES * 64, 2) hybrid_fwd(Args args) {
    extern __shared__ __attribute__((aligned(16))) unsigned char lds[];
    Frame F;
    F.lds = (LAS unsigned char*)lds;
    F.tid = threadIdx.x; F.lane = F.tid & 63; F.wave = __builtin_amdgcn_readfirstlane(F.tid >> 6);
    F.G = gridDim.x; { const int bx = blockIdx.x; F.vcu = (F.G % 8 == 0) ? (bx % 8) * (F.G / 8) + bx / 8 : bx; }
    F.ws = args.ws; F.out = args.out; F.ctl = (unsigned*)(args.ws + WS_CTL);
    for (int u = F.tid; u < (LDS_BYTES - MISC_OFF) / 4; u += NWAVES * 64) ((LAS unsigned*)(F.lds + MISC_OFF))[u] = 0u;
    __syncthreads();
    const int lo = args.ph_lo, hi = args.ph_hi;
    XcdBarrier bar; bar.bar = F.ctl + CW_BAR; bar.x = 0; bar.st = nullptr;
    if (hi - lo > 1) bar = xcd_barrier_post(F.ctl + CW_BAR, (volatile LAS unsigned*)(F.lds + MISC_OFF) + 8);
#define IN(k) (lo <= (k) && (k) < hi)
#define SEAM(k) do { if (IN(k) && hi > (k) + 1) xcd_barrier(bar); } while (0)

    if (PH_EN(0) && IN(0)) { for (int rep = 0; rep < REPS(0); ++rep) p0_prologue(F); } SEAM(0);

#pragma unroll 1
    for (int l = 0; l < DEPTH; ++l) {
        const int pb = 1 + l * PH_PER_LAYER, j = l >> 1; const bool is_ret = (l & 1);
        if (PH_EN(1) && IN(pb + 0)) { row_phase1(F, l, 0); if (REPS(13) > 1 && l > 0) { __syncthreads(); row_phase1(F, l, 0, true); } }
        SEAM(pb + 0);
        if (IN(pb + 1)) {
            if (PH_EN(2) && !is_ret) {
                for (int rep = 0; rep < REPS(2); ++rep) {
                    if constexpr (HG_N8 > 0) {
                        pg8::Gemm g{(const bf16*)(F.ws + WS_H8), (const bf16*)(F.ws + WS_HWIN + (size_t)j * HG_N8 * DM), MTOK, HG_N8, DM / 2}; pg8::StaticOrder S; S.init(MTOK, HG_N8, F.G, (int)blockIdx.x);
                        const EpiHgrnIn E{F.ws + WS_R1, (const float*)(F.ws + WS_LBV) + j * DM, hg_smap(HGRN_FP8_MASK), 1.0f / 512.f};
                        pg8::gemm_phase<EpiHgrnIn, pg8::StaticOrder, true, true, false, true>(F.lds + RING_OFF, g, S, E); }
                    if constexpr (HG_N16 > 0) {
                        pg8::Gemm g{(const bf16*)(F.ws + WS_H), (const bf16*)(F.ws + WS_HWIN + 8 * MiB) + (size_t)j * HG_N16 * DM, MTOK, HG_N16, DM}; pg8::StaticOrder S; S.init(MTOK, HG_N16, F.G, (int)blockIdx.x);
                        const EpiHgrnIn E{F.ws + WS_R1, (const float*)(F.ws + WS_LBV) + j * DM, hg_smap(0xF & ~HGRN_FP8_MASK), 1.0f};
                        pg8::gemm_phase<EpiHgrnIn, pg8::StaticOrder, true, true>(F.lds + RING_OFF, g, S, E); }
                }
            } else if (PH_EN(3)) {
                pg8::StaticOrder S; S.init(MTOK, RT_N, F.G, (int)blockIdx.x);
                if constexpr (RET_IN_FP8) {
                    pg8::Gemm g{(const bf16*)(F.ws + WS_H8), (const bf16*)(F.ws + WS_RWIN + (size_t)j * RT_N * DM), MTOK, RT_N, DM / 2};
                    EpiRetIn E{F.ws + WS_R1, (const int*)kin_(I_POS), 1.0f / 512.f};
                    for (int rep = 0; rep < REPS(3); ++rep) pg8::gemm_phase<EpiRetIn, pg8::StaticOrder, true, true, false, true>(F.lds + RING_OFF, g, S, E);
                } else {
                    pg8::Gemm g{(const bf16*)(F.ws + WS_H), (const bf16*)(F.ws + WS_RWIN) + (size_t)j * RT_N * DM, MTOK, RT_N, DM};
                    EpiRetIn E{F.ws + WS_R1, (const int*)kin_(I_POS), 1.0f};
                    for (int rep = 0; rep < REPS(3); ++rep) pg8::gemm_phase<EpiRetIn, pg8::StaticOrder, true, true>(F.lds + RING_OFF, g, S, E);
                }
            }
        }
        SEAM(pb + 1);
        if (IN(pb + 2)) { if (!is_ret) { if (PH_EN(4)) { for (int rep = 0; rep < REPS(4); ++rep) { if (HGRN_MFMA) hgrn_scan_mfma(F, j); else hgrn_scan(F, j); } } } else { if (PH_EN(5)) { for (int rep = 0; rep < REPS(5); ++rep) { if (RET_MFMA && RET_WIDE && RET_FOLD) ret_scan_mfma2(F); else if (RET_MFMA) ret_scan_mfma(F); else ret_scan(F); } } } }
        SEAM(pb + 2);
        if (RET_MFMA && !RET_FOLD && PH_EN(12) && IN(pb + 3) && is_ret) { if (REPS(14) > 1) ret_norm(F, true); ret_norm(F); }
        if (RET_MFMA && !RET_FOLD && is_ret) SEAM(pb + 3);
        if (PH_EN(6) && IN(pb + 4)) {
            const int Ko = is_ret ? 2048 : DM;
            const bf16* Wt = is_ret ? (const bf16*)(F.ws + WS_RWOUT) + (size_t)j * DM * 2048 : (const bf16*)(F.ws + WS_HWOUT) + (size_t)j * DM * DM;
            pg8::Gemm g{(const bf16*)(F.ws + WS_R2), Wt, MTOK, DM, Ko}; pg8::StaticOrder S; S.init(MTOK, DM, F.G, (int)blockIdx.x);
            const float* gate1 = (const float*)(F.ws + WS_MOD) + (size_t)l * NBATCH * 6 * DM + 2 * DM; bf16* xb = (bf16*)(F.ws + WS_XB);
            if (REPS(15) > 1) { EpiOutT<false> Ed{l == 0 ? (const void*)(F.ws + WS_R1 + 512 * MiB) : (const void*)xb, (bf16*)(F.ws + WS_R1), gate1, 1.0f}; pg8::gemm_phase<EpiOutT<false>, pg8::StaticOrder, true, true>(F.lds + RING_OFF, g, S, Ed); }
            if (RET_MFMA && RET_FOLD && is_ret) { const pg8::HScale hs{(const float*)(F.ws + WS_R2 + 256 * MiB), (LAS float*)(F.lds + 131072), EPS}; const EpiOutT<false> E{xb, xb, gate1, 1.0f};
                pg8::gemm_phase<EpiOutT<false>, pg8::StaticOrder, true, true, false, false, false, true>(F.lds + RING_OFF, g, S, E, hs); }
            else if (HGRN_OUT_FP8 && !is_ret) { const pg8::Gemm g8{(const bf16*)(F.ws + WS_R2), (const bf16*)(F.ws + WS_HWOUT + (size_t)j * DM * DM), MTOK, DM, DM / 2};
                if (l == 0) { const EpiOutT<true> E{KIN(I_X), xb, gate1, 1.0f / 512.f}; pg8::gemm_phase<EpiOutT<true>, pg8::StaticOrder, true, true, false, true>(F.lds + RING_OFF, g8, S, E); }
                else { const EpiOutT<false> E{xb, xb, gate1, 1.0f / 512.f}; pg8::gemm_phase<EpiOutT<false>, pg8::StaticOrder, true, true, false, true>(F.lds + RING_OFF, g8, S, E); } }
            else if (l == 0) { const EpiOutT<true> E{KIN(I_X), xb, gate1, 1.0f}; pg8::gemm_phase<EpiOutT<true>, pg8::StaticOrder, true, true>(F.lds + RING_OFF, g, S, E); }
            else { const EpiOutT<false> E{xb, xb, gate1, 1.0f}; pg8::gemm_phase<EpiOutT<false>, pg8::StaticOrder, true, true>(F.lds + RING_OFF, g, S, E); }
        }
        SEAM(pb + 4);
        if (PH_EN(7) && IN(pb + 5)) { if (REPS(18) > 1) row_phase2(F, l, true); row_phase2(F, l); }
        SEAM(pb + 5);
        if (MOE_GATHER_PASS) { if (PH_EN(8) && IN(pb + 6)) { for (int rep = 0; rep < REPS(8); ++rep) moe_gather(F, l); } SEAM(pb + 6); }
        if (PH_EN(9) && IN(pb + 7)) {
            build_tiles(F, l);
            if (!MOE_GATHER_PASS) moe_build_tt(F, 8);
            pg8::MoeOrder S{8, F.G, F.vcu, (const LAS int*)(F.lds + TAB_OFF), (const LAS unsigned short*)(F.lds + 131072)};
            if constexpr (MOE_FP8) {
                static_assert(!MOE_FP8 || !MOE_GATHER_PASS, "the fp8 expert GEMM gathers while staging");
                pg8::Gemm g{(const bf16*)(F.ws + WS_H8), (const bf16*)(F.ws + WS_W1T + (size_t)l * NEXP * 2048 * DM), 0, 0, DM / 2};
                EpiMoe1F8 E{F.ws + WS_R2, KIN(I_B1) + (size_t)l * NEXP * 2048};
                for (int rep = 0; rep < REPS(9); ++rep) pg8::gemm_phase<EpiMoe1F8, pg8::MoeOrder, MOE_ALIGN, true, true, true>(F.lds + RING_OFF, g, S, E);
                if (REPS(12) > 1) pg8::gemm_phase<EpiMoe1F8, pg8::MoeOrder, true, true, true, true, true>(F.lds + RING_OFF, g, S, E);
            } else {
                pg8::Gemm g{(const bf16*)(F.ws + (MOE_GATHER_PASS ? WS_R1 : WS_H)), (const bf16*)(F.ws + WS_W1T) + (size_t)l * NEXP * 2048 * DM, 0, 0, DM};
                EpiMoe1 E{(bf16*)(F.ws + WS_R2), KIN(I_B1) + (size_t)l * NEXP * 2048};
                for (int rep = 0; rep < REPS(9); ++rep) pg8::gemm_phase<EpiMoe1, pg8::MoeOrder, true, true, !MOE_GATHER_PASS>(F.lds + RING_OFF, g, S, E);
            }
        }
        SEAM(pb + 7);
        if (PH_EN(10) && IN(pb + 8)) {
            build_tiles(F, l);
            pg8::MoeOrder S{4, F.G, F.vcu, (const LAS int*)(F.lds + TAB_OFF), nullptr};
            if (SKEW_TICKS) phase_skew(F, SKEW_TICKS);
            if constexpr (MOE_FP8) {
                pg8::Gemm g{(const bf16*)(F.ws + WS_R2), (const bf16*)(F.ws + WS_W2T + (size_t)l * NEXP * DM * DM), 0, 0, DM / 2};
                EpiMoe2Y8 E{F.ws + WS_R1, KIN(I_B2) + (size_t)l * NEXP * DM, 1.0f / 256.f};
                for (int rep = 0; rep < REPS(10); ++rep) pg8::gemm_phase<EpiMoe2Y8, pg8::MoeOrder, MOE_ALIGN, true, false, true>(F.lds + RING_OFF, g, S, E);
            } else {
                pg8::Gemm g{(const bf16*)(F.ws + WS_R2), (const bf16*)(F.ws + WS_W2T) + (size_t)l * NEXP * DM * DM, 0, 0, DM};
                EpiMoe2 E{(bf16*)(F.ws + WS_R1), KIN(I_B2) + (size_t)l * NEXP * DM, 1.0f};
                for (int rep = 0; rep < REPS(10); ++rep) pg8::gemm_phase<EpiMoe2, pg8::MoeOrder, true, true>(F.lds + RING_OFF, g, S, E);
            }
        }
        SEAM(pb + 8);
    }
    if (PH_EN(11) && IN(NPHASES - 1)) row_phase1(F, DEPTH, 1);
#undef IN
#undef SEAM
}

extern "C" void kernel_launch(void* const* d_in, const int* in_sizes, int n_in, void* d_out, int out_size, void* d_ws, size_t ws_size, hipStream_t stream) {
    static int grid = 0;
    if (grid == 0) {
        if (n_in != 22 || in_sizes[0] != MTOK * DM || out_size != MTOK * DM || ws_size < WS_END) { fprintf(stderr, "kernel_launch: unexpected shapes (n_in %d, in0 %d, out %d, ws %zu < %zu)\n", n_in, n_in > 0 ? in_sizes[0] : -1, out_size, ws_size, (size_t)WS_END); grid = -1; return; }
        int dev = 0, cus = 0, per_cu = 0;
        if (hipGetDevice(&dev) != hipSuccess || hipDeviceGetAttribute(&cus, hipDeviceAttributeMultiprocessorCount, dev) != hipSuccess) { grid = -1; return; }
        if (hipFuncSetAttribute((const void*)hybrid_fwd, hipFuncAttributeMaxDynamicSharedMemorySize, LDS_BYTES) != hipSuccess) { fprintf(stderr, "kernel_launch: hipFuncSetAttribute failed\n"); grid = -1; return; }
        if (hipOccupancyMaxActiveBlocksPerMultiprocessor(&per_cu, (const void*)hybrid_fwd, NWAVES * 64, LDS_BYTES) != hipSuccess || per_cu < 1) { fprintf(stderr, "kernel_launch: occupancy query says %d blocks per CU\n", per_cu); }
        (void)hipGetLastError();
        if (cus != 256) { fprintf(stderr, "kernel_launch: built for a 256-CU device (one workgroup per CU); this one reports %d; nothing launched\n", cus); grid = -1; return; }
        grid = cus;
    }
    if (grid < 0) return;
    (void)hipMemsetAsync((char*)d_ws + WS_CTL, 0, CTL_ZERO_BYTES, stream);
    Args a{};
    for (int i = 0; i < 22; ++i) a.in[i] = d_in[i];
    a.out = (float*)d_out; a.ws = (unsigned char*)d_ws;
#if MK_SPLIT
    for (int p = 0; p < DBG_LIMIT; ++p) {
        if (p >= 1 && p < NPHASES - 1 && ((p - 1) % PH_PER_LAYER) == 3 && (!RET_MFMA || RET_FOLD || (((p - 1) / PH_PER_LAYER) & 1) == 0)) continue;
        if (!MOE_GATHER_PASS && p >= 1 && p < NPHASES - 1 && ((p - 1) % PH_PER_LAYER) == 6) continue;
        a.ph_lo = p; a.ph_hi = p + 1;
        hipLaunchKernelGGL(hybrid_fwd, dim3(grid), dim3(NWAVES * 64), LDS_BYTES, stream, a);
    }
#else
    a.ph_lo = 0; a.ph_hi = NPHASES;
    hipLaunchKernelGGL(hybrid_fwd, dim3(grid), dim3(NWAVES * 64), LDS_BYTES, stream, a);
#endif
    const hipError_t le = hipPeekAtLastError();
    if (le != hipSuccess) fprintf(stderr, "kernel_launch: launch failed: %s\n", hipGetErrorName(le));
}
```
